# Optimizing an MI355X kernel written in HIP

```python
import math
import jax, jax.numpy as jnp
from jax import lax
import numpy as np

D_MODEL = 1024
BATCH = 4
SEQ = 4096
DEPTH = 1
DEC_BATCH = 32
DEC_SEQ = 4
PAST_LEN = 8192
PAGE_SIZE = 128

HEAD_DIM = 64
NSA_HEADS = 8
NSA_KV_HEADS = 2
NSA_GROUP = NSA_HEADS // NSA_KV_HEADS
CMP_LEN = 32
CMP_STRIDE = 16
CMP_RATIO = CMP_LEN // CMP_STRIDE
CMP_HIDDEN = 64
SLC_BLOCK = 64
SLC_RATIO = SLC_BLOCK // CMP_STRIDE
N_SELECT = 16
WINDOW = 512
Q_BLOCK = 128
N_KV_SLOTS = 6
GLA_HEADS = 4
GLA_DK = 64
GLA_DV = 128
GLA_LOWRANK = 16
GLA_NORMALIZER = 16.0
GLA_CHUNK = 32
N_BUCKETS = 32
MAX_DISTANCE = 128
D_FF = ((8 * D_MODEL + 767) // 768) * 256
D_PLE = 256
EPS = 1e-6
NEG_INF = -1e30
FORCED_SCORE = 1e9

NSA_Q_DIM = NSA_HEADS * HEAD_DIM
NSA_KV_DIM = N_KV_SLOTS * NSA_KV_HEADS * HEAD_DIM
NSA_GATE_DIM = 3 * NSA_HEADS
GLA_QK_DIM = GLA_HEADS * GLA_DK
GLA_V_DIM = GLA_HEADS * GLA_DV
MIX_WIDTH = NSA_Q_DIM + GLA_V_DIM
IN_SPLITS = (NSA_Q_DIM, NSA_KV_DIM, NSA_GATE_DIM, GLA_QK_DIM, GLA_QK_DIM, GLA_V_DIM, GLA_LOWRANK, GLA_V_DIM)
IN_DIM = sum(IN_SPLITS)

kernel_name = "nsa_gla_hybrid_step"


def rmsnorm(x, g):
    xf = x.astype(jnp.float32)
    xf = xf * lax.rsqrt(jnp.mean(xf * xf, axis=-1, keepdims=True) + EPS)
    return xf.astype(x.dtype) * g


def t5_bucket(dist):
    n = jnp.maximum(dist, 0)
    max_exact = N_BUCKETS // 2
    nf = jnp.maximum(n, 1).astype(jnp.float32)
    large = max_exact + (jnp.log(nf / max_exact) / math.log(MAX_DISTANCE / max_exact)
                         * (N_BUCKETS - max_exact)).astype(jnp.int32)
    large = jnp.minimum(large, N_BUCKETS - 1)
    return jnp.where(n < max_exact, n, large)


def split_projection(xn, w_in):
    B, T, _ = xn.shape
    offs = np.cumsum(IN_SPLITS)[:-1].tolist()
    q_n, kv, gt, q_g, k_g, v_g, lr, g_g = jnp.split(xn @ w_in, offs, axis=-1)
    q_n = q_n.reshape(B, T, NSA_KV_HEADS, NSA_GROUP, HEAD_DIM)
    kv = kv.reshape(B, T, N_KV_SLOTS, NSA_KV_HEADS, HEAD_DIM)
    gt = jax.nn.sigmoid(gt).reshape(B, T, 3, NSA_KV_HEADS, NSA_GROUP, 1)
    q_g = q_g.reshape(B, T, GLA_HEADS, GLA_DK) * (GLA_DK ** -0.5)
    k_g = k_g.reshape(B, T, GLA_HEADS, GLA_DK)
    v_g = v_g.reshape(B, T, GLA_HEADS, GLA_DV)
    g_g = g_g.reshape(B, T, GLA_HEADS, GLA_DV)
    return q_n, kv, gt, q_g, k_g, v_g, lr, g_g


def compress_rows(rows, pe, w1, w2):
    B, T, G, HD = rows.shape
    nb = T // CMP_STRIDE
    sub = rows[:, :nb * CMP_STRIDE].reshape(B, nb, CMP_STRIDE, G, HD)
    pe_r = pe.reshape(CMP_RATIO, CMP_STRIDE, HD)
    w1_r = w1.reshape(CMP_RATIO, CMP_STRIDE, HD, CMP_HIDDEN)
    n_cmp = nb - CMP_RATIO + 1
    h = sum(jnp.einsum('bnsgd,sdh->bngh', sub[:, j:j + n_cmp] + pe_r[j][:, None, :], w1_r[j])
            for j in range(CMP_RATIO))
    return jnp.einsum('bngh,hd->bngd', jax.nn.gelu(h), w2)


def nsa_query_block(q, pos, k_cmp, v_cmp, k_slc, v_slc, rel_bias):
    B, Q, G, R, _ = q.shape
    scale = HEAD_DIM ** -0.5
    n_cmp = k_cmp.shape[1]
    n_slc = k_slc.shape[2]
    blk_end = jnp.arange(n_cmp, dtype=jnp.int32) * CMP_STRIDE + (CMP_LEN - 1)
    dist_c = pos[:, None] - blk_end[None, :]
    vis_c = (dist_c >= 0)[None, :, :, None, None]
    bias_c = rel_bias[t5_bucket(dist_c)].reshape(Q, n_cmp, G, R)
    s_c = jnp.einsum('bqgrd,bngd->bqngr', q, k_cmp).astype(jnp.float32) * scale + bias_c
    p_c = jax.nn.softmax(jnp.where(vis_c, s_c, NEG_INF), axis=2) * vis_c
    o_cmp = jnp.einsum('bqngr,bngd->bqgrd', p_c.astype(v_cmp.dtype), v_cmp)
    imp = jnp.swapaxes(p_c.sum(-1), 2, 3)
    lead = CMP_RATIO - 1
    total = SLC_RATIO * n_slc + lead
    imp = jnp.pad(imp, ((0, 0), (0, 0), (0, 0), (lead, total - lead - n_cmp)))
    span = SLC_RATIO * (n_slc - 1) + 1
    imp_slc = sum(imp[..., m - n + lead: m - n + lead + span: SLC_RATIO]
                  for m in range(SLC_RATIO) for n in range(CMP_RATIO))
    blk = jnp.arange(n_slc, dtype=jnp.int32)[None, :]
    cur = (pos // SLC_BLOCK)[:, None]
    vis_s = blk * SLC_BLOCK <= pos[:, None]
    forced = (blk == 0) | (blk == cur) | (blk == cur - 1)
    score = jnp.where(forced[None, :, None], FORCED_SCORE,
                      jnp.where(vis_s[None, :, None], imp_slc, -1.0))
    n_sel = min(N_SELECT, n_slc)
    _, idx = lax.top_k(score, n_sel)
    b_idx = jnp.arange(B)[:, None, None, None]
    g_idx = jnp.arange(G)[None, None, :, None]
    n_keys = n_sel * SLC_BLOCK
    ks = k_slc[b_idx, g_idx, idx].reshape(B, Q, G, n_keys, HEAD_DIM)
    vs = v_slc[b_idx, g_idx, idx].reshape(B, Q, G, n_keys, HEAD_DIM)
    key_pos = (idx[..., None] * SLC_BLOCK + jnp.arange(SLC_BLOCK, dtype=jnp.int32)).reshape(B, Q, G, n_keys)
    dist_s = pos[None, :, None, None] - key_pos
    table_g = rel_bias.reshape(N_BUCKETS, G, R).transpose(1, 0, 2)
    bias_s = table_g[g_idx, t5_bucket(dist_s)]
    s_s = jnp.einsum('bqgrd,bqgkd->bqgkr', q, ks).astype(jnp.float32) * scale + bias_s
    p_s = jax.nn.softmax(jnp.where((dist_s >= 0)[..., None], s_s, NEG_INF), axis=3)
    o_slc = jnp.einsum('bqgkr,bqgkd->bqgrd', p_s.astype(vs.dtype), vs)
    return o_cmp, o_slc


def nsa_global(q, pos, rows, cmp_pe, cmp_w1, cmp_w2, rel_bias, q_block):
    B, T = rows.shape[:2]
    k_cmp = compress_rows(rows[:, :, 0], cmp_pe[0], cmp_w1[0], cmp_w2[0])
    v_cmp = compress_rows(rows[:, :, 1], cmp_pe[1], cmp_w1[1], cmp_w2[1])
    n_slc = -(-T // SLC_BLOCK)
    slc = jnp.pad(rows[:, :, 2:4], ((0, 0), (0, n_slc * SLC_BLOCK - T), (0, 0), (0, 0), (0, 0)))
    slc = slc.reshape(B, n_slc, SLC_BLOCK, 2, NSA_KV_HEADS, HEAD_DIM).transpose(3, 0, 4, 1, 2, 5)
    Q = q.shape[1]
    nqb = Q // q_block
    qb = jnp.swapaxes(q.reshape(B, nqb, q_block, NSA_KV_HEADS, NSA_GROUP, HEAD_DIM), 0, 1)
    pb = pos.reshape(nqb, q_block)
    o_cmp, o_slc = lax.map(
        lambda a: nsa_query_block(a[0], a[1], k_cmp, v_cmp, slc[0], slc[1], rel_bias), (qb, pb))
    o_cmp = jnp.swapaxes(o_cmp, 0, 1).reshape(B, Q, NSA_KV_HEADS, NSA_GROUP, HEAD_DIM)
    o_slc = jnp.swapaxes(o_slc, 0, 1).reshape(B, Q, NSA_KV_HEADS, NSA_GROUP, HEAD_DIM)
    return o_cmp, o_slc


def window_attend(q, k, v, q_pos, k_pos, rel_bias):
    B, N, Q, G, R, _ = q.shape
    K = k.shape[2]
    dist = q_pos[:, :, None] - k_pos[:, None, :]
    valid = ((dist >= 0) & (dist < WINDOW) & (k_pos[:, None, :] >= 0))[None, :, :, :, None, None]
    bias = rel_bias[t5_bucket(dist)].reshape(N, Q, K, G, R)
    s = jnp.einsum('bnqgrd,bnkgd->bnqkgr', q, k).astype(jnp.float32) * (HEAD_DIM ** -0.5) + bias
    p = jax.nn.softmax(jnp.where(valid, s, NEG_INF), axis=3)
    return jnp.einsum('bnqkgr,bnkgd->bnqgrd', p.astype(v.dtype), v)


def gla_chunked(q, k, v, log_a, s0):
    B, T, H, _ = q.shape
    DV = v.shape[-1]
    C = min(GLA_CHUNK, T)
    nc = -(-T // C)
    pad = nc * C - T

    def blocks(a):
        a = jnp.pad(a.astype(jnp.float32), ((0, 0), (0, pad), (0, 0), (0, 0)))
        return jnp.swapaxes(a.reshape(B, nc, C, H, a.shape[-1]), 0, 1)

    causal = jnp.tril(jnp.ones((C, C), dtype=bool))

    def step(S, blk):
        qc, kc, vc, ac = blk
        b = jnp.cumsum(ac, axis=1)
        qe = qc * jnp.exp(b)
        ke = kc * jnp.exp(-b)
        att = jnp.where(causal, jnp.einsum('bihd,bjhd->bhij', qe, ke), 0.0)
        o = jnp.einsum('bhij,bjhv->bihv', att, vc) + jnp.einsum('bihd,bhdv->bihv', qe, S)
        b_last = b[:, -1]
        kd = kc * jnp.exp(b_last[:, None] - b)
        S = S * jnp.exp(b_last)[..., None] + jnp.einsum('bjhd,bjhv->bhdv', kd, vc)
        return S, o

    S, o = lax.scan(step, s0.astype(jnp.float32), (blocks(q), blocks(k), blocks(v), blocks(log_a)))
    o = jnp.swapaxes(o, 0, 1).reshape(B, nc * C, H, DV)[:, :T]
    return o, S


def gla_branch(q_g, k_g, v_g, lr, w_gk, b_gk, s0):
    B, T = q_g.shape[:2]
    log_a = jax.nn.log_sigmoid((lr @ w_gk + b_gk).astype(jnp.float32)) / GLA_NORMALIZER
    o, S = gla_chunked(q_g, k_g, v_g, log_a.reshape(B, T, GLA_HEADS, GLA_DK), s0)
    return o.astype(q_g.dtype), S


def mixer_output(o_cmp, o_slc, o_win, gates, o_gla, g_gla, gla_norm, w_o):
    B, T = o_cmp.shape[:2]
    o_nsa = (gates[:, :, 0] * o_cmp + gates[:, :, 1] * o_slc + gates[:, :, 2] * o_win).reshape(B, T, NSA_Q_DIM)
    o_g = (rmsnorm(o_gla, gla_norm) * jax.nn.silu(g_gla)).reshape(B, T, GLA_V_DIM)
    return jnp.concatenate([o_nsa, o_g], axis=-1) @ w_o


def mix_prompt(xn, w_in, cmp_pe, cmp_w1, cmp_w2, w_gk, b_gk, gla_norm, w_o, rel_bias):
    B, T, _ = xn.shape
    q_n, kv, gates, q_g, k_g, v_g, lr, g_g = split_projection(xn, w_in)
    pos = jnp.arange(T, dtype=jnp.int32)
    o_cmp, o_slc = nsa_global(q_n, pos, kv[:, :, :4], cmp_pe, cmp_w1, cmp_w2, rel_bias, min(Q_BLOCK, T))
    nb = T // Q_BLOCK
    nwb = WINDOW // Q_BLOCK
    wk = jnp.pad(kv[:, :, 4:], ((0, 0), (nwb * Q_BLOCK, 0), (0, 0), (0, 0), (0, 0)))
    wk = wk.reshape(B, nb + nwb, Q_BLOCK, 2, NSA_KV_HEADS, HEAD_DIM)
    band = jnp.concatenate([wk[:, j:j + nb] for j in range(nwb + 1)], axis=2)
    k_pos = (jnp.arange(nb, dtype=jnp.int32)[:, None] - nwb) * Q_BLOCK + jnp.arange((nwb + 1) * Q_BLOCK, dtype=jnp.int32)[None, :]
    o_win = window_attend(q_n.reshape(B, nb, Q_BLOCK, NSA_KV_HEADS, NSA_GROUP, HEAD_DIM),
                          band[:, :, :, 0], band[:, :, :, 1], pos.reshape(nb, Q_BLOCK), k_pos, rel_bias)
    o_win = o_win.reshape(B, T, NSA_KV_HEADS, NSA_GROUP, HEAD_DIM)
    s0 = jnp.zeros((B, GLA_HEADS, GLA_DK, GLA_DV), jnp.float32)
    o_gla, s_new = gla_branch(q_g, k_g, v_g, lr, w_gk, b_gk, s0)
    out = mixer_output(o_cmp, o_slc, o_win, gates, o_gla, g_g, gla_norm, w_o)
    keep = min(WINDOW, T)
    return out, kv[:, :, :4], kv[:, T - keep:, 4:], s_new


def mix_sample(xn, cache_kv, page_table, win_buf, s0, w_in, cmp_pe, cmp_w1, cmp_w2, w_gk, b_gk,
               gla_norm, w_o, rel_bias):
    B, Tn, _ = xn.shape
    q_n, kv, gates, q_g, k_g, v_g, lr, g_g = split_projection(xn, w_in)
    n_pages = page_table.shape[1]
    past_len = n_pages * cache_kv.shape[1]
    past = cache_kv[page_table].reshape(B, past_len, 4, NSA_KV_HEADS, HEAD_DIM)
    rows_full = jnp.concatenate([past, kv[:, :, :4].astype(past.dtype)], axis=1)
    pos = past_len + jnp.arange(Tn, dtype=jnp.int32)
    o_cmp, o_slc = nsa_global(q_n, pos, rows_full, cmp_pe, cmp_w1, cmp_w2, rel_bias, Tn)
    w_buf = win_buf.shape[1]
    win_full = jnp.concatenate([win_buf, kv[:, :, 4:].astype(win_buf.dtype)], axis=1)
    k_pos = past_len - w_buf + jnp.arange(w_buf + Tn, dtype=jnp.int32)
    o_win = window_attend(q_n[:, None], win_full[:, None, :, 0], win_full[:, None, :, 1],
                          pos[None], k_pos[None], rel_bias)[:, 0]
    o_gla, s_new = gla_branch(q_g, k_g, v_g, lr, w_gk, b_gk, s0)
    out = mixer_output(o_cmp, o_slc, o_win, gates, o_gla, g_g, gla_norm, w_o)
    return out, kv[:, :, :4], win_full[:, Tn:], s_new


def ffn_ple(h, p_l, norm_ffn, w_gate, w_up, w_down, w_ple, norm_ple, w_ple_gate):
    xn = rmsnorm(h, norm_ffn)
    h = h + (jax.nn.silu(xn @ w_gate) * (xn @ w_up)) @ w_down
    gate = jax.nn.sigmoid(rmsnorm(h, norm_ple) @ w_ple_gate)
    return h + (p_l @ w_ple) * gate


def setup_inputs(seed: int = 0) -> dict:
    key = jax.random.key(seed)
    ks = iter(jax.random.split(key, 32))
    nrm = lambda shape, s=1.0: jax.random.normal(next(ks), shape, jnp.float32) * s
    n_pages = PAST_LEN // PAGE_SIZE
    used = DEC_BATCH * n_pages
    n_pool = used + max(1, used // 4)
    w_buf = min(WINDOW, PAST_LEN)
    page_table = jax.random.permutation(next(ks), n_pool)[:used].reshape(DEC_BATCH, n_pages).astype(jnp.int32)
    return {
        'x_prompt': nrm((BATCH, SEQ, D_MODEL)),
        'x_sample': nrm((DEC_BATCH, DEC_SEQ, D_MODEL)),
        'cache_nsa_kv': nrm((DEPTH, n_pool, PAGE_SIZE, 4, NSA_KV_HEADS, HEAD_DIM)),
        'cache_win_kv': nrm((DEPTH, DEC_BATCH, w_buf, 2, NSA_KV_HEADS, HEAD_DIM)),
        'state_gla': nrm((DEPTH, DEC_BATCH, GLA_HEADS, GLA_DK, GLA_DV)),
        'page_table': page_table,
        'p_prompt': nrm((DEPTH, BATCH, SEQ, D_PLE)),
        'p_sample': nrm((DEPTH, DEC_BATCH, DEC_SEQ, D_PLE)),
        'norm_mix': 1.0 + nrm((DEPTH, D_MODEL), 0.1),
        'w_in': nrm((DEPTH, D_MODEL, IN_DIM), D_MODEL ** -0.5),
        'cmp_pe': nrm((DEPTH, 2, CMP_LEN, HEAD_DIM), 0.1),
        'cmp_w1': nrm((DEPTH, 2, CMP_LEN * HEAD_DIM, CMP_HIDDEN), (CMP_LEN * HEAD_DIM) ** -0.5),
        'cmp_w2': nrm((DEPTH, 2, CMP_HIDDEN, HEAD_DIM), CMP_HIDDEN ** -0.5),
        'w_gk': nrm((DEPTH, GLA_LOWRANK, GLA_QK_DIM), GLA_LOWRANK ** -0.5),
        'b_gk': nrm((DEPTH, GLA_QK_DIM), 0.1),
        'gla_norm': 1.0 + nrm((DEPTH, GLA_DV), 0.1),
        'w_o': nrm((DEPTH, MIX_WIDTH, D_MODEL), MIX_WIDTH ** -0.5),
        'norm_ffn': 1.0 + nrm((DEPTH, D_MODEL), 0.1),
        'w_gate': nrm((DEPTH, D_MODEL, D_FF), D_MODEL ** -0.5),
        'w_up': nrm((DEPTH, D_MODEL, D_FF), D_MODEL ** -0.5),
        'w_down': nrm((DEPTH, D_FF, D_MODEL), D_FF ** -0.5),
        'w_ple': nrm((DEPTH, D_PLE, D_MODEL), D_PLE ** -0.5),
        'norm_ple': 1.0 + nrm((DEPTH, D_MODEL), 0.1),
        'w_ple_gate': nrm((DEPTH, D_MODEL, D_MODEL), D_MODEL ** -0.5),
        'rel_bias': nrm((N_BUCKETS, NSA_HEADS), 0.5),
        'norm_final': 1.0 + nrm((D_MODEL,), 0.1),
    }


def reference(x_prompt, x_sample, cache_nsa_kv, cache_win_kv, state_gla, page_table, p_prompt, p_sample,
              norm_mix, w_in, cmp_pe, cmp_w1, cmp_w2, w_gk, b_gk, gla_norm, w_o, norm_ffn, w_gate, w_up,
              w_down, w_ple, norm_ple, w_ple_gate, rel_bias, norm_final):
    kv_p, kv_s, win_p, win_s, st_p, st_s = [], [], [], [], [], []
    h_p, h_s = x_prompt, x_sample
    for l in range(DEPTH):
        lw = (w_in[l], cmp_pe[l], cmp_w1[l], cmp_w2[l], w_gk[l], b_gk[l], gla_norm[l], w_o[l], rel_bias)
        fw = (norm_ffn[l], w_gate[l], w_up[l], w_down[l], w_ple[l], norm_ple[l], w_ple_gate[l])
        mix, rows, win, st = mix_prompt(rmsnorm(h_p, norm_mix[l]), *lw)
        h_p = ffn_ple(h_p + mix, p_prompt[l], *fw)
        kv_p.append(rows)
        win_p.append(win)
        st_p.append(st)
        mix, rows, win, st = mix_sample(rmsnorm(h_s, norm_mix[l]), cache_nsa_kv[l], page_table,
                                        cache_win_kv[l], state_gla[l], *lw)
        h_s = ffn_ple(h_s + mix, p_sample[l], *fw)
        kv_s.append(rows)
        win_s.append(win)
        st_s.append(st)
    y_prompt = rmsnorm(h_p, norm_final)
    y_sample = rmsnorm(h_s, norm_final)
    new_kv_prompt = jnp.stack(kv_p)
    new_kv_sample = jnp.stack(kv_s)
    new_win_prompt = jnp.stack(win_p)
    new_win_sample = jnp.stack(win_s)
    new_gla_prompt = jnp.stack(st_p)
    new_gla_sample = jnp.stack(st_s)
    return (y_prompt, y_sample, new_kv_prompt, new_kv_sample, new_win_prompt, new_win_sample, new_gla_prompt, new_gla_sample)
```

```cpp
#include <hip/hip_runtime.h>
#include <cstdio>
#include <cstdint>

constexpr int DM = 1024, TP = 16384, TS = 128, MTOT = TP + TS, MPAD = 16640, SEQ = 4096, NBATCH = 4, DBATCH = 32, DSEQ = 4, PAST = 8192;
constexpr int NPROJ = 3072, DFF = 2816, DPLE = 256, NGU = 2 * DFF;
constexpr int C_QN = 0, C_KV = 512, C_WIN = 1024, C_GT = 1280, C_QG = 1304, C_KG = 1560, C_VG = 1816, C_LR = 2328, C_GG = 2344, NIN = 2856;
constexpr float EPS = 1e-6f;
constexpr size_t O_Y = 0, O_KV = (size_t)MTOT * 1024, O_WINP = O_KV + (size_t)MTOT * 512, O_WINS = O_WINP + 4 * 512 * 256,
                 O_GLAP = O_WINS + (size_t)32 * 512 * 256, O_GLAS = O_GLAP + 4 * 4 * 64 * 128, O_END = O_GLAS + (size_t)32 * 4 * 64 * 128;
namespace pg8 {
#define PG8_LAS __attribute__((address_space(3)))
typedef unsigned short bf16_t;
typedef short bf16x8 __attribute__((ext_vector_type(8)));
typedef float f32x4 __attribute__((ext_vector_type(4)));
typedef unsigned u32x4 __attribute__((ext_vector_type(4)));
constexpr int BM = 256, BK = 64, HALF = 128, HTB = HALF * BK * 2  , STAGE_BYTES = 8 * HTB, NXCD = 8, WGM = 8;

__host__ __device__ __forceinline__ int lds_byte(int r, int c) { const int st = (r >> 4) * 2 + (c >> 5), rr = r & 15, cc = c & 31, ob = rr * 64 + cc * 2; return st * 1024 + (ob ^ (((ob >> 9) & 1) << 5)); }
__host__ __device__ __forceinline__ void stage_rc(int b, int& R, int& C) { const int st = b / 1024, sb = b % 1024, swz = sb ^ (((sb >> 9) & 1) << 5); R = (st >> 1) * 16 + swz / 64; C = (st & 1) * 32 + (swz % 64) / 2; }
__host__ __device__ __forceinline__ int perm32(int rho) { const int n = rho >> 4, i = rho & 15; return 8 * (i >> 2) + 4 * n + (i & 3); }

struct Unit { int pm, pn; };
struct Gemm { const bf16_t* A; const bf16_t* Bt; int M, N, K; };

struct StaticOrder {
    int nM, nN, nwg, G, c;
    __host__ __device__ void init(int M, int N, int G_, int c_) { nM = M / BM; nN = N / BM; nwg = nM * nN; G = G_; c = c_; }
    __host__ __device__ bool next(int i, Unit& u) const {
        const long L = (long)i * G + c; if (L >= nwg) return false;
        int wgid = (int)L; { const int q = nwg / NXCD, r = nwg % NXCD, xcd = wgid % NXCD, off = wgid / NXCD; wgid = (xcd < r ? xcd * (q + 1) : r * (q + 1) + (xcd - r) * q) + off; }
        const int nig = WGM * nN, gid = wgid / nig, fm = gid * WGM, gsz = (nM - fm) < WGM ? (nM - fm) : WGM;
        u.pm = fm + ((wgid % nig) % gsz); u.pn = (wgid % nig) / gsz; return true;
    }
    __device__ __forceinline__ void a_ready(const Unit&) const {}
    __device__ __forceinline__ void done(const Unit&) const {}
};

__device__ __forceinline__ unsigned cvt_pk_bf16(float lo, float hi) { unsigned r; asm volatile("v_cvt_pk_bf16_f32 %0, %1, %2" : "=v"(r) : "v"(lo), "v"(hi)); return r; }

__device__ __forceinline__ u32x4 pack8(const f32x4 v0, const f32x4 v1) { u32x4 w; w.x = cvt_pk_bf16(v0[0], v0[1]); w.y = cvt_pk_bf16(v0[2], v0[3]); w.z = cvt_pk_bf16(v1[0], v1[1]); w.w = cvt_pk_bf16(v1[2], v1[3]); return w; }

struct EpiInProj {
    static constexpr bool PERM = true, AFTER_DRAIN = false;
    bf16_t* proj; float* out;
    __device__ __forceinline__ void operator()(const f32x4 (&acc)[2][2][4][2], const Unit& u, int wr, int wc, int fr, int fq) const {
        const int row0 = u.pm * BM + wr * 64 + fr, colb = u.pn * BM + wc * 32 + 8 * fq;
        const float sc = (u.pn < 2) ? 0.125f : 1.0f;
#pragma unroll
        for (int ai = 0; ai < 2; ++ai)
#pragma unroll
            for (int m = 0; m < 4; ++m) {
                const int r = row0 + ai * HALF + m * 16;
                if (r < MTOT) {
#pragma unroll
                    for (int bj = 0; bj < 2; ++bj) {
                        const int c = colb + bj * HALF;
                        const f32x4 v0 = acc[ai][bj][m][0] * sc, v1 = acc[ai][bj][m][1] * sc;
                        *(u32x4*)(proj + (size_t)r * NPROJ + c) = pack8(v0, v1);
                        if (u.pn == 2 || u.pn == 3) { float* o = out + O_KV + (size_t)r * 512 + (c - C_KV); *(f32x4*)o = v0; *(f32x4*)(o + 4) = v1; }
                        if (u.pn == 4) {
                            const int cc = c - C_WIN; float* o = nullptr;
                            if (r < TP) { const int pos = r & (SEQ - 1), b = r >> 12; if (pos >= SEQ - 512) o = out + O_WINP + ((size_t)(b * 512 + pos - (SEQ - 512)) * 256 + cc); }
                            else { const int rs = r - TP, b = rs >> 2, i = rs & 3; o = out + O_WINS + ((size_t)(b * 512 + 508 + i) * 256 + cc); }
                            if (o) { *(f32x4*)o = v0; *(f32x4*)(o + 4) = v1; }
                        }
                    }
                }
            }
    }
};
struct EpiResid {
    static constexpr bool PERM = true, AFTER_DRAIN = false;
    const float* baseA; const float* baseB;
    float* hout; bf16_t* hb; float* rowss;
    __device__ __forceinline__ void operator()(const f32x4 (&acc)[2][2][4][2], const Unit& u, int wr, int wc, int fr, int fq) const {
        const int row0 = u.pm * BM + wr * 64 + fr, colb = u.pn * BM + wc * 32 + 8 * fq;
#pragma unroll
        for (int ai = 0; ai < 2; ++ai)
#pragma unroll
            for (int m = 0; m < 4; ++m) {
                const int r = row0 + ai * HALF + m * 16;
                float ss = 0.f;
                if (r < MTOT) {
                    const float* bp = (r < TP) ? baseA + (size_t)r * 1024 : baseB + (size_t)(r - TP) * 1024;
#pragma unroll
                    for (int bj = 0; bj < 2; ++bj) {
                        const int c = colb + bj * HALF;
                        const f32x4 v0 = acc[ai][bj][m][0] + *(const f32x4*)(bp + c), v1 = acc[ai][bj][m][1] + *(const f32x4*)(bp + c + 4);
                        float* o = hout + (size_t)r * 1024 + c; *(f32x4*)o = v0; *(f32x4*)(o + 4) = v1;
                        *(u32x4*)(hb + (size_t)r * 1024 + c) = pack8(v0, v1);
                        ss += (v0[0] * v0[0] + v0[1] * v0[1]) + (v0[2] * v0[2] + v0[3] * v0[3]) + (v1[0] * v1[0] + v1[1] * v1[1]) + (v1[2] * v1[2] + v1[3] * v1[3]);
                    }
                }
                ss += __shfl_xor(ss, 16); ss += __shfl_xor(ss, 32);
                if (fq == 0 && r < MTOT) atomicAdd(rowss + r, ss);
            }
    }
};
struct EpiGateUp {
    static constexpr bool PERM = true, AFTER_DRAIN = false;
    bf16_t* act; const float* rowss;
    __device__ __forceinline__ void operator()(const f32x4 (&acc)[2][2][4][2], const Unit& u, int wr, int wc, int fr, int fq) const {
        const int row0 = u.pm * BM + wr * 64 + fr, colb = u.pn * HALF + wc * 32 + 8 * fq;
#pragma unroll
        for (int ai = 0; ai < 2; ++ai)
#pragma unroll
            for (int m = 0; m < 4; ++m) {
                const int r = row0 + ai * HALF + m * 16;
                if (r < MTOT) {
                    const float rstd = __builtin_amdgcn_rsqf(rowss[r] * (1.0f / 1024.0f) + EPS);
                    f32x4 o[2];
#pragma unroll
                    for (int n = 0; n < 2; ++n)
#pragma unroll
                        for (int e = 0; e < 4; ++e) { const float g = acc[ai][0][m][n][e] * rstd, up = acc[ai][1][m][n][e] * rstd; o[n][e] = g * up * __builtin_amdgcn_rcpf(1.0f + __expf(-g)); }
                    *(u32x4*)(act + (size_t)r * DFF + colb) = pack8(o[0], o[1]);
                }
            }
    }
};
struct EpiBf {
    static constexpr bool PERM = true, AFTER_DRAIN = false;
    bf16_t* O; int ldc;
    __device__ __forceinline__ void operator()(const f32x4 (&acc)[2][2][4][2], const Unit& u, int wr, int wc, int fr, int fq) const {
        const int row0 = u.pm * BM + wr * 64 + fr, colb = u.pn * BM + wc * 32 + 8 * fq;
#pragma unroll
        for (int ai = 0; ai < 2; ++ai)
#pragma unroll
            for (int m = 0; m < 4; ++m) {
                const int r = row0 + ai * HALF + m * 16;
                if (r < MTOT) {
#pragma unroll
                    for (int bj = 0; bj < 2; ++bj) *(u32x4*)(O + (size_t)r * ldc + colb + bj * HALF) = pack8(acc[ai][bj][m][0], acc[ai][bj][m][1]);
                }
            }
    }
};
struct EpiPleGate {
    static constexpr bool PERM = true, AFTER_DRAIN = false;
    const float* h2; const bf16_t* ple; const float* rowss2; float* y; float* rowss3;
    __device__ __forceinline__ void operator()(const f32x4 (&acc)[2][2][4][2], const Unit& u, int wr, int wc, int fr, int fq) const {
        const int row0 = u.pm * BM + wr * 64 + fr, colb = u.pn * BM + wc * 32 + 8 * fq;
#pragma unroll
        for (int ai = 0; ai < 2; ++ai)
#pragma unroll
            for (int m = 0; m < 4; ++m) {
                const int r = row0 + ai * HALF + m * 16;
                float ss = 0.f;
                if (r < MTOT) {
                    const float rstd = __builtin_amdgcn_rsqf(rowss2[r] * (1.0f / 1024.0f) + EPS);
#pragma unroll
                    for (int bj = 0; bj < 2; ++bj) {
                        const int c = colb + bj * HALF;
                        const u32x4 pw = *(const u32x4*)(ple + (size_t)r * 1024 + c);
                        const f32x4 b0 = *(const f32x4*)(h2 + (size_t)r * 1024 + c), b1 = *(const f32x4*)(h2 + (size_t)r * 1024 + c + 4);
                        float pv[8];
#pragma unroll
                        for (int e = 0; e < 4; ++e) { pv[2 * e] = __uint_as_float(pw[e] << 16); pv[2 * e + 1] = __uint_as_float(pw[e] & 0xffff0000u); }
                        f32x4 v0, v1;
#pragma unroll
                        for (int e = 0; e < 4; ++e) {
                            v0[e] = b0[e] + pv[e] * __builtin_amdgcn_rcpf(1.0f + __expf(-acc[ai][bj][m][0][e] * rstd));
                            v1[e] = b1[e] + pv[4 + e] * __builtin_amdgcn_rcpf(1.0f + __expf(-acc[ai][bj][m][1][e] * rstd));
                        }
                        float* o = y + (size_t)r * 1024 + c; *(f32x4*)o = v0; *(f32x4*)(o + 4) = v1;
                        ss += (v0[0] * v0[0] + v0[1] * v0[1]) + (v0[2] * v0[2] + v0[3] * v0[3]) + (v1[0] * v1[0] + v1[1] * v1[1]) + (v1[2] * v1[2] + v1[3] * v1[3]);
                    }
                }
                ss += __shfl_xor(ss, 16); ss += __shfl_xor(ss, 32);
                if (fq == 0 && r < MTOT) atomicAdd(rowss3 + r, ss);
            }
    }
};
template <class Epi, class Sched, bool ALIGN_EPI = false, bool SP2 = false>
__device__ __forceinline__ void gemm_phase(PG8_LAS unsigned char* lds, const Gemm g, const Sched& S, const Epi& E, const int tid) {
    const int wid = __builtin_amdgcn_readfirstlane(tid >> 6), lane = tid & 63, wr = wid >> 2, wc = wid & 3, fr = lane & 15, fq = lane >> 4;
    const int K = g.K, nt = K / BK;
    unsigned voffA[2], voffB[2];
#pragma unroll
    for (int i = 0; i < 2; ++i) { int R, C; stage_rc(tid * 16 + i * 8192, R, C); const int Rb = Epi::PERM ? ((R & ~31) + perm32(R & 31)) : R;
        voffA[i] = (unsigned)(R * K + C) * 2u; voffB[i] = (unsigned)(Rb * K + C) * 2u; }
    const size_t kstep = (size_t)(BK * 2);
    const size_t hstep = (size_t)HALF * K * 2;
    const size_t tstep = 2 * hstep;
    const unsigned ldsw = (unsigned)wid * 1024u;
    const int aoff = lds_byte(wr * 64 + fr, fq * 8), boff = lds_byte(wc * 32 + fr, fq * 8);
#define PG8_SA(b, h) (((b) * 2 + (h)) * HTB)
#define PG8_SB(b, h) ((4 + (b) * 2 + (h)) * HTB)
#define PG8_STAGE(bufoff, gbase, voff) do { _Pragma("unroll") for (int _i = 0; _i < 2; ++_i) \
        __builtin_amdgcn_global_load_lds((const unsigned*)((const char*)(gbase) + (voff)[_i]), (PG8_LAS unsigned*)(lds + (bufoff) + ldsw + _i * 8192), 16, 0, 0); } while (0)
#define PG8_LDA(dst, b, h) do { _Pragma("unroll") for (int m = 0; m < 4; ++m) _Pragma("unroll") for (int k = 0; k < 2; ++k) dst[m][k] = *(const PG8_LAS bf16x8*)(lds + PG8_SA(b, h) + aoff + m * 2048 + k * 1024); } while (0)
#define PG8_LDB(dst, b, h) do { _Pragma("unroll") for (int n = 0; n < 2; ++n) _Pragma("unroll") for (int k = 0; k < 2; ++k) dst[n][k] = *(const PG8_LAS bf16x8*)(lds + PG8_SB(b, h) + boff + n * 2048 + k * 1024); } while (0)
#define PG8_MMA(ai, bj, At, Bt) do { __builtin_amdgcn_s_setprio(1); _Pragma("unroll") for (int m = 0; m < 4; ++m) _Pragma("unroll") for (int n = 0; n < 2; ++n) _Pragma("unroll") for (int k = 0; k < 2; ++k) \
        acc[ai][bj][m][n] = __builtin_amdgcn_mfma_f32_16x16x32_bf16(Bt[n][k], At[m][k], acc[ai][bj][m][n], 0, 0, 0); __builtin_amdgcn_s_setprio(0); } while (0)
#define PG8_WAIT_V(n) asm volatile("s_waitcnt vmcnt(" #n ")" ::: "memory")
#define PG8_WAIT_L(n) asm volatile("s_waitcnt lgkmcnt(" #n ")" ::: "memory")
#define PG8_BAR __builtin_amdgcn_s_barrier()
#define PG8_SCHED __builtin_amdgcn_sched_barrier(0)
    Unit cur, nxt; int ui = 0;
    if (!S.next(0, cur)) return;
    f32x4 acc[2][2][4][2];
#pragma unroll
    for (int a = 0; a < 2; ++a)
#pragma unroll
        for (int b = 0; b < 2; ++b)
#pragma unroll
            for (int m = 0; m < 4; ++m)
#pragma unroll
                for (int n = 0; n < 2; ++n) acc[a][b][m][n] = (f32x4){0.f, 0.f, 0.f, 0.f};
    bf16x8 At[4][2], B0[2][2], B1[2][2];
    const char* cA = (const char*)g.A + (size_t)cur.pm * tstep; const char* cB = (const char*)g.Bt + (size_t)cur.pn * tstep;
    S.a_ready(cur);
    if constexpr (SP2) {
        PG8_STAGE(PG8_SB(0, 0), cB, voffB); PG8_STAGE(PG8_SB(0, 1), cB + hstep, voffB); PG8_STAGE(PG8_SA(0, 0), cA, voffA); PG8_STAGE(PG8_SA(0, 1), cA + hstep, voffA);
        if (wr == 1) PG8_BAR;
        PG8_WAIT_V(2); PG8_BAR;
        PG8_STAGE(PG8_SB(1, 0), cB + kstep, voffB); PG8_STAGE(PG8_SA(1, 0), cA + kstep, voffA); PG8_STAGE(PG8_SB(1, 1), cB + hstep + kstep, voffB);
        PG8_WAIT_V(6); PG8_BAR;
    } else {
        PG8_STAGE(PG8_SB(0, 0), cB, voffB); PG8_STAGE(PG8_SA(0, 0), cA, voffA); PG8_STAGE(PG8_SB(0, 1), cB + hstep, voffB); PG8_STAGE(PG8_SA(0, 1), cA + hstep, voffA);
        if (wr == 1) PG8_BAR;
        PG8_WAIT_V(4); PG8_BAR;
        PG8_STAGE(PG8_SB(1, 0), cB + kstep, voffB); PG8_STAGE(PG8_SA(1, 0), cA + kstep, voffA); PG8_STAGE(PG8_SB(1, 1), cB + hstep + kstep, voffB);
        PG8_WAIT_V(6); PG8_BAR;
    }
    for (;;) {
        const bool has_next = S.next(ui + 1, nxt);
        const char* nA = has_next ? (const char*)g.A + (size_t)nxt.pm * tstep : cA; const char* nB = has_next ? (const char*)g.Bt + (size_t)nxt.pn * tstep : cB;
        for (int t = 0; t < nt; t += 2) {
            const bool last = (t == nt - 2);
            const char* a1 = cA + (size_t)(t + 1) * kstep;
            const char* a2 = last ? nA : cA + (size_t)(t + 2) * kstep; const char* b2 = last ? nB : cB + (size_t)(t + 2) * kstep;
            const char* a3 = a2 + kstep; const char* b3 = b2 + kstep;
            if (last && has_next) S.a_ready(nxt);
            if constexpr (SP2) {
            PG8_LDB(B0, 0, 0); PG8_LDB(B1, 0, 1); PG8_SCHED; PG8_LDA(At, 0, 0); PG8_STAGE(PG8_SA(1, 1), a1 + hstep, voffA);
            PG8_WAIT_V(8); PG8_WAIT_L(0); PG8_BAR; PG8_MMA(0, 0, At, B0); PG8_MMA(0, 1, At, B1); PG8_BAR; PG8_SCHED;
            PG8_LDA(At, 0, 1); PG8_STAGE(PG8_SB(0, 0), b2, voffB); PG8_STAGE(PG8_SB(0, 1), b2 + hstep, voffB); PG8_STAGE(PG8_SA(0, 0), a2, voffA);
            PG8_WAIT_V(8); PG8_WAIT_L(0); PG8_BAR; PG8_MMA(1, 0, At, B0); PG8_MMA(1, 1, At, B1); PG8_BAR; PG8_SCHED;
            PG8_LDB(B0, 1, 0); PG8_LDB(B1, 1, 1); PG8_SCHED; PG8_LDA(At, 1, 0); PG8_STAGE(PG8_SA(0, 1), a2 + hstep, voffA);
            PG8_WAIT_V(8); PG8_WAIT_L(0); PG8_BAR; PG8_MMA(0, 0, At, B0); PG8_MMA(0, 1, At, B1); PG8_BAR; PG8_SCHED;
            PG8_LDA(At, 1, 1); PG8_STAGE(PG8_SB(1, 0), b3, voffB); PG8_STAGE(PG8_SB(1, 1), b3 + hstep, voffB); PG8_STAGE(PG8_SA(1, 0), a3, voffA);
            PG8_WAIT_V(8); PG8_WAIT_L(0); PG8_BAR; PG8_MMA(1, 0, At, B0); PG8_MMA(1, 1, At, B1); PG8_BAR; PG8_SCHED;
            } else {
            PG8_LDB(B0, 0, 0); PG8_SCHED; PG8_LDA(At, 0, 0); PG8_STAGE(PG8_SA(1, 1), a1 + hstep, voffA);
            PG8_WAIT_L(8); PG8_BAR; PG8_WAIT_L(0); PG8_MMA(0, 0, At, B0); PG8_BAR; PG8_SCHED;
            PG8_LDB(B1, 0, 1); PG8_STAGE(PG8_SB(0, 0), b2, voffB);
            PG8_BAR; PG8_WAIT_L(0); PG8_MMA(0, 1, At, B1); PG8_BAR;
            PG8_LDA(At, 0, 1); PG8_STAGE(PG8_SA(0, 0), a2, voffA);
            PG8_BAR; PG8_WAIT_L(0); PG8_MMA(1, 0, At, B0); PG8_BAR; PG8_SCHED;
            PG8_STAGE(PG8_SB(0, 1), b2 + hstep, voffB);
            PG8_WAIT_V(6); PG8_BAR; PG8_MMA(1, 1, At, B1); PG8_BAR;
            PG8_LDB(B0, 1, 0); PG8_SCHED; PG8_LDA(At, 1, 0); PG8_STAGE(PG8_SA(0, 1), a2 + hstep, voffA);
            PG8_WAIT_L(8); PG8_BAR; PG8_WAIT_L(0); PG8_MMA(0, 0, At, B0); PG8_BAR; PG8_SCHED;
            PG8_LDB(B1, 1, 1); PG8_STAGE(PG8_SB(1, 0), b3, voffB);
            PG8_BAR; PG8_WAIT_L(0); PG8_MMA(0, 1, At, B1); PG8_BAR;
            PG8_LDA(At, 1, 1); PG8_STAGE(PG8_SA(1, 0), a3, voffA);
            PG8_BAR; PG8_WAIT_L(0); PG8_MMA(1, 0, At, B0); PG8_BAR; PG8_SCHED;
            PG8_STAGE(PG8_SB(1, 1), b3 + hstep, voffB);
            PG8_WAIT_V(6); PG8_BAR; PG8_MMA(1, 1, At, B1); PG8_BAR;
            }
        }
        if constexpr (ALIGN_EPI) { if (wr == 0) PG8_BAR; }
        if constexpr (!Epi::AFTER_DRAIN) { E(acc, cur, wr, wc, fr, fq); S.done(cur); }
        if (!has_next) break;
#pragma unroll
        for (int a = 0; a < 2; ++a)
#pragma unroll
            for (int b = 0; b < 2; ++b)
#pragma unroll
                for (int m = 0; m < 4; ++m)
#pragma unroll
                    for (int n = 0; n < 2; ++n) acc[a][b][m][n] = (f32x4){0.f, 0.f, 0.f, 0.f};
        cur = nxt; cA = nA; cB = nB; ++ui;
        if constexpr (ALIGN_EPI) { if (wr == 1) PG8_BAR; }
    }
    PG8_WAIT_V(0);
    if constexpr (!ALIGN_EPI) { if (wr == 0) PG8_BAR; }
    PG8_BAR;
    if constexpr (Epi::AFTER_DRAIN) { E.fused(acc, cur, wr, wc, fr, fq, lds, wid, lane); S.done(cur); }
#undef PG8_SA
#undef PG8_SB
#undef PG8_STAGE
#undef PG8_LDA
#undef PG8_LDB
#undef PG8_MMA
#undef PG8_WAIT_V
#undef PG8_WAIT_L
#undef PG8_BAR
#undef PG8_SCHED
}
}


#define GAS __attribute__((address_space(1)))
#define LAS __attribute__((address_space(3)))
typedef unsigned short bf16;
typedef unsigned v4u __attribute__((ext_vector_type(4)));
typedef unsigned v2u __attribute__((ext_vector_type(2)));
typedef float f32x4 __attribute__((ext_vector_type(4)));
typedef float f32x2 __attribute__((ext_vector_type(2)));
typedef float f32x16 __attribute__((ext_vector_type(16)));
typedef short bf16x8 __attribute__((ext_vector_type(8)));
typedef short s16x4 __attribute__((ext_vector_type(4)));
typedef GAS unsigned gu32;
#define RLX_AGENT __ATOMIC_RELAXED, __HIP_MEMORY_SCOPE_AGENT
#define LDS_WAIT() asm volatile("s_waitcnt lgkmcnt(0)" ::: "memory")
#define VM_WAIT() asm volatile("s_waitcnt vmcnt(0)" ::: "memory")
__device__ __forceinline__ unsigned f2bf(float f) { unsigned u = __builtin_bit_cast(unsigned, f); return (u + 0x7fffu + ((u >> 16) & 1u)) >> 16; }
__device__ __forceinline__ unsigned pk2(float lo, float hi) { return f2bf(lo) | (f2bf(hi) << 16); }
__device__ __forceinline__ float bf2f(unsigned short h) { return __uint_as_float(((unsigned)h) << 16); }
__device__ __forceinline__ float bflo(unsigned w) { return __uint_as_float(w << 16); }
__device__ __forceinline__ float bfhi(unsigned w) { return __uint_as_float(w & 0xffff0000u); }

constexpr int NWAVES = 8;
constexpr size_t MiB = 1u << 20;
constexpr size_t WS_CTL = 0, CTL_ZERO_BYTES = 1 * MiB;
constexpr int CW_BAR = 4096;
constexpr size_t WS_ROWSS = 256 * 1024;
constexpr size_t WS_WIN = 2 * MiB;
constexpr size_t WS_WO = 8 * MiB;
constexpr size_t WS_WGU = 10 * MiB;
constexpr size_t WS_WDN = 21 * MiB;
constexpr size_t WS_WPG = 27 * MiB;
constexpr size_t WS_WPLE = 29 * MiB;
constexpr size_t WS_WC1 = 30 * MiB;
constexpr size_t WS_WC2 = 31 * MiB;
constexpr size_t WS_C1 = 31 * MiB + 65536;
constexpr size_t WS_KCP = 32 * MiB;
constexpr size_t WS_VCP = 33 * MiB;
constexpr size_t WS_KCS = 34 * MiB;
constexpr size_t WS_VCS = 38 * MiB;
constexpr size_t WS_DSC = 42 * MiB;
constexpr size_t WS_USC = 43 * MiB;
constexpr size_t WS_QB = 51 * MiB;
constexpr size_t WS_XN = 64 * MiB;
constexpr size_t WS_PPLE = 97 * MiB;
constexpr size_t WS_PROJ = 106 * MiB;
constexpr size_t WS_OWIN = 204 * MiB;
constexpr size_t WS_MIX = 221 * MiB;
constexpr size_t WS_OLOC = 254 * MiB;
constexpr size_t WS_H1 = 287 * MiB;
constexpr size_t WS_H1B = 353 * MiB;
constexpr size_t WS_ACT = 386 * MiB;
constexpr size_t WS_H2 = 476 * MiB;
constexpr size_t WS_H2B = 542 * MiB;
constexpr size_t WS_PLEB = 575 * MiB;
constexpr size_t WS_END = 608 * MiB;
constexpr int RING_BYTES = 131072;
constexpr int MISC_OFF = RING_BYTES + 320;
constexpr int LDS_BYTES = 147456;
#define XB_TMO      128
#define XB_XCNT(j)  (256  + 64 * (j))
#define XB_XSUB(j)  (1280 + 64 * (j))
#define XB_XGEN(j)  (2304 + 64 * (j))
#define XB_TOP      3328
#define XB_TOPGEN   3392
#define XCD_BAR_WORDS 3456
#define XB_SPIN_CAP (1u << 18)

__device__ __forceinline__ unsigned xb_ld(unsigned* p)              { return __hip_atomic_load(p, __ATOMIC_RELAXED, __HIP_MEMORY_SCOPE_AGENT); }
__device__ __forceinline__ unsigned xb_add(unsigned* p, unsigned v) { return __hip_atomic_fetch_add(p, v, __ATOMIC_RELAXED, __HIP_MEMORY_SCOPE_AGENT); }
__device__ __forceinline__ unsigned xb_xcc_id() { return (unsigned)__builtin_amdgcn_s_getreg((3 << 11) | 20) & 0xFu; }
#define XB_SPIN(cond, bar) do { unsigned _sp = 0; while (cond) { __builtin_amdgcn_s_sleep(1); \
    if ((++_sp & 255u) == 0u) { if (xb_ld(&(bar)[XB_TMO])) break; if (_sp > XB_SPIN_CAP) { atomicAdd(&(bar)[XB_TMO], 1u); break; } } } } while (0)

struct XcdBarrier {
    unsigned* bar; unsigned x;
    volatile LAS unsigned* st;
};

__device__ __forceinline__ XcdBarrier xcd_barrier_post(unsigned* bar, volatile LAS unsigned* st, const int tid) {
    XcdBarrier b; b.bar = bar; b.x = xb_xcc_id(); b.st = st;
    if (tid == 0) (void)xb_add(&bar[XB_XCNT(b.x)], 1u);
    return b;
}
__device__ __forceinline__ void xcd_barrier_complete(unsigned* bar, unsigned x, unsigned& nloc, unsigned& nx) {
    const unsigned G = gridDim.x * gridDim.y * gridDim.z;
    unsigned sum, cnt, mine, sp = 0u;
    for (;;) {
        sum = 0u; cnt = 0u; mine = 0u;
#pragma unroll
        for (unsigned j = 0; j < 16; ++j) { const unsigned c = xb_ld(&bar[XB_XCNT(j)]); sum += c; cnt += (c > 0u) ? 1u : 0u; mine = (j == x) ? c : mine; }
        if (sum == G) break;
        __builtin_amdgcn_s_sleep(1);
        if ((++sp & 255u) == 0u) { if (xb_ld(&bar[XB_TMO])) break; if (sp > XB_SPIN_CAP) { atomicAdd(&bar[XB_TMO], 1u); break; } }
    }
    nloc = mine > 0u ? mine : 1u; nx = cnt > 0u ? cnt : 1u;
}

__device__ __forceinline__ void xcd_barrier(const XcdBarrier& b, const int tid) {
    asm volatile("s_waitcnt vmcnt(0)" ::: "memory");
    __syncthreads();
    if (tid == 0) {
        unsigned* bar = b.bar;
        __builtin_amdgcn_s_waitcnt(0);
        unsigned nloc = b.st[0], nx = b.st[1];
        if (nloc == 0u) { xcd_barrier_complete(bar, b.x, nloc, nx); b.st[0] = nloc; b.st[1] = nx; }
        const unsigned old = xb_add(&bar[XB_XSUB(b.x)], 1u);
        const unsigned gen = old / nloc;
        if (old + 1u == (gen + 1u) * nloc) {
            __builtin_amdgcn_fence(__ATOMIC_RELEASE, "agent");
            asm volatile("s_waitcnt vmcnt(0)" ::: "memory");
            const unsigned og = xb_add(&bar[XB_TOP], 1u);
            const unsigned tg = og / nx;
            if (og + 1u == (tg + 1u) * nx) xb_add(&bar[XB_TOPGEN], 1u);
            else XB_SPIN(xb_ld(&bar[XB_TOPGEN]) == tg, bar);
            __builtin_amdgcn_fence(__ATOMIC_ACQUIRE, "agent");
            xb_add(&bar[XB_XGEN(b.x)], 1u);
            asm volatile("s_waitcnt vmcnt(0)" ::: "memory");
        } else {
            XB_SPIN(xb_ld(&bar[XB_XGEN(b.x)]) == gen, bar);
            __builtin_amdgcn_fence(__ATOMIC_ACQUIRE, "agent");
            asm volatile("s_waitcnt vmcnt(0)" ::: "memory");
        }
    }
    __syncthreads();
}

struct Args { const float* in[26]; float* out; unsigned char* ws; int ph_lo, ph_hi; };
struct Frame {
    LAS unsigned char* lds;
    int tid, lane, wave, vcu, G;
};
__device__ __forceinline__ int hw_lane() { int l; asm volatile("v_mbcnt_lo_u32_b32 %0, -1, 0\n\tv_mbcnt_hi_u32_b32 %0, -1, %0" : "=v"(l)); return l; }
__device__ __forceinline__ float wave_sum(float v) {
#pragma unroll
    for (int o = 1; o < 64; o <<= 1) v += __shfl_xor(v, o);
    return v;
}
__device__ __forceinline__ void p0_tr_item(const float* W, int ldw, int K, int nsrc, int nblk, bf16* WT, int mode, const float* kscale, LAS float* scr, int item, int lane) {
    const int kb = item / nblk, nb = item % nblk, k0 = 64 * kb, n0 = 32 * nb;
    const int nn = n0 + (lane & 31);
#pragma unroll 8
    for (int i = 0; i < 32; ++i) { const int kk = 2 * i + (lane >> 5); float v = 0.f; if (nn < nsrc) { v = W[(size_t)(k0 + kk) * ldw + nn]; if (kscale) v *= kscale[k0 + kk]; } scr[kk * 33 + (lane & 31)] = v; }
    LDS_WAIT(); asm volatile("" ::: "memory");
    const int c = lane & 7;
#pragma unroll
    for (int j = 0; j < 4; ++j) { const int n = (lane >> 3) + 8 * j; const LAS float* s = scr + (8 * c) * 33 + n;
        v4u o; o.x = pk2(s[0 * 33], s[1 * 33]); o.y = pk2(s[2 * 33], s[3 * 33]); o.z = pk2(s[4 * 33], s[5 * 33]); o.w = pk2(s[6 * 33], s[7 * 33]);
        const int ng = n0 + n; const int drow = (mode == 0) ? ng : (256 * (ng >> 7) + (ng & 127) + (mode == 2 ? 128 : 0));
        *(GAS v4u*)(WT + (size_t)drow * K + k0 + 8 * c) = o; }
    LDS_WAIT(); asm volatile("" ::: "memory");
}
__device__ __forceinline__ void rms_row_to_bf16(const float* xrow, const float* g, bf16* orow, int lane) {
    const GAS f32x4* xr = (const GAS f32x4*)xrow + lane; const GAS f32x4* gr = (const GAS f32x4*)g + lane;
    f32x4 v[4]; float s = 0.f;
#pragma unroll
    for (int j = 0; j < 4; ++j) { v[j] = xr[64 * j]; s += (v[j].x * v[j].x + v[j].y * v[j].y) + (v[j].z * v[j].z + v[j].w * v[j].w); }
    const float rstd = 1.0f / sqrtf(wave_sum(s) * (1.f / DM) + EPS);
    GAS unsigned long long* o8 = (GAS unsigned long long*)orow + lane;
#pragma unroll
    for (int j = 0; j < 4; ++j) { const f32x4 gg = gr[64 * j];
        o8[64 * j] = (unsigned long long)pk2(v[j].x * rstd * gg.x, v[j].y * rstd * gg.y) | ((unsigned long long)pk2(v[j].z * rstd * gg.z, v[j].w * rstd * gg.w) << 32); }
}
__device__ __forceinline__ void p0_prologue(const Frame& F, const Args& A) {
    unsigned char* ws = A.ws;
    LAS float* scr = (LAS float*)(F.lds + F.wave * 16384);
    const int gw = F.vcu * NWAVES + F.wave, NGW = F.G * NWAVES, lane = F.lane;
    constexpr int I_IN = 16 * 96, I_O = 16 * 32, I_G = 16 * 88, I_D = 44 * 32, I_PG = 16 * 32, I_PL = 4 * 32, I_C1 = 2 * 32 * 2, I_C2 = 2 * 1 * 2;
    constexpr int NITEMS = I_IN + I_O + 2 * I_G + I_D + I_PG + I_PL + I_C1 + I_C2;
    for (int it = gw; it < NITEMS; it += NGW) {
        int r = it;
        if (r < I_IN) { p0_tr_item(A.in[9], NIN, 1024, NIN, 96, (bf16*)(ws + WS_WIN), 0, nullptr, scr, r, lane); continue; } r -= I_IN;
        if (r < I_O) { p0_tr_item(A.in[16], 1024, 1024, 1024, 32, (bf16*)(ws + WS_WO), 0, nullptr, scr, r, lane); continue; } r -= I_O;
        if (r < I_G) { p0_tr_item(A.in[18], DFF, 1024, DFF, 88, (bf16*)(ws + WS_WGU), 1, A.in[17], scr, r, lane); continue; } r -= I_G;
        if (r < I_G) { p0_tr_item(A.in[19], DFF, 1024, DFF, 88, (bf16*)(ws + WS_WGU), 2, A.in[17], scr, r, lane); continue; } r -= I_G;
        if (r < I_D) { p0_tr_item(A.in[20], 1024, DFF, 1024, 32, (bf16*)(ws + WS_WDN), 0, nullptr, scr, r, lane); continue; } r -= I_D;
        if (r < I_PG) { p0_tr_item(A.in[23], 1024, 1024, 1024, 32, (bf16*)(ws + WS_WPG), 0, A.in[22], scr, r, lane); continue; } r -= I_PG;
        if (r < I_PL) { p0_tr_item(A.in[21], 1024, 256, 1024, 32, (bf16*)(ws + WS_WPLE), 0, nullptr, scr, r, lane); continue; } r -= I_PL;
        if (r < I_C1) { const int slot = r / 64; p0_tr_item(A.in[11] + (size_t)slot * 2048 * 64, 64, 2048, 64, 2, (bf16*)(ws + WS_WC1) + (size_t)slot * 64 * 2048, 0, nullptr, scr, r % 64, lane); continue; } r -= I_C1;
        { const int slot = r / 2; p0_tr_item(A.in[12] + (size_t)slot * 64 * 64, 64, 64, 64, 2, (bf16*)(ws + WS_WC2) + (size_t)slot * 64 * 64, 0, nullptr, scr, r % 2, lane); }
    }
    if (F.vcu < 2) { const int slot = F.vcu; const float* pe = A.in[10] + slot * 2048 + F.wave * 256; const float* w1 = A.in[11] + (size_t)slot * 2048 * 64 + (size_t)F.wave * 256 * 64; float a = 0.f;
#pragma unroll 16
        for (int k = 0; k < 256; ++k) a += pe[k] * w1[k * 64 + lane];
        ((LAS float*)(F.lds + F.wave * 16384 + 12288))[lane] = a; __syncthreads();
        if (F.wave == 0) { float t = 0.f;
#pragma unroll
            for (int w = 0; w < 8; ++w) t += ((LAS float*)(F.lds + w * 16384 + 12288))[lane];
            ((float*)(ws + WS_C1))[slot * 64 + lane] = t; }
    }
    bf16* XN = (bf16*)(ws + WS_XN);
    for (int m = gw; m < MPAD; m += NGW) {
        if (m < MTOT) { const float* xr = (m < TP) ? A.in[0] + (size_t)m * DM : A.in[1] + (size_t)(m - TP) * DM; rms_row_to_bf16(xr, A.in[8], XN + (size_t)m * DM, lane); }
        else { GAS v4u* o = (GAS v4u*)(XN + (size_t)m * DM) + lane; o[0] = (v4u){0, 0, 0, 0}; o[64] = (v4u){0, 0, 0, 0}; }
    }
    bf16* PP = (bf16*)(ws + WS_PPLE);
    for (int m = gw; m < MPAD; m += NGW) {
        v2u o = (v2u){0, 0};
        if (m < MTOT) { const float* pr = (m < TP) ? A.in[6] + (size_t)m * DPLE : A.in[7] + (size_t)(m - TP) * DPLE; const f32x4 v = ((const GAS f32x4*)pr)[lane]; o.x = pk2(v.x, v.y); o.y = pk2(v.z, v.w); }
        ((GAS v2u*)(PP + (size_t)m * DPLE))[lane] = o;
        if (m >= MTOT) { GAS v4u* z = (GAS v4u*)((bf16*)(ws + WS_MIX) + (size_t)m * DM) + lane; z[0] = (v4u){0, 0, 0, 0}; z[64] = (v4u){0, 0, 0, 0}; }
    }
    for (int it = gw; it < DBATCH * 508; it += NGW) { const int b = it / 508, r = it % 508;
        ((GAS f32x4*)(A.out + O_WINS + (size_t)(b * 512 + r) * 256))[lane] = ((const GAS f32x4*)(A.in[3] + (size_t)(b * 512 + r + 4) * 256))[lane]; }
}

constexpr float LOG2E = 1.4426950408889634f;
typedef short v4i16_t __attribute__((ext_vector_type(4)));
__device__ __forceinline__ s16x4 vtr(LAS const unsigned char* p) { return __builtin_bit_cast(s16x4, __builtin_amdgcn_ds_read_tr16_b64_v4i16((LAS v4i16_t*)p)); }
__device__ __forceinline__ unsigned cvtpk(float lo, float hi) { typedef float f2 __attribute__((ext_vector_type(2))); typedef __bf16 b2 __attribute__((ext_vector_type(2))); f2 v = {lo, hi}; b2 b = __builtin_convertvector(v, b2); return __builtin_bit_cast(unsigned, b); }
__device__ __forceinline__ int t5_bucket(int n) {
    if (n < 16) return n;
    const int large = 16 + (int)(logf((float)n / 16.0f) / 2.0794415416798357f * 16.0f);
    return large < 31 ? large : 31;
}
constexpr int AT_K0 = 0, AT_V0 = 16384, AT_LUT = 32768, AT_IMPA = 36864, AT_IMPB = AT_IMPA + 64 * 65 * 4 + 64, AT_SEL = AT_IMPB + 64 * 65 * 4 + 64, AT_MISC = AT_SEL + 1024, AT_END = AT_MISC + 4096;
struct AttnLane {
    int koff;
    int kx;
    int voff0, voff1;
    int r32, h;
};
__device__ __forceinline__ AttnLane attn_lane(int lane) {
    AttnLane L; L.r32 = lane & 31; L.h = lane >> 5; L.koff = L.r32 * 128; L.kx = (L.r32 >> 1) & 7;
    const int i16 = lane & 15, q = i16 >> 2, p = i16 & 3, g1 = (lane >> 4) & 1;
    const int base = (4 * L.h + q) * 128 + g1 * 32 + (p >> 1) * 16 + (p & 1) * 8;
    L.voff0 = base + ((q >> 1) * 64); L.voff1 = base + (((q >> 1) ^ 1) * 64);
    return L;
}
__device__ __forceinline__ void attn_fill_lut(LAS float* lut, const float* rel_bias, int tid) {
    for (int e = tid; e < 1024; e += NWAVES * 64) { const int dist = e >> 3, hd = e & 7; lut[e] = rel_bias[t5_bucket(dist) * 8 + hd] * LOG2E; }
}
__device__ __forceinline__ void attn_commit(LAS unsigned char* kb, LAS unsigned char* vb, int tid, v4u k, v4u v) {
    const int row = tid >> 3, ch = tid & 7;
    *(LAS v4u*)(kb + row * 128 + ((ch ^ ((row >> 1) & 7)) << 4)) = k;
    *(LAS v4u*)(vb + row * 128 + ((ch ^ (((row >> 1) & 1) << 2)) << 4)) = v;
}
__device__ __forceinline__ f32x16 attn_qk(LAS const unsigned char* kb, int hf, const AttnLane& L, const bf16x8 (&qf)[4]) {
    f32x16 s = {};
#pragma unroll
    for (int ks = 0; ks < 4; ++ks) { const bf16x8 kf = *(LAS const bf16x8*)(kb + hf * 4096 + L.koff + (((2 * ks + L.h) ^ L.kx) << 4)); s = __builtin_amdgcn_mfma_f32_32x32x16_bf16(kf, qf[ks], s, 0, 0, 0); }
    return s;
}
__device__ __forceinline__ void attn_pv(LAS const unsigned char* vb, int hf, const AttnLane& L, const f32x16& p, f32x16 (&o)[2]) {
#pragma unroll
    for (int s = 0; s < 2; ++s) {
        v4u pw; pw.x = cvtpk(p[8 * s + 0], p[8 * s + 1]); pw.y = cvtpk(p[8 * s + 2], p[8 * s + 3]); pw.z = cvtpk(p[8 * s + 4], p[8 * s + 5]); pw.w = cvtpk(p[8 * s + 6], p[8 * s + 7]);
        const bf16x8 pb = __builtin_bit_cast(bf16x8, pw);
        const int rb = (32 * hf + 16 * s) * 128;
        { const s16x4 lo = vtr(vb + rb + L.voff0), hi = vtr(vb + rb + 1024 + L.voff0); const bf16x8 vf = {lo[0], lo[1], lo[2], lo[3], hi[0], hi[1], hi[2], hi[3]};
          o[0] = __builtin_amdgcn_mfma_f32_32x32x16_bf16(vf, pb, o[0], 0, 0, 0); }
        { const s16x4 lo = vtr(vb + rb + L.voff1), hi = vtr(vb + rb + 1024 + L.voff1); const bf16x8 vf = {lo[0], lo[1], lo[2], lo[3], hi[0], hi[1], hi[2], hi[3]};
          o[1] = __builtin_amdgcn_mfma_f32_32x32x16_bf16(vf, pb, o[1], 0, 0, 0); }
    }
}
__device__ __forceinline__ float max16(const f32x16& a) {
    float m0 = fmaxf(fmaxf(a[0], a[1]), fmaxf(a[2], a[3])), m1 = fmaxf(fmaxf(a[4], a[5]), fmaxf(a[6], a[7])), m2 = fmaxf(fmaxf(a[8], a[9]), fmaxf(a[10], a[11])), m3 = fmaxf(fmaxf(a[12], a[13]), fmaxf(a[14], a[15]));
    return fmaxf(fmaxf(m0, m1), fmaxf(m2, m3));
}
__device__ __forceinline__ float sum16(const f32x16& a) {
    return ((a[0] + a[1]) + (a[2] + a[3])) + ((a[4] + a[5]) + (a[6] + a[7])) + (((a[8] + a[9]) + (a[10] + a[11])) + ((a[12] + a[13]) + (a[14] + a[15])));
}
__device__ __forceinline__ void attn_softmax_pv(LAS const unsigned char* vb, const AttnLane& L, f32x16& t0, f32x16& t1, float& m, float& l, f32x16 (&o)[2]) {
    float tm = fmaxf(max16(t0), max16(t1)); tm = fmaxf(tm, __shfl_xor(tm, 32));
    const float mn = fmaxf(m, tm), mu = (mn == -INFINITY) ? 0.f : mn;
    const float alpha = __builtin_amdgcn_exp2f(m - mu);
#pragma unroll
    for (int r = 0; r < 16; ++r) { t0[r] = __builtin_amdgcn_exp2f(t0[r] - mu); t1[r] = __builtin_amdgcn_exp2f(t1[r] - mu); }
    float ps = sum16(t0) + sum16(t1); ps += __shfl_xor(ps, 32);
    l = l * alpha + ps; m = mn;
#pragma unroll
    for (int r = 0; r < 16; ++r) { o[0][r] *= alpha; o[1][r] *= alpha; }
    attn_pv(vb, 0, L, t0, o); attn_pv(vb, 1, L, t1, o);
}
#define KEYIDX(hf, reg, h) (32 * (hf) + ((reg) & 3) + 8 * ((reg) >> 2) + 4 * (h))

__device__ __forceinline__ void win_unit(const Frame& F, const Args& A, LAS unsigned char* sh, int b, int g, int qb) {
    const bf16* PROJ = (const bf16*)(A.ws + WS_PROJ);
    const AttnLane L = attn_lane(F.lane);
    const int tid = F.tid, w = F.wave;
    const int tq = 64 * qb + 8 * w + (L.r32 >> 2), hd = g * 4 + (L.r32 & 3);
    const size_t tokq = (size_t)b * SEQ + tq;
    bf16x8 qf[4];
#pragma unroll
    for (int ks = 0; ks < 4; ++ks) qf[ks] = *(const bf16x8*)(PROJ + tokq * NPROJ + C_QN + hd * 64 + 16 * ks + 8 * L.h);
    LAS const float* lut = (LAS const float*)(sh + AT_LUT);
    const int kt0 = qb >= 8 ? qb - 8 : 0, nt = qb - kt0 + 1;
    const int srow = tid >> 3, sch = tid & 7;
    const bf16* ksrc = PROJ + ((size_t)b * SEQ + srow) * NPROJ + C_WIN + g * 64 + sch * 8;
    v4u kr, vr;
    kr = *(const v4u*)(ksrc + (size_t)(64 * kt0) * NPROJ); vr = *(const v4u*)(ksrc + (size_t)(64 * kt0) * NPROJ + 128);
    __syncthreads();
    attn_commit(sh + AT_K0, sh + AT_V0, tid, kr, vr);
    __syncthreads();
    float m = -INFINITY, l = 0.f; f32x16 o[2]; o[0] = f32x16{}; o[1] = f32x16{};
    for (int it = 0; it < nt; ++it) {
        const int kt = kt0 + it, buf = it & 1;
        if (it + 1 < nt) { kr = *(const v4u*)(ksrc + (size_t)(64 * (kt + 1)) * NPROJ); vr = *(const v4u*)(ksrc + (size_t)(64 * (kt + 1)) * NPROJ + 128); }
        LAS const unsigned char* kb = sh + AT_K0 + buf * 8192; LAS const unsigned char* vb = sh + AT_V0 + buf * 8192;
        f32x16 t0 = attn_qk(kb, 0, L, qf), t1 = attn_qk(kb, 1, L, qf);
        const int dbase = tq - 64 * kt;
#pragma unroll
        for (int r = 0; r < 16; ++r) {
            { const int dist = dbase - KEYIDX(0, r, L.h); const int di = dist < 127 ? dist : 127; const bool ok = dist >= 0 && dist < 512; t0[r] = ok ? t0[r] * LOG2E + lut[(di < 0 ? 0 : di) * 8 + hd] : -INFINITY; }
            { const int dist = dbase - KEYIDX(1, r, L.h); const int di = dist < 127 ? dist : 127; const bool ok = dist >= 0 && dist < 512; t1[r] = ok ? t1[r] * LOG2E + lut[(di < 0 ? 0 : di) * 8 + hd] : -INFINITY; }
        }
        attn_softmax_pv(vb, L, t0, t1, m, l, o);
        if (it + 1 < nt) attn_commit(sh + AT_K0 + (buf ^ 1) * 8192, sh + AT_V0 + (buf ^ 1) * 8192, tid, kr, vr);
        __syncthreads();
    }
    const float rl = 1.0f / l;
    bf16* dst = (bf16*)(A.ws + WS_OWIN) + tokq * 512 + hd * 64;
#pragma unroll
    for (int dt = 0; dt < 2; ++dt)
#pragma unroll
        for (int rq = 0; rq < 4; ++rq) { v2u wv; wv.x = cvtpk(o[dt][4 * rq] * rl, o[dt][4 * rq + 1] * rl); wv.y = cvtpk(o[dt][4 * rq + 2] * rl, o[dt][4 * rq + 3] * rl);
            *(v2u*)(dst + 32 * dt + 8 * rq + 4 * L.h) = wv; }
}

__device__ __forceinline__ void nsa_unit(const Frame& F, const Args& A, LAS unsigned char* sh, int b, int g, int qb) {
    const bf16* PROJ = (const bf16*)(A.ws + WS_PROJ);
    const AttnLane L = attn_lane(F.lane);
    const int tid = F.tid, w = F.wave, lane = F.lane;
    const int qloc = 8 * w + (L.r32 >> 2);
    const int tq = 64 * qb + qloc, hd = g * 4 + (L.r32 & 3);
    const size_t tokq = (size_t)b * SEQ + tq;
    bf16x8 qf[4];
#pragma unroll
    for (int ks = 0; ks < 4; ++ks) qf[ks] = *(const bf16x8*)(PROJ + tokq * NPROJ + C_QN + hd * 64 + 16 * ks + 8 * L.h);
    LAS const float* lut = (LAS const float*)(sh + AT_LUT);
    LAS float* impA = (LAS float*)(sh + AT_IMPA); LAS float* impB = (LAS float*)(sh + AT_IMPB);
    LAS unsigned long long* selm = (LAS unsigned long long*)(sh + AT_SEL);
    const int srow = tid >> 3, sch = tid & 7;
    v4u kr, vr;
    const int nct = (4 * qb + 3 + 63) >> 6;
    const bf16* kcs = (const bf16*)(A.ws + WS_KCP) + ((size_t)(b * 256 + srow) * 2 + g) * 64 + sch * 8;
    const bf16* vcs = (const bf16*)(A.ws + WS_VCP) + ((size_t)(b * 256 + srow) * 2 + g) * 64 + sch * 8;
    __syncthreads();
    for (int e = tid; e < 64 * 65; e += NWAVES * 64) { impA[e] = 0.f; impB[e] = 0.f; }
    float mc = -INFINITY, lc = 0.f;
    f32x16 oc[2]; oc[0] = f32x16{}; oc[1] = f32x16{};
#pragma unroll 1
    for (int pass = 0; pass < 2; ++pass) {
        kr = *(const v4u*)(kcs); vr = *(const v4u*)(vcs);
        __syncthreads();
        attn_commit(sh + AT_K0, sh + AT_V0, tid, kr, vr);
        __syncthreads();
        const float mu = (mc == -INFINITY) ? 0.f : mc, il = lc > 0.f ? 1.0f / lc : 0.f;
#pragma unroll 1
        for (int ct = 0; ct < nct; ++ct) {
            const int buf = ct & 1;
            if (ct + 1 < nct) { kr = *(const v4u*)(kcs + (size_t)(64 * (ct + 1)) * 128); vr = *(const v4u*)(vcs + (size_t)(64 * (ct + 1)) * 128); }
            LAS const unsigned char* kb = sh + AT_K0 + buf * 8192; LAS const unsigned char* vb = sh + AT_V0 + buf * 8192;
            f32x16 t0 = attn_qk(kb, 0, L, qf), t1 = attn_qk(kb, 1, L, qf);
#pragma unroll
            for (int r = 0; r < 16; ++r) {
                { const int i = 64 * ct + KEYIDX(0, r, L.h); const int dist = tq - 16 * i - 31; const int di = dist < 127 ? dist : 127; const bool ok = dist >= 0 && i < 255; t0[r] = ok ? t0[r] * LOG2E + lut[(di < 0 ? 0 : di) * 8 + hd] : -INFINITY; }
                { const int i = 64 * ct + KEYIDX(1, r, L.h); const int dist = tq - 16 * i - 31; const int di = dist < 127 ? dist : 127; const bool ok = dist >= 0 && i < 255; t1[r] = ok ? t1[r] * LOG2E + lut[(di < 0 ? 0 : di) * 8 + hd] : -INFINITY; }
            }
            if (pass == 0) {
                float tm = fmaxf(max16(t0), max16(t1)); tm = fmaxf(tm, __shfl_xor(tm, 32));
                const float mn = fmaxf(mc, tm), mu0 = (mn == -INFINITY) ? 0.f : mn;
                const float alpha = __builtin_amdgcn_exp2f(mc - mu0);
                float ps = 0.f;
#pragma unroll
                for (int r = 0; r < 16; ++r) ps += __builtin_amdgcn_exp2f(t0[r] - mu0) + __builtin_amdgcn_exp2f(t1[r] - mu0);
                ps += __shfl_xor(ps, 32);
                lc = lc * alpha + ps; mc = mn;
            } else {
#pragma unroll
                for (int r = 0; r < 16; ++r) { t0[r] = __builtin_amdgcn_exp2f(t0[r] - mu) * il; t1[r] = __builtin_amdgcn_exp2f(t1[r] - mu) * il; }
                attn_pv(vb, 0, L, t0, oc); attn_pv(vb, 1, L, t1, oc);
#pragma unroll
                for (int hf = 0; hf < 2; ++hf) {
                    float x[16];
#pragma unroll
                    for (int r = 0; r < 16; ++r) { float v = hf ? t1[r] : t0[r]; v += __shfl_xor(v, 1); v += __shfl_xor(v, 2); x[r] = v; }
                    if ((L.r32 & 3) == 0) {
#pragma unroll
                        for (int rq = 0; rq < 4; ++rq) { const int jq = 16 * ct + 8 * hf + 2 * rq + L.h;
                            impA[qloc * 65 + jq] = 2.0f * (x[4 * rq] + x[4 * rq + 1] + x[4 * rq + 2]) + x[4 * rq + 3];
                            impB[qloc * 65 + jq + 1] = x[4 * rq + 3]; }
                    }
                }
            }
            if (ct + 1 < nct) attn_commit(sh + AT_K0 + (buf ^ 1) * 8192, sh + AT_V0 + (buf ^ 1) * 8192, tid, kr, vr);
            __syncthreads();
        }
    }
#pragma unroll 1
    for (int qi = 0; qi < 8; ++qi) {
        const int q = 8 * w + qi;
        unsigned long long mk;
        if (qb < 16) mk = (2ull << qb) - 1ull;
        else {
            const bool forced = (lane == 0) || (lane == qb) || (lane == qb - 1);
            const float sc = forced ? 1e9f : (lane <= qb ? impA[q * 65 + lane] + impB[q * 65 + lane] : -1.0f);
            int rank = 0;
#pragma unroll 8
            for (int jj = 0; jj < 64; ++jj) { const float ov = __uint_as_float(__builtin_amdgcn_readlane(__float_as_uint(sc), jj)); rank += ((ov > sc) || (ov == sc && jj < lane)) ? 1 : 0; }
            mk = __ballot(rank < 16 && lane <= qb);
        }
        if (lane == 0) selm[q] = mk;
    }
    __syncthreads();
    const unsigned long long mysel = selm[qloc];
    unsigned long long um = selm[lane];
#pragma unroll
    for (int o_ = 1; o_ < 64; o_ <<= 1) { const unsigned lo = __shfl_xor((unsigned)um, o_), hi = __shfl_xor((unsigned)(um >> 32), o_); um |= ((unsigned long long)hi << 32) | lo; }
    um = ((unsigned long long)__builtin_amdgcn_readfirstlane((unsigned)(um >> 32)) << 32) | (unsigned long long)__builtin_amdgcn_readfirstlane((unsigned)um);
    const bf16* ksrc = PROJ + ((size_t)b * SEQ + srow) * NPROJ + C_KV + 2 * 128 + g * 64 + sch * 8;
    float m = -INFINITY, l = 0.f; f32x16 o[2]; o[0] = f32x16{}; o[1] = f32x16{};
    int j = __builtin_ctzll(um); um &= um - 1;
    kr = *(const v4u*)(ksrc + (size_t)(64 * j) * NPROJ); vr = *(const v4u*)(ksrc + (size_t)(64 * j) * NPROJ + 128);
    attn_commit(sh + AT_K0, sh + AT_V0, tid, kr, vr);
    __syncthreads();
    int buf = 0;
#pragma unroll 1
    for (;;) {
        const int jn = um ? __builtin_ctzll(um) : -1; um &= um - 1;
        if (jn >= 0) { kr = *(const v4u*)(ksrc + (size_t)(64 * jn) * NPROJ); vr = *(const v4u*)(ksrc + (size_t)(64 * jn) * NPROJ + 128); }
        LAS const unsigned char* kb = sh + AT_K0 + buf * 8192; LAS const unsigned char* vb = sh + AT_V0 + buf * 8192;
        f32x16 t0 = attn_qk(kb, 0, L, qf), t1 = attn_qk(kb, 1, L, qf);
        const bool selj = (mysel >> j) & 1ull;
        const int dbase = tq - 64 * j;
#pragma unroll
        for (int r = 0; r < 16; ++r) {
            { const int dist = dbase - KEYIDX(0, r, L.h); const int di = dist < 127 ? dist : 127; const bool ok = selj && dist >= 0; t0[r] = ok ? t0[r] * LOG2E + lut[(di < 0 ? 0 : di) * 8 + hd] : -INFINITY; }
            { const int dist = dbase - KEYIDX(1, r, L.h); const int di = dist < 127 ? dist : 127; const bool ok = selj && dist >= 0; t1[r] = ok ? t1[r] * LOG2E + lut[(di < 0 ? 0 : di) * 8 + hd] : -INFINITY; }
        }
        attn_softmax_pv(vb, L, t0, t1, m, l, o);
        if (jn >= 0) attn_commit(sh + AT_K0 + (buf ^ 1) * 8192, sh + AT_V0 + (buf ^ 1) * 8192, tid, kr, vr);
        __syncthreads();
        if (jn < 0) break;
        j = jn; buf ^= 1;
    }
    const bf16* gp = PROJ + tokq * NPROJ + C_GT + hd;
    const float g0 = 1.0f / (1.0f + __expf(-bf2f(gp[0]))), g1 = 1.0f / (1.0f + __expf(-bf2f(gp[8]))), g2 = 1.0f / (1.0f + __expf(-bf2f(gp[16])));
    const float rl = g1 / l;
    const bf16* ow = (const bf16*)(A.ws + WS_OWIN) + tokq * 512 + hd * 64;
    bf16* dst = (bf16*)(A.ws + WS_MIX) + tokq * 1024 + hd * 64;
#pragma unroll
    for (int dt = 0; dt < 2; ++dt)
#pragma unroll
        for (int rq = 0; rq < 4; ++rq) { const int d0 = 32 * dt + 8 * rq + 4 * L.h; const v2u wv = *(const v2u*)(ow + d0);
            const float a0 = g0 * oc[dt][4 * rq] + rl * o[dt][4 * rq] + g2 * bflo(wv.x), a1 = g0 * oc[dt][4 * rq + 1] + rl * o[dt][4 * rq + 1] + g2 * bfhi(wv.x);
            const float a2 = g0 * oc[dt][4 * rq + 2] + rl * o[dt][4 * rq + 2] + g2 * bflo(wv.y), a3 = g0 * oc[dt][4 * rq + 3] + rl * o[dt][4 * rq + 3] + g2 * bfhi(wv.y);
            v2u ov; ov.x = cvtpk(a0, a1); ov.y = cvtpk(a2, a3); *(v2u*)(dst + d0) = ov; }
}

__device__ __forceinline__ v4u pack_f32x8(const float* p) { const f32x4 a = *(const f32x4*)p, b = *(const f32x4*)(p + 4); v4u w; w.x = pk2(a.x, a.y); w.y = pk2(a.z, a.w); w.z = pk2(b.x, b.y); w.w = pk2(b.z, b.w); return w; }
__device__ __forceinline__ void samp_load(const Args& A, int mode, int tile, int b, int g, int srow, int sch, v4u& kr, v4u& vr) {
    const bf16* PROJ = (const bf16*)(A.ws + WS_PROJ);
    kr = (v4u){0, 0, 0, 0}; vr = (v4u){0, 0, 0, 0};
    if (mode == 0) {
        const size_t off = ((size_t)(b * 512 + 64 * tile + srow) * 2 + g) * 64 + sch * 8;
        kr = *(const v4u*)((const bf16*)(A.ws + WS_KCS) + off); vr = *(const v4u*)((const bf16*)(A.ws + WS_VCS) + off);
    } else if (mode == 1) {
        if (tile < 128) { const int page = ((const int*)A.in[5])[b * 64 + (tile >> 1)]; const int row = (tile & 1) * 64 + srow;
            const float* p = A.in[2] + ((size_t)(page * 128 + row) * 4 + 2) * 128 + g * 64 + sch * 8; kr = pack_f32x8(p); vr = pack_f32x8(p + 128); }
        else if (srow < 4) { const bf16* p = PROJ + (size_t)(TP + b * 4 + srow) * NPROJ + C_KV + 2 * 128 + g * 64 + sch * 8; kr = *(const v4u*)p; vr = *(const v4u*)(p + 128); }
    } else {
        const int idx = 64 * tile + srow;
        if (idx < 512) { const float* p = A.in[3] + ((size_t)(b * 512 + idx) * 2) * 128 + g * 64 + sch * 8; kr = pack_f32x8(p); vr = pack_f32x8(p + 128); }
        else if (idx < 516) { const bf16* p = PROJ + (size_t)(TP + b * 4 + idx - 512) * NPROJ + C_WIN + g * 64 + sch * 8; kr = *(const v4u*)p; vr = *(const v4u*)(p + 128); }
    }
}
__device__ __forceinline__ void samp_unit(const Frame& F, const Args& A, LAS unsigned char* sh, int b, int g) {
    const bf16* PROJ = (const bf16*)(A.ws + WS_PROJ);
    const AttnLane L = attn_lane(F.lane);
    const int tid = F.tid, w = F.wave, lane = F.lane;
    const bool cw = (w == 0);
    const bool colok = cw && L.r32 < 16;
    const int qi = (L.r32 >> 2) & 3, hd = g * 4 + (L.r32 & 3);
    const int pos = PAST + qi;
    const size_t tokq = (size_t)TP + b * 4 + qi;
#define SAMP_LOADQ() bf16x8 qf[4]; _Pragma("unroll") for (int ks = 0; ks < 4; ++ks) qf[ks] = *(const bf16x8*)(PROJ + tokq * NPROJ + C_QN + hd * 64 + 16 * ks + 8 * L.h)
    LAS const float* lut = (LAS const float*)(sh + AT_LUT);
    LAS float* impA = (LAS float*)(sh + AT_IMPA); LAS float* impB = (LAS float*)(sh + AT_IMPB);
    LAS unsigned long long* selm = (LAS unsigned long long*)(sh + AT_SEL);
    LAS float* scs = (LAS float*)(sh + AT_MISC);
    LAS int* tlist = (LAS int*)(sh + AT_MISC + 1024);
    const int srow = tid >> 3, sch = tid & 7;
    v4u kr, vr;
    __syncthreads();
    for (int e = tid; e < 4 * 132; e += NWAVES * 64) { impA[e] = 0.f; impB[e] = 0.f; }
    float mc = -INFINITY, lc = 0.f; f32x16 oc[2]; oc[0] = f32x16{}; oc[1] = f32x16{};
#pragma unroll 1
    for (int pass = 0; pass < 2; ++pass) {
        samp_load(A, 0, 0, b, g, srow, sch, kr, vr);
        __syncthreads();
        attn_commit(sh + AT_K0, sh + AT_V0, tid, kr, vr);
        __syncthreads();
        const float mu = (mc == -INFINITY) ? 0.f : mc, il = lc > 0.f ? 1.0f / lc : 0.f;
#pragma unroll 1
        for (int ct = 0; ct < 8; ++ct) {
            const int buf = ct & 1;
            if (ct + 1 < 8) samp_load(A, 0, ct + 1, b, g, srow, sch, kr, vr);
            if (cw) {
                LAS const unsigned char* kb = sh + AT_K0 + buf * 8192; LAS const unsigned char* vb = sh + AT_V0 + buf * 8192;
                SAMP_LOADQ();
                f32x16 t0 = attn_qk(kb, 0, L, qf), t1 = attn_qk(kb, 1, L, qf);
#pragma unroll
                for (int r = 0; r < 16; ++r) {
                    { const int i = 64 * ct + KEYIDX(0, r, L.h); const int dist = pos - 16 * i - 31; const int di = dist < 127 ? dist : 127; const bool ok = colok && dist >= 0 && i < 511; t0[r] = ok ? t0[r] * LOG2E + lut[(di < 0 ? 0 : di) * 8 + hd] : -INFINITY; }
                    { const int i = 64 * ct + KEYIDX(1, r, L.h); const int dist = pos - 16 * i - 31; const int di = dist < 127 ? dist : 127; const bool ok = colok && dist >= 0 && i < 511; t1[r] = ok ? t1[r] * LOG2E + lut[(di < 0 ? 0 : di) * 8 + hd] : -INFINITY; }
                }
                if (pass == 0) {
                    float tm = fmaxf(max16(t0), max16(t1)); tm = fmaxf(tm, __shfl_xor(tm, 32));
                    const float mn = fmaxf(mc, tm), mu0 = (mn == -INFINITY) ? 0.f : mn;
                    const float alpha = __builtin_amdgcn_exp2f(mc - mu0);
                    float ps = 0.f;
#pragma unroll
                    for (int r = 0; r < 16; ++r) ps += __builtin_amdgcn_exp2f(t0[r] - mu0) + __builtin_amdgcn_exp2f(t1[r] - mu0);
                    ps += __shfl_xor(ps, 32);
                    lc = lc * alpha + ps; mc = mn;
                } else {
#pragma unroll
                    for (int r = 0; r < 16; ++r) { t0[r] = __builtin_amdgcn_exp2f(t0[r] - mu) * il; t1[r] = __builtin_amdgcn_exp2f(t1[r] - mu) * il; }
                    attn_pv(vb, 0, L, t0, oc); attn_pv(vb, 1, L, t1, oc);
#pragma unroll
                    for (int hf = 0; hf < 2; ++hf) {
                        float x[16];
#pragma unroll
                        for (int r = 0; r < 16; ++r) { float v = hf ? t1[r] : t0[r]; v += __shfl_xor(v, 1); v += __shfl_xor(v, 2); x[r] = v; }
                        if ((L.r32 & 3) == 0 && L.r32 < 16) {
#pragma unroll
                            for (int rq = 0; rq < 4; ++rq) { const int jq = 16 * ct + 8 * hf + 2 * rq + L.h;
                                impA[qi * 132 + jq] = 2.0f * (x[4 * rq] + x[4 * rq + 1] + x[4 * rq + 2]) + x[4 * rq + 3];
                                impB[qi * 132 + jq + 1] = x[4 * rq + 3]; }
                        }
                    }
                }
            }
            if (ct + 1 < 8) attn_commit(sh + AT_K0 + (buf ^ 1) * 8192, sh + AT_V0 + (buf ^ 1) * 8192, tid, kr, vr);
            __syncthreads();
        }
    }
    if (cw) {
        unsigned long long ulo = 0ull, uhi = 0ull;
#pragma unroll 1
        for (int q = 0; q < 4; ++q) {
            const int j0 = lane, j1 = lane + 64;
            const float s0 = (j0 == 0) ? 1e9f : impA[q * 132 + j0] + impB[q * 132 + j0];
            const float s1 = (j1 == 127) ? 1e9f : impA[q * 132 + j1] + impB[q * 132 + j1];
            scs[j0] = s0; scs[j1] = s1;
            LDS_WAIT(); asm volatile("" ::: "memory");
            int r0 = 0, r1 = 0;
#pragma unroll 8
            for (int jj = 0; jj < 128; ++jj) { const float ov = scs[jj]; r0 += ((ov > s0) || (ov == s0 && jj < j0)) ? 1 : 0; r1 += ((ov > s1) || (ov == s1 && jj < j1)) ? 1 : 0; }
            const unsigned long long mlo = __ballot(r0 < 15), mhi = __ballot(r1 < 15);
            if (lane == 0) { selm[2 * q] = mlo; selm[2 * q + 1] = mhi; }
            ulo |= mlo; uhi |= mhi;
            LDS_WAIT(); asm volatile("" ::: "memory");
        }
        if (lane == 0) { int n = 0; for (int j = 0; j < 64; ++j) if ((ulo >> j) & 1ull) tlist[1 + n++] = j; for (int j = 0; j < 64; ++j) if ((uhi >> j) & 1ull) tlist[1 + n++] = 64 + j; tlist[1 + n++] = 128; tlist[0] = n; }
    }
    __syncthreads();
    const unsigned long long mylo = selm[2 * qi], myhi = selm[2 * qi + 1];
    const int nsel = tlist[0];
    const bf16* gp = PROJ + tokq * NPROJ + C_GT + hd;
    const float g0 = 1.0f / (1.0f + __expf(-bf2f(gp[0]))), g1 = 1.0f / (1.0f + __expf(-bf2f(gp[8]))), g2 = 1.0f / (1.0f + __expf(-bf2f(gp[16])));
#pragma unroll
    for (int r = 0; r < 16; ++r) { oc[0][r] *= g0; oc[1][r] *= g0; }
#pragma unroll 1
    for (int br = 0; br < 2; ++br) {
        const int nt = br == 0 ? nsel : 9;
        float m = -INFINITY, l = 0.f; f32x16 o[2]; o[0] = f32x16{}; o[1] = f32x16{};
        int j = br == 0 ? tlist[1] : 0;
        samp_load(A, 1 + br, j, b, g, srow, sch, kr, vr);
        __syncthreads();
        attn_commit(sh + AT_K0, sh + AT_V0, tid, kr, vr);
        __syncthreads();
#pragma unroll 1
        for (int it = 0; it < nt; ++it) {
            const int buf = it & 1;
            const int jn = (it + 1 < nt) ? (br == 0 ? tlist[2 + it] : it + 1) : -1;
            if (jn >= 0) samp_load(A, 1 + br, jn, b, g, srow, sch, kr, vr);
            if (cw) {
                LAS const unsigned char* kb = sh + AT_K0 + buf * 8192; LAS const unsigned char* vb = sh + AT_V0 + buf * 8192;
                SAMP_LOADQ();
                f32x16 t0 = attn_qk(kb, 0, L, qf), t1 = attn_qk(kb, 1, L, qf);
                bool selj = colok;
                int kp0;
                if (br == 0) { selj = selj && (j >= 128 ? true : (j < 64 ? ((mylo >> j) & 1ull) : ((myhi >> (j - 64)) & 1ull))); kp0 = 64 * j; }
                else kp0 = PAST - 512 + 64 * j;
                const int dbase = pos - kp0;
#pragma unroll
                for (int r = 0; r < 16; ++r) {
                    { const int ki = KEYIDX(0, r, L.h); const int dist = dbase - ki; const int di = dist < 127 ? dist : 127; const bool ok = selj && dist >= 0 && (br == 0 || (dist < 512 && 64 * j + ki < 516)); t0[r] = ok ? t0[r] * LOG2E + lut[(di < 0 ? 0 : di) * 8 + hd] : -INFINITY; }
                    { const int ki = KEYIDX(1, r, L.h); const int dist = dbase - ki; const int di = dist < 127 ? dist : 127; const bool ok = selj && dist >= 0 && (br == 0 || (dist < 512 && 64 * j + ki < 516)); t1[r] = ok ? t1[r] * LOG2E + lut[(di < 0 ? 0 : di) * 8 + hd] : -INFINITY; }
                }
                attn_softmax_pv(vb, L, t0, t1, m, l, o);
            }
            if (jn >= 0) attn_commit(sh + AT_K0 + (buf ^ 1) * 8192, sh + AT_V0 + (buf ^ 1) * 8192, tid, kr, vr);
            __syncthreads();
            j = jn;
        }
        const float sc = l > 0.f ? (br == 0 ? g1 : g2) / l : 0.f;
#pragma unroll
        for (int r = 0; r < 16; ++r) { oc[0][r] += sc * o[0][r]; oc[1][r] += sc * o[1][r]; }
    }
    if (colok) {
        bf16* dst = (bf16*)(A.ws + WS_MIX) + tokq * 1024 + hd * 64;
#pragma unroll
        for (int dt = 0; dt < 2; ++dt)
#pragma unroll
            for (int rq = 0; rq < 4; ++rq) { const int d0 = 32 * dt + 8 * rq + 4 * L.h;
                v2u ov; ov.x = cvtpk(oc[dt][4 * rq], oc[dt][4 * rq + 1]); ov.y = cvtpk(oc[dt][4 * rq + 2], oc[dt][4 * rq + 3]); *(v2u*)(dst + d0) = ov; }
    }
}
#undef SAMP_LOADQ

__device__ __forceinline__ float gelu_tanh(float x) { const float u = 0.7978845608028654f * (x + 0.044715f * x * x * x); const float t = 1.0f - 2.0f / (1.0f + __expf(2.0f * u)); return 0.5f * x * (1.0f + t); }
template <bool SAMPLE>
__device__ __forceinline__ void cmp_job(const Args& A, int b, int slot, int g, int grp, int lane) {
    const int r32 = lane & 31, h = lane >> 5;
    const int nsb = SAMPLE ? 512 : 256;
    int sb = 31 * grp + r32; const bool sbok = sb < nsb; if (!sbok) sb = nsb - 1;
    const bf16* W1 = (const bf16*)(A.ws + WS_WC1) + (size_t)slot * 64 * 2048;
    const bf16* PROJ = (const bf16*)(A.ws + WS_PROJ);
    f32x16 acc[2][2];
#pragma unroll
    for (int j = 0; j < 2; ++j) { acc[j][0] = f32x16{}; acc[j][1] = f32x16{}; }
    const bf16* w1p = W1 + (size_t)r32 * 2048 + 8 * h;
    const float* crow = nullptr; const bf16* prow = nullptr;
    if (SAMPLE) { const int p0 = 16 * sb; const int page = ((const int*)A.in[5])[b * 64 + (p0 >> 7)];
        crow = A.in[2] + ((size_t)(page * 128 + (p0 & 127)) * 4 + slot) * 128 + g * 64 + 8 * h; }
    else prow = PROJ + (size_t)(b * SEQ + 16 * sb) * NPROJ + C_KV + slot * 128 + g * 64 + 8 * h;
#pragma unroll 2
    for (int s = 0; s < 16; ++s) {
#pragma unroll
        for (int dq = 0; dq < 4; ++dq) {
            bf16x8 bf;
            if (SAMPLE) bf = __builtin_bit_cast(bf16x8, pack_f32x8(crow + (size_t)s * 512 + dq * 16));
            else bf = *(const bf16x8*)(prow + (size_t)s * NPROJ + dq * 16);
#pragma unroll
            for (int j = 0; j < 2; ++j)
#pragma unroll
                for (int ht = 0; ht < 2; ++ht) { const bf16x8 af = *(const bf16x8*)(w1p + (size_t)ht * 32 * 2048 + j * 1024 + s * 64 + dq * 16);
                    acc[j][ht] = __builtin_amdgcn_mfma_f32_32x32x16_bf16(af, bf, acc[j][ht], 0, 0, 0); }
        }
    }
    const float* c1p = (const float*)(A.ws + WS_C1) + slot * 64;
    bf16x8 xb[2][2];
#pragma unroll
    for (int ht = 0; ht < 2; ++ht) {
        float xv[16];
#pragma unroll
        for (int r = 0; r < 16; ++r) { const int hid = 32 * ht + (r & 3) + 8 * (r >> 2) + 4 * h;
            const float c1 = c1p[hid];
            const float h1 = __shfl(acc[1][ht][r], (lane & 32) | ((r32 + 1) & 31));
            xv[r] = gelu_tanh(acc[0][ht][r] + h1 + c1); }
#pragma unroll
        for (int s = 0; s < 2; ++s) { v4u pw; pw.x = cvtpk(xv[8 * s], xv[8 * s + 1]); pw.y = cvtpk(xv[8 * s + 2], xv[8 * s + 3]); pw.z = cvtpk(xv[8 * s + 4], xv[8 * s + 5]); pw.w = cvtpk(xv[8 * s + 6], xv[8 * s + 7]); xb[ht][s] = __builtin_bit_cast(bf16x8, pw); }
    }
    const bf16* W2 = (const bf16*)(A.ws + WS_WC2) + (size_t)slot * 64 * 64;
    f32x16 oo[2];
#pragma unroll
    for (int dt = 0; dt < 2; ++dt) {
        oo[dt] = f32x16{};
#pragma unroll
        for (int ht = 0; ht < 2; ++ht)
#pragma unroll
            for (int s = 0; s < 2; ++s) { const bf16* wp = W2 + (size_t)(32 * dt + r32) * 64 + 32 * ht + 16 * s + 4 * h;
                const v2u lo = *(const v2u*)wp, hi = *(const v2u*)(wp + 8); const v4u af = {lo.x, lo.y, hi.x, hi.y};
                oo[dt] = __builtin_amdgcn_mfma_f32_32x32x16_bf16(__builtin_bit_cast(bf16x8, af), xb[ht][s], oo[dt], 0, 0, 0); }
    }
    const int nblk = SAMPLE ? 511 : 255;
    if (r32 < 31 && sb < nblk && sbok) {
        bf16* dst = (bf16*)(A.ws + (SAMPLE ? (slot ? WS_VCS : WS_KCS) : (slot ? WS_VCP : WS_KCP))) + ((size_t)(b * nsb + sb) * 2 + g) * 64;
#pragma unroll
        for (int dt = 0; dt < 2; ++dt)
#pragma unroll
            for (int rq = 0; rq < 4; ++rq) { v2u wv; wv.x = cvtpk(oo[dt][4 * rq], oo[dt][4 * rq + 1]); wv.y = cvtpk(oo[dt][4 * rq + 2], oo[dt][4 * rq + 3]); *(v2u*)(dst + 32 * dt + 8 * rq + 4 * h) = wv; }
    }
}

__device__ __forceinline__ float log_sigmoid(float x) { return fminf(x, 0.f) - __logf(1.0f + __expf(-fabsf(x))); }
constexpr int G_QE = 0, G_KE = 8192, G_KDT = 16384, G_V = 24576, G_ST = 40960, G_LR = 73728, G_SEG = 77824, G_DEC = 79872, G_END = 80128;
__device__ __forceinline__ int sw128(int row, int ch) { return row * 128 + ((ch ^ ((row >> 1) & 7)) << 4); }

__device__ __forceinline__ void gla_local(const Frame& F, const Args& A, LAS unsigned char* sh, int unit) {
    const int b = unit >> 6, hh = (unit >> 4) & 3, sc = unit & 15;
    const int tid = F.tid, w = F.wave, lane = F.lane, r32 = lane & 31, h = lane >> 5;
    const bf16* PROJ = (const bf16*)(A.ws + WS_PROJ);
    const size_t tok0 = (size_t)b * SEQ + 256 * sc;
    const int c = lane;
    float wg[16];
#pragma unroll
    for (int r = 0; r < 16; ++r) wg[r] = A.in[13][r * 256 + hh * 64 + c];
    const float bg = A.in[14][hh * 64 + c];
    float Bprev = 0.f;
    const int dvt = w >> 1, it = w & 1;
    f32x16 accS = {};
    const int i16 = lane & 15, tq = i16 >> 2, tp = i16 & 3, g1 = (lane >> 4) & 1;
    const int vcol = ((4 * (dvt ^ tq) + 2 * g1 + (tp >> 1)) << 4) + (tp & 1) * 8;
    __syncthreads();
#pragma unroll 1
    for (int n = 0; n < 4; ++n) {
        const size_t tb = tok0 + 64 * n;
        { const int trow = tid >> 3, pr = tid & 7; const unsigned lw = *(const unsigned*)(PROJ + (tb + trow) * NPROJ + C_LR + 2 * pr);
          LAS float* lr = (LAS float*)(sh + G_LR); lr[trow * 16 + 2 * pr] = bflo(lw); lr[trow * 16 + 2 * pr + 1] = bfhi(lw);
#pragma unroll
          for (int k2 = 0; k2 < 2; ++k2) { const int ch = pr * 2 + k2; const v4u vv = *(const v4u*)(PROJ + (tb + trow) * NPROJ + C_VG + hh * 128 + ch * 8);
              *(LAS v4u*)(sh + G_V + trow * 256 + ((ch ^ ((trow & 3) << 2)) << 4)) = vv; } }
        __syncthreads();
        float cum[8], qv[8], kv[8];
        { LAS const float* lr = (LAS const float*)(sh + G_LR); float run = 0.f;
#pragma unroll
          for (int k = 0; k < 8; ++k) { const int i = 8 * w + k; float x = bg;
#pragma unroll
              for (int r = 0; r < 16; ++r) x += lr[i * 16 + r] * wg[r];
              run += log_sigmoid(x) * (1.0f / 16.0f); cum[k] = run;
              qv[k] = 0.125f * bf2f(PROJ[(tb + i) * NPROJ + C_QG + hh * 64 + c]); kv[k] = bf2f(PROJ[(tb + i) * NPROJ + C_KG + hh * 64 + c]); }
          ((LAS float*)(sh + G_SEG))[w * 64 + c] = run; }
        __syncthreads();
        { LAS const float* seg = (LAS const float*)(sh + G_SEG); float pre = 0.f, tot = 0.f;
#pragma unroll
          for (int g_ = 0; g_ < 8; ++g_) { const float sv = seg[g_ * 64 + c]; tot += sv; if (g_ < w) pre += sv; }
          const float eB = __expf(Bprev);
          unsigned kdw[4];
#pragma unroll
          for (int k = 0; k < 8; ++k) { const int i = 8 * w + k; const float bb = pre + cum[k];
              const float qe = qv[k] * __expf(bb), ke = kv[k] * __expf(-bb), kd = kv[k] * __expf(tot - bb);
              *(LAS unsigned short*)(sh + G_QE + sw128(i, c >> 3) + (c & 7) * 2) = (unsigned short)f2bf(qe);
              *(LAS unsigned short*)(sh + G_KE + sw128(i, c >> 3) + (c & 7) * 2) = (unsigned short)f2bf(ke);
              ((bf16*)(A.ws + WS_QB))[(tb + i) * 256 + hh * 64 + c] = (bf16)f2bf(qe * eB);
              if (k & 1) kdw[k >> 1] |= f2bf(kd) << 16; else kdw[k >> 1] = f2bf(kd); }
          *(LAS v4u*)(sh + G_KDT + sw128(c, w)) = (v4u){kdw[0], kdw[1], kdw[2], kdw[3]};
          if (w == 0) ((LAS float*)(sh + G_DEC))[c] = __expf(tot);
          Bprev += tot; }
        __syncthreads();
        LAS const unsigned char* qeb = sh + G_QE; LAS const unsigned char* keb = sh + G_KE; LAS const unsigned char* vbase = sh + G_V;
        bf16x8 qfr[4];
#pragma unroll
        for (int ks = 0; ks < 4; ++ks) qfr[ks] = *(LAS const bf16x8*)(qeb + sw128(32 * it + r32, 2 * ks + h));
        f32x16 oT = {};
#pragma unroll
        for (int jt = 0; jt < 2; ++jt) {
            if (jt <= it) {
                f32x16 s = {};
#pragma unroll
                for (int ks = 0; ks < 4; ++ks) { const bf16x8 kf = *(LAS const bf16x8*)(keb + sw128(32 * jt + r32, 2 * ks + h)); s = __builtin_amdgcn_mfma_f32_32x32x16_bf16(kf, qfr[ks], s, 0, 0, 0); }
                if (jt == it) {
#pragma unroll
                    for (int r = 0; r < 16; ++r) { const int j = (r & 3) + 8 * (r >> 2) + 4 * h; if (j > r32) s[r] = 0.f; }
                }
#pragma unroll
                for (int s2 = 0; s2 < 2; ++s2) {
                    v4u pw; pw.x = cvtpk(s[8 * s2], s[8 * s2 + 1]); pw.y = cvtpk(s[8 * s2 + 2], s[8 * s2 + 3]); pw.z = cvtpk(s[8 * s2 + 4], s[8 * s2 + 5]); pw.w = cvtpk(s[8 * s2 + 6], s[8 * s2 + 7]);
                    const int row = 32 * jt + 16 * s2 + 4 * h + tq;
                    const s16x4 lo = vtr(vbase + row * 256 + vcol), hi = vtr(vbase + (row + 8) * 256 + vcol);
                    const bf16x8 vf = {lo[0], lo[1], lo[2], lo[3], hi[0], hi[1], hi[2], hi[3]};
                    oT = __builtin_amdgcn_mfma_f32_32x32x16_bf16(vf, __builtin_bit_cast(bf16x8, pw), oT, 0, 0, 0);
                }
            }
        }
        if (n > 0) {
            LAS const unsigned char* stb = sh + G_ST + (n & 1) * 16384;
#pragma unroll
            for (int ks = 0; ks < 4; ++ks) { const bf16x8 sf = *(LAS const bf16x8*)(stb + sw128(32 * dvt + r32, 2 * ks + h)); oT = __builtin_amdgcn_mfma_f32_32x32x16_bf16(sf, qfr[ks], oT, 0, 0, 0); }
        }
        { float* op = (float*)(A.ws + WS_OLOC) + (tb + 32 * it + r32) * 512 + hh * 128 + 32 * dvt + 4 * h;
#pragma unroll
          for (int rq = 0; rq < 4; ++rq) *(f32x4*)(op + 8 * rq) = (f32x4){oT[4 * rq], oT[4 * rq + 1], oT[4 * rq + 2], oT[4 * rq + 3]}; }
        { const float dec = ((LAS const float*)(sh + G_DEC))[32 * it + r32];
#pragma unroll
          for (int r = 0; r < 16; ++r) accS[r] *= dec;
#pragma unroll
          for (int ks = 0; ks < 4; ++ks) {
              const bf16x8 kdf = *(LAS const bf16x8*)(sh + G_KDT + sw128(32 * it + r32, 2 * ks + h));
              const int row = 16 * ks + 8 * h + tq;
              const s16x4 lo = vtr(vbase + row * 256 + vcol), hi = vtr(vbase + (row + 4) * 256 + vcol);
              const bf16x8 vf = {lo[0], lo[1], lo[2], lo[3], hi[0], hi[1], hi[2], hi[3]};
              accS = __builtin_amdgcn_mfma_f32_32x32x16_bf16(vf, kdf, accS, 0, 0, 0);
          }
          LAS unsigned char* stn = sh + G_ST + ((n + 1) & 1) * 16384; const int d = 32 * it + r32;
#pragma unroll
          for (int r = 0; r < 16; ++r) { const int dv = 32 * dvt + (r & 3) + 8 * (r >> 2) + 4 * h; *(LAS unsigned short*)(stn + sw128(dv, d >> 3) + (d & 7) * 2) = (unsigned short)f2bf(accS[r]); } }
        __syncthreads();
    }
    { float* up = (float*)(A.ws + WS_USC) + (size_t)unit * 8192; const int d = 32 * it + r32;
#pragma unroll
      for (int r = 0; r < 16; ++r) { const int dv = 32 * dvt + (r & 3) + 8 * (r >> 2) + 4 * h; up[dv * 64 + d] = accS[r]; }
      if (w == 0) ((float*)(A.ws + WS_DSC))[unit * 64 + c] = __expf(Bprev); }
}

__device__ __forceinline__ void gla_out(const Frame& F, const Args& A, LAS unsigned char* sh, int unit) {
    const int b = unit >> 6, hh = (unit >> 4) & 3, sc = unit & 15;
    const int tid = F.tid, w = F.wave, lane = F.lane, r32 = lane & 31, h = lane >> 5;
    const bf16* PROJ = (const bf16*)(A.ws + WS_PROJ);
    const size_t tok0 = (size_t)b * SEQ + 256 * sc;
    const int d4 = (tid & 15) * 4, dvr = tid >> 4;
    f32x4 S[4];
#pragma unroll
    for (int k = 0; k < 4; ++k) S[k] = (f32x4){0.f, 0.f, 0.f, 0.f};
    const float* U0 = (const float*)(A.ws + WS_USC) + (size_t)(unit - sc) * 8192; const float* D0 = (const float*)(A.ws + WS_DSC) + (size_t)(unit - sc) * 64;
#pragma unroll 1
    for (int s = 0; s < sc; ++s) { const f32x4 dd = *(const f32x4*)(D0 + s * 64 + d4);
#pragma unroll
        for (int k = 0; k < 4; ++k) { const f32x4 u = *(const f32x4*)(U0 + (size_t)s * 8192 + (32 * k + dvr) * 64 + d4); S[k] = S[k] * dd + u; } }
    __syncthreads();
#pragma unroll
    for (int k = 0; k < 4; ++k) { const int dv = 32 * k + dvr; v2u wv; wv.x = pk2(S[k].x, S[k].y); wv.y = pk2(S[k].z, S[k].w);
        *(LAS v2u*)(sh + sw128(dv, d4 >> 3) + (d4 & 7) * 2) = wv; }
    if (sc == 15) {
        const f32x4 dd = *(const f32x4*)(D0 + 15 * 64 + d4); float* op = A.out + O_GLAP + (size_t)(b * 4 + hh) * 8192;
#pragma unroll
        for (int k = 0; k < 4; ++k) { const int dv = 32 * k + dvr; const f32x4 u = *(const f32x4*)(U0 + (size_t)15 * 8192 + dv * 64 + d4); const f32x4 e = S[k] * dd + u;
            op[(d4 + 0) * 128 + dv] = e.x; op[(d4 + 1) * 128 + dv] = e.y; op[(d4 + 2) * 128 + dv] = e.z; op[(d4 + 3) * 128 + dv] = e.w; }
    }
    __syncthreads();
    const size_t tok = tok0 + 32 * w + r32;
    f32x16 acc[4];
#pragma unroll
    for (int t = 0; t < 4; ++t) acc[t] = f32x16{};
#pragma unroll
    for (int ks = 0; ks < 4; ++ks) { const bf16x8 qb = *(const bf16x8*)((const bf16*)(A.ws + WS_QB) + tok * 256 + hh * 64 + 16 * ks + 8 * h);
#pragma unroll
        for (int t = 0; t < 4; ++t) { const bf16x8 sf = *(LAS const bf16x8*)(sh + sw128(32 * t + r32, 2 * ks + h)); acc[t] = __builtin_amdgcn_mfma_f32_32x32x16_bf16(sf, qb, acc[t], 0, 0, 0); } }
    const float* ol = (const float*)(A.ws + WS_OLOC) + tok * 512 + hh * 128;
    float ss = 0.f;
#pragma unroll
    for (int t = 0; t < 4; ++t)
#pragma unroll
        for (int rq = 0; rq < 4; ++rq) { const f32x4 v = *(const f32x4*)(ol + 32 * t + 8 * rq + 4 * h);
#pragma unroll
            for (int e = 0; e < 4; ++e) { acc[t][4 * rq + e] += v[e]; ss += acc[t][4 * rq + e] * acc[t][4 * rq + e]; } }
    ss += __shfl_xor(ss, 32);
    const float rstd = 1.0f / sqrtf(ss * (1.0f / 128.0f) + EPS);
    const float* gn = A.in[15]; const bf16* gg = PROJ + tok * NPROJ + C_GG + hh * 128;
    bf16* dst = (bf16*)(A.ws + WS_MIX) + tok * 1024 + 512 + hh * 128;
#pragma unroll
    for (int t = 0; t < 4; ++t)
#pragma unroll
        for (int rq = 0; rq < 4; ++rq) { const int dv0 = 32 * t + 8 * rq + 4 * h; const f32x4 gnv = *(const f32x4*)(gn + dv0); const v2u gw = *(const v2u*)(gg + dv0);
            const float gv[4] = {bflo(gw.x), bfhi(gw.x), bflo(gw.y), bfhi(gw.y)}; float y[4];
#pragma unroll
            for (int e = 0; e < 4; ++e) y[e] = acc[t][4 * rq + e] * rstd * gnv[e] * gv[e] / (1.0f + __expf(-gv[e]));
            v2u ov; ov.x = cvtpk(y[0], y[1]); ov.y = cvtpk(y[2], y[3]); *(v2u*)(dst + dv0) = ov; }
}

__device__ __forceinline__ void gla_sample(const Frame& F, const Args& A, LAS unsigned char* sh, int unit) {
    const int b = unit >> 2, hh = unit & 3, tid = F.tid;
    const bf16* PROJ = (const bf16*)(A.ws + WS_PROJ);
    LAS float* la = (LAS float*)sh;
    LAS float* qs = la + 256;
    LAS float* ks = qs + 256;
    LAS float* op = ks + 256;
    LAS float* of = op + 2048;
    __syncthreads();
    if (tid < 256) { const int t = tid >> 6, c = tid & 63; const size_t tok = (size_t)TP + b * 4 + t; float x = A.in[14][hh * 64 + c];
#pragma unroll
        for (int r = 0; r < 16; ++r) x += bf2f(PROJ[tok * NPROJ + C_LR + r]) * A.in[13][r * 256 + hh * 64 + c];
        la[tid] = __expf(log_sigmoid(x) * (1.0f / 16.0f)); qs[tid] = 0.125f * bf2f(PROJ[tok * NPROJ + C_QG + hh * 64 + c]); ks[tid] = bf2f(PROJ[tok * NPROJ + C_KG + hh * 64 + c]); }
    __syncthreads();
    const int dv = tid & 127, cg = tid >> 7;
    const float* s0 = A.in[4] + (size_t)(b * 4 + hh) * 8192;
    float S[16];
#pragma unroll
    for (int k = 0; k < 16; ++k) S[k] = s0[(16 * cg + k) * 128 + dv];
#pragma unroll
    for (int t = 0; t < 4; ++t) { const float vv = bf2f(PROJ[((size_t)TP + b * 4 + t) * NPROJ + C_VG + hh * 128 + dv]); float o = 0.f;
#pragma unroll
        for (int k = 0; k < 16; ++k) { const int c = 16 * cg + k; S[k] = la[t * 64 + c] * S[k] + ks[t * 64 + c] * vv; o += qs[t * 64 + c] * S[k]; }
        op[(cg * 4 + t) * 128 + dv] = o; }
    float* so = A.out + O_GLAS + (size_t)(b * 4 + hh) * 8192;
#pragma unroll
    for (int k = 0; k < 16; ++k) so[(16 * cg + k) * 128 + dv] = S[k];
    __syncthreads();
    { const int t = tid >> 7; of[t * 128 + dv] = (op[(0 * 4 + t) * 128 + dv] + op[(1 * 4 + t) * 128 + dv]) + (op[(2 * 4 + t) * 128 + dv] + op[(3 * 4 + t) * 128 + dv]); }
    __syncthreads();
    { const int t = tid >> 7; float ss = 0.f;
      for (int k = 0; k < 128; ++k) { const float v = of[t * 128 + k]; ss += v * v; }
      const float rstd = 1.0f / sqrtf(ss * (1.0f / 128.0f) + EPS); const size_t tok = (size_t)TP + b * 4 + t;
      const float gv = bf2f(PROJ[tok * NPROJ + C_GG + hh * 128 + dv]);
      const float y = of[t * 128 + dv] * rstd * A.in[15][dv] * gv / (1.0f + __expf(-gv));
      ((bf16*)(A.ws + WS_MIX))[tok * 1024 + 512 + hh * 128 + dv] = (bf16)f2bf(y); }
}

__device__ __forceinline__ void phase2(const Frame& F, const Args& A) {
    LAS unsigned char* sh = F.lds;
    { const int gw = F.vcu * NWAVES + F.wave, NGW = F.G * NWAVES; constexpr int NJP = 4 * 2 * 2 * 9, NJS = 32 * 2 * 2 * 17;
      for (int job = gw; job < NJP + NJS; job += NGW) {
          if (job >= NJS) { const int j = job - NJS; const int grp = j % 9, g = (j / 9) & 1, slot = (j / 18) & 1, b = j / 36;
#ifndef SKIP_CMP
 cmp_job<false>(A, b, slot, g, grp, F.lane);
#endif
 }
          else { const int grp = job % 17, g = (job / 17) & 1, slot = (job / 34) & 1, b = job / 68;
#ifndef SKIP_CMP
 cmp_job<true>(A, b, slot, g, grp, F.lane);
#endif
 }
      } }
    #ifndef SKIP_GLAL
    for (int u = F.vcu; u < 256; u += F.G) gla_local(F, A, sh, u);
#endif
    #ifndef SKIP_GLAS
    for (int u = F.vcu; u < 128; u += F.G) gla_sample(F, A, sh, u);
#endif
    __syncthreads();
    attn_fill_lut((LAS float*)(sh + AT_LUT), A.in[24], F.tid);
    __syncthreads();
    for (int p = F.vcu; p < 256; p += F.G) { const int bg = p >> 5, s = p & 31;
#ifndef SKIP_WIN
 win_unit(F, A, sh, bg >> 1, bg & 1, 63 - s); win_unit(F, A, sh, bg >> 1, bg & 1, s);
#endif
 }
}
__device__ __forceinline__ void phase3(const Frame& F, const Args& A) {
    LAS unsigned char* sh = F.lds;
    #ifndef SKIP_GLAO
    for (int u = F.vcu; u < 256; u += F.G) gla_out(F, A, sh, u);
#endif
    __syncthreads();
    attn_fill_lut((LAS float*)(sh + AT_LUT), A.in[24], F.tid);
    __syncthreads();
    #ifndef SKIP_SAMP
    for (int u = F.vcu; u < 64; u += F.G) samp_unit(F, A, sh, u >> 1, u & 1);
#endif
    for (int p = F.vcu; p < 256; p += F.G) { const int bg = p >> 5, s = p & 31;
#ifndef SKIP_NSA
 nsa_unit(F, A, sh, bg >> 1, bg & 1, 63 - s); nsa_unit(F, A, sh, bg >> 1, bg & 1, s);
#endif
 }
}

typedef const __attribute__((address_space(4))) Args* ArgsP;
__device__ __forceinline__ Args load_args() {
    Args r{};
#if defined(__HIP_DEVICE_COMPILE__)
    ArgsP p = (ArgsP)__builtin_amdgcn_kernarg_segment_ptr(); asm volatile("" : "+s"(p));
#pragma unroll
    for (int i = 0; i < 26; ++i) r.in[i] = p->in[i];
    r.out = p->out; r.ws = p->ws; r.ph_lo = p->ph_lo; r.ph_hi = p->ph_hi;
#endif
    return r;
}
__global__ void __launch_bounds__(NWAVES * 64, 2) mega_fwd(Args args_unused) {
    extern __shared__ __attribute__((aligned(16))) unsigned char lds_raw[];
    Frame F;
    F.lds = (LAS unsigned char*)lds_raw;
    F.wave = __builtin_amdgcn_readfirstlane((int)threadIdx.x >> 6); F.lane = hw_lane(); F.tid = F.wave * 64 + F.lane;
    F.G = gridDim.x; { const int bx = blockIdx.x; F.vcu = (F.G % 8 == 0) ? (bx % 8) * (F.G / 8) + bx / 8 : bx; }
    int lo, hi; unsigned char* ws;
    { const Args a0 = load_args(); lo = a0.ph_lo; hi = a0.ph_hi; ws = a0.ws; }
    gu32* ctl = (gu32*)(ws + WS_CTL);
    volatile LAS unsigned* MISC = (volatile LAS unsigned*)(F.lds + MISC_OFF);
    for (int u = F.tid; u < (LDS_BYTES - RING_BYTES) / 4; u += NWAVES * 64) ((LAS unsigned*)(F.lds + RING_BYTES))[u] = 0u;
    __syncthreads();
    const bool multi = (hi - lo) > 1;
    XcdBarrier bar; bar.bar = (unsigned*)(ctl + CW_BAR); bar.x = 0; bar.st = nullptr;
    if (multi) bar = xcd_barrier_post((unsigned*)(ctl + CW_BAR), MISC + 8, F.tid);
#define IN(k) (lo <= (k) && (k) < hi)
#define SEAM(k) do { if (IN(k) && IN((k) + 1)) { F.lane = hw_lane(); F.tid = F.wave * 64 + F.lane; xcd_barrier(bar, F.tid); } } while (0)
#define REFRESH() do { F.lane = hw_lane(); F.tid = F.wave * 64 + F.lane; } while (0)

    if (IN(0)) { REFRESH(); const Args args = load_args(); p0_prologue(F, args); } SEAM(0);
    if (IN(1)) { REFRESH(); const Args args = load_args(); unsigned char* ws = args.ws;
        pg8::Gemm g{(const pg8::bf16_t*)(ws + WS_XN), (const pg8::bf16_t*)(ws + WS_WIN), MPAD, NPROJ, 1024}; pg8::StaticOrder S; S.init(MPAD, NPROJ, F.G, (int)blockIdx.x);
        pg8::EpiInProj E{(pg8::bf16_t*)(ws + WS_PROJ), args.out};
        pg8::gemm_phase<pg8::EpiInProj, pg8::StaticOrder, true, true>(F.lds, g, S, E, F.tid);
    } SEAM(1);
    if (IN(2)) { REFRESH(); const Args args = load_args(); phase2(F, args); } SEAM(2);
    if (IN(3)) { REFRESH(); const Args args = load_args(); phase3(F, args); } SEAM(3);
    if (IN(4)) { REFRESH(); const Args args = load_args(); unsigned char* ws = args.ws; float* rowss1 = (float*)(ws + WS_ROWSS);
        { pg8::Gemm g{(const pg8::bf16_t*)(ws + WS_MIX), (const pg8::bf16_t*)(ws + WS_WO), MPAD, 1024, 1024}; pg8::StaticOrder S; S.init(MPAD, 1024, F.G, (int)blockIdx.x);
          pg8::EpiResid E{args.in[0], args.in[1], (float*)(ws + WS_H1), (pg8::bf16_t*)(ws + WS_H1B), rowss1};
          pg8::gemm_phase<pg8::EpiResid, pg8::StaticOrder, true, true>(F.lds, g, S, E, F.tid); }
        { pg8::Gemm g{(const pg8::bf16_t*)(ws + WS_PPLE), (const pg8::bf16_t*)(ws + WS_WPLE), MPAD, 1024, 256}; pg8::StaticOrder S; S.init(MPAD, 1024, F.G, (int)blockIdx.x);
          pg8::EpiBf E{(pg8::bf16_t*)(ws + WS_PLEB), 1024};
          pg8::gemm_phase<pg8::EpiBf, pg8::StaticOrder, true, true>(F.lds, g, S, E, F.tid); }
    } SEAM(4);
    if (IN(5)) { REFRESH(); const Args args = load_args(); unsigned char* ws = args.ws; float* rowss1 = (float*)(ws + WS_ROWSS);
        pg8::Gemm g{(const pg8::bf16_t*)(ws + WS_H1B), (const pg8::bf16_t*)(ws + WS_WGU), MPAD, NGU, 1024}; pg8::StaticOrder S; S.init(MPAD, NGU, F.G, (int)blockIdx.x);
        pg8::EpiGateUp E{(pg8::bf16_t*)(ws + WS_ACT), rowss1};
        pg8::gemm_phase<pg8::EpiGateUp, pg8::StaticOrder, true, true>(F.lds, g, S, E, F.tid);
    } SEAM(5);
    if (IN(6)) { REFRESH(); const Args args = load_args(); unsigned char* ws = args.ws; float* rowss2 = (float*)(ws + WS_ROWSS) + MPAD;
        pg8::Gemm g{(const pg8::bf16_t*)(ws + WS_ACT), (const pg8::bf16_t*)(ws + WS_WDN), MPAD, 1024, DFF}; pg8::StaticOrder S; S.init(MPAD, 1024, F.G, (int)blockIdx.x);
        pg8::EpiResid E{(const float*)(ws + WS_H1), (const float*)(ws + WS_H1) + (size_t)TP * 1024, (float*)(ws + WS_H2), (pg8::bf16_t*)(ws + WS_H2B), rowss2};
        pg8::gemm_phase<pg8::EpiResid, pg8::StaticOrder, true, true>(F.lds, g, S, E, F.tid);
    } SEAM(6);
    if (IN(7)) { REFRESH(); const Args args = load_args(); unsigned char* ws = args.ws; float* rowss2 = (float*)(ws + WS_ROWSS) + MPAD; float* rowss3 = rowss2 + MPAD;
        pg8::Gemm g{(const pg8::bf16_t*)(ws + WS_H2B), (const pg8::bf16_t*)(ws + WS_WPG), MPAD, 1024, 1024}; pg8::StaticOrder S; S.init(MPAD, 1024, F.G, (int)blockIdx.x);
        pg8::EpiPleGate E{(const float*)(ws + WS_H2), (const pg8::bf16_t*)(ws + WS_PLEB), rowss2, args.out + O_Y, rowss3};
        pg8::gemm_phase<pg8::EpiPleGate, pg8::StaticOrder, true, true>(F.lds, g, S, E, F.tid);
    } SEAM(7);
    if (IN(8)) { REFRESH(); const Args args = load_args(); unsigned char* ws = args.ws; float* rowss3 = (float*)(ws + WS_ROWSS) + 2 * MPAD;
        const int gw = F.vcu * NWAVES + F.wave, NGW = F.G * NWAVES; const GAS f32x4* gr = (const GAS f32x4*)args.in[25] + F.lane;
        for (int m = gw; m < MTOT; m += NGW) { GAS f32x4* yr = (GAS f32x4*)(args.out + O_Y + (size_t)m * 1024) + F.lane; const float rstd = 1.0f / sqrtf(rowss3[m] * (1.0f / 1024.0f) + EPS);
#pragma unroll
            for (int j = 0; j < 4; ++j) { const f32x4 v = yr[64 * j], gg = gr[64 * j]; yr[64 * j] = (f32x4){v.x * rstd * gg.x, v.y * rstd * gg.y, v.z * rstd * gg.z, v.w * rstd * gg.w}; } }
    }
#undef IN
#undef SEAM
#undef REFRESH
}

extern "C" void kernel_launch(void* const* d_in, const int* in_sizes, int n_in, void* d_out, int out_size, void* d_ws, size_t ws_size, hipStream_t stream) {
    static int grid = 0;
    if (grid == 0) {
        if (n_in != 26 || (size_t)out_size != O_END || ws_size < WS_END) { fprintf(stderr, "kernel_launch: unexpected shapes: n_in %d out %d ws %zu\n", n_in, out_size, ws_size); grid = -1; return; }
        int dev = 0, cus = 0, per_cu = 0;
        if (hipGetDevice(&dev) != hipSuccess || hipDeviceGetAttribute(&cus, hipDeviceAttributeMultiprocessorCount, dev) != hipSuccess) { grid = -1; return; }
        if (hipFuncSetAttribute((const void*)mega_fwd, hipFuncAttributeMaxDynamicSharedMemorySize, LDS_BYTES) != hipSuccess) { fprintf(stderr, "kernel_launch: hipFuncSetAttribute failed\n"); grid = -1; return; }
        if (hipOccupancyMaxActiveBlocksPerMultiprocessor(&per_cu, (const void*)mega_fwd, NWAVES * 64, LDS_BYTES) != hipSuccess || per_cu < 1) { fprintf(stderr, "kernel_launch: occupancy query says %d blocks per CU\n", per_cu); grid = -1; return; }
        (void)hipGetLastError();
        grid = cus;
    }
    if (grid < 0) return;
    (void)hipMemsetAsync((char*)d_ws + WS_CTL, 0, CTL_ZERO_BYTES, stream);
    Args a{};
    for (int i = 0; i < 26; ++i) a.in[i] = (const float*)d_in[i];
    a.out = (float*)d_out; a.ws = (unsigned char*)d_ws;
#ifndef N_LAUNCH_SPLIT
    a.ph_lo = 0; a.ph_hi = 9;
    hipLaunchKernelGGL(mega_fwd, dim3(grid), dim3(NWAVES * 64), LDS_BYTES, stream, a);
#else
    for (int p = 0; p < 9; ++p) { a.ph_lo = p; a.ph_hi = p + 1; hipLaunchKernelGGL(mega_fwd, dim3(grid), dim3(NWAVES * 64), LDS_BYTES, stream, a); }
#endif
}
```

```cpp
#include <hip/hip_runtime.h>
#include <cstdio>
#include <cstdint>

constexpr int DM = 1024, TP = 16384, TS = 128, MTOT = TP + TS, MPAD = 16640, SEQ = 4096, NBATCH = 4, DBATCH = 32, DSEQ = 4, PAST = 8192;
constexpr int NPROJ = 3072, DFF = 2816, DPLE = 256, NGU = 2 * DFF;
constexpr int C_QN = 0, C_KV = 512, C_WIN = 1024, C_GT = 1280, C_QG = 1304, C_KG = 1560, C_VG = 1816, C_LR = 2328, C_GG = 2344, NIN = 2856;
constexpr float EPS = 1e-6f;
constexpr size_t O_Y = 0, O_KV = (size_t)MTOT * 1024, O_WINP = O_KV + (size_t)MTOT * 512, O_WINS = O_WINP + 4 * 512 * 256,
                 O_GLAP = O_WINS + (size_t)32 * 512 * 256, O_GLAS = O_GLAP + 4 * 4 * 64 * 128, O_END = O_GLAS + (size_t)32 * 4 * 64 * 128;
namespace pg8 {
#define PG8_LAS __attribute__((address_space(3)))
typedef unsigned short bf16_t;
typedef short bf16x8 __attribute__((ext_vector_type(8)));
typedef float f32x4 __attribute__((ext_vector_type(4)));
typedef unsigned u32x4 __attribute__((ext_vector_type(4)));
constexpr int BM = 256, BK = 64, HALF = 128, HTB = HALF * BK * 2  , STAGE_BYTES = 8 * HTB, NXCD = 8, WGM = 8;

__host__ __device__ __forceinline__ int lds_byte(int r, int c) { const int st = (r >> 4) * 2 + (c >> 5), rr = r & 15, cc = c & 31, ob = rr * 64 + cc * 2; return st * 1024 + (ob ^ (((ob >> 9) & 1) << 5)); }
__host__ __device__ __forceinline__ void stage_rc(int b, int& R, int& C) { const int st = b / 1024, sb = b % 1024, swz = sb ^ (((sb >> 9) & 1) << 5); R = (st >> 1) * 16 + swz / 64; C = (st & 1) * 32 + (swz % 64) / 2; }
__host__ __device__ __forceinline__ int perm32(int rho) { const int n = rho >> 4, i = rho & 15; return 8 * (i >> 2) + 4 * n + (i & 3); }

struct Unit { int pm, pn; };
struct Gemm { const bf16_t* A; const bf16_t* Bt; int M, N, K; };

struct StaticOrder {
    int nM, nN, nwg, G, c;
    __host__ __device__ void init(int M, int N, int G_, int c_) { nM = M / BM; nN = N / BM; nwg = nM * nN; G = G_; c = c_; }
    __host__ __device__ bool next(int i, Unit& u) const {
        const long L = (long)i * G + c; if (L >= nwg) return false;
        int wgid = (int)L; { const int q = nwg / NXCD, r = nwg % NXCD, xcd = wgid % NXCD, off = wgid / NXCD; wgid = (xcd < r ? xcd * (q + 1) : r * (q + 1) + (xcd - r) * q) + off; }
        const int nig = WGM * nN, gid = wgid / nig, fm = gid * WGM, gsz = (nM - fm) < WGM ? (nM - fm) : WGM;
        u.pm = fm + ((wgid % nig) % gsz); u.pn = (wgid % nig) / gsz; return true;
    }
    __device__ __forceinline__ void a_ready(const Unit&) const {}
    __device__ __forceinline__ void done(const Unit&) const {}
};

__device__ __forceinline__ unsigned cvt_pk_bf16(float lo, float hi) { unsigned r; asm volatile("v_cvt_pk_bf16_f32 %0, %1, %2" : "=v"(r) : "v"(lo), "v"(hi)); return r; }

__device__ __forceinline__ u32x4 pack8(const f32x4 v0, const f32x4 v1) { u32x4 w; w.x = cvt_pk_bf16(v0[0], v0[1]); w.y = cvt_pk_bf16(v0[2], v0[3]); w.z = cvt_pk_bf16(v1[0], v1[1]); w.w = cvt_pk_bf16(v1[2], v1[3]); return w; }

struct EpiInProj {
    static constexpr bool PERM = true, AFTER_DRAIN = false;
    bf16_t* proj; float* out;
    __device__ __forceinline__ void operator()(const f32x4 (&acc)[2][2][4][2], const Unit& u, int wr, int wc, int fr, int fq) const {
        const int row0 = u.pm * BM + wr * 64 + fr, colb = u.pn * BM + wc * 32 + 8 * fq;
        const float sc = (u.pn < 2) ? 0.125f : 1.0f;
#pragma unroll
        for (int ai = 0; ai < 2; ++ai)
#pragma unroll
            for (int m = 0; m < 4; ++m) {
                const int r = row0 + ai * HALF + m * 16;
                if (r < MTOT) {
#pragma unroll
                    for (int bj = 0; bj < 2; ++bj) {
                        const int c = colb + bj * HALF;
                        const f32x4 v0 = acc[ai][bj][m][0] * sc, v1 = acc[ai][bj][m][1] * sc;
                        *(u32x4*)(proj + (size_t)r * NPROJ + c) = pack8(v0, v1);
                        if (u.pn == 2 || u.pn == 3) { float* o = out + O_KV + (size_t)r * 512 + (c - C_KV); *(f32x4*)o = v0; *(f32x4*)(o + 4) = v1; }
                        if (u.pn == 4) {
                            const int cc = c - C_WIN; float* o = nullptr;
                            if (r < TP) { const int pos = r & (SEQ - 1), b = r >> 12; if (pos >= SEQ - 512) o = out + O_WINP + ((size_t)(b * 512 + pos - (SEQ - 512)) * 256 + cc); }
                            else { const int rs = r - TP, b = rs >> 2, i = rs & 3; o = out + O_WINS + ((size_t)(b * 512 + 508 + i) * 256 + cc); }
                            if (o) { *(f32x4*)o = v0; *(f32x4*)(o + 4) = v1; }
                        }
                    }
                }
            }
    }
};
struct EpiResid {
    static constexpr bool PERM = true, AFTER_DRAIN = false;
    const float* baseA; const float* baseB;
    float* hout; bf16_t* hb; float* rowss;
    __device__ __forceinline__ void operator()(const f32x4 (&acc)[2][2][4][2], const Unit& u, int wr, int wc, int fr, int fq) const {
        const int row0 = u.pm * BM + wr * 64 + fr, colb = u.pn * BM + wc * 32 + 8 * fq;
#pragma unroll
        for (int ai = 0; ai < 2; ++ai)
#pragma unroll
            for (int m = 0; m < 4; ++m) {
                const int r = row0 + ai * HALF + m * 16;
                float ss = 0.f;
                if (r < MTOT) {
                    const float* bp = (r < TP) ? baseA + (size_t)r * 1024 : baseB + (size_t)(r - TP) * 1024;
#pragma unroll
                    for (int bj = 0; bj < 2; ++bj) {
                        const int c = colb + bj * HALF;
                        const f32x4 v0 = acc[ai][bj][m][0] + *(const f32x4*)(bp + c), v1 = acc[ai][bj][m][1] + *(const f32x4*)(bp + c + 4);
                        float* o = hout + (size_t)r * 1024 + c; *(f32x4*)o = v0; *(f32x4*)(o + 4) = v1;
                        *(u32x4*)(hb + (size_t)r * 1024 + c) = pack8(v0, v1);
                        ss += (v0[0] * v0[0] + v0[1] * v0[1]) + (v0[2] * v0[2] + v0[3] * v0[3]) + (v1[0] * v1[0] + v1[1] * v1[1]) + (v1[2] * v1[2] + v1[3] * v1[3]);
                    }
                }
                ss += __shfl_xor(ss, 16); ss += __shfl_xor(ss, 32);
                if (fq == 0 && r < MTOT) atomicAdd(rowss + r, ss);
            }
    }
};
struct EpiGateUp {
    static constexpr bool PERM = true, AFTER_DRAIN = false;
    bf16_t* act; const float* rowss;
    __device__ __forceinline__ void operator()(const f32x4 (&acc)[2][2][4][2], const Unit& u, int wr, int wc, int fr, int fq) const {
        const int row0 = u.pm * BM + wr * 64 + fr, colb = u.pn * HALF + wc * 32 + 8 * fq;
#pragma unroll
        for (int ai = 0; ai < 2; ++ai)
#pragma unroll
            for (int m = 0; m < 4; ++m) {
                const int r = row0 + ai * HALF + m * 16;
                if (r < MTOT) {
                    const float rstd = __builtin_amdgcn_rsqf(rowss[r] * (1.0f / 1024.0f) + EPS);
                    f32x4 o[2];
#pragma unroll
                    for (int n = 0; n < 2; ++n)
#pragma unroll
                        for (int e = 0; e < 4; ++e) { const float g = acc[ai][0][m][n][e] * rstd, up = acc[ai][1][m][n][e] * rstd; o[n][e] = g * up * __builtin_amdgcn_rcpf(1.0f + __expf(-g)); }
                    *(u32x4*)(act + (size_t)r * DFF + colb) = pack8(o[0], o[1]);
                }
            }
    }
};
struct EpiBf {
    static constexpr bool PERM = true, AFTER_DRAIN = false;
    bf16_t* O; int ldc;
    __device__ __forceinline__ void operator()(const f32x4 (&acc)[2][2][4][2], const Unit& u, int wr, int wc, int fr, int fq) const {
        const int row0 = u.pm * BM + wr * 64 + fr, colb = u.pn * BM + wc * 32 + 8 * fq;
#pragma unroll
        for (int ai = 0; ai < 2; ++ai)
#pragma unroll
            for (int m = 0; m < 4; ++m) {
                const int r = row0 + ai * HALF + m * 16;
                if (r < MTOT) {
#pragma unroll
                    for (int bj = 0; bj < 2; ++bj) *(u32x4*)(O + (size_t)r * ldc + colb + bj * HALF) = pack8(acc[ai][bj][m][0], acc[ai][bj][m][1]);
                }
            }
    }
};
struct EpiPleGate {
    static constexpr bool PERM = true, AFTER_DRAIN = false;
    const float* h2; const bf16_t* ple; const float* rowss2; float* y; float* rowss3;
    __device__ __forceinline__ void operator()(const f32x4 (&acc)[2][2][4][2], const Unit& u, int wr, int wc, int fr, int fq) const {
        const int row0 = u.pm * BM + wr * 64 + fr, colb = u.pn * BM + wc * 32 + 8 * fq;
#pragma unroll
        for (int ai = 0; ai < 2; ++ai)
#pragma unroll
            for (int m = 0; m < 4; ++m) {
                const int r = row0 + ai * HALF + m * 16;
                float ss = 0.f;
                if (r < MTOT) {
                    const float rstd = __builtin_amdgcn_rsqf(rowss2[r] * (1.0f / 1024.0f) + EPS);
#pragma unroll
                    for (int bj = 0; bj < 2; ++bj) {
                        const int c = colb + bj * HALF;
                        const u32x4 pw = *(const u32x4*)(ple + (size_t)r * 1024 + c);
                        const f32x4 b0 = *(const f32x4*)(h2 + (size_t)r * 1024 + c), b1 = *(const f32x4*)(h2 + (size_t)r * 1024 + c + 4);
                        float pv[8];
#pragma unroll
                        for (int e = 0; e < 4; ++e) { pv[2 * e] = __uint_as_float(pw[e] << 16); pv[2 * e + 1] = __uint_as_float(pw[e] & 0xffff0000u); }
                        f32x4 v0, v1;
#pragma unroll
                        for (int e = 0; e < 4; ++e) {
                            v0[e] = b0[e] + pv[e] * __builtin_amdgcn_rcpf(1.0f + __expf(-acc[ai][bj][m][0][e] * rstd));
                            v1[e] = b1[e] + pv[4 + e] * __builtin_amdgcn_rcpf(1.0f + __expf(-acc[ai][bj][m][1][e] * rstd));
                        }
                        float* o = y + (size_t)r * 1024 + c; *(f32x4*)o = v0; *(f32x4*)(o + 4) = v1;
                        ss += (v0[0] * v0[0] + v0[1] * v0[1]) + (v0[2] * v0[2] + v0[3] * v0[3]) + (v1[0] * v1[0] + v1[1] * v1[1]) + (v1[2] * v1[2] + v1[3] * v1[3]);
                    }
                }
                ss += __shfl_xor(ss, 16); ss += __shfl_xor(ss, 32);
                if (fq == 0 && r < MTOT) atomicAdd(rowss3 + r, ss);
            }
    }
};
template <class Epi, class Sched, bool ALIGN_EPI = false, bool SP2 = false>
__device__ __forceinline__ void gemm_phase(PG8_LAS unsigned char* lds, const Gemm g, const Sched& S, const Epi& E, const int tid) {
    const int wid = __builtin_amdgcn_readfirstlane(tid >> 6), lane = tid & 63, wr = wid >> 2, wc = wid & 3, fr = lane & 15, fq = lane >> 4;
    const int K = g.K, nt = K / BK;
    unsigned voffA[2], voffB[2];
#pragma unroll
    for (int i = 0; i < 2; ++i) { int R, C; stage_rc(tid * 16 + i * 8192, R, C); const int Rb = Epi::PERM ? ((R & ~31) + perm32(R & 31)) : R;
        voffA[i] = (unsigned)(R * K + C) * 2u; voffB[i] = (unsigned)(Rb * K + C) * 2u; }
    const size_t kstep = (size_t)(BK * 2);
    const size_t hstep = (size_t)HALF * K * 2;
    const size_t tstep = 2 * hstep;
    const unsigned ldsw = (unsigned)wid * 1024u;
    const int aoff = lds_byte(wr * 64 + fr, fq * 8), boff = lds_byte(wc * 32 + fr, fq * 8);
#define PG8_SA(b, h) (((b) * 2 + (h)) * HTB)
#define PG8_SB(b, h) ((4 + (b) * 2 + (h)) * HTB)
#define PG8_STAGE(bufoff, gbase, voff) do { _Pragma("unroll") for (int _i = 0; _i < 2; ++_i) \
        __builtin_amdgcn_global_load_lds((const unsigned*)((const char*)(gbase) + (voff)[_i]), (PG8_LAS unsigned*)(lds + (bufoff) + ldsw + _i * 8192), 16, 0, 0); } while (0)
#define PG8_LDA(dst, b, h) do { _Pragma("unroll") for (int m = 0; m < 4; ++m) _Pragma("unroll") for (int k = 0; k < 2; ++k) dst[m][k] = *(const PG8_LAS bf16x8*)(lds + PG8_SA(b, h) + aoff + m * 2048 + k * 1024); } while (0)
#define PG8_LDB(dst, b, h) do { _Pragma("unroll") for (int n = 0; n < 2; ++n) _Pragma("unroll") for (int k = 0; k < 2; ++k) dst[n][k] = *(const PG8_LAS bf16x8*)(lds + PG8_SB(b, h) + boff + n * 2048 + k * 1024); } while (0)
#define PG8_MMA(ai, bj, At, Bt) do { __builtin_amdgcn_s_setprio(1); _Pragma("unroll") for (int m = 0; m < 4; ++m) _Pragma("unroll") for (int n = 0; n < 2; ++n) _Pragma("unroll") for (int k = 0; k < 2; ++k) \
        acc[ai][bj][m][n] = __builtin_amdgcn_mfma_f32_16x16x32_bf16(Bt[n][k], At[m][k], acc[ai][bj][m][n], 0, 0, 0); __builtin_amdgcn_s_setprio(0); } while (0)
#define PG8_WAIT_V(n) asm volatile("s_waitcnt vmcnt(" #n ")" ::: "memory")
#define PG8_WAIT_L(n) asm volatile("s_waitcnt lgkmcnt(" #n ")" ::: "memory")
#define PG8_BAR __builtin_amdgcn_s_barrier()
#define PG8_SCHED __builtin_amdgcn_sched_barrier(0)
    Unit cur, nxt; int ui = 0;
    if (!S.next(0, cur)) return;
    f32x4 acc[2][2][4][2];
#pragma unroll
    for (int a = 0; a < 2; ++a)
#pragma unroll
        for (int b = 0; b < 2; ++b)
#pragma unroll
            for (int m = 0; m < 4; ++m)
#pragma unroll
                for (int n = 0; n < 2; ++n) acc[a][b][m][n] = (f32x4){0.f, 0.f, 0.f, 0.f};
    bf16x8 At[4][2], B0[2][2], B1[2][2];
    const char* cA = (const char*)g.A + (size_t)cur.pm * tstep; const char* cB = (const char*)g.Bt + (size_t)cur.pn * tstep;
    S.a_ready(cur);
    if constexpr (SP2) {
        PG8_STAGE(PG8_SB(0, 0), cB, voffB); PG8_STAGE(PG8_SB(0, 1), cB + hstep, voffB); PG8_STAGE(PG8_SA(0, 0), cA, voffA); PG8_STAGE(PG8_SA(0, 1), cA + hstep, voffA);
        if (wr == 1) PG8_BAR;
        PG8_WAIT_V(2); PG8_BAR;
        PG8_STAGE(PG8_SB(1, 0), cB + kstep, voffB); PG8_STAGE(PG8_SA(1, 0), cA + kstep, voffA); PG8_STAGE(PG8_SB(1, 1), cB + hstep + kstep, voffB);
        PG8_WAIT_V(6); PG8_BAR;
    } else {
        PG8_STAGE(PG8_SB(0, 0), cB, voffB); PG8_STAGE(PG8_SA(0, 0), cA, voffA); PG8_STAGE(PG8_SB(0, 1), cB + hstep, voffB); PG8_STAGE(PG8_SA(0, 1), cA + hstep, voffA);
        if (wr == 1) PG8_BAR;
        PG8_WAIT_V(4); PG8_BAR;
        PG8_STAGE(PG8_SB(1, 0), cB + kstep, voffB); PG8_STAGE(PG8_SA(1, 0), cA + kstep, voffA); PG8_STAGE(PG8_SB(1, 1), cB + hstep + kstep, voffB);
        PG8_WAIT_V(6); PG8_BAR;
    }
    for (;;) {
        const bool has_next = S.next(ui + 1, nxt);
        const char* nA = has_next ? (const char*)g.A + (size_t)nxt.pm * tstep : cA; const char* nB = has_next ? (const char*)g.Bt + (size_t)nxt.pn * tstep : cB;
        for (int t = 0; t < nt; t += 2) {
            const bool last = (t == nt - 2);
            const char* a1 = cA + (size_t)(t + 1) * kstep;
            const char* a2 = last ? nA : cA + (size_t)(t + 2) * kstep; const char* b2 = last ? nB : cB + (size_t)(t + 2) * kstep;
            const char* a3 = a2 + kstep; const char* b3 = b2 + kstep;
            if (last && has_next) S.a_ready(nxt);
            if constexpr (SP2) {
            PG8_LDB(B0, 0, 0); PG8_LDB(B1, 0, 1); PG8_SCHED; PG8_LDA(At, 0, 0); PG8_STAGE(PG8_SA(1, 1), a1 + hstep, voffA);
            PG8_WAIT_V(8); PG8_WAIT_L(0); PG8_BAR; PG8_MMA(0, 0, At, B0); PG8_MMA(0, 1, At, B1); PG8_BAR; PG8_SCHED;
            PG8_LDA(At, 0, 1); PG8_STAGE(PG8_SB(0, 0), b2, voffB); PG8_STAGE(PG8_SB(0, 1), b2 + hstep, voffB); PG8_STAGE(PG8_SA(0, 0), a2, voffA);
            PG8_WAIT_V(8); PG8_WAIT_L(0); PG8_BAR; PG8_MMA(1, 0, At, B0); PG8_MMA(1, 1, At, B1); PG8_BAR; PG8_SCHED;
            PG8_LDB(B0, 1, 0); PG8_LDB(B1, 1, 1); PG8_SCHED; PG8_LDA(At, 1, 0); PG8_STAGE(PG8_SA(0, 1), a2 + hstep, voffA);
            PG8_WAIT_V(8); PG8_WAIT_L(0); PG8_BAR; PG8_MMA(0, 0, At, B0); PG8_MMA(0, 1, At, B1); PG8_BAR; PG8_SCHED;
            PG8_LDA(At, 1, 1); PG8_STAGE(PG8_SB(1, 0), b3, voffB); PG8_STAGE(PG8_SB(1, 1), b3 + hstep, voffB); PG8_STAGE(PG8_SA(1, 0), a3, voffA);
            PG8_WAIT_V(8); PG8_WAIT_L(0); PG8_BAR; PG8_MMA(1, 0, At, B0); PG8_MMA(1, 1, At, B1); PG8_BAR; PG8_SCHED;
            } else {
            PG8_LDB(B0, 0, 0); PG8_SCHED; PG8_LDA(At, 0, 0); PG8_STAGE(PG8_SA(1, 1), a1 + hstep, voffA);
            PG8_WAIT_L(8); PG8_BAR; PG8_WAIT_L(0); PG8_MMA(0, 0, At, B0); PG8_BAR; PG8_SCHED;
            PG8_LDB(B1, 0, 1); PG8_STAGE(PG8_SB(0, 0), b2, voffB);
            PG8_BAR; PG8_WAIT_L(0); PG8_MMA(0, 1, At, B1); PG8_BAR;
            PG8_LDA(At, 0, 1); PG8_STAGE(PG8_SA(0, 0), a2, voffA);
            PG8_BAR; PG8_WAIT_L(0); PG8_MMA(1, 0, At, B0); PG8_BAR; PG8_SCHED;
            PG8_STAGE(PG8_SB(0, 1), b2 + hstep, voffB);
            PG8_WAIT_V(6); PG8_BAR; PG8_MMA(1, 1, At, B1); PG8_BAR;
            PG8_LDB(B0, 1, 0); PG8_SCHED; PG8_LDA(At, 1, 0); PG8_STAGE(PG8_SA(0, 1), a2 + hstep, voffA);
            PG8_WAIT_L(8); PG8_BAR; PG8_WAIT_L(0); PG8_MMA(0, 0, At, B0); PG8_BAR; PG8_SCHED;
            PG8_LDB(B1, 1, 1); PG8_STAGE(PG8_SB(1, 0), b3, voffB);
            PG8_BAR; PG8_WAIT_L(0); PG8_MMA(0, 1, At, B1); PG8_BAR;
            PG8_LDA(At, 1, 1); PG8_STAGE(PG8_SA(1, 0), a3, voffA);
            PG8_BAR; PG8_WAIT_L(0); PG8_MMA(1, 0, At, B0); PG8_BAR; PG8_SCHED;
            PG8_STAGE(PG8_SB(1, 1), b3 + hstep, voffB);
            PG8_WAIT_V(6); PG8_BAR; PG8_MMA(1, 1, At, B1); PG8_BAR;
            }
        }
        if constexpr (ALIGN_EPI) { if (wr == 0) PG8_BAR; }
        if constexpr (!Epi::AFTER_DRAIN) { E(acc, cur, wr, wc, fr, fq); S.done(cur); }
        if (!has_next) break;
#pragma unroll
        for (int a = 0; a < 2; ++a)
#pragma unroll
            for (int b = 0; b < 2; ++b)
#pragma unroll
                for (int m = 0; m < 4; ++m)
#pragma unroll
                    for (int n = 0; n < 2; ++n) acc[a][b][m][n] = (f32x4){0.f, 0.f, 0.f, 0.f};
        cur = nxt; cA = nA; cB = nB; ++ui;
        if constexpr (ALIGN_EPI) { if (wr == 1) PG8_BAR; }
    }
    PG8_WAIT_V(0);
    if constexpr (!ALIGN_EPI) { if (wr == 0) PG8_BAR; }
    PG8_BAR;
    if constexpr (Epi::AFTER_DRAIN) { E.fused(acc, cur, wr, wc, fr, fq, lds, wid, lane); S.done(cur); }
#undef PG8_SA
#undef PG8_SB
#undef PG8_STAGE
#undef PG8_LDA
#undef PG8_LDB
#undef PG8_MMA
#undef PG8_WAIT_V
#undef PG8_WAIT_L
#undef PG8_BAR
#undef PG8_SCHED
}
}


#define GAS __attribute__((address_space(1)))
#define LAS __attribute__((address_space(3)))
typedef unsigned short bf16;
typedef unsigned v4u __attribute__((ext_vector_type(4)));
typedef unsigned v2u __attribute__((ext_vector_type(2)));
typedef float f32x4 __attribute__((ext_vector_type(4)));
typedef float f32x2 __attribute__((ext_vector_type(2)));
typedef float f32x16 __attribute__((ext_vector_type(16)));
typedef short bf16x8 __attribute__((ext_vector_type(8)));
typedef short s16x4 __attribute__((ext_vector_type(4)));
typedef GAS unsigned gu32;
#define RLX_AGENT __ATOMIC_RELAXED, __HIP_MEMORY_SCOPE_AGENT
#define LDS_WAIT() asm volatile("s_waitcnt lgkmcnt(0)" ::: "memory")
#define VM_WAIT() asm volatile("s_waitcnt vmcnt(0)" ::: "memory")
__device__ __forceinline__ unsigned f2bf(float f) { unsigned u = __builtin_bit_cast(unsigned, f); return (u + 0x7fffu + ((u >> 16) & 1u)) >> 16; }
__device__ __forceinline__ unsigned pk2(float lo, float hi) { return f2bf(lo) | (f2bf(hi) << 16); }
__device__ __forceinline__ float bf2f(unsigned short h) { return __uint_as_float(((unsigned)h) << 16); }
__device__ __forceinline__ float bflo(unsigned w) { return __uint_as_float(w << 16); }
__device__ __forceinline__ float bfhi(unsigned w) { return __uint_as_float(w & 0xffff0000u); }

constexpr int NWAVES = 8;
constexpr size_t MiB = 1u << 20;
constexpr size_t WS_CTL = 0, CTL_ZERO_BYTES = 1 * MiB;
constexpr int CW_BAR = 4096;
constexpr size_t WS_ROWSS = 256 * 1024;
constexpr size_t WS_WIN = 2 * MiB;
constexpr size_t WS_WO = 8 * MiB;
constexpr size_t WS_WGU = 10 * MiB;
constexpr size_t WS_WDN = 21 * MiB;
constexpr size_t WS_WPG = 27 * MiB;
constexpr size_t WS_WPLE = 29 * MiB;
constexpr size_t WS_WC1 = 30 * MiB;
constexpr size_t WS_WC2 = 31 * MiB;
constexpr size_t WS_C1 = 31 * MiB + 65536;
constexpr size_t WS_KCP = 32 * MiB;
constexpr size_t WS_VCP = 33 * MiB;
constexpr size_t WS_KCS = 34 * MiB;
constexpr size_t WS_VCS = 38 * MiB;
constexpr size_t WS_DSC = 42 * MiB;
constexpr size_t WS_USC = 43 * MiB;
constexpr size_t WS_QB = 51 * MiB;
constexpr size_t WS_XN = 64 * MiB;
constexpr size_t WS_PPLE = 97 * MiB;
constexpr size_t WS_PROJ = 106 * MiB;
constexpr size_t WS_OWIN = 204 * MiB;
constexpr size_t WS_MIX = 221 * MiB;
constexpr size_t WS_OLOC = 254 * MiB;
constexpr size_t WS_H1 = 287 * MiB;
constexpr size_t WS_H1B = 353 * MiB;
constexpr size_t WS_ACT = 386 * MiB;
constexpr size_t WS_H2 = 476 * MiB;
constexpr size_t WS_H2B = 542 * MiB;
constexpr size_t WS_PLEB = 575 * MiB;
constexpr size_t WS_END = 608 * MiB;
constexpr int RING_BYTES = 131072;
constexpr int MISC_OFF = RING_BYTES + 320;
constexpr int LDS_BYTES = 147456;
#define XB_TMO      128
#define XB_XCNT(j)  (256  + 64 * (j))
#define XB_XSUB(j)  (1280 + 64 * (j))
#define XB_XGEN(j)  (2304 + 64 * (j))
#define XB_TOP      3328
#define XB_TOPGEN   3392
#define XCD_BAR_WORDS 3456
#define XB_SPIN_CAP (1u << 18)

__device__ __forceinline__ unsigned xb_ld(unsigned* p)              { return __hip_atomic_load(p, __ATOMIC_RELAXED, __HIP_MEMORY_SCOPE_AGENT); }
__device__ __forceinline__ unsigned xb_add(unsigned* p, unsigned v) { return __hip_atomic_fetch_add(p, v, __ATOMIC_RELAXED, __HIP_MEMORY_SCOPE_AGENT); }
__device__ __forceinline__ unsigned xb_xcc_id() { return (unsigned)__builtin_amdgcn_s_getreg((3 << 11) | 20) & 0xFu; }
#define XB_SPIN(cond, bar) do { unsigned _sp = 0; while (cond) { __builtin_amdgcn_s_sleep(1); \
    if ((++_sp & 255u) == 0u) { if (xb_ld(&(bar)[XB_TMO])) break; if (_sp > XB_SPIN_CAP) { atomicAdd(&(bar)[XB_TMO], 1u); break; } } } } while (0)

struct XcdBarrier {
    unsigned* bar; unsigned x;
    volatile LAS unsigned* st;
};

__device__ __forceinline__ XcdBarrier xcd_barrier_post(unsigned* bar, volatile LAS unsigned* st, const int tid) {
    XcdBarrier b; b.bar = bar; b.x = xb_xcc_id(); b.st = st;
    if (tid == 0) (void)xb_add(&bar[XB_XCNT(b.x)], 1u);
    return b;
}
__device__ __forceinline__ void xcd_barrier_complete(unsigned* bar, unsigned x, unsigned& nloc, unsigned& nx) {
    const unsigned G = gridDim.x * gridDim.y * gridDim.z;
    unsigned sum, cnt, mine, sp = 0u;
    for (;;) {
        sum = 0u; cnt = 0u; mine = 0u;
#pragma unroll
        for (unsigned j = 0; j < 16; ++j) { const unsigned c = xb_ld(&bar[XB_XCNT(j)]); sum += c; cnt += (c > 0u) ? 1u : 0u; mine = (j == x) ? c : mine; }
        if (sum == G) break;
        __builtin_amdgcn_s_sleep(1);
        if ((++sp & 255u) == 0u) { if (xb_ld(&bar[XB_TMO])) break; if (sp > XB_SPIN_CAP) { atomicAdd(&bar[XB_TMO], 1u); break; } }
    }
    nloc = mine > 0u ? mine : 1u; nx = cnt > 0u ? cnt : 1u;
}

__device__ __forceinline__ void xcd_barrier(const XcdBarrier& b, const int tid) {
    asm volatile("s_waitcnt vmcnt(0)" ::: "memory");
    __syncthreads();
    if (tid == 0) {
        unsigned* bar = b.bar;
        __builtin_amdgcn_s_waitcnt(0);
        unsigned nloc = b.st[0], nx = b.st[1];
        if (nloc == 0u) { xcd_barrier_complete(bar, b.x, nloc, nx); b.st[0] = nloc; b.st[1] = nx; }
        const unsigned old = xb_add(&bar[XB_XSUB(b.x)], 1u);
        const unsigned gen = old / nloc;
        if (old + 1u == (gen + 1u) * nloc) {
            __builtin_amdgcn_fence(__ATOMIC_RELEASE, "agent");
            asm volatile("s_waitcnt vmcnt(0)" ::: "memory");
            const unsigned og = xb_add(&bar[XB_TOP], 1u);
            const unsigned tg = og / nx;
            if (og + 1u == (tg + 1u) * nx) xb_add(&bar[XB_TOPGEN], 1u);
            else XB_SPIN(xb_ld(&bar[XB_TOPGEN]) == tg, bar);
            __builtin_amdgcn_fence(__ATOMIC_ACQUIRE, "agent");
            xb_add(&bar[XB_XGEN(b.x)], 1u);
            asm volatile("s_waitcnt vmcnt(0)" ::: "memory");
        } else {
            XB_SPIN(xb_ld(&bar[XB_XGEN(b.x)]) == gen, bar);
            __builtin_amdgcn_fence(__ATOMIC_ACQUIRE, "agent");
            asm volatile("s_waitcnt vmcnt(0)" ::: "memory");
        }
    }
    __syncthreads();
}

struct Args { const float* in[26]; float* out; unsigned char* ws; int ph_lo, ph_hi; };
struct Frame {
    LAS unsigned char* lds;
    int tid, lane, wave, vcu, G;
};
__device__ __forceinline__ int hw_lane() { int l; asm volatile("v_mbcnt_lo_u32_b32 %0, -1, 0\n\tv_mbcnt_hi_u32_b32 %0, -1, %0" : "=v"(l)); return l; }
__device__ __forceinline__ float wave_sum(float v) {
#pragma unroll
    for (int o = 1; o < 64; o <<= 1) v += __shfl_xor(v, o);
    return v;
}
__device__ __forceinline__ void p0_tr_item(const float* W, int ldw, int K, int nsrc, int nblk, bf16* WT, int mode, const float* kscale, LAS float* scr, int item, int lane) {
    const int kb = item / nblk, nb = item % nblk, k0 = 64 * kb, n0 = 32 * nb;
    const int nn = n0 + (lane & 31);
#pragma unroll 8
    for (int i = 0; i < 32; ++i) { const int kk = 2 * i + (lane >> 5); float v = 0.f; if (nn < nsrc) { v = W[(size_t)(k0 + kk) * ldw + nn]; if (kscale) v *= kscale[k0 + kk]; } scr[kk * 33 + (lane & 31)] = v; }
    LDS_WAIT(); asm volatile("" ::: "memory");
    const int c = lane & 7;
#pragma unroll
    for (int j = 0; j < 4; ++j) { const int n = (lane >> 3) + 8 * j; const LAS float* s = scr + (8 * c) * 33 + n;
        v4u o; o.x = pk2(s[0 * 33], s[1 * 33]); o.y = pk2(s[2 * 33], s[3 * 33]); o.z = pk2(s[4 * 33], s[5 * 33]); o.w = pk2(s[6 * 33], s[7 * 33]);
        const int ng = n0 + n; const int drow = (mode == 0) ? ng : (256 * (ng >> 7) + (ng & 127) + (mode == 2 ? 128 : 0));
        *(GAS v4u*)(WT + (size_t)drow * K + k0 + 8 * c) = o; }
    LDS_WAIT(); asm volatile("" ::: "memory");
}
__device__ __forceinline__ void rms_row_to_bf16(const float* xrow, const float* g, bf16* orow, int lane) {
    const GAS f32x4* xr = (const GAS f32x4*)xrow + lane; const GAS f32x4* gr = (const GAS f32x4*)g + lane;
    f32x4 v[4]; float s = 0.f;
#pragma unroll
    for (int j = 0; j < 4; ++j) { v[j] = xr[64 * j]; s += (v[j].x * v[j].x + v[j].y * v[j].y) + (v[j].z * v[j].z + v[j].w * v[j].w); }
    const float rstd = 1.0f / sqrtf(wave_sum(s) * (1.f / DM) + EPS);
    GAS unsigned long long* o8 = (GAS unsigned long long*)orow + lane;
#pragma unroll
    for (int j = 0; j < 4; ++j) { const f32x4 gg = gr[64 * j];
        o8[64 * j] = (unsigned long long)pk2(v[j].x * rstd * gg.x, v[j].y * rstd * gg.y) | ((unsigned long long)pk2(v[j].z * rstd * gg.z, v[j].w * rstd * gg.w) << 32); }
}
__device__ __forceinline__ void p0_prologue(const Frame& F, const Args& A) {
    unsigned char* ws = A.ws;
    LAS float* scr = (LAS float*)(F.lds + F.wave * 16384);
    const int gw = F.vcu * NWAVES + F.wave, NGW = F.G * NWAVES, lane = F.lane;
    constexpr int I_IN = 16 * 96, I_O = 16 * 32, I_G = 16 * 88, I_D = 44 * 32, I_PG = 16 * 32, I_PL = 4 * 32, I_C1 = 2 * 32 * 2, I_C2 = 2 * 1 * 2;
    constexpr int NITEMS = I_IN + I_O + 2 * I_G + I_D + I_PG + I_PL + I_C1 + I_C2;
    for (int it = gw; it < NITEMS; it += NGW) {
        int r = it;
        if (r < I_IN) { p0_tr_item(A.in[9], NIN, 1024, NIN, 96, (bf16*)(ws + WS_WIN), 0, nullptr, scr, r, lane); continue; } r -= I_IN;
        if (r < I_O) { p0_tr_item(A.in[16], 1024, 1024, 1024, 32, (bf16*)(ws + WS_WO), 0, nullptr, scr, r, lane); continue; } r -= I_O;
        if (r < I_G) { p0_tr_item(A.in[18], DFF, 1024, DFF, 88, (bf16*)(ws + WS_WGU), 1, A.in[17], scr, r, lane); continue; } r -= I_G;
        if (r < I_G) { p0_tr_item(A.in[19], DFF, 1024, DFF, 88, (bf16*)(ws + WS_WGU), 2, A.in[17], scr, r, lane); continue; } r -= I_G;
        if (r < I_D) { p0_tr_item(A.in[20], 1024, DFF, 1024, 32, (bf16*)(ws + WS_WDN), 0, nullptr, scr, r, lane); continue; } r -= I_D;
        if (r < I_PG) { p0_tr_item(A.in[23], 1024, 1024, 1024, 32, (bf16*)(ws + WS_WPG), 0, A.in[22], scr, r, lane); continue; } r -= I_PG;
        if (r < I_PL) { p0_tr_item(A.in[21], 1024, 256, 1024, 32, (bf16*)(ws + WS_WPLE), 0, nullptr, scr, r, lane); continue; } r -= I_PL;
        if (r < I_C1) { const int slot = r / 64; p0_tr_item(A.in[11] + (size_t)slot * 2048 * 64, 64, 2048, 64, 2, (bf16*)(ws + WS_WC1) + (size_t)slot * 64 * 2048, 0, nullptr, scr, r % 64, lane); continue; } r -= I_C1;
        { const int slot = r / 2; p0_tr_item(A.in[12] + (size_t)slot * 64 * 64, 64, 64, 64, 2, (bf16*)(ws + WS_WC2) + (size_t)slot * 64 * 64, 0, nullptr, scr, r % 2, lane); }
    }
    if (F.vcu < 2) { const int slot = F.vcu; const float* pe = A.in[10] + slot * 2048 + F.wave * 256; const float* w1 = A.in[11] + (size_t)slot * 2048 * 64 + (size_t)F.wave * 256 * 64; float a = 0.f;
#pragma unroll 16
        for (int k = 0; k < 256; ++k) a += pe[k] * w1[k * 64 + lane];
        ((LAS float*)(F.lds + F.wave * 16384 + 12288))[lane] = a; __syncthreads();
        if (F.wave == 0) { float t = 0.f;
#pragma unroll
            for (int w = 0; w < 8; ++w) t += ((LAS float*)(F.lds + w * 16384 + 12288))[lane];
            ((float*)(ws + WS_C1))[slot * 64 + lane] = t; }
    }
    bf16* XN = (bf16*)(ws + WS_XN);
    for (int m = gw; m < MPAD; m += NGW) {
        if (m < MTOT) { const float* xr = (m < TP) ? A.in[0] + (size_t)m * DM : A.in[1] + (size_t)(m - TP) * DM; rms_row_to_bf16(xr, A.in[8], XN + (size_t)m * DM, lane); }
        else { GAS v4u* o = (GAS v4u*)(XN + (size_t)m * DM) + lane; o[0] = (v4u){0, 0, 0, 0}; o[64] = (v4u){0, 0, 0, 0}; }
    }
    bf16* PP = (bf16*)(ws + WS_PPLE);
    for (int m = gw; m < MPAD; m += NGW) {
        v2u o = (v2u){0, 0};
        if (m < MTOT) { const float* pr = (m < TP) ? A.in[6] + (size_t)m * DPLE : A.in[7] + (size_t)(m - TP) * DPLE; const f32x4 v = ((const GAS f32x4*)pr)[lane]; o.x = pk2(v.x, v.y); o.y = pk2(v.z, v.w); }
        ((GAS v2u*)(PP + (size_t)m * DPLE))[lane] = o;
        if (m >= MTOT) { GAS v4u* z = (GAS v4u*)((bf16*)(ws + WS_MIX) + (size_t)m * DM) + lane; z[0] = (v4u){0, 0, 0, 0}; z[64] = (v4u){0, 0, 0, 0}; }
    }
    for (int it = gw; it < DBATCH * 508; it += NGW) { const int b = it / 508, r = it % 508;
        ((GAS f32x4*)(A.out + O_WINS + (size_t)(b * 512 + r) * 256))[lane] = ((const GAS f32x4*)(A.in[3] + (size_t)(b * 512 + r + 4) * 256))[lane]; }
}

constexpr float LOG2E = 1.4426950408889634f;
typedef short v4i16_t __attribute__((ext_vector_type(4)));
__device__ __forceinline__ s16x4 vtr(LAS const unsigned char* p) { return __builtin_bit_cast(s16x4, __builtin_amdgcn_ds_read_tr16_b64_v4i16((LAS v4i16_t*)p)); }
__device__ __forceinline__ unsigned cvtpk(float lo, float hi) { typedef float f2 __attribute__((ext_vector_type(2))); typedef __bf16 b2 __attribute__((ext_vector_type(2))); f2 v = {lo, hi}; b2 b = __builtin_convertvector(v, b2); return __builtin_bit_cast(unsigned, b); }
__device__ __forceinline__ int t5_bucket(int n) {
    if (n < 16) return n;
    const int large = 16 + (int)(logf((float)n / 16.0f) / 2.0794415416798357f * 16.0f);
    return large < 31 ? large : 31;
}
constexpr int AT_K0 = 0, AT_V0 = 16384, AT_LUT = 32768, AT_IMPA = 36864, AT_IMPB = AT_IMPA + 64 * 65 * 4 + 64, AT_SEL = AT_IMPB + 64 * 65 * 4 + 64, AT_MISC = AT_SEL + 1024, AT_QF = ((AT_MISC + 4096 + 1023) / 1024) * 1024, AT_END = AT_QF + 32768;
struct AttnLane {
    int koff;
    int kx;
    int voff0, voff1;
    int r32, h;
};
__device__ __forceinline__ AttnLane attn_lane(int lane) {
    AttnLane L; L.r32 = lane & 31; L.h = lane >> 5; L.koff = L.r32 * 128; L.kx = (L.r32 >> 1) & 7;
    const int i16 = lane & 15, q = i16 >> 2, p = i16 & 3, g1 = (lane >> 4) & 1;
    const int base = (4 * L.h + q) * 128 + g1 * 32 + (p >> 1) * 16 + (p & 1) * 8;
    L.voff0 = base + ((q >> 1) * 64); L.voff1 = base + (((q >> 1) ^ 1) * 64);
    return L;
}
__device__ __forceinline__ void attn_fill_lut(LAS float* lut, const float* rel_bias, int tid) {
    for (int e = tid; e < 1024; e += NWAVES * 64) { const int dist = e >> 3, hd = e & 7; lut[e] = rel_bias[t5_bucket(dist) * 8 + hd] * LOG2E; }
}
__device__ __forceinline__ void attn_commit(LAS unsigned char* kb, LAS unsigned char* vb, int tid, v4u k, v4u v) {
    const int row = tid >> 3, ch = tid & 7;
    *(LAS v4u*)(kb + row * 128 + ((ch ^ ((row >> 1) & 7)) << 4)) = k;
    *(LAS v4u*)(vb + row * 128 + ((ch ^ (((row >> 1) & 1) << 2)) << 4)) = v;
}
__device__ __forceinline__ f32x16 attn_qk(LAS const unsigned char* kb, int hf, const AttnLane& L, const bf16x8 (&qf)[4]) {
    f32x16 s = {};
#pragma unroll
    for (int ks = 0; ks < 4; ++ks) { const bf16x8 kf = *(LAS const bf16x8*)(kb + hf * 4096 + L.koff + (((2 * ks + L.h) ^ L.kx) << 4)); s = __builtin_amdgcn_mfma_f32_32x32x16_bf16(kf, qf[ks], s, 0, 0, 0); }
    return s;
}
__device__ __forceinline__ void attn_pv(LAS const unsigned char* vb, int hf, const AttnLane& L, const f32x16& p, f32x16 (&o)[2]) {
#pragma unroll
    for (int s = 0; s < 2; ++s) {
        v4u pw; pw.x = cvtpk(p[8 * s + 0], p[8 * s + 1]); pw.y = cvtpk(p[8 * s + 2], p[8 * s + 3]); pw.z = cvtpk(p[8 * s + 4], p[8 * s + 5]); pw.w = cvtpk(p[8 * s + 6], p[8 * s + 7]);
        const bf16x8 pb = __builtin_bit_cast(bf16x8, pw);
        const int rb = (32 * hf + 16 * s) * 128;
        { const s16x4 lo = vtr(vb + rb + L.voff0), hi = vtr(vb + rb + 1024 + L.voff0); const bf16x8 vf = {lo[0], lo[1], lo[2], lo[3], hi[0], hi[1], hi[2], hi[3]};
          o[0] = __builtin_amdgcn_mfma_f32_32x32x16_bf16(vf, pb, o[0], 0, 0, 0); }
        { const s16x4 lo = vtr(vb + rb + L.voff1), hi = vtr(vb + rb + 1024 + L.voff1); const bf16x8 vf = {lo[0], lo[1], lo[2], lo[3], hi[0], hi[1], hi[2], hi[3]};
          o[1] = __builtin_amdgcn_mfma_f32_32x32x16_bf16(vf, pb, o[1], 0, 0, 0); }
    }
}
__device__ __forceinline__ float max16(const f32x16& a) {
    float m0 = fmaxf(fmaxf(a[0], a[1]), fmaxf(a[2], a[3])), m1 = fmaxf(fmaxf(a[4], a[5]), fmaxf(a[6], a[7])), m2 = fmaxf(fmaxf(a[8], a[9]), fmaxf(a[10], a[11])), m3 = fmaxf(fmaxf(a[12], a[13]), fmaxf(a[14], a[15]));
    return fmaxf(fmaxf(m0, m1), fmaxf(m2, m3));
}
__device__ __forceinline__ float sum16(const f32x16& a) {
    return ((a[0] + a[1]) + (a[2] + a[3])) + ((a[4] + a[5]) + (a[6] + a[7])) + (((a[8] + a[9]) + (a[10] + a[11])) + ((a[12] + a[13]) + (a[14] + a[15])));
}
__device__ __forceinline__ void attn_softmax_pv(LAS const unsigned char* vb, const AttnLane& L, f32x16& t0, f32x16& t1, float& m, float& l, f32x16 (&o)[2]) {
    float tm = fmaxf(max16(t0), max16(t1)); tm = fmaxf(tm, __shfl_xor(tm, 32));
    const float mn = fmaxf(m, tm), mu = (mn == -INFINITY) ? 0.f : mn;
    const float alpha = __builtin_amdgcn_exp2f(m - mu);
#pragma unroll
    for (int r = 0; r < 16; ++r) { t0[r] = __builtin_amdgcn_exp2f(t0[r] - mu); t1[r] = __builtin_amdgcn_exp2f(t1[r] - mu); }
    float ps = sum16(t0) + sum16(t1); ps += __shfl_xor(ps, 32);
    l = l * alpha + ps; m = mn;
#pragma unroll
    for (int r = 0; r < 16; ++r) { o[0][r] *= alpha; o[1][r] *= alpha; }
    attn_pv(vb, 0, L, t0, o); attn_pv(vb, 1, L, t1, o);
}
#define KEYIDX(hf, reg, h) (32 * (hf) + ((reg) & 3) + 8 * ((reg) >> 2) + 4 * (h))

__device__ __forceinline__ void win_unit(const Frame& F, const Args& A, LAS unsigned char* sh, int b, int g, int qb) {
    const bf16* PROJ = (const bf16*)(A.ws + WS_PROJ);
    const AttnLane L = attn_lane(F.lane);
    const int tid = F.tid, w = F.wave;
    const int tq = 64 * qb + 8 * w + (L.r32 >> 2), hd = g * 4 + (L.r32 & 3);
    const size_t tokq = (size_t)b * SEQ + tq;
    bf16x8 qf[4];
#pragma unroll
    for (int ks = 0; ks < 4; ++ks) qf[ks] = *(const bf16x8*)(PROJ + tokq * NPROJ + C_QN + hd * 64 + 16 * ks + 8 * L.h);
    LAS const float* lut = (LAS const float*)(sh + AT_LUT);
    const int kt0 = qb >= 8 ? qb - 8 : 0, nt = qb - kt0 + 1;
    const int srow = tid >> 3, sch = tid & 7;
    const bf16* ksrc = PROJ + ((size_t)b * SEQ + srow) * NPROJ + C_WIN + g * 64 + sch * 8;
    v4u kr, vr;
    kr = *(const v4u*)(ksrc + (size_t)(64 * kt0) * NPROJ); vr = *(const v4u*)(ksrc + (size_t)(64 * kt0) * NPROJ + 128);
    __syncthreads();
    attn_commit(sh + AT_K0, sh + AT_V0, tid, kr, vr);
    __syncthreads();
    float m = -INFINITY, l = 0.f; f32x16 o[2]; o[0] = f32x16{}; o[1] = f32x16{};
    for (int it = 0; it < nt; ++it) {
        const int kt = kt0 + it, buf = it & 1;
        if (it + 1 < nt) { kr = *(const v4u*)(ksrc + (size_t)(64 * (kt + 1)) * NPROJ); vr = *(const v4u*)(ksrc + (size_t)(64 * (kt + 1)) * NPROJ + 128); }
        LAS const unsigned char* kb = sh + AT_K0 + buf * 8192; LAS const unsigned char* vb = sh + AT_V0 + buf * 8192;
        f32x16 t0 = attn_qk(kb, 0, L, qf), t1 = attn_qk(kb, 1, L, qf);
        const int dbase = tq - 64 * kt;
#pragma unroll
        for (int r = 0; r < 16; ++r) {
            { const int dist = dbase - KEYIDX(0, r, L.h); const int di = dist < 127 ? dist : 127; const bool ok = dist >= 0 && dist < 512; t0[r] = ok ? t0[r] * LOG2E + lut[(di < 0 ? 0 : di) * 8 + hd] : -INFINITY; }
            { const int dist = dbase - KEYIDX(1, r, L.h); const int di = dist < 127 ? dist : 127; const bool ok = dist >= 0 && dist < 512; t1[r] = ok ? t1[r] * LOG2E + lut[(di < 0 ? 0 : di) * 8 + hd] : -INFINITY; }
        }
        attn_softmax_pv(vb, L, t0, t1, m, l, o);
        if (it + 1 < nt) attn_commit(sh + AT_K0 + (buf ^ 1) * 8192, sh + AT_V0 + (buf ^ 1) * 8192, tid, kr, vr);
        __syncthreads();
    }
    const float rl = 1.0f / l;
    bf16* dst = (bf16*)(A.ws + WS_OWIN) + tokq * 512 + hd * 64;
#pragma unroll
    for (int dt = 0; dt < 2; ++dt)
#pragma unroll
        for (int rq = 0; rq < 4; ++rq) { v2u wv; wv.x = cvtpk(o[dt][4 * rq] * rl, o[dt][4 * rq + 1] * rl); wv.y = cvtpk(o[dt][4 * rq + 2] * rl, o[dt][4 * rq + 3] * rl);
            *(v2u*)(dst + 32 * dt + 8 * rq + 4 * L.h) = wv; }
}

__device__ __forceinline__ void nsa_unit(const Frame& F, const Args& A, LAS unsigned char* sh, int b, int g, int qb) {
    const bf16* PROJ = (const bf16*)(A.ws + WS_PROJ);
    const AttnLane L = attn_lane(F.lane);
    const int tid = F.tid, w = F.wave, lane = F.lane;
    const int qloc = 8 * w + (L.r32 >> 2);
    const int tq = 64 * qb + qloc, hd = g * 4 + (L.r32 & 3);
    const size_t tokq = (size_t)b * SEQ + tq;
    LAS bf16x8* qlds = (LAS bf16x8*)(sh + AT_QF) + tid;
    __syncthreads();
#pragma unroll
    for (int ks = 0; ks < 4; ++ks) qlds[ks * 512] = *(const bf16x8*)(PROJ + tokq * NPROJ + C_QN + hd * 64 + 16 * ks + 8 * L.h);
#define NSA_LOADQ() bf16x8 qf[4]; _Pragma("unroll") for (int ks = 0; ks < 4; ++ks) qf[ks] = qlds[ks * 512]
    LAS const float* lut = (LAS const float*)(sh + AT_LUT);
    LAS float* impA = (LAS float*)(sh + AT_IMPA); LAS float* impB = (LAS float*)(sh + AT_IMPB);
    LAS unsigned long long* selm = (LAS unsigned long long*)(sh + AT_SEL);
    const int srow = tid >> 3, sch = tid & 7;
    v4u kr, vr;
    const int nct = (4 * qb + 3 + 63) >> 6;
    const bf16* kcs = (const bf16*)(A.ws + WS_KCP) + ((size_t)(b * 256 + srow) * 2 + g) * 64 + sch * 8;
    const bf16* vcs = (const bf16*)(A.ws + WS_VCP) + ((size_t)(b * 256 + srow) * 2 + g) * 64 + sch * 8;
    __syncthreads();
    for (int e = tid; e < 64 * 65; e += NWAVES * 64) { impA[e] = 0.f; impB[e] = 0.f; }
    float mc = -INFINITY, lc = 0.f;
    f32x16 oc[2]; oc[0] = f32x16{}; oc[1] = f32x16{};
#pragma unroll 1
    for (int pass = 0; pass < 2; ++pass) {
        kr = *(const v4u*)(kcs); vr = *(const v4u*)(vcs);
        __syncthreads();
        attn_commit(sh + AT_K0, sh + AT_V0, tid, kr, vr);
        __syncthreads();
        const float mu = (mc == -INFINITY) ? 0.f : mc, il = lc > 0.f ? 1.0f / lc : 0.f;
#pragma unroll 1
        for (int ct = 0; ct < nct; ++ct) {
            const int buf = ct & 1;
            if (ct + 1 < nct) { kr = *(const v4u*)(kcs + (size_t)(64 * (ct + 1)) * 128); vr = *(const v4u*)(vcs + (size_t)(64 * (ct + 1)) * 128); }
            LAS const unsigned char* kb = sh + AT_K0 + buf * 8192; LAS const unsigned char* vb = sh + AT_V0 + buf * 8192;
            NSA_LOADQ();
            f32x16 t0 = attn_qk(kb, 0, L, qf), t1 = attn_qk(kb, 1, L, qf);
#pragma unroll
            for (int r = 0; r < 16; ++r) {
                { const int i = 64 * ct + KEYIDX(0, r, L.h); const int dist = tq - 16 * i - 31; const int di = dist < 127 ? dist : 127; const bool ok = dist >= 0 && i < 255; t0[r] = ok ? t0[r] * LOG2E + lut[(di < 0 ? 0 : di) * 8 + hd] : -INFINITY; }
                { const int i = 64 * ct + KEYIDX(1, r, L.h); const int dist = tq - 16 * i - 31; const int di = dist < 127 ? dist : 127; const bool ok = dist >= 0 && i < 255; t1[r] = ok ? t1[r] * LOG2E + lut[(di < 0 ? 0 : di) * 8 + hd] : -INFINITY; }
            }
            if (pass == 0) {
                float tm = fmaxf(max16(t0), max16(t1)); tm = fmaxf(tm, __shfl_xor(tm, 32));
                const float mn = fmaxf(mc, tm), mu0 = (mn == -INFINITY) ? 0.f : mn;
                const float alpha = __builtin_amdgcn_exp2f(mc - mu0);
                float ps = 0.f;
#pragma unroll
                for (int r = 0; r < 16; ++r) ps += __builtin_amdgcn_exp2f(t0[r] - mu0) + __builtin_amdgcn_exp2f(t1[r] - mu0);
                ps += __shfl_xor(ps, 32);
                lc = lc * alpha + ps; mc = mn;
            } else {
#pragma unroll
                for (int r = 0; r < 16; ++r) { t0[r] = __builtin_amdgcn_exp2f(t0[r] - mu) * il; t1[r] = __builtin_amdgcn_exp2f(t1[r] - mu) * il; }
                attn_pv(vb, 0, L, t0, oc); attn_pv(vb, 1, L, t1, oc);
#pragma unroll
                for (int hf = 0; hf < 2; ++hf) {
                    float x[16];
#pragma unroll
                    for (int r = 0; r < 16; ++r) { float v = hf ? t1[r] : t0[r]; v += __shfl_xor(v, 1); v += __shfl_xor(v, 2); x[r] = v; }
                    if ((L.r32 & 3) == 0) {
#pragma unroll
                        for (int rq = 0; rq < 4; ++rq) { const int jq = 16 * ct + 8 * hf + 2 * rq + L.h;
                            impA[qloc * 65 + jq] = 2.0f * (x[4 * rq] + x[4 * rq + 1] + x[4 * rq + 2]) + x[4 * rq + 3];
                            impB[qloc * 65 + jq + 1] = x[4 * rq + 3]; }
                    }
                }
            }
            if (ct + 1 < nct) attn_commit(sh + AT_K0 + (buf ^ 1) * 8192, sh + AT_V0 + (buf ^ 1) * 8192, tid, kr, vr);
            __syncthreads();
        }
    }
#pragma unroll 1
    for (int qi = 0; qi < 8; ++qi) {
        const int q = 8 * w + qi;
        unsigned long long mk;
        if (qb < 16) mk = (2ull << qb) - 1ull;
        else {
            const bool forced = (lane == 0) || (lane == qb) || (lane == qb - 1);
            const float sc = forced ? 1e9f : (lane <= qb ? impA[q * 65 + lane] + impB[q * 65 + lane] : -1.0f);
            int rank = 0;
#pragma unroll 8
            for (int jj = 0; jj < 64; ++jj) { const float ov = __uint_as_float(__builtin_amdgcn_readlane(__float_as_uint(sc), jj)); rank += ((ov > sc) || (ov == sc && jj < lane)) ? 1 : 0; }
            mk = __ballot(rank < 16 && lane <= qb);
        }
        if (lane == 0) selm[q] = mk;
    }
    __syncthreads();
    const unsigned long long mysel = selm[qloc];
    unsigned long long um = selm[lane];
#pragma unroll
    for (int o_ = 1; o_ < 64; o_ <<= 1) { const unsigned lo = __shfl_xor((unsigned)um, o_), hi = __shfl_xor((unsigned)(um >> 32), o_); um |= ((unsigned long long)hi << 32) | lo; }
    um = ((unsigned long long)__builtin_amdgcn_readfirstlane((unsigned)(um >> 32)) << 32) | (unsigned long long)__builtin_amdgcn_readfirstlane((unsigned)um);
    const bf16* ksrc = PROJ + ((size_t)b * SEQ + srow) * NPROJ + C_KV + 2 * 128 + g * 64 + sch * 8;
    float m = -INFINITY, l = 0.f; f32x16 o[2]; o[0] = f32x16{}; o[1] = f32x16{};
    int j = __builtin_ctzll(um); um &= um - 1;
    kr = *(const v4u*)(ksrc + (size_t)(64 * j) * NPROJ); vr = *(const v4u*)(ksrc + (size_t)(64 * j) * NPROJ + 128);
    attn_commit(sh + AT_K0, sh + AT_V0, tid, kr, vr);
    __syncthreads();
    int buf = 0;
#pragma unroll 1
    for (;;) {
        const int jn = um ? __builtin_ctzll(um) : -1; um &= um - 1;
        if (jn >= 0) { kr = *(const v4u*)(ksrc + (size_t)(64 * jn) * NPROJ); vr = *(const v4u*)(ksrc + (size_t)(64 * jn) * NPROJ + 128); }
        LAS const unsigned char* kb = sh + AT_K0 + buf * 8192; LAS const unsigned char* vb = sh + AT_V0 + buf * 8192;
        NSA_LOADQ();
        f32x16 t0 = attn_qk(kb, 0, L, qf), t1 = attn_qk(kb, 1, L, qf);
        const bool selj = (mysel >> j) & 1ull;
        const int dbase = tq - 64 * j;
#pragma unroll
        for (int r = 0; r < 16; ++r) {
            { const int dist = dbase - KEYIDX(0, r, L.h); const int di = dist < 127 ? dist : 127; const bool ok = selj && dist >= 0; t0[r] = ok ? t0[r] * LOG2E + lut[(di < 0 ? 0 : di) * 8 + hd] : -INFINITY; }
            { const int dist = dbase - KEYIDX(1, r, L.h); const int di = dist < 127 ? dist : 127; const bool ok = selj && dist >= 0; t1[r] = ok ? t1[r] * LOG2E + lut[(di < 0 ? 0 : di) * 8 + hd] : -INFINITY; }
        }
        attn_softmax_pv(vb, L, t0, t1, m, l, o);
        if (jn >= 0) attn_commit(sh + AT_K0 + (buf ^ 1) * 8192, sh + AT_V0 + (buf ^ 1) * 8192, tid, kr, vr);
        __syncthreads();
        if (jn < 0) break;
        j = jn; buf ^= 1;
    }
    const bf16* gp = PROJ + tokq * NPROJ + C_GT + hd;
    const float g0 = 1.0f / (1.0f + __expf(-bf2f(gp[0]))), g1 = 1.0f / (1.0f + __expf(-bf2f(gp[8]))), g2 = 1.0f / (1.0f + __expf(-bf2f(gp[16])));
    const float rl = g1 / l;
    const bf16* ow = (const bf16*)(A.ws + WS_OWIN) + tokq * 512 + hd * 64;
    bf16* dst = (bf16*)(A.ws + WS_MIX) + tokq * 1024 + hd * 64;
#pragma unroll
    for (int dt = 0; dt < 2; ++dt)
#pragma unroll
        for (int rq = 0; rq < 4; ++rq) { const int d0 = 32 * dt + 8 * rq + 4 * L.h; const v2u wv = *(const v2u*)(ow + d0);
            const float a0 = g0 * oc[dt][4 * rq] + rl * o[dt][4 * rq] + g2 * bflo(wv.x), a1 = g0 * oc[dt][4 * rq + 1] + rl * o[dt][4 * rq + 1] + g2 * bfhi(wv.x);
            const float a2 = g0 * oc[dt][4 * rq + 2] + rl * o[dt][4 * rq + 2] + g2 * bflo(wv.y), a3 = g0 * oc[dt][4 * rq + 3] + rl * o[dt][4 * rq + 3] + g2 * bfhi(wv.y);
            v2u ov; ov.x = cvtpk(a0, a1); ov.y = cvtpk(a2, a3); *(v2u*)(dst + d0) = ov; }
}
#undef NSA_LOADQ

__device__ __forceinline__ v4u pack_f32x8(const float* p) { const f32x4 a = *(const f32x4*)p, b = *(const f32x4*)(p + 4); v4u w; w.x = pk2(a.x, a.y); w.y = pk2(a.z, a.w); w.z = pk2(b.x, b.y); w.w = pk2(b.z, b.w); return w; }
__device__ __forceinline__ void samp_load(const Args& A, int mode, int tile, int b, int g, int srow, int sch, v4u& kr, v4u& vr) {
    const bf16* PROJ = (const bf16*)(A.ws + WS_PROJ);
    kr = (v4u){0, 0, 0, 0}; vr = (v4u){0, 0, 0, 0};
    if (mode == 0) {
        const size_t off = ((size_t)(b * 512 + 64 * tile + srow) * 2 + g) * 64 + sch * 8;
        kr = *(const v4u*)((const bf16*)(A.ws + WS_KCS) + off); vr = *(const v4u*)((const bf16*)(A.ws + WS_VCS) + off);
    } else if (mode == 1) {
        if (tile < 128) { const int page = ((const int*)A.in[5])[b * 64 + (tile >> 1)]; const int row = (tile & 1) * 64 + srow;
            const float* p = A.in[2] + ((size_t)(page * 128 + row) * 4 + 2) * 128 + g * 64 + sch * 8; kr = pack_f32x8(p); vr = pack_f32x8(p + 128); }
        else if (srow < 4) { const bf16* p = PROJ + (size_t)(TP + b * 4 + srow) * NPROJ + C_KV + 2 * 128 + g * 64 + sch * 8; kr = *(const v4u*)p; vr = *(const v4u*)(p + 128); }
    } else {
        const int idx = 64 * tile + srow;
        if (idx < 512) { const float* p = A.in[3] + ((size_t)(b * 512 + idx) * 2) * 128 + g * 64 + sch * 8; kr = pack_f32x8(p); vr = pack_f32x8(p + 128); }
        else if (idx < 516) { const bf16* p = PROJ + (size_t)(TP + b * 4 + idx - 512) * NPROJ + C_WIN + g * 64 + sch * 8; kr = *(const v4u*)p; vr = *(const v4u*)(p + 128); }
    }
}
__device__ __forceinline__ void samp_unit(const Frame& F, const Args& A, LAS unsigned char* sh, int b, int g) {
    const bf16* PROJ = (const bf16*)(A.ws + WS_PROJ);
    const AttnLane L = attn_lane(F.lane);
    const int tid = F.tid, w = F.wave, lane = F.lane;
    const bool cw = (w == 0);
    const bool colok = cw && L.r32 < 16;
    const int qi = (L.r32 >> 2) & 3, hd = g * 4 + (L.r32 & 3);
    const int pos = PAST + qi;
    const size_t tokq = (size_t)TP + b * 4 + qi;
#define SAMP_LOADQ() bf16x8 qf[4]; _Pragma("unroll") for (int ks = 0; ks < 4; ++ks) qf[ks] = *(const bf16x8*)(PROJ + tokq * NPROJ + C_QN + hd * 64 + 16 * ks + 8 * L.h)
    LAS const float* lut = (LAS const float*)(sh + AT_LUT);
    LAS float* impA = (LAS float*)(sh + AT_IMPA); LAS float* impB = (LAS float*)(sh + AT_IMPB);
    LAS unsigned long long* selm = (LAS unsigned long long*)(sh + AT_SEL);
    LAS float* scs = (LAS float*)(sh + AT_MISC);
    LAS int* tlist = (LAS int*)(sh + AT_MISC + 1024);
    const int srow = tid >> 3, sch = tid & 7;
    v4u kr, vr;
    __syncthreads();
    for (int e = tid; e < 4 * 132; e += NWAVES * 64) { impA[e] = 0.f; impB[e] = 0.f; }
    float mc = -INFINITY, lc = 0.f; f32x16 oc[2]; oc[0] = f32x16{}; oc[1] = f32x16{};
#pragma unroll 1
    for (int pass = 0; pass < 2; ++pass) {
        samp_load(A, 0, 0, b, g, srow, sch, kr, vr);
        __syncthreads();
        attn_commit(sh + AT_K0, sh + AT_V0, tid, kr, vr);
        __syncthreads();
        const float mu = (mc == -INFINITY) ? 0.f : mc, il = lc > 0.f ? 1.0f / lc : 0.f;
#pragma unroll 1
        for (int ct = 0; ct < 8; ++ct) {
            const int buf = ct & 1;
            if (ct + 1 < 8) samp_load(A, 0, ct + 1, b, g, srow, sch, kr, vr);
            if (cw) {
                LAS const unsigned char* kb = sh + AT_K0 + buf * 8192; LAS const unsigned char* vb = sh + AT_V0 + buf * 8192;
                SAMP_LOADQ();
                f32x16 t0 = attn_qk(kb, 0, L, qf), t1 = attn_qk(kb, 1, L, qf);
#pragma unroll
                for (int r = 0; r < 16; ++r) {
                    { const int i = 64 * ct + KEYIDX(0, r, L.h); const int dist = pos - 16 * i - 31; const int di = dist < 127 ? dist : 127; const bool ok = colok && dist >= 0 && i < 511; t0[r] = ok ? t0[r] * LOG2E + lut[(di < 0 ? 0 : di) * 8 + hd] : -INFINITY; }
                    { const int i = 64 * ct + KEYIDX(1, r, L.h); const int dist = pos - 16 * i - 31; const int di = dist < 127 ? dist : 127; const bool ok = colok && dist >= 0 && i < 511; t1[r] = ok ? t1[r] * LOG2E + lut[(di < 0 ? 0 : di) * 8 + hd] : -INFINITY; }
                }
                if (pass == 0) {
                    float tm = fmaxf(max16(t0), max16(t1)); tm = fmaxf(tm, __shfl_xor(tm, 32));
                    const float mn = fmaxf(mc, tm), mu0 = (mn == -INFINITY) ? 0.f : mn;
                    const float alpha = __builtin_amdgcn_exp2f(mc - mu0);
                    float ps = 0.f;
#pragma unroll
                    for (int r = 0; r < 16; ++r) ps += __builtin_amdgcn_exp2f(t0[r] - mu0) + __builtin_amdgcn_exp2f(t1[r] - mu0);
                    ps += __shfl_xor(ps, 32);
                    lc = lc * alpha + ps; mc = mn;
                } else {
#pragma unroll
                    for (int r = 0; r < 16; ++r) { t0[r] = __builtin_amdgcn_exp2f(t0[r] - mu) * il; t1[r] = __builtin_amdgcn_exp2f(t1[r] - mu) * il; }
                    attn_pv(vb, 0, L, t0, oc); attn_pv(vb, 1, L, t1, oc);
#pragma unroll
                    for (int hf = 0; hf < 2; ++hf) {
                        float x[16];
#pragma unroll
                        for (int r = 0; r < 16; ++r) { float v = hf ? t1[r] : t0[r]; v += __shfl_xor(v, 1); v += __shfl_xor(v, 2); x[r] = v; }
                        if ((L.r32 & 3) == 0 && L.r32 < 16) {
#pragma unroll
                            for (int rq = 0; rq < 4; ++rq) { const int jq = 16 * ct + 8 * hf + 2 * rq + L.h;
                                impA[qi * 132 + jq] = 2.0f * (x[4 * rq] + x[4 * rq + 1] + x[4 * rq + 2]) + x[4 * rq + 3];
                                impB[qi * 132 + jq + 1] = x[4 * rq + 3]; }
                        }
                    }
                }
            }
            if (ct + 1 < 8) attn_commit(sh + AT_K0 + (buf ^ 1) * 8192, sh + AT_V0 + (buf ^ 1) * 8192, tid, kr, vr);
            __syncthreads();
        }
    }
    if (cw) {
        unsigned long long ulo = 0ull, uhi = 0ull;
#pragma unroll 1
        for (int q = 0; q < 4; ++q) {
            const int j0 = lane, j1 = lane + 64;
            const float s0 = (j0 == 0) ? 1e9f : impA[q * 132 + j0] + impB[q * 132 + j0];
            const float s1 = (j1 == 127) ? 1e9f : impA[q * 132 + j1] + impB[q * 132 + j1];
            scs[j0] = s0; scs[j1] = s1;
            LDS_WAIT(); asm volatile("" ::: "memory");
            int r0 = 0, r1 = 0;
#pragma unroll 8
            for (int jj = 0; jj < 128; ++jj) { const float ov = scs[jj]; r0 += ((ov > s0) || (ov == s0 && jj < j0)) ? 1 : 0; r1 += ((ov > s1) || (ov == s1 && jj < j1)) ? 1 : 0; }
            const unsigned long long mlo = __ballot(r0 < 15), mhi = __ballot(r1 < 15);
            if (lane == 0) { selm[2 * q] = mlo; selm[2 * q + 1] = mhi; }
            ulo |= mlo; uhi |= mhi;
            LDS_WAIT(); asm volatile("" ::: "memory");
        }
        if (lane == 0) { int n = 0; for (int j = 0; j < 64; ++j) if ((ulo >> j) & 1ull) tlist[1 + n++] = j; for (int j = 0; j < 64; ++j) if ((uhi >> j) & 1ull) tlist[1 + n++] = 64 + j; tlist[1 + n++] = 128; tlist[0] = n; }
    }
    __syncthreads();
    const unsigned long long mylo = selm[2 * qi], myhi = selm[2 * qi + 1];
    const int nsel = tlist[0];
    const bf16* gp = PROJ + tokq * NPROJ + C_GT + hd;
    const float g0 = 1.0f / (1.0f + __expf(-bf2f(gp[0]))), g1 = 1.0f / (1.0f + __expf(-bf2f(gp[8]))), g2 = 1.0f / (1.0f + __expf(-bf2f(gp[16])));
#pragma unroll
    for (int r = 0; r < 16; ++r) { oc[0][r] *= g0; oc[1][r] *= g0; }
#pragma unroll 1
    for (int br = 0; br < 2; ++br) {
        const int nt = br == 0 ? nsel : 9;
        float m = -INFINITY, l = 0.f; f32x16 o[2]; o[0] = f32x16{}; o[1] = f32x16{};
        int j = br == 0 ? tlist[1] : 0;
        samp_load(A, 1 + br, j, b, g, srow, sch, kr, vr);
        __syncthreads();
        attn_commit(sh + AT_K0, sh + AT_V0, tid, kr, vr);
        __syncthreads();
#pragma unroll 1
        for (int it = 0; it < nt; ++it) {
            const int buf = it & 1;
            const int jn = (it + 1 < nt) ? (br == 0 ? tlist[2 + it] : it + 1) : -1;
            if (jn >= 0) samp_load(A, 1 + br, jn, b, g, srow, sch, kr, vr);
            if (cw) {
                LAS const unsigned char* kb = sh + AT_K0 + buf * 8192; LAS const unsigned char* vb = sh + AT_V0 + buf * 8192;
                SAMP_LOADQ();
                f32x16 t0 = attn_qk(kb, 0, L, qf), t1 = attn_qk(kb, 1, L, qf);
                bool selj = colok;
                int kp0;
                if (br == 0) { selj = selj && (j >= 128 ? true : (j < 64 ? ((mylo >> j) & 1ull) : ((myhi >> (j - 64)) & 1ull))); kp0 = 64 * j; }
                else kp0 = PAST - 512 + 64 * j;
                const int dbase = pos - kp0;
#pragma unroll
                for (int r = 0; r < 16; ++r) {
                    { const int ki = KEYIDX(0, r, L.h); const int dist = dbase - ki; const int di = dist < 127 ? dist : 127; const bool ok = selj && dist >= 0 && (br == 0 || (dist < 512 && 64 * j + ki < 516)); t0[r] = ok ? t0[r] * LOG2E + lut[(di < 0 ? 0 : di) * 8 + hd] : -INFINITY; }
                    { const int ki = KEYIDX(1, r, L.h); const int dist = dbase - ki; const int di = dist < 127 ? dist : 127; const bool ok = selj && dist >= 0 && (br == 0 || (dist < 512 && 64 * j + ki < 516)); t1[r] = ok ? t1[r] * LOG2E + lut[(di < 0 ? 0 : di) * 8 + hd] : -INFINITY; }
                }
                attn_softmax_pv(vb, L, t0, t1, m, l, o);
            }
            if (jn >= 0) attn_commit(sh + AT_K0 + (buf ^ 1) * 8192, sh + AT_V0 + (buf ^ 1) * 8192, tid, kr, vr);
            __syncthreads();
            j = jn;
        }
        const float sc = l > 0.f ? (br == 0 ? g1 : g2) / l : 0.f;
#pragma unroll
        for (int r = 0; r < 16; ++r) { oc[0][r] += sc * o[0][r]; oc[1][r] += sc * o[1][r]; }
    }
    if (colok) {
        bf16* dst = (bf16*)(A.ws + WS_MIX) + tokq * 1024 + hd * 64;
#pragma unroll
        for (int dt = 0; dt < 2; ++dt)
#pragma unroll
            for (int rq = 0; rq < 4; ++rq) { const int d0 = 32 * dt + 8 * rq + 4 * L.h;
                v2u ov; ov.x = cvtpk(oc[dt][4 * rq], oc[dt][4 * rq + 1]); ov.y = cvtpk(oc[dt][4 * rq + 2], oc[dt][4 * rq + 3]); *(v2u*)(dst + d0) = ov; }
    }
}
#undef SAMP_LOADQ

__device__ __forceinline__ float gelu_tanh(float x) { const float u = 0.7978845608028654f * (x + 0.044715f * x * x * x); const float t = 1.0f - 2.0f / (1.0f + __expf(2.0f * u)); return 0.5f * x * (1.0f + t); }
template <bool SAMPLE>
__device__ __forceinline__ void cmp_job(const Args& A, int b, int slot, int g, int grp, int lane) {
    const int r32 = lane & 31, h = lane >> 5;
    const int nsb = SAMPLE ? 512 : 256;
    int sb = 31 * grp + r32; const bool sbok = sb < nsb; if (!sbok) sb = nsb - 1;
    const bf16* W1 = (const bf16*)(A.ws + WS_WC1) + (size_t)slot * 64 * 2048;
    const bf16* PROJ = (const bf16*)(A.ws + WS_PROJ);
    f32x16 acc[2][2];
#pragma unroll
    for (int j = 0; j < 2; ++j) { acc[j][0] = f32x16{}; acc[j][1] = f32x16{}; }
    const bf16* w1p = W1 + (size_t)r32 * 2048 + 8 * h;
    const float* crow = nullptr; const bf16* prow = nullptr;
    if (SAMPLE) { const int p0 = 16 * sb; const int page = ((const int*)A.in[5])[b * 64 + (p0 >> 7)];
        crow = A.in[2] + ((size_t)(page * 128 + (p0 & 127)) * 4 + slot) * 128 + g * 64 + 8 * h; }
    else prow = PROJ + (size_t)(b * SEQ + 16 * sb) * NPROJ + C_KV + slot * 128 + g * 64 + 8 * h;
#pragma unroll 2
    for (int s = 0; s < 16; ++s) {
#pragma unroll
        for (int dq = 0; dq < 4; ++dq) {
            bf16x8 bf;
            if (SAMPLE) bf = __builtin_bit_cast(bf16x8, pack_f32x8(crow + (size_t)s * 512 + dq * 16));
            else bf = *(const bf16x8*)(prow + (size_t)s * NPROJ + dq * 16);
#pragma unroll
            for (int j = 0; j < 2; ++j)
#pragma unroll
                for (int ht = 0; ht < 2; ++ht) { const bf16x8 af = *(const bf16x8*)(w1p + (size_t)ht * 32 * 2048 + j * 1024 + s * 64 + dq * 16);
                    acc[j][ht] = __builtin_amdgcn_mfma_f32_32x32x16_bf16(af, bf, acc[j][ht], 0, 0, 0); }
        }
    }
    const float* c1p = (const float*)(A.ws + WS_C1) + slot * 64;
    bf16x8 xb[2][2];
#pragma unroll
    for (int ht = 0; ht < 2; ++ht) {
        float xv[16];
#pragma unroll
        for (int r = 0; r < 16; ++r) { const int hid = 32 * ht + (r & 3) + 8 * (r >> 2) + 4 * h;
            const float c1 = c1p[hid];
            const float h1 = __shfl(acc[1][ht][r], (lane & 32) | ((r32 + 1) & 31));
            xv[r] = gelu_tanh(acc[0][ht][r] + h1 + c1); }
#pragma unroll
        for (int s = 0; s < 2; ++s) { v4u pw; pw.x = cvtpk(xv[8 * s], xv[8 * s + 1]); pw.y = cvtpk(xv[8 * s + 2], xv[8 * s + 3]); pw.z = cvtpk(xv[8 * s + 4], xv[8 * s + 5]); pw.w = cvtpk(xv[8 * s + 6], xv[8 * s + 7]); xb[ht][s] = __builtin_bit_cast(bf16x8, pw); }
    }
    const bf16* W2 = (const bf16*)(A.ws + WS_WC2) + (size_t)slot * 64 * 64;
    f32x16 oo[2];
#pragma unroll
    for (int dt = 0; dt < 2; ++dt) {
        oo[dt] = f32x16{};
#pragma unroll
        for (int ht = 0; ht < 2; ++ht)
#pragma unroll
            for (int s = 0; s < 2; ++s) { const bf16* wp = W2 + (size_t)(32 * dt + r32) * 64 + 32 * ht + 16 * s + 4 * h;
                const v2u lo = *(const v2u*)wp, hi = *(const v2u*)(wp + 8); const v4u af = {lo.x, lo.y, hi.x, hi.y};
                oo[dt] = __builtin_amdgcn_mfma_f32_32x32x16_bf16(__builtin_bit_cast(bf16x8, af), xb[ht][s], oo[dt], 0, 0, 0); }
    }
    const int nblk = SAMPLE ? 511 : 255;
    if (r32 < 31 && sb < nblk && sbok) {
        bf16* dst = (bf16*)(A.ws + (SAMPLE ? (slot ? WS_VCS : WS_KCS) : (slot ? WS_VCP : WS_KCP))) + ((size_t)(b * nsb + sb) * 2 + g) * 64;
#pragma unroll
        for (int dt = 0; dt < 2; ++dt)
#pragma unroll
            for (int rq = 0; rq < 4; ++rq) { v2u wv; wv.x = cvtpk(oo[dt][4 * rq], oo[dt][4 * rq + 1]); wv.y = cvtpk(oo[dt][4 * rq + 2], oo[dt][4 * rq + 3]); *(v2u*)(dst + 32 * dt + 8 * rq + 4 * h) = wv; }
    }
}

__device__ __forceinline__ float log_sigmoid(float x) { return fminf(x, 0.f) - __logf(1.0f + __expf(-fabsf(x))); }
constexpr int G_QE = 0, G_KE = 8192, G_KDT = 16384, G_V = 24576, G_ST = 40960, G_LR = 73728, G_SEG = 77824, G_DEC = 79872, G_END = 80128;
__device__ __forceinline__ int sw128(int row, int ch) { return row * 128 + ((ch ^ ((row >> 1) & 7)) << 4); }

__device__ __forceinline__ void gla_local(const Frame& F, const Args& A, LAS unsigned char* sh, int unit) {
    const int b = unit >> 6, hh = (unit >> 4) & 3, sc = unit & 15;
    const int tid = F.tid, w = F.wave, lane = F.lane, r32 = lane & 31, h = lane >> 5;
    const bf16* PROJ = (const bf16*)(A.ws + WS_PROJ);
    const size_t tok0 = (size_t)b * SEQ + 256 * sc;
    const int c = lane;
    float wg[16];
#pragma unroll
    for (int r = 0; r < 16; ++r) wg[r] = A.in[13][r * 256 + hh * 64 + c];
    const float bg = A.in[14][hh * 64 + c];
    float Bprev = 0.f;
    const int dvt = w >> 1, it = w & 1;
    f32x16 accS = {};
    const int i16 = lane & 15, tq = i16 >> 2, tp = i16 & 3, g1 = (lane >> 4) & 1;
    const int vcol = ((4 * (dvt ^ tq) + 2 * g1 + (tp >> 1)) << 4) + (tp & 1) * 8;
    __syncthreads();
#pragma unroll 1
    for (int n = 0; n < 4; ++n) {
        const size_t tb = tok0 + 64 * n;
        { const int trow = tid >> 3, pr = tid & 7; const unsigned lw = *(const unsigned*)(PROJ + (tb + trow) * NPROJ + C_LR + 2 * pr);
          LAS float* lr = (LAS float*)(sh + G_LR); lr[trow * 16 + 2 * pr] = bflo(lw); lr[trow * 16 + 2 * pr + 1] = bfhi(lw);
#pragma unroll
          for (int k2 = 0; k2 < 2; ++k2) { const int ch = pr * 2 + k2; const v4u vv = *(const v4u*)(PROJ + (tb + trow) * NPROJ + C_VG + hh * 128 + ch * 8);
              *(LAS v4u*)(sh + G_V + trow * 256 + ((ch ^ ((trow & 3) << 2)) << 4)) = vv; } }
        __syncthreads();
        float cum[8], qv[8], kv[8];
        { LAS const float* lr = (LAS const float*)(sh + G_LR); float run = 0.f;
#pragma unroll
          for (int k = 0; k < 8; ++k) { const int i = 8 * w + k; float x = bg;
#pragma unroll
              for (int r = 0; r < 16; ++r) x += lr[i * 16 + r] * wg[r];
              run += log_sigmoid(x) * (1.0f / 16.0f); cum[k] = run;
              qv[k] = 0.125f * bf2f(PROJ[(tb + i) * NPROJ + C_QG + hh * 64 + c]); kv[k] = bf2f(PROJ[(tb + i) * NPROJ + C_KG + hh * 64 + c]); }
          ((LAS float*)(sh + G_SEG))[w * 64 + c] = run; }
        __syncthreads();
        { LAS const float* seg = (LAS const float*)(sh + G_SEG); float pre = 0.f, tot = 0.f;
#pragma unroll
          for (int g_ = 0; g_ < 8; ++g_) { const float sv = seg[g_ * 64 + c]; tot += sv; if (g_ < w) pre += sv; }
          const float eB = __expf(Bprev);
          unsigned kdw[4];
#pragma unroll
          for (int k = 0; k < 8; ++k) { const int i = 8 * w + k; const float bb = pre + cum[k];
              const float qe = qv[k] * __expf(bb), ke = kv[k] * __expf(-bb), kd = kv[k] * __expf(tot - bb);
              *(LAS unsigned short*)(sh + G_QE + sw128(i, c >> 3) + (c & 7) * 2) = (unsigned short)f2bf(qe);
              *(LAS unsigned short*)(sh + G_KE + sw128(i, c >> 3) + (c & 7) * 2) = (unsigned short)f2bf(ke);
              ((bf16*)(A.ws + WS_QB))[(tb + i) * 256 + hh * 64 + c] = (bf16)f2bf(qe * eB);
              if (k & 1) kdw[k >> 1] |= f2bf(kd) << 16; else kdw[k >> 1] = f2bf(kd); }
          *(LAS v4u*)(sh + G_KDT + sw128(c, w)) = (v4u){kdw[0], kdw[1], kdw[2], kdw[3]};
          if (w == 0) ((LAS float*)(sh + G_DEC))[c] = __expf(tot);
          Bprev += tot; }
        __syncthreads();
        LAS const unsigned char* qeb = sh + G_QE; LAS const unsigned char* keb = sh + G_KE; LAS const unsigned char* vbase = sh + G_V;
        bf16x8 qfr[4];
#pragma unroll
        for (int ks = 0; ks < 4; ++ks) qfr[ks] = *(LAS const bf16x8*)(qeb + sw128(32 * it + r32, 2 * ks + h));
        f32x16 oT = {};
#pragma unroll
        for (int jt = 0; jt < 2; ++jt) {
            if (jt <= it) {
                f32x16 s = {};
#pragma unroll
                for (int ks = 0; ks < 4; ++ks) { const bf16x8 kf = *(LAS const bf16x8*)(keb + sw128(32 * jt + r32, 2 * ks + h)); s = __builtin_amdgcn_mfma_f32_32x32x16_bf16(kf, qfr[ks], s, 0, 0, 0); }
                if (jt == it) {
#pragma unroll
                    for (int r = 0; r < 16; ++r) { const int j = (r & 3) + 8 * (r >> 2) + 4 * h; if (j > r32) s[r] = 0.f; }
                }
#pragma unroll
                for (int s2 = 0; s2 < 2; ++s2) {
                    v4u pw; pw.x = cvtpk(s[8 * s2], s[8 * s2 + 1]); pw.y = cvtpk(s[8 * s2 + 2], s[8 * s2 + 3]); pw.z = cvtpk(s[8 * s2 + 4], s[8 * s2 + 5]); pw.w = cvtpk(s[8 * s2 + 6], s[8 * s2 + 7]);
                    const int row = 32 * jt + 16 * s2 + 4 * h + tq;
                    const s16x4 lo = vtr(vbase + row * 256 + vcol), hi = vtr(vbase + (row + 8) * 256 + vcol);
                    const bf16x8 vf = {lo[0], lo[1], lo[2], lo[3], hi[0], hi[1], hi[2], hi[3]};
                    oT = __builtin_amdgcn_mfma_f32_32x32x16_bf16(vf, __builtin_bit_cast(bf16x8, pw), oT, 0, 0, 0);
                }
            }
        }
        if (n > 0) {
            LAS const unsigned char* stb = sh + G_ST + (n & 1) * 16384;
#pragma unroll
            for (int ks = 0; ks < 4; ++ks) { const bf16x8 sf = *(LAS const bf16x8*)(stb + sw128(32 * dvt + r32, 2 * ks + h)); oT = __builtin_amdgcn_mfma_f32_32x32x16_bf16(sf, qfr[ks], oT, 0, 0, 0); }
        }
        { float* op = (float*)(A.ws + WS_OLOC) + (tb + 32 * it + r32) * 512 + hh * 128 + 32 * dvt + 4 * h;
#pragma unroll
          for (int rq = 0; rq < 4; ++rq) *(f32x4*)(op + 8 * rq) = (f32x4){oT[4 * rq], oT[4 * rq + 1], oT[4 * rq + 2], oT[4 * rq + 3]}; }
        { const float dec = ((LAS const float*)(sh + G_DEC))[32 * it + r32];
#pragma unroll
          for (int r = 0; r < 16; ++r) accS[r] *= dec;
#pragma unroll
          for (int ks = 0; ks < 4; ++ks) {
              const bf16x8 kdf = *(LAS const bf16x8*)(sh + G_KDT + sw128(32 * it + r32, 2 * ks + h));
              const int row = 16 * ks + 8 * h + tq;
              const s16x4 lo = vtr(vbase + row * 256 + vcol), hi = vtr(vbase + (row + 4) * 256 + vcol);
              const bf16x8 vf = {lo[0], lo[1], lo[2], lo[3], hi[0], hi[1], hi[2], hi[3]};
              accS = __builtin_amdgcn_mfma_f32_32x32x16_bf16(vf, kdf, accS, 0, 0, 0);
          }
          LAS unsigned char* stn = sh + G_ST + ((n + 1) & 1) * 16384; const int d = 32 * it + r32;
#pragma unroll
          for (int r = 0; r < 16; ++r) { const int dv = 32 * dvt + (r & 3) + 8 * (r >> 2) + 4 * h; *(LAS unsigned short*)(stn + sw128(dv, d >> 3) + (d & 7) * 2) = (unsigned short)f2bf(accS[r]); } }
        __syncthreads();
    }
    { float* up = (float*)(A.ws + WS_USC) + (size_t)unit * 8192; const int d = 32 * it + r32;
#pragma unroll
      for (int r = 0; r < 16; ++r) { const int dv = 32 * dvt + (r & 3) + 8 * (r >> 2) + 4 * h; up[dv * 64 + d] = accS[r]; }
      if (w == 0) ((float*)(A.ws + WS_DSC))[unit * 64 + c] = __expf(Bprev); }
}

__device__ __forceinline__ void gla_out(const Frame& F, const Args& A, LAS unsigned char* sh, int unit) {
    const int b = unit >> 6, hh = (unit >> 4) & 3, sc = unit & 15;
    const int tid = F.tid, w = F.wave, lane = F.lane, r32 = lane & 31, h = lane >> 5;
    const bf16* PROJ = (const bf16*)(A.ws + WS_PROJ);
    const size_t tok0 = (size_t)b * SEQ + 256 * sc;
    const int d4 = (tid & 15) * 4, dvr = tid >> 4;
    f32x4 S[4];
#pragma unroll
    for (int k = 0; k < 4; ++k) S[k] = (f32x4){0.f, 0.f, 0.f, 0.f};
    const float* U0 = (const float*)(A.ws + WS_USC) + (size_t)(unit - sc) * 8192; const float* D0 = (const float*)(A.ws + WS_DSC) + (size_t)(unit - sc) * 64;
#pragma unroll 1
    for (int s = 0; s < sc; ++s) { const f32x4 dd = *(const f32x4*)(D0 + s * 64 + d4);
#pragma unroll
        for (int k = 0; k < 4; ++k) { const f32x4 u = *(const f32x4*)(U0 + (size_t)s * 8192 + (32 * k + dvr) * 64 + d4); S[k] = S[k] * dd + u; } }
    __syncthreads();
#pragma unroll
    for (int k = 0; k < 4; ++k) { const int dv = 32 * k + dvr; v2u wv; wv.x = pk2(S[k].x, S[k].y); wv.y = pk2(S[k].z, S[k].w);
        *(LAS v2u*)(sh + sw128(dv, d4 >> 3) + (d4 & 7) * 2) = wv; }
    if (sc == 15) {
        const f32x4 dd = *(const f32x4*)(D0 + 15 * 64 + d4); float* op = A.out + O_GLAP + (size_t)(b * 4 + hh) * 8192;
#pragma unroll
        for (int k = 0; k < 4; ++k) { const int dv = 32 * k + dvr; const f32x4 u = *(const f32x4*)(U0 + (size_t)15 * 8192 + dv * 64 + d4); const f32x4 e = S[k] * dd + u;
            op[(d4 + 0) * 128 + dv] = e.x; op[(d4 + 1) * 128 + dv] = e.y; op[(d4 + 2) * 128 + dv] = e.z; op[(d4 + 3) * 128 + dv] = e.w; }
    }
    __syncthreads();
    const size_t tok = tok0 + 32 * w + r32;
    f32x16 acc[4];
#pragma unroll
    for (int t = 0; t < 4; ++t) acc[t] = f32x16{};
#pragma unroll
    for (int ks = 0; ks < 4; ++ks) { const bf16x8 qb = *(const bf16x8*)((const bf16*)(A.ws + WS_QB) + tok * 256 + hh * 64 + 16 * ks + 8 * h);
#pragma unroll
        for (int t = 0; t < 4; ++t) { const bf16x8 sf = *(LAS const bf16x8*)(sh + sw128(32 * t + r32, 2 * ks + h)); acc[t] = __builtin_amdgcn_mfma_f32_32x32x16_bf16(sf, qb, acc[t], 0, 0, 0); } }
    const float* ol = (const float*)(A.ws + WS_OLOC) + tok * 512 + hh * 128;
    float ss = 0.f;
#pragma unroll
    for (int t = 0; t < 4; ++t)
#pragma unroll
        for (int rq = 0; rq < 4; ++rq) { const f32x4 v = *(const f32x4*)(ol + 32 * t + 8 * rq + 4 * h);
#pragma unroll
            for (int e = 0; e < 4; ++e) { acc[t][4 * rq + e] += v[e]; ss += acc[t][4 * rq + e] * acc[t][4 * rq + e]; } }
    ss += __shfl_xor(ss, 32);
    const float rstd = 1.0f / sqrtf(ss * (1.0f / 128.0f) + EPS);
    const float* gn = A.in[15]; const bf16* gg = PROJ + tok * NPROJ + C_GG + hh * 128;
    bf16* dst = (bf16*)(A.ws + WS_MIX) + tok * 1024 + 512 + hh * 128;
#pragma unroll
    for (int t = 0; t < 4; ++t)
#pragma unroll
        for (int rq = 0; rq < 4; ++rq) { const int dv0 = 32 * t + 8 * rq + 4 * h; const f32x4 gnv = *(const f32x4*)(gn + dv0); const v2u gw = *(const v2u*)(gg + dv0);
            const float gv[4] = {bflo(gw.x), bfhi(gw.x), bflo(gw.y), bfhi(gw.y)}; float y[4];
#pragma unroll
            for (int e = 0; e < 4; ++e) y[e] = acc[t][4 * rq + e] * rstd * gnv[e] * gv[e] / (1.0f + __expf(-gv[e]));
            v2u ov; ov.x = cvtpk(y[0], y[1]); ov.y = cvtpk(y[2], y[3]); *(v2u*)(dst + dv0) = ov; }
}

__device__ __forceinline__ void gla_sample(const Frame& F, const Args& A, LAS unsigned char* sh, int unit) {
    const int b = unit >> 2, hh = unit & 3, tid = F.tid;
    const bf16* PROJ = (const bf16*)(A.ws + WS_PROJ);
    LAS float* la = (LAS float*)sh;
    LAS float* qs = la + 256;
    LAS float* ks = qs + 256;
    LAS float* op = ks + 256;
    LAS float* of = op + 2048;
    __syncthreads();
    if (tid < 256) { const int t = tid >> 6, c = tid & 63; const size_t tok = (size_t)TP + b * 4 + t; float x = A.in[14][hh * 64 + c];
#pragma unroll
        for (int r = 0; r < 16; ++r) x += bf2f(PROJ[tok * NPROJ + C_LR + r]) * A.in[13][r * 256 + hh * 64 + c];
        la[tid] = __expf(log_sigmoid(x) * (1.0f / 16.0f)); qs[tid] = 0.125f * bf2f(PROJ[tok * NPROJ + C_QG + hh * 64 + c]); ks[tid] = bf2f(PROJ[tok * NPROJ + C_KG + hh * 64 + c]); }
    __syncthreads();
    const int dv = tid & 127, cg = tid >> 7;
    const float* s0 = A.in[4] + (size_t)(b * 4 + hh) * 8192;
    float S[16];
#pragma unroll
    for (int k = 0; k < 16; ++k) S[k] = s0[(16 * cg + k) * 128 + dv];
#pragma unroll
    for (int t = 0; t < 4; ++t) { const float vv = bf2f(PROJ[((size_t)TP + b * 4 + t) * NPROJ + C_VG + hh * 128 + dv]); float o = 0.f;
#pragma unroll
        for (int k = 0; k < 16; ++k) { const int c = 16 * cg + k; S[k] = la[t * 64 + c] * S[k] + ks[t * 64 + c] * vv; o += qs[t * 64 + c] * S[k]; }
        op[(cg * 4 + t) * 128 + dv] = o; }
    float* so = A.out + O_GLAS + (size_t)(b * 4 + hh) * 8192;
#pragma unroll
    for (int k = 0; k < 16; ++k) so[(16 * cg + k) * 128 + dv] = S[k];
    __syncthreads();
    { const int t = tid >> 7; of[t * 128 + dv] = (op[(0 * 4 + t) * 128 + dv] + op[(1 * 4 + t) * 128 + dv]) + (op[(2 * 4 + t) * 128 + dv] + op[(3 * 4 + t) * 128 + dv]); }
    __syncthreads();
    { const int t = tid >> 7; float ss = 0.f;
      for (int k = 0; k < 128; ++k) { const float v = of[t * 128 + k]; ss += v * v; }
      const float rstd = 1.0f / sqrtf(ss * (1.0f / 128.0f) + EPS); const size_t tok = (size_t)TP + b * 4 + t;
      const float gv = bf2f(PROJ[tok * NPROJ + C_GG + hh * 128 + dv]);
      const float y = of[t * 128 + dv] * rstd * A.in[15][dv] * gv / (1.0f + __expf(-gv));
      ((bf16*)(A.ws + WS_MIX))[tok * 1024 + 512 + hh * 128 + dv] = (bf16)f2bf(y); }
}

#ifdef PROBE_PHASE
#define PREP(k) ((PROBE_PHASE) == (k) ? 2 : 1)
#else
#define PREP(k) 1
#endif
__device__ __forceinline__ void phase2(const Frame& F, const Args& A) {
    LAS unsigned char* sh = F.lds;
    _Pragma("unroll 1") for (int rep = 0; rep < PREP(21); ++rep) { const int gw = F.vcu * NWAVES + F.wave, NGW = F.G * NWAVES; constexpr int NJP = 4 * 2 * 2 * 9, NJS = 32 * 2 * 2 * 17;
      for (int job = gw; job < NJP + NJS; job += NGW) {
          if (job >= NJS) { const int j = job - NJS; const int grp = j % 9, g = (j / 9) & 1, slot = (j / 18) & 1, b = j / 36;
#ifndef SKIP_CMP
 cmp_job<false>(A, b, slot, g, grp, F.lane);
#endif
 }
          else { const int grp = job % 17, g = (job / 17) & 1, slot = (job / 34) & 1, b = job / 68;
#ifndef SKIP_CMP
 cmp_job<true>(A, b, slot, g, grp, F.lane);
#endif
 }
      } }
    #ifndef SKIP_GLAL
    _Pragma("unroll 1") for (int rep = 0; rep < PREP(22); ++rep) for (int u = F.vcu; u < 256; u += F.G) gla_local(F, A, sh, u);
#endif
    #ifndef SKIP_GLAS
    _Pragma("unroll 1") for (int rep = 0; rep < PREP(24); ++rep) for (int u = F.vcu; u < 128; u += F.G) gla_sample(F, A, sh, u);
#endif
    __syncthreads();
    attn_fill_lut((LAS float*)(sh + AT_LUT), A.in[24], F.tid);
    __syncthreads();
    _Pragma("unroll 1") for (int rep = 0; rep < PREP(23); ++rep) for (int p = F.vcu; p < 256; p += F.G) { const int bg = p >> 5, s = p & 31;
#ifndef SKIP_WIN
 win_unit(F, A, sh, bg >> 1, bg & 1, 63 - s); win_unit(F, A, sh, bg >> 1, bg & 1, s);
#endif
 }
}
__device__ __forceinline__ void phase3(const Frame& F, const Args& A) {
    LAS unsigned char* sh = F.lds;
    #ifndef SKIP_GLAO
    _Pragma("unroll 1") for (int rep = 0; rep < PREP(31); ++rep) for (int u = F.vcu; u < 256; u += F.G) gla_out(F, A, sh, u);
#endif
    __syncthreads();
    attn_fill_lut((LAS float*)(sh + AT_LUT), A.in[24], F.tid);
    __syncthreads();
    #ifndef SKIP_SAMP
    _Pragma("unroll 1") for (int rep = 0; rep < PREP(32); ++rep) for (int u = F.vcu; u < 64; u += F.G) samp_unit(F, A, sh, u >> 1, u & 1);
#endif
    _Pragma("unroll 1") for (int rep = 0; rep < PREP(33); ++rep) for (int p = F.vcu; p < 256; p += F.G) { const int bg = p >> 5, s = p & 31;
#ifndef SKIP_NSA
 nsa_unit(F, A, sh, bg >> 1, bg & 1, 63 - s); nsa_unit(F, A, sh, bg >> 1, bg & 1, s);
#endif
 }
}

typedef const __attribute__((address_space(4))) Args* ArgsP;
__device__ __forceinline__ Args load_args() {
    Args r{};
#if defined(__HIP_DEVICE_COMPILE__)
    ArgsP p = (ArgsP)__builtin_amdgcn_kernarg_segment_ptr(); asm volatile("" : "+s"(p));
#pragma unroll
    for (int i = 0; i < 26; ++i) r.in[i] = p->in[i];
    r.out = p->out; r.ws = p->ws; r.ph_lo = p->ph_lo; r.ph_hi = p->ph_hi;
#endif
    return r;
}
__global__ void __launch_bounds__(NWAVES * 64, 2) mega_fwd(Args args_unused) {
    extern __shared__ __attribute__((aligned(16))) unsigned char lds_raw[];
    Frame F;
    F.lds = (LAS unsigned char*)lds_raw;
    F.wave = __builtin_amdgcn_readfirstlane((int)threadIdx.x >> 6); F.lane = hw_lane(); F.tid = F.wave * 64 + F.lane;
    F.G = gridDim.x; { const int bx = blockIdx.x; F.vcu = (F.G % 8 == 0) ? (bx % 8) * (F.G / 8) + bx / 8 : bx; }
    int lo, hi; unsigned char* ws;
    { const Args a0 = load_args(); lo = a0.ph_lo; hi = a0.ph_hi; ws = a0.ws; }
    gu32* ctl = (gu32*)(ws + WS_CTL);
    volatile LAS unsigned* MISC = (volatile LAS unsigned*)(F.lds + MISC_OFF);
    for (int u = F.tid; u < (LDS_BYTES - RING_BYTES) / 4; u += NWAVES * 64) ((LAS unsigned*)(F.lds + RING_BYTES))[u] = 0u;
    __syncthreads();
    const bool multi = (hi - lo) > 1;
    XcdBarrier bar; bar.bar = (unsigned*)(ctl + CW_BAR); bar.x = 0; bar.st = nullptr;
    if (multi) bar = xcd_barrier_post((unsigned*)(ctl + CW_BAR), MISC + 8, F.tid);
#define IN(k) (lo <= (k) && (k) < hi)
#ifdef PROBE_PHASE
#define NREP(k) ((PROBE_PHASE) == (k) ? 2 : 1)
#else
#define NREP(k) 1
#endif
    float* dummy_rowss = (float*)(ws + WS_END);
#define SEAM(k) do { if (IN(k) && IN((k) + 1)) { F.lane = hw_lane(); F.tid = F.wave * 64 + F.lane; xcd_barrier(bar, F.tid); } } while (0)
#define REFRESH() do { F.lane = hw_lane(); F.tid = F.wave * 64 + F.lane; } while (0)

    if (IN(0)) { REFRESH(); const Args args = load_args(); _Pragma("unroll 1") for (int rep = 0; rep < NREP(0); ++rep) { __syncthreads(); p0_prologue(F, args); } } SEAM(0);
    if (IN(1)) { REFRESH(); const Args args = load_args(); unsigned char* ws = args.ws;
        pg8::Gemm g{(const pg8::bf16_t*)(ws + WS_XN), (const pg8::bf16_t*)(ws + WS_WIN), MPAD, NPROJ, 1024}; pg8::StaticOrder S; S.init(MPAD, NPROJ, F.G, (int)blockIdx.x);
        pg8::EpiInProj E{(pg8::bf16_t*)(ws + WS_PROJ), args.out};
        _Pragma("unroll 1") for (int rep = 0; rep < NREP(1); ++rep) pg8::gemm_phase<pg8::EpiInProj, pg8::StaticOrder, true, true>(F.lds, g, S, E, F.tid);
    } SEAM(1);
    if (IN(2)) { REFRESH(); const Args args = load_args(); phase2(F, args); } SEAM(2);
    if (IN(3)) { REFRESH(); const Args args = load_args(); phase3(F, args); } SEAM(3);
    if (IN(4)) { REFRESH(); const Args args = load_args(); unsigned char* ws = args.ws; float* rowss1 = (float*)(ws + WS_ROWSS);
        { pg8::Gemm g{(const pg8::bf16_t*)(ws + WS_MIX), (const pg8::bf16_t*)(ws + WS_WO), MPAD, 1024, 1024}; pg8::StaticOrder S; S.init(MPAD, 1024, F.G, (int)blockIdx.x);
          _Pragma("unroll 1") for (int rep = 0; rep < NREP(4); ++rep) { pg8::EpiResid E{args.in[0], args.in[1], (float*)(ws + WS_H1), (pg8::bf16_t*)(ws + WS_H1B), rep ? dummy_rowss : rowss1};
          pg8::gemm_phase<pg8::EpiResid, pg8::StaticOrder, true, true>(F.lds, g, S, E, F.tid); } }
        { pg8::Gemm g{(const pg8::bf16_t*)(ws + WS_PPLE), (const pg8::bf16_t*)(ws + WS_WPLE), MPAD, 1024, 256}; pg8::StaticOrder S; S.init(MPAD, 1024, F.G, (int)blockIdx.x);
          pg8::EpiBf E{(pg8::bf16_t*)(ws + WS_PLEB), 1024};
          _Pragma("unroll 1") for (int rep = 0; rep < NREP(41); ++rep) pg8::gemm_phase<pg8::EpiBf, pg8::StaticOrder, true, true>(F.lds, g, S, E, F.tid); }
    } SEAM(4);
    if (IN(5)) { REFRESH(); const Args args = load_args(); unsigned char* ws = args.ws; float* rowss1 = (float*)(ws + WS_ROWSS);
        pg8::Gemm g{(const pg8::bf16_t*)(ws + WS_H1B), (const pg8::bf16_t*)(ws + WS_WGU), MPAD, NGU, 1024}; pg8::StaticOrder S; S.init(MPAD, NGU, F.G, (int)blockIdx.x);
        pg8::EpiGateUp E{(pg8::bf16_t*)(ws + WS_ACT), rowss1};
        _Pragma("unroll 1") for (int rep = 0; rep < NREP(5); ++rep) pg8::gemm_phase<pg8::EpiGateUp, pg8::StaticOrder, true, true>(F.lds, g, S, E, F.tid);
    } SEAM(5);
    if (IN(6)) { REFRESH(); const Args args = load_args(); unsigned char* ws = args.ws; float* rowss2 = (float*)(ws + WS_ROWSS) + MPAD;
        pg8::Gemm g{(const pg8::bf16_t*)(ws + WS_ACT), (const pg8::bf16_t*)(ws + WS_WDN), MPAD, 1024, DFF}; pg8::StaticOrder S; S.init(MPAD, 1024, F.G, (int)blockIdx.x);
        _Pragma("unroll 1") for (int rep = 0; rep < NREP(6); ++rep) { pg8::EpiResid E{(const float*)(ws + WS_H1), (const float*)(ws + WS_H1) + (size_t)TP * 1024, (float*)(ws + WS_H2), (pg8::bf16_t*)(ws + WS_H2B), rep ? dummy_rowss : rowss2};
        pg8::gemm_phase<pg8::EpiResid, pg8::StaticOrder, true, true>(F.lds, g, S, E, F.tid); }
    } SEAM(6);
    if (IN(7)) { REFRESH(); const Args args = load_args(); unsigned char* ws = args.ws; float* rowss2 = (float*)(ws + WS_ROWSS) + MPAD; float* rowss3 = rowss2 + MPAD;
        pg8::Gemm g{(const pg8::bf16_t*)(ws + WS_H2B), (const pg8::bf16_t*)(ws + WS_WPG), MPAD, 1024, 1024}; pg8::StaticOrder S; S.init(MPAD, 1024, F.G, (int)blockIdx.x);
        _Pragma("unroll 1") for (int rep = 0; rep < NREP(7); ++rep) { pg8::EpiPleGate E{(const float*)(ws + WS_H2), (const pg8::bf16_t*)(ws + WS_PLEB), rowss2, args.out + O_Y, rep ? dummy_rowss : rowss3};
        pg8::gemm_phase<pg8::EpiPleGate, pg8::StaticOrder, true, true>(F.lds, g, S, E, F.tid); }
    } SEAM(7);
    if (IN(8)) { REFRESH(); const Args args = load_args(); unsigned char* ws = args.ws; float* rowss3 = (float*)(ws + WS_ROWSS) + 2 * MPAD;
        const int gw = F.vcu * NWAVES + F.wave, NGW = F.G * NWAVES; const GAS f32x4* gr = (const GAS f32x4*)args.in[25] + F.lane;
        for (int m = gw; m < MTOT; m += NGW) { GAS f32x4* yr = (GAS f32x4*)(args.out + O_Y + (size_t)m * 1024) + F.lane; const float rstd = 1.0f / sqrtf(rowss3[m] * (1.0f / 1024.0f) + EPS);
#pragma unroll
            for (int j = 0; j < 4; ++j) { const f32x4 v = yr[64 * j], gg = gr[64 * j]; yr[64 * j] = (f32x4){v.x * rstd * gg.x, v.y * rstd * gg.y, v.z * rstd * gg.z, v.w * rstd * gg.w}; } }
    }
#undef IN
#undef SEAM
#undef REFRESH
}

extern "C" void kernel_launch(void* const* d_in, const int* in_sizes, int n_in, void* d_out, int out_size, void* d_ws, size_t ws_size, hipStream_t stream) {
    static int grid = 0;
    if (grid == 0) {
        if (n_in != 26 || (size_t)out_size != O_END || ws_size < WS_END + (1u << 20)) { fprintf(stderr, "kernel_launch: unexpected shapes: n_in %d out %d ws %zu\n", n_in, out_size, ws_size); grid = -1; return; }
        int dev = 0, cus = 0, per_cu = 0;
        if (hipGetDevice(&dev) != hipSuccess || hipDeviceGetAttribute(&cus, hipDeviceAttributeMultiprocessorCount, dev) != hipSuccess) { grid = -1; return; }
        if (hipFuncSetAttribute((const void*)mega_fwd, hipFuncAttributeMaxDynamicSharedMemorySize, LDS_BYTES) != hipSuccess) { fprintf(stderr, "kernel_launch: hipFuncSetAttribute failed\n"); grid = -1; return; }
        if (hipOccupancyMaxActiveBlocksPerMultiprocessor(&per_cu, (const void*)mega_fwd, NWAVES * 64, LDS_BYTES) != hipSuccess || per_cu < 1) { fprintf(stderr, "kernel_launch: occupancy query says %d blocks per CU\n", per_cu); grid = -1; return; }
        (void)hipGetLastError();
        grid = cus;
    }
    if (grid < 0) return;
    (void)hipMemsetAsync((char*)d_ws + WS_CTL, 0, CTL_ZERO_BYTES, stream);
    Args a{};
    for (int i = 0; i < 26; ++i) a.in[i] = (const float*)d_in[i];
    a.out = (float*)d_out; a.ws = (unsigned char*)d_ws;
#ifndef N_LAUNCH_SPLIT
    a.ph_lo = 0; a.ph_hi = 9;
    hipLaunchKernelGGL(mega_fwd, dim3(grid), dim3(NWAVES * 64), LDS_BYTES, stream, a);
#else
    for (int p = 0; p < 9; ++p) { a.ph_lo = p; a.ph_hi = p + 1; hipLaunchKernelGGL(mega_fwd, dim3(grid), dim3(NWAVES * 64), LDS_BYTES, stream, a); }
#endif
}
```

```cpp
#include <hip/hip_runtime.h>
#include <cstdio>
#include <cstdint>

constexpr int DM = 1024, TP = 16384, TS = 128, MTOT = TP + TS, MPAD = 16640, SEQ = 4096, NBATCH = 4, DBATCH = 32, DSEQ = 4, PAST = 8192;
constexpr int NPROJ = 3072, DFF = 2816, DPLE = 256, NGU = 2 * DFF;
constexpr int C_QN = 0, C_KV = 512, C_WIN = 1024, C_GT = 1280, C_QG = 1304, C_KG = 1560, C_VG = 1816, C_LR = 2328, C_GG = 2344, NIN = 2856;
constexpr float EPS = 1e-6f;
constexpr size_t O_Y = 0, O_KV = (size_t)MTOT * 1024, O_WINP = O_KV + (size_t)MTOT * 512, O_WINS = O_WINP + 4 * 512 * 256,
                 O_GLAP = O_WINS + (size_t)32 * 512 * 256, O_GLAS = O_GLAP + 4 * 4 * 64 * 128, O_END = O_GLAS + (size_t)32 * 4 * 64 * 128;
namespace pg8 {
#define PG8_LAS __attribute__((address_space(3)))
typedef unsigned short bf16_t;
typedef short bf16x8 __attribute__((ext_vector_type(8)));
typedef float f32x4 __attribute__((ext_vector_type(4)));
typedef unsigned u32x4 __attribute__((ext_vector_type(4)));
constexpr int BM = 256, BK = 64, HALF = 128, HTB = HALF * BK * 2  , STAGE_BYTES = 8 * HTB, NXCD = 8, WGM = 8;

__host__ __device__ __forceinline__ int lds_byte(int r, int c) { const int st = (r >> 4) * 2 + (c >> 5), rr = r & 15, cc = c & 31, ob = rr * 64 + cc * 2; return st * 1024 + (ob ^ (((ob >> 9) & 1) << 5)); }
__host__ __device__ __forceinline__ void stage_rc(int b, int& R, int& C) { const int st = b / 1024, sb = b % 1024, swz = sb ^ (((sb >> 9) & 1) << 5); R = (st >> 1) * 16 + swz / 64; C = (st & 1) * 32 + (swz % 64) / 2; }
__host__ __device__ __forceinline__ int perm32(int rho) { const int n = rho >> 4, i = rho & 15; return 8 * (i >> 2) + 4 * n + (i & 3); }

struct Unit { int pm, pn; };
struct Gemm { const bf16_t* A; const bf16_t* Bt; int M, N, K; };

struct StaticOrder {
    int nM, nN, nwg, G, c;
    __host__ __device__ void init(int M, int N, int G_, int c_) { nM = M / BM; nN = N / BM; nwg = nM * nN; G = G_; c = c_; }
    __host__ __device__ bool next(int i, Unit& u) const {
        const long L = (long)i * G + c; if (L >= nwg) return false;
        int wgid = (int)L; { const int q = nwg / NXCD, r = nwg % NXCD, xcd = wgid % NXCD, off = wgid / NXCD; wgid = (xcd < r ? xcd * (q + 1) : r * (q + 1) + (xcd - r) * q) + off; }
        const int nig = WGM * nN, gid = wgid / nig, fm = gid * WGM, gsz = (nM - fm) < WGM ? (nM - fm) : WGM;
        u.pm = fm + ((wgid % nig) % gsz); u.pn = (wgid % nig) / gsz; return true;
    }
    __device__ __forceinline__ void a_ready(const Unit&) const {}
    __device__ __forceinline__ void done(const Unit&) const {}
};

__device__ __forceinline__ unsigned cvt_pk_bf16(float lo, float hi) { unsigned r; asm volatile("v_cvt_pk_bf16_f32 %0, %1, %2" : "=v"(r) : "v"(lo), "v"(hi)); return r; }

__device__ __forceinline__ u32x4 pack8(const f32x4 v0, const f32x4 v1) { u32x4 w; w.x = cvt_pk_bf16(v0[0], v0[1]); w.y = cvt_pk_bf16(v0[2], v0[3]); w.z = cvt_pk_bf16(v1[0], v1[1]); w.w = cvt_pk_bf16(v1[2], v1[3]); return w; }

struct EpiInProj {
    static constexpr bool PERM = true, AFTER_DRAIN = false;
    bf16_t* proj; float* out;
    __device__ __forceinline__ void operator()(const f32x4 (&acc)[2][2][4][2], const Unit& u, int wr, int wc, int fr, int fq) const {
        const int row0 = u.pm * BM + wr * 64 + fr, colb = u.pn * BM + wc * 32 + 8 * fq;
        const float sc = (u.pn < 2) ? 0.125f : 1.0f;
#pragma unroll
        for (int ai = 0; ai < 2; ++ai)
#pragma unroll
            for (int m = 0; m < 4; ++m) {
                const int r = row0 + ai * HALF + m * 16;
                if (r < MTOT) {
#pragma unroll
                    for (int bj = 0; bj < 2; ++bj) {
                        const int c = colb + bj * HALF;
                        const f32x4 v0 = acc[ai][bj][m][0] * sc, v1 = acc[ai][bj][m][1] * sc;
                        *(u32x4*)(proj + (size_t)r * NPROJ + c) = pack8(v0, v1);
                        if (u.pn == 2 || u.pn == 3) { float* o = out + O_KV + (size_t)r * 512 + (c - C_KV); *(f32x4*)o = v0; *(f32x4*)(o + 4) = v1; }
                        if (u.pn == 4) {
                            const int cc = c - C_WIN; float* o = nullptr;
                            if (r < TP) { const int pos = r & (SEQ - 1), b = r >> 12; if (pos >= SEQ - 512) o = out + O_WINP + ((size_t)(b * 512 + pos - (SEQ - 512)) * 256 + cc); }
                            else { const int rs = r - TP, b = rs >> 2, i = rs & 3; o = out + O_WINS + ((size_t)(b * 512 + 508 + i) * 256 + cc); }
                            if (o) { *(f32x4*)o = v0; *(f32x4*)(o + 4) = v1; }
                        }
                    }
                }
            }
    }
};
struct EpiResid {
    static constexpr bool PERM = true, AFTER_DRAIN = false;
    const float* baseA; const float* baseB;
    float* hout; bf16_t* hb; float* rowss;
    __device__ __forceinline__ void operator()(const f32x4 (&acc)[2][2][4][2], const Unit& u, int wr, int wc, int fr, int fq) const {
        const int row0 = u.pm * BM + wr * 64 + fr, colb = u.pn * BM + wc * 32 + 8 * fq;
#pragma unroll
        for (int ai = 0; ai < 2; ++ai)
#pragma unroll
            for (int m = 0; m < 4; ++m) {
                const int r = row0 + ai * HALF + m * 16;
                float ss = 0.f;
                if (r < MTOT) {
                    const float* bp = (r < TP) ? baseA + (size_t)r * 1024 : baseB + (size_t)(r - TP) * 1024;
#pragma unroll
                    for (int bj = 0; bj < 2; ++bj) {
                        const int c = colb + bj * HALF;
                        const f32x4 v0 = acc[ai][bj][m][0] + *(const f32x4*)(bp + c), v1 = acc[ai][bj][m][1] + *(const f32x4*)(bp + c + 4);
                        float* o = hout + (size_t)r * 1024 + c; *(f32x4*)o = v0; *(f32x4*)(o + 4) = v1;
                        *(u32x4*)(hb + (size_t)r * 1024 + c) = pack8(v0, v1);
                        ss += (v0[0] * v0[0] + v0[1] * v0[1]) + (v0[2] * v0[2] + v0[3] * v0[3]) + (v1[0] * v1[0] + v1[1] * v1[1]) + (v1[2] * v1[2] + v1[3] * v1[3]);
                    }
                }
                ss += __shfl_xor(ss, 16); ss += __shfl_xor(ss, 32);
                if (fq == 0 && r < MTOT) atomicAdd(rowss + r, ss);
            }
    }
};
struct EpiGateUp {
    static constexpr bool PERM = true, AFTER_DRAIN = false;
    bf16_t* act; const float* rowss;
    __device__ __forceinline__ void operator()(const f32x4 (&acc)[2][2][4][2], const Unit& u, int wr, int wc, int fr, int fq) const {
        const int row0 = u.pm * BM + wr * 64 + fr, colb = u.pn * HALF + wc * 32 + 8 * fq;
#pragma unroll
        for (int ai = 0; ai < 2; ++ai)
#pragma unroll
            for (int m = 0; m < 4; ++m) {
                const int r = row0 + ai * HALF + m * 16;
                if (r < MTOT) {
                    const float rstd = __builtin_amdgcn_rsqf(rowss[r] * (1.0f / 1024.0f) + EPS);
                    f32x4 o[2];
#pragma unroll
                    for (int n = 0; n < 2; ++n)
#pragma unroll
                        for (int e = 0; e < 4; ++e) { const float g = acc[ai][0][m][n][e] * rstd, up = acc[ai][1][m][n][e] * rstd; o[n][e] = g * up * __builtin_amdgcn_rcpf(1.0f + __expf(-g)); }
                    *(u32x4*)(act + (size_t)r * DFF + colb) = pack8(o[0], o[1]);
                }
            }
    }
};
struct EpiBf {
    static constexpr bool PERM = true, AFTER_DRAIN = false;
    bf16_t* O; int ldc;
    __device__ __forceinline__ void operator()(const f32x4 (&acc)[2][2][4][2], const Unit& u, int wr, int wc, int fr, int fq) const {
        const int row0 = u.pm * BM + wr * 64 + fr, colb = u.pn * BM + wc * 32 + 8 * fq;
#pragma unroll
        for (int ai = 0; ai < 2; ++ai)
#pragma unroll
            for (int m = 0; m < 4; ++m) {
                const int r = row0 + ai * HALF + m * 16;
                if (r < MTOT) {
#pragma unroll
                    for (int bj = 0; bj < 2; ++bj) *(u32x4*)(O + (size_t)r * ldc + colb + bj * HALF) = pack8(acc[ai][bj][m][0], acc[ai][bj][m][1]);
                }
            }
    }
};
struct EpiPleGate {
    static constexpr bool PERM = true, AFTER_DRAIN = false;
    const float* h2; const bf16_t* ple; const float* rowss2; float* y; float* rowss3;
    __device__ __forceinline__ void operator()(const f32x4 (&acc)[2][2][4][2], const Unit& u, int wr, int wc, int fr, int fq) const {
        const int row0 = u.pm * BM + wr * 64 + fr, colb = u.pn * BM + wc * 32 + 8 * fq;
#pragma unroll
        for (int ai = 0; ai < 2; ++ai)
#pragma unroll
            for (int m = 0; m < 4; ++m) {
                const int r = row0 + ai * HALF + m * 16;
                float ss = 0.f;
                if (r < MTOT) {
                    const float rstd = __builtin_amdgcn_rsqf(rowss2[r] * (1.0f / 1024.0f) + EPS);
#pragma unroll
                    for (int bj = 0; bj < 2; ++bj) {
                        const int c = colb + bj * HALF;
                        const u32x4 pw = *(const u32x4*)(ple + (size_t)r * 1024 + c);
                        const f32x4 b0 = *(const f32x4*)(h2 + (size_t)r * 1024 + c), b1 = *(const f32x4*)(h2 + (size_t)r * 1024 + c + 4);
                        float pv[8];
#pragma unroll
                        for (int e = 0; e < 4; ++e) { pv[2 * e] = __uint_as_float(pw[e] << 16); pv[2 * e + 1] = __uint_as_float(pw[e] & 0xffff0000u); }
                        f32x4 v0, v1;
#pragma unroll
                        for (int e = 0; e < 4; ++e) {
                            v0[e] = b0[e] + pv[e] * __builtin_amdgcn_rcpf(1.0f + __expf(-acc[ai][bj][m][0][e] * rstd));
                            v1[e] = b1[e] + pv[4 + e] * __builtin_amdgcn_rcpf(1.0f + __expf(-acc[ai][bj][m][1][e] * rstd));
                        }
                        float* o = y + (size_t)r * 1024 + c; *(f32x4*)o = v0; *(f32x4*)(o + 4) = v1;
                        ss += (v0[0] * v0[0] + v0[1] * v0[1]) + (v0[2] * v0[2] + v0[3] * v0[3]) + (v1[0] * v1[0] + v1[1] * v1[1]) + (v1[2] * v1[2] + v1[3] * v1[3]);
                    }
                }
                ss += __shfl_xor(ss, 16); ss += __shfl_xor(ss, 32);
                if (fq == 0 && r < MTOT) atomicAdd(rowss3 + r, ss);
            }
    }
};
template <class Epi, class Sched, bool ALIGN_EPI = false, bool SP2 = false>
__device__ __forceinline__ void gemm_phase(PG8_LAS unsigned char* lds, const Gemm g, const Sched& S, const Epi& E, const int tid) {
    const int wid = __builtin_amdgcn_readfirstlane(tid >> 6), lane = tid & 63, wr = wid >> 2, wc = wid & 3, fr = lane & 15, fq = lane >> 4;
    const int K = g.K, nt = K / BK;
    unsigned voffA[2], voffB[2];
#pragma unroll
    for (int i = 0; i < 2; ++i) { int R, C; stage_rc(tid * 16 + i * 8192, R, C); const int Rb = Epi::PERM ? ((R & ~31) + perm32(R & 31)) : R;
        voffA[i] = (unsigned)(R * K + C) * 2u; voffB[i] = (unsigned)(Rb * K + C) * 2u; }
    const size_t kstep = (size_t)(BK * 2);
    const size_t hstep = (size_t)HALF * K * 2;
    const size_t tstep = 2 * hstep;
    const unsigned ldsw = (unsigned)wid * 1024u;
    const int aoff = lds_byte(wr * 64 + fr, fq * 8), boff = lds_byte(wc * 32 + fr, fq * 8);
#define PG8_SA(b, h) (((b) * 2 + (h)) * HTB)
#define PG8_SB(b, h) ((4 + (b) * 2 + (h)) * HTB)
#define PG8_STAGE(bufoff, gbase, voff) do { _Pragma("unroll") for (int _i = 0; _i < 2; ++_i) \
        __builtin_amdgcn_global_load_lds((const unsigned*)((const char*)(gbase) + (voff)[_i]), (PG8_LAS unsigned*)(lds + (bufoff) + ldsw + _i * 8192), 16, 0, 0); } while (0)
#define PG8_LDA(dst, b, h) do { _Pragma("unroll") for (int m = 0; m < 4; ++m) _Pragma("unroll") for (int k = 0; k < 2; ++k) dst[m][k] = *(const PG8_LAS bf16x8*)(lds + PG8_SA(b, h) + aoff + m * 2048 + k * 1024); } while (0)
#define PG8_LDB(dst, b, h) do { _Pragma("unroll") for (int n = 0; n < 2; ++n) _Pragma("unroll") for (int k = 0; k < 2; ++k) dst[n][k] = *(const PG8_LAS bf16x8*)(lds + PG8_SB(b, h) + boff + n * 2048 + k * 1024); } while (0)
#define PG8_MMA(ai, bj, At, Bt) do { __builtin_amdgcn_s_setprio(1); _Pragma("unroll") for (int m = 0; m < 4; ++m) _Pragma("unroll") for (int n = 0; n < 2; ++n) _Pragma("unroll") for (int k = 0; k < 2; ++k) \
        acc[ai][bj][m][n] = __builtin_amdgcn_mfma_f32_16x16x32_bf16(Bt[n][k], At[m][k], acc[ai][bj][m][n], 0, 0, 0); __builtin_amdgcn_s_setprio(0); } while (0)
#define PG8_WAIT_V(n) asm volatile("s_waitcnt vmcnt(" #n ")" ::: "memory")
#define PG8_WAIT_L(n) asm volatile("s_waitcnt lgkmcnt(" #n ")" ::: "memory")
#define PG8_BAR __builtin_amdgcn_s_barrier()
#define PG8_SCHED __builtin_amdgcn_sched_barrier(0)
    Unit cur, nxt; int ui = 0;
    if (!S.next(0, cur)) return;
    f32x4 acc[2][2][4][2];
#pragma unroll
    for (int a = 0; a < 2; ++a)
#pragma unroll
        for (int b = 0; b < 2; ++b)
#pragma unroll
            for (int m = 0; m < 4; ++m)
#pragma unroll
                for (int n = 0; n < 2; ++n) acc[a][b][m][n] = (f32x4){0.f, 0.f, 0.f, 0.f};
    bf16x8 At[4][2], B0[2][2], B1[2][2];
    const char* cA = (const char*)g.A + (size_t)cur.pm * tstep; const char* cB = (const char*)g.Bt + (size_t)cur.pn * tstep;
    S.a_ready(cur);
    if constexpr (SP2) {
        PG8_STAGE(PG8_SB(0, 0), cB, voffB); PG8_STAGE(PG8_SB(0, 1), cB + hstep, voffB); PG8_STAGE(PG8_SA(0, 0), cA, voffA); PG8_STAGE(PG8_SA(0, 1), cA + hstep, voffA);
        if (wr == 1) PG8_BAR;
        PG8_WAIT_V(2); PG8_BAR;
        PG8_STAGE(PG8_SB(1, 0), cB + kstep, voffB); PG8_STAGE(PG8_SA(1, 0), cA + kstep, voffA); PG8_STAGE(PG8_SB(1, 1), cB + hstep + kstep, voffB);
        PG8_WAIT_V(6); PG8_BAR;
    } else {
        PG8_STAGE(PG8_SB(0, 0), cB, voffB); PG8_STAGE(PG8_SA(0, 0), cA, voffA); PG8_STAGE(PG8_SB(0, 1), cB + hstep, voffB); PG8_STAGE(PG8_SA(0, 1), cA + hstep, voffA);
        if (wr == 1) PG8_BAR;
        PG8_WAIT_V(4); PG8_BAR;
        PG8_STAGE(PG8_SB(1, 0), cB + kstep, voffB); PG8_STAGE(PG8_SA(1, 0), cA + kstep, voffA); PG8_STAGE(PG8_SB(1, 1), cB + hstep + kstep, voffB);
        PG8_WAIT_V(6); PG8_BAR;
    }
    for (;;) {
        const bool has_next = S.next(ui + 1, nxt);
        const char* nA = has_next ? (const char*)g.A + (size_t)nxt.pm * tstep : cA; const char* nB = has_next ? (const char*)g.Bt + (size_t)nxt.pn * tstep : cB;
        for (int t = 0; t < nt; t += 2) {
            const bool last = (t == nt - 2);
            const char* a1 = cA + (size_t)(t + 1) * kstep;
            const char* a2 = last ? nA : cA + (size_t)(t + 2) * kstep; const char* b2 = last ? nB : cB + (size_t)(t + 2) * kstep;
            const char* a3 = a2 + kstep; const char* b3 = b2 + kstep;
            if (last && has_next) S.a_ready(nxt);
            if constexpr (SP2) {
            PG8_LDB(B0, 0, 0); PG8_LDB(B1, 0, 1); PG8_SCHED; PG8_LDA(At, 0, 0); PG8_STAGE(PG8_SA(1, 1), a1 + hstep, voffA);
            PG8_WAIT_V(8); PG8_WAIT_L(0); PG8_BAR; PG8_MMA(0, 0, At, B0); PG8_MMA(0, 1, At, B1); PG8_BAR; PG8_SCHED;
            PG8_LDA(At, 0, 1); PG8_STAGE(PG8_SB(0, 0), b2, voffB); PG8_STAGE(PG8_SB(0, 1), b2 + hstep, voffB); PG8_STAGE(PG8_SA(0, 0), a2, voffA);
            PG8_WAIT_V(8); PG8_WAIT_L(0); PG8_BAR; PG8_MMA(1, 0, At, B0); PG8_MMA(1, 1, At, B1); PG8_BAR; PG8_SCHED;
            PG8_LDB(B0, 1, 0); PG8_LDB(B1, 1, 1); PG8_SCHED; PG8_LDA(At, 1, 0); PG8_STAGE(PG8_SA(0, 1), a2 + hstep, voffA);
            PG8_WAIT_V(8); PG8_WAIT_L(0); PG8_BAR; PG8_MMA(0, 0, At, B0); PG8_MMA(0, 1, At, B1); PG8_BAR; PG8_SCHED;
            PG8_LDA(At, 1, 1); PG8_STAGE(PG8_SB(1, 0), b3, voffB); PG8_STAGE(PG8_SB(1, 1), b3 + hstep, voffB); PG8_STAGE(PG8_SA(1, 0), a3, voffA);
            PG8_WAIT_V(8); PG8_WAIT_L(0); PG8_BAR; PG8_MMA(1, 0, At, B0); PG8_MMA(1, 1, At, B1); PG8_BAR; PG8_SCHED;
            } else {
            PG8_LDB(B0, 0, 0); PG8_SCHED; PG8_LDA(At, 0, 0); PG8_STAGE(PG8_SA(1, 1), a1 + hstep, voffA);
            PG8_WAIT_L(8); PG8_BAR; PG8_WAIT_L(0); PG8_MMA(0, 0, At, B0); PG8_BAR; PG8_SCHED;
            PG8_LDB(B1, 0, 1); PG8_STAGE(PG8_SB(0, 0), b2, voffB);
            PG8_BAR; PG8_WAIT_L(0); PG8_MMA(0, 1, At, B1); PG8_BAR;
            PG8_LDA(At, 0, 1); PG8_STAGE(PG8_SA(0, 0), a2, voffA);
            PG8_BAR; PG8_WAIT_L(0); PG8_MMA(1, 0, At, B0); PG8_BAR; PG8_SCHED;
            PG8_STAGE(PG8_SB(0, 1), b2 + hstep, voffB);
            PG8_WAIT_V(6); PG8_BAR; PG8_MMA(1, 1, At, B1); PG8_BAR;
            PG8_LDB(B0, 1, 0); PG8_SCHED; PG8_LDA(At, 1, 0); PG8_STAGE(PG8_SA(0, 1), a2 + hstep, voffA);
            PG8_WAIT_L(8); PG8_BAR; PG8_WAIT_L(0); PG8_MMA(0, 0, At, B0); PG8_BAR; PG8_SCHED;
            PG8_LDB(B1, 1, 1); PG8_STAGE(PG8_SB(1, 0), b3, voffB);
            PG8_BAR; PG8_WAIT_L(0); PG8_MMA(0, 1, At, B1); PG8_BAR;
            PG8_LDA(At, 1, 1); PG8_STAGE(PG8_SA(1, 0), a3, voffA);
            PG8_BAR; PG8_WAIT_L(0); PG8_MMA(1, 0, At, B0); PG8_BAR; PG8_SCHED;
            PG8_STAGE(PG8_SB(1, 1), b3 + hstep, voffB);
            PG8_WAIT_V(6); PG8_BAR; PG8_MMA(1, 1, At, B1); PG8_BAR;
            }
        }
        if constexpr (ALIGN_EPI) { if (wr == 0) PG8_BAR; }
        if constexpr (!Epi::AFTER_DRAIN) { E(acc, cur, wr, wc, fr, fq); S.done(cur); }
        if (!has_next) break;
#pragma unroll
        for (int a = 0; a < 2; ++a)
#pragma unroll
            for (int b = 0; b < 2; ++b)
#pragma unroll
                for (int m = 0; m < 4; ++m)
#pragma unroll
                    for (int n = 0; n < 2; ++n) acc[a][b][m][n] = (f32x4){0.f, 0.f, 0.f, 0.f};
        cur = nxt; cA = nA; cB = nB; ++ui;
        if constexpr (ALIGN_EPI) { if (wr == 1) PG8_BAR; }
    }
    PG8_WAIT_V(0);
    if constexpr (!ALIGN_EPI) { if (wr == 0) PG8_BAR; }
    PG8_BAR;
    if constexpr (Epi::AFTER_DRAIN) { E.fused(acc, cur, wr, wc, fr, fq, lds, wid, lane); S.done(cur); }
#undef PG8_SA
#undef PG8_SB
#undef PG8_STAGE
#undef PG8_LDA
#undef PG8_LDB
#undef PG8_MMA
#undef PG8_WAIT_V
#undef PG8_WAIT_L
#undef PG8_BAR
#undef PG8_SCHED
}
}


#define GAS __attribute__((address_space(1)))
#define LAS __attribute__((address_space(3)))
typedef unsigned short bf16;
typedef unsigned v4u __attribute__((ext_vector_type(4)));
typedef unsigned v2u __attribute__((ext_vector_type(2)));
typedef float f32x4 __attribute__((ext_vector_type(4)));
typedef float f32x2 __attribute__((ext_vector_type(2)));
typedef float f32x16 __attribute__((ext_vector_type(16)));
typedef short bf16x8 __attribute__((ext_vector_type(8)));
typedef short s16x4 __attribute__((ext_vector_type(4)));
typedef GAS unsigned gu32;
#define RLX_AGENT __ATOMIC_RELAXED, __HIP_MEMORY_SCOPE_AGENT
#define LDS_WAIT() asm volatile("s_waitcnt lgkmcnt(0)" ::: "memory")
#define VM_WAIT() asm volatile("s_waitcnt vmcnt(0)" ::: "memory")
__device__ __forceinline__ unsigned f2bf(float f) { unsigned u = __builtin_bit_cast(unsigned, f); return (u + 0x7fffu + ((u >> 16) & 1u)) >> 16; }
__device__ __forceinline__ unsigned pk2(float lo, float hi) { return f2bf(lo) | (f2bf(hi) << 16); }
__device__ __forceinline__ float bf2f(unsigned short h) { return __uint_as_float(((unsigned)h) << 16); }
__device__ __forceinline__ float bflo(unsigned w) { return __uint_as_float(w << 16); }
__device__ __forceinline__ float bfhi(unsigned w) { return __uint_as_float(w & 0xffff0000u); }

constexpr int NWAVES = 8;
constexpr size_t MiB = 1u << 20;
constexpr size_t WS_CTL = 0, CTL_ZERO_BYTES = 1 * MiB;
constexpr int CW_BAR = 4096;
constexpr size_t WS_ROWSS = 256 * 1024;
constexpr size_t WS_WIN = 2 * MiB;
constexpr size_t WS_WO = 8 * MiB;
constexpr size_t WS_WGU = 10 * MiB;
constexpr size_t WS_WDN = 21 * MiB;
constexpr size_t WS_WPG = 27 * MiB;
constexpr size_t WS_WPLE = 29 * MiB;
constexpr size_t WS_WC1 = 30 * MiB;
constexpr size_t WS_WC2 = 31 * MiB;
constexpr size_t WS_C1 = 31 * MiB + 65536;
constexpr size_t WS_KCP = 32 * MiB;
constexpr size_t WS_VCP = 33 * MiB;
constexpr size_t WS_KCS = 34 * MiB;
constexpr size_t WS_VCS = 38 * MiB;
constexpr size_t WS_DSC = 42 * MiB;
constexpr size_t WS_USC = 43 * MiB;
constexpr size_t WS_QB = 51 * MiB;
constexpr size_t WS_XN = 64 * MiB;
constexpr size_t WS_PPLE = 97 * MiB;
constexpr size_t WS_PROJ = 106 * MiB;
constexpr size_t WS_OWIN = 204 * MiB;
constexpr size_t WS_MIX = 221 * MiB;
constexpr size_t WS_OLOC = 254 * MiB;
constexpr size_t WS_H1 = 287 * MiB;
constexpr size_t WS_H1B = 353 * MiB;
constexpr size_t WS_ACT = 386 * MiB;
constexpr size_t WS_H2 = 476 * MiB;
constexpr size_t WS_H2B = 542 * MiB;
constexpr size_t WS_PLEB = 575 * MiB;
constexpr size_t WS_END = 608 * MiB;
constexpr int RING_BYTES = 131072;
constexpr int MISC_OFF = RING_BYTES + 320;
constexpr int LDS_BYTES = 163840;
#define XB_TMO      128
#define XB_XCNT(j)  (256  + 64 * (j))
#define XB_XSUB(j)  (1280 + 64 * (j))
#define XB_XGEN(j)  (2304 + 64 * (j))
#define XB_TOP      3328
#define XB_TOPGEN   3392
#define XCD_BAR_WORDS 3456
#define XB_SPIN_CAP (1u << 18)

__device__ __forceinline__ unsigned xb_ld(unsigned* p)              { return __hip_atomic_load(p, __ATOMIC_RELAXED, __HIP_MEMORY_SCOPE_AGENT); }
__device__ __forceinline__ unsigned xb_add(unsigned* p, unsigned v) { return __hip_atomic_fetch_add(p, v, __ATOMIC_RELAXED, __HIP_MEMORY_SCOPE_AGENT); }
__device__ __forceinline__ unsigned xb_xcc_id() { return (unsigned)__builtin_amdgcn_s_getreg((3 << 11) | 20) & 0xFu; }
#define XB_SPIN(cond, bar) do { unsigned _sp = 0; while (cond) { __builtin_amdgcn_s_sleep(1); \
    if ((++_sp & 255u) == 0u) { if (xb_ld(&(bar)[XB_TMO])) break; if (_sp > XB_SPIN_CAP) { atomicAdd(&(bar)[XB_TMO], 1u); break; } } } } while (0)

struct XcdBarrier {
    unsigned* bar; unsigned x;
    volatile LAS unsigned* st;
};

__device__ __forceinline__ XcdBarrier xcd_barrier_post(unsigned* bar, volatile LAS unsigned* st, const int tid) {
    XcdBarrier b; b.bar = bar; b.x = xb_xcc_id(); b.st = st;
    if (tid == 0) (void)xb_add(&bar[XB_XCNT(b.x)], 1u);
    return b;
}
__device__ __forceinline__ void xcd_barrier_complete(unsigned* bar, unsigned x, unsigned& nloc, unsigned& nx) {
    const unsigned G = gridDim.x * gridDim.y * gridDim.z;
    unsigned sum, cnt, mine, sp = 0u;
    for (;;) {
        sum = 0u; cnt = 0u; mine = 0u;
#pragma unroll
        for (unsigned j = 0; j < 16; ++j) { const unsigned c = xb_ld(&bar[XB_XCNT(j)]); sum += c; cnt += (c > 0u) ? 1u : 0u; mine = (j == x) ? c : mine; }
        if (sum == G) break;
        __builtin_amdgcn_s_sleep(1);
        if ((++sp & 255u) == 0u) { if (xb_ld(&bar[XB_TMO])) break; if (sp > XB_SPIN_CAP) { atomicAdd(&bar[XB_TMO], 1u); break; } }
    }
    nloc = mine > 0u ? mine : 1u; nx = cnt > 0u ? cnt : 1u;
}

__device__ __forceinline__ void xcd_barrier(const XcdBarrier& b, const int tid) {
    asm volatile("s_waitcnt vmcnt(0)" ::: "memory");
    __syncthreads();
    if (tid == 0) {
        unsigned* bar = b.bar;
        __builtin_amdgcn_s_waitcnt(0);
        unsigned nloc = b.st[0], nx = b.st[1];
        if (nloc == 0u) { xcd_barrier_complete(bar, b.x, nloc, nx); b.st[0] = nloc; b.st[1] = nx; }
        const unsigned old = xb_add(&bar[XB_XSUB(b.x)], 1u);
        const unsigned gen = old / nloc;
        if (old + 1u == (gen + 1u) * nloc) {
            __builtin_amdgcn_fence(__ATOMIC_RELEASE, "agent");
            asm volatile("s_waitcnt vmcnt(0)" ::: "memory");
            const unsigned og = xb_add(&bar[XB_TOP], 1u);
            const unsigned tg = og / nx;
            if (og + 1u == (tg + 1u) * nx) xb_add(&bar[XB_TOPGEN], 1u);
            else XB_SPIN(xb_ld(&bar[XB_TOPGEN]) == tg, bar);
            __builtin_amdgcn_fence(__ATOMIC_ACQUIRE, "agent");
            xb_add(&bar[XB_XGEN(b.x)], 1u);
            asm volatile("s_waitcnt vmcnt(0)" ::: "memory");
        } else {
            XB_SPIN(xb_ld(&bar[XB_XGEN(b.x)]) == gen, bar);
            __builtin_amdgcn_fence(__ATOMIC_ACQUIRE, "agent");
            asm volatile("s_waitcnt vmcnt(0)" ::: "memory");
        }
    }
    __syncthreads();
}

struct Args { const float* in[26]; float* out; unsigned char* ws; int ph_lo, ph_hi; };
struct Frame {
    LAS unsigned char* lds;
    int tid, lane, wave, vcu, G;
};
__device__ __forceinline__ int hw_lane() { int l; asm volatile("v_mbcnt_lo_u32_b32 %0, -1, 0\n\tv_mbcnt_hi_u32_b32 %0, -1, %0" : "=v"(l)); return l; }
__device__ __forceinline__ int opaque(int x) { asm volatile("" : "+v"(x)); return x; }
__device__ __forceinline__ float wave_sum(float v) {
#pragma unroll
    for (int o = 1; o < 64; o <<= 1) v += __shfl_xor(v, o);
    return v;
}
__device__ __forceinline__ void p0_tr_item(const float* W, int ldw, int K, int nsrc, int nblk, bf16* WT, int mode, const float* kscale, LAS float* scr, int item, int lane) {
    const int kb = item / nblk, nb = item % nblk, k0 = 64 * kb, n0 = 32 * nb;
    const int nn = n0 + (lane & 31);
#pragma unroll 8
    for (int i = 0; i < 32; ++i) { const int kk = 2 * i + (lane >> 5); float v = 0.f; if (nn < nsrc) { v = W[(size_t)(k0 + kk) * ldw + nn]; if (kscale) v *= kscale[k0 + kk]; } scr[kk * 33 + (lane & 31)] = v; }
    LDS_WAIT(); asm volatile("" ::: "memory");
    const int c = lane & 7;
#pragma unroll
    for (int j = 0; j < 4; ++j) { const int n = (lane >> 3) + 8 * j; const LAS float* s = scr + (8 * c) * 33 + n;
        v4u o; o.x = pk2(s[0 * 33], s[1 * 33]); o.y = pk2(s[2 * 33], s[3 * 33]); o.z = pk2(s[4 * 33], s[5 * 33]); o.w = pk2(s[6 * 33], s[7 * 33]);
        const int ng = n0 + n; const int drow = (mode == 0) ? ng : (256 * (ng >> 7) + (ng & 127) + (mode == 2 ? 128 : 0));
        *(GAS v4u*)(WT + (size_t)drow * K + k0 + 8 * c) = o; }
    LDS_WAIT(); asm volatile("" ::: "memory");
}
__device__ __forceinline__ void rms_row_to_bf16(const float* xrow, const float* g, bf16* orow, int lane) {
    const GAS f32x4* xr = (const GAS f32x4*)xrow + lane; const GAS f32x4* gr = (const GAS f32x4*)g + lane;
    f32x4 v[4]; float s = 0.f;
#pragma unroll
    for (int j = 0; j < 4; ++j) { v[j] = xr[64 * j]; s += (v[j].x * v[j].x + v[j].y * v[j].y) + (v[j].z * v[j].z + v[j].w * v[j].w); }
    const float rstd = 1.0f / sqrtf(wave_sum(s) * (1.f / DM) + EPS);
    GAS unsigned long long* o8 = (GAS unsigned long long*)orow + lane;
#pragma unroll
    for (int j = 0; j < 4; ++j) { const f32x4 gg = gr[64 * j];
        o8[64 * j] = (unsigned long long)pk2(v[j].x * rstd * gg.x, v[j].y * rstd * gg.y) | ((unsigned long long)pk2(v[j].z * rstd * gg.z, v[j].w * rstd * gg.w) << 32); }
}
__device__ __forceinline__ void p0_prologue(const Frame& F, const Args& A) {
    unsigned char* ws = A.ws;
    LAS float* scr = (LAS float*)(F.lds + F.wave * 16384);
    const int gw = F.vcu * NWAVES + F.wave, NGW = F.G * NWAVES, lane = F.lane;
    constexpr int I_IN = 16 * 96, I_O = 16 * 32, I_G = 16 * 88, I_D = 44 * 32, I_PG = 16 * 32, I_PL = 4 * 32, I_C1 = 2 * 32 * 2, I_C2 = 2 * 1 * 2;
    constexpr int NITEMS = I_IN + I_O + 2 * I_G + I_D + I_PG + I_PL + I_C1 + I_C2;
    for (int it = gw; it < NITEMS; it += NGW) {
        int r = it;
        if (r < I_IN) { p0_tr_item(A.in[9], NIN, 1024, NIN, 96, (bf16*)(ws + WS_WIN), 0, nullptr, scr, r, lane); continue; } r -= I_IN;
        if (r < I_O) { p0_tr_item(A.in[16], 1024, 1024, 1024, 32, (bf16*)(ws + WS_WO), 0, nullptr, scr, r, lane); continue; } r -= I_O;
        if (r < I_G) { p0_tr_item(A.in[18], DFF, 1024, DFF, 88, (bf16*)(ws + WS_WGU), 1, A.in[17], scr, r, lane); continue; } r -= I_G;
        if (r < I_G) { p0_tr_item(A.in[19], DFF, 1024, DFF, 88, (bf16*)(ws + WS_WGU), 2, A.in[17], scr, r, lane); continue; } r -= I_G;
        if (r < I_D) { p0_tr_item(A.in[20], 1024, DFF, 1024, 32, (bf16*)(ws + WS_WDN), 0, nullptr, scr, r, lane); continue; } r -= I_D;
        if (r < I_PG) { p0_tr_item(A.in[23], 1024, 1024, 1024, 32, (bf16*)(ws + WS_WPG), 0, A.in[22], scr, r, lane); continue; } r -= I_PG;
        if (r < I_PL) { p0_tr_item(A.in[21], 1024, 256, 1024, 32, (bf16*)(ws + WS_WPLE), 0, nullptr, scr, r, lane); continue; } r -= I_PL;
        if (r < I_C1) { const int slot = r / 64; p0_tr_item(A.in[11] + (size_t)slot * 2048 * 64, 64, 2048, 64, 2, (bf16*)(ws + WS_WC1) + (size_t)slot * 64 * 2048, 0, nullptr, scr, r % 64, lane); continue; } r -= I_C1;
        { const int slot = r / 2; p0_tr_item(A.in[12] + (size_t)slot * 64 * 64, 64, 64, 64, 2, (bf16*)(ws + WS_WC2) + (size_t)slot * 64 * 64, 0, nullptr, scr, r % 2, lane); }
    }
    if (F.vcu < 2) { const int slot = F.vcu; const float* pe = A.in[10] + slot * 2048 + F.wave * 256; const float* w1 = A.in[11] + (size_t)slot * 2048 * 64 + (size_t)F.wave * 256 * 64; float a = 0.f;
#pragma unroll 16
        for (int k = 0; k < 256; ++k) a += pe[k] * w1[k * 64 + lane];
        ((LAS float*)(F.lds + F.wave * 16384 + 12288))[lane] = a; __syncthreads();
        if (F.wave == 0) { float t = 0.f;
#pragma unroll
            for (int w = 0; w < 8; ++w) t += ((LAS float*)(F.lds + w * 16384 + 12288))[lane];
            ((float*)(ws + WS_C1))[slot * 64 + lane] = t; }
    }
    bf16* XN = (bf16*)(ws + WS_XN);
    for (int m = gw; m < MPAD; m += NGW) {
        if (m < MTOT) { const float* xr = (m < TP) ? A.in[0] + (size_t)m * DM : A.in[1] + (size_t)(m - TP) * DM; rms_row_to_bf16(xr, A.in[8], XN + (size_t)m * DM, lane); }
        else { GAS v4u* o = (GAS v4u*)(XN + (size_t)m * DM) + lane; o[0] = (v4u){0, 0, 0, 0}; o[64] = (v4u){0, 0, 0, 0}; }
    }
    bf16* PP = (bf16*)(ws + WS_PPLE);
    for (int m = gw; m < MPAD; m += NGW) {
        v2u o = (v2u){0, 0};
        if (m < MTOT) { const float* pr = (m < TP) ? A.in[6] + (size_t)m * DPLE : A.in[7] + (size_t)(m - TP) * DPLE; const f32x4 v = ((const GAS f32x4*)pr)[lane]; o.x = pk2(v.x, v.y); o.y = pk2(v.z, v.w); }
        ((GAS v2u*)(PP + (size_t)m * DPLE))[lane] = o;
        if (m >= MTOT) { GAS v4u* z = (GAS v4u*)((bf16*)(ws + WS_MIX) + (size_t)m * DM) + lane; z[0] = (v4u){0, 0, 0, 0}; z[64] = (v4u){0, 0, 0, 0}; }
    }
    for (int it = gw; it < DBATCH * 508; it += NGW) { const int b = it / 508, r = it % 508;
        ((GAS f32x4*)(A.out + O_WINS + (size_t)(b * 512 + r) * 256))[lane] = ((const GAS f32x4*)(A.in[3] + (size_t)(b * 512 + r + 4) * 256))[lane]; }
}

constexpr float LOG2E = 1.4426950408889634f;
typedef short v4i16_t __attribute__((ext_vector_type(4)));
__device__ __forceinline__ s16x4 vtr(LAS const unsigned char* p) { return __builtin_bit_cast(s16x4, __builtin_amdgcn_ds_read_tr16_b64_v4i16((LAS v4i16_t*)p)); }
__device__ __forceinline__ unsigned cvtpk(float lo, float hi) { typedef float f2 __attribute__((ext_vector_type(2))); typedef __bf16 b2 __attribute__((ext_vector_type(2))); f2 v = {lo, hi}; b2 b = __builtin_convertvector(v, b2); return __builtin_bit_cast(unsigned, b); }
__device__ __forceinline__ int t5_bucket(int n) {
    if (n < 16) return n;
    const int large = 16 + (int)(logf((float)n / 16.0f) / 2.0794415416798357f * 16.0f);
    return large < 31 ? large : 31;
}
constexpr int HI_BASE = 131072 + 512, AT_LUT = HI_BASE, HI_IMPA = AT_LUT + 4096, HI_IMPB = HI_IMPA + 2176, HI_SEL = HI_IMPB + 2176, HI_SCS = HI_SEL + 128, HI_TL = HI_SCS + 512, HI_XCH = HI_TL + 512, HI_END = HI_XCH + 8192;
constexpr int AT_K0 = 0, AT_V0 = 16384, AT_IMPA = 36864, AT_IMPB = AT_IMPA + 64 * 65 * 4 + 64, AT_SEL = AT_IMPB + 64 * 65 * 4 + 64, AT_MISC = AT_SEL + 1024, AT_QF = ((AT_MISC + 4096 + 1023) / 1024) * 1024, AT_END = AT_QF + 32768;
struct AttnLane {
    int koff;
    int kx;
    int voff0, voff1;
    int r32, h;
};
__device__ __forceinline__ AttnLane attn_lane(int lane) {
    AttnLane L; L.r32 = lane & 31; L.h = lane >> 5; L.koff = L.r32 * 128; L.kx = (L.r32 >> 1) & 7;
    const int i16 = lane & 15, q = i16 >> 2, p = i16 & 3, g1 = (lane >> 4) & 1;
    const int base = (4 * L.h + q) * 128 + g1 * 32 + (p >> 1) * 16 + (p & 1) * 8;
    L.voff0 = base + ((q >> 1) * 64); L.voff1 = base + (((q >> 1) ^ 1) * 64);
    return L;
}
__device__ __forceinline__ void attn_fill_lut(LAS float* lut, const float* rel_bias, int tid) {
    for (int e = tid; e < 1024; e += NWAVES * 64) { const int dist = e >> 3, hd = e & 7; lut[e] = rel_bias[t5_bucket(dist) * 8 + hd] * LOG2E; }
}
__device__ __forceinline__ void attn_commit(LAS unsigned char* kb, LAS unsigned char* vb, int tid, v4u k, v4u v) {
    const int row = tid >> 3, ch = tid & 7;
    *(LAS v4u*)(kb + row * 128 + ((ch ^ ((row >> 1) & 7)) << 4)) = k;
    *(LAS v4u*)(vb + row * 128 + ((ch ^ (((row >> 1) & 1) << 2)) << 4)) = v;
}
__device__ __forceinline__ f32x16 attn_qk(LAS const unsigned char* kb, int hf, const AttnLane& L, const bf16x8 (&qf)[4]) {
    f32x16 s = {};
#pragma unroll
    for (int ks = 0; ks < 4; ++ks) { const bf16x8 kf = *(LAS const bf16x8*)(kb + hf * 4096 + L.koff + (((2 * ks + L.h) ^ L.kx) << 4)); s = __builtin_amdgcn_mfma_f32_32x32x16_bf16(kf, qf[ks], s, 0, 0, 0); }
    return s;
}
__device__ __forceinline__ void attn_pv(LAS const unsigned char* vb, int hf, const AttnLane& L, const f32x16& p, f32x16 (&o)[2]) {
#pragma unroll
    for (int s = 0; s < 2; ++s) {
        v4u pw; pw.x = cvtpk(p[8 * s + 0], p[8 * s + 1]); pw.y = cvtpk(p[8 * s + 2], p[8 * s + 3]); pw.z = cvtpk(p[8 * s + 4], p[8 * s + 5]); pw.w = cvtpk(p[8 * s + 6], p[8 * s + 7]);
        const bf16x8 pb = __builtin_bit_cast(bf16x8, pw);
        const int rb = (32 * hf + 16 * s) * 128;
        { const s16x4 lo = vtr(vb + rb + L.voff0), hi = vtr(vb + rb + 1024 + L.voff0); const bf16x8 vf = {lo[0], lo[1], lo[2], lo[3], hi[0], hi[1], hi[2], hi[3]};
          o[0] = __builtin_amdgcn_mfma_f32_32x32x16_bf16(vf, pb, o[0], 0, 0, 0); }
        { const s16x4 lo = vtr(vb + rb + L.voff1), hi = vtr(vb + rb + 1024 + L.voff1); const bf16x8 vf = {lo[0], lo[1], lo[2], lo[3], hi[0], hi[1], hi[2], hi[3]};
          o[1] = __builtin_amdgcn_mfma_f32_32x32x16_bf16(vf, pb, o[1], 0, 0, 0); }
    }
}
__device__ __forceinline__ float max16(const f32x16& a) {
    float m0 = fmaxf(fmaxf(a[0], a[1]), fmaxf(a[2], a[3])), m1 = fmaxf(fmaxf(a[4], a[5]), fmaxf(a[6], a[7])), m2 = fmaxf(fmaxf(a[8], a[9]), fmaxf(a[10], a[11])), m3 = fmaxf(fmaxf(a[12], a[13]), fmaxf(a[14], a[15]));
    return fmaxf(fmaxf(m0, m1), fmaxf(m2, m3));
}
__device__ __forceinline__ float sum16(const f32x16& a) {
    return ((a[0] + a[1]) + (a[2] + a[3])) + ((a[4] + a[5]) + (a[6] + a[7])) + (((a[8] + a[9]) + (a[10] + a[11])) + ((a[12] + a[13]) + (a[14] + a[15])));
}
__device__ __forceinline__ float xmax32(float v) { const auto rr = __builtin_amdgcn_permlane32_swap(__float_as_uint(v), __float_as_uint(v), false, false); return fmaxf(__uint_as_float(rr[0]), __uint_as_float(rr[1])); }
__device__ __forceinline__ float xsum32(float v) { const auto rr = __builtin_amdgcn_permlane32_swap(__float_as_uint(v), __float_as_uint(v), false, false); return __uint_as_float(rr[0]) + __uint_as_float(rr[1]); }
__device__ __forceinline__ void attn_softmax_pv(LAS const unsigned char* vb, const AttnLane& L, f32x16& t0, f32x16& t1, float& m, float& lh, f32x16 (&o)[2]) {
    const float tm = xmax32(fmaxf(max16(t0), max16(t1)));
    if (__any(tm > m + 8.0f)) {
        const float mn = fmaxf(m, tm), mu0 = (mn == -INFINITY) ? 0.f : mn;
        const float alpha = __builtin_amdgcn_exp2f(m - mu0);
#pragma unroll
        for (int r = 0; r < 16; ++r) { o[0][r] *= alpha; o[1][r] *= alpha; }
        lh *= alpha; m = mn;
    }
    const float mu = (m == -INFINITY) ? 0.f : m;
#pragma unroll
    for (int r = 0; r < 16; ++r) { t0[r] = __builtin_amdgcn_exp2f(t0[r] - mu); t1[r] = __builtin_amdgcn_exp2f(t1[r] - mu); }
    lh += sum16(t0) + sum16(t1);
    attn_pv(vb, 0, L, t0, o); attn_pv(vb, 1, L, t1, o);
}
#define KEYIDX(hf, reg, h) (32 * (hf) + ((reg) & 3) + 8 * ((reg) >> 2) + 4 * (h))
__device__ __forceinline__ void score_far(f32x16& t0, f32x16& t1, float cb) {
#pragma unroll
    for (int r = 0; r < 16; ++r) { t0[r] = fmaf(t0[r], LOG2E, cb); t1[r] = fmaf(t1[r], LOG2E, cb); }
}
__device__ __forceinline__ void score_near1(f32x16& t, int hf, int h, LAS const float* lut, int hd, int dbase, int dstep, int dmax, int klim, bool colok) {
#pragma unroll
    for (int r = 0; r < 16; ++r) {
        const int ki = KEYIDX(hf, r, h); const int dist = dbase - dstep * ki; const int di = dist < 0 ? 0 : (dist > 127 ? 127 : dist); const float bv = lut[di * 8 + hd];
        const bool ok = colok && dist >= 0 && dist < dmax && ki < klim; const float v = fmaf(t[r], LOG2E, bv); t[r] = ok ? v : -INFINITY; }
}
__device__ __forceinline__ void score_near(f32x16& t0, f32x16& t1, int h, LAS const float* lut, int hd, int dbase, int dstep, int dmax, int klim, bool colok) {
    score_near1(t0, 0, h, lut, hd, dbase, dstep, dmax, klim, colok);
    __builtin_amdgcn_sched_barrier(0);
    score_near1(t1, 1, h, lut, hd, dbase, dstep, dmax, klim, colok);
    __builtin_amdgcn_sched_barrier(0);
}

__device__ __forceinline__ void win_unit(const Frame& F, const Args& A, LAS unsigned char* sh, int b, int g, int qb) {
    const bf16* PROJ = (const bf16*)(A.ws + WS_PROJ);
    const int lane = opaque(F.lane), w = F.wave, tid = w * 64 + lane;
    const AttnLane L = attn_lane(lane);
    const int tq = 64 * qb + 8 * w + (L.r32 >> 2), hd = g * 4 + (L.r32 & 3);
    const size_t tokq = (size_t)b * SEQ + tq;
    bf16x8 qf[4];
#pragma unroll
    for (int ks = 0; ks < 4; ++ks) qf[ks] = *(const bf16x8*)(PROJ + tokq * NPROJ + C_QN + hd * 64 + 16 * ks + 8 * L.h);
    LAS const float* lut = (LAS const float*)(sh + AT_LUT);
    const float bfar = lut[127 * 8 + hd];
    const int kt0 = qb >= 8 ? qb - 8 : 0, nt = qb - kt0 + 1;
    const int srow = tid >> 3, sch = tid & 7;
    const bf16* ksrc = PROJ + ((size_t)b * SEQ + srow) * NPROJ + C_WIN + g * 64 + sch * 8;
    v4u kr, vr;
    kr = *(const v4u*)(ksrc + (size_t)(64 * kt0) * NPROJ); vr = *(const v4u*)(ksrc + (size_t)(64 * kt0) * NPROJ + 128);
    __syncthreads();
    attn_commit(sh + AT_K0, sh + AT_V0, tid, kr, vr);
    __syncthreads();
    float m = -INFINITY, l = 0.f; f32x16 o[2]; o[0] = f32x16{}; o[1] = f32x16{};
    for (int it = 0; it < nt; ++it) {
        const int kt = kt0 + it, buf = it & 1;
        if (it + 1 < nt) { kr = *(const v4u*)(ksrc + (size_t)(64 * (kt + 1)) * NPROJ); vr = *(const v4u*)(ksrc + (size_t)(64 * (kt + 1)) * NPROJ + 128); }
        LAS const unsigned char* kb = sh + AT_K0 + buf * 8192; LAS const unsigned char* vb = sh + AT_V0 + buf * 8192;
        f32x16 t0 = attn_qk(kb, 0, L, qf), t1 = attn_qk(kb, 1, L, qf);
        if (kt <= qb - 3 && kt >= qb - 7) score_far(t0, t1, bfar);
        else score_near(t0, t1, L.h, lut, hd, tq - 64 * kt, 1, 512, 64, true);
        attn_softmax_pv(vb, L, t0, t1, m, l, o);
        if (it + 1 < nt) attn_commit(sh + AT_K0 + (buf ^ 1) * 8192, sh + AT_V0 + (buf ^ 1) * 8192, tid, kr, vr);
        __syncthreads();
    }
    const float rl = 1.0f / xsum32(l);
    bf16* dst = (bf16*)(A.ws + WS_OWIN) + tokq * 512 + hd * 64;
#pragma unroll
    for (int dt = 0; dt < 2; ++dt)
#pragma unroll
        for (int rq = 0; rq < 4; ++rq) { v2u wv; wv.x = cvtpk(o[dt][4 * rq] * rl, o[dt][4 * rq + 1] * rl); wv.y = cvtpk(o[dt][4 * rq + 2] * rl, o[dt][4 * rq + 3] * rl);
            *(v2u*)(dst + 32 * dt + 8 * rq + 4 * L.h) = wv; }
}

__device__ __forceinline__ void nsa_unit(const Frame& F, const Args& A, LAS unsigned char* sh, int b, int g, int qb) {
    const bf16* PROJ = (const bf16*)(A.ws + WS_PROJ);
    const int lane = opaque(F.lane), w = F.wave, tid = w * 64 + lane;
    const AttnLane L = attn_lane(lane);
    const int qloc = 8 * w + (L.r32 >> 2);
    const int tq = 64 * qb + qloc, hd = g * 4 + (L.r32 & 3);
    const size_t tokq = (size_t)b * SEQ + tq;
    LAS bf16x8* qlds = (LAS bf16x8*)(sh + AT_QF) + tid;
    __syncthreads();
#pragma unroll
    for (int ks = 0; ks < 4; ++ks) qlds[ks * 512] = *(const bf16x8*)(PROJ + tokq * NPROJ + C_QN + hd * 64 + 16 * ks + 8 * L.h);
#define NSA_LOADQ() bf16x8 qf[4]; _Pragma("unroll") for (int ks = 0; ks < 4; ++ks) qf[ks] = qlds[ks * 512]
    LAS const float* lut = (LAS const float*)(sh + AT_LUT);
    const float bfar = lut[127 * 8 + hd];
    LAS float* impA = (LAS float*)(sh + AT_IMPA); LAS float* impB = (LAS float*)(sh + AT_IMPB);
    LAS unsigned long long* selm = (LAS unsigned long long*)(sh + AT_SEL);
    const int srow = tid >> 3, sch = tid & 7;
    v4u kr, vr;
    const int nct = (4 * qb + 3 + 63) >> 6;
    const bf16* kcs = (const bf16*)(A.ws + WS_KCP) + ((size_t)(b * 256 + srow) * 2 + g) * 64 + sch * 8;
    const bf16* vcs = (const bf16*)(A.ws + WS_VCP) + ((size_t)(b * 256 + srow) * 2 + g) * 64 + sch * 8;
    __syncthreads();
    for (int e = tid; e < 64 * 65; e += NWAVES * 64) { impA[e] = 0.f; impB[e] = 0.f; }
    float mc = -INFINITY, lc = 0.f;
    f32x16 oc[2]; oc[0] = f32x16{}; oc[1] = f32x16{};
#pragma unroll 1
    for (int pass = 0; pass < 2; ++pass) {
        kr = *(const v4u*)(kcs); vr = *(const v4u*)(vcs);
        __syncthreads();
        attn_commit(sh + AT_K0, sh + AT_V0, tid, kr, vr);
        __syncthreads();
        const float mu = (mc == -INFINITY) ? 0.f : mc, il = lc > 0.f ? 1.0f / lc : 0.f;
#pragma unroll 1
        for (int ct = 0; ct < nct; ++ct) {
            const int buf = ct & 1;
            if (ct + 1 < nct) { kr = *(const v4u*)(kcs + (size_t)(64 * (ct + 1)) * 128); vr = *(const v4u*)(vcs + (size_t)(64 * (ct + 1)) * 128); }
            LAS const unsigned char* kb = sh + AT_K0 + buf * 8192; LAS const unsigned char* vb = sh + AT_V0 + buf * 8192;
            NSA_LOADQ();
            f32x16 t0 = attn_qk(kb, 0, L, qf), t1 = attn_qk(kb, 1, L, qf);
            score_near(t0, t1, L.h, lut, hd, tq - 31 - 1024 * ct, 16, 1 << 30, 255 - 64 * ct, true);
            if (pass == 0) {
                const float tm = xmax32(fmaxf(max16(t0), max16(t1)));
                const float mn = fmaxf(mc, tm), mu0 = (mn == -INFINITY) ? 0.f : mn;
                const float alpha = __builtin_amdgcn_exp2f(mc - mu0);
                float ps = 0.f;
#pragma unroll
                for (int r = 0; r < 16; ++r) ps += __builtin_amdgcn_exp2f(t0[r] - mu0) + __builtin_amdgcn_exp2f(t1[r] - mu0);
                ps = xsum32(ps);
                lc = lc * alpha + ps; mc = mn;
            } else {
#pragma unroll
                for (int r = 0; r < 16; ++r) { t0[r] = __builtin_amdgcn_exp2f(t0[r] - mu) * il; t1[r] = __builtin_amdgcn_exp2f(t1[r] - mu) * il; }
                attn_pv(vb, 0, L, t0, oc); attn_pv(vb, 1, L, t1, oc);
#pragma unroll
                for (int hf = 0; hf < 2; ++hf) {
                    float x[16];
#pragma unroll
                    for (int r = 0; r < 16; ++r) { float v = hf ? t1[r] : t0[r]; v += __shfl_xor(v, 1); v += __shfl_xor(v, 2); x[r] = v; }
                    if ((L.r32 & 3) == 0) {
#pragma unroll
                        for (int rq = 0; rq < 4; ++rq) { const int jq = 16 * ct + 8 * hf + 2 * rq + L.h;
                            impA[qloc * 65 + jq] = 2.0f * (x[4 * rq] + x[4 * rq + 1] + x[4 * rq + 2]) + x[4 * rq + 3];
                            impB[qloc * 65 + jq + 1] = x[4 * rq + 3]; }
                    }
                }
            }
            if (ct + 1 < nct) attn_commit(sh + AT_K0 + (buf ^ 1) * 8192, sh + AT_V0 + (buf ^ 1) * 8192, tid, kr, vr);
            __syncthreads();
        }
    }
#pragma unroll 1
    for (int qi = 0; qi < 8; ++qi) {
        const int q = 8 * w + qi;
        unsigned long long mk;
        if (qb < 16) mk = (2ull << qb) - 1ull;
        else {
            const bool forced = (lane == 0) || (lane == qb) || (lane == qb - 1);
            const float sc = forced ? 1e9f : (lane <= qb ? impA[q * 65 + lane] + impB[q * 65 + lane] : -1.0f);
            int rank = 0;
#pragma unroll 8
            for (int jj = 0; jj < 64; ++jj) { const float ov = __uint_as_float(__builtin_amdgcn_readlane(__float_as_uint(sc), jj)); rank += ((ov > sc) || (ov == sc && jj < lane)) ? 1 : 0; }
            mk = __ballot(rank < 16 && lane <= qb);
        }
        if (lane == 0) selm[q] = mk;
    }
    __syncthreads();
    const unsigned long long mysel = selm[qloc];
    unsigned long long um = 0ull;
#pragma unroll 8
    for (int q_ = 0; q_ < 64; ++q_) um |= selm[q_];
    um = ((unsigned long long)__builtin_amdgcn_readfirstlane((unsigned)(um >> 32)) << 32) | (unsigned long long)__builtin_amdgcn_readfirstlane((unsigned)um);
    const bf16* ksrc = PROJ + ((size_t)b * SEQ + srow) * NPROJ + C_KV + 2 * 128 + g * 64 + sch * 8;
    float m = -INFINITY, l = 0.f; f32x16 o[2]; o[0] = f32x16{}; o[1] = f32x16{};
    int j = __builtin_ctzll(um); um &= um - 1;
    kr = *(const v4u*)(ksrc + (size_t)(64 * j) * NPROJ); vr = *(const v4u*)(ksrc + (size_t)(64 * j) * NPROJ + 128);
    attn_commit(sh + AT_K0, sh + AT_V0, tid, kr, vr);
    __syncthreads();
    int buf = 0;
#pragma unroll 1
    for (;;) {
        const int jn = um ? __builtin_ctzll(um) : -1; um &= um - 1;
        if (jn >= 0) { kr = *(const v4u*)(ksrc + (size_t)(64 * jn) * NPROJ); vr = *(const v4u*)(ksrc + (size_t)(64 * jn) * NPROJ + 128); }
        LAS const unsigned char* kb = sh + AT_K0 + buf * 8192; LAS const unsigned char* vb = sh + AT_V0 + buf * 8192;
        const bool selj = (mysel >> j) & 1ull;
        if (__any(selj)) {
            NSA_LOADQ();
            f32x16 t0 = attn_qk(kb, 0, L, qf), t1 = attn_qk(kb, 1, L, qf);
            if (j <= qb - 3) score_far(t0, t1, selj ? bfar : -INFINITY);
            else score_near(t0, t1, L.h, lut, hd, tq - 64 * j, 1, 1 << 30, 64, selj);
            attn_softmax_pv(vb, L, t0, t1, m, l, o);
        }
        if (jn >= 0) attn_commit(sh + AT_K0 + (buf ^ 1) * 8192, sh + AT_V0 + (buf ^ 1) * 8192, tid, kr, vr);
        __syncthreads();
        if (jn < 0) break;
        j = jn; buf ^= 1;
    }
    const bf16* gp = PROJ + tokq * NPROJ + C_GT + hd;
    const float g0 = 1.0f / (1.0f + __expf(-bf2f(gp[0]))), g1 = 1.0f / (1.0f + __expf(-bf2f(gp[8]))), g2 = 1.0f / (1.0f + __expf(-bf2f(gp[16])));
    const float rl = g1 / xsum32(l);
    const bf16* ow = (const bf16*)(A.ws + WS_OWIN) + tokq * 512 + hd * 64;
    bf16* dst = (bf16*)(A.ws + WS_MIX) + tokq * 1024 + hd * 64;
#pragma unroll
    for (int dt = 0; dt < 2; ++dt)
#pragma unroll
        for (int rq = 0; rq < 4; ++rq) { const int d0 = 32 * dt + 8 * rq + 4 * L.h; const v2u wv = *(const v2u*)(ow + d0);
            const float a0 = g0 * oc[dt][4 * rq] + rl * o[dt][4 * rq] + g2 * bflo(wv.x), a1 = g0 * oc[dt][4 * rq + 1] + rl * o[dt][4 * rq + 1] + g2 * bfhi(wv.x);
            const float a2 = g0 * oc[dt][4 * rq + 2] + rl * o[dt][4 * rq + 2] + g2 * bflo(wv.y), a3 = g0 * oc[dt][4 * rq + 3] + rl * o[dt][4 * rq + 3] + g2 * bfhi(wv.y);
            v2u ov; ov.x = cvtpk(a0, a1); ov.y = cvtpk(a2, a3); *(v2u*)(dst + d0) = ov; }
}
#undef NSA_LOADQ

__device__ __forceinline__ v4u pack_f32x8(const float* p) { const f32x4 a = *(const f32x4*)p, b = *(const f32x4*)(p + 4); v4u w; w.x = pk2(a.x, a.y); w.y = pk2(a.z, a.w); w.z = pk2(b.x, b.y); w.w = pk2(b.z, b.w); return w; }
__device__ __forceinline__ void samp_load(const Args& A, int mode, int tile, int b, int g, int srow, int sch, v4u& kr, v4u& vr) {
    const bf16* PROJ = (const bf16*)(A.ws + WS_PROJ);
    kr = (v4u){0, 0, 0, 0}; vr = (v4u){0, 0, 0, 0};
    if (mode == 0) {
        const size_t off = ((size_t)(b * 512 + 64 * tile + srow) * 2 + g) * 64 + sch * 8;
        kr = *(const v4u*)((const bf16*)(A.ws + WS_KCS) + off); vr = *(const v4u*)((const bf16*)(A.ws + WS_VCS) + off);
    } else if (mode == 1) {
        if (tile < 128) { const int page = ((const int*)A.in[5])[b * 64 + (tile >> 1)]; const int row = (tile & 1) * 64 + srow;
            const float* p = A.in[2] + ((size_t)(page * 128 + row) * 4 + 2) * 128 + g * 64 + sch * 8; kr = pack_f32x8(p); vr = pack_f32x8(p + 128); }
        else if (srow < 4) { const bf16* p = PROJ + (size_t)(TP + b * 4 + srow) * NPROJ + C_KV + 2 * 128 + g * 64 + sch * 8; kr = *(const v4u*)p; vr = *(const v4u*)(p + 128); }
    } else {
        const int idx = 64 * tile + srow;
        if (idx < 512) { const float* p = A.in[3] + ((size_t)(b * 512 + idx) * 2) * 128 + g * 64 + sch * 8; kr = pack_f32x8(p); vr = pack_f32x8(p + 128); }
        else if (idx < 516) { const bf16* p = PROJ + (size_t)(TP + b * 4 + idx - 512) * NPROJ + C_WIN + g * 64 + sch * 8; kr = *(const v4u*)p; vr = *(const v4u*)(p + 128); }
    }
}
__device__ __forceinline__ void samp_stage_tile(const Args& A, int mode, int tile, int b, int g, int lane, LAS unsigned char* kb, LAS unsigned char* vb) {
#pragma unroll 1
    for (int i0 = 0; i0 < 8; i0 += 2) {
        v4u kr[2], vr[2];
#pragma unroll
        for (int i = 0; i < 2; ++i) samp_load(A, mode, tile, b, g, (lane >> 3) + 8 * (i0 + i), lane & 7, kr[i], vr[i]);
#pragma unroll
        for (int i = 0; i < 2; ++i) { const int row = (lane >> 3) + 8 * (i0 + i), ch = lane & 7;
            *(LAS v4u*)(kb + row * 128 + ((ch ^ ((row >> 1) & 7)) << 4)) = kr[i];
            *(LAS v4u*)(vb + row * 128 + ((ch ^ (((row >> 1) & 1) << 2)) << 4)) = vr[i]; }
    }
}
__device__ __forceinline__ void samp_unit(const Frame& F, const Args& A, LAS unsigned char* sh, int b, int g) {
    const bf16* PROJ = (const bf16*)(A.ws + WS_PROJ);
    const int lane = opaque(F.lane), w = F.wave, tid = w * 64 + lane;
    const AttnLane L = attn_lane(lane);
    const bool colok = L.r32 < 16;
    const int qi = (L.r32 >> 2) & 3, hd = g * 4 + (L.r32 & 3);
    const int pos = PAST + qi;
    const size_t tokq = (size_t)TP + b * 4 + qi;
    LAS unsigned char* kb = sh + w * 16384; LAS unsigned char* vb = kb + 8192;
    LAS float* lut = (LAS float*)(sh + AT_LUT);
    LAS float* impA = (LAS float*)(sh + HI_IMPA); LAS float* impB = (LAS float*)(sh + HI_IMPB);
    LAS unsigned long long* selm = (LAS unsigned long long*)(sh + HI_SEL);
    LAS float* scs = (LAS float*)(sh + HI_SCS);
    LAS int* tlist = (LAS int*)(sh + HI_TL);
    LAS float* xch = (LAS float*)(sh + HI_XCH);
    bf16x8 qf[4];
#pragma unroll
    for (int ks = 0; ks < 4; ++ks) qf[ks] = *(const bf16x8*)(PROJ + tokq * NPROJ + C_QN + hd * 64 + 16 * ks + 8 * L.h);
    const float bfar = lut[127 * 8 + hd];
    __syncthreads();
    for (int e = tid; e < 4 * 132; e += NWAVES * 64) { impA[e] = 0.f; impB[e] = 0.f; }
    f32x16 oc[2]; oc[0] = f32x16{}; oc[1] = f32x16{};
    {
        samp_stage_tile(A, 0, w, b, g, lane, kb, vb);
        f32x16 t0 = attn_qk(kb, 0, L, qf), t1 = attn_qk(kb, 1, L, qf);
        score_near(t0, t1, L.h, lut, hd, pos - 31 - 1024 * w, 16, 1 << 30, 511 - 64 * w, colok);
        const float tm = xmax32(fmaxf(max16(t0), max16(t1)));
        xch[(w * 64 + lane) * 4] = tm;
        __syncthreads();
        float M = -INFINITY;
#pragma unroll
        for (int ww = 0; ww < 8; ++ww) M = fmaxf(M, xch[(ww * 64 + lane) * 4]);
        const float mu = (M == -INFINITY) ? 0.f : M;
#pragma unroll
        for (int r = 0; r < 16; ++r) { t0[r] = __builtin_amdgcn_exp2f(t0[r] - mu); t1[r] = __builtin_amdgcn_exp2f(t1[r] - mu); }
        const float ps = xsum32(sum16(t0) + sum16(t1));
        xch[(w * 64 + lane) * 4 + 1] = ps;
        __syncthreads();
        float Lc = 0.f;
#pragma unroll
        for (int ww = 0; ww < 8; ++ww) Lc += xch[(ww * 64 + lane) * 4 + 1];
        const float il = Lc > 0.f ? 1.0f / Lc : 0.f;
#pragma unroll
        for (int r = 0; r < 16; ++r) { t0[r] *= il; t1[r] *= il; }
        attn_pv(vb, 0, L, t0, oc); attn_pv(vb, 1, L, t1, oc);
#pragma unroll
        for (int hf = 0; hf < 2; ++hf) {
            float x[16];
#pragma unroll
            for (int r = 0; r < 16; ++r) { float v = hf ? t1[r] : t0[r]; v += __shfl_xor(v, 1); v += __shfl_xor(v, 2); x[r] = v; }
            if ((L.r32 & 3) == 0 && colok) {
#pragma unroll
                for (int rq = 0; rq < 4; ++rq) { const int jq = 16 * w + 8 * hf + 2 * rq + L.h;
                    impA[qi * 132 + jq] = 2.0f * (x[4 * rq] + x[4 * rq + 1] + x[4 * rq + 2]) + x[4 * rq + 3];
                    impB[qi * 132 + jq + 1] = x[4 * rq + 3]; }
            }
        }
    }
    __syncthreads();
    if (w == 0) {
        unsigned long long ulo = 0ull, uhi = 0ull;
#pragma unroll 1
        for (int q = 0; q < 4; ++q) {
            const int j0 = lane, j1 = lane + 64;
            const float s0 = (j0 == 0) ? 1e9f : impA[q * 132 + j0] + impB[q * 132 + j0];
            const float s1 = (j1 == 127) ? 1e9f : impA[q * 132 + j1] + impB[q * 132 + j1];
            scs[j0] = s0; scs[j1] = s1;
            LDS_WAIT(); asm volatile("" ::: "memory");
            int r0 = 0, r1 = 0;
#pragma unroll 8
            for (int jj = 0; jj < 128; ++jj) { const float ov = scs[jj]; r0 += ((ov > s0) || (ov == s0 && jj < j0)) ? 1 : 0; r1 += ((ov > s1) || (ov == s1 && jj < j1)) ? 1 : 0; }
            const unsigned long long mlo = __ballot(r0 < 15), mhi = __ballot(r1 < 15);
            if (lane == 0) { selm[2 * q] = mlo; selm[2 * q + 1] = mhi; }
            ulo |= mlo; uhi |= mhi;
            LDS_WAIT(); asm volatile("" ::: "memory");
        }
        if (lane == 0) { int n = 0; for (int j = 0; j < 64; ++j) if ((ulo >> j) & 1ull) tlist[1 + n++] = j; for (int j = 0; j < 64; ++j) if ((uhi >> j) & 1ull) tlist[1 + n++] = 64 + j; tlist[1 + n++] = 128; tlist[0] = n; }
    }
    __syncthreads();
    const unsigned long long mylo = selm[2 * qi], myhi = selm[2 * qi + 1];
    const int nsel = tlist[0];
    const bf16* gp = PROJ + tokq * NPROJ + C_GT + hd;
    const float g0 = 1.0f / (1.0f + __expf(-bf2f(gp[0]))), g1 = 1.0f / (1.0f + __expf(-bf2f(gp[8]))), g2 = 1.0f / (1.0f + __expf(-bf2f(gp[16])));
#pragma unroll
    for (int r = 0; r < 16; ++r) { oc[0][r] *= g0; oc[1][r] *= g0; }
#pragma unroll 1
    for (int br = 0; br < 2; ++br) {
        const int nt = br == 0 ? nsel : 9;
        float m = -INFINITY, l = 0.f; f32x16 o[2]; o[0] = f32x16{}; o[1] = f32x16{};
#pragma unroll 1
        for (int it = w; it < nt; it += 8) {
            const int j = br == 0 ? tlist[1 + it] : it;
            samp_stage_tile(A, 1 + br, j, b, g, lane, kb, vb);
            f32x16 t0 = attn_qk(kb, 0, L, qf), t1 = attn_qk(kb, 1, L, qf);
            if (br == 0) {
                const bool selj = colok && (j >= 128 ? true : (j < 64 ? ((mylo >> j) & 1ull) : ((myhi >> (j - 64)) & 1ull)));
                if (j <= 125) score_far(t0, t1, selj ? bfar : -INFINITY);
                else score_near(t0, t1, L.h, lut, hd, pos - 64 * j, 1, 1 << 30, 64, selj);
            } else score_near(t0, t1, L.h, lut, hd, pos - (PAST - 512 + 64 * j), 1, 512, 516 - 64 * j, colok);
            attn_softmax_pv(vb, L, t0, t1, m, l, o);
        }
        l = xsum32(l);
        xch[(w * 64 + lane) * 4 + 2] = m; xch[(w * 64 + lane) * 4 + 3] = l;
        __syncthreads();
        float M = -INFINITY;
#pragma unroll
        for (int ww = 0; ww < 8; ++ww) M = fmaxf(M, xch[(ww * 64 + lane) * 4 + 2]);
        float Lt = 0.f;
#pragma unroll
        for (int ww = 0; ww < 8; ++ww) { const float mw = xch[(ww * 64 + lane) * 4 + 2]; Lt += (mw == -INFINITY) ? 0.f : xch[(ww * 64 + lane) * 4 + 3] * __builtin_amdgcn_exp2f(mw - M); }
        const float sc = (m == -INFINITY || !(Lt > 0.f)) ? 0.f : (br == 0 ? g1 : g2) * __builtin_amdgcn_exp2f(m - M) / Lt;
#pragma unroll
        for (int r = 0; r < 16; ++r) { oc[0][r] += sc * o[0][r]; oc[1][r] += sc * o[1][r]; }
        __syncthreads();
    }
    { LAS float* part = (LAS float*)kb;
#pragma unroll
      for (int r = 0; r < 16; ++r) { part[r * 64 + lane] = oc[0][r]; part[(16 + r) * 64 + lane] = oc[1][r]; } }
    __syncthreads();
    if (w == 0 && colok) {
        float res[32];
#pragma unroll
        for (int r = 0; r < 32; ++r) { float a = 0.f;
#pragma unroll
            for (int ww = 0; ww < 8; ++ww) a += ((LAS const float*)(sh + ww * 16384))[r * 64 + lane];
            res[r] = a; }
        bf16* dst = (bf16*)(A.ws + WS_MIX) + tokq * 1024 + hd * 64;
#pragma unroll
        for (int dt = 0; dt < 2; ++dt)
#pragma unroll
            for (int rq = 0; rq < 4; ++rq) { const int d0 = 32 * dt + 8 * rq + 4 * L.h;
                v2u ov; ov.x = cvtpk(res[16 * dt + 4 * rq], res[16 * dt + 4 * rq + 1]); ov.y = cvtpk(res[16 * dt + 4 * rq + 2], res[16 * dt + 4 * rq + 3]); *(v2u*)(dst + d0) = ov; }
    }
}

__device__ __forceinline__ float gelu_tanh(float x) { const float u = 0.7978845608028654f * (x + 0.044715f * x * x * x); const float t = 1.0f - 2.0f / (1.0f + __expf(2.0f * u)); return 0.5f * x * (1.0f + t); }
template <bool SAMPLE>
__device__ __forceinline__ void cmp_job(const Args& A, int b, int slot, int g, int grp, int lane) {
    const int r32 = lane & 31, h = lane >> 5;
    const int nsb = SAMPLE ? 512 : 256;
    int sb = 31 * grp + r32; const bool sbok = sb < nsb; if (!sbok) sb = nsb - 1;
    const bf16* W1 = (const bf16*)(A.ws + WS_WC1) + (size_t)slot * 64 * 2048;
    const bf16* PROJ = (const bf16*)(A.ws + WS_PROJ);
    f32x16 acc[2][2];
#pragma unroll
    for (int j = 0; j < 2; ++j) { acc[j][0] = f32x16{}; acc[j][1] = f32x16{}; }
    const bf16* w1p = W1 + (size_t)r32 * 2048 + 8 * h;
    const float* crow = nullptr; const bf16* prow = nullptr;
    if (SAMPLE) { const int p0 = 16 * sb; const int page = ((const int*)A.in[5])[b * 64 + (p0 >> 7)];
        crow = A.in[2] + ((size_t)(page * 128 + (p0 & 127)) * 4 + slot) * 128 + g * 64 + 8 * h; }
    else prow = PROJ + (size_t)(b * SEQ + 16 * sb) * NPROJ + C_KV + slot * 128 + g * 64 + 8 * h;
#pragma unroll 2
    for (int s = 0; s < 16; ++s) {
#pragma unroll
        for (int dq = 0; dq < 4; ++dq) {
            bf16x8 bf;
            if (SAMPLE) bf = __builtin_bit_cast(bf16x8, pack_f32x8(crow + (size_t)s * 512 + dq * 16));
            else bf = *(const bf16x8*)(prow + (size_t)s * NPROJ + dq * 16);
#pragma unroll
            for (int j = 0; j < 2; ++j)
#pragma unroll
                for (int ht = 0; ht < 2; ++ht) { const bf16x8 af = *(const bf16x8*)(w1p + (size_t)ht * 32 * 2048 + j * 1024 + s * 64 + dq * 16);
                    acc[j][ht] = __builtin_amdgcn_mfma_f32_32x32x16_bf16(af, bf, acc[j][ht], 0, 0, 0); }
        }
    }
    const float* c1p = (const float*)(A.ws + WS_C1) + slot * 64;
    bf16x8 xb[2][2];
#pragma unroll
    for (int ht = 0; ht < 2; ++ht) {
        float xv[16];
#pragma unroll
        for (int r = 0; r < 16; ++r) { const int hid = 32 * ht + (r & 3) + 8 * (r >> 2) + 4 * h;
            const float c1 = c1p[hid];
            const float h1 = __shfl(acc[1][ht][r], (lane & 32) | ((r32 + 1) & 31));
            xv[r] = gelu_tanh(acc[0][ht][r] + h1 + c1); }
#pragma unroll
        for (int s = 0; s < 2; ++s) { v4u pw; pw.x = cvtpk(xv[8 * s], xv[8 * s + 1]); pw.y = cvtpk(xv[8 * s + 2], xv[8 * s + 3]); pw.z = cvtpk(xv[8 * s + 4], xv[8 * s + 5]); pw.w = cvtpk(xv[8 * s + 6], xv[8 * s + 7]); xb[ht][s] = __builtin_bit_cast(bf16x8, pw); }
    }
    const bf16* W2 = (const bf16*)(A.ws + WS_WC2) + (size_t)slot * 64 * 64;
    f32x16 oo[2];
#pragma unroll
    for (int dt = 0; dt < 2; ++dt) {
        oo[dt] = f32x16{};
#pragma unroll
        for (int ht = 0; ht < 2; ++ht)
#pragma unroll
            for (int s = 0; s < 2; ++s) { const bf16* wp = W2 + (size_t)(32 * dt + r32) * 64 + 32 * ht + 16 * s + 4 * h;
                const v2u lo = *(const v2u*)wp, hi = *(const v2u*)(wp + 8); const v4u af = {lo.x, lo.y, hi.x, hi.y};
                oo[dt] = __builtin_amdgcn_mfma_f32_32x32x16_bf16(__builtin_bit_cast(bf16x8, af), xb[ht][s], oo[dt], 0, 0, 0); }
    }
    const int nblk = SAMPLE ? 511 : 255;
    if (r32 < 31 && sb < nblk && sbok) {
        bf16* dst = (bf16*)(A.ws + (SAMPLE ? (slot ? WS_VCS : WS_KCS) : (slot ? WS_VCP : WS_KCP))) + ((size_t)(b * nsb + sb) * 2 + g) * 64;
#pragma unroll
        for (int dt = 0; dt < 2; ++dt)
#pragma unroll
            for (int rq = 0; rq < 4; ++rq) { v2u wv; wv.x = cvtpk(oo[dt][4 * rq], oo[dt][4 * rq + 1]); wv.y = cvtpk(oo[dt][4 * rq + 2], oo[dt][4 * rq + 3]); *(v2u*)(dst + 32 * dt + 8 * rq + 4 * h) = wv; }
    }
}

__device__ __forceinline__ float log_sigmoid(float x) { return fminf(x, 0.f) - __logf(1.0f + __expf(-fabsf(x))); }
constexpr int G_QE = 0, G_KE = 8192, G_KDT = 16384, G_V = 24576, G_ST = 40960, G_LR = 73728, G_SEG = 77824, G_DEC = 79872, G_END = 80128;
__device__ __forceinline__ int sw128(int row, int ch) { return row * 128 + ((ch ^ ((row >> 1) & 7)) << 4); }

__device__ __forceinline__ void gla_local(const Frame& F, const Args& A, LAS unsigned char* sh, int unit) {
    const int b = unit >> 6, hh = (unit >> 4) & 3, sc = unit & 15;
    const int lane = opaque(F.lane), w = F.wave, tid = w * 64 + lane, r32 = lane & 31, h = lane >> 5;
    const bf16* PROJ = (const bf16*)(A.ws + WS_PROJ);
    const size_t tok0 = (size_t)b * SEQ + 256 * sc;
    const int c = lane;
    float wg[16];
#pragma unroll
    for (int r = 0; r < 16; ++r) wg[r] = A.in[13][r * 256 + hh * 64 + c];
    const float bg = A.in[14][hh * 64 + c];
    float Bprev = 0.f;
    const int dvt = w >> 1, it = w & 1;
    f32x16 accS = {};
    const int i16 = lane & 15, tq = i16 >> 2, tp = i16 & 3, g1 = (lane >> 4) & 1;
    const int vcol = ((4 * (dvt ^ tq) + 2 * g1 + (tp >> 1)) << 4) + (tp & 1) * 8;
    __syncthreads();
#pragma unroll 1
    for (int n = 0; n < 4; ++n) {
        const size_t tb = tok0 + 64 * n;
        { const int trow = tid >> 3, pr = tid & 7; const unsigned lw = *(const unsigned*)(PROJ + (tb + trow) * NPROJ + C_LR + 2 * pr);
          LAS float* lr = (LAS float*)(sh + G_LR); lr[trow * 16 + 2 * pr] = bflo(lw); lr[trow * 16 + 2 * pr + 1] = bfhi(lw);
#pragma unroll
          for (int k2 = 0; k2 < 2; ++k2) { const int ch = pr * 2 + k2; const v4u vv = *(const v4u*)(PROJ + (tb + trow) * NPROJ + C_VG + hh * 128 + ch * 8);
              *(LAS v4u*)(sh + G_V + trow * 256 + ((ch ^ ((trow & 3) << 2)) << 4)) = vv; } }
        __syncthreads();
        float cum[8], qv[8], kv[8];
        { LAS const float* lr = (LAS const float*)(sh + G_LR); float run = 0.f;
#pragma unroll
          for (int k = 0; k < 8; ++k) { const int i = 8 * w + k; float x = bg;
#pragma unroll
              for (int r = 0; r < 16; ++r) x += lr[i * 16 + r] * wg[r];
              run += log_sigmoid(x) * (1.0f / 16.0f); cum[k] = run;
              qv[k] = 0.125f * bf2f(PROJ[(tb + i) * NPROJ + C_QG + hh * 64 + c]); kv[k] = bf2f(PROJ[(tb + i) * NPROJ + C_KG + hh * 64 + c]); }
          ((LAS float*)(sh + G_SEG))[w * 64 + c] = run; }
        __syncthreads();
        { LAS const float* seg = (LAS const float*)(sh + G_SEG); float pre = 0.f, tot = 0.f;
#pragma unroll
          for (int g_ = 0; g_ < 8; ++g_) { const float sv = seg[g_ * 64 + c]; tot += sv; if (g_ < w) pre += sv; }
          const float eB = __expf(Bprev);
          unsigned kdw[4];
#pragma unroll
          for (int k = 0; k < 8; ++k) { const int i = 8 * w + k; const float bb = pre + cum[k];
              const float qe = qv[k] * __expf(bb), ke = kv[k] * __expf(-bb), kd = kv[k] * __expf(tot - bb);
              *(LAS unsigned short*)(sh + G_QE + sw128(i, c >> 3) + (c & 7) * 2) = (unsigned short)f2bf(qe);
              *(LAS unsigned short*)(sh + G_KE + sw128(i, c >> 3) + (c & 7) * 2) = (unsigned short)f2bf(ke);
              ((bf16*)(A.ws + WS_QB))[(tb + i) * 256 + hh * 64 + c] = (bf16)f2bf(qe * eB);
              if (k & 1) kdw[k >> 1] |= f2bf(kd) << 16; else kdw[k >> 1] = f2bf(kd); }
          *(LAS v4u*)(sh + G_KDT + sw128(c, w)) = (v4u){kdw[0], kdw[1], kdw[2], kdw[3]};
          if (w == 0) ((LAS float*)(sh + G_DEC))[c] = __expf(tot);
          Bprev += tot; }
        __syncthreads();
        LAS const unsigned char* qeb = sh + G_QE; LAS const unsigned char* keb = sh + G_KE; LAS const unsigned char* vbase = sh + G_V;
        bf16x8 qfr[4];
#pragma unroll
        for (int ks = 0; ks < 4; ++ks) qfr[ks] = *(LAS const bf16x8*)(qeb + sw128(32 * it + r32, 2 * ks + h));
        f32x16 oT = {};
#pragma unroll
        for (int jt = 0; jt < 2; ++jt) {
            if (jt <= it) {
                f32x16 s = {};
#pragma unroll
                for (int ks = 0; ks < 4; ++ks) { const bf16x8 kf = *(LAS const bf16x8*)(keb + sw128(32 * jt + r32, 2 * ks + h)); s = __builtin_amdgcn_mfma_f32_32x32x16_bf16(kf, qfr[ks], s, 0, 0, 0); }
                if (jt == it) {
#pragma unroll
                    for (int r = 0; r < 16; ++r) { const int j = (r & 3) + 8 * (r >> 2) + 4 * h; if (j > r32) s[r] = 0.f; }
                }
#pragma unroll
                for (int s2 = 0; s2 < 2; ++s2) {
                    v4u pw; pw.x = cvtpk(s[8 * s2], s[8 * s2 + 1]); pw.y = cvtpk(s[8 * s2 + 2], s[8 * s2 + 3]); pw.z = cvtpk(s[8 * s2 + 4], s[8 * s2 + 5]); pw.w = cvtpk(s[8 * s2 + 6], s[8 * s2 + 7]);
                    const int row = 32 * jt + 16 * s2 + 4 * h + tq;
                    const s16x4 lo = vtr(vbase + row * 256 + vcol), hi = vtr(vbase + (row + 8) * 256 + vcol);
                    const bf16x8 vf = {lo[0], lo[1], lo[2], lo[3], hi[0], hi[1], hi[2], hi[3]};
                    oT = __builtin_amdgcn_mfma_f32_32x32x16_bf16(vf, __builtin_bit_cast(bf16x8, pw), oT, 0, 0, 0);
                }
            }
        }
        if (n > 0) {
            LAS const unsigned char* stb = sh + G_ST + (n & 1) * 16384;
#pragma unroll
            for (int ks = 0; ks < 4; ++ks) { const bf16x8 sf = *(LAS const bf16x8*)(stb + sw128(32 * dvt + r32, 2 * ks + h)); oT = __builtin_amdgcn_mfma_f32_32x32x16_bf16(sf, qfr[ks], oT, 0, 0, 0); }
        }
        { float* op = (float*)(A.ws + WS_OLOC) + (tb + 32 * it + r32) * 512 + hh * 128 + 32 * dvt + 4 * h;
#pragma unroll
          for (int rq = 0; rq < 4; ++rq) *(f32x4*)(op + 8 * rq) = (f32x4){oT[4 * rq], oT[4 * rq + 1], oT[4 * rq + 2], oT[4 * rq + 3]}; }
        { const float dec = ((LAS const float*)(sh + G_DEC))[32 * it + r32];
#pragma unroll
          for (int r = 0; r < 16; ++r) accS[r] *= dec;
#pragma unroll
          for (int ks = 0; ks < 4; ++ks) {
              const bf16x8 kdf = *(LAS const bf16x8*)(sh + G_KDT + sw128(32 * it + r32, 2 * ks + h));
              const int row = 16 * ks + 8 * h + tq;
              const s16x4 lo = vtr(vbase + row * 256 + vcol), hi = vtr(vbase + (row + 4) * 256 + vcol);
              const bf16x8 vf = {lo[0], lo[1], lo[2], lo[3], hi[0], hi[1], hi[2], hi[3]};
              accS = __builtin_amdgcn_mfma_f32_32x32x16_bf16(vf, kdf, accS, 0, 0, 0);
          }
          LAS unsigned char* stn = sh + G_ST + ((n + 1) & 1) * 16384; const int d = 32 * it + r32;
#pragma unroll
          for (int r = 0; r < 16; ++r) { const int dv = 32 * dvt + (r & 3) + 8 * (r >> 2) + 4 * h; *(LAS unsigned short*)(stn + sw128(dv, d >> 3) + (d & 7) * 2) = (unsigned short)f2bf(accS[r]); } }
        __syncthreads();
    }
    { float* up = (float*)(A.ws + WS_USC) + (size_t)unit * 8192; const int d = 32 * it + r32;
#pragma unroll
      for (int r = 0; r < 16; ++r) { const int dv = 32 * dvt + (r & 3) + 8 * (r >> 2) + 4 * h; up[dv * 64 + d] = accS[r]; }
      if (w == 0) ((float*)(A.ws + WS_DSC))[unit * 64 + c] = __expf(Bprev); }
}

__device__ __forceinline__ void gla_out(const Frame& F, const Args& A, LAS unsigned char* sh, int unit) {
    const int b = unit >> 6, hh = (unit >> 4) & 3, sc = unit & 15;
    const int lane = opaque(F.lane), w = F.wave, tid = w * 64 + lane, r32 = lane & 31, h = lane >> 5;
    const bf16* PROJ = (const bf16*)(A.ws + WS_PROJ);
    const size_t tok0 = (size_t)b * SEQ + 256 * sc;
    const int d4 = (tid & 15) * 4, dvr = tid >> 4;
    f32x4 S[4];
#pragma unroll
    for (int k = 0; k < 4; ++k) S[k] = (f32x4){0.f, 0.f, 0.f, 0.f};
    const float* U0 = (const float*)(A.ws + WS_USC) + (size_t)(unit - sc) * 8192; const float* D0 = (const float*)(A.ws + WS_DSC) + (size_t)(unit - sc) * 64;
#pragma unroll 1
    for (int s = 0; s < sc; ++s) { const f32x4 dd = *(const f32x4*)(D0 + s * 64 + d4);
#pragma unroll
        for (int k = 0; k < 4; ++k) { const f32x4 u = *(const f32x4*)(U0 + (size_t)s * 8192 + (32 * k + dvr) * 64 + d4); S[k] = S[k] * dd + u; } }
    __syncthreads();
#pragma unroll
    for (int k = 0; k < 4; ++k) { const int dv = 32 * k + dvr; v2u wv; wv.x = pk2(S[k].x, S[k].y); wv.y = pk2(S[k].z, S[k].w);
        *(LAS v2u*)(sh + sw128(dv, d4 >> 3) + (d4 & 7) * 2) = wv; }
    if (sc == 15) {
        const f32x4 dd = *(const f32x4*)(D0 + 15 * 64 + d4); float* op = A.out + O_GLAP + (size_t)(b * 4 + hh) * 8192;
#pragma unroll
        for (int k = 0; k < 4; ++k) { const int dv = 32 * k + dvr; const f32x4 u = *(const f32x4*)(U0 + (size_t)15 * 8192 + dv * 64 + d4); const f32x4 e = S[k] * dd + u;
            op[(d4 + 0) * 128 + dv] = e.x; op[(d4 + 1) * 128 + dv] = e.y; op[(d4 + 2) * 128 + dv] = e.z; op[(d4 + 3) * 128 + dv] = e.w; }
    }
    __syncthreads();
    const size_t tok = tok0 + 32 * w + r32;
    f32x16 acc[4];
#pragma unroll
    for (int t = 0; t < 4; ++t) acc[t] = f32x16{};
#pragma unroll
    for (int ks = 0; ks < 4; ++ks) { const bf16x8 qb = *(const bf16x8*)((const bf16*)(A.ws + WS_QB) + tok * 256 + hh * 64 + 16 * ks + 8 * h);
#pragma unroll
        for (int t = 0; t < 4; ++t) { const bf16x8 sf = *(LAS const bf16x8*)(sh + sw128(32 * t + r32, 2 * ks + h)); acc[t] = __builtin_amdgcn_mfma_f32_32x32x16_bf16(sf, qb, acc[t], 0, 0, 0); } }
    const float* ol = (const float*)(A.ws + WS_OLOC) + tok * 512 + hh * 128;
    float ss = 0.f;
#pragma unroll
    for (int t = 0; t < 4; ++t)
#pragma unroll
        for (int rq = 0; rq < 4; ++rq) { const f32x4 v = *(const f32x4*)(ol + 32 * t + 8 * rq + 4 * h);
#pragma unroll
            for (int e = 0; e < 4; ++e) { acc[t][4 * rq + e] += v[e]; ss += acc[t][4 * rq + e] * acc[t][4 * rq + e]; } }
    ss += __shfl_xor(ss, 32);
    const float rstd = 1.0f / sqrtf(ss * (1.0f / 128.0f) + EPS);
    const float* gn = A.in[15]; const bf16* gg = PROJ + tok * NPROJ + C_GG + hh * 128;
    bf16* dst = (bf16*)(A.ws + WS_MIX) + tok * 1024 + 512 + hh * 128;
#pragma unroll
    for (int t = 0; t < 4; ++t)
#pragma unroll
        for (int rq = 0; rq < 4; ++rq) { const int dv0 = 32 * t + 8 * rq + 4 * h; const f32x4 gnv = *(const f32x4*)(gn + dv0); const v2u gw = *(const v2u*)(gg + dv0);
            const float gv[4] = {bflo(gw.x), bfhi(gw.x), bflo(gw.y), bfhi(gw.y)}; float y[4];
#pragma unroll
            for (int e = 0; e < 4; ++e) y[e] = acc[t][4 * rq + e] * rstd * gnv[e] * gv[e] / (1.0f + __expf(-gv[e]));
            v2u ov; ov.x = cvtpk(y[0], y[1]); ov.y = cvtpk(y[2], y[3]); *(v2u*)(dst + dv0) = ov; }
}

__device__ __forceinline__ void gla_sample(const Frame& F, const Args& A, LAS unsigned char* sh, int unit) {
    const int b = unit >> 2, hh = unit & 3, tid = F.wave * 64 + opaque(F.lane);
    const bf16* PROJ = (const bf16*)(A.ws + WS_PROJ);
    LAS float* la = (LAS float*)sh;
    LAS float* qs = la + 256;
    LAS float* ks = qs + 256;
    LAS float* op = ks + 256;
    LAS float* of = op + 2048;
    __syncthreads();
    if (tid < 256) { const int t = tid >> 6, c = tid & 63; const size_t tok = (size_t)TP + b * 4 + t; float x = A.in[14][hh * 64 + c];
#pragma unroll
        for (int r = 0; r < 16; ++r) x += bf2f(PROJ[tok * NPROJ + C_LR + r]) * A.in[13][r * 256 + hh * 64 + c];
        la[tid] = __expf(log_sigmoid(x) * (1.0f / 16.0f)); qs[tid] = 0.125f * bf2f(PROJ[tok * NPROJ + C_QG + hh * 64 + c]); ks[tid] = bf2f(PROJ[tok * NPROJ + C_KG + hh * 64 + c]); }
    __syncthreads();
    const int dv = tid & 127, cg = tid >> 7;
    const float* s0 = A.in[4] + (size_t)(b * 4 + hh) * 8192;
    float S[16];
#pragma unroll
    for (int k = 0; k < 16; ++k) S[k] = s0[(16 * cg + k) * 128 + dv];
#pragma unroll
    for (int t = 0; t < 4; ++t) { const float vv = bf2f(PROJ[((size_t)TP + b * 4 + t) * NPROJ + C_VG + hh * 128 + dv]); float o = 0.f;
#pragma unroll
        for (int k = 0; k < 16; ++k) { const int c = 16 * cg + k; S[k] = la[t * 64 + c] * S[k] + ks[t * 64 + c] * vv; o += qs[t * 64 + c] * S[k]; }
        op[(cg * 4 + t) * 128 + dv] = o; }
    float* so = A.out + O_GLAS + (size_t)(b * 4 + hh) * 8192;
#pragma unroll
    for (int k = 0; k < 16; ++k) so[(16 * cg + k) * 128 + dv] = S[k];
    __syncthreads();
    { const int t = tid >> 7; of[t * 128 + dv] = (op[(0 * 4 + t) * 128 + dv] + op[(1 * 4 + t) * 128 + dv]) + (op[(2 * 4 + t) * 128 + dv] + op[(3 * 4 + t) * 128 + dv]); }
    __syncthreads();
    { const int t = tid >> 7; float ss = 0.f;
      for (int k = 0; k < 128; ++k) { const float v = of[t * 128 + k]; ss += v * v; }
      const float rstd = 1.0f / sqrtf(ss * (1.0f / 128.0f) + EPS); const size_t tok = (size_t)TP + b * 4 + t;
      const float gv = bf2f(PROJ[tok * NPROJ + C_GG + hh * 128 + dv]);
      const float y = of[t * 128 + dv] * rstd * A.in[15][dv] * gv / (1.0f + __expf(-gv));
      ((bf16*)(A.ws + WS_MIX))[tok * 1024 + 512 + hh * 128 + dv] = (bf16)f2bf(y); }
}

#ifdef PROBE_PHASE
#define PREP(k) ((PROBE_PHASE) == (k) ? 2 : 1)
#else
#define PREP(k) 1
#endif
__device__ __forceinline__ void phase2(const Frame& F, const Args& A) {
    LAS unsigned char* sh = F.lds;
    _Pragma("unroll 1") for (int rep = 0; rep < PREP(21); ++rep) { const int gw = F.vcu * NWAVES + F.wave, NGW = F.G * NWAVES; constexpr int NJP = 4 * 2 * 2 * 9, NJS = 32 * 2 * 2 * 17;
      for (int job = gw; job < NJP + NJS; job += NGW) {
          if (job >= NJS) { const int j = job - NJS; const int grp = j % 9, g = (j / 9) & 1, slot = (j / 18) & 1, b = j / 36;
#ifndef SKIP_CMP
 cmp_job<false>(A, b, slot, g, grp, opaque(F.lane));
#endif
 }
          else { const int grp = job % 17, g = (job / 17) & 1, slot = (job / 34) & 1, b = job / 68;
#ifndef SKIP_CMP
 cmp_job<true>(A, b, slot, g, grp, opaque(F.lane));
#endif
 }
      } }
    #ifndef SKIP_GLAL
    _Pragma("unroll 1") for (int rep = 0; rep < PREP(22); ++rep) for (int u = F.vcu; u < 256; u += F.G) gla_local(F, A, sh, u);
#endif
    #ifndef SKIP_GLAS
    _Pragma("unroll 1") for (int rep = 0; rep < PREP(24); ++rep) for (int u = F.vcu; u < 128; u += F.G) gla_sample(F, A, sh, u);
#endif
    __syncthreads();
    attn_fill_lut((LAS float*)(sh + AT_LUT), A.in[24], F.tid);
    __syncthreads();
    _Pragma("unroll 1") for (int rep = 0; rep < PREP(23); ++rep) for (int p = F.vcu; p < 256; p += F.G) { const int bg = p >> 5, s = p & 31;
#ifndef SKIP_WIN
 win_unit(F, A, sh, bg >> 1, bg & 1, 63 - s); win_unit(F, A, sh, bg >> 1, bg & 1, s);
#endif
 }
}
__device__ __forceinline__ void phase3(const Frame& F, const Args& A) {
    LAS unsigned char* sh = F.lds;
    #ifndef SKIP_GLAO
    _Pragma("unroll 1") for (int rep = 0; rep < PREP(31); ++rep) for (int u = F.vcu; u < 256; u += F.G) gla_out(F, A, sh, u);
#endif
    __syncthreads();
    attn_fill_lut((LAS float*)(sh + AT_LUT), A.in[24], F.tid);
    __syncthreads();
    #ifndef SKIP_SAMP
    _Pragma("unroll 1") for (int rep = 0; rep < PREP(32); ++rep) for (int u = F.vcu; u < 64; u += F.G) samp_unit(F, A, sh, u >> 1, u & 1);
#endif
    _Pragma("unroll 1") for (int rep = 0; rep < PREP(33); ++rep) for (int p = F.vcu; p < 256; p += F.G) { const int bg = p >> 5, s = p & 31;
#ifndef SKIP_NSA
 nsa_unit(F, A, sh, bg >> 1, bg & 1, 63 - s); nsa_unit(F, A, sh, bg >> 1, bg & 1, s);
#endif
 }
}

typedef const __attribute__((address_space(4))) Args* ArgsP;
__device__ __forceinline__ Args load_args() {
    Args r{};
#if defined(__HIP_DEVICE_COMPILE__)
    ArgsP p = (ArgsP)__builtin_amdgcn_kernarg_segment_ptr(); asm volatile("" : "+s"(p));
#pragma unroll
    for (int i = 0; i < 26; ++i) r.in[i] = p->in[i];
    r.out = p->out; r.ws = p->ws; r.ph_lo = p->ph_lo; r.ph_hi = p->ph_hi;
#endif
    return r;
}
__global__ void __launch_bounds__(NWAVES * 64, 2) mega_fwd(Args args_unused) {
    extern __shared__ __attribute__((aligned(16))) unsigned char lds_raw[];
    Frame F;
    F.lds = (LAS unsigned char*)lds_raw;
    F.wave = __builtin_amdgcn_readfirstlane((int)threadIdx.x >> 6); F.lane = hw_lane(); F.tid = F.wave * 64 + F.lane;
    F.G = gridDim.x; { const int bx = blockIdx.x; F.vcu = (F.G % 8 == 0) ? (bx % 8) * (F.G / 8) + bx / 8 : bx; }
    int lo, hi; unsigned char* ws;
    { const Args a0 = load_args(); lo = a0.ph_lo; hi = a0.ph_hi; ws = a0.ws; }
    gu32* ctl = (gu32*)(ws + WS_CTL);
    volatile LAS unsigned* MISC = (volatile LAS unsigned*)(F.lds + MISC_OFF);
    for (int u = F.tid; u < (LDS_BYTES - RING_BYTES) / 4; u += NWAVES * 64) ((LAS unsigned*)(F.lds + RING_BYTES))[u] = 0u;
    __syncthreads();
    const bool multi = (hi - lo) > 1;
    XcdBarrier bar; bar.bar = (unsigned*)(ctl + CW_BAR); bar.x = 0; bar.st = nullptr;
    if (multi) bar = xcd_barrier_post((unsigned*)(ctl + CW_BAR), MISC + 8, F.tid);
#define IN(k) (lo <= (k) && (k) < hi)
#ifdef PROBE_PHASE
#define NREP(k) ((PROBE_PHASE) == (k) ? 2 : 1)
#else
#define NREP(k) 1
#endif
    float* dummy_rowss = (float*)(ws + WS_END);
#define SEAM(k) do { if (IN(k) && IN((k) + 1)) { F.lane = hw_lane(); F.tid = F.wave * 64 + F.lane; xcd_barrier(bar, F.tid); } } while (0)
#define REFRESH() do { F.lane = hw_lane(); F.tid = F.wave * 64 + F.lane; } while (0)

    if (IN(0)) { REFRESH(); const Args args = load_args(); _Pragma("unroll 1") for (int rep = 0; rep < NREP(0); ++rep) { __syncthreads(); p0_prologue(F, args); } } SEAM(0);
    if (IN(1)) { REFRESH(); const Args args = load_args(); unsigned char* ws = args.ws;
        pg8::Gemm g{(const pg8::bf16_t*)(ws + WS_XN), (const pg8::bf16_t*)(ws + WS_WIN), MPAD, NPROJ, 1024}; pg8::StaticOrder S; S.init(MPAD, NPROJ, F.G, (int)blockIdx.x);
        pg8::EpiInProj E{(pg8::bf16_t*)(ws + WS_PROJ), args.out};
        _Pragma("unroll 1") for (int rep = 0; rep < NREP(1); ++rep) pg8::gemm_phase<pg8::EpiInProj, pg8::StaticOrder, true, true>(F.lds, g, S, E, F.tid);
    } SEAM(1);
    if (IN(2)) { REFRESH(); const Args args = load_args(); phase2(F, args); } SEAM(2);
    if (IN(3)) { REFRESH(); const Args args = load_args(); phase3(F, args); } SEAM(3);
    if (IN(4)) { REFRESH(); const Args args = load_args(); unsigned char* ws = args.ws; float* rowss1 = (float*)(ws + WS_ROWSS);
        { pg8::Gemm g{(const pg8::bf16_t*)(ws + WS_MIX), (const pg8::bf16_t*)(ws + WS_WO), MPAD, 1024, 1024}; pg8::StaticOrder S; S.init(MPAD, 1024, F.G, (int)blockIdx.x);
          _Pragma("unroll 1") for (int rep = 0; rep < NREP(4); ++rep) { pg8::EpiResid E{args.in[0], args.in[1], (float*)(ws + WS_H1), (pg8::bf16_t*)(ws + WS_H1B), rep ? dummy_rowss : rowss1};
          pg8::gemm_phase<pg8::EpiResid, pg8::StaticOrder, true, true>(F.lds, g, S, E, F.tid); } }
        { pg8::Gemm g{(const pg8::bf16_t*)(ws + WS_PPLE), (const pg8::bf16_t*)(ws + WS_WPLE), MPAD, 1024, 256}; pg8::StaticOrder S; S.init(MPAD, 1024, F.G, (int)blockIdx.x);
          pg8::EpiBf E{(pg8::bf16_t*)(ws + WS_PLEB), 1024};
          _Pragma("unroll 1") for (int rep = 0; rep < NREP(41); ++rep) pg8::gemm_phase<pg8::EpiBf, pg8::StaticOrder, true, true>(F.lds, g, S, E, F.tid); }
    } SEAM(4);
    if (IN(5)) { REFRESH(); const Args args = load_args(); unsigned char* ws = args.ws; float* rowss1 = (float*)(ws + WS_ROWSS);
        pg8::Gemm g{(const pg8::bf16_t*)(ws + WS_H1B), (const pg8::bf16_t*)(ws + WS_WGU), MPAD, NGU, 1024}; pg8::StaticOrder S; S.init(MPAD, NGU, F.G, (int)blockIdx.x);
        pg8::EpiGateUp E{(pg8::bf16_t*)(ws + WS_ACT), rowss1};
        _Pragma("unroll 1") for (int rep = 0; rep < NREP(5); ++rep) pg8::gemm_phase<pg8::EpiGateUp, pg8::StaticOrder, true, true>(F.lds, g, S, E, F.tid);
    } SEAM(5);
    if (IN(6)) { REFRESH(); const Args args = load_args(); unsigned char* ws = args.ws; float* rowss2 = (float*)(ws + WS_ROWSS) + MPAD;
        pg8::Gemm g{(const pg8::bf16_t*)(ws + WS_ACT), (const pg8::bf16_t*)(ws + WS_WDN), MPAD, 1024, DFF}; pg8::StaticOrder S; S.init(MPAD, 1024, F.G, (int)blockIdx.x);
        _Pragma("unroll 1") for (int rep = 0; rep < NREP(6); ++rep) { pg8::EpiResid E{(const float*)(ws + WS_H1), (const float*)(ws + WS_H1) + (size_t)TP * 1024, (float*)(ws + WS_H2), (pg8::bf16_t*)(ws + WS_H2B), rep ? dummy_rowss : rowss2};
        pg8::gemm_phase<pg8::EpiResid, pg8::StaticOrder, true, true>(F.lds, g, S, E, F.tid); }
    } SEAM(6);
    if (IN(7)) { REFRESH(); const Args args = load_args(); unsigned char* ws = args.ws; float* rowss2 = (float*)(ws + WS_ROWSS) + MPAD; float* rowss3 = rowss2 + MPAD;
        pg8::Gemm g{(const pg8::bf16_t*)(ws + WS_H2B), (const pg8::bf16_t*)(ws + WS_WPG), MPAD, 1024, 1024}; pg8::StaticOrder S; S.init(MPAD, 1024, F.G, (int)blockIdx.x);
        _Pragma("unroll 1") for (int rep = 0; rep < NREP(7); ++rep) { pg8::EpiPleGate E{(const float*)(ws + WS_H2), (const pg8::bf16_t*)(ws + WS_PLEB), rowss2, args.out + O_Y, rep ? dummy_rowss : rowss3};
        pg8::gemm_phase<pg8::EpiPleGate, pg8::StaticOrder, true, true>(F.lds, g, S, E, F.tid); }
    } SEAM(7);
    if (IN(8)) { REFRESH(); const Args args = load_args(); unsigned char* ws = args.ws; float* rowss3 = (float*)(ws + WS_ROWSS) + 2 * MPAD;
        const int gw = F.vcu * NWAVES + F.wave, NGW = F.G * NWAVES; const GAS f32x4* gr = (const GAS f32x4*)args.in[25] + F.lane;
        for (int m = gw; m < MTOT; m += NGW) { GAS f32x4* yr = (GAS f32x4*)(args.out + O_Y + (size_t)m * 1024) + F.lane; const float rstd = 1.0f / sqrtf(rowss3[m] * (1.0f / 1024.0f) + EPS);
#pragma unroll
            for (int j = 0; j < 4; ++j) { const f32x4 v = yr[64 * j], gg = gr[64 * j]; yr[64 * j] = (f32x4){v.x * rstd * gg.x, v.y * rstd * gg.y, v.z * rstd * gg.z, v.w * rstd * gg.w}; } }
    }
#undef IN
#undef SEAM
#undef REFRESH
}

extern "C" void kernel_launch(void* const* d_in, const int* in_sizes, int n_in, void* d_out, int out_size, void* d_ws, size_t ws_size, hipStream_t stream) {
    static int grid = 0;
    if (grid == 0) {
        if (n_in != 26 || (size_t)out_size != O_END || ws_size < WS_END + (1u << 20)) { fprintf(stderr, "kernel_launch: unexpected shapes: n_in %d out %d ws %zu\n", n_in, out_size, ws_size); grid = -1; return; }
        int dev = 0, cus = 0, per_cu = 0;
        if (hipGetDevice(&dev) != hipSuccess || hipDeviceGetAttribute(&cus, hipDeviceAttributeMultiprocessorCount, dev) != hipSuccess) { grid = -1; return; }
        if (hipFuncSetAttribute((const void*)mega_fwd, hipFuncAttributeMaxDynamicSharedMemorySize, LDS_BYTES) != hipSuccess) { fprintf(stderr, "kernel_launch: hipFuncSetAttribute failed\n"); grid = -1; return; }
        if (hipOccupancyMaxActiveBlocksPerMultiprocessor(&per_cu, (const void*)mega_fwd, NWAVES * 64, LDS_BYTES) != hipSuccess || per_cu < 1) { fprintf(stderr, "kernel_launch: occupancy query says %d blocks per CU\n", per_cu); grid = -1; return; }
        (void)hipGetLastError();
        grid = cus;
    }
    if (grid < 0) return;
    (void)hipMemsetAsync((char*)d_ws + WS_CTL, 0, CTL_ZERO_BYTES, stream);
    Args a{};
    for (int i = 0; i < 26; ++i) a.in[i] = (const float*)d_in[i];
    a.out = (float*)d_out; a.ws = (unsigned char*)d_ws;
#ifndef N_LAUNCH_SPLIT
    a.ph_lo = 0; a.ph_hi = 9;
    hipLaunchKernelGGL(mega_fwd, dim3(grid), dim3(NWAVES * 64), LDS_BYTES, stream, a);
#else
    for (int p = 0; p < 9; ++p) { a.ph_lo = p; a.ph_hi = p + 1; hipLaunchKernelGGL(mega_fwd, dim3(grid), dim3(NWAVES * 64), LDS_BYTES, stream, a); }
#endif
}
```

```cpp
#include <hip/hip_runtime.h>
#include <cstdio>
#include <cstdint>

constexpr int DM = 1024, TP = 16384, TS = 128, MTOT = TP + TS, MPAD = 16640, SEQ = 4096, NBATCH = 4, DBATCH = 32, DSEQ = 4, PAST = 8192;
constexpr int NPROJ = 3072, DFF = 2816, DPLE = 256, NGU = 2 * DFF;
constexpr int C_QN = 0, C_KV = 512, C_WIN = 1024, C_GT = 1280, C_QG = 1304, C_KG = 1560, C_VG = 1816, C_LR = 2328, C_GG = 2344, NIN = 2856;
constexpr float EPS = 1e-6f;
constexpr size_t O_Y = 0, O_KV = (size_t)MTOT * 1024, O_WINP = O_KV + (size_t)MTOT * 512, O_WINS = O_WINP + 4 * 512 * 256,
                 O_GLAP = O_WINS + (size_t)32 * 512 * 256, O_GLAS = O_GLAP + 4 * 4 * 64 * 128, O_END = O_GLAS + (size_t)32 * 4 * 64 * 128;
namespace pg8 {
#define PG8_LAS __attribute__((address_space(3)))
typedef unsigned short bf16_t;
typedef short bf16x8 __attribute__((ext_vector_type(8)));
typedef float f32x4 __attribute__((ext_vector_type(4)));
typedef unsigned u32x4 __attribute__((ext_vector_type(4)));
constexpr int BM = 256, BK = 64, HALF = 128, HTB = HALF * BK * 2  , STAGE_BYTES = 8 * HTB, NXCD = 8, WGM = 8;

__host__ __device__ __forceinline__ int lds_byte(int r, int c) { const int st = (r >> 4) * 2 + (c >> 5), rr = r & 15, cc = c & 31, ob = rr * 64 + cc * 2; return st * 1024 + (ob ^ (((ob >> 9) & 1) << 5)); }
__host__ __device__ __forceinline__ void stage_rc(int b, int& R, int& C) { const int st = b / 1024, sb = b % 1024, swz = sb ^ (((sb >> 9) & 1) << 5); R = (st >> 1) * 16 + swz / 64; C = (st & 1) * 32 + (swz % 64) / 2; }
__host__ __device__ __forceinline__ int perm32(int rho) { const int n = rho >> 4, i = rho & 15; return 8 * (i >> 2) + 4 * n + (i & 3); }

struct Unit { int pm, pn; };
struct Gemm { const bf16_t* A; const bf16_t* Bt; int M, N, K; };

struct StaticOrder {
    int nM, nN, nwg, G, c;
    __host__ __device__ void init(int M, int N, int G_, int c_) { nM = M / BM; nN = N / BM; nwg = nM * nN; G = G_; c = c_; }
    __host__ __device__ bool next(int i, Unit& u) const {
        const long L = (long)i * G + c; if (L >= nwg) return false;
        int wgid = (int)L; { const int q = nwg / NXCD, r = nwg % NXCD, xcd = wgid % NXCD, off = wgid / NXCD; wgid = (xcd < r ? xcd * (q + 1) : r * (q + 1) + (xcd - r) * q) + off; }
        const int nig = WGM * nN, gid = wgid / nig, fm = gid * WGM, gsz = (nM - fm) < WGM ? (nM - fm) : WGM;
        u.pm = fm + ((wgid % nig) % gsz); u.pn = (wgid % nig) / gsz; return true;
    }
    __device__ __forceinline__ void a_ready(const Unit&) const {}
    __device__ __forceinline__ void done(const Unit&) const {}
};

__device__ __forceinline__ unsigned cvt_pk_bf16(float lo, float hi) { unsigned r; asm volatile("v_cvt_pk_bf16_f32 %0, %1, %2" : "=v"(r) : "v"(lo), "v"(hi)); return r; }

__device__ __forceinline__ u32x4 pack8(const f32x4 v0, const f32x4 v1) { u32x4 w; w.x = cvt_pk_bf16(v0[0], v0[1]); w.y = cvt_pk_bf16(v0[2], v0[3]); w.z = cvt_pk_bf16(v1[0], v1[1]); w.w = cvt_pk_bf16(v1[2], v1[3]); return w; }

struct EpiInProj {
    static constexpr bool PERM = true, AFTER_DRAIN = false;
    bf16_t* proj; float* out;
    __device__ __forceinline__ void operator()(const f32x4 (&acc)[2][2][4][2], const Unit& u, int wr, int wc, int fr, int fq) const {
        const int row0 = u.pm * BM + wr * 64 + fr, colb = u.pn * BM + wc * 32 + 8 * fq;
        const float sc = (u.pn < 2) ? 0.125f : 1.0f;
#pragma unroll
        for (int ai = 0; ai < 2; ++ai)
#pragma unroll
            for (int m = 0; m < 4; ++m) {
                const int r = row0 + ai * HALF + m * 16;
                if (r < MTOT) {
#pragma unroll
                    for (int bj = 0; bj < 2; ++bj) {
                        const int c = colb + bj * HALF;
                        const f32x4 v0 = acc[ai][bj][m][0] * sc, v1 = acc[ai][bj][m][1] * sc;
                        *(u32x4*)(proj + (size_t)r * NPROJ + c) = pack8(v0, v1);
                        if (u.pn == 2 || u.pn == 3) { float* o = out + O_KV + (size_t)r * 512 + (c - C_KV); *(f32x4*)o = v0; *(f32x4*)(o + 4) = v1; }
                        if (u.pn == 4) {
                            const int cc = c - C_WIN; float* o = nullptr;
                            if (r < TP) { const int pos = r & (SEQ - 1), b = r >> 12; if (pos >= SEQ - 512) o = out + O_WINP + ((size_t)(b * 512 + pos - (SEQ - 512)) * 256 + cc); }
                            else { const int rs = r - TP, b = rs >> 2, i = rs & 3; o = out + O_WINS + ((size_t)(b * 512 + 508 + i) * 256 + cc); }
                            if (o) { *(f32x4*)o = v0; *(f32x4*)(o + 4) = v1; }
                        }
                    }
                }
            }
    }
};
struct EpiResid {
    static constexpr bool PERM = true, AFTER_DRAIN = false;
    const float* baseA; const float* baseB;
    float* hout; bf16_t* hb; float* rowss;
    __device__ __forceinline__ void operator()(const f32x4 (&acc)[2][2][4][2], const Unit& u, int wr, int wc, int fr, int fq) const {
        const int row0 = u.pm * BM + wr * 64 + fr, colb = u.pn * BM + wc * 32 + 8 * fq;
#pragma unroll
        for (int ai = 0; ai < 2; ++ai)
#pragma unroll
            for (int m = 0; m < 4; ++m) {
                const int r = row0 + ai * HALF + m * 16;
                float ss = 0.f;
                if (r < MTOT) {
                    const float* bp = (r < TP) ? baseA + (size_t)r * 1024 : baseB + (size_t)(r - TP) * 1024;
#pragma unroll
                    for (int bj = 0; bj < 2; ++bj) {
                        const int c = colb + bj * HALF;
                        const f32x4 v0 = acc[ai][bj][m][0] + *(const f32x4*)(bp + c), v1 = acc[ai][bj][m][1] + *(const f32x4*)(bp + c + 4);
                        float* o = hout + (size_t)r * 1024 + c; *(f32x4*)o = v0; *(f32x4*)(o + 4) = v1;
                        *(u32x4*)(hb + (size_t)r * 1024 + c) = pack8(v0, v1);
                        ss += (v0[0] * v0[0] + v0[1] * v0[1]) + (v0[2] * v0[2] + v0[3] * v0[3]) + (v1[0] * v1[0] + v1[1] * v1[1]) + (v1[2] * v1[2] + v1[3] * v1[3]);
                    }
                }
                ss += __shfl_xor(ss, 16); ss += __shfl_xor(ss, 32);
                if (fq == 0 && r < MTOT) atomicAdd(rowss + r, ss);
            }
    }
};
struct EpiGateUp {
    static constexpr bool PERM = true, AFTER_DRAIN = false;
    bf16_t* act; const float* rowss;
    __device__ __forceinline__ void operator()(const f32x4 (&acc)[2][2][4][2], const Unit& u, int wr, int wc, int fr, int fq) const {
        const int row0 = u.pm * BM + wr * 64 + fr, colb = u.pn * HALF + wc * 32 + 8 * fq;
#pragma unroll
        for (int ai = 0; ai < 2; ++ai)
#pragma unroll
            for (int m = 0; m < 4; ++m) {
                const int r = row0 + ai * HALF + m * 16;
                if (r < MTOT) {
                    const float rstd = __builtin_amdgcn_rsqf(rowss[r] * (1.0f / 1024.0f) + EPS);
                    f32x4 o[2];
#pragma unroll
                    for (int n = 0; n < 2; ++n)
#pragma unroll
                        for (int e = 0; e < 4; ++e) { const float g = acc[ai][0][m][n][e] * rstd, up = acc[ai][1][m][n][e] * rstd; o[n][e] = g * up * __builtin_amdgcn_rcpf(1.0f + __expf(-g)); }
                    *(u32x4*)(act + (size_t)r * DFF + colb) = pack8(o[0], o[1]);
                }
            }
    }
};
struct EpiBf {
    static constexpr bool PERM = true, AFTER_DRAIN = false;
    bf16_t* O; int ldc;
    __device__ __forceinline__ void operator()(const f32x4 (&acc)[2][2][4][2], const Unit& u, int wr, int wc, int fr, int fq) const {
        const int row0 = u.pm * BM + wr * 64 + fr, colb = u.pn * BM + wc * 32 + 8 * fq;
#pragma unroll
        for (int ai = 0; ai < 2; ++ai)
#pragma unroll
            for (int m = 0; m < 4; ++m) {
                const int r = row0 + ai * HALF + m * 16;
                if (r < MTOT) {
#pragma unroll
                    for (int bj = 0; bj < 2; ++bj) *(u32x4*)(O + (size_t)r * ldc + colb + bj * HALF) = pack8(acc[ai][bj][m][0], acc[ai][bj][m][1]);
                }
            }
    }
};
struct EpiPleGate {
    static constexpr bool PERM = true, AFTER_DRAIN = false;
    const float* h2; const bf16_t* ple; const float* rowss2; float* y; float* rowss3;
    __device__ __forceinline__ void operator()(const f32x4 (&acc)[2][2][4][2], const Unit& u, int wr, int wc, int fr, int fq) const {
        const int row0 = u.pm * BM + wr * 64 + fr, colb = u.pn * BM + wc * 32 + 8 * fq;
#pragma unroll
        for (int ai = 0; ai < 2; ++ai)
#pragma unroll
            for (int m = 0; m < 4; ++m) {
                const int r = row0 + ai * HALF + m * 16;
                float ss = 0.f;
                if (r < MTOT) {
                    const float rstd = __builtin_amdgcn_rsqf(rowss2[r] * (1.0f / 1024.0f) + EPS);
#pragma unroll
                    for (int bj = 0; bj < 2; ++bj) {
                        const int c = colb + bj * HALF;
                        const u32x4 pw = *(const u32x4*)(ple + (size_t)r * 1024 + c);
                        const f32x4 b0 = *(const f32x4*)(h2 + (size_t)r * 1024 + c), b1 = *(const f32x4*)(h2 + (size_t)r * 1024 + c + 4);
                        float pv[8];
#pragma unroll
                        for (int e = 0; e < 4; ++e) { pv[2 * e] = __uint_as_float(pw[e] << 16); pv[2 * e + 1] = __uint_as_float(pw[e] & 0xffff0000u); }
                        f32x4 v0, v1;
#pragma unroll
                        for (int e = 0; e < 4; ++e) {
                            v0[e] = b0[e] + pv[e] * __builtin_amdgcn_rcpf(1.0f + __expf(-acc[ai][bj][m][0][e] * rstd));
                            v1[e] = b1[e] + pv[4 + e] * __builtin_amdgcn_rcpf(1.0f + __expf(-acc[ai][bj][m][1][e] * rstd));
                        }
                        float* o = y + (size_t)r * 1024 + c; *(f32x4*)o = v0; *(f32x4*)(o + 4) = v1;
                        ss += (v0[0] * v0[0] + v0[1] * v0[1]) + (v0[2] * v0[2] + v0[3] * v0[3]) + (v1[0] * v1[0] + v1[1] * v1[1]) + (v1[2] * v1[2] + v1[3] * v1[3]);
                    }
                }
                ss += __shfl_xor(ss, 16); ss += __shfl_xor(ss, 32);
                if (fq == 0 && r < MTOT) atomicAdd(rowss3 + r, ss);
            }
    }
};
template <class Epi, class Sched, bool ALIGN_EPI = false, bool SP2 = false>
__device__ __forceinline__ void gemm_phase(PG8_LAS unsigned char* lds, const Gemm g, const Sched& S, const Epi& E, const int tid) {
    const int wid = __builtin_amdgcn_readfirstlane(tid >> 6), lane = tid & 63, wr = wid >> 2, wc = wid & 3, fr = lane & 15, fq = lane >> 4;
    const int K = g.K, nt = K / BK;
    unsigned voffA[2], voffB[2];
#pragma unroll
    for (int i = 0; i < 2; ++i) { int R, C; stage_rc(tid * 16 + i * 8192, R, C); const int Rb = Epi::PERM ? ((R & ~31) + perm32(R & 31)) : R;
        voffA[i] = (unsigned)(R * K + C) * 2u; voffB[i] = (unsigned)(Rb * K + C) * 2u; }
    const size_t kstep = (size_t)(BK * 2);
    const size_t hstep = (size_t)HALF * K * 2;
    const size_t tstep = 2 * hstep;
    const unsigned ldsw = (unsigned)wid * 1024u;
    const int aoff = lds_byte(wr * 64 + fr, fq * 8), boff = lds_byte(wc * 32 + fr, fq * 8);
#define PG8_SA(b, h) (((b) * 2 + (h)) * HTB)
#define PG8_SB(b, h) ((4 + (b) * 2 + (h)) * HTB)
#define PG8_STAGE(bufoff, gbase, voff) do { _Pragma("unroll") for (int _i = 0; _i < 2; ++_i) \
        __builtin_amdgcn_global_load_lds((const unsigned*)((const char*)(gbase) + (voff)[_i]), (PG8_LAS unsigned*)(lds + (bufoff) + ldsw + _i * 8192), 16, 0, 0); } while (0)
#define PG8_LDA(dst, b, h) do { _Pragma("unroll") for (int m = 0; m < 4; ++m) _Pragma("unroll") for (int k = 0; k < 2; ++k) dst[m][k] = *(const PG8_LAS bf16x8*)(lds + PG8_SA(b, h) + aoff + m * 2048 + k * 1024); } while (0)
#define PG8_LDB(dst, b, h) do { _Pragma("unroll") for (int n = 0; n < 2; ++n) _Pragma("unroll") for (int k = 0; k < 2; ++k) dst[n][k] = *(const PG8_LAS bf16x8*)(lds + PG8_SB(b, h) + boff + n * 2048 + k * 1024); } while (0)
#define PG8_MMA(ai, bj, At, Bt) do { __builtin_amdgcn_s_setprio(1); _Pragma("unroll") for (int m = 0; m < 4; ++m) _Pragma("unroll") for (int n = 0; n < 2; ++n) _Pragma("unroll") for (int k = 0; k < 2; ++k) \
        acc[ai][bj][m][n] = __builtin_amdgcn_mfma_f32_16x16x32_bf16(Bt[n][k], At[m][k], acc[ai][bj][m][n], 0, 0, 0); __builtin_amdgcn_s_setprio(0); } while (0)
#define PG8_WAIT_V(n) asm volatile("s_waitcnt vmcnt(" #n ")" ::: "memory")
#define PG8_WAIT_L(n) asm volatile("s_waitcnt lgkmcnt(" #n ")" ::: "memory")
#define PG8_BAR __builtin_amdgcn_s_barrier()
#define PG8_SCHED __builtin_amdgcn_sched_barrier(0)
    Unit cur, nxt; int ui = 0;
    if (!S.next(0, cur)) return;
    f32x4 acc[2][2][4][2];
#pragma unroll
    for (int a = 0; a < 2; ++a)
#pragma unroll
        for (int b = 0; b < 2; ++b)
#pragma unroll
            for (int m = 0; m < 4; ++m)
#pragma unroll
                for (int n = 0; n < 2; ++n) acc[a][b][m][n] = (f32x4){0.f, 0.f, 0.f, 0.f};
    bf16x8 At[4][2], B0[2][2], B1[2][2];
    const char* cA = (const char*)g.A + (size_t)cur.pm * tstep; const char* cB = (const char*)g.Bt + (size_t)cur.pn * tstep;
    S.a_ready(cur);
    if constexpr (SP2) {
        PG8_STAGE(PG8_SB(0, 0), cB, voffB); PG8_STAGE(PG8_SB(0, 1), cB + hstep, voffB); PG8_STAGE(PG8_SA(0, 0), cA, voffA); PG8_STAGE(PG8_SA(0, 1), cA + hstep, voffA);
        if (wr == 1) PG8_BAR;
        PG8_WAIT_V(2); PG8_BAR;
        PG8_STAGE(PG8_SB(1, 0), cB + kstep, voffB); PG8_STAGE(PG8_SA(1, 0), cA + kstep, voffA); PG8_STAGE(PG8_SB(1, 1), cB + hstep + kstep, voffB);
        PG8_WAIT_V(6); PG8_BAR;
    } else {
        PG8_STAGE(PG8_SB(0, 0), cB, voffB); PG8_STAGE(PG8_SA(0, 0), cA, voffA); PG8_STAGE(PG8_SB(0, 1), cB + hstep, voffB); PG8_STAGE(PG8_SA(0, 1), cA + hstep, voffA);
        if (wr == 1) PG8_BAR;
        PG8_WAIT_V(4); PG8_BAR;
        PG8_STAGE(PG8_SB(1, 0), cB + kstep, voffB); PG8_STAGE(PG8_SA(1, 0), cA + kstep, voffA); PG8_STAGE(PG8_SB(1, 1), cB + hstep + kstep, voffB);
        PG8_WAIT_V(6); PG8_BAR;
    }
    for (;;) {
        const bool has_next = S.next(ui + 1, nxt);
        const char* nA = has_next ? (const char*)g.A + (size_t)nxt.pm * tstep : cA; const char* nB = has_next ? (const char*)g.Bt + (size_t)nxt.pn * tstep : cB;
        for (int t = 0; t < nt; t += 2) {
            const bool last = (t == nt - 2);
            const char* a1 = cA + (size_t)(t + 1) * kstep;
            const char* a2 = last ? nA : cA + (size_t)(t + 2) * kstep; const char* b2 = last ? nB : cB + (size_t)(t + 2) * kstep;
            const char* a3 = a2 + kstep; const char* b3 = b2 + kstep;
            if (last && has_next) S.a_ready(nxt);
            if constexpr (SP2) {
            PG8_LDB(B0, 0, 0); PG8_LDB(B1, 0, 1); PG8_SCHED; PG8_LDA(At, 0, 0); PG8_STAGE(PG8_SA(1, 1), a1 + hstep, voffA);
            PG8_WAIT_V(8); PG8_WAIT_L(0); PG8_BAR; PG8_MMA(0, 0, At, B0); PG8_MMA(0, 1, At, B1); PG8_BAR; PG8_SCHED;
            PG8_LDA(At, 0, 1); PG8_STAGE(PG8_SB(0, 0), b2, voffB); PG8_STAGE(PG8_SB(0, 1), b2 + hstep, voffB); PG8_STAGE(PG8_SA(0, 0), a2, voffA);
            PG8_WAIT_V(8); PG8_WAIT_L(0); PG8_BAR; PG8_MMA(1, 0, At, B0); PG8_MMA(1, 1, At, B1); PG8_BAR; PG8_SCHED;
            PG8_LDB(B0, 1, 0); PG8_LDB(B1, 1, 1); PG8_SCHED; PG8_LDA(At, 1, 0); PG8_STAGE(PG8_SA(0, 1), a2 + hstep, voffA);
            PG8_WAIT_V(8); PG8_WAIT_L(0); PG8_BAR; PG8_MMA(0, 0, At, B0); PG8_MMA(0, 1, At, B1); PG8_BAR; PG8_SCHED;
            PG8_LDA(At, 1, 1); PG8_STAGE(PG8_SB(1, 0), b3, voffB); PG8_STAGE(PG8_SB(1, 1), b3 + hstep, voffB); PG8_STAGE(PG8_SA(1, 0), a3, voffA);
            PG8_WAIT_V(8); PG8_WAIT_L(0); PG8_BAR; PG8_MMA(1, 0, At, B0); PG8_MMA(1, 1, At, B1); PG8_BAR; PG8_SCHED;
            } else {
            PG8_LDB(B0, 0, 0); PG8_SCHED; PG8_LDA(At, 0, 0); PG8_STAGE(PG8_SA(1, 1), a1 + hstep, voffA);
            PG8_WAIT_L(8); PG8_BAR; PG8_WAIT_L(0); PG8_MMA(0, 0, At, B0); PG8_BAR; PG8_SCHED;
            PG8_LDB(B1, 0, 1); PG8_STAGE(PG8_SB(0, 0), b2, voffB);
            PG8_BAR; PG8_WAIT_L(0); PG8_MMA(0, 1, At, B1); PG8_BAR;
            PG8_LDA(At, 0, 1); PG8_STAGE(PG8_SA(0, 0), a2, voffA);
            PG8_BAR; PG8_WAIT_L(0); PG8_MMA(1, 0, At, B0); PG8_BAR; PG8_SCHED;
            PG8_STAGE(PG8_SB(0, 1), b2 + hstep, voffB);
            PG8_WAIT_V(6); PG8_BAR; PG8_MMA(1, 1, At, B1); PG8_BAR;
            PG8_LDB(B0, 1, 0); PG8_SCHED; PG8_LDA(At, 1, 0); PG8_STAGE(PG8_SA(0, 1), a2 + hstep, voffA);
            PG8_WAIT_L(8); PG8_BAR; PG8_WAIT_L(0); PG8_MMA(0, 0, At, B0); PG8_BAR; PG8_SCHED;
            PG8_LDB(B1, 1, 1); PG8_STAGE(PG8_SB(1, 0), b3, voffB);
            PG8_BAR; PG8_WAIT_L(0); PG8_MMA(0, 1, At, B1); PG8_BAR;
            PG8_LDA(At, 1, 1); PG8_STAGE(PG8_SA(1, 0), a3, voffA);
            PG8_BAR; PG8_WAIT_L(0); PG8_MMA(1, 0, At, B0); PG8_BAR; PG8_SCHED;
            PG8_STAGE(PG8_SB(1, 1), b3 + hstep, voffB);
            PG8_WAIT_V(6); PG8_BAR; PG8_MMA(1, 1, At, B1); PG8_BAR;
            }
        }
        if constexpr (ALIGN_EPI) { if (wr == 0) PG8_BAR; }
        if constexpr (!Epi::AFTER_DRAIN) { E(acc, cur, wr, wc, fr, fq); S.done(cur); }
        if (!has_next) break;
#pragma unroll
        for (int a = 0; a < 2; ++a)
#pragma unroll
            for (int b = 0; b < 2; ++b)
#pragma unroll
                for (int m = 0; m < 4; ++m)
#pragma unroll
                    for (int n = 0; n < 2; ++n) acc[a][b][m][n] = (f32x4){0.f, 0.f, 0.f, 0.f};
        cur = nxt; cA = nA; cB = nB; ++ui;
        if constexpr (ALIGN_EPI) { if (wr == 1) PG8_BAR; }
    }
    PG8_WAIT_V(0);
    if constexpr (!ALIGN_EPI) { if (wr == 0) PG8_BAR; }
    PG8_BAR;
    if constexpr (Epi::AFTER_DRAIN) { E.fused(acc, cur, wr, wc, fr, fq, lds, wid, lane); S.done(cur); }
#undef PG8_SA
#undef PG8_SB
#undef PG8_STAGE
#undef PG8_LDA
#undef PG8_LDB
#undef PG8_MMA
#undef PG8_WAIT_V
#undef PG8_WAIT_L
#undef PG8_BAR
#undef PG8_SCHED
}
}


#define GAS __attribute__((address_space(1)))
#define LAS __attribute__((address_space(3)))
typedef unsigned short bf16;
typedef unsigned v4u __attribute__((ext_vector_type(4)));
typedef unsigned v2u __attribute__((ext_vector_type(2)));
typedef float f32x4 __attribute__((ext_vector_type(4)));
typedef float f32x2 __attribute__((ext_vector_type(2)));
typedef float f32x16 __attribute__((ext_vector_type(16)));
typedef short bf16x8 __attribute__((ext_vector_type(8)));
typedef short s16x4 __attribute__((ext_vector_type(4)));
typedef GAS unsigned gu32;
#define RLX_AGENT __ATOMIC_RELAXED, __HIP_MEMORY_SCOPE_AGENT
#define LDS_WAIT() asm volatile("s_waitcnt lgkmcnt(0)" ::: "memory")
#define VM_WAIT() asm volatile("s_waitcnt vmcnt(0)" ::: "memory")
__device__ __forceinline__ unsigned f2bf(float f) { unsigned u = __builtin_bit_cast(unsigned, f); return (u + 0x7fffu + ((u >> 16) & 1u)) >> 16; }
__device__ __forceinline__ unsigned pk2(float lo, float hi) { return f2bf(lo) | (f2bf(hi) << 16); }
__device__ __forceinline__ float bf2f(unsigned short h) { return __uint_as_float(((unsigned)h) << 16); }
__device__ __forceinline__ float bflo(unsigned w) { return __uint_as_float(w << 16); }
__device__ __forceinline__ float bfhi(unsigned w) { return __uint_as_float(w & 0xffff0000u); }

constexpr int NWAVES = 8;
constexpr size_t MiB = 1u << 20;
constexpr size_t WS_CTL = 0, CTL_ZERO_BYTES = 1 * MiB;
constexpr int CW_BAR = 4096;
constexpr size_t WS_ROWSS = 256 * 1024;
constexpr size_t WS_WIN = 2 * MiB;
constexpr size_t WS_WO = 8 * MiB;
constexpr size_t WS_WGU = 10 * MiB;
constexpr size_t WS_WDN = 21 * MiB;
constexpr size_t WS_WPG = 27 * MiB;
constexpr size_t WS_WPLE = 29 * MiB;
constexpr size_t WS_WC1 = 30 * MiB;
constexpr size_t WS_WC2 = 31 * MiB;
constexpr size_t WS_C1 = 31 * MiB + 65536;
constexpr size_t WS_KCP = 32 * MiB;
constexpr size_t WS_VCP = 33 * MiB;
constexpr size_t WS_KCS = 34 * MiB;
constexpr size_t WS_VCS = 38 * MiB;
constexpr size_t WS_DSC = 42 * MiB;
constexpr size_t WS_USC = 43 * MiB;
constexpr size_t WS_QB = 51 * MiB;
constexpr size_t WS_XN = 64 * MiB;
constexpr size_t WS_PPLE = 97 * MiB;
constexpr size_t WS_PROJ = 106 * MiB;
constexpr size_t WS_OWIN = 204 * MiB;
constexpr size_t WS_MIX = 221 * MiB;
constexpr size_t WS_OLOC = 254 * MiB;
constexpr size_t WS_H1 = 287 * MiB;
constexpr size_t WS_H1B = 353 * MiB;
constexpr size_t WS_ACT = 386 * MiB;
constexpr size_t WS_H2 = 476 * MiB;
constexpr size_t WS_H2B = 542 * MiB;
constexpr size_t WS_PLEB = 575 * MiB;
constexpr size_t WS_END = 608 * MiB;
constexpr int RING_BYTES = 131072;
constexpr int MISC_OFF = RING_BYTES + 320;
constexpr int LDS_BYTES = 163840;
#define XB_TMO      128
#define XB_XCNT(j)  (256  + 64 * (j))
#define XB_XSUB(j)  (1280 + 64 * (j))
#define XB_XGEN(j)  (2304 + 64 * (j))
#define XB_TOP      3328
#define XB_TOPGEN   3392
#define XCD_BAR_WORDS 3456
#define XB_SPIN_CAP (1u << 18)

__device__ __forceinline__ unsigned xb_ld(unsigned* p)              { return __hip_atomic_load(p, __ATOMIC_RELAXED, __HIP_MEMORY_SCOPE_AGENT); }
__device__ __forceinline__ unsigned xb_add(unsigned* p, unsigned v) { return __hip_atomic_fetch_add(p, v, __ATOMIC_RELAXED, __HIP_MEMORY_SCOPE_AGENT); }
__device__ __forceinline__ unsigned xb_xcc_id() { return (unsigned)__builtin_amdgcn_s_getreg((3 << 11) | 20) & 0xFu; }
#define XB_SPIN(cond, bar) do { unsigned _sp = 0; while (cond) { __builtin_amdgcn_s_sleep(1); \
    if ((++_sp & 255u) == 0u) { if (xb_ld(&(bar)[XB_TMO])) break; if (_sp > XB_SPIN_CAP) { atomicAdd(&(bar)[XB_TMO], 1u); break; } } } } while (0)

struct XcdBarrier {
    unsigned* bar; unsigned x;
    volatile LAS unsigned* st;
};

__device__ __forceinline__ XcdBarrier xcd_barrier_post(unsigned* bar, volatile LAS unsigned* st, const int tid) {
    XcdBarrier b; b.bar = bar; b.x = xb_xcc_id(); b.st = st;
    if (tid == 0) (void)xb_add(&bar[XB_XCNT(b.x)], 1u);
    return b;
}
__device__ __forceinline__ void xcd_barrier_complete(unsigned* bar, unsigned x, unsigned& nloc, unsigned& nx) {
    const unsigned G = gridDim.x * gridDim.y * gridDim.z;
    unsigned sum, cnt, mine, sp = 0u;
    for (;;) {
        sum = 0u; cnt = 0u; mine = 0u;
#pragma unroll
        for (unsigned j = 0; j < 16; ++j) { const unsigned c = xb_ld(&bar[XB_XCNT(j)]); sum += c; cnt += (c > 0u) ? 1u : 0u; mine = (j == x) ? c : mine; }
        if (sum == G) break;
        __builtin_amdgcn_s_sleep(1);
        if ((++sp & 255u) == 0u) { if (xb_ld(&bar[XB_TMO])) break; if (sp > XB_SPIN_CAP) { atomicAdd(&bar[XB_TMO], 1u); break; } }
    }
    nloc = mine > 0u ? mine : 1u; nx = cnt > 0u ? cnt : 1u;
}

__device__ __forceinline__ void xcd_barrier(const XcdBarrier& b, const int tid) {
    asm volatile("s_waitcnt vmcnt(0)" ::: "memory");
    __syncthreads();
    if (tid == 0) {
        unsigned* bar = b.bar;
        __builtin_amdgcn_s_waitcnt(0);
        unsigned nloc = b.st[0], nx = b.st[1];
        if (nloc == 0u) { xcd_barrier_complete(bar, b.x, nloc, nx); b.st[0] = nloc; b.st[1] = nx; }
        const unsigned old = xb_add(&bar[XB_XSUB(b.x)], 1u);
        const unsigned gen = old / nloc;
        if (old + 1u == (gen + 1u) * nloc) {
            __builtin_amdgcn_fence(__ATOMIC_RELEASE, "agent");
            asm volatile("s_waitcnt vmcnt(0)" ::: "memory");
            const unsigned og = xb_add(&bar[XB_TOP], 1u);
            const unsigned tg = og / nx;
            if (og + 1u == (tg + 1u) * nx) xb_add(&bar[XB_TOPGEN], 1u);
            else XB_SPIN(xb_ld(&bar[XB_TOPGEN]) == tg, bar);
            __builtin_amdgcn_fence(__ATOMIC_ACQUIRE, "agent");
            xb_add(&bar[XB_XGEN(b.x)], 1u);
            asm volatile("s_waitcnt vmcnt(0)" ::: "memory");
        } else {
            XB_SPIN(xb_ld(&bar[XB_XGEN(b.x)]) == gen, bar);
            __builtin_amdgcn_fence(__ATOMIC_ACQUIRE, "agent");
            asm volatile("s_waitcnt vmcnt(0)" ::: "memory");
        }
    }
    __syncthreads();
}

struct Args { const float* in[26]; float* out; unsigned char* ws; int ph_lo, ph_hi; };
struct Frame {
    LAS unsigned char* lds;
    int tid, lane, wave, vcu, G;
};
__device__ __forceinline__ int hw_lane() { int l; asm volatile("v_mbcnt_lo_u32_b32 %0, -1, 0\n\tv_mbcnt_hi_u32_b32 %0, -1, %0" : "=v"(l)); return l; }
__device__ __forceinline__ int opaque(int x) { asm volatile("" : "+v"(x)); return x; }
__device__ __forceinline__ float wave_sum(float v) {
#pragma unroll
    for (int o = 1; o < 64; o <<= 1) v += __shfl_xor(v, o);
    return v;
}
__device__ __forceinline__ void p0_tr_item(const float* W, int ldw, int K, int nsrc, int nblk, bf16* WT, int mode, const float* kscale, LAS float* scr, int item, int lane) {
    const int kb = item / nblk, nb = item % nblk, k0 = 64 * kb, n0 = 32 * nb;
    const int nn = n0 + (lane & 31);
#pragma unroll 8
    for (int i = 0; i < 32; ++i) { const int kk = 2 * i + (lane >> 5); float v = 0.f; if (nn < nsrc) { v = W[(size_t)(k0 + kk) * ldw + nn]; if (kscale) v *= kscale[k0 + kk]; } scr[kk * 33 + (lane & 31)] = v; }
    LDS_WAIT(); asm volatile("" ::: "memory");
    const int c = lane & 7;
#pragma unroll
    for (int j = 0; j < 4; ++j) { const int n = (lane >> 3) + 8 * j; const LAS float* s = scr + (8 * c) * 33 + n;
        v4u o; o.x = pk2(s[0 * 33], s[1 * 33]); o.y = pk2(s[2 * 33], s[3 * 33]); o.z = pk2(s[4 * 33], s[5 * 33]); o.w = pk2(s[6 * 33], s[7 * 33]);
        const int ng = n0 + n; const int drow = (mode == 0) ? ng : (256 * (ng >> 7) + (ng & 127) + (mode == 2 ? 128 : 0));
        *(GAS v4u*)(WT + (size_t)drow * K + k0 + 8 * c) = o; }
    LDS_WAIT(); asm volatile("" ::: "memory");
}
__device__ __forceinline__ void rms_row_to_bf16(const float* xrow, const float* g, bf16* orow, int lane) {
    const GAS f32x4* xr = (const GAS f32x4*)xrow + lane; const GAS f32x4* gr = (const GAS f32x4*)g + lane;
    f32x4 v[4]; float s = 0.f;
#pragma unroll
    for (int j = 0; j < 4; ++j) { v[j] = xr[64 * j]; s += (v[j].x * v[j].x + v[j].y * v[j].y) + (v[j].z * v[j].z + v[j].w * v[j].w); }
    const float rstd = 1.0f / sqrtf(wave_sum(s) * (1.f / DM) + EPS);
    GAS unsigned long long* o8 = (GAS unsigned long long*)orow + lane;
#pragma unroll
    for (int j = 0; j < 4; ++j) { const f32x4 gg = gr[64 * j];
        o8[64 * j] = (unsigned long long)pk2(v[j].x * rstd * gg.x, v[j].y * rstd * gg.y) | ((unsigned long long)pk2(v[j].z * rstd * gg.z, v[j].w * rstd * gg.w) << 32); }
}
__device__ __forceinline__ void p0_prologue(const Frame& F, const Args& A) {
    unsigned char* ws = A.ws;
    LAS float* scr = (LAS float*)(F.lds + F.wave * 16384);
    const int gw = F.vcu * NWAVES + F.wave, NGW = F.G * NWAVES, lane = F.lane;
    constexpr int I_IN = 16 * 96, I_O = 16 * 32, I_G = 16 * 88, I_D = 44 * 32, I_PG = 16 * 32, I_PL = 4 * 32, I_C1 = 2 * 32 * 2, I_C2 = 2 * 1 * 2;
    constexpr int NITEMS = I_IN + I_O + 2 * I_G + I_D + I_PG + I_PL + I_C1 + I_C2;
    for (int it = gw; it < NITEMS; it += NGW) {
        int r = it;
        if (r < I_IN) { p0_tr_item(A.in[9], NIN, 1024, NIN, 96, (bf16*)(ws + WS_WIN), 0, nullptr, scr, r, lane); continue; } r -= I_IN;
        if (r < I_O) { p0_tr_item(A.in[16], 1024, 1024, 1024, 32, (bf16*)(ws + WS_WO), 0, nullptr, scr, r, lane); continue; } r -= I_O;
        if (r < I_G) { p0_tr_item(A.in[18], DFF, 1024, DFF, 88, (bf16*)(ws + WS_WGU), 1, A.in[17], scr, r, lane); continue; } r -= I_G;
        if (r < I_G) { p0_tr_item(A.in[19], DFF, 1024, DFF, 88, (bf16*)(ws + WS_WGU), 2, A.in[17], scr, r, lane); continue; } r -= I_G;
        if (r < I_D) { p0_tr_item(A.in[20], 1024, DFF, 1024, 32, (bf16*)(ws + WS_WDN), 0, nullptr, scr, r, lane); continue; } r -= I_D;
        if (r < I_PG) { p0_tr_item(A.in[23], 1024, 1024, 1024, 32, (bf16*)(ws + WS_WPG), 0, A.in[22], scr, r, lane); continue; } r -= I_PG;
        if (r < I_PL) { p0_tr_item(A.in[21], 1024, 256, 1024, 32, (bf16*)(ws + WS_WPLE), 0, nullptr, scr, r, lane); continue; } r -= I_PL;
        if (r < I_C1) { const int slot = r / 64; p0_tr_item(A.in[11] + (size_t)slot * 2048 * 64, 64, 2048, 64, 2, (bf16*)(ws + WS_WC1) + (size_t)slot * 64 * 2048, 0, nullptr, scr, r % 64, lane); continue; } r -= I_C1;
        { const int slot = r / 2; p0_tr_item(A.in[12] + (size_t)slot * 64 * 64, 64, 64, 64, 2, (bf16*)(ws + WS_WC2) + (size_t)slot * 64 * 64, 0, nullptr, scr, r % 2, lane); }
    }
    if (F.vcu < 2) { const int slot = F.vcu; const float* pe = A.in[10] + slot * 2048 + F.wave * 256; const float* w1 = A.in[11] + (size_t)slot * 2048 * 64 + (size_t)F.wave * 256 * 64; float a = 0.f;
#pragma unroll 16
        for (int k = 0; k < 256; ++k) a += pe[k] * w1[k * 64 + lane];
        ((LAS float*)(F.lds + F.wave * 16384 + 12288))[lane] = a; __syncthreads();
        if (F.wave == 0) { float t = 0.f;
#pragma unroll
            for (int w = 0; w < 8; ++w) t += ((LAS float*)(F.lds + w * 16384 + 12288))[lane];
            ((float*)(ws + WS_C1))[slot * 64 + lane] = t; }
    }
    bf16* XN = (bf16*)(ws + WS_XN);
    for (int m = gw; m < MPAD; m += NGW) {
        if (m < MTOT) { const float* xr = (m < TP) ? A.in[0] + (size_t)m * DM : A.in[1] + (size_t)(m - TP) * DM; rms_row_to_bf16(xr, A.in[8], XN + (size_t)m * DM, lane); }
        else { GAS v4u* o = (GAS v4u*)(XN + (size_t)m * DM) + lane; o[0] = (v4u){0, 0, 0, 0}; o[64] = (v4u){0, 0, 0, 0}; }
    }
    bf16* PP = (bf16*)(ws + WS_PPLE);
    for (int m = gw; m < MPAD; m += NGW) {
        v2u o = (v2u){0, 0};
        if (m < MTOT) { const float* pr = (m < TP) ? A.in[6] + (size_t)m * DPLE : A.in[7] + (size_t)(m - TP) * DPLE; const f32x4 v = ((const GAS f32x4*)pr)[lane]; o.x = pk2(v.x, v.y); o.y = pk2(v.z, v.w); }
        ((GAS v2u*)(PP + (size_t)m * DPLE))[lane] = o;
        if (m >= MTOT) { GAS v4u* z = (GAS v4u*)((bf16*)(ws + WS_MIX) + (size_t)m * DM) + lane; z[0] = (v4u){0, 0, 0, 0}; z[64] = (v4u){0, 0, 0, 0}; }
    }
    for (int it = gw; it < DBATCH * 508; it += NGW) { const int b = it / 508, r = it % 508;
        ((GAS f32x4*)(A.out + O_WINS + (size_t)(b * 512 + r) * 256))[lane] = ((const GAS f32x4*)(A.in[3] + (size_t)(b * 512 + r + 4) * 256))[lane]; }
}

constexpr float LOG2E = 1.4426950408889634f;
typedef short v4i16_t __attribute__((ext_vector_type(4)));
__device__ __forceinline__ s16x4 vtr(LAS const unsigned char* p) { return __builtin_bit_cast(s16x4, __builtin_amdgcn_ds_read_tr16_b64_v4i16((LAS v4i16_t*)p)); }
__device__ __forceinline__ unsigned cvtpk(float lo, float hi) { typedef float f2 __attribute__((ext_vector_type(2))); typedef __bf16 b2 __attribute__((ext_vector_type(2))); f2 v = {lo, hi}; b2 b = __builtin_convertvector(v, b2); return __builtin_bit_cast(unsigned, b); }
__device__ __forceinline__ int t5_bucket(int n) {
    if (n < 16) return n;
    const int large = 16 + (int)(logf((float)n / 16.0f) / 2.0794415416798357f * 16.0f);
    return large < 31 ? large : 31;
}
constexpr int HI_BASE = 131072 + 512, AT_LUT = HI_BASE, HI_IMPA = AT_LUT + 4096, HI_IMPB = HI_IMPA + 2176, HI_SEL = HI_IMPB + 2176, HI_SCS = HI_SEL + 128, HI_TL = HI_SCS + 512, HI_XCH = HI_TL + 512, HI_END = HI_XCH + 8192;
constexpr int AT_K0 = 0, AT_V0 = 16384, AT_IMPA = 36864, AT_IMPB = AT_IMPA + 64 * 65 * 4 + 64, AT_SEL = AT_IMPB + 64 * 65 * 4 + 64, AT_MISC = AT_SEL + 1024, AT_QF = ((AT_MISC + 4096 + 1023) / 1024) * 1024, AT_END = AT_QF + 32768;
struct AttnLane {
    int koff;
    int kx;
    int voff0, voff1;
    int r32, h;
};
__device__ __forceinline__ AttnLane attn_lane(int lane) {
    AttnLane L; L.r32 = lane & 31; L.h = lane >> 5; L.koff = L.r32 * 128; L.kx = (L.r32 >> 1) & 7;
    const int i16 = lane & 15, q = i16 >> 2, p = i16 & 3, g1 = (lane >> 4) & 1;
    const int base = (4 * L.h + q) * 128 + g1 * 32 + (p >> 1) * 16 + (p & 1) * 8;
    L.voff0 = base + ((q >> 1) * 64); L.voff1 = base + (((q >> 1) ^ 1) * 64);
    return L;
}
__device__ __forceinline__ void attn_fill_lut(LAS float* lut, const float* rel_bias, int tid) {
    for (int e = tid; e < 1024; e += NWAVES * 64) { const int dist = e >> 3, hd = e & 7; lut[e] = rel_bias[t5_bucket(dist) * 8 + hd] * LOG2E; }
}
__device__ __forceinline__ void attn_commit(LAS unsigned char* kb, LAS unsigned char* vb, int tid, v4u k, v4u v) {
    const int row = tid >> 3, ch = tid & 7;
    *(LAS v4u*)(kb + row * 128 + ((ch ^ ((row >> 1) & 7)) << 4)) = k;
    *(LAS v4u*)(vb + row * 128 + ((ch ^ (((row >> 1) & 1) << 2)) << 4)) = v;
}
__device__ __forceinline__ f32x16 attn_qk(LAS const unsigned char* kb, int hf, const AttnLane& L, const bf16x8 (&qf)[4]) {
    f32x16 s = {};
#pragma unroll
    for (int ks = 0; ks < 4; ++ks) { const bf16x8 kf = *(LAS const bf16x8*)(kb + hf * 4096 + L.koff + (((2 * ks + L.h) ^ L.kx) << 4)); s = __builtin_amdgcn_mfma_f32_32x32x16_bf16(kf, qf[ks], s, 0, 0, 0); }
    return s;
}
__device__ __forceinline__ void attn_pv(LAS const unsigned char* vb, int hf, const AttnLane& L, const f32x16& p, f32x16 (&o)[2]) {
#pragma unroll
    for (int s = 0; s < 2; ++s) {
        v4u pw; pw.x = cvtpk(p[8 * s + 0], p[8 * s + 1]); pw.y = cvtpk(p[8 * s + 2], p[8 * s + 3]); pw.z = cvtpk(p[8 * s + 4], p[8 * s + 5]); pw.w = cvtpk(p[8 * s + 6], p[8 * s + 7]);
        const bf16x8 pb = __builtin_bit_cast(bf16x8, pw);
        const int rb = (32 * hf + 16 * s) * 128;
        { const s16x4 lo = vtr(vb + rb + L.voff0), hi = vtr(vb + rb + 1024 + L.voff0); const bf16x8 vf = {lo[0], lo[1], lo[2], lo[3], hi[0], hi[1], hi[2], hi[3]};
          o[0] = __builtin_amdgcn_mfma_f32_32x32x16_bf16(vf, pb, o[0], 0, 0, 0); }
        { const s16x4 lo = vtr(vb + rb + L.voff1), hi = vtr(vb + rb + 1024 + L.voff1); const bf16x8 vf = {lo[0], lo[1], lo[2], lo[3], hi[0], hi[1], hi[2], hi[3]};
          o[1] = __builtin_amdgcn_mfma_f32_32x32x16_bf16(vf, pb, o[1], 0, 0, 0); }
    }
}
__device__ __forceinline__ float max16(const f32x16& a) {
    float m0 = fmaxf(fmaxf(a[0], a[1]), fmaxf(a[2], a[3])), m1 = fmaxf(fmaxf(a[4], a[5]), fmaxf(a[6], a[7])), m2 = fmaxf(fmaxf(a[8], a[9]), fmaxf(a[10], a[11])), m3 = fmaxf(fmaxf(a[12], a[13]), fmaxf(a[14], a[15]));
    return fmaxf(fmaxf(m0, m1), fmaxf(m2, m3));
}
__device__ __forceinline__ float sum16(const f32x16& a) {
    return ((a[0] + a[1]) + (a[2] + a[3])) + ((a[4] + a[5]) + (a[6] + a[7])) + (((a[8] + a[9]) + (a[10] + a[11])) + ((a[12] + a[13]) + (a[14] + a[15])));
}
__device__ __forceinline__ float xmax32(float v) { const auto rr = __builtin_amdgcn_permlane32_swap(__float_as_uint(v), __float_as_uint(v), false, false); return fmaxf(__uint_as_float(rr[0]), __uint_as_float(rr[1])); }
__device__ __forceinline__ float xsum32(float v) { const auto rr = __builtin_amdgcn_permlane32_swap(__float_as_uint(v), __float_as_uint(v), false, false); return __uint_as_float(rr[0]) + __uint_as_float(rr[1]); }
__device__ __forceinline__ void attn_softmax_pv(LAS const unsigned char* vb, const AttnLane& L, f32x16& t0, f32x16& t1, float& m, float& lh, f32x16 (&o)[2]) {
    const float tm = xmax32(fmaxf(max16(t0), max16(t1)));
    if (__any(tm > m + 8.0f)) {
        const float mn = fmaxf(m, tm), mu0 = (mn == -INFINITY) ? 0.f : mn;
        const float alpha = __builtin_amdgcn_exp2f(m - mu0);
#pragma unroll
        for (int r = 0; r < 16; ++r) { o[0][r] *= alpha; o[1][r] *= alpha; }
        lh *= alpha; m = mn;
    }
    const float mu = (m == -INFINITY) ? 0.f : m;
#pragma unroll
    for (int r = 0; r < 16; ++r) { t0[r] = __builtin_amdgcn_exp2f(t0[r] - mu); t1[r] = __builtin_amdgcn_exp2f(t1[r] - mu); }
    lh += sum16(t0) + sum16(t1);
    attn_pv(vb, 0, L, t0, o); attn_pv(vb, 1, L, t1, o);
}
#define KEYIDX(hf, reg, h) (32 * (hf) + ((reg) & 3) + 8 * ((reg) >> 2) + 4 * (h))
__device__ __forceinline__ void score_far(f32x16& t0, f32x16& t1, float cb) {
#pragma unroll
    for (int r = 0; r < 16; ++r) { t0[r] = fmaf(t0[r], LOG2E, cb); t1[r] = fmaf(t1[r], LOG2E, cb); }
}
__device__ __forceinline__ void score_near1(f32x16& t, int hf, int h, LAS const float* lut, int hd, int dbase, int dstep, int dmax, int klim, bool colok) {
#pragma unroll
    for (int r = 0; r < 16; ++r) {
        const int ki = KEYIDX(hf, r, h); const int dist = dbase - dstep * ki; const int di = dist < 0 ? 0 : (dist > 127 ? 127 : dist); const float bv = lut[di * 8 + hd];
        const bool ok = colok && dist >= 0 && dist < dmax && ki < klim; const float v = fmaf(t[r], LOG2E, bv); t[r] = ok ? v : -INFINITY; }
}
__device__ __forceinline__ void score_near(f32x16& t0, f32x16& t1, int h, LAS const float* lut, int hd, int dbase, int dstep, int dmax, int klim, bool colok) {
    score_near1(t0, 0, h, lut, hd, dbase, dstep, dmax, klim, colok);
    __builtin_amdgcn_sched_barrier(0);
    score_near1(t1, 1, h, lut, hd, dbase, dstep, dmax, klim, colok);
    __builtin_amdgcn_sched_barrier(0);
}

__device__ __forceinline__ void win_unit(const Frame& F, const Args& A, LAS unsigned char* sh, int b, int g, int qb) {
    const bf16* PROJ = (const bf16*)(A.ws + WS_PROJ);
    const int lane = opaque(F.lane), w = F.wave, tid = w * 64 + lane;
    const AttnLane L = attn_lane(lane);
    const int tq = 64 * qb + 8 * w + (L.r32 >> 2), hd = g * 4 + (L.r32 & 3);
    const size_t tokq = (size_t)b * SEQ + tq;
    bf16x8 qf[4];
#pragma unroll
    for (int ks = 0; ks < 4; ++ks) qf[ks] = *(const bf16x8*)(PROJ + tokq * NPROJ + C_QN + hd * 64 + 16 * ks + 8 * L.h);
    LAS const float* lut = (LAS const float*)(sh + AT_LUT);
    const float bfar = lut[127 * 8 + hd];
    const int kt0 = qb >= 8 ? qb - 8 : 0, nt = qb - kt0 + 1;
    const int srow = tid >> 3, sch = tid & 7;
    const bf16* ksrc = PROJ + ((size_t)b * SEQ + srow) * NPROJ + C_WIN + g * 64 + sch * 8;
    v4u kr, vr;
    kr = *(const v4u*)(ksrc + (size_t)(64 * kt0) * NPROJ); vr = *(const v4u*)(ksrc + (size_t)(64 * kt0) * NPROJ + 128);
    __syncthreads();
    attn_commit(sh + AT_K0, sh + AT_V0, tid, kr, vr);
    __syncthreads();
    float m = -INFINITY, l = 0.f; f32x16 o[2]; o[0] = f32x16{}; o[1] = f32x16{};
    for (int it = 0; it < nt; ++it) {
        const int kt = kt0 + it, buf = it & 1;
        if (it + 1 < nt) { kr = *(const v4u*)(ksrc + (size_t)(64 * (kt + 1)) * NPROJ); vr = *(const v4u*)(ksrc + (size_t)(64 * (kt + 1)) * NPROJ + 128); }
        LAS const unsigned char* kb = sh + AT_K0 + buf * 8192; LAS const unsigned char* vb = sh + AT_V0 + buf * 8192;
        f32x16 t0 = attn_qk(kb, 0, L, qf), t1 = attn_qk(kb, 1, L, qf);
        if (kt <= qb - 3 && kt >= qb - 7) score_far(t0, t1, bfar);
        else score_near(t0, t1, L.h, lut, hd, tq - 64 * kt, 1, 512, 64, true);
        attn_softmax_pv(vb, L, t0, t1, m, l, o);
        if (it + 1 < nt) attn_commit(sh + AT_K0 + (buf ^ 1) * 8192, sh + AT_V0 + (buf ^ 1) * 8192, tid, kr, vr);
        __syncthreads();
    }
    const float rl = 1.0f / xsum32(l);
    bf16* dst = (bf16*)(A.ws + WS_OWIN) + tokq * 512 + hd * 64;
#pragma unroll
    for (int dt = 0; dt < 2; ++dt)
#pragma unroll
        for (int rq = 0; rq < 4; ++rq) { v2u wv; wv.x = cvtpk(o[dt][4 * rq] * rl, o[dt][4 * rq + 1] * rl); wv.y = cvtpk(o[dt][4 * rq + 2] * rl, o[dt][4 * rq + 3] * rl);
            *(v2u*)(dst + 32 * dt + 8 * rq + 4 * L.h) = wv; }
}

__device__ __forceinline__ void nsa_unit(const Frame& F, const Args& A, LAS unsigned char* sh, int b, int g, int qb) {
    const bf16* PROJ = (const bf16*)(A.ws + WS_PROJ);
    const int lane = opaque(F.lane), w = F.wave, tid = w * 64 + lane;
    const AttnLane L = attn_lane(lane);
    const int qloc = 8 * w + (L.r32 >> 2);
    const int tq = 64 * qb + qloc, hd = g * 4 + (L.r32 & 3);
    const size_t tokq = (size_t)b * SEQ + tq;
    LAS bf16x8* qlds = (LAS bf16x8*)(sh + AT_QF) + tid;
    __syncthreads();
#pragma unroll
    for (int ks = 0; ks < 4; ++ks) qlds[ks * 512] = *(const bf16x8*)(PROJ + tokq * NPROJ + C_QN + hd * 64 + 16 * ks + 8 * L.h);
#define NSA_LOADQ() bf16x8 qf[4]; _Pragma("unroll") for (int ks = 0; ks < 4; ++ks) qf[ks] = qlds[ks * 512]
    LAS const float* lut = (LAS const float*)(sh + AT_LUT);
    const float bfar = lut[127 * 8 + hd];
    LAS float* impA = (LAS float*)(sh + AT_IMPA); LAS float* impB = (LAS float*)(sh + AT_IMPB);
    LAS unsigned long long* selm = (LAS unsigned long long*)(sh + AT_SEL);
    const int srow = tid >> 3, sch = tid & 7;
    v4u kr, vr;
    const int nct = (4 * qb + 3 + 63) >> 6;
    const bf16* kcs = (const bf16*)(A.ws + WS_KCP) + ((size_t)(b * 256 + srow) * 2 + g) * 64 + sch * 8;
    const bf16* vcs = (const bf16*)(A.ws + WS_VCP) + ((size_t)(b * 256 + srow) * 2 + g) * 64 + sch * 8;
    __syncthreads();
    for (int e = tid; e < 64 * 65; e += NWAVES * 64) { impA[e] = 0.f; impB[e] = 0.f; }
    float mc = -INFINITY, lc = 0.f;
    f32x16 oc[2]; oc[0] = f32x16{}; oc[1] = f32x16{};
#pragma unroll 1
    for (int pass = 0; pass < 2; ++pass) {
        kr = *(const v4u*)(kcs); vr = *(const v4u*)(vcs);
        __syncthreads();
        attn_commit(sh + AT_K0, sh + AT_V0, tid, kr, vr);
        __syncthreads();
        const float mu = (mc == -INFINITY) ? 0.f : mc, il = lc > 0.f ? 1.0f / lc : 0.f;
#pragma unroll 1
        for (int ct = 0; ct < nct; ++ct) {
            const int buf = ct & 1;
            if (ct + 1 < nct) { kr = *(const v4u*)(kcs + (size_t)(64 * (ct + 1)) * 128); vr = *(const v4u*)(vcs + (size_t)(64 * (ct + 1)) * 128); }
            LAS const unsigned char* kb = sh + AT_K0 + buf * 8192; LAS const unsigned char* vb = sh + AT_V0 + buf * 8192;
            NSA_LOADQ();
            f32x16 t0 = attn_qk(kb, 0, L, qf), t1 = attn_qk(kb, 1, L, qf);
            score_near(t0, t1, L.h, lut, hd, tq - 31 - 1024 * ct, 16, 1 << 30, 255 - 64 * ct, true);
            if (pass == 0) {
                const float tm = xmax32(fmaxf(max16(t0), max16(t1)));
                const float mn = fmaxf(mc, tm), mu0 = (mn == -INFINITY) ? 0.f : mn;
                const float alpha = __builtin_amdgcn_exp2f(mc - mu0);
                float ps = 0.f;
#pragma unroll
                for (int r = 0; r < 16; ++r) ps += __builtin_amdgcn_exp2f(t0[r] - mu0) + __builtin_amdgcn_exp2f(t1[r] - mu0);
                ps = xsum32(ps);
                lc = lc * alpha + ps; mc = mn;
            } else {
#pragma unroll
                for (int r = 0; r < 16; ++r) { t0[r] = __builtin_amdgcn_exp2f(t0[r] - mu) * il; t1[r] = __builtin_amdgcn_exp2f(t1[r] - mu) * il; }
                attn_pv(vb, 0, L, t0, oc); attn_pv(vb, 1, L, t1, oc);
#pragma unroll
                for (int hf = 0; hf < 2; ++hf) {
                    float x[16];
#pragma unroll
                    for (int r = 0; r < 16; ++r) { float v = hf ? t1[r] : t0[r]; v += __shfl_xor(v, 1); v += __shfl_xor(v, 2); x[r] = v; }
                    if ((L.r32 & 3) == 0) {
#pragma unroll
                        for (int rq = 0; rq < 4; ++rq) { const int jq = 16 * ct + 8 * hf + 2 * rq + L.h;
                            impA[qloc * 65 + jq] = 2.0f * (x[4 * rq] + x[4 * rq + 1] + x[4 * rq + 2]) + x[4 * rq + 3];
                            impB[qloc * 65 + jq + 1] = x[4 * rq + 3]; }
                    }
                }
            }
            if (ct + 1 < nct) attn_commit(sh + AT_K0 + (buf ^ 1) * 8192, sh + AT_V0 + (buf ^ 1) * 8192, tid, kr, vr);
            __syncthreads();
        }
    }
#pragma unroll 1
    for (int qi = 0; qi < 8; ++qi) {
        const int q = 8 * w + qi;
        unsigned long long mk;
        if (qb < 16) mk = (2ull << qb) - 1ull;
        else {
            const bool forced = (lane == 0) || (lane == qb) || (lane == qb - 1);
            const float sc = forced ? 1e9f : (lane <= qb ? impA[q * 65 + lane] + impB[q * 65 + lane] : -1.0f);
            int rank = 0;
#pragma unroll 8
            for (int jj = 0; jj < 64; ++jj) { const float ov = __uint_as_float(__builtin_amdgcn_readlane(__float_as_uint(sc), jj)); rank += ((ov > sc) || (ov == sc && jj < lane)) ? 1 : 0; }
            mk = __ballot(rank < 16 && lane <= qb);
        }
        if (lane == 0) selm[q] = mk;
    }
    __syncthreads();
    const unsigned long long mysel = selm[qloc];
    unsigned long long um = 0ull;
#pragma unroll 8
    for (int q_ = 0; q_ < 64; ++q_) um |= selm[q_];
    um = ((unsigned long long)__builtin_amdgcn_readfirstlane((unsigned)(um >> 32)) << 32) | (unsigned long long)__builtin_amdgcn_readfirstlane((unsigned)um);
    const bf16* ksrc = PROJ + ((size_t)b * SEQ + srow) * NPROJ + C_KV + 2 * 128 + g * 64 + sch * 8;
    float m = -INFINITY, l = 0.f; f32x16 o[2]; o[0] = f32x16{}; o[1] = f32x16{};
    int j = __builtin_ctzll(um); um &= um - 1;
    kr = *(const v4u*)(ksrc + (size_t)(64 * j) * NPROJ); vr = *(const v4u*)(ksrc + (size_t)(64 * j) * NPROJ + 128);
    attn_commit(sh + AT_K0, sh + AT_V0, tid, kr, vr);
    __syncthreads();
    int buf = 0;
#pragma unroll 1
    for (;;) {
        const int jn = um ? __builtin_ctzll(um) : -1; um &= um - 1;
        if (jn >= 0) { kr = *(const v4u*)(ksrc + (size_t)(64 * jn) * NPROJ); vr = *(const v4u*)(ksrc + (size_t)(64 * jn) * NPROJ + 128); }
        LAS const unsigned char* kb = sh + AT_K0 + buf * 8192; LAS const unsigned char* vb = sh + AT_V0 + buf * 8192;
        const bool selj = (mysel >> j) & 1ull;
        if (__any(selj)) {
            NSA_LOADQ();
            f32x16 t0 = attn_qk(kb, 0, L, qf), t1 = attn_qk(kb, 1, L, qf);
            if (j <= qb - 3) score_far(t0, t1, selj ? bfar : -INFINITY);
            else score_near(t0, t1, L.h, lut, hd, tq - 64 * j, 1, 1 << 30, 64, selj);
            attn_softmax_pv(vb, L, t0, t1, m, l, o);
        }
        if (jn >= 0) attn_commit(sh + AT_K0 + (buf ^ 1) * 8192, sh + AT_V0 + (buf ^ 1) * 8192, tid, kr, vr);
        __syncthreads();
        if (jn < 0) break;
        j = jn; buf ^= 1;
    }
    const bf16* gp = PROJ + tokq * NPROJ + C_GT + hd;
    const float g0 = 1.0f / (1.0f + __expf(-bf2f(gp[0]))), g1 = 1.0f / (1.0f + __expf(-bf2f(gp[8]))), g2 = 1.0f / (1.0f + __expf(-bf2f(gp[16])));
    const float rl = g1 / xsum32(l);
    const bf16* ow = (const bf16*)(A.ws + WS_OWIN) + tokq * 512 + hd * 64;
    bf16* dst = (bf16*)(A.ws + WS_MIX) + tokq * 1024 + hd * 64;
#pragma unroll
    for (int dt = 0; dt < 2; ++dt)
#pragma unroll
        for (int rq = 0; rq < 4; ++rq) { const int d0 = 32 * dt + 8 * rq + 4 * L.h; const v2u wv = *(const v2u*)(ow + d0);
            const float a0 = g0 * oc[dt][4 * rq] + rl * o[dt][4 * rq] + g2 * bflo(wv.x), a1 = g0 * oc[dt][4 * rq + 1] + rl * o[dt][4 * rq + 1] + g2 * bfhi(wv.x);
            const float a2 = g0 * oc[dt][4 * rq + 2] + rl * o[dt][4 * rq + 2] + g2 * bflo(wv.y), a3 = g0 * oc[dt][4 * rq + 3] + rl * o[dt][4 * rq + 3] + g2 * bfhi(wv.y);
            v2u ov; ov.x = cvtpk(a0, a1); ov.y = cvtpk(a2, a3); *(v2u*)(dst + d0) = ov; }
}
#undef NSA_LOADQ

__device__ __forceinline__ v4u pack_f32x8(const float* p) { const f32x4 a = *(const f32x4*)p, b = *(const f32x4*)(p + 4); v4u w; w.x = pk2(a.x, a.y); w.y = pk2(a.z, a.w); w.z = pk2(b.x, b.y); w.w = pk2(b.z, b.w); return w; }
__device__ __forceinline__ void samp_load(const Args& A, int mode, int tile, int b, int g, int srow, int sch, v4u& kr, v4u& vr) {
    const bf16* PROJ = (const bf16*)(A.ws + WS_PROJ);
    kr = (v4u){0, 0, 0, 0}; vr = (v4u){0, 0, 0, 0};
    if (mode == 0) {
        const size_t off = ((size_t)(b * 512 + 64 * tile + srow) * 2 + g) * 64 + sch * 8;
        kr = *(const v4u*)((const bf16*)(A.ws + WS_KCS) + off); vr = *(const v4u*)((const bf16*)(A.ws + WS_VCS) + off);
    } else if (mode == 1) {
        if (tile < 128) { const int page = ((const int*)A.in[5])[b * 64 + (tile >> 1)]; const int row = (tile & 1) * 64 + srow;
            const float* p = A.in[2] + ((size_t)(page * 128 + row) * 4 + 2) * 128 + g * 64 + sch * 8; kr = pack_f32x8(p); vr = pack_f32x8(p + 128); }
        else if (srow < 4) { const bf16* p = PROJ + (size_t)(TP + b * 4 + srow) * NPROJ + C_KV + 2 * 128 + g * 64 + sch * 8; kr = *(const v4u*)p; vr = *(const v4u*)(p + 128); }
    } else {
        const int idx = 64 * tile + srow;
        if (idx < 512) { const float* p = A.in[3] + ((size_t)(b * 512 + idx) * 2) * 128 + g * 64 + sch * 8; kr = pack_f32x8(p); vr = pack_f32x8(p + 128); }
        else if (idx < 516) { const bf16* p = PROJ + (size_t)(TP + b * 4 + idx - 512) * NPROJ + C_WIN + g * 64 + sch * 8; kr = *(const v4u*)p; vr = *(const v4u*)(p + 128); }
    }
}
__device__ __forceinline__ void samp_stage_tile(const Args& A, int mode, int tile, int b, int g, int lane, LAS unsigned char* kb, LAS unsigned char* vb) {
#pragma unroll 1
    for (int i0 = 0; i0 < 8; i0 += 2) {
        v4u kr[2], vr[2];
#pragma unroll
        for (int i = 0; i < 2; ++i) samp_load(A, mode, tile, b, g, (lane >> 3) + 8 * (i0 + i), lane & 7, kr[i], vr[i]);
#pragma unroll
        for (int i = 0; i < 2; ++i) { const int row = (lane >> 3) + 8 * (i0 + i), ch = lane & 7;
            *(LAS v4u*)(kb + row * 128 + ((ch ^ ((row >> 1) & 7)) << 4)) = kr[i];
            *(LAS v4u*)(vb + row * 128 + ((ch ^ (((row >> 1) & 1) << 2)) << 4)) = vr[i]; }
    }
}
__device__ __forceinline__ void samp_unit(const Frame& F, const Args& A, LAS unsigned char* sh, int b, int g) {
    const bf16* PROJ = (const bf16*)(A.ws + WS_PROJ);
    const int lane = opaque(F.lane), w = F.wave, tid = w * 64 + lane;
    const AttnLane L = attn_lane(lane);
    const bool colok = L.r32 < 16;
    const int qi = (L.r32 >> 2) & 3, hd = g * 4 + (L.r32 & 3);
    const int pos = PAST + qi;
    const size_t tokq = (size_t)TP + b * 4 + qi;
    LAS unsigned char* kb = sh + w * 16384; LAS unsigned char* vb = kb + 8192;
    LAS float* lut = (LAS float*)(sh + AT_LUT);
    LAS float* impA = (LAS float*)(sh + HI_IMPA); LAS float* impB = (LAS float*)(sh + HI_IMPB);
    LAS unsigned long long* selm = (LAS unsigned long long*)(sh + HI_SEL);
    LAS float* scs = (LAS float*)(sh + HI_SCS);
    LAS int* tlist = (LAS int*)(sh + HI_TL);
    LAS float* xch = (LAS float*)(sh + HI_XCH);
    bf16x8 qf[4];
#pragma unroll
    for (int ks = 0; ks < 4; ++ks) qf[ks] = *(const bf16x8*)(PROJ + tokq * NPROJ + C_QN + hd * 64 + 16 * ks + 8 * L.h);
    const float bfar = lut[127 * 8 + hd];
    __syncthreads();
    for (int e = tid; e < 4 * 132; e += NWAVES * 64) { impA[e] = 0.f; impB[e] = 0.f; }
    f32x16 oc[2]; oc[0] = f32x16{}; oc[1] = f32x16{};
    {
        samp_stage_tile(A, 0, w, b, g, lane, kb, vb);
        f32x16 t0 = attn_qk(kb, 0, L, qf), t1 = attn_qk(kb, 1, L, qf);
        score_near(t0, t1, L.h, lut, hd, pos - 31 - 1024 * w, 16, 1 << 30, 511 - 64 * w, colok);
        const float tm = xmax32(fmaxf(max16(t0), max16(t1)));
        xch[(w * 64 + lane) * 4] = tm;
        __syncthreads();
        float M = -INFINITY;
#pragma unroll
        for (int ww = 0; ww < 8; ++ww) M = fmaxf(M, xch[(ww * 64 + lane) * 4]);
        const float mu = (M == -INFINITY) ? 0.f : M;
#pragma unroll
        for (int r = 0; r < 16; ++r) { t0[r] = __builtin_amdgcn_exp2f(t0[r] - mu); t1[r] = __builtin_amdgcn_exp2f(t1[r] - mu); }
        const float ps = xsum32(sum16(t0) + sum16(t1));
        xch[(w * 64 + lane) * 4 + 1] = ps;
        __syncthreads();
        float Lc = 0.f;
#pragma unroll
        for (int ww = 0; ww < 8; ++ww) Lc += xch[(ww * 64 + lane) * 4 + 1];
        const float il = Lc > 0.f ? 1.0f / Lc : 0.f;
#pragma unroll
        for (int r = 0; r < 16; ++r) { t0[r] *= il; t1[r] *= il; }
        attn_pv(vb, 0, L, t0, oc); attn_pv(vb, 1, L, t1, oc);
#pragma unroll
        for (int hf = 0; hf < 2; ++hf) {
            float x[16];
#pragma unroll
            for (int r = 0; r < 16; ++r) { float v = hf ? t1[r] : t0[r]; v += __shfl_xor(v, 1); v += __shfl_xor(v, 2); x[r] = v; }
            if ((L.r32 & 3) == 0 && colok) {
#pragma unroll
                for (int rq = 0; rq < 4; ++rq) { const int jq = 16 * w + 8 * hf + 2 * rq + L.h;
                    impA[qi * 132 + jq] = 2.0f * (x[4 * rq] + x[4 * rq + 1] + x[4 * rq + 2]) + x[4 * rq + 3];
                    impB[qi * 132 + jq + 1] = x[4 * rq + 3]; }
            }
        }
    }
    __syncthreads();
    if (w == 0) {
        unsigned long long ulo = 0ull, uhi = 0ull;
#pragma unroll 1
        for (int q = 0; q < 4; ++q) {
            const int j0 = lane, j1 = lane + 64;
            const float s0 = (j0 == 0) ? 1e9f : impA[q * 132 + j0] + impB[q * 132 + j0];
            const float s1 = (j1 == 127) ? 1e9f : impA[q * 132 + j1] + impB[q * 132 + j1];
            scs[j0] = s0; scs[j1] = s1;
            LDS_WAIT(); asm volatile("" ::: "memory");
            int r0 = 0, r1 = 0;
#pragma unroll 8
            for (int jj = 0; jj < 128; ++jj) { const float ov = scs[jj]; r0 += ((ov > s0) || (ov == s0 && jj < j0)) ? 1 : 0; r1 += ((ov > s1) || (ov == s1 && jj < j1)) ? 1 : 0; }
            const unsigned long long mlo = __ballot(r0 < 15), mhi = __ballot(r1 < 15);
            if (lane == 0) { selm[2 * q] = mlo; selm[2 * q + 1] = mhi; }
            ulo |= mlo; uhi |= mhi;
            LDS_WAIT(); asm volatile("" ::: "memory");
        }
        if (lane == 0) { int n = 0; for (int j = 0; j < 64; ++j) if ((ulo >> j) & 1ull) tlist[1 + n++] = j; for (int j = 0; j < 64; ++j) if ((uhi >> j) & 1ull) tlist[1 + n++] = 64 + j; tlist[1 + n++] = 128; tlist[0] = n; }
    }
    __syncthreads();
    const unsigned long long mylo = selm[2 * qi], myhi = selm[2 * qi + 1];
    const int nsel = tlist[0];
    const bf16* gp = PROJ + tokq * NPROJ + C_GT + hd;
    const float g0 = 1.0f / (1.0f + __expf(-bf2f(gp[0]))), g1 = 1.0f / (1.0f + __expf(-bf2f(gp[8]))), g2 = 1.0f / (1.0f + __expf(-bf2f(gp[16])));
#pragma unroll
    for (int r = 0; r < 16; ++r) { oc[0][r] *= g0; oc[1][r] *= g0; }
#pragma unroll 1
    for (int br = 0; br < 2; ++br) {
        const int nt = br == 0 ? nsel : 9;
        float m = -INFINITY, l = 0.f; f32x16 o[2]; o[0] = f32x16{}; o[1] = f32x16{};
#pragma unroll 1
        for (int it = w; it < nt; it += 8) {
            const int j = br == 0 ? tlist[1 + it] : it;
            samp_stage_tile(A, 1 + br, j, b, g, lane, kb, vb);
            f32x16 t0 = attn_qk(kb, 0, L, qf), t1 = attn_qk(kb, 1, L, qf);
            if (br == 0) {
                const bool selj = colok && (j >= 128 ? true : (j < 64 ? ((mylo >> j) & 1ull) : ((myhi >> (j - 64)) & 1ull)));
                if (j <= 125) score_far(t0, t1, selj ? bfar : -INFINITY);
                else score_near(t0, t1, L.h, lut, hd, pos - 64 * j, 1, 1 << 30, 64, selj);
            } else score_near(t0, t1, L.h, lut, hd, pos - (PAST - 512 + 64 * j), 1, 512, 516 - 64 * j, colok);
            attn_softmax_pv(vb, L, t0, t1, m, l, o);
        }
        l = xsum32(l);
        xch[(w * 64 + lane) * 4 + 2] = m; xch[(w * 64 + lane) * 4 + 3] = l;
        __syncthreads();
        float M = -INFINITY;
#pragma unroll
        for (int ww = 0; ww < 8; ++ww) M = fmaxf(M, xch[(ww * 64 + lane) * 4 + 2]);
        float Lt = 0.f;
#pragma unroll
        for (int ww = 0; ww < 8; ++ww) { const float mw = xch[(ww * 64 + lane) * 4 + 2]; Lt += (mw == -INFINITY) ? 0.f : xch[(ww * 64 + lane) * 4 + 3] * __builtin_amdgcn_exp2f(mw - M); }
        const float sc = (m == -INFINITY || !(Lt > 0.f)) ? 0.f : (br == 0 ? g1 : g2) * __builtin_amdgcn_exp2f(m - M) / Lt;
#pragma unroll
        for (int r = 0; r < 16; ++r) { oc[0][r] += sc * o[0][r]; oc[1][r] += sc * o[1][r]; }
        __syncthreads();
    }
    { LAS float* part = (LAS float*)kb;
#pragma unroll
      for (int r = 0; r < 16; ++r) { part[r * 64 + lane] = oc[0][r]; part[(16 + r) * 64 + lane] = oc[1][r]; } }
    __syncthreads();
    if (w == 0 && colok) {
        float res[32];
#pragma unroll
        for (int r = 0; r < 32; ++r) { float a = 0.f;
#pragma unroll
            for (int ww = 0; ww < 8; ++ww) a += ((LAS const float*)(sh + ww * 16384))[r * 64 + lane];
            res[r] = a; }
        bf16* dst = (bf16*)(A.ws + WS_MIX) + tokq * 1024 + hd * 64;
#pragma unroll
        for (int dt = 0; dt < 2; ++dt)
#pragma unroll
            for (int rq = 0; rq < 4; ++rq) { const int d0 = 32 * dt + 8 * rq + 4 * L.h;
                v2u ov; ov.x = cvtpk(res[16 * dt + 4 * rq], res[16 * dt + 4 * rq + 1]); ov.y = cvtpk(res[16 * dt + 4 * rq + 2], res[16 * dt + 4 * rq + 3]); *(v2u*)(dst + d0) = ov; }
    }
}

__device__ __forceinline__ float gelu_tanh(float x) { const float u = 0.7978845608028654f * (x + 0.044715f * x * x * x); const float t = 1.0f - 2.0f / (1.0f + __expf(2.0f * u)); return 0.5f * x * (1.0f + t); }
template <bool SAMPLE>
__device__ __forceinline__ void cmp_job(const Args& A, int b, int slot, int g, int grp, int lane) {
    const int r32 = lane & 31, h = lane >> 5;
    const int nsb = SAMPLE ? 512 : 256;
    int sb = 31 * grp + r32; const bool sbok = sb < nsb; if (!sbok) sb = nsb - 1;
    const bf16* W1 = (const bf16*)(A.ws + WS_WC1) + (size_t)slot * 64 * 2048;
    const bf16* PROJ = (const bf16*)(A.ws + WS_PROJ);
    f32x16 acc[2][2];
#pragma unroll
    for (int j = 0; j < 2; ++j) { acc[j][0] = f32x16{}; acc[j][1] = f32x16{}; }
    const bf16* w1p = W1 + (size_t)r32 * 2048 + 8 * h;
    const float* crow = nullptr; const bf16* prow = nullptr;
    if (SAMPLE) { const int p0 = 16 * sb; const int page = ((const int*)A.in[5])[b * 64 + (p0 >> 7)];
        crow = A.in[2] + ((size_t)(page * 128 + (p0 & 127)) * 4 + slot) * 128 + g * 64 + 8 * h; }
    else prow = PROJ + (size_t)(b * SEQ + 16 * sb) * NPROJ + C_KV + slot * 128 + g * 64 + 8 * h;
#pragma unroll 2
    for (int s = 0; s < 16; ++s) {
#pragma unroll
        for (int dq = 0; dq < 4; ++dq) {
            bf16x8 bf;
            if (SAMPLE) bf = __builtin_bit_cast(bf16x8, pack_f32x8(crow + (size_t)s * 512 + dq * 16));
            else bf = *(const bf16x8*)(prow + (size_t)s * NPROJ + dq * 16);
#pragma unroll
            for (int j = 0; j < 2; ++j)
#pragma unroll
                for (int ht = 0; ht < 2; ++ht) { const bf16x8 af = *(const bf16x8*)(w1p + (size_t)ht * 32 * 2048 + j * 1024 + s * 64 + dq * 16);
                    acc[j][ht] = __builtin_amdgcn_mfma_f32_32x32x16_bf16(af, bf, acc[j][ht], 0, 0, 0); }
        }
    }
    const float* c1p = (const float*)(A.ws + WS_C1) + slot * 64;
    bf16x8 xb[2][2];
#pragma unroll
    for (int ht = 0; ht < 2; ++ht) {
        float xv[16];
#pragma unroll
        for (int r = 0; r < 16; ++r) { const int hid = 32 * ht + (r & 3) + 8 * (r >> 2) + 4 * h;
            const float c1 = c1p[hid];
            const float h1 = __shfl(acc[1][ht][r], (lane & 32) | ((r32 + 1) & 31));
            xv[r] = gelu_tanh(acc[0][ht][r] + h1 + c1); }
#pragma unroll
        for (int s = 0; s < 2; ++s) { v4u pw; pw.x = cvtpk(xv[8 * s], xv[8 * s + 1]); pw.y = cvtpk(xv[8 * s + 2], xv[8 * s + 3]); pw.z = cvtpk(xv[8 * s + 4], xv[8 * s + 5]); pw.w = cvtpk(xv[8 * s + 6], xv[8 * s + 7]); xb[ht][s] = __builtin_bit_cast(bf16x8, pw); }
    }
    const bf16* W2 = (const bf16*)(A.ws + WS_WC2) + (size_t)slot * 64 * 64;
    f32x16 oo[2];
#pragma unroll
    for (int dt = 0; dt < 2; ++dt) {
        oo[dt] = f32x16{};
#pragma unroll
        for (int ht = 0; ht < 2; ++ht)
#pragma unroll
            for (int s = 0; s < 2; ++s) { const bf16* wp = W2 + (size_t)(32 * dt + r32) * 64 + 32 * ht + 16 * s + 4 * h;
                const v2u lo = *(const v2u*)wp, hi = *(const v2u*)(wp + 8); const v4u af = {lo.x, lo.y, hi.x, hi.y};
                oo[dt] = __builtin_amdgcn_mfma_f32_32x32x16_bf16(__builtin_bit_cast(bf16x8, af), xb[ht][s], oo[dt], 0, 0, 0); }
    }
    const int nblk = SAMPLE ? 511 : 255;
    if (r32 < 31 && sb < nblk && sbok) {
        bf16* dst = (bf16*)(A.ws + (SAMPLE ? (slot ? WS_VCS : WS_KCS) : (slot ? WS_VCP : WS_KCP))) + ((size_t)(b * nsb + sb) * 2 + g) * 64;
#pragma unroll
        for (int dt = 0; dt < 2; ++dt)
#pragma unroll
            for (int rq = 0; rq < 4; ++rq) { v2u wv; wv.x = cvtpk(oo[dt][4 * rq], oo[dt][4 * rq + 1]); wv.y = cvtpk(oo[dt][4 * rq + 2], oo[dt][4 * rq + 3]); *(v2u*)(dst + 32 * dt + 8 * rq + 4 * h) = wv; }
    }
}

__device__ __forceinline__ float log_sigmoid(float x) { return fminf(x, 0.f) - __logf(1.0f + __expf(-fabsf(x))); }
constexpr int G_QE = 0, G_KE = 8192, G_KDT = 16384, G_V = 24576, G_ST = 40960, G_LR = 73728, G_SEG = 77824, G_DEC = 79872, G_END = 80128;
__device__ __forceinline__ int sw128(int row, int ch) { return row * 128 + ((ch ^ ((row >> 1) & 7)) << 4); }

__device__ __forceinline__ void gla_local(const Frame& F, const Args& A, LAS unsigned char* sh, int unit) {
    const int b = unit >> 6, hh = (unit >> 4) & 3, sc = unit & 15;
    const int lane = opaque(F.lane), w = F.wave, tid = w * 64 + lane, r32 = lane & 31, h = lane >> 5;
    const bf16* PROJ = (const bf16*)(A.ws + WS_PROJ);
    const size_t tok0 = (size_t)b * SEQ + 256 * sc;
    const int c = lane;
    float wg[16];
#pragma unroll
    for (int r = 0; r < 16; ++r) wg[r] = A.in[13][r * 256 + hh * 64 + c];
    const float bg = A.in[14][hh * 64 + c];
    float Bprev = 0.f;
    const int dvt = w >> 1, it = w & 1;
    f32x16 accS = {};
    const int i16 = lane & 15, tq = i16 >> 2, tp = i16 & 3, g1 = (lane >> 4) & 1;
    const int vcol = ((4 * (dvt ^ tq) + 2 * g1 + (tp >> 1)) << 4) + (tp & 1) * 8;
    __syncthreads();
#pragma unroll 1
    for (int n = 0; n < 4; ++n) {
        const size_t tb = tok0 + 64 * n;
        { const int trow = tid >> 3, pr = tid & 7; const unsigned lw = *(const unsigned*)(PROJ + (tb + trow) * NPROJ + C_LR + 2 * pr);
          LAS float* lr = (LAS float*)(sh + G_LR); lr[trow * 16 + 2 * pr] = bflo(lw); lr[trow * 16 + 2 * pr + 1] = bfhi(lw);
#pragma unroll
          for (int k2 = 0; k2 < 2; ++k2) { const int ch = pr * 2 + k2; const v4u vv = *(const v4u*)(PROJ + (tb + trow) * NPROJ + C_VG + hh * 128 + ch * 8);
              *(LAS v4u*)(sh + G_V + trow * 256 + ((ch ^ ((trow & 3) << 2)) << 4)) = vv; } }
        __syncthreads();
        float cum[8], qv[8], kv[8];
        { LAS const float* lr = (LAS const float*)(sh + G_LR); float run = 0.f;
#pragma unroll
          for (int k = 0; k < 8; ++k) { const int i = 8 * w + k; float x = bg;
#pragma unroll
              for (int r = 0; r < 16; ++r) x += lr[i * 16 + r] * wg[r];
              run += log_sigmoid(x) * (1.0f / 16.0f); cum[k] = run;
              qv[k] = 0.125f * bf2f(PROJ[(tb + i) * NPROJ + C_QG + hh * 64 + c]); kv[k] = bf2f(PROJ[(tb + i) * NPROJ + C_KG + hh * 64 + c]); }
          ((LAS float*)(sh + G_SEG))[w * 64 + c] = run; }
        __syncthreads();
        { LAS const float* seg = (LAS const float*)(sh + G_SEG); float pre = 0.f, tot = 0.f;
#pragma unroll
          for (int g_ = 0; g_ < 8; ++g_) { const float sv = seg[g_ * 64 + c]; tot += sv; if (g_ < w) pre += sv; }
          const float eB = __expf(Bprev);
          unsigned kdw[4];
#pragma unroll
          for (int k = 0; k < 8; ++k) { const int i = 8 * w + k; const float bb = pre + cum[k];
              const float qe = qv[k] * __expf(bb), ke = kv[k] * __expf(-bb), kd = kv[k] * __expf(tot - bb);
              *(LAS unsigned short*)(sh + G_QE + sw128(i, c >> 3) + (c & 7) * 2) = (unsigned short)f2bf(qe);
              *(LAS unsigned short*)(sh + G_KE + sw128(i, c >> 3) + (c & 7) * 2) = (unsigned short)f2bf(ke);
              ((bf16*)(A.ws + WS_QB))[(tb + i) * 256 + hh * 64 + c] = (bf16)f2bf(qe * eB);
              if (k & 1) kdw[k >> 1] |= f2bf(kd) << 16; else kdw[k >> 1] = f2bf(kd); }
          *(LAS v4u*)(sh + G_KDT + sw128(c, w)) = (v4u){kdw[0], kdw[1], kdw[2], kdw[3]};
          if (w == 0) ((LAS float*)(sh + G_DEC))[c] = __expf(tot);
          Bprev += tot; }
        __syncthreads();
        LAS const unsigned char* qeb = sh + G_QE; LAS const unsigned char* keb = sh + G_KE; LAS const unsigned char* vbase = sh + G_V;
        bf16x8 qfr[4];
#pragma unroll
        for (int ks = 0; ks < 4; ++ks) qfr[ks] = *(LAS const bf16x8*)(qeb + sw128(32 * it + r32, 2 * ks + h));
        f32x16 oT = {};
#pragma unroll
        for (int jt = 0; jt < 2; ++jt) {
            if (jt <= it) {
                f32x16 s = {};
#pragma unroll
                for (int ks = 0; ks < 4; ++ks) { const bf16x8 kf = *(LAS const bf16x8*)(keb + sw128(32 * jt + r32, 2 * ks + h)); s = __builtin_amdgcn_mfma_f32_32x32x16_bf16(kf, qfr[ks], s, 0, 0, 0); }
                if (jt == it) {
#pragma unroll
                    for (int r = 0; r < 16; ++r) { const int j = (r & 3) + 8 * (r >> 2) + 4 * h; if (j > r32) s[r] = 0.f; }
                }
#pragma unroll
                for (int s2 = 0; s2 < 2; ++s2) {
                    v4u pw; pw.x = cvtpk(s[8 * s2], s[8 * s2 + 1]); pw.y = cvtpk(s[8 * s2 + 2], s[8 * s2 + 3]); pw.z = cvtpk(s[8 * s2 + 4], s[8 * s2 + 5]); pw.w = cvtpk(s[8 * s2 + 6], s[8 * s2 + 7]);
                    const int row = 32 * jt + 16 * s2 + 4 * h + tq;
                    const s16x4 lo = vtr(vbase + row * 256 + vcol), hi = vtr(vbase + (row + 8) * 256 + vcol);
                    const bf16x8 vf = {lo[0], lo[1], lo[2], lo[3], hi[0], hi[1], hi[2], hi[3]};
                    oT = __builtin_amdgcn_mfma_f32_32x32x16_bf16(vf, __builtin_bit_cast(bf16x8, pw), oT, 0, 0, 0);
                }
            }
        }
        if (n > 0) {
            LAS const unsigned char* stb = sh + G_ST + (n & 1) * 16384;
#pragma unroll
            for (int ks = 0; ks < 4; ++ks) { const bf16x8 sf = *(LAS const bf16x8*)(stb + sw128(32 * dvt + r32, 2 * ks + h)); oT = __builtin_amdgcn_mfma_f32_32x32x16_bf16(sf, qfr[ks], oT, 0, 0, 0); }
        }
        { float* op = (float*)(A.ws + WS_OLOC) + (tb + 32 * it + r32) * 512 + hh * 128 + 32 * dvt + 4 * h;
#pragma unroll
          for (int rq = 0; rq < 4; ++rq) *(f32x4*)(op + 8 * rq) = (f32x4){oT[4 * rq], oT[4 * rq + 1], oT[4 * rq + 2], oT[4 * rq + 3]}; }
        { const float dec = ((LAS const float*)(sh + G_DEC))[32 * it + r32];
#pragma unroll
          for (int r = 0; r < 16; ++r) accS[r] *= dec;
#pragma unroll
          for (int ks = 0; ks < 4; ++ks) {
              const bf16x8 kdf = *(LAS const bf16x8*)(sh + G_KDT + sw128(32 * it + r32, 2 * ks + h));
              const int row = 16 * ks + 8 * h + tq;
              const s16x4 lo = vtr(vbase + row * 256 + vcol), hi = vtr(vbase + (row + 4) * 256 + vcol);
              const bf16x8 vf = {lo[0], lo[1], lo[2], lo[3], hi[0], hi[1], hi[2], hi[3]};
              accS = __builtin_amdgcn_mfma_f32_32x32x16_bf16(vf, kdf, accS, 0, 0, 0);
          }
          LAS unsigned char* stn = sh + G_ST + ((n + 1) & 1) * 16384; const int d = 32 * it + r32;
#pragma unroll
          for (int r = 0; r < 16; ++r) { const int dv = 32 * dvt + (r & 3) + 8 * (r >> 2) + 4 * h; *(LAS unsigned short*)(stn + sw128(dv, d >> 3) + (d & 7) * 2) = (unsigned short)f2bf(accS[r]); } }
        __syncthreads();
    }
    { float* up = (float*)(A.ws + WS_USC) + (size_t)unit * 8192; const int d = 32 * it + r32;
#pragma unroll
      for (int r = 0; r < 16; ++r) { const int dv = 32 * dvt + (r & 3) + 8 * (r >> 2) + 4 * h; up[dv * 64 + d] = accS[r]; }
      if (w == 0) ((float*)(A.ws + WS_DSC))[unit * 64 + c] = __expf(Bprev); }
}

__device__ __forceinline__ void gla_out(const Frame& F, const Args& A, LAS unsigned char* sh, int unit) {
    const int b = unit >> 6, hh = (unit >> 4) & 3, sc = unit & 15;
    const int lane = opaque(F.lane), w = F.wave, tid = w * 64 + lane, r32 = lane & 31, h = lane >> 5;
    const bf16* PROJ = (const bf16*)(A.ws + WS_PROJ);
    const size_t tok0 = (size_t)b * SEQ + 256 * sc;
    const int d4 = (tid & 15) * 4, dvr = tid >> 4;
    f32x4 S[4];
#pragma unroll
    for (int k = 0; k < 4; ++k) S[k] = (f32x4){0.f, 0.f, 0.f, 0.f};
    const float* U0 = (const float*)(A.ws + WS_USC) + (size_t)(unit - sc) * 8192; const float* D0 = (const float*)(A.ws + WS_DSC) + (size_t)(unit - sc) * 64;
#pragma unroll 1
    for (int s = 0; s < sc; ++s) { const f32x4 dd = *(const f32x4*)(D0 + s * 64 + d4);
#pragma unroll
        for (int k = 0; k < 4; ++k) { const f32x4 u = *(const f32x4*)(U0 + (size_t)s * 8192 + (32 * k + dvr) * 64 + d4); S[k] = S[k] * dd + u; } }
    __syncthreads();
#pragma unroll
    for (int k = 0; k < 4; ++k) { const int dv = 32 * k + dvr; v2u wv; wv.x = pk2(S[k].x, S[k].y); wv.y = pk2(S[k].z, S[k].w);
        *(LAS v2u*)(sh + sw128(dv, d4 >> 3) + (d4 & 7) * 2) = wv; }
    if (sc == 15) {
        const f32x4 dd = *(const f32x4*)(D0 + 15 * 64 + d4); float* op = A.out + O_GLAP + (size_t)(b * 4 + hh) * 8192;
#pragma unroll
        for (int k = 0; k < 4; ++k) { const int dv = 32 * k + dvr; const f32x4 u = *(const f32x4*)(U0 + (size_t)15 * 8192 + dv * 64 + d4); const f32x4 e = S[k] * dd + u;
            op[(d4 + 0) * 128 + dv] = e.x; op[(d4 + 1) * 128 + dv] = e.y; op[(d4 + 2) * 128 + dv] = e.z; op[(d4 + 3) * 128 + dv] = e.w; }
    }
    __syncthreads();
    const size_t tok = tok0 + 32 * w + r32;
    f32x16 acc[4];
#pragma unroll
    for (int t = 0; t < 4; ++t) acc[t] = f32x16{};
#pragma unroll
    for (int ks = 0; ks < 4; ++ks) { const bf16x8 qb = *(const bf16x8*)((const bf16*)(A.ws + WS_QB) + tok * 256 + hh * 64 + 16 * ks + 8 * h);
#pragma unroll
        for (int t = 0; t < 4; ++t) { const bf16x8 sf = *(LAS const bf16x8*)(sh + sw128(32 * t + r32, 2 * ks + h)); acc[t] = __builtin_amdgcn_mfma_f32_32x32x16_bf16(sf, qb, acc[t], 0, 0, 0); } }
    const float* ol = (const float*)(A.ws + WS_OLOC) + tok * 512 + hh * 128;
    float ss = 0.f;
#pragma unroll
    for (int t = 0; t < 4; ++t)
#pragma unroll
        for (int rq = 0; rq < 4; ++rq) { const f32x4 v = *(const f32x4*)(ol + 32 * t + 8 * rq + 4 * h);
#pragma unroll
            for (int e = 0; e < 4; ++e) { acc[t][4 * rq + e] += v[e]; ss += acc[t][4 * rq + e] * acc[t][4 * rq + e]; } }
    ss += __shfl_xor(ss, 32);
    const float rstd = 1.0f / sqrtf(ss * (1.0f / 128.0f) + EPS);
    const float* gn = A.in[15]; const bf16* gg = PROJ + tok * NPROJ + C_GG + hh * 128;
    bf16* dst = (bf16*)(A.ws + WS_MIX) + tok * 1024 + 512 + hh * 128;
#pragma unroll
    for (int t = 0; t < 4; ++t)
#pragma unroll
        for (int rq = 0; rq < 4; ++rq) { const int dv0 = 32 * t + 8 * rq + 4 * h; const f32x4 gnv = *(const f32x4*)(gn + dv0); const v2u gw = *(const v2u*)(gg + dv0);
            const float gv[4] = {bflo(gw.x), bfhi(gw.x), bflo(gw.y), bfhi(gw.y)}; float y[4];
#pragma unroll
            for (int e = 0; e < 4; ++e) y[e] = acc[t][4 * rq + e] * rstd * gnv[e] * gv[e] / (1.0f + __expf(-gv[e]));
            v2u ov; ov.x = cvtpk(y[0], y[1]); ov.y = cvtpk(y[2], y[3]); *(v2u*)(dst + dv0) = ov; }
}

__device__ __forceinline__ void gla_sample(const Frame& F, const Args& A, LAS unsigned char* sh, int unit) {
    const int b = unit >> 2, hh = unit & 3, tid = F.wave * 64 + opaque(F.lane);
    const bf16* PROJ = (const bf16*)(A.ws + WS_PROJ);
    LAS float* la = (LAS float*)sh;
    LAS float* qs = la + 256;
    LAS float* ks = qs + 256;
    LAS float* op = ks + 256;
    LAS float* of = op + 2048;
    __syncthreads();
    if (tid < 256) { const int t = tid >> 6, c = tid & 63; const size_t tok = (size_t)TP + b * 4 + t; float x = A.in[14][hh * 64 + c];
#pragma unroll
        for (int r = 0; r < 16; ++r) x += bf2f(PROJ[tok * NPROJ + C_LR + r]) * A.in[13][r * 256 + hh * 64 + c];
        la[tid] = __expf(log_sigmoid(x) * (1.0f / 16.0f)); qs[tid] = 0.125f * bf2f(PROJ[tok * NPROJ + C_QG + hh * 64 + c]); ks[tid] = bf2f(PROJ[tok * NPROJ + C_KG + hh * 64 + c]); }
    __syncthreads();
    const int dv = tid & 127, cg = tid >> 7;
    const float* s0 = A.in[4] + (size_t)(b * 4 + hh) * 8192;
    float S[16];
#pragma unroll
    for (int k = 0; k < 16; ++k) S[k] = s0[(16 * cg + k) * 128 + dv];
#pragma unroll
    for (int t = 0; t < 4; ++t) { const float vv = bf2f(PROJ[((size_t)TP + b * 4 + t) * NPROJ + C_VG + hh * 128 + dv]); float o = 0.f;
#pragma unroll
        for (int k = 0; k < 16; ++k) { const int c = 16 * cg + k; S[k] = la[t * 64 + c] * S[k] + ks[t * 64 + c] * vv; o += qs[t * 64 + c] * S[k]; }
        op[(cg * 4 + t) * 128 + dv] = o; }
    float* so = A.out + O_GLAS + (size_t)(b * 4 + hh) * 8192;
#pragma unroll
    for (int k = 0; k < 16; ++k) so[(16 * cg + k) * 128 + dv] = S[k];
    __syncthreads();
    { const int t = tid >> 7; of[t * 128 + dv] = (op[(0 * 4 + t) * 128 + dv] + op[(1 * 4 + t) * 128 + dv]) + (op[(2 * 4 + t) * 128 + dv] + op[(3 * 4 + t) * 128 + dv]); }
    __syncthreads();
    { const int t = tid >> 7; float ss = 0.f;
      for (int k = 0; k < 128; ++k) { const float v = of[t * 128 + k]; ss += v * v; }
      const float rstd = 1.0f / sqrtf(ss * (1.0f / 128.0f) + EPS); const size_t tok = (size_t)TP + b * 4 + t;
      const float gv = bf2f(PROJ[tok * NPROJ + C_GG + hh * 128 + dv]);
      const float y = of[t * 128 + dv] * rstd * A.in[15][dv] * gv / (1.0f + __expf(-gv));
      ((bf16*)(A.ws + WS_MIX))[tok * 1024 + 512 + hh * 128 + dv] = (bf16)f2bf(y); }
}

#ifdef PROBE_PHASE
#define PREP(k) ((PROBE_PHASE) == (k) ? 2 : 1)
#else
#define PREP(k) 1
#endif
__device__ __forceinline__ void phase2(const Frame& F, const Args& A) {
    LAS unsigned char* sh = F.lds;
    _Pragma("unroll 1") for (int rep = 0; rep < PREP(21); ++rep) { const int gw = F.vcu * NWAVES + F.wave, NGW = F.G * NWAVES; constexpr int NJP = 4 * 2 * 2 * 9, NJS = 32 * 2 * 2 * 17;
      for (int job = gw; job < NJP + NJS; job += NGW) {
          if (job >= NJS) { const int j = job - NJS; const int grp = j % 9, g = (j / 9) & 1, slot = (j / 18) & 1, b = j / 36;
#ifndef SKIP_CMP
 cmp_job<false>(A, b, slot, g, grp, opaque(F.lane));
#endif
 }
          else { const int grp = job % 17, g = (job / 17) & 1, slot = (job / 34) & 1, b = job / 68;
#ifndef SKIP_CMP
 cmp_job<true>(A, b, slot, g, grp, opaque(F.lane));
#endif
 }
      } }
    #ifndef SKIP_GLAL
    _Pragma("unroll 1") for (int rep = 0; rep < PREP(22); ++rep) for (int u = F.vcu; u < 256; u += F.G) gla_local(F, A, sh, u);
#endif
    #ifndef SKIP_GLAS
    _Pragma("unroll 1") for (int rep = 0; rep < PREP(24); ++rep) for (int u = F.vcu; u < 128; u += F.G) gla_sample(F, A, sh, u);
#endif
    __syncthreads();
    attn_fill_lut((LAS float*)(sh + AT_LUT), A.in[24], F.tid);
    __syncthreads();
    _Pragma("unroll 1") for (int rep = 0; rep < PREP(23); ++rep) for (int p = F.vcu; p < 256; p += F.G) { const int bg = p >> 5, s = p & 31;
#ifndef SKIP_WIN
 win_unit(F, A, sh, bg >> 1, bg & 1, 63 - s); win_unit(F, A, sh, bg >> 1, bg & 1, s);
#endif
 }
}
__device__ __forceinline__ void phase3(const Frame& F, const Args& A) {
    LAS unsigned char* sh = F.lds;
    #ifndef SKIP_GLAO
    _Pragma("unroll 1") for (int rep = 0; rep < PREP(31); ++rep) for (int u = F.vcu; u < 256; u += F.G) gla_out(F, A, sh, u);
#endif
    __syncthreads();
    attn_fill_lut((LAS float*)(sh + AT_LUT), A.in[24], F.tid);
    __syncthreads();
    #ifndef SKIP_SAMP
    _Pragma("unroll 1") for (int rep = 0; rep < PREP(32); ++rep) for (int u = F.vcu; u < 64; u += F.G) samp_unit(F, A, sh, u >> 1, u & 1);
#endif
    _Pragma("unroll 1") for (int rep = 0; rep < PREP(33); ++rep) for (int p = F.vcu; p < 256; p += F.G) { const int bg = p >> 5, s = p & 31;
#ifndef SKIP_NSA
 nsa_unit(F, A, sh, bg >> 1, bg & 1, 63 - s); nsa_unit(F, A, sh, bg >> 1, bg & 1, s);
#endif
 }
}

template <class Epi>
__device__ __forceinline__ void skinny_phase(const Frame& F, const bf16* Act, int lda, const bf16* Bt, int K, int njobs, const Epi& E) {
    const int lane = hw_lane(), w = F.wave, c16 = lane & 15, kg = lane >> 4;
    const int tok = TP + 16 * w + c16;
    for (int job = blockIdx.x; job < njobs; job += F.G) {
        const bf16* ap = Bt + (size_t)(16 * job + c16) * K + 8 * kg;
        const bf16* bp = Act + (size_t)tok * lda + 8 * kg;
        f32x4 acc = {0.f, 0.f, 0.f, 0.f};
#pragma unroll 8
        for (int ks = 0; ks < K / 32; ++ks) { const bf16x8 af = *(const bf16x8*)(ap + 32 * ks), bf = *(const bf16x8*)(bp + 32 * ks); acc = __builtin_amdgcn_mfma_f32_16x16x32_bf16(af, bf, acc, 0, 0, 0); }
        E(acc, tok, 16 * job + 4 * kg);
    }
}
struct SkInProj { bf16* proj; float* out;
    __device__ __forceinline__ void operator()(f32x4 v, int tok, int col) const {
        if (col < 512) v = v * 0.125f;
        v2u w; w.x = cvtpk(v[0], v[1]); w.y = cvtpk(v[2], v[3]); *(v2u*)(proj + (size_t)tok * NPROJ + col) = w;
        if (col >= C_KV && col < C_WIN) *(f32x4*)(out + O_KV + (size_t)tok * 512 + (col - C_KV)) = v;
        else if (col >= C_WIN && col < C_GT) { const int rs = tok - TP, b = rs >> 2, i = rs & 3; *(f32x4*)(out + O_WINS + ((size_t)(b * 512 + 508 + i) * 256 + (col - C_WIN))) = v; }
    } };
struct SkResid { const float* base; float* hout; bf16* hb; float* rowss;
    __device__ __forceinline__ void operator()(f32x4 v, int tok, int col) const {
        v = v + *(const f32x4*)(base + (size_t)(tok - TP) * 1024 + col);
        *(f32x4*)(hout + (size_t)tok * 1024 + col) = v;
        v2u w; w.x = cvtpk(v[0], v[1]); w.y = cvtpk(v[2], v[3]); *(v2u*)(hb + (size_t)tok * 1024 + col) = w;
        float ss = (v[0] * v[0] + v[1] * v[1]) + (v[2] * v[2] + v[3] * v[3]); ss += __shfl_xor(ss, 16); ss += __shfl_xor(ss, 32);
        if ((int)(__builtin_amdgcn_mbcnt_hi(~0u, __builtin_amdgcn_mbcnt_lo(~0u, 0u)) >> 4) == 0) atomicAdd(rowss + tok, ss);
    } };
struct SkBf { bf16* O; int ldc;
    __device__ __forceinline__ void operator()(f32x4 v, int tok, int col) const { v2u w; w.x = cvtpk(v[0], v[1]); w.y = cvtpk(v[2], v[3]); *(v2u*)(O + (size_t)tok * ldc + col) = w; } };
struct SkPleGate { const float* h2; const bf16* ple; const float* rowss2; float* y; float* rowss3;
    __device__ __forceinline__ void operator()(f32x4 a, int tok, int col) const {
        const float rstd = __builtin_amdgcn_rsqf(rowss2[tok] * (1.0f / 1024.0f) + EPS);
        const v2u pw = *(const v2u*)(ple + (size_t)tok * 1024 + col); const f32x4 b = *(const f32x4*)(h2 + (size_t)tok * 1024 + col);
        const float pv[4] = {bflo(pw.x), bfhi(pw.x), bflo(pw.y), bfhi(pw.y)}; f32x4 v;
#pragma unroll
        for (int e = 0; e < 4; ++e) v[e] = b[e] + pv[e] * __builtin_amdgcn_rcpf(1.0f + __expf(-a[e] * rstd));
        *(f32x4*)(y + (size_t)tok * 1024 + col) = v;
        float ss = (v[0] * v[0] + v[1] * v[1]) + (v[2] * v[2] + v[3] * v[3]); ss += __shfl_xor(ss, 16); ss += __shfl_xor(ss, 32);
        if ((int)(__builtin_amdgcn_mbcnt_hi(~0u, __builtin_amdgcn_mbcnt_lo(~0u, 0u)) >> 4) == 0) atomicAdd(rowss3 + tok, ss);
    } };

typedef const __attribute__((address_space(4))) Args* ArgsP;
__device__ __forceinline__ Args load_args() {
    Args r{};
#if defined(__HIP_DEVICE_COMPILE__)
    ArgsP p = (ArgsP)__builtin_amdgcn_kernarg_segment_ptr(); asm volatile("" : "+s"(p));
#pragma unroll
    for (int i = 0; i < 26; ++i) r.in[i] = p->in[i];
    r.out = p->out; r.ws = p->ws; r.ph_lo = p->ph_lo; r.ph_hi = p->ph_hi;
#endif
    return r;
}
__global__ void __launch_bounds__(NWAVES * 64, 2) mega_fwd(Args args_unused) {
    extern __shared__ __attribute__((aligned(16))) unsigned char lds_raw[];
    Frame F;
    F.lds = (LAS unsigned char*)lds_raw;
    F.wave = __builtin_amdgcn_readfirstlane((int)threadIdx.x >> 6); F.lane = hw_lane(); F.tid = F.wave * 64 + F.lane;
    F.G = gridDim.x; { const int bx = blockIdx.x; F.vcu = (F.G % 8 == 0) ? (bx % 8) * (F.G / 8) + bx / 8 : bx; }
    int lo, hi; unsigned char* ws;
    { const Args a0 = load_args(); lo = a0.ph_lo; hi = a0.ph_hi; ws = a0.ws; }
    gu32* ctl = (gu32*)(ws + WS_CTL);
    volatile LAS unsigned* MISC = (volatile LAS unsigned*)(F.lds + MISC_OFF);
    for (int u = F.tid; u < (LDS_BYTES - RING_BYTES) / 4; u += NWAVES * 64) ((LAS unsigned*)(F.lds + RING_BYTES))[u] = 0u;
    __syncthreads();
    const bool multi = (hi - lo) > 1;
    XcdBarrier bar; bar.bar = (unsigned*)(ctl + CW_BAR); bar.x = 0; bar.st = nullptr;
    if (multi) bar = xcd_barrier_post((unsigned*)(ctl + CW_BAR), MISC + 8, F.tid);
#define IN(k) (lo <= (k) && (k) < hi)
#ifdef PROBE_PHASE
#define NREP(k) ((PROBE_PHASE) == (k) ? 2 : 1)
#else
#define NREP(k) 1
#endif
    float* dummy_rowss = (float*)(ws + WS_END);
#define SEAM(k) do { if (IN(k) && IN((k) + 1)) { F.lane = hw_lane(); F.tid = F.wave * 64 + F.lane; xcd_barrier(bar, F.tid); } } while (0)
#define REFRESH() do { F.lane = hw_lane(); F.tid = F.wave * 64 + F.lane; } while (0)

    if (IN(0)) { REFRESH(); const Args args = load_args(); _Pragma("unroll 1") for (int rep = 0; rep < NREP(0); ++rep) { __syncthreads(); p0_prologue(F, args); } } SEAM(0);
    if (IN(1)) { REFRESH(); const Args args = load_args(); unsigned char* ws = args.ws;
        pg8::Gemm g{(const pg8::bf16_t*)(ws + WS_XN), (const pg8::bf16_t*)(ws + WS_WIN), TP, NPROJ, 1024}; pg8::StaticOrder S; S.init(TP, NPROJ, F.G, (int)blockIdx.x);
        pg8::EpiInProj E{(pg8::bf16_t*)(ws + WS_PROJ), args.out};
        _Pragma("unroll 1") for (int rep = 0; rep < NREP(1); ++rep) pg8::gemm_phase<pg8::EpiInProj, pg8::StaticOrder, true, true>(F.lds, g, S, E, F.tid);
        skinny_phase(F, (const bf16*)(ws + WS_XN), 1024, (const bf16*)(ws + WS_WIN), 1024, (NIN + 15) / 16, SkInProj{(bf16*)(ws + WS_PROJ), args.out});
    } SEAM(1);
    if (IN(2)) { REFRESH(); const Args args = load_args(); phase2(F, args); } SEAM(2);
    if (IN(3)) { REFRESH(); const Args args = load_args(); phase3(F, args); } SEAM(3);
    if (IN(4)) { REFRESH(); const Args args = load_args(); unsigned char* ws = args.ws; float* rowss1 = (float*)(ws + WS_ROWSS);
        { pg8::Gemm g{(const pg8::bf16_t*)(ws + WS_MIX), (const pg8::bf16_t*)(ws + WS_WO), TP, 1024, 1024}; pg8::StaticOrder S; S.init(TP, 1024, F.G, (int)blockIdx.x);
          _Pragma("unroll 1") for (int rep = 0; rep < NREP(4); ++rep) { pg8::EpiResid E{args.in[0], args.in[1], (float*)(ws + WS_H1), (pg8::bf16_t*)(ws + WS_H1B), rep ? dummy_rowss : rowss1};
          pg8::gemm_phase<pg8::EpiResid, pg8::StaticOrder, true, true>(F.lds, g, S, E, F.tid); } }
        { pg8::Gemm g{(const pg8::bf16_t*)(ws + WS_PPLE), (const pg8::bf16_t*)(ws + WS_WPLE), TP, 1024, 256}; pg8::StaticOrder S; S.init(TP, 1024, F.G, (int)blockIdx.x);
          pg8::EpiBf E{(pg8::bf16_t*)(ws + WS_PLEB), 1024};
          _Pragma("unroll 1") for (int rep = 0; rep < NREP(41); ++rep) pg8::gemm_phase<pg8::EpiBf, pg8::StaticOrder, true, true>(F.lds, g, S, E, F.tid); }
        skinny_phase(F, (const bf16*)(ws + WS_MIX), 1024, (const bf16*)(ws + WS_WO), 1024, 64, SkResid{args.in[1], (float*)(ws + WS_H1), (bf16*)(ws + WS_H1B), rowss1});
        skinny_phase(F, (const bf16*)(ws + WS_PPLE), 256, (const bf16*)(ws + WS_WPLE), 256, 64, SkBf{(bf16*)(ws + WS_PLEB), 1024});
    } SEAM(4);
    if (IN(5)) { REFRESH(); const Args args = load_args(); unsigned char* ws = args.ws; float* rowss1 = (float*)(ws + WS_ROWSS);
        pg8::Gemm g{(const pg8::bf16_t*)(ws + WS_H1B), (const pg8::bf16_t*)(ws + WS_WGU), MPAD, NGU, 1024}; pg8::StaticOrder S; S.init(MPAD, NGU, F.G, (int)blockIdx.x);
        pg8::EpiGateUp E{(pg8::bf16_t*)(ws + WS_ACT), rowss1};
        _Pragma("unroll 1") for (int rep = 0; rep < NREP(5); ++rep) pg8::gemm_phase<pg8::EpiGateUp, pg8::StaticOrder, true, true>(F.lds, g, S, E, F.tid);
    } SEAM(5);
    if (IN(6)) { REFRESH(); const Args args = load_args(); unsigned char* ws = args.ws; float* rowss2 = (float*)(ws + WS_ROWSS) + MPAD;
        pg8::Gemm g{(const pg8::bf16_t*)(ws + WS_ACT), (const pg8::bf16_t*)(ws + WS_WDN), TP, 1024, DFF}; pg8::StaticOrder S; S.init(TP, 1024, F.G, (int)blockIdx.x);
        _Pragma("unroll 1") for (int rep = 0; rep < NREP(6); ++rep) { pg8::EpiResid E{(const float*)(ws + WS_H1), (const float*)(ws + WS_H1) + (size_t)TP * 1024, (float*)(ws + WS_H2), (pg8::bf16_t*)(ws + WS_H2B), rep ? dummy_rowss : rowss2};
        pg8::gemm_phase<pg8::EpiResid, pg8::StaticOrder, true, true>(F.lds, g, S, E, F.tid); }
        skinny_phase(F, (const bf16*)(ws + WS_ACT), DFF, (const bf16*)(ws + WS_WDN), DFF, 64, SkResid{(const float*)(ws + WS_H1) + (size_t)TP * 1024, (float*)(ws + WS_H2), (bf16*)(ws + WS_H2B), rowss2});
    } SEAM(6);
    if (IN(7)) { REFRESH(); const Args args = load_args(); unsigned char* ws = args.ws; float* rowss2 = (float*)(ws + WS_ROWSS) + MPAD; float* rowss3 = rowss2 + MPAD;
        pg8::Gemm g{(const pg8::bf16_t*)(ws + WS_H2B), (const pg8::bf16_t*)(ws + WS_WPG), TP, 1024, 1024}; pg8::StaticOrder S; S.init(TP, 1024, F.G, (int)blockIdx.x);
        _Pragma("unroll 1") for (int rep = 0; rep < NREP(7); ++rep) { pg8::EpiPleGate E{(const float*)(ws + WS_H2), (const pg8::bf16_t*)(ws + WS_PLEB), rowss2, args.out + O_Y, rep ? dummy_rowss : rowss3};
        pg8::gemm_phase<pg8::EpiPleGate, pg8::StaticOrder, true, true>(F.lds, g, S, E, F.tid); }
        skinny_phase(F, (const bf16*)(ws + WS_H2B), 1024, (const bf16*)(ws + WS_WPG), 1024, 64, SkPleGate{(const float*)(ws + WS_H2), (const bf16*)(ws + WS_PLEB), rowss2, args.out + O_Y, rowss3});
    } SEAM(7);
    if (IN(8)) { REFRESH(); const Args args = load_args(); unsigned char* ws = args.ws; float* rowss3 = (float*)(ws + WS_ROWSS) + 2 * MPAD;
        const int gw = F.vcu * NWAVES + F.wave, NGW = F.G * NWAVES; const GAS f32x4* gr = (const GAS f32x4*)args.in[25] + F.lane;
        for (int m = gw; m < MTOT; m += NGW) { GAS f32x4* yr = (GAS f32x4*)(args.out + O_Y + (size_t)m * 1024) + F.lane; const float rstd = 1.0f / sqrtf(rowss3[m] * (1.0f / 1024.0f) + EPS);
#pragma unroll
            for (int j = 0; j < 4; ++j) { const f32x4 v = yr[64 * j], gg = gr[64 * j]; yr[64 * j] = (f32x4){v.x * rstd * gg.x, v.y * rstd * gg.y, v.z * rstd * gg.z, v.w * rstd * gg.w}; } }
    }
#undef IN
#undef SEAM
#undef REFRESH
}

extern "C" void kernel_launch(void* const* d_in, const int* in_sizes, int n_in, void* d_out, int out_size, void* d_ws, size_t ws_size, hipStream_t stream) {
    static int grid = 0;
    if (grid == 0) {
        if (n_in != 26 || (size_t)out_size != O_END || ws_size < WS_END + (1u << 20)) { fprintf(stderr, "kernel_launch: unexpected shapes: n_in %d out %d ws %zu\n", n_in, out_size, ws_size); grid = -1; return; }
        int dev = 0, cus = 0, per_cu = 0;
        if (hipGetDevice(&dev) != hipSuccess || hipDeviceGetAttribute(&cus, hipDeviceAttributeMultiprocessorCount, dev) != hipSuccess) { grid = -1; return; }
        if (hipFuncSetAttribute((const void*)mega_fwd, hipFuncAttributeMaxDynamicSharedMemorySize, LDS_BYTES) != hipSuccess) { fprintf(stderr, "kernel_launch: hipFuncSetAttribute failed\n"); grid = -1; return; }
        if (hipOccupancyMaxActiveBlocksPerMultiprocessor(&per_cu, (const void*)mega_fwd, NWAVES * 64, LDS_BYTES) != hipSuccess || per_cu < 1) { fprintf(stderr, "kernel_launch: occupancy query says %d blocks per CU\n", per_cu); grid = -1; return; }
        (void)hipGetLastError();
        grid = cus;
    }
    if (grid < 0) return;
    (void)hipMemsetAsync((char*)d_ws + WS_CTL, 0, CTL_ZERO_BYTES, stream);
    Args a{};
    for (int i = 0; i < 26; ++i) a.in[i] = (const float*)d_in[i];
    a.out = (float*)d_out; a.ws = (unsigned char*)d_ws;
#ifndef N_LAUNCH_SPLIT
    a.ph_lo = 0; a.ph_hi = 9;
    hipLaunchKernelGGL(mega_fwd, dim3(grid), dim3(NWAVES * 64), LDS_BYTES, stream, a);
#else
    for (int p = 0; p < 9; ++p) { a.ph_lo = p; a.ph_hi = p + 1; hipLaunchKernelGGL(mega_fwd, dim3(grid), dim3(NWAVES * 64), LDS_BYTES, stream, a); }
#endif
}
```

```cpp
#include <hip/hip_runtime.h>
#include <cstdio>
#include <cstdint>

constexpr int DM = 1024, TP = 16384, TS = 128, MTOT = TP + TS, MPAD = 16640, SEQ = 4096, NBATCH = 4, DBATCH = 32, DSEQ = 4, PAST = 8192;
constexpr int NPROJ = 3072, DFF = 2816, DPLE = 256, NGU = 2 * DFF;
constexpr int C_QN = 0, C_KV = 512, C_WIN = 1024, C_GT = 1280, C_QG = 1304, C_KG = 1560, C_VG = 1816, C_LR = 2328, C_GG = 2344, NIN = 2856;
constexpr float EPS = 1e-6f;
constexpr size_t O_Y = 0, O_KV = (size_t)MTOT * 1024, O_WINP = O_KV + (size_t)MTOT * 512, O_WINS = O_WINP + 4 * 512 * 256,
                 O_GLAP = O_WINS + (size_t)32 * 512 * 256, O_GLAS = O_GLAP + 4 * 4 * 64 * 128, O_END = O_GLAS + (size_t)32 * 4 * 64 * 128;
namespace pg8 {
#define PG8_LAS __attribute__((address_space(3)))
typedef unsigned short bf16_t;
typedef short bf16x8 __attribute__((ext_vector_type(8)));
typedef float f32x4 __attribute__((ext_vector_type(4)));
typedef unsigned u32x4 __attribute__((ext_vector_type(4)));
constexpr int BM = 256, BK = 64, HALF = 128, HTB = HALF * BK * 2  , STAGE_BYTES = 8 * HTB, NXCD = 8, WGM = 8;

__host__ __device__ __forceinline__ int lds_byte(int r, int c) { const int st = (r >> 4) * 2 + (c >> 5), rr = r & 15, cc = c & 31, ob = rr * 64 + cc * 2; return st * 1024 + (ob ^ (((ob >> 9) & 1) << 5)); }
__host__ __device__ __forceinline__ void stage_rc(int b, int& R, int& C) { const int st = b / 1024, sb = b % 1024, swz = sb ^ (((sb >> 9) & 1) << 5); R = (st >> 1) * 16 + swz / 64; C = (st & 1) * 32 + (swz % 64) / 2; }
__host__ __device__ __forceinline__ int perm32(int rho) { const int n = rho >> 4, i = rho & 15; return 8 * (i >> 2) + 4 * n + (i & 3); }

struct Unit { int pm, pn; };
struct Gemm { const bf16_t* A; const bf16_t* Bt; int M, N, K; };

struct StaticOrder {
    int nM, nN, nwg, G, c;
    __host__ __device__ void init(int M, int N, int G_, int c_) { nM = M / BM; nN = N / BM; nwg = nM * nN; G = G_; c = c_; }
    __host__ __device__ bool next(int i, Unit& u) const {
        const long L = (long)i * G + c; if (L >= nwg) return false;
        int wgid = (int)L; { const int q = nwg / NXCD, r = nwg % NXCD, xcd = wgid % NXCD, off = wgid / NXCD; wgid = (xcd < r ? xcd * (q + 1) : r * (q + 1) + (xcd - r) * q) + off; }
        const int nig = WGM * nN, gid = wgid / nig, fm = gid * WGM, gsz = (nM - fm) < WGM ? (nM - fm) : WGM;
        u.pm = fm + ((wgid % nig) % gsz); u.pn = (wgid % nig) / gsz; return true;
    }
    __device__ __forceinline__ void a_ready(const Unit&) const {}
    __device__ __forceinline__ void done(const Unit&) const {}
};

__device__ __forceinline__ unsigned cvt_pk_bf16(float lo, float hi) { unsigned r; asm volatile("v_cvt_pk_bf16_f32 %0, %1, %2" : "=v"(r) : "v"(lo), "v"(hi)); return r; }

__device__ __forceinline__ u32x4 pack8(const f32x4 v0, const f32x4 v1) { u32x4 w; w.x = cvt_pk_bf16(v0[0], v0[1]); w.y = cvt_pk_bf16(v0[2], v0[3]); w.z = cvt_pk_bf16(v1[0], v1[1]); w.w = cvt_pk_bf16(v1[2], v1[3]); return w; }

struct EpiInProj {
    static constexpr bool PERM = true, AFTER_DRAIN = false;
    bf16_t* proj; float* out;
    __device__ __forceinline__ void operator()(const f32x4 (&acc)[2][2][4][2], const Unit& u, int wr, int wc, int fr, int fq) const {
        const int row0 = u.pm * BM + wr * 64 + fr, colb = u.pn * BM + wc * 32 + 8 * fq;
        const float sc = (u.pn < 2) ? 0.125f : 1.0f;
#pragma unroll
        for (int ai = 0; ai < 2; ++ai)
#pragma unroll
            for (int m = 0; m < 4; ++m) {
                const int r = row0 + ai * HALF + m * 16;
                if (r < MTOT) {
#pragma unroll
                    for (int bj = 0; bj < 2; ++bj) {
                        const int c = colb + bj * HALF;
                        const f32x4 v0 = acc[ai][bj][m][0] * sc, v1 = acc[ai][bj][m][1] * sc;
                        *(u32x4*)(proj + (size_t)r * NPROJ + c) = pack8(v0, v1);
                        if (u.pn == 2 || u.pn == 3) { float* o = out + O_KV + (size_t)r * 512 + (c - C_KV); *(f32x4*)o = v0; *(f32x4*)(o + 4) = v1; }
                        if (u.pn == 4) {
                            const int cc = c - C_WIN; float* o = nullptr;
                            if (r < TP) { const int pos = r & (SEQ - 1), b = r >> 12; if (pos >= SEQ - 512) o = out + O_WINP + ((size_t)(b * 512 + pos - (SEQ - 512)) * 256 + cc); }
                            else { const int rs = r - TP, b = rs >> 2, i = rs & 3; o = out + O_WINS + ((size_t)(b * 512 + 508 + i) * 256 + cc); }
                            if (o) { *(f32x4*)o = v0; *(f32x4*)(o + 4) = v1; }
                        }
                    }
                }
            }
    }
};
struct EpiResid {
    static constexpr bool PERM = true, AFTER_DRAIN = false;
    const float* baseA; const float* baseB;
    float* hout; bf16_t* hb; float* rowss;
    __device__ __forceinline__ void operator()(const f32x4 (&acc)[2][2][4][2], const Unit& u, int wr, int wc, int fr, int fq) const {
        const int row0 = u.pm * BM + wr * 64 + fr, colb = u.pn * BM + wc * 32 + 8 * fq;
#pragma unroll
        for (int ai = 0; ai < 2; ++ai)
#pragma unroll
            for (int m = 0; m < 4; ++m) {
                const int r = row0 + ai * HALF + m * 16;
                float ss = 0.f;
                if (r < MTOT) {
                    const float* bp = (r < TP) ? baseA + (size_t)r * 1024 : baseB + (size_t)(r - TP) * 1024;
#pragma unroll
                    for (int bj = 0; bj < 2; ++bj) {
                        const int c = colb + bj * HALF;
                        const f32x4 v0 = acc[ai][bj][m][0] + *(const f32x4*)(bp + c), v1 = acc[ai][bj][m][1] + *(const f32x4*)(bp + c + 4);
                        float* o = hout + (size_t)r * 1024 + c; *(f32x4*)o = v0; *(f32x4*)(o + 4) = v1;
                        *(u32x4*)(hb + (size_t)r * 1024 + c) = pack8(v0, v1);
                        ss += (v0[0] * v0[0] + v0[1] * v0[1]) + (v0[2] * v0[2] + v0[3] * v0[3]) + (v1[0] * v1[0] + v1[1] * v1[1]) + (v1[2] * v1[2] + v1[3] * v1[3]);
                    }
                }
                ss += __shfl_xor(ss, 16); ss += __shfl_xor(ss, 32);
                if (fq == 0 && r < MTOT) atomicAdd(rowss + r, ss);
            }
    }
};
struct EpiGateUp {
    static constexpr bool PERM = true, AFTER_DRAIN = false;
    bf16_t* act; const float* rowss;
    __device__ __forceinline__ void operator()(const f32x4 (&acc)[2][2][4][2], const Unit& u, int wr, int wc, int fr, int fq) const {
        const int row0 = u.pm * BM + wr * 64 + fr, colb = u.pn * HALF + wc * 32 + 8 * fq;
#pragma unroll
        for (int ai = 0; ai < 2; ++ai)
#pragma unroll
            for (int m = 0; m < 4; ++m) {
                const int r = row0 + ai * HALF + m * 16;
                if (r < MTOT) {
                    const float rstd = __builtin_amdgcn_rsqf(rowss[r] * (1.0f / 1024.0f) + EPS);
                    f32x4 o[2];
#pragma unroll
                    for (int n = 0; n < 2; ++n)
#pragma unroll
                        for (int e = 0; e < 4; ++e) { const float g = acc[ai][0][m][n][e] * rstd, up = acc[ai][1][m][n][e] * rstd; o[n][e] = g * up * __builtin_amdgcn_rcpf(1.0f + __expf(-g)); }
                    *(u32x4*)(act + (size_t)r * DFF + colb) = pack8(o[0], o[1]);
                }
            }
    }
};
struct EpiBf {
    static constexpr bool PERM = true, AFTER_DRAIN = false;
    bf16_t* O; int ldc;
    __device__ __forceinline__ void operator()(const f32x4 (&acc)[2][2][4][2], const Unit& u, int wr, int wc, int fr, int fq) const {
        const int row0 = u.pm * BM + wr * 64 + fr, colb = u.pn * BM + wc * 32 + 8 * fq;
#pragma unroll
        for (int ai = 0; ai < 2; ++ai)
#pragma unroll
            for (int m = 0; m < 4; ++m) {
                const int r = row0 + ai * HALF + m * 16;
                if (r < MTOT) {
#pragma unroll
                    for (int bj = 0; bj < 2; ++bj) *(u32x4*)(O + (size_t)r * ldc + colb + bj * HALF) = pack8(acc[ai][bj][m][0], acc[ai][bj][m][1]);
                }
            }
    }
};
struct EpiPleGate {
    static constexpr bool PERM = true, AFTER_DRAIN = false;
    const float* h2; const bf16_t* ple; const float* rowss2; float* y; float* rowss3;
    __device__ __forceinline__ void operator()(const f32x4 (&acc)[2][2][4][2], const Unit& u, int wr, int wc, int fr, int fq) const {
        const int row0 = u.pm * BM + wr * 64 + fr, colb = u.pn * BM + wc * 32 + 8 * fq;
#pragma unroll
        for (int ai = 0; ai < 2; ++ai)
#pragma unroll
            for (int m = 0; m < 4; ++m) {
                const int r = row0 + ai * HALF + m * 16;
                float ss = 0.f;
                if (r < MTOT) {
                    const float rstd = __builtin_amdgcn_rsqf(rowss2[r] * (1.0f / 1024.0f) + EPS);
#pragma unroll
                    for (int bj = 0; bj < 2; ++bj) {
                        const int c = colb + bj * HALF;
                        const u32x4 pw = *(const u32x4*)(ple + (size_t)r * 1024 + c);
                        const f32x4 b0 = *(const f32x4*)(h2 + (size_t)r * 1024 + c), b1 = *(const f32x4*)(h2 + (size_t)r * 1024 + c + 4);
                        float pv[8];
#pragma unroll
                        for (int e = 0; e < 4; ++e) { pv[2 * e] = __uint_as_float(pw[e] << 16); pv[2 * e + 1] = __uint_as_float(pw[e] & 0xffff0000u); }
                        f32x4 v0, v1;
#pragma unroll
                        for (int e = 0; e < 4; ++e) {
                            v0[e] = b0[e] + pv[e] * __builtin_amdgcn_rcpf(1.0f + __expf(-acc[ai][bj][m][0][e] * rstd));
                            v1[e] = b1[e] + pv[4 + e] * __builtin_amdgcn_rcpf(1.0f + __expf(-acc[ai][bj][m][1][e] * rstd));
                        }
                        float* o = y + (size_t)r * 1024 + c; *(f32x4*)o = v0; *(f32x4*)(o + 4) = v1;
                        ss += (v0[0] * v0[0] + v0[1] * v0[1]) + (v0[2] * v0[2] + v0[3] * v0[3]) + (v1[0] * v1[0] + v1[1] * v1[1]) + (v1[2] * v1[2] + v1[3] * v1[3]);
                    }
                }
                ss += __shfl_xor(ss, 16); ss += __shfl_xor(ss, 32);
                if (fq == 0 && r < MTOT) atomicAdd(rowss3 + r, ss);
            }
    }
};
template <class Epi, class Sched, bool ALIGN_EPI = false, bool SP2 = false>
__device__ __forceinline__ void gemm_phase(PG8_LAS unsigned char* lds, const Gemm g, const Sched& S, const Epi& E, const int tid) {
    const int wid = __builtin_amdgcn_readfirstlane(tid >> 6), lane = tid & 63, wr = wid >> 2, wc = wid & 3, fr = lane & 15, fq = lane >> 4;
    const int K = g.K, nt = K / BK;
    unsigned voffA[2], voffB[2];
#pragma unroll
    for (int i = 0; i < 2; ++i) { int R, C; stage_rc(tid * 16 + i * 8192, R, C); const int Rb = Epi::PERM ? ((R & ~31) + perm32(R & 31)) : R;
        voffA[i] = (unsigned)(R * K + C) * 2u; voffB[i] = (unsigned)(Rb * K + C) * 2u; }
    const size_t kstep = (size_t)(BK * 2);
    const size_t hstep = (size_t)HALF * K * 2;
    const size_t tstep = 2 * hstep;
    const unsigned ldsw = (unsigned)wid * 1024u;
    const int aoff = lds_byte(wr * 64 + fr, fq * 8), boff = lds_byte(wc * 32 + fr, fq * 8);
#define PG8_SA(b, h) (((b) * 2 + (h)) * HTB)
#define PG8_SB(b, h) ((4 + (b) * 2 + (h)) * HTB)
#define PG8_STAGE(bufoff, gbase, voff) do { _Pragma("unroll") for (int _i = 0; _i < 2; ++_i) \
        __builtin_amdgcn_global_load_lds((const unsigned*)((const char*)(gbase) + (voff)[_i]), (PG8_LAS unsigned*)(lds + (bufoff) + ldsw + _i * 8192), 16, 0, 0); } while (0)
#define PG8_LDA(dst, b, h) do { _Pragma("unroll") for (int m = 0; m < 4; ++m) _Pragma("unroll") for (int k = 0; k < 2; ++k) dst[m][k] = *(const PG8_LAS bf16x8*)(lds + PG8_SA(b, h) + aoff + m * 2048 + k * 1024); } while (0)
#define PG8_LDB(dst, b, h) do { _Pragma("unroll") for (int n = 0; n < 2; ++n) _Pragma("unroll") for (int k = 0; k < 2; ++k) dst[n][k] = *(const PG8_LAS bf16x8*)(lds + PG8_SB(b, h) + boff + n * 2048 + k * 1024); } while (0)
#define PG8_MMA(ai, bj, At, Bt) do { __builtin_amdgcn_s_setprio(1); _Pragma("unroll") for (int m = 0; m < 4; ++m) _Pragma("unroll") for (int n = 0; n < 2; ++n) _Pragma("unroll") for (int k = 0; k < 2; ++k) \
        acc[ai][bj][m][n] = __builtin_amdgcn_mfma_f32_16x16x32_bf16(Bt[n][k], At[m][k], acc[ai][bj][m][n], 0, 0, 0); __builtin_amdgcn_s_setprio(0); } while (0)
#define PG8_WAIT_V(n) asm volatile("s_waitcnt vmcnt(" #n ")" ::: "memory")
#define PG8_WAIT_L(n) asm volatile("s_waitcnt lgkmcnt(" #n ")" ::: "memory")
#define PG8_BAR __builtin_amdgcn_s_barrier()
#define PG8_SCHED __builtin_amdgcn_sched_barrier(0)
    Unit cur, nxt; int ui = 0;
    if (!S.next(0, cur)) return;
    f32x4 acc[2][2][4][2];
#pragma unroll
    for (int a = 0; a < 2; ++a)
#pragma unroll
        for (int b = 0; b < 2; ++b)
#pragma unroll
            for (int m = 0; m < 4; ++m)
#pragma unroll
                for (int n = 0; n < 2; ++n) acc[a][b][m][n] = (f32x4){0.f, 0.f, 0.f, 0.f};
    bf16x8 At[4][2], B0[2][2], B1[2][2];
    const char* cA = (const char*)g.A + (size_t)cur.pm * tstep; const char* cB = (const char*)g.Bt + (size_t)cur.pn * tstep;
    S.a_ready(cur);
    if constexpr (SP2) {
        PG8_STAGE(PG8_SB(0, 0), cB, voffB); PG8_STAGE(PG8_SB(0, 1), cB + hstep, voffB); PG8_STAGE(PG8_SA(0, 0), cA, voffA); PG8_STAGE(PG8_SA(0, 1), cA + hstep, voffA);
        if (wr == 1) PG8_BAR;
        PG8_WAIT_V(2); PG8_BAR;
        PG8_STAGE(PG8_SB(1, 0), cB + kstep, voffB); PG8_STAGE(PG8_SA(1, 0), cA + kstep, voffA); PG8_STAGE(PG8_SB(1, 1), cB + hstep + kstep, voffB);
        PG8_WAIT_V(6); PG8_BAR;
    } else {
        PG8_STAGE(PG8_SB(0, 0), cB, voffB); PG8_STAGE(PG8_SA(0, 0), cA, voffA); PG8_STAGE(PG8_SB(0, 1), cB + hstep, voffB); PG8_STAGE(PG8_SA(0, 1), cA + hstep, voffA);
        if (wr == 1) PG8_BAR;
        PG8_WAIT_V(4); PG8_BAR;
        PG8_STAGE(PG8_SB(1, 0), cB + kstep, voffB); PG8_STAGE(PG8_SA(1, 0), cA + kstep, voffA); PG8_STAGE(PG8_SB(1, 1), cB + hstep + kstep, voffB);
        PG8_WAIT_V(6); PG8_BAR;
    }
    for (;;) {
        const bool has_next = S.next(ui + 1, nxt);
        const char* nA = has_next ? (const char*)g.A + (size_t)nxt.pm * tstep : cA; const char* nB = has_next ? (const char*)g.Bt + (size_t)nxt.pn * tstep : cB;
        for (int t = 0; t < nt; t += 2) {
            const bool last = (t == nt - 2);
            const char* a1 = cA + (size_t)(t + 1) * kstep;
            const char* a2 = last ? nA : cA + (size_t)(t + 2) * kstep; const char* b2 = last ? nB : cB + (size_t)(t + 2) * kstep;
            const char* a3 = a2 + kstep; const char* b3 = b2 + kstep;
            if (last && has_next) S.a_ready(nxt);
            if constexpr (SP2) {
            PG8_LDB(B0, 0, 0); PG8_LDB(B1, 0, 1); PG8_SCHED; PG8_LDA(At, 0, 0); PG8_STAGE(PG8_SA(1, 1), a1 + hstep, voffA);
            PG8_WAIT_V(8); PG8_WAIT_L(0); PG8_BAR; PG8_MMA(0, 0, At, B0); PG8_MMA(0, 1, At, B1); PG8_BAR; PG8_SCHED;
            PG8_LDA(At, 0, 1); PG8_STAGE(PG8_SB(0, 0), b2, voffB); PG8_STAGE(PG8_SB(0, 1), b2 + hstep, voffB); PG8_STAGE(PG8_SA(0, 0), a2, voffA);
            PG8_WAIT_V(8); PG8_WAIT_L(0); PG8_BAR; PG8_MMA(1, 0, At, B0); PG8_MMA(1, 1, At, B1); PG8_BAR; PG8_SCHED;
            PG8_LDB(B0, 1, 0); PG8_LDB(B1, 1, 1); PG8_SCHED; PG8_LDA(At, 1, 0); PG8_STAGE(PG8_SA(0, 1), a2 + hstep, voffA);
            PG8_WAIT_V(8); PG8_WAIT_L(0); PG8_BAR; PG8_MMA(0, 0, At, B0); PG8_MMA(0, 1, At, B1); PG8_BAR; PG8_SCHED;
            PG8_LDA(At, 1, 1); PG8_STAGE(PG8_SB(1, 0), b3, voffB); PG8_STAGE(PG8_SB(1, 1), b3 + hstep, voffB); PG8_STAGE(PG8_SA(1, 0), a3, voffA);
            PG8_WAIT_V(8); PG8_WAIT_L(0); PG8_BAR; PG8_MMA(1, 0, At, B0); PG8_MMA(1, 1, At, B1); PG8_BAR; PG8_SCHED;
            } else {
            PG8_LDB(B0, 0, 0); PG8_SCHED; PG8_LDA(At, 0, 0); PG8_STAGE(PG8_SA(1, 1), a1 + hstep, voffA);
            PG8_WAIT_L(8); PG8_BAR; PG8_WAIT_L(0); PG8_MMA(0, 0, At, B0); PG8_BAR; PG8_SCHED;
            PG8_LDB(B1, 0, 1); PG8_STAGE(PG8_SB(0, 0), b2, voffB);
            PG8_BAR; PG8_WAIT_L(0); PG8_MMA(0, 1, At, B1); PG8_BAR;
            PG8_LDA(At, 0, 1); PG8_STAGE(PG8_SA(0, 0), a2, voffA);
            PG8_BAR; PG8_WAIT_L(0); PG8_MMA(1, 0, At, B0); PG8_BAR; PG8_SCHED;
            PG8_STAGE(PG8_SB(0, 1), b2 + hstep, voffB);
            PG8_WAIT_V(6); PG8_BAR; PG8_MMA(1, 1, At, B1); PG8_BAR;
            PG8_LDB(B0, 1, 0); PG8_SCHED; PG8_LDA(At, 1, 0); PG8_STAGE(PG8_SA(0, 1), a2 + hstep, voffA);
            PG8_WAIT_L(8); PG8_BAR; PG8_WAIT_L(0); PG8_MMA(0, 0, At, B0); PG8_BAR; PG8_SCHED;
            PG8_LDB(B1, 1, 1); PG8_STAGE(PG8_SB(1, 0), b3, voffB);
            PG8_BAR; PG8_WAIT_L(0); PG8_MMA(0, 1, At, B1); PG8_BAR;
            PG8_LDA(At, 1, 1); PG8_STAGE(PG8_SA(1, 0), a3, voffA);
            PG8_BAR; PG8_WAIT_L(0); PG8_MMA(1, 0, At, B0); PG8_BAR; PG8_SCHED;
            PG8_STAGE(PG8_SB(1, 1), b3 + hstep, voffB);
            PG8_WAIT_V(6); PG8_BAR; PG8_MMA(1, 1, At, B1); PG8_BAR;
            }
        }
        if constexpr (ALIGN_EPI) { if (wr == 0) PG8_BAR; }
        if constexpr (!Epi::AFTER_DRAIN) { E(acc, cur, wr, wc, fr, fq); S.done(cur); }
        if (!has_next) break;
#pragma unroll
        for (int a = 0; a < 2; ++a)
#pragma unroll
            for (int b = 0; b < 2; ++b)
#pragma unroll
                for (int m = 0; m < 4; ++m)
#pragma unroll
                    for (int n = 0; n < 2; ++n) acc[a][b][m][n] = (f32x4){0.f, 0.f, 0.f, 0.f};
        cur = nxt; cA = nA; cB = nB; ++ui;
        if constexpr (ALIGN_EPI) { if (wr == 1) PG8_BAR; }
    }
    PG8_WAIT_V(0);
    if constexpr (!ALIGN_EPI) { if (wr == 0) PG8_BAR; }
    PG8_BAR;
    if constexpr (Epi::AFTER_DRAIN) { E.fused(acc, cur, wr, wc, fr, fq, lds, wid, lane); S.done(cur); }
#undef PG8_SA
#undef PG8_SB
#undef PG8_STAGE
#undef PG8_LDA
#undef PG8_LDB
#undef PG8_MMA
#undef PG8_WAIT_V
#undef PG8_WAIT_L
#undef PG8_BAR
#undef PG8_SCHED
}
}


#define GAS __attribute__((address_space(1)))
#define LAS __attribute__((address_space(3)))
typedef unsigned short bf16;
typedef unsigned v4u __attribute__((ext_vector_type(4)));
typedef unsigned v2u __attribute__((ext_vector_type(2)));
typedef float f32x4 __attribute__((ext_vector_type(4)));
typedef float f32x2 __attribute__((ext_vector_type(2)));
typedef float f32x16 __attribute__((ext_vector_type(16)));
typedef short bf16x8 __attribute__((ext_vector_type(8)));
typedef short s16x4 __attribute__((ext_vector_type(4)));
typedef GAS unsigned gu32;
#define RLX_AGENT __ATOMIC_RELAXED, __HIP_MEMORY_SCOPE_AGENT
#define LDS_WAIT() asm volatile("s_waitcnt lgkmcnt(0)" ::: "memory")
#define VM_WAIT() asm volatile("s_waitcnt vmcnt(0)" ::: "memory")
__device__ __forceinline__ unsigned f2bf(float f) { unsigned u = __builtin_bit_cast(unsigned, f); return (u + 0x7fffu + ((u >> 16) & 1u)) >> 16; }
__device__ __forceinline__ unsigned pk2(float lo, float hi) { return f2bf(lo) | (f2bf(hi) << 16); }
__device__ __forceinline__ float bf2f(unsigned short h) { return __uint_as_float(((unsigned)h) << 16); }
__device__ __forceinline__ float bflo(unsigned w) { return __uint_as_float(w << 16); }
__device__ __forceinline__ float bfhi(unsigned w) { return __uint_as_float(w & 0xffff0000u); }

constexpr int NWAVES = 8;
constexpr size_t MiB = 1u << 20;
constexpr size_t WS_CTL = 0, CTL_ZERO_BYTES = 1 * MiB;
constexpr int CW_BAR = 4096;
constexpr size_t WS_ROWSS = 256 * 1024;
constexpr size_t WS_WIN = 2 * MiB;
constexpr size_t WS_WO = 8 * MiB;
constexpr size_t WS_WGU = 10 * MiB;
constexpr size_t WS_WDN = 21 * MiB;
constexpr size_t WS_WPG = 27 * MiB;
constexpr size_t WS_WPLE = 29 * MiB;
constexpr size_t WS_WC1 = 30 * MiB;
constexpr size_t WS_WC2 = 31 * MiB;
constexpr size_t WS_C1 = 31 * MiB + 65536;
constexpr size_t WS_KCP = 32 * MiB;
constexpr size_t WS_VCP = 33 * MiB;
constexpr size_t WS_KCS = 34 * MiB;
constexpr size_t WS_VCS = 38 * MiB;
constexpr size_t WS_DSC = 42 * MiB;
constexpr size_t WS_USC = 43 * MiB;
constexpr size_t WS_QB = 51 * MiB;
constexpr size_t WS_XN = 64 * MiB;
constexpr size_t WS_PPLE = 97 * MiB;
constexpr size_t WS_PROJ = 106 * MiB;
constexpr size_t WS_OWIN = 204 * MiB;
constexpr size_t WS_MIX = 221 * MiB;
constexpr size_t WS_OLOC = 254 * MiB;
constexpr size_t WS_H1 = 287 * MiB;
constexpr size_t WS_H1B = 353 * MiB;
constexpr size_t WS_ACT = 386 * MiB;
constexpr size_t WS_H2 = 476 * MiB;
constexpr size_t WS_H2B = 542 * MiB;
constexpr size_t WS_PLEB = 575 * MiB;
constexpr size_t WS_END = 608 * MiB;
constexpr int RING_BYTES = 131072;
constexpr int MISC_OFF = RING_BYTES + 320;
constexpr int LDS_BYTES = 163840;
#define XB_TMO      128
#define XB_XCNT(j)  (256  + 64 * (j))
#define XB_XSUB(j)  (1280 + 64 * (j))
#define XB_XGEN(j)  (2304 + 64 * (j))
#define XB_TOP      3328
#define XB_TOPGEN   3392
#define XCD_BAR_WORDS 3456
#define XB_SPIN_CAP (1u << 18)

__device__ __forceinline__ unsigned xb_ld(unsigned* p)              { return __hip_atomic_load(p, __ATOMIC_RELAXED, __HIP_MEMORY_SCOPE_AGENT); }
__device__ __forceinline__ unsigned xb_add(unsigned* p, unsigned v) { return __hip_atomic_fetch_add(p, v, __ATOMIC_RELAXED, __HIP_MEMORY_SCOPE_AGENT); }
__device__ __forceinline__ unsigned xb_xcc_id() { return (unsigned)__builtin_amdgcn_s_getreg((3 << 11) | 20) & 0xFu; }
#define XB_SPIN(cond, bar) do { unsigned _sp = 0; while (cond) { __builtin_amdgcn_s_sleep(1); \
    if ((++_sp & 255u) == 0u) { if (xb_ld(&(bar)[XB_TMO])) break; if (_sp > XB_SPIN_CAP) { atomicAdd(&(bar)[XB_TMO], 1u); break; } } } } while (0)

struct XcdBarrier {
    unsigned* bar; unsigned x;
    volatile LAS unsigned* st;
};

__device__ __forceinline__ XcdBarrier xcd_barrier_post(unsigned* bar, volatile LAS unsigned* st, const int tid) {
    XcdBarrier b; b.bar = bar; b.x = xb_xcc_id(); b.st = st;
    if (tid == 0) (void)xb_add(&bar[XB_XCNT(b.x)], 1u);
    return b;
}
__device__ __forceinline__ void xcd_barrier_complete(unsigned* bar, unsigned x, unsigned& nloc, unsigned& nx) {
    const unsigned G = gridDim.x * gridDim.y * gridDim.z;
    unsigned sum, cnt, mine, sp = 0u;
    for (;;) {
        sum = 0u; cnt = 0u; mine = 0u;
#pragma unroll
        for (unsigned j = 0; j < 16; ++j) { const unsigned c = xb_ld(&bar[XB_XCNT(j)]); sum += c; cnt += (c > 0u) ? 1u : 0u; mine = (j == x) ? c : mine; }
        if (sum == G) break;
        __builtin_amdgcn_s_sleep(1);
        if ((++sp & 255u) == 0u) { if (xb_ld(&bar[XB_TMO])) break; if (sp > XB_SPIN_CAP) { atomicAdd(&bar[XB_TMO], 1u); break; } }
    }
    nloc = mine > 0u ? mine : 1u; nx = cnt > 0u ? cnt : 1u;
}

__device__ __forceinline__ void xcd_barrier(const XcdBarrier& b, const int tid) {
    asm volatile("s_waitcnt vmcnt(0)" ::: "memory");
    __syncthreads();
    if (tid == 0) {
        unsigned* bar = b.bar;
        __builtin_amdgcn_s_waitcnt(0);
        unsigned nloc = b.st[0], nx = b.st[1];
        if (nloc == 0u) { xcd_barrier_complete(bar, b.x, nloc, nx); b.st[0] = nloc; b.st[1] = nx; }
        const unsigned old = xb_add(&bar[XB_XSUB(b.x)], 1u);
        const unsigned gen = old / nloc;
        if (old + 1u == (gen + 1u) * nloc) {
            __builtin_amdgcn_fence(__ATOMIC_RELEASE, "agent");
            asm volatile("s_waitcnt vmcnt(0)" ::: "memory");
            const unsigned og = xb_add(&bar[XB_TOP], 1u);
            const unsigned tg = og / nx;
            if (og + 1u == (tg + 1u) * nx) xb_add(&bar[XB_TOPGEN], 1u);
            else XB_SPIN(xb_ld(&bar[XB_TOPGEN]) == tg, bar);
            __builtin_amdgcn_fence(__ATOMIC_ACQUIRE, "agent");
            xb_add(&bar[XB_XGEN(b.x)], 1u);
            asm volatile("s_waitcnt vmcnt(0)" ::: "memory");
        } else {
            XB_SPIN(xb_ld(&bar[XB_XGEN(b.x)]) == gen, bar);
            __builtin_amdgcn_fence(__ATOMIC_ACQUIRE, "agent");
            asm volatile("s_waitcnt vmcnt(0)" ::: "memory");
        }
    }
    __syncthreads();
}

struct Args { const float* in[26]; float* out; unsigned char* ws; int ph_lo, ph_hi; };
struct Frame {
    LAS unsigned char* lds;
    int tid, lane, wave, vcu, G;
};
__device__ __forceinline__ int hw_lane() { int l; asm volatile("v_mbcnt_lo_u32_b32 %0, -1, 0\n\tv_mbcnt_hi_u32_b32 %0, -1, %0" : "=v"(l)); return l; }
__device__ __forceinline__ int opaque(int x) { asm volatile("" : "+v"(x)); return x; }
__device__ __forceinline__ float wave_sum(float v) {
#pragma unroll
    for (int o = 1; o < 64; o <<= 1) v += __shfl_xor(v, o);
    return v;
}
__device__ __forceinline__ void p0_tr_item(const float* W, int ldw, int K, int nsrc, int nblk, bf16* WT, int mode, const float* kscale, LAS float* scr, int item, int lane) {
    const int kb = item / nblk, nb = item % nblk, k0 = 64 * kb, n0 = 32 * nb;
    const int nn = n0 + (lane & 31);
#pragma unroll 8
    for (int i = 0; i < 32; ++i) { const int kk = 2 * i + (lane >> 5); float v = 0.f; if (nn < nsrc) { v = W[(size_t)(k0 + kk) * ldw + nn]; if (kscale) v *= kscale[k0 + kk]; } scr[kk * 33 + (lane & 31)] = v; }
    LDS_WAIT(); asm volatile("" ::: "memory");
    const int c = lane & 7;
#pragma unroll
    for (int j = 0; j < 4; ++j) { const int n = (lane >> 3) + 8 * j; const LAS float* s = scr + (8 * c) * 33 + n;
        v4u o; o.x = pk2(s[0 * 33], s[1 * 33]); o.y = pk2(s[2 * 33], s[3 * 33]); o.z = pk2(s[4 * 33], s[5 * 33]); o.w = pk2(s[6 * 33], s[7 * 33]);
        const int ng = n0 + n; const int drow = (mode == 0) ? ng : (256 * (ng >> 7) + (ng & 127) + (mode == 2 ? 128 : 0));
        *(GAS v4u*)(WT + (size_t)drow * K + k0 + 8 * c) = o; }
    LDS_WAIT(); asm volatile("" ::: "memory");
}
__device__ __forceinline__ void rms_row_to_bf16(const float* xrow, const float* g, bf16* orow, int lane) {
    const GAS f32x4* xr = (const GAS f32x4*)xrow + lane; const GAS f32x4* gr = (const GAS f32x4*)g + lane;
    f32x4 v[4]; float s = 0.f;
#pragma unroll
    for (int j = 0; j < 4; ++j) { v[j] = xr[64 * j]; s += (v[j].x * v[j].x + v[j].y * v[j].y) + (v[j].z * v[j].z + v[j].w * v[j].w); }
    const float rstd = 1.0f / sqrtf(wave_sum(s) * (1.f / DM) + EPS);
    GAS unsigned long long* o8 = (GAS unsigned long long*)orow + lane;
#pragma unroll
    for (int j = 0; j < 4; ++j) { const f32x4 gg = gr[64 * j];
        o8[64 * j] = (unsigned long long)pk2(v[j].x * rstd * gg.x, v[j].y * rstd * gg.y) | ((unsigned long long)pk2(v[j].z * rstd * gg.z, v[j].w * rstd * gg.w) << 32); }
}
__device__ __forceinline__ void p0_prologue(const Frame& F, const Args& A) {
    unsigned char* ws = A.ws;
    LAS float* scr = (LAS float*)(F.lds + F.wave * 16384);
    const int gw = F.vcu * NWAVES + F.wave, NGW = F.G * NWAVES, lane = F.lane;
    constexpr int I_IN = 16 * 96, I_O = 16 * 32, I_G = 16 * 88, I_D = 44 * 32, I_PG = 16 * 32, I_PL = 4 * 32, I_C1 = 2 * 32 * 2, I_C2 = 2 * 1 * 2;
    constexpr int NITEMS = I_IN + I_O + 2 * I_G + I_D + I_PG + I_PL + I_C1 + I_C2;
    for (int it = gw; it < NITEMS; it += NGW) {
        int r = it;
        if (r < I_IN) { p0_tr_item(A.in[9], NIN, 1024, NIN, 96, (bf16*)(ws + WS_WIN), 0, nullptr, scr, r, lane); continue; } r -= I_IN;
        if (r < I_O) { p0_tr_item(A.in[16], 1024, 1024, 1024, 32, (bf16*)(ws + WS_WO), 0, nullptr, scr, r, lane); continue; } r -= I_O;
        if (r < I_G) { p0_tr_item(A.in[18], DFF, 1024, DFF, 88, (bf16*)(ws + WS_WGU), 1, A.in[17], scr, r, lane); continue; } r -= I_G;
        if (r < I_G) { p0_tr_item(A.in[19], DFF, 1024, DFF, 88, (bf16*)(ws + WS_WGU), 2, A.in[17], scr, r, lane); continue; } r -= I_G;
        if (r < I_D) { p0_tr_item(A.in[20], 1024, DFF, 1024, 32, (bf16*)(ws + WS_WDN), 0, nullptr, scr, r, lane); continue; } r -= I_D;
        if (r < I_PG) { p0_tr_item(A.in[23], 1024, 1024, 1024, 32, (bf16*)(ws + WS_WPG), 0, A.in[22], scr, r, lane); continue; } r -= I_PG;
        if (r < I_PL) { p0_tr_item(A.in[21], 1024, 256, 1024, 32, (bf16*)(ws + WS_WPLE), 0, nullptr, scr, r, lane); continue; } r -= I_PL;
        if (r < I_C1) { const int slot = r / 64; p0_tr_item(A.in[11] + (size_t)slot * 2048 * 64, 64, 2048, 64, 2, (bf16*)(ws + WS_WC1) + (size_t)slot * 64 * 2048, 0, nullptr, scr, r % 64, lane); continue; } r -= I_C1;
        { const int slot = r / 2; p0_tr_item(A.in[12] + (size_t)slot * 64 * 64, 64, 64, 64, 2, (bf16*)(ws + WS_WC2) + (size_t)slot * 64 * 64, 0, nullptr, scr, r % 2, lane); }
    }
    if (F.vcu < 2) { const int slot = F.vcu; const float* pe = A.in[10] + slot * 2048 + F.wave * 256; const float* w1 = A.in[11] + (size_t)slot * 2048 * 64 + (size_t)F.wave * 256 * 64; float a = 0.f;
#pragma unroll 16
        for (int k = 0; k < 256; ++k) a += pe[k] * w1[k * 64 + lane];
        ((LAS float*)(F.lds + F.wave * 16384 + 12288))[lane] = a; __syncthreads();
        if (F.wave == 0) { float t = 0.f;
#pragma unroll
            for (int w = 0; w < 8; ++w) t += ((LAS float*)(F.lds + w * 16384 + 12288))[lane];
            ((float*)(ws + WS_C1))[slot * 64 + lane] = t; }
    }
    bf16* XN = (bf16*)(ws + WS_XN);
    for (int m = gw; m < MPAD; m += NGW) {
        if (m < MTOT) { const float* xr = (m < TP) ? A.in[0] + (size_t)m * DM : A.in[1] + (size_t)(m - TP) * DM; rms_row_to_bf16(xr, A.in[8], XN + (size_t)m * DM, lane); }
        else { GAS v4u* o = (GAS v4u*)(XN + (size_t)m * DM) + lane; o[0] = (v4u){0, 0, 0, 0}; o[64] = (v4u){0, 0, 0, 0}; }
    }
    bf16* PP = (bf16*)(ws + WS_PPLE);
    for (int m = gw; m < MPAD; m += NGW) {
        v2u o = (v2u){0, 0};
        if (m < MTOT) { const float* pr = (m < TP) ? A.in[6] + (size_t)m * DPLE : A.in[7] + (size_t)(m - TP) * DPLE; const f32x4 v = ((const GAS f32x4*)pr)[lane]; o.x = pk2(v.x, v.y); o.y = pk2(v.z, v.w); }
        ((GAS v2u*)(PP + (size_t)m * DPLE))[lane] = o;
        if (m >= MTOT) { GAS v4u* z = (GAS v4u*)((bf16*)(ws + WS_MIX) + (size_t)m * DM) + lane; z[0] = (v4u){0, 0, 0, 0}; z[64] = (v4u){0, 0, 0, 0}; }
    }
    for (int it = gw; it < DBATCH * 508; it += NGW) { const int b = it / 508, r = it % 508;
        ((GAS f32x4*)(A.out + O_WINS + (size_t)(b * 512 + r) * 256))[lane] = ((const GAS f32x4*)(A.in[3] + (size_t)(b * 512 + r + 4) * 256))[lane]; }
}

constexpr float LOG2E = 1.4426950408889634f;
typedef short v4i16_t __attribute__((ext_vector_type(4)));
__device__ __forceinline__ s16x4 vtr(LAS const unsigned char* p) { return __builtin_bit_cast(s16x4, __builtin_amdgcn_ds_read_tr16_b64_v4i16((LAS v4i16_t*)p)); }
__device__ __forceinline__ unsigned cvtpk(float lo, float hi) { typedef float f2 __attribute__((ext_vector_type(2))); typedef __bf16 b2 __attribute__((ext_vector_type(2))); f2 v = {lo, hi}; b2 b = __builtin_convertvector(v, b2); return __builtin_bit_cast(unsigned, b); }
__device__ __forceinline__ int t5_bucket(int n) {
    if (n < 16) return n;
    const int large = 16 + (int)(logf((float)n / 16.0f) / 2.0794415416798357f * 16.0f);
    return large < 31 ? large : 31;
}
constexpr int HI_BASE = 131072 + 512, AT_LUT = HI_BASE, HI_IMPA = AT_LUT + 4096, HI_IMPB = HI_IMPA + 2176, HI_SEL = HI_IMPB + 2176, HI_SCS = HI_SEL + 128, HI_TL = HI_SCS + 512, HI_XCH = HI_TL + 512, HI_END = HI_XCH + 8192;
constexpr int AT_K0 = 0, AT_V0 = 16384, AT_IMPA = 36864, AT_IMPB = AT_IMPA + 64 * 65 * 4 + 64, AT_SEL = AT_IMPB + 64 * 65 * 4 + 64, AT_MISC = AT_SEL + 1024, AT_QF = ((AT_MISC + 4096 + 1023) / 1024) * 1024, AT_END = AT_QF + 32768;
struct AttnLane {
    int koff;
    int kx;
    int voff0, voff1;
    int r32, h;
};
__device__ __forceinline__ AttnLane attn_lane(int lane) {
    AttnLane L; L.r32 = lane & 31; L.h = lane >> 5; L.koff = L.r32 * 128; L.kx = (L.r32 >> 1) & 7;
    const int i16 = lane & 15, q = i16 >> 2, p = i16 & 3, g1 = (lane >> 4) & 1;
    const int base = (4 * L.h + q) * 128 + g1 * 32 + (p >> 1) * 16 + (p & 1) * 8;
    L.voff0 = base + ((q >> 1) * 64); L.voff1 = base + (((q >> 1) ^ 1) * 64);
    return L;
}
__device__ __forceinline__ void attn_fill_lut(LAS float* lut, const float* rel_bias, int tid) {
    for (int e = tid; e < 1024; e += NWAVES * 64) { const int dist = e >> 3, hd = e & 7; lut[e] = rel_bias[t5_bucket(dist) * 8 + hd] * LOG2E; }
}
__device__ __forceinline__ void attn_commit(LAS unsigned char* kb, LAS unsigned char* vb, int tid, v4u k, v4u v) {
    const int row = tid >> 3, ch = tid & 7;
    *(LAS v4u*)(kb + row * 128 + ((ch ^ ((row >> 1) & 7)) << 4)) = k;
    *(LAS v4u*)(vb + row * 128 + ((ch ^ (((row >> 1) & 1) << 2)) << 4)) = v;
}
__device__ __forceinline__ f32x16 attn_qk(LAS const unsigned char* kb, int hf, const AttnLane& L, const bf16x8 (&qf)[4]) {
    f32x16 s = {};
#pragma unroll
    for (int ks = 0; ks < 4; ++ks) { const bf16x8 kf = *(LAS const bf16x8*)(kb + hf * 4096 + L.koff + (((2 * ks + L.h) ^ L.kx) << 4)); s = __builtin_amdgcn_mfma_f32_32x32x16_bf16(kf, qf[ks], s, 0, 0, 0); }
    return s;
}
__device__ __forceinline__ void attn_pv(LAS const unsigned char* vb, int hf, const AttnLane& L, const f32x16& p, f32x16 (&o)[2]) {
#pragma unroll
    for (int s = 0; s < 2; ++s) {
        v4u pw; pw.x = cvtpk(p[8 * s + 0], p[8 * s + 1]); pw.y = cvtpk(p[8 * s + 2], p[8 * s + 3]); pw.z = cvtpk(p[8 * s + 4], p[8 * s + 5]); pw.w = cvtpk(p[8 * s + 6], p[8 * s + 7]);
        const bf16x8 pb = __builtin_bit_cast(bf16x8, pw);
        const int rb = (32 * hf + 16 * s) * 128;
        { const s16x4 lo = vtr(vb + rb + L.voff0), hi = vtr(vb + rb + 1024 + L.voff0); const bf16x8 vf = {lo[0], lo[1], lo[2], lo[3], hi[0], hi[1], hi[2], hi[3]};
          o[0] = __builtin_amdgcn_mfma_f32_32x32x16_bf16(vf, pb, o[0], 0, 0, 0); }
        { const s16x4 lo = vtr(vb + rb + L.voff1), hi = vtr(vb + rb + 1024 + L.voff1); const bf16x8 vf = {lo[0], lo[1], lo[2], lo[3], hi[0], hi[1], hi[2], hi[3]};
          o[1] = __builtin_amdgcn_mfma_f32_32x32x16_bf16(vf, pb, o[1], 0, 0, 0); }
    }
}
__device__ __forceinline__ float max16(const f32x16& a) {
    float m0 = fmaxf(fmaxf(a[0], a[1]), fmaxf(a[2], a[3])), m1 = fmaxf(fmaxf(a[4], a[5]), fmaxf(a[6], a[7])), m2 = fmaxf(fmaxf(a[8], a[9]), fmaxf(a[10], a[11])), m3 = fmaxf(fmaxf(a[12], a[13]), fmaxf(a[14], a[15]));
    return fmaxf(fmaxf(m0, m1), fmaxf(m2, m3));
}
__device__ __forceinline__ float sum16(const f32x16& a) {
    return ((a[0] + a[1]) + (a[2] + a[3])) + ((a[4] + a[5]) + (a[6] + a[7])) + (((a[8] + a[9]) + (a[10] + a[11])) + ((a[12] + a[13]) + (a[14] + a[15])));
}
__device__ __forceinline__ float xmax32(float v) { const auto rr = __builtin_amdgcn_permlane32_swap(__float_as_uint(v), __float_as_uint(v), false, false); return fmaxf(__uint_as_float(rr[0]), __uint_as_float(rr[1])); }
__device__ __forceinline__ float xsum32(float v) { const auto rr = __builtin_amdgcn_permlane32_swap(__float_as_uint(v), __float_as_uint(v), false, false); return __uint_as_float(rr[0]) + __uint_as_float(rr[1]); }
__device__ __forceinline__ void attn_softmax_pv(LAS const unsigned char* vb, const AttnLane& L, f32x16& t0, f32x16& t1, float& m, float& lh, f32x16 (&o)[2]) {
    const float tm = xmax32(fmaxf(max16(t0), max16(t1)));
    if (__any(tm > m + 8.0f)) {
        const float mn = fmaxf(m, tm), mu0 = (mn == -INFINITY) ? 0.f : mn;
        const float alpha = __builtin_amdgcn_exp2f(m - mu0);
#pragma unroll
        for (int r = 0; r < 16; ++r) { o[0][r] *= alpha; o[1][r] *= alpha; }
        lh *= alpha; m = mn;
    }
    const float mu = (m == -INFINITY) ? 0.f : m;
#pragma unroll
    for (int r = 0; r < 16; ++r) { t0[r] = __builtin_amdgcn_exp2f(t0[r] - mu); t1[r] = __builtin_amdgcn_exp2f(t1[r] - mu); }
    lh += sum16(t0) + sum16(t1);
    attn_pv(vb, 0, L, t0, o); attn_pv(vb, 1, L, t1, o);
}
#define KEYIDX(hf, reg, h) (32 * (hf) + ((reg) & 3) + 8 * ((reg) >> 2) + 4 * (h))
__device__ __forceinline__ void score_far(f32x16& t0, f32x16& t1, float cb) {
#pragma unroll
    for (int r = 0; r < 16; ++r) { t0[r] = fmaf(t0[r], LOG2E, cb); t1[r] = fmaf(t1[r], LOG2E, cb); }
}
__device__ __forceinline__ void score_near1(f32x16& t, int hf, int h, LAS const float* lut, int hd, int dbase, int dstep, int dmax, int klim, bool colok) {
#pragma unroll
    for (int r = 0; r < 16; ++r) {
        const int ki = KEYIDX(hf, r, h); const int dist = dbase - dstep * ki; const int di = dist < 0 ? 0 : (dist > 127 ? 127 : dist); const float bv = lut[di * 8 + hd];
        const bool ok = colok && dist >= 0 && dist < dmax && ki < klim; const float v = fmaf(t[r], LOG2E, bv); t[r] = ok ? v : -INFINITY; }
}
__device__ __forceinline__ void score_near(f32x16& t0, f32x16& t1, int h, LAS const float* lut, int hd, int dbase, int dstep, int dmax, int klim, bool colok) {
    score_near1(t0, 0, h, lut, hd, dbase, dstep, dmax, klim, colok);
    __builtin_amdgcn_sched_barrier(0);
    score_near1(t1, 1, h, lut, hd, dbase, dstep, dmax, klim, colok);
    __builtin_amdgcn_sched_barrier(0);
}

__device__ __forceinline__ void win_unit(const Frame& F, const Args& A, LAS unsigned char* sh, int b, int g, int qb) {
    const bf16* PROJ = (const bf16*)(A.ws + WS_PROJ);
    const int lane = opaque(F.lane), w = F.wave, tid = w * 64 + lane;
    const AttnLane L = attn_lane(lane);
    const int tq = 64 * qb + 8 * w + (L.r32 >> 2), hd = g * 4 + (L.r32 & 3);
    const size_t tokq = (size_t)b * SEQ + tq;
    bf16x8 qf[4];
#pragma unroll
    for (int ks = 0; ks < 4; ++ks) qf[ks] = *(const bf16x8*)(PROJ + tokq * NPROJ + C_QN + hd * 64 + 16 * ks + 8 * L.h);
    LAS const float* lut = (LAS const float*)(sh + AT_LUT);
    const float bfar = lut[127 * 8 + hd];
    const int kt0 = qb >= 8 ? qb - 8 : 0, nt = qb - kt0 + 1;
    const int srow = tid >> 3, sch = tid & 7;
    const bf16* ksrc = PROJ + ((size_t)b * SEQ + srow) * NPROJ + C_WIN + g * 64 + sch * 8;
    v4u kr, vr;
    kr = *(const v4u*)(ksrc + (size_t)(64 * kt0) * NPROJ); vr = *(const v4u*)(ksrc + (size_t)(64 * kt0) * NPROJ + 128);
    __syncthreads();
    attn_commit(sh + AT_K0, sh + AT_V0, tid, kr, vr);
    __syncthreads();
    float m = -INFINITY, l = 0.f; f32x16 o[2]; o[0] = f32x16{}; o[1] = f32x16{};
    for (int it = 0; it < nt; ++it) {
        const int kt = kt0 + it, buf = it & 1;
        if (it + 1 < nt) { kr = *(const v4u*)(ksrc + (size_t)(64 * (kt + 1)) * NPROJ); vr = *(const v4u*)(ksrc + (size_t)(64 * (kt + 1)) * NPROJ + 128); }
        LAS const unsigned char* kb = sh + AT_K0 + buf * 8192; LAS const unsigned char* vb = sh + AT_V0 + buf * 8192;
        f32x16 t0 = attn_qk(kb, 0, L, qf), t1 = attn_qk(kb, 1, L, qf);
        if (kt <= qb - 3 && kt >= qb - 7) score_far(t0, t1, bfar);
        else score_near(t0, t1, L.h, lut, hd, tq - 64 * kt, 1, 512, 64, true);
        attn_softmax_pv(vb, L, t0, t1, m, l, o);
        if (it + 1 < nt) attn_commit(sh + AT_K0 + (buf ^ 1) * 8192, sh + AT_V0 + (buf ^ 1) * 8192, tid, kr, vr);
        __syncthreads();
    }
    const float rl = 1.0f / xsum32(l);
    bf16* dst = (bf16*)(A.ws + WS_OWIN) + tokq * 512 + hd * 64;
#pragma unroll
    for (int dt = 0; dt < 2; ++dt)
#pragma unroll
        for (int rq = 0; rq < 4; ++rq) { v2u wv; wv.x = cvtpk(o[dt][4 * rq] * rl, o[dt][4 * rq + 1] * rl); wv.y = cvtpk(o[dt][4 * rq + 2] * rl, o[dt][4 * rq + 3] * rl);
            *(v2u*)(dst + 32 * dt + 8 * rq + 4 * L.h) = wv; }
}

__device__ __forceinline__ void nsa_unit(const Frame& F, const Args& A, LAS unsigned char* sh, int b, int g, int qb) {
    const bf16* PROJ = (const bf16*)(A.ws + WS_PROJ);
    const int lane = opaque(F.lane), w = F.wave, tid = w * 64 + lane;
    const AttnLane L = attn_lane(lane);
    const int qloc = 8 * w + (L.r32 >> 2);
    const int tq = 64 * qb + qloc, hd = g * 4 + (L.r32 & 3);
    const size_t tokq = (size_t)b * SEQ + tq;
    LAS bf16x8* qlds = (LAS bf16x8*)(sh + AT_QF) + tid;
    __syncthreads();
#pragma unroll
    for (int ks = 0; ks < 4; ++ks) qlds[ks * 512] = *(const bf16x8*)(PROJ + tokq * NPROJ + C_QN + hd * 64 + 16 * ks + 8 * L.h);
#define NSA_LOADQ() bf16x8 qf[4]; _Pragma("unroll") for (int ks = 0; ks < 4; ++ks) qf[ks] = qlds[ks * 512]
    LAS const float* lut = (LAS const float*)(sh + AT_LUT);
    const float bfar = lut[127 * 8 + hd];
    LAS float* impA = (LAS float*)(sh + AT_IMPA); LAS float* impB = (LAS float*)(sh + AT_IMPB);
    LAS unsigned long long* selm = (LAS unsigned long long*)(sh + AT_SEL);
    const int srow = tid >> 3, sch = tid & 7;
    v4u kr, vr;
    const int nct = (4 * qb + 3 + 63) >> 6;
    const bf16* kcs = (const bf16*)(A.ws + WS_KCP) + ((size_t)(b * 256 + srow) * 2 + g) * 64 + sch * 8;
    const bf16* vcs = (const bf16*)(A.ws + WS_VCP) + ((size_t)(b * 256 + srow) * 2 + g) * 64 + sch * 8;
    __syncthreads();
    for (int e = tid; e < 64 * 65; e += NWAVES * 64) { impA[e] = 0.f; impB[e] = 0.f; }
    float mc = -INFINITY, lc = 0.f;
    f32x16 oc[2]; oc[0] = f32x16{}; oc[1] = f32x16{};
#pragma unroll 1
    for (int pass = 0; pass < 2; ++pass) {
        kr = *(const v4u*)(kcs); vr = *(const v4u*)(vcs);
        __syncthreads();
        attn_commit(sh + AT_K0, sh + AT_V0, tid, kr, vr);
        __syncthreads();
        const float mu = (mc == -INFINITY) ? 0.f : mc, il = lc > 0.f ? 1.0f / lc : 0.f;
#pragma unroll 1
        for (int ct = 0; ct < nct; ++ct) {
            const int buf = ct & 1;
            if (ct + 1 < nct) { kr = *(const v4u*)(kcs + (size_t)(64 * (ct + 1)) * 128); vr = *(const v4u*)(vcs + (size_t)(64 * (ct + 1)) * 128); }
            LAS const unsigned char* kb = sh + AT_K0 + buf * 8192; LAS const unsigned char* vb = sh + AT_V0 + buf * 8192;
            NSA_LOADQ();
            f32x16 t0 = attn_qk(kb, 0, L, qf), t1 = attn_qk(kb, 1, L, qf);
            score_near(t0, t1, L.h, lut, hd, tq - 31 - 1024 * ct, 16, 1 << 30, 255 - 64 * ct, true);
            if (pass == 0) {
                const float tm = xmax32(fmaxf(max16(t0), max16(t1)));
                const float mn = fmaxf(mc, tm), mu0 = (mn == -INFINITY) ? 0.f : mn;
                const float alpha = __builtin_amdgcn_exp2f(mc - mu0);
                float ps = 0.f;
#pragma unroll
                for (int r = 0; r < 16; ++r) ps += __builtin_amdgcn_exp2f(t0[r] - mu0) + __builtin_amdgcn_exp2f(t1[r] - mu0);
                ps = xsum32(ps);
                lc = lc * alpha + ps; mc = mn;
            } else {
#pragma unroll
                for (int r = 0; r < 16; ++r) { t0[r] = __builtin_amdgcn_exp2f(t0[r] - mu) * il; t1[r] = __builtin_amdgcn_exp2f(t1[r] - mu) * il; }
                attn_pv(vb, 0, L, t0, oc); attn_pv(vb, 1, L, t1, oc);
#pragma unroll
                for (int hf = 0; hf < 2; ++hf) {
                    float x[16];
#pragma unroll
                    for (int r = 0; r < 16; ++r) { float v = hf ? t1[r] : t0[r]; v += __shfl_xor(v, 1); v += __shfl_xor(v, 2); x[r] = v; }
                    if ((L.r32 & 3) == 0) {
#pragma unroll
                        for (int rq = 0; rq < 4; ++rq) { const int jq = 16 * ct + 8 * hf + 2 * rq + L.h;
                            impA[qloc * 65 + jq] = 2.0f * (x[4 * rq] + x[4 * rq + 1] + x[4 * rq + 2]) + x[4 * rq + 3];
                            impB[qloc * 65 + jq + 1] = x[4 * rq + 3]; }
                    }
                }
            }
            if (ct + 1 < nct) attn_commit(sh + AT_K0 + (buf ^ 1) * 8192, sh + AT_V0 + (buf ^ 1) * 8192, tid, kr, vr);
            __syncthreads();
        }
    }
#pragma unroll 1
    for (int qi = 0; qi < 8; ++qi) {
        const int q = 8 * w + qi;
        unsigned long long mk;
        if (qb < 16) mk = (2ull << qb) - 1ull;
        else {
            const bool forced = (lane == 0) || (lane == qb) || (lane == qb - 1);
            const float sc = forced ? 1e9f : (lane <= qb ? impA[q * 65 + lane] + impB[q * 65 + lane] : -1.0f);
            int rank = 0;
#pragma unroll 8
            for (int jj = 0; jj < 64; ++jj) { const float ov = __uint_as_float(__builtin_amdgcn_readlane(__float_as_uint(sc), jj)); rank += ((ov > sc) || (ov == sc && jj < lane)) ? 1 : 0; }
            mk = __ballot(rank < 16 && lane <= qb);
        }
        if (lane == 0) selm[q] = mk;
    }
    __syncthreads();
    const unsigned long long mysel = selm[qloc];
    unsigned long long um = 0ull;
#pragma unroll 8
    for (int q_ = 0; q_ < 64; ++q_) um |= selm[q_];
    um = ((unsigned long long)__builtin_amdgcn_readfirstlane((unsigned)(um >> 32)) << 32) | (unsigned long long)__builtin_amdgcn_readfirstlane((unsigned)um);
    const bf16* ksrc = PROJ + ((size_t)b * SEQ + srow) * NPROJ + C_KV + 2 * 128 + g * 64 + sch * 8;
    float m = -INFINITY, l = 0.f; f32x16 o[2]; o[0] = f32x16{}; o[1] = f32x16{};
    int j = __builtin_ctzll(um); um &= um - 1;
    kr = *(const v4u*)(ksrc + (size_t)(64 * j) * NPROJ); vr = *(const v4u*)(ksrc + (size_t)(64 * j) * NPROJ + 128);
    attn_commit(sh + AT_K0, sh + AT_V0, tid, kr, vr);
    __syncthreads();
    int buf = 0;
#pragma unroll 1
    for (;;) {
        const int jn = um ? __builtin_ctzll(um) : -1; um &= um - 1;
        if (jn >= 0) { kr = *(const v4u*)(ksrc + (size_t)(64 * jn) * NPROJ); vr = *(const v4u*)(ksrc + (size_t)(64 * jn) * NPROJ + 128); }
        LAS const unsigned char* kb = sh + AT_K0 + buf * 8192; LAS const unsigned char* vb = sh + AT_V0 + buf * 8192;
        const bool selj = (mysel >> j) & 1ull;
        if (__any(selj)) {
            NSA_LOADQ();
            f32x16 t0 = attn_qk(kb, 0, L, qf), t1 = attn_qk(kb, 1, L, qf);
            if (j <= qb - 3) score_far(t0, t1, selj ? bfar : -INFINITY);
            else score_near(t0, t1, L.h, lut, hd, tq - 64 * j, 1, 1 << 30, 64, selj);
            attn_softmax_pv(vb, L, t0, t1, m, l, o);
        }
        if (jn >= 0) attn_commit(sh + AT_K0 + (buf ^ 1) * 8192, sh + AT_V0 + (buf ^ 1) * 8192, tid, kr, vr);
        __syncthreads();
        if (jn < 0) break;
        j = jn; buf ^= 1;
    }
    const bf16* gp = PROJ + tokq * NPROJ + C_GT + hd;
    const float g0 = 1.0f / (1.0f + __expf(-bf2f(gp[0]))), g1 = 1.0f / (1.0f + __expf(-bf2f(gp[8]))), g2 = 1.0f / (1.0f + __expf(-bf2f(gp[16])));
    const float rl = g1 / xsum32(l);
    const bf16* ow = (const bf16*)(A.ws + WS_OWIN) + tokq * 512 + hd * 64;
    bf16* dst = (bf16*)(A.ws + WS_MIX) + tokq * 1024 + hd * 64;
#pragma unroll
    for (int dt = 0; dt < 2; ++dt)
#pragma unroll
        for (int rq = 0; rq < 4; ++rq) { const int d0 = 32 * dt + 8 * rq + 4 * L.h; const v2u wv = *(const v2u*)(ow + d0);
            const float a0 = g0 * oc[dt][4 * rq] + rl * o[dt][4 * rq] + g2 * bflo(wv.x), a1 = g0 * oc[dt][4 * rq + 1] + rl * o[dt][4 * rq + 1] + g2 * bfhi(wv.x);
            const float a2 = g0 * oc[dt][4 * rq + 2] + rl * o[dt][4 * rq + 2] + g2 * bflo(wv.y), a3 = g0 * oc[dt][4 * rq + 3] + rl * o[dt][4 * rq + 3] + g2 * bfhi(wv.y);
            v2u ov; ov.x = cvtpk(a0, a1); ov.y = cvtpk(a2, a3); *(v2u*)(dst + d0) = ov; }
}
#undef NSA_LOADQ

__device__ __forceinline__ v4u pack_f32x8(const float* p) { const f32x4 a = *(const f32x4*)p, b = *(const f32x4*)(p + 4); v4u w; w.x = pk2(a.x, a.y); w.y = pk2(a.z, a.w); w.z = pk2(b.x, b.y); w.w = pk2(b.z, b.w); return w; }
__device__ __forceinline__ void samp_load(const Args& A, int mode, int tile, int b, int g, int srow, int sch, v4u& kr, v4u& vr) {
    const bf16* PROJ = (const bf16*)(A.ws + WS_PROJ);
    kr = (v4u){0, 0, 0, 0}; vr = (v4u){0, 0, 0, 0};
    if (mode == 0) {
        const size_t off = ((size_t)(b * 512 + 64 * tile + srow) * 2 + g) * 64 + sch * 8;
        kr = *(const v4u*)((const bf16*)(A.ws + WS_KCS) + off); vr = *(const v4u*)((const bf16*)(A.ws + WS_VCS) + off);
    } else if (mode == 1) {
        if (tile < 128) { const int page = ((const int*)A.in[5])[b * 64 + (tile >> 1)]; const int row = (tile & 1) * 64 + srow;
            const float* p = A.in[2] + ((size_t)(page * 128 + row) * 4 + 2) * 128 + g * 64 + sch * 8; kr = pack_f32x8(p); vr = pack_f32x8(p + 128); }
        else if (srow < 4) { const bf16* p = PROJ + (size_t)(TP + b * 4 + srow) * NPROJ + C_KV + 2 * 128 + g * 64 + sch * 8; kr = *(const v4u*)p; vr = *(const v4u*)(p + 128); }
    } else {
        const int idx = 64 * tile + srow;
        if (idx < 512) { const float* p = A.in[3] + ((size_t)(b * 512 + idx) * 2) * 128 + g * 64 + sch * 8; kr = pack_f32x8(p); vr = pack_f32x8(p + 128); }
        else if (idx < 516) { const bf16* p = PROJ + (size_t)(TP + b * 4 + idx - 512) * NPROJ + C_WIN + g * 64 + sch * 8; kr = *(const v4u*)p; vr = *(const v4u*)(p + 128); }
    }
}
__device__ __forceinline__ void samp_stage_tile(const Args& A, int mode, int tile, int b, int g, int lane, LAS unsigned char* kb, LAS unsigned char* vb) {
#pragma unroll 1
    for (int i0 = 0; i0 < 8; i0 += 2) {
        v4u kr[2], vr[2];
#pragma unroll
        for (int i = 0; i < 2; ++i) samp_load(A, mode, tile, b, g, (lane >> 3) + 8 * (i0 + i), lane & 7, kr[i], vr[i]);
#pragma unroll
        for (int i = 0; i < 2; ++i) { const int row = (lane >> 3) + 8 * (i0 + i), ch = lane & 7;
            *(LAS v4u*)(kb + row * 128 + ((ch ^ ((row >> 1) & 7)) << 4)) = kr[i];
            *(LAS v4u*)(vb + row * 128 + ((ch ^ (((row >> 1) & 1) << 2)) << 4)) = vr[i]; }
    }
}
__device__ __forceinline__ void samp_unit(const Frame& F, const Args& A, LAS unsigned char* sh, int b, int g) {
    const bf16* PROJ = (const bf16*)(A.ws + WS_PROJ);
    const int lane = opaque(F.lane), w = F.wave, tid = w * 64 + lane;
    const AttnLane L = attn_lane(lane);
    const bool colok = L.r32 < 16;
    const int qi = (L.r32 >> 2) & 3, hd = g * 4 + (L.r32 & 3);
    const int pos = PAST + qi;
    const size_t tokq = (size_t)TP + b * 4 + qi;
    LAS unsigned char* kb = sh + w * 16384; LAS unsigned char* vb = kb + 8192;
    LAS float* lut = (LAS float*)(sh + AT_LUT);
    LAS float* impA = (LAS float*)(sh + HI_IMPA); LAS float* impB = (LAS float*)(sh + HI_IMPB);
    LAS unsigned long long* selm = (LAS unsigned long long*)(sh + HI_SEL);
    LAS float* scs = (LAS float*)(sh + HI_SCS);
    LAS int* tlist = (LAS int*)(sh + HI_TL);
    LAS float* xch = (LAS float*)(sh + HI_XCH);
    bf16x8 qf[4];
#pragma unroll
    for (int ks = 0; ks < 4; ++ks) qf[ks] = *(const bf16x8*)(PROJ + tokq * NPROJ + C_QN + hd * 64 + 16 * ks + 8 * L.h);
    const float bfar = lut[127 * 8 + hd];
    __syncthreads();
    for (int e = tid; e < 4 * 132; e += NWAVES * 64) { impA[e] = 0.f; impB[e] = 0.f; }
    f32x16 oc[2]; oc[0] = f32x16{}; oc[1] = f32x16{};
    {
        samp_stage_tile(A, 0, w, b, g, lane, kb, vb);
        f32x16 t0 = attn_qk(kb, 0, L, qf), t1 = attn_qk(kb, 1, L, qf);
        score_near(t0, t1, L.h, lut, hd, pos - 31 - 1024 * w, 16, 1 << 30, 511 - 64 * w, colok);
        const float tm = xmax32(fmaxf(max16(t0), max16(t1)));
        xch[(w * 64 + lane) * 4] = tm;
        __syncthreads();
        float M = -INFINITY;
#pragma unroll
        for (int ww = 0; ww < 8; ++ww) M = fmaxf(M, xch[(ww * 64 + lane) * 4]);
        const float mu = (M == -INFINITY) ? 0.f : M;
#pragma unroll
        for (int r = 0; r < 16; ++r) { t0[r] = __builtin_amdgcn_exp2f(t0[r] - mu); t1[r] = __builtin_amdgcn_exp2f(t1[r] - mu); }
        const float ps = xsum32(sum16(t0) + sum16(t1));
        xch[(w * 64 + lane) * 4 + 1] = ps;
        __syncthreads();
        float Lc = 0.f;
#pragma unroll
        for (int ww = 0; ww < 8; ++ww) Lc += xch[(ww * 64 + lane) * 4 + 1];
        const float il = Lc > 0.f ? 1.0f / Lc : 0.f;
#pragma unroll
        for (int r = 0; r < 16; ++r) { t0[r] *= il; t1[r] *= il; }
        attn_pv(vb, 0, L, t0, oc); attn_pv(vb, 1, L, t1, oc);
#pragma unroll
        for (int hf = 0; hf < 2; ++hf) {
            float x[16];
#pragma unroll
            for (int r = 0; r < 16; ++r) { float v = hf ? t1[r] : t0[r]; v += __shfl_xor(v, 1); v += __shfl_xor(v, 2); x[r] = v; }
            if ((L.r32 & 3) == 0 && colok) {
#pragma unroll
                for (int rq = 0; rq < 4; ++rq) { const int jq = 16 * w + 8 * hf + 2 * rq + L.h;
                    impA[qi * 132 + jq] = 2.0f * (x[4 * rq] + x[4 * rq + 1] + x[4 * rq + 2]) + x[4 * rq + 3];
                    impB[qi * 132 + jq + 1] = x[4 * rq + 3]; }
            }
        }
    }
    __syncthreads();
    if (w == 0) {
        unsigned long long ulo = 0ull, uhi = 0ull;
#pragma unroll 1
        for (int q = 0; q < 4; ++q) {
            const int j0 = lane, j1 = lane + 64;
            const float s0 = (j0 == 0) ? 1e9f : impA[q * 132 + j0] + impB[q * 132 + j0];
            const float s1 = (j1 == 127) ? 1e9f : impA[q * 132 + j1] + impB[q * 132 + j1];
            scs[j0] = s0; scs[j1] = s1;
            LDS_WAIT(); asm volatile("" ::: "memory");
            int r0 = 0, r1 = 0;
#pragma unroll 8
            for (int jj = 0; jj < 128; ++jj) { const float ov = scs[jj]; r0 += ((ov > s0) || (ov == s0 && jj < j0)) ? 1 : 0; r1 += ((ov > s1) || (ov == s1 && jj < j1)) ? 1 : 0; }
            const unsigned long long mlo = __ballot(r0 < 15), mhi = __ballot(r1 < 15);
            if (lane == 0) { selm[2 * q] = mlo; selm[2 * q + 1] = mhi; }
            ulo |= mlo; uhi |= mhi;
            LDS_WAIT(); asm volatile("" ::: "memory");
        }
        if (lane == 0) { int n = 0; for (int j = 0; j < 64; ++j) if ((ulo >> j) & 1ull) tlist[1 + n++] = j; for (int j = 0; j < 64; ++j) if ((uhi >> j) & 1ull) tlist[1 + n++] = 64 + j; tlist[1 + n++] = 128; tlist[0] = n; }
    }
    __syncthreads();
    const unsigned long long mylo = selm[2 * qi], myhi = selm[2 * qi + 1];
    const int nsel = tlist[0];
    const bf16* gp = PROJ + tokq * NPROJ + C_GT + hd;
    const float g0 = 1.0f / (1.0f + __expf(-bf2f(gp[0]))), g1 = 1.0f / (1.0f + __expf(-bf2f(gp[8]))), g2 = 1.0f / (1.0f + __expf(-bf2f(gp[16])));
#pragma unroll
    for (int r = 0; r < 16; ++r) { oc[0][r] *= g0; oc[1][r] *= g0; }
#pragma unroll 1
    for (int br = 0; br < 2; ++br) {
        const int nt = br == 0 ? nsel : 9;
        float m = -INFINITY, l = 0.f; f32x16 o[2]; o[0] = f32x16{}; o[1] = f32x16{};
#pragma unroll 1
        for (int it = w; it < nt; it += 8) {
            const int j = br == 0 ? tlist[1 + it] : it;
            samp_stage_tile(A, 1 + br, j, b, g, lane, kb, vb);
            f32x16 t0 = attn_qk(kb, 0, L, qf), t1 = attn_qk(kb, 1, L, qf);
            if (br == 0) {
                const bool selj = colok && (j >= 128 ? true : (j < 64 ? ((mylo >> j) & 1ull) : ((myhi >> (j - 64)) & 1ull)));
                if (j <= 125) score_far(t0, t1, selj ? bfar : -INFINITY);
                else score_near(t0, t1, L.h, lut, hd, pos - 64 * j, 1, 1 << 30, 64, selj);
            } else score_near(t0, t1, L.h, lut, hd, pos - (PAST - 512 + 64 * j), 1, 512, 516 - 64 * j, colok);
            attn_softmax_pv(vb, L, t0, t1, m, l, o);
        }
        l = xsum32(l);
        xch[(w * 64 + lane) * 4 + 2] = m; xch[(w * 64 + lane) * 4 + 3] = l;
        __syncthreads();
        float M = -INFINITY;
#pragma unroll
        for (int ww = 0; ww < 8; ++ww) M = fmaxf(M, xch[(ww * 64 + lane) * 4 + 2]);
        float Lt = 0.f;
#pragma unroll
        for (int ww = 0; ww < 8; ++ww) { const float mw = xch[(ww * 64 + lane) * 4 + 2]; Lt += (mw == -INFINITY) ? 0.f : xch[(ww * 64 + lane) * 4 + 3] * __builtin_amdgcn_exp2f(mw - M); }
        const float sc = (m == -INFINITY || !(Lt > 0.f)) ? 0.f : (br == 0 ? g1 : g2) * __builtin_amdgcn_exp2f(m - M) / Lt;
#pragma unroll
        for (int r = 0; r < 16; ++r) { oc[0][r] += sc * o[0][r]; oc[1][r] += sc * o[1][r]; }
        __syncthreads();
    }
    { LAS float* part = (LAS float*)kb;
#pragma unroll
      for (int r = 0; r < 16; ++r) { part[r * 64 + lane] = oc[0][r]; part[(16 + r) * 64 + lane] = oc[1][r]; } }
    __syncthreads();
    if (w == 0 && colok) {
        float res[32];
#pragma unroll
        for (int r = 0; r < 32; ++r) { float a = 0.f;
#pragma unroll
            for (int ww = 0; ww < 8; ++ww) a += ((LAS const float*)(sh + ww * 16384))[r * 64 + lane];
            res[r] = a; }
        bf16* dst = (bf16*)(A.ws + WS_MIX) + tokq * 1024 + hd * 64;
#pragma unroll
        for (int dt = 0; dt < 2; ++dt)
#pragma unroll
            for (int rq = 0; rq < 4; ++rq) { const int d0 = 32 * dt + 8 * rq + 4 * L.h;
                v2u ov; ov.x = cvtpk(res[16 * dt + 4 * rq], res[16 * dt + 4 * rq + 1]); ov.y = cvtpk(res[16 * dt + 4 * rq + 2], res[16 * dt + 4 * rq + 3]); *(v2u*)(dst + d0) = ov; }
    }
}

__device__ __forceinline__ float gelu_tanh(float x) { const float u = 0.7978845608028654f * (x + 0.044715f * x * x * x); const float t = 1.0f - 2.0f / (1.0f + __expf(2.0f * u)); return 0.5f * x * (1.0f + t); }
template <bool SAMPLE>
__device__ __forceinline__ void cmp_job(const Args& A, int b, int slot, int g, int grp, int lane) {
    const int r32 = lane & 31, h = lane >> 5;
    const int nsb = SAMPLE ? 512 : 256;
    int sb = 31 * grp + r32; const bool sbok = sb < nsb; if (!sbok) sb = nsb - 1;
    const bf16* W1 = (const bf16*)(A.ws + WS_WC1) + (size_t)slot * 64 * 2048;
    const bf16* PROJ = (const bf16*)(A.ws + WS_PROJ);
    f32x16 acc[2][2];
#pragma unroll
    for (int j = 0; j < 2; ++j) { acc[j][0] = f32x16{}; acc[j][1] = f32x16{}; }
    const bf16* w1p = W1 + (size_t)r32 * 2048 + 8 * h;
    const float* crow = nullptr; const bf16* prow = nullptr;
    if (SAMPLE) { const int p0 = 16 * sb; const int page = ((const int*)A.in[5])[b * 64 + (p0 >> 7)];
        crow = A.in[2] + ((size_t)(page * 128 + (p0 & 127)) * 4 + slot) * 128 + g * 64 + 8 * h; }
    else prow = PROJ + (size_t)(b * SEQ + 16 * sb) * NPROJ + C_KV + slot * 128 + g * 64 + 8 * h;
#pragma unroll 2
    for (int s = 0; s < 16; ++s) {
#pragma unroll
        for (int dq = 0; dq < 4; ++dq) {
            bf16x8 bf;
            if (SAMPLE) bf = __builtin_bit_cast(bf16x8, pack_f32x8(crow + (size_t)s * 512 + dq * 16));
            else bf = *(const bf16x8*)(prow + (size_t)s * NPROJ + dq * 16);
#pragma unroll
            for (int j = 0; j < 2; ++j)
#pragma unroll
                for (int ht = 0; ht < 2; ++ht) { const bf16x8 af = *(const bf16x8*)(w1p + (size_t)ht * 32 * 2048 + j * 1024 + s * 64 + dq * 16);
                    acc[j][ht] = __builtin_amdgcn_mfma_f32_32x32x16_bf16(af, bf, acc[j][ht], 0, 0, 0); }
        }
    }
    const float* c1p = (const float*)(A.ws + WS_C1) + slot * 64;
    bf16x8 xb[2][2];
#pragma unroll
    for (int ht = 0; ht < 2; ++ht) {
        float xv[16];
#pragma unroll
        for (int r = 0; r < 16; ++r) { const int hid = 32 * ht + (r & 3) + 8 * (r >> 2) + 4 * h;
            const float c1 = c1p[hid];
            const float h1 = __shfl(acc[1][ht][r], (lane & 32) | ((r32 + 1) & 31));
            xv[r] = gelu_tanh(acc[0][ht][r] + h1 + c1); }
#pragma unroll
        for (int s = 0; s < 2; ++s) { v4u pw; pw.x = cvtpk(xv[8 * s], xv[8 * s + 1]); pw.y = cvtpk(xv[8 * s + 2], xv[8 * s + 3]); pw.z = cvtpk(xv[8 * s + 4], xv[8 * s + 5]); pw.w = cvtpk(xv[8 * s + 6], xv[8 * s + 7]); xb[ht][s] = __builtin_bit_cast(bf16x8, pw); }
    }
    const bf16* W2 = (const bf16*)(A.ws + WS_WC2) + (size_t)slot * 64 * 64;
    f32x16 oo[2];
#pragma unroll
    for (int dt = 0; dt < 2; ++dt) {
        oo[dt] = f32x16{};
#pragma unroll
        for (int ht = 0; ht < 2; ++ht)
#pragma unroll
            for (int s = 0; s < 2; ++s) { const bf16* wp = W2 + (size_t)(32 * dt + r32) * 64 + 32 * ht + 16 * s + 4 * h;
                const v2u lo = *(const v2u*)wp, hi = *(const v2u*)(wp + 8); const v4u af = {lo.x, lo.y, hi.x, hi.y};
                oo[dt] = __builtin_amdgcn_mfma_f32_32x32x16_bf16(__builtin_bit_cast(bf16x8, af), xb[ht][s], oo[dt], 0, 0, 0); }
    }
    const int nblk = SAMPLE ? 511 : 255;
    if (r32 < 31 && sb < nblk && sbok) {
        bf16* dst = (bf16*)(A.ws + (SAMPLE ? (slot ? WS_VCS : WS_KCS) : (slot ? WS_VCP : WS_KCP))) + ((size_t)(b * nsb + sb) * 2 + g) * 64;
#pragma unroll
        for (int dt = 0; dt < 2; ++dt)
#pragma unroll
            for (int rq = 0; rq < 4; ++rq) { v2u wv; wv.x = cvtpk(oo[dt][4 * rq], oo[dt][4 * rq + 1]); wv.y = cvtpk(oo[dt][4 * rq + 2], oo[dt][4 * rq + 3]); *(v2u*)(dst + 32 * dt + 8 * rq + 4 * h) = wv; }
    }
}

__device__ __forceinline__ float log_sigmoid(float x) { return fminf(x, 0.f) - __logf(1.0f + __expf(-fabsf(x))); }
constexpr int G_QE = 0, G_KE = 8192, G_KDT = 16384, G_V = 24576, G_ST = 40960, G_LR = 73728, G_SEG = 77824, G_DEC = 79872, G_END = 80128;
__device__ __forceinline__ int sw128(int row, int ch) { return row * 128 + ((ch ^ ((row >> 1) & 7)) << 4); }

__device__ __forceinline__ void gla_local(const Frame& F, const Args& A, LAS unsigned char* sh, int unit) {
    const int b = unit >> 6, hh = (unit >> 4) & 3, sc = unit & 15;
    const int lane = opaque(F.lane), w = F.wave, tid = w * 64 + lane, r32 = lane & 31, h = lane >> 5;
    const bf16* PROJ = (const bf16*)(A.ws + WS_PROJ);
    const size_t tok0 = (size_t)b * SEQ + 256 * sc;
    const int c = lane;
    float wg[16];
#pragma unroll
    for (int r = 0; r < 16; ++r) wg[r] = A.in[13][r * 256 + hh * 64 + c];
    const float bg = A.in[14][hh * 64 + c];
    float Bprev = 0.f;
    const int dvt = w >> 1, it = w & 1;
    f32x16 accS = {};
    const int i16 = lane & 15, tq = i16 >> 2, tp = i16 & 3, g1 = (lane >> 4) & 1;
    const int vcol = ((4 * (dvt ^ tq) + 2 * g1 + (tp >> 1)) << 4) + (tp & 1) * 8;
    __syncthreads();
#pragma unroll 1
    for (int n = 0; n < 4; ++n) {
        const size_t tb = tok0 + 64 * n;
        { const int trow = tid >> 3, pr = tid & 7; const unsigned lw = *(const unsigned*)(PROJ + (tb + trow) * NPROJ + C_LR + 2 * pr);
          LAS float* lr = (LAS float*)(sh + G_LR); lr[trow * 16 + 2 * pr] = bflo(lw); lr[trow * 16 + 2 * pr + 1] = bfhi(lw);
#pragma unroll
          for (int k2 = 0; k2 < 2; ++k2) { const int ch = pr * 2 + k2; const v4u vv = *(const v4u*)(PROJ + (tb + trow) * NPROJ + C_VG + hh * 128 + ch * 8);
              *(LAS v4u*)(sh + G_V + trow * 256 + ((ch ^ ((trow & 3) << 2)) << 4)) = vv; } }
        __syncthreads();
        float cum[8], qv[8], kv[8];
        { LAS const float* lr = (LAS const float*)(sh + G_LR); float run = 0.f;
#pragma unroll
          for (int k = 0; k < 8; ++k) { const int i = 8 * w + k; float x = bg;
#pragma unroll
              for (int r = 0; r < 16; ++r) x += lr[i * 16 + r] * wg[r];
              run += log_sigmoid(x) * (1.0f / 16.0f); cum[k] = run;
              qv[k] = 0.125f * bf2f(PROJ[(tb + i) * NPROJ + C_QG + hh * 64 + c]); kv[k] = bf2f(PROJ[(tb + i) * NPROJ + C_KG + hh * 64 + c]); }
          ((LAS float*)(sh + G_SEG))[w * 64 + c] = run; }
        __syncthreads();
        { LAS const float* seg = (LAS const float*)(sh + G_SEG); float pre = 0.f, tot = 0.f;
#pragma unroll
          for (int g_ = 0; g_ < 8; ++g_) { const float sv = seg[g_ * 64 + c]; tot += sv; if (g_ < w) pre += sv; }
          const float eB = __expf(Bprev);
          unsigned kdw[4];
#pragma unroll
          for (int k = 0; k < 8; ++k) { const int i = 8 * w + k; const float bb = pre + cum[k];
              const float qe = qv[k] * __expf(bb), ke = kv[k] * __expf(-bb), kd = kv[k] * __expf(tot - bb);
              *(LAS unsigned short*)(sh + G_QE + sw128(i, c >> 3) + (c & 7) * 2) = (unsigned short)f2bf(qe);
              *(LAS unsigned short*)(sh + G_KE + sw128(i, c >> 3) + (c & 7) * 2) = (unsigned short)f2bf(ke);
              ((bf16*)(A.ws + WS_QB))[(tb + i) * 256 + hh * 64 + c] = (bf16)f2bf(qe * eB);
              if (k & 1) kdw[k >> 1] |= f2bf(kd) << 16; else kdw[k >> 1] = f2bf(kd); }
          *(LAS v4u*)(sh + G_KDT + sw128(c, w)) = (v4u){kdw[0], kdw[1], kdw[2], kdw[3]};
          if (w == 0) ((LAS float*)(sh + G_DEC))[c] = __expf(tot);
          Bprev += tot; }
        __syncthreads();
        LAS const unsigned char* qeb = sh + G_QE; LAS const unsigned char* keb = sh + G_KE; LAS const unsigned char* vbase = sh + G_V;
        bf16x8 qfr[4];
#pragma unroll
        for (int ks = 0; ks < 4; ++ks) qfr[ks] = *(LAS const bf16x8*)(qeb + sw128(32 * it + r32, 2 * ks + h));
        f32x16 oT = {};
#pragma unroll
        for (int jt = 0; jt < 2; ++jt) {
            if (jt <= it) {
                f32x16 s = {};
#pragma unroll
                for (int ks = 0; ks < 4; ++ks) { const bf16x8 kf = *(LAS const bf16x8*)(keb + sw128(32 * jt + r32, 2 * ks + h)); s = __builtin_amdgcn_mfma_f32_32x32x16_bf16(kf, qfr[ks], s, 0, 0, 0); }
                if (jt == it) {
#pragma unroll
                    for (int r = 0; r < 16; ++r) { const int j = (r & 3) + 8 * (r >> 2) + 4 * h; if (j > r32) s[r] = 0.f; }
                }
#pragma unroll
                for (int s2 = 0; s2 < 2; ++s2) {
                    v4u pw; pw.x = cvtpk(s[8 * s2], s[8 * s2 + 1]); pw.y = cvtpk(s[8 * s2 + 2], s[8 * s2 + 3]); pw.z = cvtpk(s[8 * s2 + 4], s[8 * s2 + 5]); pw.w = cvtpk(s[8 * s2 + 6], s[8 * s2 + 7]);
                    const int row = 32 * jt + 16 * s2 + 4 * h + tq;
                    const s16x4 lo = vtr(vbase + row * 256 + vcol), hi = vtr(vbase + (row + 8) * 256 + vcol);
                    const bf16x8 vf = {lo[0], lo[1], lo[2], lo[3], hi[0], hi[1], hi[2], hi[3]};
                    oT = __builtin_amdgcn_mfma_f32_32x32x16_bf16(vf, __builtin_bit_cast(bf16x8, pw), oT, 0, 0, 0);
                }
            }
        }
        if (n > 0) {
            LAS const unsigned char* stb = sh + G_ST + (n & 1) * 16384;
#pragma unroll
            for (int ks = 0; ks < 4; ++ks) { const bf16x8 sf = *(LAS const bf16x8*)(stb + sw128(32 * dvt + r32, 2 * ks + h)); oT = __builtin_amdgcn_mfma_f32_32x32x16_bf16(sf, qfr[ks], oT, 0, 0, 0); }
        }
        { float* op = (float*)(A.ws + WS_OLOC) + (tb + 32 * it + r32) * 512 + hh * 128 + 32 * dvt + 4 * h;
#pragma unroll
          for (int rq = 0; rq < 4; ++rq) *(f32x4*)(op + 8 * rq) = (f32x4){oT[4 * rq], oT[4 * rq + 1], oT[4 * rq + 2], oT[4 * rq + 3]}; }
        { const float dec = ((LAS const float*)(sh + G_DEC))[32 * it + r32];
#pragma unroll
          for (int r = 0; r < 16; ++r) accS[r] *= dec;
#pragma unroll
          for (int ks = 0; ks < 4; ++ks) {
              const bf16x8 kdf = *(LAS const bf16x8*)(sh + G_KDT + sw128(32 * it + r32, 2 * ks + h));
              const int row = 16 * ks + 8 * h + tq;
              const s16x4 lo = vtr(vbase + row * 256 + vcol), hi = vtr(vbase + (row + 4) * 256 + vcol);
              const bf16x8 vf = {lo[0], lo[1], lo[2], lo[3], hi[0], hi[1], hi[2], hi[3]};
              accS = __builtin_amdgcn_mfma_f32_32x32x16_bf16(vf, kdf, accS, 0, 0, 0);
          }
          LAS unsigned char* stn = sh + G_ST + ((n + 1) & 1) * 16384; const int d = 32 * it + r32;
#pragma unroll
          for (int r = 0; r < 16; ++r) { const int dv = 32 * dvt + (r & 3) + 8 * (r >> 2) + 4 * h; *(LAS unsigned short*)(stn + sw128(dv, d >> 3) + (d & 7) * 2) = (unsigned short)f2bf(accS[r]); } }
        __syncthreads();
    }
    { float* up = (float*)(A.ws + WS_USC) + (size_t)unit * 8192; const int d = 32 * it + r32;
#pragma unroll
      for (int r = 0; r < 16; ++r) { const int dv = 32 * dvt + (r & 3) + 8 * (r >> 2) + 4 * h; up[dv * 64 + d] = accS[r]; }
      if (w == 0) ((float*)(A.ws + WS_DSC))[unit * 64 + c] = __expf(Bprev); }
}

__device__ __forceinline__ void gla_out(const Frame& F, const Args& A, LAS unsigned char* sh, int unit) {
    const int b = unit >> 6, hh = (unit >> 4) & 3, sc = unit & 15;
    const int lane = opaque(F.lane), w = F.wave, tid = w * 64 + lane, r32 = lane & 31, h = lane >> 5;
    const bf16* PROJ = (const bf16*)(A.ws + WS_PROJ);
    const size_t tok0 = (size_t)b * SEQ + 256 * sc;
    const int d4 = (tid & 15) * 4, dvr = tid >> 4;
    f32x4 S[4];
#pragma unroll
    for (int k = 0; k < 4; ++k) S[k] = (f32x4){0.f, 0.f, 0.f, 0.f};
    const float* U0 = (const float*)(A.ws + WS_USC) + (size_t)(unit - sc) * 8192; const float* D0 = (const float*)(A.ws + WS_DSC) + (size_t)(unit - sc) * 64;
#pragma unroll 1
    for (int s = 0; s < sc; ++s) { const f32x4 dd = *(const f32x4*)(D0 + s * 64 + d4);
#pragma unroll
        for (int k = 0; k < 4; ++k) { const f32x4 u = *(const f32x4*)(U0 + (size_t)s * 8192 + (32 * k + dvr) * 64 + d4); S[k] = S[k] * dd + u; } }
    __syncthreads();
#pragma unroll
    for (int k = 0; k < 4; ++k) { const int dv = 32 * k + dvr; v2u wv; wv.x = pk2(S[k].x, S[k].y); wv.y = pk2(S[k].z, S[k].w);
        *(LAS v2u*)(sh + sw128(dv, d4 >> 3) + (d4 & 7) * 2) = wv; }
    if (sc == 15) {
        const f32x4 dd = *(const f32x4*)(D0 + 15 * 64 + d4); float* op = A.out + O_GLAP + (size_t)(b * 4 + hh) * 8192;
#pragma unroll
        for (int k = 0; k < 4; ++k) { const int dv = 32 * k + dvr; const f32x4 u = *(const f32x4*)(U0 + (size_t)15 * 8192 + dv * 64 + d4); const f32x4 e = S[k] * dd + u;
            op[(d4 + 0) * 128 + dv] = e.x; op[(d4 + 1) * 128 + dv] = e.y; op[(d4 + 2) * 128 + dv] = e.z; op[(d4 + 3) * 128 + dv] = e.w; }
    }
    __syncthreads();
    const size_t tok = tok0 + 32 * w + r32;
    f32x16 acc[4];
#pragma unroll
    for (int t = 0; t < 4; ++t) acc[t] = f32x16{};
#pragma unroll
    for (int ks = 0; ks < 4; ++ks) { const bf16x8 qb = *(const bf16x8*)((const bf16*)(A.ws + WS_QB) + tok * 256 + hh * 64 + 16 * ks + 8 * h);
#pragma unroll
        for (int t = 0; t < 4; ++t) { const bf16x8 sf = *(LAS const bf16x8*)(sh + sw128(32 * t + r32, 2 * ks + h)); acc[t] = __builtin_amdgcn_mfma_f32_32x32x16_bf16(sf, qb, acc[t], 0, 0, 0); } }
    const float* ol = (const float*)(A.ws + WS_OLOC) + tok * 512 + hh * 128;
    float ss = 0.f;
#pragma unroll
    for (int t = 0; t < 4; ++t)
#pragma unroll
        for (int rq = 0; rq < 4; ++rq) { const f32x4 v = *(const f32x4*)(ol + 32 * t + 8 * rq + 4 * h);
#pragma unroll
            for (int e = 0; e < 4; ++e) { acc[t][4 * rq + e] += v[e]; ss += acc[t][4 * rq + e] * acc[t][4 * rq + e]; } }
    ss += __shfl_xor(ss, 32);
    const float rstd = 1.0f / sqrtf(ss * (1.0f / 128.0f) + EPS);
    const float* gn = A.in[15]; const bf16* gg = PROJ + tok * NPROJ + C_GG + hh * 128;
    bf16* dst = (bf16*)(A.ws + WS_MIX) + tok * 1024 + 512 + hh * 128;
#pragma unroll
    for (int t = 0; t < 4; ++t)
#pragma unroll
        for (int rq = 0; rq < 4; ++rq) { const int dv0 = 32 * t + 8 * rq + 4 * h; const f32x4 gnv = *(const f32x4*)(gn + dv0); const v2u gw = *(const v2u*)(gg + dv0);
            const float gv[4] = {bflo(gw.x), bfhi(gw.x), bflo(gw.y), bfhi(gw.y)}; float y[4];
#pragma unroll
            for (int e = 0; e < 4; ++e) y[e] = acc[t][4 * rq + e] * rstd * gnv[e] * gv[e] / (1.0f + __expf(-gv[e]));
            v2u ov; ov.x = cvtpk(y[0], y[1]); ov.y = cvtpk(y[2], y[3]); *(v2u*)(dst + dv0) = ov; }
}

__device__ __forceinline__ void gla_sample(const Frame& F, const Args& A, LAS unsigned char* sh, int unit) {
    const int b = unit >> 2, hh = unit & 3, tid = F.wave * 64 + opaque(F.lane);
    const bf16* PROJ = (const bf16*)(A.ws + WS_PROJ);
    LAS float* la = (LAS float*)sh;
    LAS float* qs = la + 256;
    LAS float* ks = qs + 256;
    LAS float* op = ks + 256;
    LAS float* of = op + 2048;
    __syncthreads();
    if (tid < 256) { const int t = tid >> 6, c = tid & 63; const size_t tok = (size_t)TP + b * 4 + t; float x = A.in[14][hh * 64 + c];
#pragma unroll
        for (int r = 0; r < 16; ++r) x += bf2f(PROJ[tok * NPROJ + C_LR + r]) * A.in[13][r * 256 + hh * 64 + c];
        la[tid] = __expf(log_sigmoid(x) * (1.0f / 16.0f)); qs[tid] = 0.125f * bf2f(PROJ[tok * NPROJ + C_QG + hh * 64 + c]); ks[tid] = bf2f(PROJ[tok * NPROJ + C_KG + hh * 64 + c]); }
    __syncthreads();
    const int dv = tid & 127, cg = tid >> 7;
    const float* s0 = A.in[4] + (size_t)(b * 4 + hh) * 8192;
    float S[16];
#pragma unroll
    for (int k = 0; k < 16; ++k) S[k] = s0[(16 * cg + k) * 128 + dv];
#pragma unroll
    for (int t = 0; t < 4; ++t) { const float vv = bf2f(PROJ[((size_t)TP + b * 4 + t) * NPROJ + C_VG + hh * 128 + dv]); float o = 0.f;
#pragma unroll
        for (int k = 0; k < 16; ++k) { const int c = 16 * cg + k; S[k] = la[t * 64 + c] * S[k] + ks[t * 64 + c] * vv; o += qs[t * 64 + c] * S[k]; }
        op[(cg * 4 + t) * 128 + dv] = o; }
    float* so = A.out + O_GLAS + (size_t)(b * 4 + hh) * 8192;
#pragma unroll
    for (int k = 0; k < 16; ++k) so[(16 * cg + k) * 128 + dv] = S[k];
    __syncthreads();
    { const int t = tid >> 7; of[t * 128 + dv] = (op[(0 * 4 + t) * 128 + dv] + op[(1 * 4 + t) * 128 + dv]) + (op[(2 * 4 + t) * 128 + dv] + op[(3 * 4 + t) * 128 + dv]); }
    __syncthreads();
    { const int t = tid >> 7; float ss = 0.f;
      for (int k = 0; k < 128; ++k) { const float v = of[t * 128 + k]; ss += v * v; }
      const float rstd = 1.0f / sqrtf(ss * (1.0f / 128.0f) + EPS); const size_t tok = (size_t)TP + b * 4 + t;
      const float gv = bf2f(PROJ[tok * NPROJ + C_GG + hh * 128 + dv]);
      const float y = of[t * 128 + dv] * rstd * A.in[15][dv] * gv / (1.0f + __expf(-gv));
      ((bf16*)(A.ws + WS_MIX))[tok * 1024 + 512 + hh * 128 + dv] = (bf16)f2bf(y); }
}

#ifdef PROBE_PHASE
#define PREP(k) ((PROBE_PHASE) == (k) ? 2 : 1)
#else
#define PREP(k) 1
#endif
__device__ __forceinline__ void phase2(const Frame& F, const Args& A) {
    LAS unsigned char* sh = F.lds;
    _Pragma("unroll 1") for (int rep = 0; rep < PREP(21); ++rep) { const int gw = F.vcu * NWAVES + F.wave, NGW = F.G * NWAVES; constexpr int NJP = 4 * 2 * 2 * 9, NJS = 32 * 2 * 2 * 17;
      for (int job = gw; job < NJP + NJS; job += NGW) {
          if (job >= NJS) { const int j = job - NJS; const int grp = j % 9, g = (j / 9) & 1, slot = (j / 18) & 1, b = j / 36;
#ifndef SKIP_CMP
 cmp_job<false>(A, b, slot, g, grp, opaque(F.lane));
#endif
 }
          else { const int grp = job % 17, g = (job / 17) & 1, slot = (job / 34) & 1, b = job / 68;
#ifndef SKIP_CMP
 cmp_job<true>(A, b, slot, g, grp, opaque(F.lane));
#endif
 }
      } }
    #ifndef SKIP_GLAL
    _Pragma("unroll 1") for (int rep = 0; rep < PREP(22); ++rep) for (int u = F.vcu; u < 256; u += F.G) gla_local(F, A, sh, u);
#endif
    #ifndef SKIP_GLAS
    _Pragma("unroll 1") for (int rep = 0; rep < PREP(24); ++rep) for (int u = F.vcu; u < 128; u += F.G) gla_sample(F, A, sh, u);
#endif
    __syncthreads();
    attn_fill_lut((LAS float*)(sh + AT_LUT), A.in[24], F.tid);
    __syncthreads();
    _Pragma("unroll 1") for (int rep = 0; rep < PREP(23); ++rep) for (int p = F.vcu; p < 256; p += F.G) { const int bg = p >> 5, s = p & 31;
#ifndef SKIP_WIN
 win_unit(F, A, sh, bg >> 1, bg & 1, 63 - s); win_unit(F, A, sh, bg >> 1, bg & 1, s);
#endif
 }
}
__device__ __forceinline__ void phase3(const Frame& F, const Args& A) {
    LAS unsigned char* sh = F.lds;
    #ifndef SKIP_GLAO
    _Pragma("unroll 1") for (int rep = 0; rep < PREP(31); ++rep) for (int u = F.vcu; u < 256; u += F.G) gla_out(F, A, sh, u);
#endif
    __syncthreads();
    attn_fill_lut((LAS float*)(sh + AT_LUT), A.in[24], F.tid);
    __syncthreads();
    #ifndef SKIP_SAMP
    _Pragma("unroll 1") for (int rep = 0; rep < PREP(32); ++rep) for (int u = F.vcu; u < 64; u += F.G) samp_unit(F, A, sh, u >> 1, u & 1);
#endif
    _Pragma("unroll 1") for (int rep = 0; rep < PREP(33); ++rep) for (int p = F.vcu; p < 256; p += F.G) { const int bg = p >> 5, s = p & 31;
#ifndef SKIP_NSA
 nsa_unit(F, A, sh, bg >> 1, bg & 1, 63 - s); nsa_unit(F, A, sh, bg >> 1, bg & 1, s);
#endif
 }
}

template <class Epi>
__device__ __forceinline__ void skinny_phase(const Frame& F, const bf16* Act, int lda, const bf16* Bt, int K, int ncolgrp, const Epi& E) {
    const int lane = hw_lane(), w = F.wave, c16 = lane & 15, kg = lane >> 4;
    const int tg = w & 1, kq = w >> 1, kq_len = K / 4;
    LAS f32x4* xs = (LAS f32x4*)F.lds;
    for (int job = blockIdx.x; job < 4 * ncolgrp; job += F.G) {
        const int cg = job >> 2, tok = TP + 32 * (job & 3) + 16 * tg + c16;
        const bf16* ap = Bt + (size_t)(16 * cg + c16) * K + kq * kq_len + 8 * kg;
        const bf16* bp = Act + (size_t)tok * lda + kq * kq_len + 8 * kg;
        f32x4 acc = {0.f, 0.f, 0.f, 0.f};
#pragma unroll 8
        for (int ks = 0; ks < kq_len / 32; ++ks) { const bf16x8 af = *(const bf16x8*)(ap + 32 * ks), bf = *(const bf16x8*)(bp + 32 * ks); acc = __builtin_amdgcn_mfma_f32_16x16x32_bf16(af, bf, acc, 0, 0, 0); }
        __syncthreads();
        xs[w * 64 + lane] = acc;
        __syncthreads();
        if (kq == 0) { const f32x4 v = (xs[tg * 64 + lane] + xs[(2 + tg) * 64 + lane]) + (xs[(4 + tg) * 64 + lane] + xs[(6 + tg) * 64 + lane]); E(v, tok, 16 * cg + 4 * kg, kg); }
    }
}
struct SkInProj { bf16* proj; float* out;
    __device__ __forceinline__ void operator()(f32x4 v, int tok, int col, int kg) const {
        if (col < 512) v = v * 0.125f;
        v2u w; w.x = cvtpk(v[0], v[1]); w.y = cvtpk(v[2], v[3]); *(v2u*)(proj + (size_t)tok * NPROJ + col) = w;
        if (col >= C_KV && col < C_WIN) *(f32x4*)(out + O_KV + (size_t)tok * 512 + (col - C_KV)) = v;
        else if (col >= C_WIN && col < C_GT) { const int rs = tok - TP, b = rs >> 2, i = rs & 3; *(f32x4*)(out + O_WINS + ((size_t)(b * 512 + 508 + i) * 256 + (col - C_WIN))) = v; }
    } };
struct SkResid { const float* base; float* hout; bf16* hb; float* rowss;
    __device__ __forceinline__ void operator()(f32x4 v, int tok, int col, int kg) const {
        v = v + *(const f32x4*)(base + (size_t)(tok - TP) * 1024 + col);
        *(f32x4*)(hout + (size_t)tok * 1024 + col) = v;
        v2u w; w.x = cvtpk(v[0], v[1]); w.y = cvtpk(v[2], v[3]); *(v2u*)(hb + (size_t)tok * 1024 + col) = w;
        float ss = (v[0] * v[0] + v[1] * v[1]) + (v[2] * v[2] + v[3] * v[3]); ss += __shfl_xor(ss, 16); ss += __shfl_xor(ss, 32);
        if (kg == 0) atomicAdd(rowss + tok, ss);
    } };
struct SkBf { bf16* O; int ldc;
    __device__ __forceinline__ void operator()(f32x4 v, int tok, int col, int kg) const { v2u w; w.x = cvtpk(v[0], v[1]); w.y = cvtpk(v[2], v[3]); *(v2u*)(O + (size_t)tok * ldc + col) = w; } };
struct SkPleGate { const float* h2; const bf16* ple; const float* rowss2; float* y; float* rowss3;
    __device__ __forceinline__ void operator()(f32x4 a, int tok, int col, int kg) const {
        const float rstd = __builtin_amdgcn_rsqf(rowss2[tok] * (1.0f / 1024.0f) + EPS);
        const v2u pw = *(const v2u*)(ple + (size_t)tok * 1024 + col); const f32x4 b = *(const f32x4*)(h2 + (size_t)tok * 1024 + col);
        const float pv[4] = {bflo(pw.x), bfhi(pw.x), bflo(pw.y), bfhi(pw.y)}; f32x4 v;
#pragma unroll
        for (int e = 0; e < 4; ++e) v[e] = b[e] + pv[e] * __builtin_amdgcn_rcpf(1.0f + __expf(-a[e] * rstd));
        *(f32x4*)(y + (size_t)tok * 1024 + col) = v;
        float ss = (v[0] * v[0] + v[1] * v[1]) + (v[2] * v[2] + v[3] * v[3]); ss += __shfl_xor(ss, 16); ss += __shfl_xor(ss, 32);
        if (kg == 0) atomicAdd(rowss3 + tok, ss);
    } };

typedef const __attribute__((address_space(4))) Args* ArgsP;
__device__ __forceinline__ Args load_args() {
    Args r{};
#if defined(__HIP_DEVICE_COMPILE__)
    ArgsP p = (ArgsP)__builtin_amdgcn_kernarg_segment_ptr(); asm volatile("" : "+s"(p));
#pragma unroll
    for (int i = 0; i < 26; ++i) r.in[i] = p->in[i];
    r.out = p->out; r.ws = p->ws; r.ph_lo = p->ph_lo; r.ph_hi = p->ph_hi;
#endif
    return r;
}
__global__ void __launch_bounds__(NWAVES * 64, 2) mega_fwd(Args args_unused) {
    extern __shared__ __attribute__((aligned(16))) unsigned char lds_raw[];
    Frame F;
    F.lds = (LAS unsigned char*)lds_raw;
    F.wave = __builtin_amdgcn_readfirstlane((int)threadIdx.x >> 6); F.lane = hw_lane(); F.tid = F.wave * 64 + F.lane;
    F.G = gridDim.x; { const int bx = blockIdx.x; F.vcu = (F.G % 8 == 0) ? (bx % 8) * (F.G / 8) + bx / 8 : bx; }
    int lo, hi; unsigned char* ws;
    { const Args a0 = load_args(); lo = a0.ph_lo; hi = a0.ph_hi; ws = a0.ws; }
    gu32* ctl = (gu32*)(ws + WS_CTL);
    volatile LAS unsigned* MISC = (volatile LAS unsigned*)(F.lds + MISC_OFF);
    for (int u = F.tid; u < (LDS_BYTES - RING_BYTES) / 4; u += NWAVES * 64) ((LAS unsigned*)(F.lds + RING_BYTES))[u] = 0u;
    __syncthreads();
    const bool multi = (hi - lo) > 1;
    XcdBarrier bar; bar.bar = (unsigned*)(ctl + CW_BAR); bar.x = 0; bar.st = nullptr;
    if (multi) bar = xcd_barrier_post((unsigned*)(ctl + CW_BAR), MISC + 8, F.tid);
#define IN(k) (lo <= (k) && (k) < hi)
#ifdef PROBE_PHASE
#define NREP(k) ((PROBE_PHASE) == (k) ? 2 : 1)
#else
#define NREP(k) 1
#endif
    float* dummy_rowss = (float*)(ws + WS_END);
#define SEAM(k) do { if (IN(k) && IN((k) + 1)) { F.lane = hw_lane(); F.tid = F.wave * 64 + F.lane; xcd_barrier(bar, F.tid); } } while (0)
#define REFRESH() do { F.lane = hw_lane(); F.tid = F.wave * 64 + F.lane; } while (0)

    if (IN(0)) { REFRESH(); const Args args = load_args(); _Pragma("unroll 1") for (int rep = 0; rep < NREP(0); ++rep) { __syncthreads(); p0_prologue(F, args); } } SEAM(0);
    if (IN(1)) { REFRESH(); const Args args = load_args(); unsigned char* ws = args.ws;
        pg8::Gemm g{(const pg8::bf16_t*)(ws + WS_XN), (const pg8::bf16_t*)(ws + WS_WIN), TP, NPROJ, 1024}; pg8::StaticOrder S; S.init(TP, NPROJ, F.G, (int)blockIdx.x);
        pg8::EpiInProj E{(pg8::bf16_t*)(ws + WS_PROJ), args.out};
        _Pragma("unroll 1") for (int rep = 0; rep < NREP(1); ++rep) pg8::gemm_phase<pg8::EpiInProj, pg8::StaticOrder, true, true>(F.lds, g, S, E, F.tid);
        skinny_phase(F, (const bf16*)(ws + WS_XN), 1024, (const bf16*)(ws + WS_WIN), 1024, (NIN + 15) / 16, SkInProj{(bf16*)(ws + WS_PROJ), args.out});
    } SEAM(1);
    if (IN(2)) { REFRESH(); const Args args = load_args(); phase2(F, args); } SEAM(2);
    if (IN(3)) { REFRESH(); const Args args = load_args(); phase3(F, args); } SEAM(3);
    if (IN(4)) { REFRESH(); const Args args = load_args(); unsigned char* ws = args.ws; float* rowss1 = (float*)(ws + WS_ROWSS);
        { pg8::Gemm g{(const pg8::bf16_t*)(ws + WS_MIX), (const pg8::bf16_t*)(ws + WS_WO), TP, 1024, 1024}; pg8::StaticOrder S; S.init(TP, 1024, F.G, (int)blockIdx.x);
          _Pragma("unroll 1") for (int rep = 0; rep < NREP(4); ++rep) { pg8::EpiResid E{args.in[0], args.in[1], (float*)(ws + WS_H1), (pg8::bf16_t*)(ws + WS_H1B), rep ? dummy_rowss : rowss1};
          pg8::gemm_phase<pg8::EpiResid, pg8::StaticOrder, true, true>(F.lds, g, S, E, F.tid); } }
        { pg8::Gemm g{(const pg8::bf16_t*)(ws + WS_PPLE), (const pg8::bf16_t*)(ws + WS_WPLE), TP, 1024, 256}; pg8::StaticOrder S; S.init(TP, 1024, F.G, (int)blockIdx.x);
          pg8::EpiBf E{(pg8::bf16_t*)(ws + WS_PLEB), 1024};
          _Pragma("unroll 1") for (int rep = 0; rep < NREP(41); ++rep) pg8::gemm_phase<pg8::EpiBf, pg8::StaticOrder, true, true>(F.lds, g, S, E, F.tid); }
        skinny_phase(F, (const bf16*)(ws + WS_MIX), 1024, (const bf16*)(ws + WS_WO), 1024, 64, SkResid{args.in[1], (float*)(ws + WS_H1), (bf16*)(ws + WS_H1B), rowss1});
        skinny_phase(F, (const bf16*)(ws + WS_PPLE), 256, (const bf16*)(ws + WS_WPLE), 256, 64, SkBf{(bf16*)(ws + WS_PLEB), 1024});
    } SEAM(4);
    if (IN(5)) { REFRESH(); const Args args = load_args(); unsigned char* ws = args.ws; float* rowss1 = (float*)(ws + WS_ROWSS);
        pg8::Gemm g{(const pg8::bf16_t*)(ws + WS_H1B), (const pg8::bf16_t*)(ws + WS_WGU), MPAD, NGU, 1024}; pg8::StaticOrder S; S.init(MPAD, NGU, F.G, (int)blockIdx.x);
        pg8::EpiGateUp E{(pg8::bf16_t*)(ws + WS_ACT), rowss1};
        _Pragma("unroll 1") for (int rep = 0; rep < NREP(5); ++rep) pg8::gemm_phase<pg8::EpiGateUp, pg8::StaticOrder, true, true>(F.lds, g, S, E, F.tid);
    } SEAM(5);
    if (IN(6)) { REFRESH(); const Args args = load_args(); unsigned char* ws = args.ws; float* rowss2 = (float*)(ws + WS_ROWSS) + MPAD;
        pg8::Gemm g{(const pg8::bf16_t*)(ws + WS_ACT), (const pg8::bf16_t*)(ws + WS_WDN), TP, 1024, DFF}; pg8::StaticOrder S; S.init(TP, 1024, F.G, (int)blockIdx.x);
        _Pragma("unroll 1") for (int rep = 0; rep < NREP(6); ++rep) { pg8::EpiResid E{(const float*)(ws + WS_H1), (const float*)(ws + WS_H1) + (size_t)TP * 1024, (float*)(ws + WS_H2), (pg8::bf16_t*)(ws + WS_H2B), rep ? dummy_rowss : rowss2};
        pg8::gemm_phase<pg8::EpiResid, pg8::StaticOrder, true, true>(F.lds, g, S, E, F.tid); }
        skinny_phase(F, (const bf16*)(ws + WS_ACT), DFF, (const bf16*)(ws + WS_WDN), DFF, 64, SkResid{(const float*)(ws + WS_H1) + (size_t)TP * 1024, (float*)(ws + WS_H2), (bf16*)(ws + WS_H2B), rowss2});
    } SEAM(6);
    if (IN(7)) { REFRESH(); const Args args = load_args(); unsigned char* ws = args.ws; float* rowss2 = (float*)(ws + WS_ROWSS) + MPAD; float* rowss3 = rowss2 + MPAD;
        pg8::Gemm g{(const pg8::bf16_t*)(ws + WS_H2B), (const pg8::bf16_t*)(ws + WS_WPG), TP, 1024, 1024}; pg8::StaticOrder S; S.init(TP, 1024, F.G, (int)blockIdx.x);
        _Pragma("unroll 1") for (int rep = 0; rep < NREP(7); ++rep) { pg8::EpiPleGate E{(const float*)(ws + WS_H2), (const pg8::bf16_t*)(ws + WS_PLEB), rowss2, args.out + O_Y, rep ? dummy_rowss : rowss3};
        pg8::gemm_phase<pg8::EpiPleGate, pg8::StaticOrder, true, true>(F.lds, g, S, E, F.tid); }
        skinny_phase(F, (const bf16*)(ws + WS_H2B), 1024, (const bf16*)(ws + WS_WPG), 1024, 64, SkPleGate{(const float*)(ws + WS_H2), (const bf16*)(ws + WS_PLEB), rowss2, args.out + O_Y, rowss3});
    } SEAM(7);
    if (IN(8)) { REFRESH(); const Args args = load_args(); unsigned char* ws = args.ws; float* rowss3 = (float*)(ws + WS_ROWSS) + 2 * MPAD;
        const int gw = F.vcu * NWAVES + F.wave, NGW = F.G * NWAVES; const GAS f32x4* gr = (const GAS f32x4*)args.in[25] + F.lane;
        for (int m = gw; m < MTOT; m += NGW) { GAS f32x4* yr = (GAS f32x4*)(args.out + O_Y + (size_t)m * 1024) + F.lane; const float rstd = 1.0f / sqrtf(rowss3[m] * (1.0f / 1024.0f) + EPS);
#pragma unroll
            for (int j = 0; j < 4; ++j) { const f32x4 v = yr[64 * j], gg = gr[64 * j]; yr[64 * j] = (f32x4){v.x * rstd * gg.x, v.y * rstd * gg.y, v.z * rstd * gg.z, v.w * rstd * gg.w}; } }
    }
#undef IN
#undef SEAM
#undef REFRESH
}

extern "C" void kernel_launch(void* const* d_in, const int* in_sizes, int n_in, void* d_out, int out_size, void* d_ws, size_t ws_size, hipStream_t stream) {
    static int grid = 0;
    if (grid == 0) {
        if (n_in != 26 || (size_t)out_size != O_END || ws_size < WS_END + (1u << 20)) { fprintf(stderr, "kernel_launch: unexpected shapes: n_in %d out %d ws %zu\n", n_in, out_size, ws_size); grid = -1; return; }
        int dev = 0, cus = 0, per_cu = 0;
        if (hipGetDevice(&dev) != hipSuccess || hipDeviceGetAttribute(&cus, hipDeviceAttributeMultiprocessorCount, dev) != hipSuccess) { grid = -1; return; }
        if (hipFuncSetAttribute((const void*)mega_fwd, hipFuncAttributeMaxDynamicSharedMemorySize, LDS_BYTES) != hipSuccess) { fprintf(stderr, "kernel_launch: hipFuncSetAttribute failed\n"); grid = -1; return; }
        if (hipOccupancyMaxActiveBlocksPerMultiprocessor(&per_cu, (const void*)mega_fwd, NWAVES * 64, LDS_BYTES) != hipSuccess || per_cu < 1) { fprintf(stderr, "kernel_launch: occupancy query says %d blocks per CU\n", per_cu); grid = -1; return; }
        (void)hipGetLastError();
        grid = cus;
    }
    if (grid < 0) return;
    (void)hipMemsetAsync((char*)d_ws + WS_CTL, 0, CTL_ZERO_BYTES, stream);
    Args a{};
    for (int i = 0; i < 26; ++i) a.in[i] = (const float*)d_in[i];
    a.out = (float*)d_out; a.ws = (unsigned char*)d_ws;
#ifndef N_LAUNCH_SPLIT
    a.ph_lo = 0; a.ph_hi = 9;
    hipLaunchKernelGGL(mega_fwd, dim3(grid), dim3(NWAVES * 64), LDS_BYTES, stream, a);
#else
    for (int p = 0; p < 9; ++p) { a.ph_lo = p; a.ph_hi = p + 1; hipLaunchKernelGGL(mega_fwd, dim3(grid), dim3(NWAVES * 64), LDS_BYTES, stream, a); }
#endif
}
```

```cpp
#include <hip/hip_runtime.h>
#include <cstdio>
#include <cstdint>

constexpr int DM = 1024, TP = 16384, TS = 128, MTOT = TP + TS, MPAD = 16640, SEQ = 4096, NBATCH = 4, DBATCH = 32, DSEQ = 4, PAST = 8192;
constexpr int NPROJ = 3072, DFF = 2816, DPLE = 256, NGU = 2 * DFF;
constexpr int C_QN = 0, C_KV = 512, C_WIN = 1024, C_GT = 1280, C_QG = 1304, C_KG = 1560, C_VG = 1816, C_LR = 2328, C_GG = 2344, NIN = 2856;
constexpr float EPS = 1e-6f;
constexpr size_t O_Y = 0, O_KV = (size_t)MTOT * 1024, O_WINP = O_KV + (size_t)MTOT * 512, O_WINS = O_WINP + 4 * 512 * 256,
                 O_GLAP = O_WINS + (size_t)32 * 512 * 256, O_GLAS = O_GLAP + 4 * 4 * 64 * 128, O_END = O_GLAS + (size_t)32 * 4 * 64 * 128;
namespace pg8 {
#define PG8_LAS __attribute__((address_space(3)))
typedef unsigned short bf16_t;
typedef short bf16x8 __attribute__((ext_vector_type(8)));
typedef float f32x4 __attribute__((ext_vector_type(4)));
typedef unsigned u32x4 __attribute__((ext_vector_type(4)));
constexpr int BM = 256, BK = 64, HALF = 128, HTB = HALF * BK * 2  , STAGE_BYTES = 8 * HTB, NXCD = 8, WGM = 8;

__host__ __device__ __forceinline__ int lds_byte(int r, int c) { const int st = (r >> 4) * 2 + (c >> 5), rr = r & 15, cc = c & 31, ob = rr * 64 + cc * 2; return st * 1024 + (ob ^ (((ob >> 9) & 1) << 5)); }
__host__ __device__ __forceinline__ void stage_rc(int b, int& R, int& C) { const int st = b / 1024, sb = b % 1024, swz = sb ^ (((sb >> 9) & 1) << 5); R = (st >> 1) * 16 + swz / 64; C = (st & 1) * 32 + (swz % 64) / 2; }
__host__ __device__ __forceinline__ int perm32(int rho) { const int n = rho >> 4, i = rho & 15; return 8 * (i >> 2) + 4 * n + (i & 3); }

struct Unit { int pm, pn; };
struct Gemm { const bf16_t* A; const bf16_t* Bt; int M, N, K; };

struct StaticOrder {
    int nM, nN, nwg, G, c;
    __host__ __device__ void init(int M, int N, int G_, int c_) { nM = M / BM; nN = N / BM; nwg = nM * nN; G = G_; c = c_; }
    __host__ __device__ bool next(int i, Unit& u) const {
        const long L = (long)i * G + c; if (L >= nwg) return false;
        int wgid = (int)L; { const int q = nwg / NXCD, r = nwg % NXCD, xcd = wgid % NXCD, off = wgid / NXCD; wgid = (xcd < r ? xcd * (q + 1) : r * (q + 1) + (xcd - r) * q) + off; }
        const int nig = WGM * nN, gid = wgid / nig, fm = gid * WGM, gsz = (nM - fm) < WGM ? (nM - fm) : WGM;
        u.pm = fm + ((wgid % nig) % gsz); u.pn = (wgid % nig) / gsz; return true;
    }
    __device__ __forceinline__ void a_ready(const Unit&) const {}
    __device__ __forceinline__ void done(const Unit&) const {}
};

__device__ __forceinline__ unsigned cvt_pk_bf16(float lo, float hi) { unsigned r; asm volatile("v_cvt_pk_bf16_f32 %0, %1, %2" : "=v"(r) : "v"(lo), "v"(hi)); return r; }

__device__ __forceinline__ u32x4 pack8(const f32x4 v0, const f32x4 v1) { u32x4 w; w.x = cvt_pk_bf16(v0[0], v0[1]); w.y = cvt_pk_bf16(v0[2], v0[3]); w.z = cvt_pk_bf16(v1[0], v1[1]); w.w = cvt_pk_bf16(v1[2], v1[3]); return w; }

struct EpiInProj {
    static constexpr bool PERM = true, AFTER_DRAIN = false;
    bf16_t* proj; float* out;
    __device__ __forceinline__ void operator()(const f32x4 (&acc)[2][2][4][2], const Unit& u, int wr, int wc, int fr, int fq) const {
        const int row0 = u.pm * BM + wr * 64 + fr, colb = u.pn * BM + wc * 32 + 8 * fq;
        const float sc = (u.pn < 2) ? 0.125f : 1.0f;
#pragma unroll
        for (int ai = 0; ai < 2; ++ai)
#pragma unroll
            for (int m = 0; m < 4; ++m) {
                const int r = row0 + ai * HALF + m * 16;
                if (r < MTOT) {
#pragma unroll
                    for (int bj = 0; bj < 2; ++bj) {
                        const int c = colb + bj * HALF;
                        const f32x4 v0 = acc[ai][bj][m][0] * sc, v1 = acc[ai][bj][m][1] * sc;
                        *(u32x4*)(proj + (size_t)r * NPROJ + c) = pack8(v0, v1);
                        if (u.pn == 2 || u.pn == 3) { float* o = out + O_KV + (size_t)r * 512 + (c - C_KV); *(f32x4*)o = v0; *(f32x4*)(o + 4) = v1; }
                        if (u.pn == 4) {
                            const int cc = c - C_WIN; float* o = nullptr;
                            if (r < TP) { const int pos = r & (SEQ - 1), b = r >> 12; if (pos >= SEQ - 512) o = out + O_WINP + ((size_t)(b * 512 + pos - (SEQ - 512)) * 256 + cc); }
                            else { const int rs = r - TP, b = rs >> 2, i = rs & 3; o = out + O_WINS + ((size_t)(b * 512 + 508 + i) * 256 + cc); }
                            if (o) { *(f32x4*)o = v0; *(f32x4*)(o + 4) = v1; }
                        }
                    }
                }
            }
    }
};
struct EpiResid {
    static constexpr bool PERM = true, AFTER_DRAIN = false;
    const float* baseA; const float* baseB;
    float* hout; bf16_t* hb; float* rowss;
    __device__ __forceinline__ void operator()(const f32x4 (&acc)[2][2][4][2], const Unit& u, int wr, int wc, int fr, int fq) const {
        const int row0 = u.pm * BM + wr * 64 + fr, colb = u.pn * BM + wc * 32 + 8 * fq;
#pragma unroll
        for (int ai = 0; ai < 2; ++ai)
#pragma unroll
            for (int m = 0; m < 4; ++m) {
                const int r = row0 + ai * HALF + m * 16;
                float ss = 0.f;
                if (r < MTOT) {
                    const float* bp = (r < TP) ? baseA + (size_t)r * 1024 : baseB + (size_t)(r - TP) * 1024;
#pragma unroll
                    for (int bj = 0; bj < 2; ++bj) {
                        const int c = colb + bj * HALF;
                        const f32x4 v0 = acc[ai][bj][m][0] + *(const f32x4*)(bp + c), v1 = acc[ai][bj][m][1] + *(const f32x4*)(bp + c + 4);
                        float* o = hout + (size_t)r * 1024 + c; *(f32x4*)o = v0; *(f32x4*)(o + 4) = v1;
                        *(u32x4*)(hb + (size_t)r * 1024 + c) = pack8(v0, v1);
                        ss += (v0[0] * v0[0] + v0[1] * v0[1]) + (v0[2] * v0[2] + v0[3] * v0[3]) + (v1[0] * v1[0] + v1[1] * v1[1]) + (v1[2] * v1[2] + v1[3] * v1[3]);
                    }
                }
                ss += __shfl_xor(ss, 16); ss += __shfl_xor(ss, 32);
                if (fq == 0 && r < MTOT) atomicAdd(rowss + r, ss);
            }
    }
};
struct EpiGateUp {
    static constexpr bool PERM = true, AFTER_DRAIN = false;
    bf16_t* act; const float* rowss;
    __device__ __forceinline__ void operator()(const f32x4 (&acc)[2][2][4][2], const Unit& u, int wr, int wc, int fr, int fq) const {
        const int row0 = u.pm * BM + wr * 64 + fr, colb = u.pn * HALF + wc * 32 + 8 * fq;
#pragma unroll
        for (int ai = 0; ai < 2; ++ai)
#pragma unroll
            for (int m = 0; m < 4; ++m) {
                const int r = row0 + ai * HALF + m * 16;
                if (r < MTOT) {
                    const float rstd = __builtin_amdgcn_rsqf(rowss[r] * (1.0f / 1024.0f) + EPS);
                    f32x4 o[2];
#pragma unroll
                    for (int n = 0; n < 2; ++n)
#pragma unroll
                        for (int e = 0; e < 4; ++e) { const float g = acc[ai][0][m][n][e] * rstd, up = acc[ai][1][m][n][e] * rstd; o[n][e] = g * up * __builtin_amdgcn_rcpf(1.0f + __expf(-g)); }
                    *(u32x4*)(act + (size_t)r * DFF + colb) = pack8(o[0], o[1]);
                }
            }
    }
};
struct EpiBf {
    static constexpr bool PERM = true, AFTER_DRAIN = false;
    bf16_t* O; int ldc;
    __device__ __forceinline__ void operator()(const f32x4 (&acc)[2][2][4][2], const Unit& u, int wr, int wc, int fr, int fq) const {
        const int row0 = u.pm * BM + wr * 64 + fr, colb = u.pn * BM + wc * 32 + 8 * fq;
#pragma unroll
        for (int ai = 0; ai < 2; ++ai)
#pragma unroll
            for (int m = 0; m < 4; ++m) {
                const int r = row0 + ai * HALF + m * 16;
                if (r < MTOT) {
#pragma unroll
                    for (int bj = 0; bj < 2; ++bj) *(u32x4*)(O + (size_t)r * ldc + colb + bj * HALF) = pack8(acc[ai][bj][m][0], acc[ai][bj][m][1]);
                }
            }
    }
};
struct EpiPleGate {
    static constexpr bool PERM = true, AFTER_DRAIN = false;
    const float* h2; const bf16_t* ple; const float* rowss2; float* y; float* rowss3;
    __device__ __forceinline__ void operator()(const f32x4 (&acc)[2][2][4][2], const Unit& u, int wr, int wc, int fr, int fq) const {
        const int row0 = u.pm * BM + wr * 64 + fr, colb = u.pn * BM + wc * 32 + 8 * fq;
#pragma unroll
        for (int ai = 0; ai < 2; ++ai)
#pragma unroll
            for (int m = 0; m < 4; ++m) {
                const int r = row0 + ai * HALF + m * 16;
                float ss = 0.f;
                if (r < MTOT) {
                    const float rstd = __builtin_amdgcn_rsqf(rowss2[r] * (1.0f / 1024.0f) + EPS);
#pragma unroll
                    for (int bj = 0; bj < 2; ++bj) {
                        const int c = colb + bj * HALF;
                        const u32x4 pw = *(const u32x4*)(ple + (size_t)r * 1024 + c);
                        const f32x4 b0 = *(const f32x4*)(h2 + (size_t)r * 1024 + c), b1 = *(const f32x4*)(h2 + (size_t)r * 1024 + c + 4);
                        float pv[8];
#pragma unroll
                        for (int e = 0; e < 4; ++e) { pv[2 * e] = __uint_as_float(pw[e] << 16); pv[2 * e + 1] = __uint_as_float(pw[e] & 0xffff0000u); }
                        f32x4 v0, v1;
#pragma unroll
                        for (int e = 0; e < 4; ++e) {
                            v0[e] = b0[e] + pv[e] * __builtin_amdgcn_rcpf(1.0f + __expf(-acc[ai][bj][m][0][e] * rstd));
                            v1[e] = b1[e] + pv[4 + e] * __builtin_amdgcn_rcpf(1.0f + __expf(-acc[ai][bj][m][1][e] * rstd));
                        }
                        float* o = y + (size_t)r * 1024 + c; *(f32x4*)o = v0; *(f32x4*)(o + 4) = v1;
                        ss += (v0[0] * v0[0] + v0[1] * v0[1]) + (v0[2] * v0[2] + v0[3] * v0[3]) + (v1[0] * v1[0] + v1[1] * v1[1]) + (v1[2] * v1[2] + v1[3] * v1[3]);
                    }
                }
                ss += __shfl_xor(ss, 16); ss += __shfl_xor(ss, 32);
                if (fq == 0 && r < MTOT) atomicAdd(rowss3 + r, ss);
            }
    }
};
template <class Epi, class Sched, bool ALIGN_EPI = false, bool SP2 = false>
__device__ __forceinline__ void gemm_phase(PG8_LAS unsigned char* lds, const Gemm g, const Sched& S, const Epi& E, const int tid) {
    const int wid = __builtin_amdgcn_readfirstlane(tid >> 6), lane = tid & 63, wr = wid >> 2, wc = wid & 3, fr = lane & 15, fq = lane >> 4;
    const int K = g.K, nt = K / BK;
    unsigned voffA[2], voffB[2];
#pragma unroll
    for (int i = 0; i < 2; ++i) { int R, C; stage_rc(tid * 16 + i * 8192, R, C); const int Rb = Epi::PERM ? ((R & ~31) + perm32(R & 31)) : R;
        voffA[i] = (unsigned)(R * K + C) * 2u; voffB[i] = (unsigned)(Rb * K + C) * 2u; }
    const size_t kstep = (size_t)(BK * 2);
    const size_t hstep = (size_t)HALF * K * 2;
    const size_t tstep = 2 * hstep;
    const unsigned ldsw = (unsigned)wid * 1024u;
    const int aoff = lds_byte(wr * 64 + fr, fq * 8), boff = lds_byte(wc * 32 + fr, fq * 8);
#define PG8_SA(b, h) (((b) * 2 + (h)) * HTB)
#define PG8_SB(b, h) ((4 + (b) * 2 + (h)) * HTB)
#define PG8_STAGE(bufoff, gbase, voff) do { _Pragma("unroll") for (int _i = 0; _i < 2; ++_i) \
        __builtin_amdgcn_global_load_lds((const unsigned*)((const char*)(gbase) + (voff)[_i]), (PG8_LAS unsigned*)(lds + (bufoff) + ldsw + _i * 8192), 16, 0, 0); } while (0)
#define PG8_LDA(dst, b, h) do { _Pragma("unroll") for (int m = 0; m < 4; ++m) _Pragma("unroll") for (int k = 0; k < 2; ++k) dst[m][k] = *(const PG8_LAS bf16x8*)(lds + PG8_SA(b, h) + aoff + m * 2048 + k * 1024); } while (0)
#define PG8_LDB(dst, b, h) do { _Pragma("unroll") for (int n = 0; n < 2; ++n) _Pragma("unroll") for (int k = 0; k < 2; ++k) dst[n][k] = *(const PG8_LAS bf16x8*)(lds + PG8_SB(b, h) + boff + n * 2048 + k * 1024); } while (0)
#define PG8_MMA(ai, bj, At, Bt) do { __builtin_amdgcn_s_setprio(1); _Pragma("unroll") for (int m = 0; m < 4; ++m) _Pragma("unroll") for (int n = 0; n < 2; ++n) _Pragma("unroll") for (int k = 0; k < 2; ++k) \
        acc[ai][bj][m][n] = __builtin_amdgcn_mfma_f32_16x16x32_bf16(Bt[n][k], At[m][k], acc[ai][bj][m][n], 0, 0, 0); __builtin_amdgcn_s_setprio(0); } while (0)
#define PG8_WAIT_V(n) asm volatile("s_waitcnt vmcnt(" #n ")" ::: "memory")
#define PG8_WAIT_L(n) asm volatile("s_waitcnt lgkmcnt(" #n ")" ::: "memory")
#define PG8_BAR __builtin_amdgcn_s_barrier()
#define PG8_SCHED __builtin_amdgcn_sched_barrier(0)
    Unit cur, nxt; int ui = 0;
    if (!S.next(0, cur)) return;
    f32x4 acc[2][2][4][2];
#pragma unroll
    for (int a = 0; a < 2; ++a)
#pragma unroll
        for (int b = 0; b < 2; ++b)
#pragma unroll
            for (int m = 0; m < 4; ++m)
#pragma unroll
                for (int n = 0; n < 2; ++n) acc[a][b][m][n] = (f32x4){0.f, 0.f, 0.f, 0.f};
    bf16x8 At[4][2], B0[2][2], B1[2][2];
    const char* cA = (const char*)g.A + (size_t)cur.pm * tstep; const char* cB = (const char*)g.Bt + (size_t)cur.pn * tstep;
    S.a_ready(cur);
    if constexpr (SP2) {
        PG8_STAGE(PG8_SB(0, 0), cB, voffB); PG8_STAGE(PG8_SB(0, 1), cB + hstep, voffB); PG8_STAGE(PG8_SA(0, 0), cA, voffA); PG8_STAGE(PG8_SA(0, 1), cA + hstep, voffA);
        if (wr == 1) PG8_BAR;
        PG8_WAIT_V(2); PG8_BAR;
        PG8_STAGE(PG8_SB(1, 0), cB + kstep, voffB); PG8_STAGE(PG8_SA(1, 0), cA + kstep, voffA); PG8_STAGE(PG8_SB(1, 1), cB + hstep + kstep, voffB);
        PG8_WAIT_V(6); PG8_BAR;
    } else {
        PG8_STAGE(PG8_SB(0, 0), cB, voffB); PG8_STAGE(PG8_SA(0, 0), cA, voffA); PG8_STAGE(PG8_SB(0, 1), cB + hstep, voffB); PG8_STAGE(PG8_SA(0, 1), cA + hstep, voffA);
        if (wr == 1) PG8_BAR;
        PG8_WAIT_V(4); PG8_BAR;
        PG8_STAGE(PG8_SB(1, 0), cB + kstep, voffB); PG8_STAGE(PG8_SA(1, 0), cA + kstep, voffA); PG8_STAGE(PG8_SB(1, 1), cB + hstep + kstep, voffB);
        PG8_WAIT_V(6); PG8_BAR;
    }
    for (;;) {
        const bool has_next = S.next(ui + 1, nxt);
        const char* nA = has_next ? (const char*)g.A + (size_t)nxt.pm * tstep : cA; const char* nB = has_next ? (const char*)g.Bt + (size_t)nxt.pn * tstep : cB;
        for (int t = 0; t < nt; t += 2) {
            const bool last = (t == nt - 2);
            const char* a1 = cA + (size_t)(t + 1) * kstep;
            const char* a2 = last ? nA : cA + (size_t)(t + 2) * kstep; const char* b2 = last ? nB : cB + (size_t)(t + 2) * kstep;
            const char* a3 = a2 + kstep; const char* b3 = b2 + kstep;
            if (last && has_next) S.a_ready(nxt);
            if constexpr (SP2) {
            PG8_LDB(B0, 0, 0); PG8_LDB(B1, 0, 1); PG8_SCHED; PG8_LDA(At, 0, 0); PG8_STAGE(PG8_SA(1, 1), a1 + hstep, voffA);
            PG8_WAIT_V(8); PG8_WAIT_L(0); PG8_BAR; PG8_MMA(0, 0, At, B0); PG8_MMA(0, 1, At, B1); PG8_BAR; PG8_SCHED;
            PG8_LDA(At, 0, 1); PG8_STAGE(PG8_SB(0, 0), b2, voffB); PG8_STAGE(PG8_SB(0, 1), b2 + hstep, voffB); PG8_STAGE(PG8_SA(0, 0), a2, voffA);
            PG8_WAIT_V(8); PG8_WAIT_L(0); PG8_BAR; PG8_MMA(1, 0, At, B0); PG8_MMA(1, 1, At, B1); PG8_BAR; PG8_SCHED;
            PG8_LDB(B0, 1, 0); PG8_LDB(B1, 1, 1); PG8_SCHED; PG8_LDA(At, 1, 0); PG8_STAGE(PG8_SA(0, 1), a2 + hstep, voffA);
            PG8_WAIT_V(8); PG8_WAIT_L(0); PG8_BAR; PG8_MMA(0, 0, At, B0); PG8_MMA(0, 1, At, B1); PG8_BAR; PG8_SCHED;
            PG8_LDA(At, 1, 1); PG8_STAGE(PG8_SB(1, 0), b3, voffB); PG8_STAGE(PG8_SB(1, 1), b3 + hstep, voffB); PG8_STAGE(PG8_SA(1, 0), a3, voffA);
            PG8_WAIT_V(8); PG8_WAIT_L(0); PG8_BAR; PG8_MMA(1, 0, At, B0); PG8_MMA(1, 1, At, B1); PG8_BAR; PG8_SCHED;
            } else {
            PG8_LDB(B0, 0, 0); PG8_SCHED; PG8_LDA(At, 0, 0); PG8_STAGE(PG8_SA(1, 1), a1 + hstep, voffA);
            PG8_WAIT_L(8); PG8_BAR; PG8_WAIT_L(0); PG8_MMA(0, 0, At, B0); PG8_BAR; PG8_SCHED;
            PG8_LDB(B1, 0, 1); PG8_STAGE(PG8_SB(0, 0), b2, voffB);
            PG8_BAR; PG8_WAIT_L(0); PG8_MMA(0, 1, At, B1); PG8_BAR;
            PG8_LDA(At, 0, 1); PG8_STAGE(PG8_SA(0, 0), a2, voffA);
            PG8_BAR; PG8_WAIT_L(0); PG8_MMA(1, 0, At, B0); PG8_BAR; PG8_SCHED;
            PG8_STAGE(PG8_SB(0, 1), b2 + hstep, voffB);
            PG8_WAIT_V(6); PG8_BAR; PG8_MMA(1, 1, At, B1); PG8_BAR;
            PG8_LDB(B0, 1, 0); PG8_SCHED; PG8_LDA(At, 1, 0); PG8_STAGE(PG8_SA(0, 1), a2 + hstep, voffA);
            PG8_WAIT_L(8); PG8_BAR; PG8_WAIT_L(0); PG8_MMA(0, 0, At, B0); PG8_BAR; PG8_SCHED;
            PG8_LDB(B1, 1, 1); PG8_STAGE(PG8_SB(1, 0), b3, voffB);
            PG8_BAR; PG8_WAIT_L(0); PG8_MMA(0, 1, At, B1); PG8_BAR;
            PG8_LDA(At, 1, 1); PG8_STAGE(PG8_SA(1, 0), a3, voffA);
            PG8_BAR; PG8_WAIT_L(0); PG8_MMA(1, 0, At, B0); PG8_BAR; PG8_SCHED;
            PG8_STAGE(PG8_SB(1, 1), b3 + hstep, voffB);
            PG8_WAIT_V(6); PG8_BAR; PG8_MMA(1, 1, At, B1); PG8_BAR;
            }
        }
        if constexpr (ALIGN_EPI) { if (wr == 0) PG8_BAR; }
        if constexpr (!Epi::AFTER_DRAIN) { E(acc, cur, wr, wc, fr, fq); S.done(cur); }
        if (!has_next) break;
#pragma unroll
        for (int a = 0; a < 2; ++a)
#pragma unroll
            for (int b = 0; b < 2; ++b)
#pragma unroll
                for (int m = 0; m < 4; ++m)
#pragma unroll
                    for (int n = 0; n < 2; ++n) acc[a][b][m][n] = (f32x4){0.f, 0.f, 0.f, 0.f};
        cur = nxt; cA = nA; cB = nB; ++ui;
        if constexpr (ALIGN_EPI) { if (wr == 1) PG8_BAR; }
    }
    PG8_WAIT_V(0);
    if constexpr (!ALIGN_EPI) { if (wr == 0) PG8_BAR; }
    PG8_BAR;
    if constexpr (Epi::AFTER_DRAIN) { E.fused(acc, cur, wr, wc, fr, fq, lds, wid, lane); S.done(cur); }
#undef PG8_SA
#undef PG8_SB
#undef PG8_STAGE
#undef PG8_LDA
#undef PG8_LDB
#undef PG8_MMA
#undef PG8_WAIT_V
#undef PG8_WAIT_L
#undef PG8_BAR
#undef PG8_SCHED
}
}


#define GAS __attribute__((address_space(1)))
#define LAS __attribute__((address_space(3)))
typedef unsigned short bf16;
typedef unsigned v4u __attribute__((ext_vector_type(4)));
typedef unsigned v2u __attribute__((ext_vector_type(2)));
typedef float f32x4 __attribute__((ext_vector_type(4)));
typedef float f32x2 __attribute__((ext_vector_type(2)));
typedef float f32x16 __attribute__((ext_vector_type(16)));
typedef short bf16x8 __attribute__((ext_vector_type(8)));
typedef short s16x4 __attribute__((ext_vector_type(4)));
typedef GAS unsigned gu32;
#define RLX_AGENT __ATOMIC_RELAXED, __HIP_MEMORY_SCOPE_AGENT
#define LDS_WAIT() asm volatile("s_waitcnt lgkmcnt(0)" ::: "memory")
#define VM_WAIT() asm volatile("s_waitcnt vmcnt(0)" ::: "memory")
__device__ __forceinline__ unsigned f2bf(float f) { unsigned u = __builtin_bit_cast(unsigned, f); return (u + 0x7fffu + ((u >> 16) & 1u)) >> 16; }
__device__ __forceinline__ unsigned pk2(float lo, float hi) { return f2bf(lo) | (f2bf(hi) << 16); }
__device__ __forceinline__ float bf2f(unsigned short h) { return __uint_as_float(((unsigned)h) << 16); }
__device__ __forceinline__ float bflo(unsigned w) { return __uint_as_float(w << 16); }
__device__ __forceinline__ float bfhi(unsigned w) { return __uint_as_float(w & 0xffff0000u); }

constexpr int NWAVES = 8;
constexpr size_t MiB = 1u << 20;
constexpr size_t WS_CTL = 0, CTL_ZERO_BYTES = 1 * MiB;
constexpr int CW_BAR = 4096;
constexpr size_t WS_ROWSS = 256 * 1024;
constexpr size_t WS_WIN = 2 * MiB;
constexpr size_t WS_WO = 8 * MiB;
constexpr size_t WS_WGU = 10 * MiB;
constexpr size_t WS_WDN = 21 * MiB;
constexpr size_t WS_WPG = 27 * MiB;
constexpr size_t WS_WPLE = 29 * MiB;
constexpr size_t WS_WC1 = 30 * MiB;
constexpr size_t WS_WC2 = 31 * MiB;
constexpr size_t WS_C1 = 31 * MiB + 65536;
constexpr size_t WS_KCP = 32 * MiB;
constexpr size_t WS_VCP = 33 * MiB;
constexpr size_t WS_KCS = 34 * MiB;
constexpr size_t WS_VCS = 38 * MiB;
constexpr size_t WS_DSC = 42 * MiB;
constexpr size_t WS_USC = 43 * MiB;
constexpr size_t WS_QB = 51 * MiB;
constexpr size_t WS_XN = 64 * MiB;
constexpr size_t WS_PPLE = 97 * MiB;
constexpr size_t WS_PROJ = 106 * MiB;
constexpr size_t WS_OWIN = 204 * MiB;
constexpr size_t WS_MIX = 221 * MiB;
constexpr size_t WS_OLOC = 254 * MiB;
constexpr size_t WS_H1 = 287 * MiB;
constexpr size_t WS_H1B = 353 * MiB;
constexpr size_t WS_ACT = 386 * MiB;
constexpr size_t WS_H2 = 476 * MiB;
constexpr size_t WS_H2B = 542 * MiB;
constexpr size_t WS_PLEB = 575 * MiB;
constexpr size_t WS_END = 608 * MiB;
constexpr int RING_BYTES = 131072;
constexpr int MISC_OFF = RING_BYTES + 320;
constexpr int LDS_BYTES = 163840;
#define XB_TMO      128
#define XB_XCNT(j)  (256  + 64 * (j))
#define XB_XSUB(j)  (1280 + 64 * (j))
#define XB_XGEN(j)  (2304 + 64 * (j))
#define XB_TOP      3328
#define XB_TOPGEN   3392
#define XCD_BAR_WORDS 3456
#define XB_SPIN_CAP (1u << 18)

__device__ __forceinline__ unsigned xb_ld(unsigned* p)              { return __hip_atomic_load(p, __ATOMIC_RELAXED, __HIP_MEMORY_SCOPE_AGENT); }
__device__ __forceinline__ unsigned xb_add(unsigned* p, unsigned v) { return __hip_atomic_fetch_add(p, v, __ATOMIC_RELAXED, __HIP_MEMORY_SCOPE_AGENT); }
__device__ __forceinline__ unsigned xb_xcc_id() { return (unsigned)__builtin_amdgcn_s_getreg((3 << 11) | 20) & 0xFu; }
#define XB_SPIN(cond, bar) do { unsigned _sp = 0; while (cond) { __builtin_amdgcn_s_sleep(1); \
    if ((++_sp & 255u) == 0u) { if (xb_ld(&(bar)[XB_TMO])) break; if (_sp > XB_SPIN_CAP) { atomicAdd(&(bar)[XB_TMO], 1u); break; } } } } while (0)

struct XcdBarrier {
    unsigned* bar; unsigned x;
    volatile LAS unsigned* st;
};

__device__ __forceinline__ XcdBarrier xcd_barrier_post(unsigned* bar, volatile LAS unsigned* st, const int tid) {
    XcdBarrier b; b.bar = bar; b.x = xb_xcc_id(); b.st = st;
    if (tid == 0) (void)xb_add(&bar[XB_XCNT(b.x)], 1u);
    return b;
}
__device__ __forceinline__ void xcd_barrier_complete(unsigned* bar, unsigned x, unsigned& nloc, unsigned& nx) {
    const unsigned G = gridDim.x * gridDim.y * gridDim.z;
    unsigned sum, cnt, mine, sp = 0u;
    for (;;) {
        sum = 0u; cnt = 0u; mine = 0u;
#pragma unroll
        for (unsigned j = 0; j < 16; ++j) { const unsigned c = xb_ld(&bar[XB_XCNT(j)]); sum += c; cnt += (c > 0u) ? 1u : 0u; mine = (j == x) ? c : mine; }
        if (sum == G) break;
        __builtin_amdgcn_s_sleep(1);
        if ((++sp & 255u) == 0u) { if (xb_ld(&bar[XB_TMO])) break; if (sp > XB_SPIN_CAP) { atomicAdd(&bar[XB_TMO], 1u); break; } }
    }
    nloc = mine > 0u ? mine : 1u; nx = cnt > 0u ? cnt : 1u;
}

__device__ __forceinline__ void xcd_barrier(const XcdBarrier& b, const int tid) {
    asm volatile("s_waitcnt vmcnt(0)" ::: "memory");
    __syncthreads();
    if (tid == 0) {
        unsigned* bar = b.bar;
        __builtin_amdgcn_s_waitcnt(0);
        unsigned nloc = b.st[0], nx = b.st[1];
        if (nloc == 0u) { xcd_barrier_complete(bar, b.x, nloc, nx); b.st[0] = nloc; b.st[1] = nx; }
        const unsigned old = xb_add(&bar[XB_XSUB(b.x)], 1u);
        const unsigned gen = old / nloc;
        if (old + 1u == (gen + 1u) * nloc) {
            __builtin_amdgcn_fence(__ATOMIC_RELEASE, "agent");
            asm volatile("s_waitcnt vmcnt(0)" ::: "memory");
            const unsigned og = xb_add(&bar[XB_TOP], 1u);
            const unsigned tg = og / nx;
            if (og + 1u == (tg + 1u) * nx) xb_add(&bar[XB_TOPGEN], 1u);
            else XB_SPIN(xb_ld(&bar[XB_TOPGEN]) == tg, bar);
            __builtin_amdgcn_fence(__ATOMIC_ACQUIRE, "agent");
            xb_add(&bar[XB_XGEN(b.x)], 1u);
            asm volatile("s_waitcnt vmcnt(0)" ::: "memory");
        } else {
            XB_SPIN(xb_ld(&bar[XB_XGEN(b.x)]) == gen, bar);
            __builtin_amdgcn_fence(__ATOMIC_ACQUIRE, "agent");
            asm volatile("s_waitcnt vmcnt(0)" ::: "memory");
        }
    }
    __syncthreads();
}

struct Args { const float* in[26]; float* out; unsigned char* ws; int ph_lo, ph_hi; };
struct Frame {
    LAS unsigned char* lds;
    int tid, lane, wave, vcu, G;
};
__device__ __forceinline__ int hw_lane() { int l; asm volatile("v_mbcnt_lo_u32_b32 %0, -1, 0\n\tv_mbcnt_hi_u32_b32 %0, -1, %0" : "=v"(l)); return l; }
__device__ __forceinline__ int opaque(int x) { asm volatile("" : "+v"(x)); return x; }
__device__ __forceinline__ float wave_sum(float v) {
#pragma unroll
    for (int o = 1; o < 64; o <<= 1) v += __shfl_xor(v, o);
    return v;
}
__device__ __forceinline__ void p0_tr_item(const float* W, int ldw, int K, int nsrc, int nblk, bf16* WT, int mode, const float* kscale, LAS float* scr, int item, int lane) {
    const int kb = item / nblk, nb = item % nblk, k0 = 64 * kb, n0 = 32 * nb;
    const int nn = n0 + (lane & 31);
#pragma unroll 8
    for (int i = 0; i < 32; ++i) { const int kk = 2 * i + (lane >> 5); float v = 0.f; if (nn < nsrc) { v = W[(size_t)(k0 + kk) * ldw + nn]; if (kscale) v *= kscale[k0 + kk]; } scr[kk * 33 + (lane & 31)] = v; }
    LDS_WAIT(); asm volatile("" ::: "memory");
    const int c = lane & 7;
#pragma unroll
    for (int j = 0; j < 4; ++j) { const int n = (lane >> 3) + 8 * j; const LAS float* s = scr + (8 * c) * 33 + n;
        v4u o; o.x = pk2(s[0 * 33], s[1 * 33]); o.y = pk2(s[2 * 33], s[3 * 33]); o.z = pk2(s[4 * 33], s[5 * 33]); o.w = pk2(s[6 * 33], s[7 * 33]);
        const int ng = n0 + n; const int drow = (mode == 0) ? ng : (256 * (ng >> 7) + (ng & 127) + (mode == 2 ? 128 : 0));
        *(GAS v4u*)(WT + (size_t)drow * K + k0 + 8 * c) = o; }
    LDS_WAIT(); asm volatile("" ::: "memory");
}
__device__ __forceinline__ void rms_row_to_bf16(const float* xrow, const float* g, bf16* orow, int lane) {
    const GAS f32x4* xr = (const GAS f32x4*)xrow + lane; const GAS f32x4* gr = (const GAS f32x4*)g + lane;
    f32x4 v[4]; float s = 0.f;
#pragma unroll
    for (int j = 0; j < 4; ++j) { v[j] = xr[64 * j]; s += (v[j].x * v[j].x + v[j].y * v[j].y) + (v[j].z * v[j].z + v[j].w * v[j].w); }
    const float rstd = 1.0f / sqrtf(wave_sum(s) * (1.f / DM) + EPS);
    GAS unsigned long long* o8 = (GAS unsigned long long*)orow + lane;
#pragma unroll
    for (int j = 0; j < 4; ++j) { const f32x4 gg = gr[64 * j];
        o8[64 * j] = (unsigned long long)pk2(v[j].x * rstd * gg.x, v[j].y * rstd * gg.y) | ((unsigned long long)pk2(v[j].z * rstd * gg.z, v[j].w * rstd * gg.w) << 32); }
}
__device__ __forceinline__ void p0_prologue(const Frame& F, const Args& A) {
    unsigned char* ws = A.ws;
    LAS float* scr = (LAS float*)(F.lds + F.wave * 16384);
    const int gw = F.vcu * NWAVES + F.wave, NGW = F.G * NWAVES, lane = F.lane;
    constexpr int I_IN = 16 * 96, I_O = 16 * 32, I_G = 16 * 88, I_D = 44 * 32, I_PG = 16 * 32, I_PL = 4 * 32, I_C1 = 128  , I_C2 = 2 * 1 * 2;
    constexpr int NITEMS = I_IN + I_O + 2 * I_G + I_D + I_PG + I_PL + I_C1 + I_C2;
    for (int it = gw; it < NITEMS; it += NGW) {
        int r = it;
        if (r < I_IN) { p0_tr_item(A.in[9], NIN, 1024, NIN, 96, (bf16*)(ws + WS_WIN), 0, nullptr, scr, r, lane); continue; } r -= I_IN;
        if (r < I_O) { p0_tr_item(A.in[16], 1024, 1024, 1024, 32, (bf16*)(ws + WS_WO), 0, nullptr, scr, r, lane); continue; } r -= I_O;
        if (r < I_G) { p0_tr_item(A.in[18], DFF, 1024, DFF, 88, (bf16*)(ws + WS_WGU), 1, A.in[17], scr, r, lane); continue; } r -= I_G;
        if (r < I_G) { p0_tr_item(A.in[19], DFF, 1024, DFF, 88, (bf16*)(ws + WS_WGU), 2, A.in[17], scr, r, lane); continue; } r -= I_G;
        if (r < I_D) { p0_tr_item(A.in[20], 1024, DFF, 1024, 32, (bf16*)(ws + WS_WDN), 0, nullptr, scr, r, lane); continue; } r -= I_D;
        if (r < I_PG) { p0_tr_item(A.in[23], 1024, 1024, 1024, 32, (bf16*)(ws + WS_WPG), 0, A.in[22], scr, r, lane); continue; } r -= I_PG;
        if (r < I_PL) { p0_tr_item(A.in[21], 1024, 256, 1024, 32, (bf16*)(ws + WS_WPLE), 0, nullptr, scr, r, lane); continue; } r -= I_PL;
        if (r < I_C1) {
#pragma unroll
            for (int q4 = 0; q4 < 4; ++q4) { const int ch = (r * 4 + q4) * 64 + lane; const int l = ch & 63, ks = (ch >> 6) & 63, ht = (ch >> 12) & 1, jj = (ch >> 13) & 1, slot = ch >> 14;
                const float* src = A.in[11] + ((size_t)slot * 2048 + jj * 1024 + 16 * ks + 8 * (l >> 5)) * 64 + 32 * ht + (l & 31);
                v4u o; o.x = pk2(src[0], src[64]); o.y = pk2(src[128], src[192]); o.z = pk2(src[256], src[320]); o.w = pk2(src[384], src[448]);
                *(GAS v4u*)((bf16*)(ws + WS_WC1) + (size_t)ch * 8) = o; }
            continue; } r -= I_C1;
        { const int slot = r / 2; p0_tr_item(A.in[12] + (size_t)slot * 64 * 64, 64, 64, 64, 2, (bf16*)(ws + WS_WC2) + (size_t)slot * 64 * 64, 0, nullptr, scr, r % 2, lane); }
    }
    if (F.vcu < 2) { const int slot = F.vcu; const float* pe = A.in[10] + slot * 2048 + F.wave * 256; const float* w1 = A.in[11] + (size_t)slot * 2048 * 64 + (size_t)F.wave * 256 * 64; float a = 0.f;
#pragma unroll 16
        for (int k = 0; k < 256; ++k) a += pe[k] * w1[k * 64 + lane];
        ((LAS float*)(F.lds + F.wave * 16384 + 12288))[lane] = a; __syncthreads();
        if (F.wave == 0) { float t = 0.f;
#pragma unroll
            for (int w = 0; w < 8; ++w) t += ((LAS float*)(F.lds + w * 16384 + 12288))[lane];
            ((float*)(ws + WS_C1))[slot * 64 + lane] = t; }
    }
    bf16* XN = (bf16*)(ws + WS_XN);
    for (int m = gw; m < MPAD; m += NGW) {
        if (m < MTOT) { const float* xr = (m < TP) ? A.in[0] + (size_t)m * DM : A.in[1] + (size_t)(m - TP) * DM; rms_row_to_bf16(xr, A.in[8], XN + (size_t)m * DM, lane); }
        else { GAS v4u* o = (GAS v4u*)(XN + (size_t)m * DM) + lane; o[0] = (v4u){0, 0, 0, 0}; o[64] = (v4u){0, 0, 0, 0}; }
    }
    bf16* PP = (bf16*)(ws + WS_PPLE);
    for (int m = gw; m < MPAD; m += NGW) {
        v2u o = (v2u){0, 0};
        if (m < MTOT) { const float* pr = (m < TP) ? A.in[6] + (size_t)m * DPLE : A.in[7] + (size_t)(m - TP) * DPLE; const f32x4 v = ((const GAS f32x4*)pr)[lane]; o.x = pk2(v.x, v.y); o.y = pk2(v.z, v.w); }
        ((GAS v2u*)(PP + (size_t)m * DPLE))[lane] = o;
        if (m >= MTOT) { GAS v4u* z = (GAS v4u*)((bf16*)(ws + WS_MIX) + (size_t)m * DM) + lane; z[0] = (v4u){0, 0, 0, 0}; z[64] = (v4u){0, 0, 0, 0}; }
    }
    for (int it = gw; it < DBATCH * 508; it += NGW) { const int b = it / 508, r = it % 508;
        ((GAS f32x4*)(A.out + O_WINS + (size_t)(b * 512 + r) * 256))[lane] = ((const GAS f32x4*)(A.in[3] + (size_t)(b * 512 + r + 4) * 256))[lane]; }
}

constexpr float LOG2E = 1.4426950408889634f;
typedef short v4i16_t __attribute__((ext_vector_type(4)));
__device__ __forceinline__ s16x4 vtr(LAS const unsigned char* p) { return __builtin_bit_cast(s16x4, __builtin_amdgcn_ds_read_tr16_b64_v4i16((LAS v4i16_t*)p)); }
__device__ __forceinline__ unsigned cvtpk(float lo, float hi) { typedef float f2 __attribute__((ext_vector_type(2))); typedef __bf16 b2 __attribute__((ext_vector_type(2))); f2 v = {lo, hi}; b2 b = __builtin_convertvector(v, b2); return __builtin_bit_cast(unsigned, b); }
__device__ __forceinline__ int t5_bucket(int n) {
    if (n < 16) return n;
    const int large = 16 + (int)(logf((float)n / 16.0f) / 2.0794415416798357f * 16.0f);
    return large < 31 ? large : 31;
}
constexpr int HI_BASE = 131072 + 512, AT_LUT = HI_BASE, HI_IMPA = AT_LUT + 4096, HI_IMPB = HI_IMPA + 2176, HI_SEL = HI_IMPB + 2176, HI_SCS = HI_SEL + 128, HI_TL = HI_SCS + 512, HI_XCH = HI_TL + 512, HI_END = HI_XCH + 8192;
constexpr int AT_K0 = 0, AT_V0 = 16384, AT_IMPA = 36864, AT_IMPB = AT_IMPA + 64 * 65 * 4 + 64, AT_SEL = AT_IMPB + 64 * 65 * 4 + 64, AT_MISC = AT_SEL + 1024, AT_QF = ((AT_MISC + 4096 + 1023) / 1024) * 1024, AT_END = AT_QF + 32768;
struct AttnLane {
    int koff;
    int kx;
    int voff0, voff1;
    int r32, h;
};
__device__ __forceinline__ AttnLane attn_lane(int lane) {
    AttnLane L; L.r32 = lane & 31; L.h = lane >> 5; L.koff = L.r32 * 128; L.kx = (L.r32 >> 1) & 7;
    const int i16 = lane & 15, q = i16 >> 2, p = i16 & 3, g1 = (lane >> 4) & 1;
    const int base = (4 * L.h + q) * 128 + g1 * 32 + (p >> 1) * 16 + (p & 1) * 8;
    L.voff0 = base + ((q >> 1) * 64); L.voff1 = base + (((q >> 1) ^ 1) * 64);
    return L;
}
__device__ __forceinline__ void attn_fill_lut(LAS float* lut, const float* rel_bias, int tid) {
    for (int e = tid; e < 1024; e += NWAVES * 64) { const int dist = e >> 3, hd = e & 7; lut[e] = rel_bias[t5_bucket(dist) * 8 + hd] * LOG2E; }
}
__device__ __forceinline__ void attn_commit(LAS unsigned char* kb, LAS unsigned char* vb, int tid, v4u k, v4u v) {
    const int row = tid >> 3, ch = tid & 7;
    *(LAS v4u*)(kb + row * 128 + ((ch ^ ((row >> 1) & 7)) << 4)) = k;
    *(LAS v4u*)(vb + row * 128 + ((ch ^ (((row >> 1) & 1) << 2)) << 4)) = v;
}
__device__ __forceinline__ f32x16 attn_qk(LAS const unsigned char* kb, int hf, const AttnLane& L, const bf16x8 (&qf)[4]) {
    f32x16 s = {};
#pragma unroll
    for (int ks = 0; ks < 4; ++ks) { const bf16x8 kf = *(LAS const bf16x8*)(kb + hf * 4096 + L.koff + (((2 * ks + L.h) ^ L.kx) << 4)); s = __builtin_amdgcn_mfma_f32_32x32x16_bf16(kf, qf[ks], s, 0, 0, 0); }
    return s;
}
__device__ __forceinline__ void attn_pv(LAS const unsigned char* vb, int hf, const AttnLane& L, const f32x16& p, f32x16 (&o)[2]) {
#pragma unroll
    for (int s = 0; s < 2; ++s) {
        v4u pw; pw.x = cvtpk(p[8 * s + 0], p[8 * s + 1]); pw.y = cvtpk(p[8 * s + 2], p[8 * s + 3]); pw.z = cvtpk(p[8 * s + 4], p[8 * s + 5]); pw.w = cvtpk(p[8 * s + 6], p[8 * s + 7]);
        const bf16x8 pb = __builtin_bit_cast(bf16x8, pw);
        const int rb = (32 * hf + 16 * s) * 128;
        { const s16x4 lo = vtr(vb + rb + L.voff0), hi = vtr(vb + rb + 1024 + L.voff0); const bf16x8 vf = {lo[0], lo[1], lo[2], lo[3], hi[0], hi[1], hi[2], hi[3]};
          o[0] = __builtin_amdgcn_mfma_f32_32x32x16_bf16(vf, pb, o[0], 0, 0, 0); }
        { const s16x4 lo = vtr(vb + rb + L.voff1), hi = vtr(vb + rb + 1024 + L.voff1); const bf16x8 vf = {lo[0], lo[1], lo[2], lo[3], hi[0], hi[1], hi[2], hi[3]};
          o[1] = __builtin_amdgcn_mfma_f32_32x32x16_bf16(vf, pb, o[1], 0, 0, 0); }
    }
}
__device__ __forceinline__ float max16(const f32x16& a) {
    float m0 = fmaxf(fmaxf(a[0], a[1]), fmaxf(a[2], a[3])), m1 = fmaxf(fmaxf(a[4], a[5]), fmaxf(a[6], a[7])), m2 = fmaxf(fmaxf(a[8], a[9]), fmaxf(a[10], a[11])), m3 = fmaxf(fmaxf(a[12], a[13]), fmaxf(a[14], a[15]));
    return fmaxf(fmaxf(m0, m1), fmaxf(m2, m3));
}
__device__ __forceinline__ float sum16(const f32x16& a) {
    return ((a[0] + a[1]) + (a[2] + a[3])) + ((a[4] + a[5]) + (a[6] + a[7])) + (((a[8] + a[9]) + (a[10] + a[11])) + ((a[12] + a[13]) + (a[14] + a[15])));
}
__device__ __forceinline__ float xmax32(float v) { const auto rr = __builtin_amdgcn_permlane32_swap(__float_as_uint(v), __float_as_uint(v), false, false); return fmaxf(__uint_as_float(rr[0]), __uint_as_float(rr[1])); }
__device__ __forceinline__ float xsum32(float v) { const auto rr = __builtin_amdgcn_permlane32_swap(__float_as_uint(v), __float_as_uint(v), false, false); return __uint_as_float(rr[0]) + __uint_as_float(rr[1]); }
__device__ __forceinline__ void attn_softmax_pv(LAS const unsigned char* vb, const AttnLane& L, f32x16& t0, f32x16& t1, float& m, float& lh, f32x16 (&o)[2]) {
    const float tm = xmax32(fmaxf(max16(t0), max16(t1)));
    if (__any(tm > m + 8.0f)) {
        const float mn = fmaxf(m, tm), mu0 = (mn == -INFINITY) ? 0.f : mn;
        const float alpha = __builtin_amdgcn_exp2f(m - mu0);
#pragma unroll
        for (int r = 0; r < 16; ++r) { o[0][r] *= alpha; o[1][r] *= alpha; }
        lh *= alpha; m = mn;
    }
    const float mu = (m == -INFINITY) ? 0.f : m;
#pragma unroll
    for (int r = 0; r < 16; ++r) { t0[r] = __builtin_amdgcn_exp2f(t0[r] - mu); t1[r] = __builtin_amdgcn_exp2f(t1[r] - mu); }
    lh += sum16(t0) + sum16(t1);
    attn_pv(vb, 0, L, t0, o); attn_pv(vb, 1, L, t1, o);
}
#define KEYIDX(hf, reg, h) (32 * (hf) + ((reg) & 3) + 8 * ((reg) >> 2) + 4 * (h))
__device__ __forceinline__ void score_far(f32x16& t0, f32x16& t1, float cb) {
#pragma unroll
    for (int r = 0; r < 16; ++r) { t0[r] = fmaf(t0[r], LOG2E, cb); t1[r] = fmaf(t1[r], LOG2E, cb); }
}
__device__ __forceinline__ void score_near1(f32x16& t, int hf, int h, LAS const float* lut, int hd, int dbase, int dstep, int dmax, int klim, bool colok) {
#pragma unroll
    for (int r = 0; r < 16; ++r) {
        const int ki = KEYIDX(hf, r, h); const int dist = dbase - dstep * ki; const int di = dist < 0 ? 0 : (dist > 127 ? 127 : dist); const float bv = lut[di * 8 + hd];
        const bool ok = colok && dist >= 0 && dist < dmax && ki < klim; const float v = fmaf(t[r], LOG2E, bv); t[r] = ok ? v : -INFINITY; }
}
__device__ __forceinline__ void score_near(f32x16& t0, f32x16& t1, int h, LAS const float* lut, int hd, int dbase, int dstep, int dmax, int klim, bool colok) {
    score_near1(t0, 0, h, lut, hd, dbase, dstep, dmax, klim, colok);
    __builtin_amdgcn_sched_barrier(0);
    score_near1(t1, 1, h, lut, hd, dbase, dstep, dmax, klim, colok);
    __builtin_amdgcn_sched_barrier(0);
}

__device__ __forceinline__ void win_unit(const Frame& F, const Args& A, LAS unsigned char* sh, int b, int g, int qb) {
    const bf16* PROJ = (const bf16*)(A.ws + WS_PROJ);
    const int lane = opaque(F.lane), w = F.wave, tid = w * 64 + lane;
    const AttnLane L = attn_lane(lane);
    const int tq = 64 * qb + 8 * w + (L.r32 >> 2), hd = g * 4 + (L.r32 & 3);
    const size_t tokq = (size_t)b * SEQ + tq;
    bf16x8 qf[4];
#pragma unroll
    for (int ks = 0; ks < 4; ++ks) qf[ks] = *(const bf16x8*)(PROJ + tokq * NPROJ + C_QN + hd * 64 + 16 * ks + 8 * L.h);
    LAS const float* lut = (LAS const float*)(sh + AT_LUT);
    const float bfar = lut[127 * 8 + hd];
    const int kt0 = qb >= 8 ? qb - 8 : 0, nt = qb - kt0 + 1;
    const int srow = tid >> 3, sch = tid & 7;
    const bf16* ksrc = PROJ + ((size_t)b * SEQ + srow) * NPROJ + C_WIN + g * 64 + sch * 8;
    v4u kr, vr;
    kr = *(const v4u*)(ksrc + (size_t)(64 * kt0) * NPROJ); vr = *(const v4u*)(ksrc + (size_t)(64 * kt0) * NPROJ + 128);
    __syncthreads();
    attn_commit(sh + AT_K0, sh + AT_V0, tid, kr, vr);
    __syncthreads();
    float m = -INFINITY, l = 0.f; f32x16 o[2]; o[0] = f32x16{}; o[1] = f32x16{};
    for (int it = 0; it < nt; ++it) {
        const int kt = kt0 + it, buf = it & 1;
        if (it + 1 < nt) { kr = *(const v4u*)(ksrc + (size_t)(64 * (kt + 1)) * NPROJ); vr = *(const v4u*)(ksrc + (size_t)(64 * (kt + 1)) * NPROJ + 128); }
        LAS const unsigned char* kb = sh + AT_K0 + buf * 8192; LAS const unsigned char* vb = sh + AT_V0 + buf * 8192;
        f32x16 t0 = attn_qk(kb, 0, L, qf), t1 = attn_qk(kb, 1, L, qf);
        if (kt <= qb - 3 && kt >= qb - 7) score_far(t0, t1, bfar);
        else score_near(t0, t1, L.h, lut, hd, tq - 64 * kt, 1, 512, 64, true);
        attn_softmax_pv(vb, L, t0, t1, m, l, o);
        if (it + 1 < nt) attn_commit(sh + AT_K0 + (buf ^ 1) * 8192, sh + AT_V0 + (buf ^ 1) * 8192, tid, kr, vr);
        __syncthreads();
    }
    const float rl = 1.0f / xsum32(l);
    bf16* dst = (bf16*)(A.ws + WS_OWIN) + tokq * 512 + hd * 64;
#pragma unroll
    for (int dt = 0; dt < 2; ++dt)
#pragma unroll
        for (int rq = 0; rq < 4; ++rq) { v2u wv; wv.x = cvtpk(o[dt][4 * rq] * rl, o[dt][4 * rq + 1] * rl); wv.y = cvtpk(o[dt][4 * rq + 2] * rl, o[dt][4 * rq + 3] * rl);
            *(v2u*)(dst + 32 * dt + 8 * rq + 4 * L.h) = wv; }
}

__device__ __forceinline__ void nsa_unit(const Frame& F, const Args& A, LAS unsigned char* sh, int b, int g, int qb) {
    const bf16* PROJ = (const bf16*)(A.ws + WS_PROJ);
    const int lane = opaque(F.lane), w = F.wave, tid = w * 64 + lane;
    const AttnLane L = attn_lane(lane);
    const int qloc = 8 * w + (L.r32 >> 2);
    const int tq = 64 * qb + qloc, hd = g * 4 + (L.r32 & 3);
    const size_t tokq = (size_t)b * SEQ + tq;
    LAS bf16x8* qlds = (LAS bf16x8*)(sh + AT_QF) + tid;
    __syncthreads();
#pragma unroll
    for (int ks = 0; ks < 4; ++ks) qlds[ks * 512] = *(const bf16x8*)(PROJ + tokq * NPROJ + C_QN + hd * 64 + 16 * ks + 8 * L.h);
#define NSA_LOADQ() bf16x8 qf[4]; _Pragma("unroll") for (int ks = 0; ks < 4; ++ks) qf[ks] = qlds[ks * 512]
    LAS const float* lut = (LAS const float*)(sh + AT_LUT);
    const float bfar = lut[127 * 8 + hd];
    LAS float* impA = (LAS float*)(sh + AT_IMPA); LAS float* impB = (LAS float*)(sh + AT_IMPB);
    LAS unsigned long long* selm = (LAS unsigned long long*)(sh + AT_SEL);
    const int srow = tid >> 3, sch = tid & 7;
    v4u kr, vr;
    const int nct = (4 * qb + 3 + 63) >> 6;
    const bf16* kcs = (const bf16*)(A.ws + WS_KCP) + ((size_t)(b * 256 + srow) * 2 + g) * 64 + sch * 8;
    const bf16* vcs = (const bf16*)(A.ws + WS_VCP) + ((size_t)(b * 256 + srow) * 2 + g) * 64 + sch * 8;
    __syncthreads();
    for (int e = tid; e < 64 * 65; e += NWAVES * 64) { impA[e] = 0.f; impB[e] = 0.f; }
    float mc = -INFINITY, lc = 0.f;
    f32x16 oc[2]; oc[0] = f32x16{}; oc[1] = f32x16{};
#pragma unroll 1
    for (int pass = 0; pass < 2; ++pass) {
        kr = *(const v4u*)(kcs); vr = *(const v4u*)(vcs);
        __syncthreads();
        attn_commit(sh + AT_K0, sh + AT_V0, tid, kr, vr);
        __syncthreads();
        const float mu = (mc == -INFINITY) ? 0.f : mc, il = lc > 0.f ? 1.0f / lc : 0.f;
#pragma unroll 1
        for (int ct = 0; ct < nct; ++ct) {
            const int buf = ct & 1;
            if (ct + 1 < nct) { kr = *(const v4u*)(kcs + (size_t)(64 * (ct + 1)) * 128); vr = *(const v4u*)(vcs + (size_t)(64 * (ct + 1)) * 128); }
            LAS const unsigned char* kb = sh + AT_K0 + buf * 8192; LAS const unsigned char* vb = sh + AT_V0 + buf * 8192;
            NSA_LOADQ();
            f32x16 t0 = attn_qk(kb, 0, L, qf), t1 = attn_qk(kb, 1, L, qf);
            score_near(t0, t1, L.h, lut, hd, tq - 31 - 1024 * ct, 16, 1 << 30, 255 - 64 * ct, true);
            if (pass == 0) {
                const float tm = xmax32(fmaxf(max16(t0), max16(t1)));
                const float mn = fmaxf(mc, tm), mu0 = (mn == -INFINITY) ? 0.f : mn;
                const float alpha = __builtin_amdgcn_exp2f(mc - mu0);
                float ps = 0.f;
#pragma unroll
                for (int r = 0; r < 16; ++r) ps += __builtin_amdgcn_exp2f(t0[r] - mu0) + __builtin_amdgcn_exp2f(t1[r] - mu0);
                ps = xsum32(ps);
                lc = lc * alpha + ps; mc = mn;
            } else {
#pragma unroll
                for (int r = 0; r < 16; ++r) { t0[r] = __builtin_amdgcn_exp2f(t0[r] - mu) * il; t1[r] = __builtin_amdgcn_exp2f(t1[r] - mu) * il; }
                attn_pv(vb, 0, L, t0, oc); attn_pv(vb, 1, L, t1, oc);
#pragma unroll
                for (int hf = 0; hf < 2; ++hf) {
                    float x[16];
#pragma unroll
                    for (int r = 0; r < 16; ++r) { float v = hf ? t1[r] : t0[r]; v += __shfl_xor(v, 1); v += __shfl_xor(v, 2); x[r] = v; }
                    if ((L.r32 & 3) == 0) {
#pragma unroll
                        for (int rq = 0; rq < 4; ++rq) { const int jq = 16 * ct + 8 * hf + 2 * rq + L.h;
                            impA[qloc * 65 + jq] = 2.0f * (x[4 * rq] + x[4 * rq + 1] + x[4 * rq + 2]) + x[4 * rq + 3];
                            impB[qloc * 65 + jq + 1] = x[4 * rq + 3]; }
                    }
                }
            }
            if (ct + 1 < nct) attn_commit(sh + AT_K0 + (buf ^ 1) * 8192, sh + AT_V0 + (buf ^ 1) * 8192, tid, kr, vr);
            __syncthreads();
        }
    }
#pragma unroll 1
    for (int qi = 0; qi < 8; ++qi) {
        const int q = 8 * w + qi;
        unsigned long long mk;
        if (qb < 16) mk = (2ull << qb) - 1ull;
        else {
            const bool forced = (lane == 0) || (lane == qb) || (lane == qb - 1);
            const float sc = forced ? 1e9f : (lane <= qb ? impA[q * 65 + lane] + impB[q * 65 + lane] : -1.0f);
            int rank = 0;
#pragma unroll 8
            for (int jj = 0; jj < 64; ++jj) { const float ov = __uint_as_float(__builtin_amdgcn_readlane(__float_as_uint(sc), jj)); rank += ((ov > sc) || (ov == sc && jj < lane)) ? 1 : 0; }
            mk = __ballot(rank < 16 && lane <= qb);
        }
        if (lane == 0) selm[q] = mk;
    }
    __syncthreads();
    const unsigned long long mysel = selm[qloc];
    unsigned long long um = 0ull;
#pragma unroll 8
    for (int q_ = 0; q_ < 64; ++q_) um |= selm[q_];
    um = ((unsigned long long)__builtin_amdgcn_readfirstlane((unsigned)(um >> 32)) << 32) | (unsigned long long)__builtin_amdgcn_readfirstlane((unsigned)um);
    const bf16* ksrc = PROJ + ((size_t)b * SEQ + srow) * NPROJ + C_KV + 2 * 128 + g * 64 + sch * 8;
    float m = -INFINITY, l = 0.f; f32x16 o[2]; o[0] = f32x16{}; o[1] = f32x16{};
    int j = __builtin_ctzll(um); um &= um - 1;
    kr = *(const v4u*)(ksrc + (size_t)(64 * j) * NPROJ); vr = *(const v4u*)(ksrc + (size_t)(64 * j) * NPROJ + 128);
    attn_commit(sh + AT_K0, sh + AT_V0, tid, kr, vr);
    __syncthreads();
    int buf = 0;
#pragma unroll 1
    for (;;) {
        const int jn = um ? __builtin_ctzll(um) : -1; um &= um - 1;
        if (jn >= 0) { kr = *(const v4u*)(ksrc + (size_t)(64 * jn) * NPROJ); vr = *(const v4u*)(ksrc + (size_t)(64 * jn) * NPROJ + 128); }
        LAS const unsigned char* kb = sh + AT_K0 + buf * 8192; LAS const unsigned char* vb = sh + AT_V0 + buf * 8192;
        const bool selj = (mysel >> j) & 1ull;
        if (__any(selj)) {
            NSA_LOADQ();
            f32x16 t0 = attn_qk(kb, 0, L, qf), t1 = attn_qk(kb, 1, L, qf);
            if (j <= qb - 3) score_far(t0, t1, selj ? bfar : -INFINITY);
            else score_near(t0, t1, L.h, lut, hd, tq - 64 * j, 1, 1 << 30, 64, selj);
            attn_softmax_pv(vb, L, t0, t1, m, l, o);
        }
        if (jn >= 0) attn_commit(sh + AT_K0 + (buf ^ 1) * 8192, sh + AT_V0 + (buf ^ 1) * 8192, tid, kr, vr);
        __syncthreads();
        if (jn < 0) break;
        j = jn; buf ^= 1;
    }
    const bf16* gp = PROJ + tokq * NPROJ + C_GT + hd;
    const float g0 = 1.0f / (1.0f + __expf(-bf2f(gp[0]))), g1 = 1.0f / (1.0f + __expf(-bf2f(gp[8]))), g2 = 1.0f / (1.0f + __expf(-bf2f(gp[16])));
    const float rl = g1 / xsum32(l);
    const bf16* ow = (const bf16*)(A.ws + WS_OWIN) + tokq * 512 + hd * 64;
    bf16* dst = (bf16*)(A.ws + WS_MIX) + tokq * 1024 + hd * 64;
#pragma unroll
    for (int dt = 0; dt < 2; ++dt)
#pragma unroll
        for (int rq = 0; rq < 4; ++rq) { const int d0 = 32 * dt + 8 * rq + 4 * L.h; const v2u wv = *(const v2u*)(ow + d0);
            const float a0 = g0 * oc[dt][4 * rq] + rl * o[dt][4 * rq] + g2 * bflo(wv.x), a1 = g0 * oc[dt][4 * rq + 1] + rl * o[dt][4 * rq + 1] + g2 * bfhi(wv.x);
            const float a2 = g0 * oc[dt][4 * rq + 2] + rl * o[dt][4 * rq + 2] + g2 * bflo(wv.y), a3 = g0 * oc[dt][4 * rq + 3] + rl * o[dt][4 * rq + 3] + g2 * bfhi(wv.y);
            v2u ov; ov.x = cvtpk(a0, a1); ov.y = cvtpk(a2, a3); *(v2u*)(dst + d0) = ov; }
}
#undef NSA_LOADQ

__device__ __forceinline__ v4u pack_f32x8(const float* p) { const f32x4 a = *(const f32x4*)p, b = *(const f32x4*)(p + 4); v4u w; w.x = pk2(a.x, a.y); w.y = pk2(a.z, a.w); w.z = pk2(b.x, b.y); w.w = pk2(b.z, b.w); return w; }
__device__ __forceinline__ void samp_load(const Args& A, int mode, int tile, int b, int g, int srow, int sch, v4u& kr, v4u& vr) {
    const bf16* PROJ = (const bf16*)(A.ws + WS_PROJ);
    kr = (v4u){0, 0, 0, 0}; vr = (v4u){0, 0, 0, 0};
    if (mode == 0) {
        const size_t off = ((size_t)(b * 512 + 64 * tile + srow) * 2 + g) * 64 + sch * 8;
        kr = *(const v4u*)((const bf16*)(A.ws + WS_KCS) + off); vr = *(const v4u*)((const bf16*)(A.ws + WS_VCS) + off);
    } else if (mode == 1) {
        if (tile < 128) { const int page = ((const int*)A.in[5])[b * 64 + (tile >> 1)]; const int row = (tile & 1) * 64 + srow;
            const float* p = A.in[2] + ((size_t)(page * 128 + row) * 4 + 2) * 128 + g * 64 + sch * 8; kr = pack_f32x8(p); vr = pack_f32x8(p + 128); }
        else if (srow < 4) { const bf16* p = PROJ + (size_t)(TP + b * 4 + srow) * NPROJ + C_KV + 2 * 128 + g * 64 + sch * 8; kr = *(const v4u*)p; vr = *(const v4u*)(p + 128); }
    } else {
        const int idx = 64 * tile + srow;
        if (idx < 512) { const float* p = A.in[3] + ((size_t)(b * 512 + idx) * 2) * 128 + g * 64 + sch * 8; kr = pack_f32x8(p); vr = pack_f32x8(p + 128); }
        else if (idx < 516) { const bf16* p = PROJ + (size_t)(TP + b * 4 + idx - 512) * NPROJ + C_WIN + g * 64 + sch * 8; kr = *(const v4u*)p; vr = *(const v4u*)(p + 128); }
    }
}
__device__ __forceinline__ void samp_stage_tile(const Args& A, int mode, int tile, int b, int g, int lane, LAS unsigned char* kb, LAS unsigned char* vb) {
#pragma unroll 1
    for (int i0 = 0; i0 < 8; i0 += 2) {
        v4u kr[2], vr[2];
#pragma unroll
        for (int i = 0; i < 2; ++i) samp_load(A, mode, tile, b, g, (lane >> 3) + 8 * (i0 + i), lane & 7, kr[i], vr[i]);
#pragma unroll
        for (int i = 0; i < 2; ++i) { const int row = (lane >> 3) + 8 * (i0 + i), ch = lane & 7;
            *(LAS v4u*)(kb + row * 128 + ((ch ^ ((row >> 1) & 7)) << 4)) = kr[i];
            *(LAS v4u*)(vb + row * 128 + ((ch ^ (((row >> 1) & 1) << 2)) << 4)) = vr[i]; }
    }
}
__device__ __forceinline__ void samp_unit(const Frame& F, const Args& A, LAS unsigned char* sh, int b, int g) {
    const bf16* PROJ = (const bf16*)(A.ws + WS_PROJ);
    const int lane = opaque(F.lane), w = F.wave, tid = w * 64 + lane;
    const AttnLane L = attn_lane(lane);
    const bool colok = L.r32 < 16;
    const int qi = (L.r32 >> 2) & 3, hd = g * 4 + (L.r32 & 3);
    const int pos = PAST + qi;
    const size_t tokq = (size_t)TP + b * 4 + qi;
    LAS unsigned char* kb = sh + w * 16384; LAS unsigned char* vb = kb + 8192;
    LAS float* lut = (LAS float*)(sh + AT_LUT);
    LAS float* impA = (LAS float*)(sh + HI_IMPA); LAS float* impB = (LAS float*)(sh + HI_IMPB);
    LAS unsigned long long* selm = (LAS unsigned long long*)(sh + HI_SEL);
    LAS float* scs = (LAS float*)(sh + HI_SCS);
    LAS int* tlist = (LAS int*)(sh + HI_TL);
    LAS float* xch = (LAS float*)(sh + HI_XCH);
    bf16x8 qf[4];
#pragma unroll
    for (int ks = 0; ks < 4; ++ks) qf[ks] = *(const bf16x8*)(PROJ + tokq * NPROJ + C_QN + hd * 64 + 16 * ks + 8 * L.h);
    const float bfar = lut[127 * 8 + hd];
    __syncthreads();
    for (int e = tid; e < 4 * 132; e += NWAVES * 64) { impA[e] = 0.f; impB[e] = 0.f; }
    f32x16 oc[2]; oc[0] = f32x16{}; oc[1] = f32x16{};
    {
        samp_stage_tile(A, 0, w, b, g, lane, kb, vb);
        f32x16 t0 = attn_qk(kb, 0, L, qf), t1 = attn_qk(kb, 1, L, qf);
        score_near(t0, t1, L.h, lut, hd, pos - 31 - 1024 * w, 16, 1 << 30, 511 - 64 * w, colok);
        const float tm = xmax32(fmaxf(max16(t0), max16(t1)));
        xch[(w * 64 + lane) * 4] = tm;
        __syncthreads();
        float M = -INFINITY;
#pragma unroll
        for (int ww = 0; ww < 8; ++ww) M = fmaxf(M, xch[(ww * 64 + lane) * 4]);
        const float mu = (M == -INFINITY) ? 0.f : M;
#pragma unroll
        for (int r = 0; r < 16; ++r) { t0[r] = __builtin_amdgcn_exp2f(t0[r] - mu); t1[r] = __builtin_amdgcn_exp2f(t1[r] - mu); }
        const float ps = xsum32(sum16(t0) + sum16(t1));
        xch[(w * 64 + lane) * 4 + 1] = ps;
        __syncthreads();
        float Lc = 0.f;
#pragma unroll
        for (int ww = 0; ww < 8; ++ww) Lc += xch[(ww * 64 + lane) * 4 + 1];
        const float il = Lc > 0.f ? 1.0f / Lc : 0.f;
#pragma unroll
        for (int r = 0; r < 16; ++r) { t0[r] *= il; t1[r] *= il; }
        attn_pv(vb, 0, L, t0, oc); attn_pv(vb, 1, L, t1, oc);
#pragma unroll
        for (int hf = 0; hf < 2; ++hf) {
            float x[16];
#pragma unroll
            for (int r = 0; r < 16; ++r) { float v = hf ? t1[r] : t0[r]; v += __shfl_xor(v, 1); v += __shfl_xor(v, 2); x[r] = v; }
            if ((L.r32 & 3) == 0 && colok) {
#pragma unroll
                for (int rq = 0; rq < 4; ++rq) { const int jq = 16 * w + 8 * hf + 2 * rq + L.h;
                    impA[qi * 132 + jq] = 2.0f * (x[4 * rq] + x[4 * rq + 1] + x[4 * rq + 2]) + x[4 * rq + 3];
                    impB[qi * 132 + jq + 1] = x[4 * rq + 3]; }
            }
        }
    }
    __syncthreads();
    if (w == 0) {
        unsigned long long ulo = 0ull, uhi = 0ull;
#pragma unroll 1
        for (int q = 0; q < 4; ++q) {
            const int j0 = lane, j1 = lane + 64;
            const float s0 = (j0 == 0) ? 1e9f : impA[q * 132 + j0] + impB[q * 132 + j0];
            const float s1 = (j1 == 127) ? 1e9f : impA[q * 132 + j1] + impB[q * 132 + j1];
            scs[j0] = s0; scs[j1] = s1;
            LDS_WAIT(); asm volatile("" ::: "memory");
            int r0 = 0, r1 = 0;
#pragma unroll 8
            for (int jj = 0; jj < 128; ++jj) { const float ov = scs[jj]; r0 += ((ov > s0) || (ov == s0 && jj < j0)) ? 1 : 0; r1 += ((ov > s1) || (ov == s1 && jj < j1)) ? 1 : 0; }
            const unsigned long long mlo = __ballot(r0 < 15), mhi = __ballot(r1 < 15);
            if (lane == 0) { selm[2 * q] = mlo; selm[2 * q + 1] = mhi; }
            ulo |= mlo; uhi |= mhi;
            LDS_WAIT(); asm volatile("" ::: "memory");
        }
        if (lane == 0) { int n = 0; for (int j = 0; j < 64; ++j) if ((ulo >> j) & 1ull) tlist[1 + n++] = j; for (int j = 0; j < 64; ++j) if ((uhi >> j) & 1ull) tlist[1 + n++] = 64 + j; tlist[1 + n++] = 128; tlist[0] = n; }
    }
    __syncthreads();
    const unsigned long long mylo = selm[2 * qi], myhi = selm[2 * qi + 1];
    const int nsel = tlist[0];
    const bf16* gp = PROJ + tokq * NPROJ + C_GT + hd;
    const float g0 = 1.0f / (1.0f + __expf(-bf2f(gp[0]))), g1 = 1.0f / (1.0f + __expf(-bf2f(gp[8]))), g2 = 1.0f / (1.0f + __expf(-bf2f(gp[16])));
#pragma unroll
    for (int r = 0; r < 16; ++r) { oc[0][r] *= g0; oc[1][r] *= g0; }
#pragma unroll 1
    for (int br = 0; br < 2; ++br) {
        const int nt = br == 0 ? nsel : 9;
        float m = -INFINITY, l = 0.f; f32x16 o[2]; o[0] = f32x16{}; o[1] = f32x16{};
#pragma unroll 1
        for (int it = w; it < nt; it += 8) {
            const int j = br == 0 ? tlist[1 + it] : it;
            samp_stage_tile(A, 1 + br, j, b, g, lane, kb, vb);
            f32x16 t0 = attn_qk(kb, 0, L, qf), t1 = attn_qk(kb, 1, L, qf);
            if (br == 0) {
                const bool selj = colok && (j >= 128 ? true : (j < 64 ? ((mylo >> j) & 1ull) : ((myhi >> (j - 64)) & 1ull)));
                if (j <= 125) score_far(t0, t1, selj ? bfar : -INFINITY);
                else score_near(t0, t1, L.h, lut, hd, pos - 64 * j, 1, 1 << 30, 64, selj);
            } else score_near(t0, t1, L.h, lut, hd, pos - (PAST - 512 + 64 * j), 1, 512, 516 - 64 * j, colok);
            attn_softmax_pv(vb, L, t0, t1, m, l, o);
        }
        l = xsum32(l);
        xch[(w * 64 + lane) * 4 + 2] = m; xch[(w * 64 + lane) * 4 + 3] = l;
        __syncthreads();
        float M = -INFINITY;
#pragma unroll
        for (int ww = 0; ww < 8; ++ww) M = fmaxf(M, xch[(ww * 64 + lane) * 4 + 2]);
        float Lt = 0.f;
#pragma unroll
        for (int ww = 0; ww < 8; ++ww) { const float mw = xch[(ww * 64 + lane) * 4 + 2]; Lt += (mw == -INFINITY) ? 0.f : xch[(ww * 64 + lane) * 4 + 3] * __builtin_amdgcn_exp2f(mw - M); }
        const float sc = (m == -INFINITY || !(Lt > 0.f)) ? 0.f : (br == 0 ? g1 : g2) * __builtin_amdgcn_exp2f(m - M) / Lt;
#pragma unroll
        for (int r = 0; r < 16; ++r) { oc[0][r] += sc * o[0][r]; oc[1][r] += sc * o[1][r]; }
        __syncthreads();
    }
    { LAS float* part = (LAS float*)kb;
#pragma unroll
      for (int r = 0; r < 16; ++r) { part[r * 64 + lane] = oc[0][r]; part[(16 + r) * 64 + lane] = oc[1][r]; } }
    __syncthreads();
    if (w == 0 && colok) {
        float res[32];
#pragma unroll
        for (int r = 0; r < 32; ++r) { float a = 0.f;
#pragma unroll
            for (int ww = 0; ww < 8; ++ww) a += ((LAS const float*)(sh + ww * 16384))[r * 64 + lane];
            res[r] = a; }
        bf16* dst = (bf16*)(A.ws + WS_MIX) + tokq * 1024 + hd * 64;
#pragma unroll
        for (int dt = 0; dt < 2; ++dt)
#pragma unroll
            for (int rq = 0; rq < 4; ++rq) { const int d0 = 32 * dt + 8 * rq + 4 * L.h;
                v2u ov; ov.x = cvtpk(res[16 * dt + 4 * rq], res[16 * dt + 4 * rq + 1]); ov.y = cvtpk(res[16 * dt + 4 * rq + 2], res[16 * dt + 4 * rq + 3]); *(v2u*)(dst + d0) = ov; }
    }
}

__device__ __forceinline__ float gelu_tanh(float x) { const float u = 0.7978845608028654f * (x + 0.044715f * x * x * x); const float t = 1.0f - 2.0f / (1.0f + __expf(2.0f * u)); return 0.5f * x * (1.0f + t); }
constexpr int CM_X = 0, CM_SB = 2064  , CM_H = 32 * CM_SB + 1024, CM_HCOL = 272  , CM_HT = 32 * CM_HCOL, CM_END = CM_H + 4 * CM_HT;
constexpr int NCU_P = 4 * 2 * 2 * 9, NCU_S = 32 * 2 * 2 * 17;
__device__ __forceinline__ int cmp_decode(int u) { if (u < NCU_S) return (1 << 20) | ((u / 68) << 12) | (((u / 34) & 1) << 9) | (((u / 17) & 1) << 8) | (u % 17); const int j = u - NCU_S; return ((j / 36) << 12) | (((j / 18) & 1) << 9) | (((j / 9) & 1) << 8) | (j % 9); }
#define CU_SAMPLE(c) ((c) >> 20)
#define CU_B(c) (((c) >> 12) & 255)
#define CU_SLOT(c) (((c) >> 9) & 1)
#define CU_G(c) (((c) >> 8) & 1)
#define CU_GRP(c) ((c) & 255)
__device__ __forceinline__ void cmp_issue(const Args& A, const int c, int tid, v4u (&R)[16]) {
    if (CU_SAMPLE(c)) {
        const float* cache = A.in[2]; const int* pt = (const int*)A.in[5] + CU_B(c) * 64;
#pragma unroll
        for (int i = 0; i < 16; ++i) { const int q = tid + 512 * i, row = q >> 4, pc = q & 15; int p = 16 * 31 * CU_GRP(c) + row; p = p < PAST ? p : PAST - 1;
            const int page = pt[p >> 7];
            R[i] = *(const v4u*)(cache + ((size_t)(page * 128 + (p & 127)) * 4 + CU_SLOT(c)) * 128 + CU_G(c) * 64 + pc * 4); }
    } else {
        const bf16* PROJ = (const bf16*)(A.ws + WS_PROJ);
#pragma unroll
        for (int i = 0; i < 8; ++i) { const int q = tid + 512 * i, row = q >> 3, pc = q & 7; int p = 16 * 31 * CU_GRP(c) + row; p = p < SEQ ? p : SEQ - 1;
            R[i] = *(const v4u*)(PROJ + ((size_t)CU_B(c) * SEQ + p) * NPROJ + C_KV + CU_SLOT(c) * 128 + CU_G(c) * 64 + pc * 8); }
#pragma unroll
        for (int i = 8; i < 16; ++i) R[i] = (v4u){0u, 0u, 0u, 0u};
    }
}
__device__ __forceinline__ void cmp_commit(LAS unsigned char* sh, const int c, int tid, const v4u (&R)[16]) {
    if (CU_SAMPLE(c)) {
#pragma unroll
        for (int i = 0; i < 16; ++i) { const int q = tid + 512 * i, row = q >> 4, pc = q & 15;
            v2u w; w.x = pk2(__uint_as_float(R[i].x), __uint_as_float(R[i].y)); w.y = pk2(__uint_as_float(R[i].z), __uint_as_float(R[i].w));
            *(LAS v2u*)(sh + CM_X + (row >> 4) * CM_SB + (row & 15) * 128 + pc * 8) = w; }
    } else {
#pragma unroll
        for (int i = 0; i < 8; ++i) { const int q = tid + 512 * i, row = q >> 3, pc = q & 7; *(LAS v4u*)(sh + CM_X + (row >> 4) * CM_SB + (row & 15) * 128 + pc * 16) = R[i]; }
    }
}
__device__ __forceinline__ void cmp_phase(const Frame& F, const Args& A, LAS unsigned char* sh) {
    const int lane = opaque(F.lane), w = F.wave, tid = w * 64 + lane, r32 = lane & 31, h = lane >> 5;
    const int j = w & 1, ht = (w >> 1) & 1, kh = w >> 2;
    v4u R[16];
    int u = F.vcu;
    if (u >= NCU_S + NCU_P) return;
    int cu = cmp_decode(u);
    cmp_issue(A, cu, tid, R);
    for (;;) {
        __syncthreads();
        cmp_commit(sh, cu, tid, R);
        __syncthreads();
        const int cur = cu;
        const int un = u + F.G; const bool more = un < NCU_S + NCU_P;
        cu = cmp_decode(more ? un : u); cmp_issue(A, cu, tid, R);
        { const bf16* wf = (const bf16*)(A.ws + WS_WC1) + ((size_t)(((CU_SLOT(cur) * 2 + j) * 2 + ht) * 64 + 32 * kh) * 64 + lane) * 8;
          LAS const unsigned char* xb = sh + CM_X + r32 * CM_SB + h * 16;
          f32x16 acc = {};
#pragma unroll 8
          for (int k2 = 0; k2 < 32; ++k2) { const int ks = 32 * kh + k2; const bf16x8 af = *(const bf16x8*)(wf + (size_t)k2 * 512);
              const bf16x8 bf = *(LAS const bf16x8*)(xb + (ks >> 2) * 128 + (ks & 3) * 32);
              acc = __builtin_amdgcn_mfma_f32_32x32x16_bf16(af, bf, acc, 0, 0, 0); }
          LAS unsigned char* hb = sh + CM_H + (j * 2 + kh) * CM_HT + r32 * CM_HCOL + (32 * ht + 4 * h) * 4;
#pragma unroll
          for (int rq = 0; rq < 4; ++rq) *(LAS f32x4*)(hb + 32 * rq) = (f32x4){acc[4 * rq], acc[4 * rq + 1], acc[4 * rq + 2], acc[4 * rq + 3]}; }
        __syncthreads();
        if (w < 2) {
            const float* c1p = (const float*)(A.ws + WS_C1) + CU_SLOT(cur) * 64;
            const bf16* W2 = (const bf16*)(A.ws + WS_WC2) + (size_t)CU_SLOT(cur) * 64 * 64;
            const int i1 = r32 < 31 ? r32 + 1 : 31;
            f32x16 oo = {};
#pragma unroll
            for (int ks = 0; ks < 4; ++ks) {
                const int hid0 = 16 * ks + 8 * h; float xv[8];
#pragma unroll
                for (int e4 = 0; e4 < 2; ++e4) {
                    const f32x4 a0 = *(LAS const f32x4*)(sh + CM_H + 0 * CM_HT + r32 * CM_HCOL + (hid0 + 4 * e4) * 4), a1 = *(LAS const f32x4*)(sh + CM_H + 1 * CM_HT + r32 * CM_HCOL + (hid0 + 4 * e4) * 4);
                    const f32x4 b0 = *(LAS const f32x4*)(sh + CM_H + 2 * CM_HT + i1 * CM_HCOL + (hid0 + 4 * e4) * 4), b1 = *(LAS const f32x4*)(sh + CM_H + 3 * CM_HT + i1 * CM_HCOL + (hid0 + 4 * e4) * 4);
                    const f32x4 cc = *(const f32x4*)(c1p + hid0 + 4 * e4);
#pragma unroll
                    for (int e = 0; e < 4; ++e) xv[4 * e4 + e] = gelu_tanh((a0[e] + a1[e]) + (b0[e] + b1[e]) + cc[e]);
                }
                v4u pw; pw.x = cvtpk(xv[0], xv[1]); pw.y = cvtpk(xv[2], xv[3]); pw.z = cvtpk(xv[4], xv[5]); pw.w = cvtpk(xv[6], xv[7]);
                const bf16x8 af = *(const bf16x8*)(W2 + (size_t)(32 * w + r32) * 64 + hid0);
                oo = __builtin_amdgcn_mfma_f32_32x32x16_bf16(af, __builtin_bit_cast(bf16x8, pw), oo, 0, 0, 0);
            }
            const int nsb = CU_SAMPLE(cur) ? 512 : 256, sb = 31 * CU_GRP(cur) + r32;
            if (r32 < 31 && sb < nsb - 1) {
                bf16* dst = (bf16*)(A.ws + (CU_SAMPLE(cur) ? (CU_SLOT(cur) ? WS_VCS : WS_KCS) : (CU_SLOT(cur) ? WS_VCP : WS_KCP))) + ((size_t)(CU_B(cur) * nsb + sb) * 2 + CU_G(cur)) * 64 + 32 * w + 4 * h;
#pragma unroll
                for (int rq = 0; rq < 4; ++rq) { v2u wv; wv.x = cvtpk(oo[4 * rq], oo[4 * rq + 1]); wv.y = cvtpk(oo[4 * rq + 2], oo[4 * rq + 3]); *(v2u*)(dst + 8 * rq) = wv; }
            }
        }
        if (!more) break;
        u = un;
    }
}

__device__ __forceinline__ float log_sigmoid(float x) { return fminf(x, 0.f) - __logf(1.0f + __expf(-fabsf(x))); }
constexpr int G_QE = 0, G_KE = 8192, G_KDT = 16384, G_V = 24576, G_ST = 40960, G_LR = 73728, G_SEG = 77824, G_DEC = 79872, G_END = 80128;
__device__ __forceinline__ int sw128(int row, int ch) { return row * 128 + ((ch ^ ((row >> 1) & 7)) << 4); }

__device__ __forceinline__ void gla_local(const Frame& F, const Args& A, LAS unsigned char* sh, int unit) {
    const int b = unit >> 6, hh = (unit >> 4) & 3, sc = unit & 15;
    const int lane = opaque(F.lane), w = F.wave, tid = w * 64 + lane, r32 = lane & 31, h = lane >> 5;
    const bf16* PROJ = (const bf16*)(A.ws + WS_PROJ);
    const size_t tok0 = (size_t)b * SEQ + 256 * sc;
    const int c = lane;
    float wg[16];
#pragma unroll
    for (int r = 0; r < 16; ++r) wg[r] = A.in[13][r * 256 + hh * 64 + c];
    const float bg = A.in[14][hh * 64 + c];
    float Bprev = 0.f;
    const int dvt = w >> 1, it = w & 1;
    f32x16 accS = {};
    const int i16 = lane & 15, tq = i16 >> 2, tp = i16 & 3, g1 = (lane >> 4) & 1;
    const int vcol = ((4 * (dvt ^ tq) + 2 * g1 + (tp >> 1)) << 4) + (tp & 1) * 8;
    __syncthreads();
#pragma unroll 1
    for (int n = 0; n < 4; ++n) {
        const size_t tb = tok0 + 64 * n;
        { const int trow = tid >> 3, pr = tid & 7; const unsigned lw = *(const unsigned*)(PROJ + (tb + trow) * NPROJ + C_LR + 2 * pr);
          LAS float* lr = (LAS float*)(sh + G_LR); lr[trow * 16 + 2 * pr] = bflo(lw); lr[trow * 16 + 2 * pr + 1] = bfhi(lw);
#pragma unroll
          for (int k2 = 0; k2 < 2; ++k2) { const int ch = pr * 2 + k2; const v4u vv = *(const v4u*)(PROJ + (tb + trow) * NPROJ + C_VG + hh * 128 + ch * 8);
              *(LAS v4u*)(sh + G_V + trow * 256 + ((ch ^ ((trow & 3) << 2)) << 4)) = vv; } }
        __syncthreads();
        float cum[8], qv[8], kv[8];
        { LAS const float* lr = (LAS const float*)(sh + G_LR); float run = 0.f;
#pragma unroll
          for (int k = 0; k < 8; ++k) { const int i = 8 * w + k; float x = bg;
#pragma unroll
              for (int r = 0; r < 16; ++r) x += lr[i * 16 + r] * wg[r];
              run += log_sigmoid(x) * (1.0f / 16.0f); cum[k] = run;
              qv[k] = 0.125f * bf2f(PROJ[(tb + i) * NPROJ + C_QG + hh * 64 + c]); kv[k] = bf2f(PROJ[(tb + i) * NPROJ + C_KG + hh * 64 + c]); }
          ((LAS float*)(sh + G_SEG))[w * 64 + c] = run; }
        __syncthreads();
        { LAS const float* seg = (LAS const float*)(sh + G_SEG); float pre = 0.f, tot = 0.f;
#pragma unroll
          for (int g_ = 0; g_ < 8; ++g_) { const float sv = seg[g_ * 64 + c]; tot += sv; if (g_ < w) pre += sv; }
          const float eB = __expf(Bprev);
          unsigned kdw[4];
#pragma unroll
          for (int k = 0; k < 8; ++k) { const int i = 8 * w + k; const float bb = pre + cum[k];
              const float qe = qv[k] * __expf(bb), ke = kv[k] * __expf(-bb), kd = kv[k] * __expf(tot - bb);
              *(LAS unsigned short*)(sh + G_QE + sw128(i, c >> 3) + (c & 7) * 2) = (unsigned short)f2bf(qe);
              *(LAS unsigned short*)(sh + G_KE + sw128(i, c >> 3) + (c & 7) * 2) = (unsigned short)f2bf(ke);
              ((bf16*)(A.ws + WS_QB))[(tb + i) * 256 + hh * 64 + c] = (bf16)f2bf(qe * eB);
              if (k & 1) kdw[k >> 1] |= f2bf(kd) << 16; else kdw[k >> 1] = f2bf(kd); }
          *(LAS v4u*)(sh + G_KDT + sw128(c, w)) = (v4u){kdw[0], kdw[1], kdw[2], kdw[3]};
          if (w == 0) ((LAS float*)(sh + G_DEC))[c] = __expf(tot);
          Bprev += tot; }
        __syncthreads();
        LAS const unsigned char* qeb = sh + G_QE; LAS const unsigned char* keb = sh + G_KE; LAS const unsigned char* vbase = sh + G_V;
        bf16x8 qfr[4];
#pragma unroll
        for (int ks = 0; ks < 4; ++ks) qfr[ks] = *(LAS const bf16x8*)(qeb + sw128(32 * it + r32, 2 * ks + h));
        f32x16 oT = {};
#pragma unroll
        for (int jt = 0; jt < 2; ++jt) {
            if (jt <= it) {
                f32x16 s = {};
#pragma unroll
                for (int ks = 0; ks < 4; ++ks) { const bf16x8 kf = *(LAS const bf16x8*)(keb + sw128(32 * jt + r32, 2 * ks + h)); s = __builtin_amdgcn_mfma_f32_32x32x16_bf16(kf, qfr[ks], s, 0, 0, 0); }
                if (jt == it) {
#pragma unroll
                    for (int r = 0; r < 16; ++r) { const int j = (r & 3) + 8 * (r >> 2) + 4 * h; if (j > r32) s[r] = 0.f; }
                }
#pragma unroll
                for (int s2 = 0; s2 < 2; ++s2) {
                    v4u pw; pw.x = cvtpk(s[8 * s2], s[8 * s2 + 1]); pw.y = cvtpk(s[8 * s2 + 2], s[8 * s2 + 3]); pw.z = cvtpk(s[8 * s2 + 4], s[8 * s2 + 5]); pw.w = cvtpk(s[8 * s2 + 6], s[8 * s2 + 7]);
                    const int row = 32 * jt + 16 * s2 + 4 * h + tq;
                    const s16x4 lo = vtr(vbase + row * 256 + vcol), hi = vtr(vbase + (row + 8) * 256 + vcol);
                    const bf16x8 vf = {lo[0], lo[1], lo[2], lo[3], hi[0], hi[1], hi[2], hi[3]};
                    oT = __builtin_amdgcn_mfma_f32_32x32x16_bf16(vf, __builtin_bit_cast(bf16x8, pw), oT, 0, 0, 0);
                }
            }
        }
        if (n > 0) {
            LAS const unsigned char* stb = sh + G_ST + (n & 1) * 16384;
#pragma unroll
            for (int ks = 0; ks < 4; ++ks) { const bf16x8 sf = *(LAS const bf16x8*)(stb + sw128(32 * dvt + r32, 2 * ks + h)); oT = __builtin_amdgcn_mfma_f32_32x32x16_bf16(sf, qfr[ks], oT, 0, 0, 0); }
        }
        { float* op = (float*)(A.ws + WS_OLOC) + (tb + 32 * it + r32) * 512 + hh * 128 + 32 * dvt + 4 * h;
#pragma unroll
          for (int rq = 0; rq < 4; ++rq) *(f32x4*)(op + 8 * rq) = (f32x4){oT[4 * rq], oT[4 * rq + 1], oT[4 * rq + 2], oT[4 * rq + 3]}; }
        { const float dec = ((LAS const float*)(sh + G_DEC))[32 * it + r32];
#pragma unroll
          for (int r = 0; r < 16; ++r) accS[r] *= dec;
#pragma unroll
          for (int ks = 0; ks < 4; ++ks) {
              const bf16x8 kdf = *(LAS const bf16x8*)(sh + G_KDT + sw128(32 * it + r32, 2 * ks + h));
              const int row = 16 * ks + 8 * h + tq;
              const s16x4 lo = vtr(vbase + row * 256 + vcol), hi = vtr(vbase + (row + 4) * 256 + vcol);
              const bf16x8 vf = {lo[0], lo[1], lo[2], lo[3], hi[0], hi[1], hi[2], hi[3]};
              accS = __builtin_amdgcn_mfma_f32_32x32x16_bf16(vf, kdf, accS, 0, 0, 0);
          }
          LAS unsigned char* stn = sh + G_ST + ((n + 1) & 1) * 16384; const int d = 32 * it + r32;
#pragma unroll
          for (int r = 0; r < 16; ++r) { const int dv = 32 * dvt + (r & 3) + 8 * (r >> 2) + 4 * h; *(LAS unsigned short*)(stn + sw128(dv, d >> 3) + (d & 7) * 2) = (unsigned short)f2bf(accS[r]); } }
        __syncthreads();
    }
    { float* up = (float*)(A.ws + WS_USC) + (size_t)unit * 8192; const int d = 32 * it + r32;
#pragma unroll
      for (int r = 0; r < 16; ++r) { const int dv = 32 * dvt + (r & 3) + 8 * (r >> 2) + 4 * h; up[dv * 64 + d] = accS[r]; }
      if (w == 0) ((float*)(A.ws + WS_DSC))[unit * 64 + c] = __expf(Bprev); }
}

__device__ __forceinline__ void gla_out(const Frame& F, const Args& A, LAS unsigned char* sh, int unit) {
    const int b = unit >> 6, hh = (unit >> 4) & 3, sc = unit & 15;
    const int lane = opaque(F.lane), w = F.wave, tid = w * 64 + lane, r32 = lane & 31, h = lane >> 5;
    const bf16* PROJ = (const bf16*)(A.ws + WS_PROJ);
    const size_t tok0 = (size_t)b * SEQ + 256 * sc;
    const int d4 = (tid & 15) * 4, dvr = tid >> 4;
    f32x4 S[4];
#pragma unroll
    for (int k = 0; k < 4; ++k) S[k] = (f32x4){0.f, 0.f, 0.f, 0.f};
    const float* U0 = (const float*)(A.ws + WS_USC) + (size_t)(unit - sc) * 8192; const float* D0 = (const float*)(A.ws + WS_DSC) + (size_t)(unit - sc) * 64;
#pragma unroll 1
    for (int s = 0; s < sc; ++s) { const f32x4 dd = *(const f32x4*)(D0 + s * 64 + d4);
#pragma unroll
        for (int k = 0; k < 4; ++k) { const f32x4 u = *(const f32x4*)(U0 + (size_t)s * 8192 + (32 * k + dvr) * 64 + d4); S[k] = S[k] * dd + u; } }
    __syncthreads();
#pragma unroll
    for (int k = 0; k < 4; ++k) { const int dv = 32 * k + dvr; v2u wv; wv.x = pk2(S[k].x, S[k].y); wv.y = pk2(S[k].z, S[k].w);
        *(LAS v2u*)(sh + sw128(dv, d4 >> 3) + (d4 & 7) * 2) = wv; }
    if (sc == 15) {
        const f32x4 dd = *(const f32x4*)(D0 + 15 * 64 + d4); float* op = A.out + O_GLAP + (size_t)(b * 4 + hh) * 8192;
#pragma unroll
        for (int k = 0; k < 4; ++k) { const int dv = 32 * k + dvr; const f32x4 u = *(const f32x4*)(U0 + (size_t)15 * 8192 + dv * 64 + d4); const f32x4 e = S[k] * dd + u;
            op[(d4 + 0) * 128 + dv] = e.x; op[(d4 + 1) * 128 + dv] = e.y; op[(d4 + 2) * 128 + dv] = e.z; op[(d4 + 3) * 128 + dv] = e.w; }
    }
    __syncthreads();
    const size_t tok = tok0 + 32 * w + r32;
    f32x16 acc[4];
#pragma unroll
    for (int t = 0; t < 4; ++t) acc[t] = f32x16{};
#pragma unroll
    for (int ks = 0; ks < 4; ++ks) { const bf16x8 qb = *(const bf16x8*)((const bf16*)(A.ws + WS_QB) + tok * 256 + hh * 64 + 16 * ks + 8 * h);
#pragma unroll
        for (int t = 0; t < 4; ++t) { const bf16x8 sf = *(LAS const bf16x8*)(sh + sw128(32 * t + r32, 2 * ks + h)); acc[t] = __builtin_amdgcn_mfma_f32_32x32x16_bf16(sf, qb, acc[t], 0, 0, 0); } }
    const float* ol = (const float*)(A.ws + WS_OLOC) + tok * 512 + hh * 128;
    float ss = 0.f;
#pragma unroll
    for (int t = 0; t < 4; ++t)
#pragma unroll
        for (int rq = 0; rq < 4; ++rq) { const f32x4 v = *(const f32x4*)(ol + 32 * t + 8 * rq + 4 * h);
#pragma unroll
            for (int e = 0; e < 4; ++e) { acc[t][4 * rq + e] += v[e]; ss += acc[t][4 * rq + e] * acc[t][4 * rq + e]; } }
    ss += __shfl_xor(ss, 32);
    const float rstd = 1.0f / sqrtf(ss * (1.0f / 128.0f) + EPS);
    const float* gn = A.in[15]; const bf16* gg = PROJ + tok * NPROJ + C_GG + hh * 128;
    bf16* dst = (bf16*)(A.ws + WS_MIX) + tok * 1024 + 512 + hh * 128;
#pragma unroll
    for (int t = 0; t < 4; ++t)
#pragma unroll
        for (int rq = 0; rq < 4; ++rq) { const int dv0 = 32 * t + 8 * rq + 4 * h; const f32x4 gnv = *(const f32x4*)(gn + dv0); const v2u gw = *(const v2u*)(gg + dv0);
            const float gv[4] = {bflo(gw.x), bfhi(gw.x), bflo(gw.y), bfhi(gw.y)}; float y[4];
#pragma unroll
            for (int e = 0; e < 4; ++e) y[e] = acc[t][4 * rq + e] * rstd * gnv[e] * gv[e] / (1.0f + __expf(-gv[e]));
            v2u ov; ov.x = cvtpk(y[0], y[1]); ov.y = cvtpk(y[2], y[3]); *(v2u*)(dst + dv0) = ov; }
}

__device__ __forceinline__ void gla_sample(const Frame& F, const Args& A, LAS unsigned char* sh, int unit) {
    const int b = unit >> 2, hh = unit & 3, tid = F.wave * 64 + opaque(F.lane);
    const bf16* PROJ = (const bf16*)(A.ws + WS_PROJ);
    LAS float* la = (LAS float*)sh;
    LAS float* qs = la + 256;
    LAS float* ks = qs + 256;
    LAS float* op = ks + 256;
    LAS float* of = op + 2048;
    __syncthreads();
    if (tid < 256) { const int t = tid >> 6, c = tid & 63; const size_t tok = (size_t)TP + b * 4 + t; float x = A.in[14][hh * 64 + c];
#pragma unroll
        for (int r = 0; r < 16; ++r) x += bf2f(PROJ[tok * NPROJ + C_LR + r]) * A.in[13][r * 256 + hh * 64 + c];
        la[tid] = __expf(log_sigmoid(x) * (1.0f / 16.0f)); qs[tid] = 0.125f * bf2f(PROJ[tok * NPROJ + C_QG + hh * 64 + c]); ks[tid] = bf2f(PROJ[tok * NPROJ + C_KG + hh * 64 + c]); }
    __syncthreads();
    const int dv = tid & 127, cg = tid >> 7;
    const float* s0 = A.in[4] + (size_t)(b * 4 + hh) * 8192;
    float S[16];
#pragma unroll
    for (int k = 0; k < 16; ++k) S[k] = s0[(16 * cg + k) * 128 + dv];
#pragma unroll
    for (int t = 0; t < 4; ++t) { const float vv = bf2f(PROJ[((size_t)TP + b * 4 + t) * NPROJ + C_VG + hh * 128 + dv]); float o = 0.f;
#pragma unroll
        for (int k = 0; k < 16; ++k) { const int c = 16 * cg + k; S[k] = la[t * 64 + c] * S[k] + ks[t * 64 + c] * vv; o += qs[t * 64 + c] * S[k]; }
        op[(cg * 4 + t) * 128 + dv] = o; }
    float* so = A.out + O_GLAS + (size_t)(b * 4 + hh) * 8192;
#pragma unroll
    for (int k = 0; k < 16; ++k) so[(16 * cg + k) * 128 + dv] = S[k];
    __syncthreads();
    { const int t = tid >> 7; of[t * 128 + dv] = (op[(0 * 4 + t) * 128 + dv] + op[(1 * 4 + t) * 128 + dv]) + (op[(2 * 4 + t) * 128 + dv] + op[(3 * 4 + t) * 128 + dv]); }
    __syncthreads();
    { const int t = tid >> 7; float ss = 0.f;
      for (int k = 0; k < 128; ++k) { const float v = of[t * 128 + k]; ss += v * v; }
      const float rstd = 1.0f / sqrtf(ss * (1.0f / 128.0f) + EPS); const size_t tok = (size_t)TP + b * 4 + t;
      const float gv = bf2f(PROJ[tok * NPROJ + C_GG + hh * 128 + dv]);
      const float y = of[t * 128 + dv] * rstd * A.in[15][dv] * gv / (1.0f + __expf(-gv));
      ((bf16*)(A.ws + WS_MIX))[tok * 1024 + 512 + hh * 128 + dv] = (bf16)f2bf(y); }
}

#ifdef PROBE_PHASE
#define PREP(k) ((PROBE_PHASE) == (k) ? 2 : 1)
#else
#define PREP(k) 1
#endif
__device__ __forceinline__ void phase2(const Frame& F, const Args& A) {
    LAS unsigned char* sh = F.lds;
#ifndef SKIP_CMP
    _Pragma("unroll 1") for (int rep = 0; rep < PREP(21); ++rep) cmp_phase(F, A, sh);
#endif
    #ifndef SKIP_GLAL
    _Pragma("unroll 1") for (int rep = 0; rep < PREP(22); ++rep) for (int u = F.vcu; u < 256; u += F.G) gla_local(F, A, sh, u);
#endif
    #ifndef SKIP_GLAS
    _Pragma("unroll 1") for (int rep = 0; rep < PREP(24); ++rep) for (int u = F.vcu; u < 128; u += F.G) gla_sample(F, A, sh, u);
#endif
    __syncthreads();
    attn_fill_lut((LAS float*)(sh + AT_LUT), A.in[24], F.tid);
    __syncthreads();
    _Pragma("unroll 1") for (int rep = 0; rep < PREP(23); ++rep) for (int p = F.vcu; p < 256; p += F.G) { const int bg = p >> 5, s = p & 31;
#ifndef SKIP_WIN
 win_unit(F, A, sh, bg >> 1, bg & 1, 63 - s); win_unit(F, A, sh, bg >> 1, bg & 1, s);
#endif
 }
}
__device__ __forceinline__ void phase3(const Frame& F, const Args& A) {
    LAS unsigned char* sh = F.lds;
    #ifndef SKIP_GLAO
    _Pragma("unroll 1") for (int rep = 0; rep < PREP(31); ++rep) for (int u = F.vcu; u < 256; u += F.G) gla_out(F, A, sh, u);
#endif
    __syncthreads();
    attn_fill_lut((LAS float*)(sh + AT_LUT), A.in[24], F.tid);
    __syncthreads();
    #ifndef SKIP_SAMP
    _Pragma("unroll 1") for (int rep = 0; rep < PREP(32); ++rep) for (int u = F.vcu; u < 64; u += F.G) samp_unit(F, A, sh, u >> 1, u & 1);
#endif
    _Pragma("unroll 1") for (int rep = 0; rep < PREP(33); ++rep) for (int p = F.vcu; p < 256; p += F.G) { const int bg = p >> 5, s = p & 31;
#ifndef SKIP_NSA
 nsa_unit(F, A, sh, bg >> 1, bg & 1, 63 - s); nsa_unit(F, A, sh, bg >> 1, bg & 1, s);
#endif
 }
}

template <class Epi>
__device__ __forceinline__ void skinny_phase(const Frame& F, const bf16* Act, int lda, const bf16* Bt, int K, int ncolgrp, const Epi& E) {
    const int lane = hw_lane(), w = F.wave, c16 = lane & 15, kg = lane >> 4;
    const int tg = w & 1, kq = w >> 1, kq_len = K / 4;
    LAS f32x4* xs = (LAS f32x4*)F.lds;
    for (int job = blockIdx.x; job < 4 * ncolgrp; job += F.G) {
        const int cg = job >> 2, tok = TP + 32 * (job & 3) + 16 * tg + c16;
        const bf16* ap = Bt + (size_t)(16 * cg + c16) * K + kq * kq_len + 8 * kg;
        const bf16* bp = Act + (size_t)tok * lda + kq * kq_len + 8 * kg;
        f32x4 acc = {0.f, 0.f, 0.f, 0.f};
#pragma unroll 8
        for (int ks = 0; ks < kq_len / 32; ++ks) { const bf16x8 af = *(const bf16x8*)(ap + 32 * ks), bf = *(const bf16x8*)(bp + 32 * ks); acc = __builtin_amdgcn_mfma_f32_16x16x32_bf16(af, bf, acc, 0, 0, 0); }
        __syncthreads();
        xs[w * 64 + lane] = acc;
        __syncthreads();
        if (kq == 0) { const f32x4 v = (xs[tg * 64 + lane] + xs[(2 + tg) * 64 + lane]) + (xs[(4 + tg) * 64 + lane] + xs[(6 + tg) * 64 + lane]); E(v, tok, 16 * cg + 4 * kg, kg); }
    }
}
struct SkInProj { bf16* proj; float* out;
    __device__ __forceinline__ void operator()(f32x4 v, int tok, int col, int kg) const {
        if (col < 512) v = v * 0.125f;
        v2u w; w.x = cvtpk(v[0], v[1]); w.y = cvtpk(v[2], v[3]); *(v2u*)(proj + (size_t)tok * NPROJ + col) = w;
        if (col >= C_KV && col < C_WIN) *(f32x4*)(out + O_KV + (size_t)tok * 512 + (col - C_KV)) = v;
        else if (col >= C_WIN && col < C_GT) { const int rs = tok - TP, b = rs >> 2, i = rs & 3; *(f32x4*)(out + O_WINS + ((size_t)(b * 512 + 508 + i) * 256 + (col - C_WIN))) = v; }
    } };
struct SkResid { const float* base; float* hout; bf16* hb; float* rowss;
    __device__ __forceinline__ void operator()(f32x4 v, int tok, int col, int kg) const {
        v = v + *(const f32x4*)(base + (size_t)(tok - TP) * 1024 + col);
        *(f32x4*)(hout + (size_t)tok * 1024 + col) = v;
        v2u w; w.x = cvtpk(v[0], v[1]); w.y = cvtpk(v[2], v[3]); *(v2u*)(hb + (size_t)tok * 1024 + col) = w;
        float ss = (v[0] * v[0] + v[1] * v[1]) + (v[2] * v[2] + v[3] * v[3]); ss += __shfl_xor(ss, 16); ss += __shfl_xor(ss, 32);
        if (kg == 0) atomicAdd(rowss + tok, ss);
    } };
struct SkBf { bf16* O; int ldc;
    __device__ __forceinline__ void operator()(f32x4 v, int tok, int col, int kg) const { v2u w; w.x = cvtpk(v[0], v[1]); w.y = cvtpk(v[2], v[3]); *(v2u*)(O + (size_t)tok * ldc + col) = w; } };
struct SkPleGate { const float* h2; const bf16* ple; const float* rowss2; float* y; float* rowss3;
    __device__ __forceinline__ void operator()(f32x4 a, int tok, int col, int kg) const {
        const float rstd = __builtin_amdgcn_rsqf(rowss2[tok] * (1.0f / 1024.0f) + EPS);
        const v2u pw = *(const v2u*)(ple + (size_t)tok * 1024 + col); const f32x4 b = *(const f32x4*)(h2 + (size_t)tok * 1024 + col);
        const float pv[4] = {bflo(pw.x), bfhi(pw.x), bflo(pw.y), bfhi(pw.y)}; f32x4 v;
#pragma unroll
        for (int e = 0; e < 4; ++e) v[e] = b[e] + pv[e] * __builtin_amdgcn_rcpf(1.0f + __expf(-a[e] * rstd));
        *(f32x4*)(y + (size_t)tok * 1024 + col) = v;
        float ss = (v[0] * v[0] + v[1] * v[1]) + (v[2] * v[2] + v[3] * v[3]); ss += __shfl_xor(ss, 16); ss += __shfl_xor(ss, 32);
        if (kg == 0) atomicAdd(rowss3 + tok, ss);
    } };

typedef const __attribute__((address_space(4))) Args* ArgsP;
__device__ __forceinline__ Args load_args() {
    Args r{};
#if defined(__HIP_DEVICE_COMPILE__)
    ArgsP p = (ArgsP)__builtin_amdgcn_kernarg_segment_ptr(); asm volatile("" : "+s"(p));
#pragma unroll
    for (int i = 0; i < 26; ++i) r.in[i] = p->in[i];
    r.out = p->out; r.ws = p->ws; r.ph_lo = p->ph_lo; r.ph_hi = p->ph_hi;
#endif
    return r;
}
__global__ void __launch_bounds__(NWAVES * 64, 2) mega_fwd(Args args_unused) {
    extern __shared__ __attribute__((aligned(16))) unsigned char lds_raw[];
    Frame F;
    F.lds = (LAS unsigned char*)lds_raw;
    F.wave = __builtin_amdgcn_readfirstlane((int)threadIdx.x >> 6); F.lane = hw_lane(); F.tid = F.wave * 64 + F.lane;
    F.G = gridDim.x; { const int bx = blockIdx.x; F.vcu = (F.G % 8 == 0) ? (bx % 8) * (F.G / 8) + bx / 8 : bx; }
    int lo, hi; unsigned char* ws;
    { const Args a0 = load_args(); lo = a0.ph_lo; hi = a0.ph_hi; ws = a0.ws; }
    gu32* ctl = (gu32*)(ws + WS_CTL);
    volatile LAS unsigned* MISC = (volatile LAS unsigned*)(F.lds + MISC_OFF);
    for (int u = F.tid; u < (LDS_BYTES - RING_BYTES) / 4; u += NWAVES * 64) ((LAS unsigned*)(F.lds + RING_BYTES))[u] = 0u;
    __syncthreads();
    const bool multi = (hi - lo) > 1;
    XcdBarrier bar; bar.bar = (unsigned*)(ctl + CW_BAR); bar.x = 0; bar.st = nullptr;
    if (multi) bar = xcd_barrier_post((unsigned*)(ctl + CW_BAR), MISC + 8, F.tid);
#define IN(k) (lo <= (k) && (k) < hi)
#ifdef PROBE_PHASE
#define NREP(k) ((PROBE_PHASE) == (k) ? 2 : 1)
#else
#define NREP(k) 1
#endif
    float* dummy_rowss = (float*)(ws + WS_END);
#define SEAM(k) do { if (IN(k) && IN((k) + 1)) { F.lane = hw_lane(); F.tid = F.wave * 64 + F.lane; xcd_barrier(bar, F.tid); } } while (0)
#define REFRESH() do { F.lane = hw_lane(); F.tid = F.wave * 64 + F.lane; } while (0)

    if (IN(0)) { REFRESH(); const Args args = load_args(); _Pragma("unroll 1") for (int rep = 0; rep < NREP(0); ++rep) { __syncthreads(); p0_prologue(F, args); } } SEAM(0);
    if (IN(1)) { REFRESH(); const Args args = load_args(); unsigned char* ws = args.ws;
        pg8::Gemm g{(const pg8::bf16_t*)(ws + WS_XN), (const pg8::bf16_t*)(ws + WS_WIN), TP, NPROJ, 1024}; pg8::StaticOrder S; S.init(TP, NPROJ, F.G, (int)blockIdx.x);
        pg8::EpiInProj E{(pg8::bf16_t*)(ws + WS_PROJ), args.out};
        _Pragma("unroll 1") for (int rep = 0; rep < NREP(1); ++rep) pg8::gemm_phase<pg8::EpiInProj, pg8::StaticOrder, true, true>(F.lds, g, S, E, F.tid);
        skinny_phase(F, (const bf16*)(ws + WS_XN), 1024, (const bf16*)(ws + WS_WIN), 1024, (NIN + 15) / 16, SkInProj{(bf16*)(ws + WS_PROJ), args.out});
    } SEAM(1);
    if (IN(2)) { REFRESH(); const Args args = load_args(); phase2(F, args); } SEAM(2);
    if (IN(3)) { REFRESH(); const Args args = load_args(); phase3(F, args); } SEAM(3);
    if (IN(4)) { REFRESH(); const Args args = load_args(); unsigned char* ws = args.ws; float* rowss1 = (float*)(ws + WS_ROWSS);
        { pg8::Gemm g{(const pg8::bf16_t*)(ws + WS_MIX), (const pg8::bf16_t*)(ws + WS_WO), TP, 1024, 1024}; pg8::StaticOrder S; S.init(TP, 1024, F.G, (int)blockIdx.x);
          _Pragma("unroll 1") for (int rep = 0; rep < NREP(4); ++rep) { pg8::EpiResid E{args.in[0], args.in[1], (float*)(ws + WS_H1), (pg8::bf16_t*)(ws + WS_H1B), rep ? dummy_rowss : rowss1};
          pg8::gemm_phase<pg8::EpiResid, pg8::StaticOrder, true, true>(F.lds, g, S, E, F.tid); } }
        { pg8::Gemm g{(const pg8::bf16_t*)(ws + WS_PPLE), (const pg8::bf16_t*)(ws + WS_WPLE), TP, 1024, 256}; pg8::StaticOrder S; S.init(TP, 1024, F.G, (int)blockIdx.x);
          pg8::EpiBf E{(pg8::bf16_t*)(ws + WS_PLEB), 1024};
          _Pragma("unroll 1") for (int rep = 0; rep < NREP(41); ++rep) pg8::gemm_phase<pg8::EpiBf, pg8::StaticOrder, true, true>(F.lds, g, S, E, F.tid); }
        skinny_phase(F, (const bf16*)(ws + WS_MIX), 1024, (const bf16*)(ws + WS_WO), 1024, 64, SkResid{args.in[1], (float*)(ws + WS_H1), (bf16*)(ws + WS_H1B), rowss1});
        skinny_phase(F, (const bf16*)(ws + WS_PPLE), 256, (const bf16*)(ws + WS_WPLE), 256, 64, SkBf{(bf16*)(ws + WS_PLEB), 1024});
    } SEAM(4);
    if (IN(5)) { REFRESH(); const Args args = load_args(); unsigned char* ws = args.ws; float* rowss1 = (float*)(ws + WS_ROWSS);
        pg8::Gemm g{(const pg8::bf16_t*)(ws + WS_H1B), (const pg8::bf16_t*)(ws + WS_WGU), MPAD, NGU, 1024}; pg8::StaticOrder S; S.init(MPAD, NGU, F.G, (int)blockIdx.x);
        pg8::EpiGateUp E{(pg8::bf16_t*)(ws + WS_ACT), rowss1};
        _Pragma("unroll 1") for (int rep = 0; rep < NREP(5); ++rep) pg8::gemm_phase<pg8::EpiGateUp, pg8::StaticOrder, true, true>(F.lds, g, S, E, F.tid);
    } SEAM(5);
    if (IN(6)) { REFRESH(); const Args args = load_args(); unsigned char* ws = args.ws; float* rowss2 = (float*)(ws + WS_ROWSS) + MPAD;
        pg8::Gemm g{(const pg8::bf16_t*)(ws + WS_ACT), (const pg8::bf16_t*)(ws + WS_WDN), TP, 1024, DFF}; pg8::StaticOrder S; S.init(TP, 1024, F.G, (int)blockIdx.x);
        _Pragma("unroll 1") for (int rep = 0; rep < NREP(6); ++rep) { pg8::EpiResid E{(const float*)(ws + WS_H1), (const float*)(ws + WS_H1) + (size_t)TP * 1024, (float*)(ws + WS_H2), (pg8::bf16_t*)(ws + WS_H2B), rep ? dummy_rowss : rowss2};
        pg8::gemm_phase<pg8::EpiResid, pg8::StaticOrder, true, true>(F.lds, g, S, E, F.tid); }
        skinny_phase(F, (const bf16*)(ws + WS_ACT), DFF, (const bf16*)(ws + WS_WDN), DFF, 64, SkResid{(const float*)(ws + WS_H1) + (size_t)TP * 1024, (float*)(ws + WS_H2), (bf16*)(ws + WS_H2B), rowss2});
    } SEAM(6);
    if (IN(7)) { REFRESH(); const Args args = load_args(); unsigned char* ws = args.ws; float* rowss2 = (float*)(ws + WS_ROWSS) + MPAD; float* rowss3 = rowss2 + MPAD;
        pg8::Gemm g{(const pg8::bf16_t*)(ws + WS_H2B), (const pg8::bf16_t*)(ws + WS_WPG), TP, 1024, 1024}; pg8::StaticOrder S; S.init(TP, 1024, F.G, (int)blockIdx.x);
        _Pragma("unroll 1") for (int rep = 0; rep < NREP(7); ++rep) { pg8::EpiPleGate E{(const float*)(ws + WS_H2), (const pg8::bf16_t*)(ws + WS_PLEB), rowss2, args.out + O_Y, rep ? dummy_rowss : rowss3};
        pg8::gemm_phase<pg8::EpiPleGate, pg8::StaticOrder, true, true>(F.lds, g, S, E, F.tid); }
        skinny_phase(F, (const bf16*)(ws + WS_H2B), 1024, (const bf16*)(ws + WS_WPG), 1024, 64, SkPleGate{(const float*)(ws + WS_H2), (const bf16*)(ws + WS_PLEB), rowss2, args.out + O_Y, rowss3});
    } SEAM(7);
    if (IN(8)) { REFRESH(); const Args args = load_args(); unsigned char* ws = args.ws; float* rowss3 = (float*)(ws + WS_ROWSS) + 2 * MPAD;
        const int gw = F.vcu * NWAVES + F.wave, NGW = F.G * NWAVES; const GAS f32x4* gr = (const GAS f32x4*)args.in[25] + F.lane;
        for (int m = gw; m < MTOT; m += NGW) { GAS f32x4* yr = (GAS f32x4*)(args.out + O_Y + (size_t)m * 1024) + F.lane; const float rstd = 1.0f / sqrtf(rowss3[m] * (1.0f / 1024.0f) + EPS);
#pragma unroll
            for (int j = 0; j < 4; ++j) { const f32x4 v = yr[64 * j], gg = gr[64 * j]; yr[64 * j] = (f32x4){v.x * rstd * gg.x, v.y * rstd * gg.y, v.z * rstd * gg.z, v.w * rstd * gg.w}; } }
    }
#undef IN
#undef SEAM
#undef REFRESH
}

extern "C" void kernel_launch(void* const* d_in, const int* in_sizes, int n_in, void* d_out, int out_size, void* d_ws, size_t ws_size, hipStream_t stream) {
    static int grid = 0;
    if (grid == 0) {
        if (n_in != 26 || (size_t)out_size != O_END || ws_size < WS_END + (1u << 20)) { fprintf(stderr, "kernel_launch: unexpected shapes: n_in %d out %d ws %zu\n", n_in, out_size, ws_size); grid = -1; return; }
        int dev = 0, cus = 0, per_cu = 0;
        if (hipGetDevice(&dev) != hipSuccess || hipDeviceGetAttribute(&cus, hipDeviceAttributeMultiprocessorCount, dev) != hipSuccess) { grid = -1; return; }
        if (hipFuncSetAttribute((const void*)mega_fwd, hipFuncAttributeMaxDynamicSharedMemorySize, LDS_BYTES) != hipSuccess) { fprintf(stderr, "kernel_launch: hipFuncSetAttribute failed\n"); grid = -1; return; }
        if (hipOccupancyMaxActiveBlocksPerMultiprocessor(&per_cu, (const void*)mega_fwd, NWAVES * 64, LDS_BYTES) != hipSuccess || per_cu < 1) { fprintf(stderr, "kernel_launch: occupancy query says %d blocks per CU\n", per_cu); grid = -1; return; }
        (void)hipGetLastError();
        grid = cus;
    }
    if (grid < 0) return;
    (void)hipMemsetAsync((char*)d_ws + WS_CTL, 0, CTL_ZERO_BYTES, stream);
    Args a{};
    for (int i = 0; i < 26; ++i) a.in[i] = (const float*)d_in[i];
    a.out = (float*)d_out; a.ws = (unsigned char*)d_ws;
#ifndef N_LAUNCH_SPLIT
    a.ph_lo = 0; a.ph_hi = 9;
    hipLaunchKernelGGL(mega_fwd, dim3(grid), dim3(NWAVES * 64), LDS_BYTES, stream, a);
#else
    for (int p = 0; p < 9; ++p) { a.ph_lo = p; a.ph_hi = p + 1; hipLaunchKernelGGL(mega_fwd, dim3(grid), dim3(NWAVES * 64), LDS_BYTES, stream, a); }
#endif
}
```

```cpp
#include <hip/hip_runtime.h>
#include <cstdio>
#include <cstdint>

constexpr int DM = 1024, TP = 16384, TS = 128, MTOT = TP + TS, MPAD = 16640, SEQ = 4096, NBATCH = 4, DBATCH = 32, DSEQ = 4, PAST = 8192;
constexpr int NPROJ = 3072, DFF = 2816, DPLE = 256, NGU = 2 * DFF;
constexpr int C_QN = 0, C_KV = 512, C_WIN = 1024, C_GT = 1280, C_QG = 1304, C_KG = 1560, C_VG = 1816, C_LR = 2328, C_GG = 2344, NIN = 2856;
constexpr float EPS = 1e-6f;
constexpr size_t O_Y = 0, O_KV = (size_t)MTOT * 1024, O_WINP = O_KV + (size_t)MTOT * 512, O_WINS = O_WINP + 4 * 512 * 256,
                 O_GLAP = O_WINS + (size_t)32 * 512 * 256, O_GLAS = O_GLAP + 4 * 4 * 64 * 128, O_END = O_GLAS + (size_t)32 * 4 * 64 * 128;
namespace pg8 {
#define PG8_LAS __attribute__((address_space(3)))
typedef unsigned short bf16_t;
typedef short bf16x8 __attribute__((ext_vector_type(8)));
typedef float f32x4 __attribute__((ext_vector_type(4)));
typedef unsigned u32x4 __attribute__((ext_vector_type(4)));
constexpr int BM = 256, BK = 64, HALF = 128, HTB = HALF * BK * 2  , STAGE_BYTES = 8 * HTB, NXCD = 8, WGM = 8;

__host__ __device__ __forceinline__ int lds_byte(int r, int c) { const int st = (r >> 4) * 2 + (c >> 5), rr = r & 15, cc = c & 31, ob = rr * 64 + cc * 2; return st * 1024 + (ob ^ (((ob >> 9) & 1) << 5)); }
__host__ __device__ __forceinline__ void stage_rc(int b, int& R, int& C) { const int st = b / 1024, sb = b % 1024, swz = sb ^ (((sb >> 9) & 1) << 5); R = (st >> 1) * 16 + swz / 64; C = (st & 1) * 32 + (swz % 64) / 2; }
__host__ __device__ __forceinline__ int perm32(int rho) { const int n = rho >> 4, i = rho & 15; return 8 * (i >> 2) + 4 * n + (i & 3); }

struct Unit { int pm, pn; };
struct Gemm { const bf16_t* A; const bf16_t* Bt; int M, N, K; };

struct StaticOrder {
    int nM, nN, nwg, G, c;
    __host__ __device__ void init(int M, int N, int G_, int c_) { nM = M / BM; nN = N / BM; nwg = nM * nN; G = G_; c = c_; }
    __host__ __device__ bool next(int i, Unit& u) const {
        const long L = (long)i * G + c; if (L >= nwg) return false;
        int wgid = (int)L; { const int q = nwg / NXCD, r = nwg % NXCD, xcd = wgid % NXCD, off = wgid / NXCD; wgid = (xcd < r ? xcd * (q + 1) : r * (q + 1) + (xcd - r) * q) + off; }
        const int nig = WGM * nN, gid = wgid / nig, fm = gid * WGM, gsz = (nM - fm) < WGM ? (nM - fm) : WGM;
        u.pm = fm + ((wgid % nig) % gsz); u.pn = (wgid % nig) / gsz; return true;
    }
    __device__ __forceinline__ void a_ready(const Unit&) const {}
    __device__ __forceinline__ void done(const Unit&) const {}
};

__device__ __forceinline__ unsigned cvt_pk_bf16(float lo, float hi) { unsigned r; asm volatile("v_cvt_pk_bf16_f32 %0, %1, %2" : "=v"(r) : "v"(lo), "v"(hi)); return r; }

__device__ __forceinline__ u32x4 pack8(const f32x4 v0, const f32x4 v1) { u32x4 w; w.x = cvt_pk_bf16(v0[0], v0[1]); w.y = cvt_pk_bf16(v0[2], v0[3]); w.z = cvt_pk_bf16(v1[0], v1[1]); w.w = cvt_pk_bf16(v1[2], v1[3]); return w; }

struct EpiInProj {
    static constexpr bool PERM = true, AFTER_DRAIN = false;
    bf16_t* proj; float* out;
    __device__ __forceinline__ void operator()(const f32x4 (&acc)[2][2][4][2], const Unit& u, int wr, int wc, int fr, int fq) const {
        const int row0 = u.pm * BM + wr * 64 + fr, colb = u.pn * BM + wc * 32 + 8 * fq;
        const float sc = (u.pn < 2) ? 0.125f : 1.0f;
#pragma unroll
        for (int ai = 0; ai < 2; ++ai)
#pragma unroll
            for (int m = 0; m < 4; ++m) {
                const int r = row0 + ai * HALF + m * 16;
                if (r < MTOT) {
#pragma unroll
                    for (int bj = 0; bj < 2; ++bj) {
                        const int c = colb + bj * HALF;
                        const f32x4 v0 = acc[ai][bj][m][0] * sc, v1 = acc[ai][bj][m][1] * sc;
                        *(u32x4*)(proj + (size_t)r * NPROJ + c) = pack8(v0, v1);
                        if (u.pn == 2 || u.pn == 3) { float* o = out + O_KV + (size_t)r * 512 + (c - C_KV); *(f32x4*)o = v0; *(f32x4*)(o + 4) = v1; }
                        if (u.pn == 4) {
                            const int cc = c - C_WIN; float* o = nullptr;
                            if (r < TP) { const int pos = r & (SEQ - 1), b = r >> 12; if (pos >= SEQ - 512) o = out + O_WINP + ((size_t)(b * 512 + pos - (SEQ - 512)) * 256 + cc); }
                            else { const int rs = r - TP, b = rs >> 2, i = rs & 3; o = out + O_WINS + ((size_t)(b * 512 + 508 + i) * 256 + cc); }
                            if (o) { *(f32x4*)o = v0; *(f32x4*)(o + 4) = v1; }
                        }
                    }
                }
            }
    }
};
struct EpiResid {
    static constexpr bool PERM = true, AFTER_DRAIN = false;
    const float* baseA; const float* baseB;
    float* hout; bf16_t* hb; float* rowss;
    __device__ __forceinline__ void operator()(const f32x4 (&acc)[2][2][4][2], const Unit& u, int wr, int wc, int fr, int fq) const {
        const int row0 = u.pm * BM + wr * 64 + fr, colb = u.pn * BM + wc * 32 + 8 * fq;
#pragma unroll
        for (int ai = 0; ai < 2; ++ai)
#pragma unroll
            for (int m = 0; m < 4; ++m) {
                const int r = row0 + ai * HALF + m * 16;
                float ss = 0.f;
                if (r < MTOT) {
                    const float* bp = (r < TP) ? baseA + (size_t)r * 1024 : baseB + (size_t)(r - TP) * 1024;
#pragma unroll
                    for (int bj = 0; bj < 2; ++bj) {
                        const int c = colb + bj * HALF;
                        const f32x4 v0 = acc[ai][bj][m][0] + *(const f32x4*)(bp + c), v1 = acc[ai][bj][m][1] + *(const f32x4*)(bp + c + 4);
                        float* o = hout + (size_t)r * 1024 + c; *(f32x4*)o = v0; *(f32x4*)(o + 4) = v1;
                        *(u32x4*)(hb + (size_t)r * 1024 + c) = pack8(v0, v1);
                        ss += (v0[0] * v0[0] + v0[1] * v0[1]) + (v0[2] * v0[2] + v0[3] * v0[3]) + (v1[0] * v1[0] + v1[1] * v1[1]) + (v1[2] * v1[2] + v1[3] * v1[3]);
                    }
                }
                ss += __shfl_xor(ss, 16); ss += __shfl_xor(ss, 32);
                if (fq == 0 && r < MTOT) atomicAdd(rowss + r, ss);
            }
    }
};
struct EpiGateUp {
    static constexpr bool PERM = true, AFTER_DRAIN = false;
    bf16_t* act; const float* rowss;
    __device__ __forceinline__ void operator()(const f32x4 (&acc)[2][2][4][2], const Unit& u, int wr, int wc, int fr, int fq) const {
        const int row0 = u.pm * BM + wr * 64 + fr, colb = u.pn * HALF + wc * 32 + 8 * fq;
#pragma unroll
        for (int ai = 0; ai < 2; ++ai)
#pragma unroll
            for (int m = 0; m < 4; ++m) {
                const int r = row0 + ai * HALF + m * 16;
                if (r < MTOT) {
                    const float rstd = __builtin_amdgcn_rsqf(rowss[r] * (1.0f / 1024.0f) + EPS);
                    f32x4 o[2];
#pragma unroll
                    for (int n = 0; n < 2; ++n)
#pragma unroll
                        for (int e = 0; e < 4; ++e) { const float g = acc[ai][0][m][n][e] * rstd, up = acc[ai][1][m][n][e] * rstd; o[n][e] = g * up * __builtin_amdgcn_rcpf(1.0f + __expf(-g)); }
                    *(u32x4*)(act + (size_t)r * DFF + colb) = pack8(o[0], o[1]);
                }
            }
    }
};
struct EpiBf {
    static constexpr bool PERM = true, AFTER_DRAIN = false;
    bf16_t* O; int ldc;
    __device__ __forceinline__ void operator()(const f32x4 (&acc)[2][2][4][2], const Unit& u, int wr, int wc, int fr, int fq) const {
        const int row0 = u.pm * BM + wr * 64 + fr, colb = u.pn * BM + wc * 32 + 8 * fq;
#pragma unroll
        for (int ai = 0; ai < 2; ++ai)
#pragma unroll
            for (int m = 0; m < 4; ++m) {
                const int r = row0 + ai * HALF + m * 16;
                if (r < MTOT) {
#pragma unroll
                    for (int bj = 0; bj < 2; ++bj) *(u32x4*)(O + (size_t)r * ldc + colb + bj * HALF) = pack8(acc[ai][bj][m][0], acc[ai][bj][m][1]);
                }
            }
    }
};
struct EpiPleGate {
    static constexpr bool PERM = true, AFTER_DRAIN = false;
    const float* h2; const bf16_t* ple; const float* rowss2; float* y; float* rowss3;
    __device__ __forceinline__ void operator()(const f32x4 (&acc)[2][2][4][2], const Unit& u, int wr, int wc, int fr, int fq) const {
        const int row0 = u.pm * BM + wr * 64 + fr, colb = u.pn * BM + wc * 32 + 8 * fq;
#pragma unroll
        for (int ai = 0; ai < 2; ++ai)
#pragma unroll
            for (int m = 0; m < 4; ++m) {
                const int r = row0 + ai * HALF + m * 16;
                float ss = 0.f;
                if (r < MTOT) {
                    const float rstd = __builtin_amdgcn_rsqf(rowss2[r] * (1.0f / 1024.0f) + EPS);
#pragma unroll
                    for (int bj = 0; bj < 2; ++bj) {
                        const int c = colb + bj * HALF;
                        const u32x4 pw = *(const u32x4*)(ple + (size_t)r * 1024 + c);
                        const f32x4 b0 = *(const f32x4*)(h2 + (size_t)r * 1024 + c), b1 = *(const f32x4*)(h2 + (size_t)r * 1024 + c + 4);
                        float pv[8];
#pragma unroll
                        for (int e = 0; e < 4; ++e) { pv[2 * e] = __uint_as_float(pw[e] << 16); pv[2 * e + 1] = __uint_as_float(pw[e] & 0xffff0000u); }
                        f32x4 v0, v1;
#pragma unroll
                        for (int e = 0; e < 4; ++e) {
                            v0[e] = b0[e] + pv[e] * __builtin_amdgcn_rcpf(1.0f + __expf(-acc[ai][bj][m][0][e] * rstd));
                            v1[e] = b1[e] + pv[4 + e] * __builtin_amdgcn_rcpf(1.0f + __expf(-acc[ai][bj][m][1][e] * rstd));
                        }
                        float* o = y + (size_t)r * 1024 + c; *(f32x4*)o = v0; *(f32x4*)(o + 4) = v1;
                        ss += (v0[0] * v0[0] + v0[1] * v0[1]) + (v0[2] * v0[2] + v0[3] * v0[3]) + (v1[0] * v1[0] + v1[1] * v1[1]) + (v1[2] * v1[2] + v1[3] * v1[3]);
                    }
                }
                ss += __shfl_xor(ss, 16); ss += __shfl_xor(ss, 32);
                if (fq == 0 && r < MTOT) atomicAdd(rowss3 + r, ss);
            }
    }
};
template <class Epi, class Sched, bool ALIGN_EPI = false, bool SP2 = false>
__device__ __forceinline__ void gemm_phase(PG8_LAS unsigned char* lds, const Gemm g, const Sched& S, const Epi& E, const int tid) {
    const int wid = __builtin_amdgcn_readfirstlane(tid >> 6), lane = tid & 63, wr = wid >> 2, wc = wid & 3, fr = lane & 15, fq = lane >> 4;
    const int K = g.K, nt = K / BK;
    unsigned voffA[2], voffB[2];
#pragma unroll
    for (int i = 0; i < 2; ++i) { int R, C; stage_rc(tid * 16 + i * 8192, R, C); const int Rb = Epi::PERM ? ((R & ~31) + perm32(R & 31)) : R;
        voffA[i] = (unsigned)(R * K + C) * 2u; voffB[i] = (unsigned)(Rb * K + C) * 2u; }
    const size_t kstep = (size_t)(BK * 2);
    const size_t hstep = (size_t)HALF * K * 2;
    const size_t tstep = 2 * hstep;
    const unsigned ldsw = (unsigned)wid * 1024u;
    const int aoff = lds_byte(wr * 64 + fr, fq * 8), boff = lds_byte(wc * 32 + fr, fq * 8);
#define PG8_SA(b, h) (((b) * 2 + (h)) * HTB)
#define PG8_SB(b, h) ((4 + (b) * 2 + (h)) * HTB)
#define PG8_STAGE(bufoff, gbase, voff) do { _Pragma("unroll") for (int _i = 0; _i < 2; ++_i) \
        __builtin_amdgcn_global_load_lds((const unsigned*)((const char*)(gbase) + (voff)[_i]), (PG8_LAS unsigned*)(lds + (bufoff) + ldsw + _i * 8192), 16, 0, 0); } while (0)
#define PG8_LDA(dst, b, h) do { _Pragma("unroll") for (int m = 0; m < 4; ++m) _Pragma("unroll") for (int k = 0; k < 2; ++k) dst[m][k] = *(const PG8_LAS bf16x8*)(lds + PG8_SA(b, h) + aoff + m * 2048 + k * 1024); } while (0)
#define PG8_LDB(dst, b, h) do { _Pragma("unroll") for (int n = 0; n < 2; ++n) _Pragma("unroll") for (int k = 0; k < 2; ++k) dst[n][k] = *(const PG8_LAS bf16x8*)(lds + PG8_SB(b, h) + boff + n * 2048 + k * 1024); } while (0)
#define PG8_MMA(ai, bj, At, Bt) do { __builtin_amdgcn_s_setprio(1); _Pragma("unroll") for (int m = 0; m < 4; ++m) _Pragma("unroll") for (int n = 0; n < 2; ++n) _Pragma("unroll") for (int k = 0; k < 2; ++k) \
        acc[ai][bj][m][n] = __builtin_amdgcn_mfma_f32_16x16x32_bf16(Bt[n][k], At[m][k], acc[ai][bj][m][n], 0, 0, 0); __builtin_amdgcn_s_setprio(0); } while (0)
#define PG8_WAIT_V(n) asm volatile("s_waitcnt vmcnt(" #n ")" ::: "memory")
#define PG8_WAIT_L(n) asm volatile("s_waitcnt lgkmcnt(" #n ")" ::: "memory")
#define PG8_BAR __builtin_amdgcn_s_barrier()
#define PG8_SCHED __builtin_amdgcn_sched_barrier(0)
    Unit cur, nxt; int ui = 0;
    if (!S.next(0, cur)) return;
    f32x4 acc[2][2][4][2];
#pragma unroll
    for (int a = 0; a < 2; ++a)
#pragma unroll
        for (int b = 0; b < 2; ++b)
#pragma unroll
            for (int m = 0; m < 4; ++m)
#pragma unroll
                for (int n = 0; n < 2; ++n) acc[a][b][m][n] = (f32x4){0.f, 0.f, 0.f, 0.f};
    bf16x8 At[4][2], B0[2][2], B1[2][2];
    const char* cA = (const char*)g.A + (size_t)cur.pm * tstep; const char* cB = (const char*)g.Bt + (size_t)cur.pn * tstep;
    S.a_ready(cur);
    if constexpr (SP2) {
        PG8_STAGE(PG8_SB(0, 0), cB, voffB); PG8_STAGE(PG8_SB(0, 1), cB + hstep, voffB); PG8_STAGE(PG8_SA(0, 0), cA, voffA); PG8_STAGE(PG8_SA(0, 1), cA + hstep, voffA);
        if (wr == 1) PG8_BAR;
        PG8_WAIT_V(2); PG8_BAR;
        PG8_STAGE(PG8_SB(1, 0), cB + kstep, voffB); PG8_STAGE(PG8_SA(1, 0), cA + kstep, voffA); PG8_STAGE(PG8_SB(1, 1), cB + hstep + kstep, voffB);
        PG8_WAIT_V(6); PG8_BAR;
    } else {
        PG8_STAGE(PG8_SB(0, 0), cB, voffB); PG8_STAGE(PG8_SA(0, 0), cA, voffA); PG8_STAGE(PG8_SB(0, 1), cB + hstep, voffB); PG8_STAGE(PG8_SA(0, 1), cA + hstep, voffA);
        if (wr == 1) PG8_BAR;
        PG8_WAIT_V(4); PG8_BAR;
        PG8_STAGE(PG8_SB(1, 0), cB + kstep, voffB); PG8_STAGE(PG8_SA(1, 0), cA + kstep, voffA); PG8_STAGE(PG8_SB(1, 1), cB + hstep + kstep, voffB);
        PG8_WAIT_V(6); PG8_BAR;
    }
    for (;;) {
        const bool has_next = S.next(ui + 1, nxt);
        const char* nA = has_next ? (const char*)g.A + (size_t)nxt.pm * tstep : cA; const char* nB = has_next ? (const char*)g.Bt + (size_t)nxt.pn * tstep : cB;
        for (int t = 0; t < nt; t += 2) {
            const bool last = (t == nt - 2);
            const char* a1 = cA + (size_t)(t + 1) * kstep;
            const char* a2 = last ? nA : cA + (size_t)(t + 2) * kstep; const char* b2 = last ? nB : cB + (size_t)(t + 2) * kstep;
            const char* a3 = a2 + kstep; const char* b3 = b2 + kstep;
            if (last && has_next) S.a_ready(nxt);
            if constexpr (SP2) {
            PG8_LDB(B0, 0, 0); PG8_LDB(B1, 0, 1); PG8_SCHED; PG8_LDA(At, 0, 0); PG8_STAGE(PG8_SA(1, 1), a1 + hstep, voffA);
            PG8_WAIT_V(8); PG8_WAIT_L(0); PG8_BAR; PG8_MMA(0, 0, At, B0); PG8_MMA(0, 1, At, B1); PG8_BAR; PG8_SCHED;
            PG8_LDA(At, 0, 1); PG8_STAGE(PG8_SB(0, 0), b2, voffB); PG8_STAGE(PG8_SB(0, 1), b2 + hstep, voffB); PG8_STAGE(PG8_SA(0, 0), a2, voffA);
            PG8_WAIT_V(8); PG8_WAIT_L(0); PG8_BAR; PG8_MMA(1, 0, At, B0); PG8_MMA(1, 1, At, B1); PG8_BAR; PG8_SCHED;
            PG8_LDB(B0, 1, 0); PG8_LDB(B1, 1, 1); PG8_SCHED; PG8_LDA(At, 1, 0); PG8_STAGE(PG8_SA(0, 1), a2 + hstep, voffA);
            PG8_WAIT_V(8); PG8_WAIT_L(0); PG8_BAR; PG8_MMA(0, 0, At, B0); PG8_MMA(0, 1, At, B1); PG8_BAR; PG8_SCHED;
            PG8_LDA(At, 1, 1); PG8_STAGE(PG8_SB(1, 0), b3, voffB); PG8_STAGE(PG8_SB(1, 1), b3 + hstep, voffB); PG8_STAGE(PG8_SA(1, 0), a3, voffA);
            PG8_WAIT_V(8); PG8_WAIT_L(0); PG8_BAR; PG8_MMA(1, 0, At, B0); PG8_MMA(1, 1, At, B1); PG8_BAR; PG8_SCHED;
            } else {
            PG8_LDB(B0, 0, 0); PG8_SCHED; PG8_LDA(At, 0, 0); PG8_STAGE(PG8_SA(1, 1), a1 + hstep, voffA);
            PG8_WAIT_L(8); PG8_BAR; PG8_WAIT_L(0); PG8_MMA(0, 0, At, B0); PG8_BAR; PG8_SCHED;
            PG8_LDB(B1, 0, 1); PG8_STAGE(PG8_SB(0, 0), b2, voffB);
            PG8_BAR; PG8_WAIT_L(0); PG8_MMA(0, 1, At, B1); PG8_BAR;
            PG8_LDA(At, 0, 1); PG8_STAGE(PG8_SA(0, 0), a2, voffA);
            PG8_BAR; PG8_WAIT_L(0); PG8_MMA(1, 0, At, B0); PG8_BAR; PG8_SCHED;
            PG8_STAGE(PG8_SB(0, 1), b2 + hstep, voffB);
            PG8_WAIT_V(6); PG8_BAR; PG8_MMA(1, 1, At, B1); PG8_BAR;
            PG8_LDB(B0, 1, 0); PG8_SCHED; PG8_LDA(At, 1, 0); PG8_STAGE(PG8_SA(0, 1), a2 + hstep, voffA);
            PG8_WAIT_L(8); PG8_BAR; PG8_WAIT_L(0); PG8_MMA(0, 0, At, B0); PG8_BAR; PG8_SCHED;
            PG8_LDB(B1, 1, 1); PG8_STAGE(PG8_SB(1, 0), b3, voffB);
            PG8_BAR; PG8_WAIT_L(0); PG8_MMA(0, 1, At, B1); PG8_BAR;
            PG8_LDA(At, 1, 1); PG8_STAGE(PG8_SA(1, 0), a3, voffA);
            PG8_BAR; PG8_WAIT_L(0); PG8_MMA(1, 0, At, B0); PG8_BAR; PG8_SCHED;
            PG8_STAGE(PG8_SB(1, 1), b3 + hstep, voffB);
            PG8_WAIT_V(6); PG8_BAR; PG8_MMA(1, 1, At, B1); PG8_BAR;
            }
        }
        if constexpr (ALIGN_EPI) { if (wr == 0) PG8_BAR; }
        if constexpr (!Epi::AFTER_DRAIN) { E(acc, cur, wr, wc, fr, fq); S.done(cur); }
        if (!has_next) break;
#pragma unroll
        for (int a = 0; a < 2; ++a)
#pragma unroll
            for (int b = 0; b < 2; ++b)
#pragma unroll
                for (int m = 0; m < 4; ++m)
#pragma unroll
                    for (int n = 0; n < 2; ++n) acc[a][b][m][n] = (f32x4){0.f, 0.f, 0.f, 0.f};
        cur = nxt; cA = nA; cB = nB; ++ui;
        if constexpr (ALIGN_EPI) { if (wr == 1) PG8_BAR; }
    }
    PG8_WAIT_V(0);
    if constexpr (!ALIGN_EPI) { if (wr == 0) PG8_BAR; }
    PG8_BAR;
    if constexpr (Epi::AFTER_DRAIN) { E.fused(acc, cur, wr, wc, fr, fq, lds, wid, lane); S.done(cur); }
#undef PG8_SA
#undef PG8_SB
#undef PG8_STAGE
#undef PG8_LDA
#undef PG8_LDB
#undef PG8_MMA
#undef PG8_WAIT_V
#undef PG8_WAIT_L
#undef PG8_BAR
#undef PG8_SCHED
}
}


#define GAS __attribute__((address_space(1)))
#define LAS __attribute__((address_space(3)))
typedef unsigned short bf16;
typedef unsigned v4u __attribute__((ext_vector_type(4)));
typedef unsigned v2u __attribute__((ext_vector_type(2)));
typedef float f32x4 __attribute__((ext_vector_type(4)));
typedef float f32x2 __attribute__((ext_vector_type(2)));
typedef float f32x16 __attribute__((ext_vector_type(16)));
typedef short bf16x8 __attribute__((ext_vector_type(8)));
typedef short s16x4 __attribute__((ext_vector_type(4)));
typedef GAS unsigned gu32;
#define RLX_AGENT __ATOMIC_RELAXED, __HIP_MEMORY_SCOPE_AGENT
#define LDS_WAIT() asm volatile("s_waitcnt lgkmcnt(0)" ::: "memory")
#define VM_WAIT() asm volatile("s_waitcnt vmcnt(0)" ::: "memory")
__device__ __forceinline__ unsigned f2bf(float f) { unsigned u = __builtin_bit_cast(unsigned, f); return (u + 0x7fffu + ((u >> 16) & 1u)) >> 16; }
__device__ __forceinline__ unsigned pk2(float lo, float hi) { return f2bf(lo) | (f2bf(hi) << 16); }
__device__ __forceinline__ float bf2f(unsigned short h) { return __uint_as_float(((unsigned)h) << 16); }
__device__ __forceinline__ float bflo(unsigned w) { return __uint_as_float(w << 16); }
__device__ __forceinline__ float bfhi(unsigned w) { return __uint_as_float(w & 0xffff0000u); }

constexpr int NWAVES = 8;
constexpr size_t MiB = 1u << 20;
constexpr size_t WS_CTL = 0, CTL_ZERO_BYTES = 1 * MiB;
constexpr int CW_BAR = 4096, CW_Q3 = 16384;
constexpr size_t WS_ROWSS = 256 * 1024;
constexpr size_t WS_WIN = 2 * MiB;
constexpr size_t WS_WO = 8 * MiB;
constexpr size_t WS_WGU = 10 * MiB;
constexpr size_t WS_WDN = 21 * MiB;
constexpr size_t WS_WPG = 27 * MiB;
constexpr size_t WS_WPLE = 29 * MiB;
constexpr size_t WS_WC1 = 30 * MiB;
constexpr size_t WS_WC2 = 31 * MiB;
constexpr size_t WS_C1 = 31 * MiB + 65536;
constexpr size_t WS_KCP = 32 * MiB;
constexpr size_t WS_VCP = 33 * MiB;
constexpr size_t WS_KCS = 34 * MiB;
constexpr size_t WS_VCS = 38 * MiB;
constexpr size_t WS_DSC = 42 * MiB;
constexpr size_t WS_USC = 43 * MiB;
constexpr size_t WS_QB = 51 * MiB;
constexpr size_t WS_XN = 64 * MiB;
constexpr size_t WS_PPLE = 97 * MiB;
constexpr size_t WS_PROJ = 106 * MiB;
constexpr size_t WS_OWIN = 204 * MiB;
constexpr size_t WS_MIX = 221 * MiB;
constexpr size_t WS_OLOC = 254 * MiB;
constexpr size_t WS_H1 = 287 * MiB;
constexpr size_t WS_H1B = 353 * MiB;
constexpr size_t WS_ACT = 386 * MiB;
constexpr size_t WS_H2 = 476 * MiB;
constexpr size_t WS_H2B = 542 * MiB;
constexpr size_t WS_PLEB = 575 * MiB;
constexpr size_t WS_END = 608 * MiB;
constexpr int RING_BYTES = 131072;
constexpr int MISC_OFF = RING_BYTES + 320;
constexpr int LDS_BYTES = 163840;
#define XB_TMO      128
#define XB_XCNT(j)  (256  + 64 * (j))
#define XB_XSUB(j)  (1280 + 64 * (j))
#define XB_XGEN(j)  (2304 + 64 * (j))
#define XB_TOP      3328
#define XB_TOPGEN   3392
#define XCD_BAR_WORDS 3456
#define XB_SPIN_CAP (1u << 18)

__device__ __forceinline__ unsigned xb_ld(unsigned* p)              { return __hip_atomic_load(p, __ATOMIC_RELAXED, __HIP_MEMORY_SCOPE_AGENT); }
__device__ __forceinline__ unsigned xb_add(unsigned* p, unsigned v) { return __hip_atomic_fetch_add(p, v, __ATOMIC_RELAXED, __HIP_MEMORY_SCOPE_AGENT); }
__device__ __forceinline__ unsigned xb_xcc_id() { return (unsigned)__builtin_amdgcn_s_getreg((3 << 11) | 20) & 0xFu; }
#define XB_SPIN(cond, bar) do { unsigned _sp = 0; while (cond) { __builtin_amdgcn_s_sleep(1); \
    if ((++_sp & 255u) == 0u) { if (xb_ld(&(bar)[XB_TMO])) break; if (_sp > XB_SPIN_CAP) { atomicAdd(&(bar)[XB_TMO], 1u); break; } } } } while (0)

struct XcdBarrier {
    unsigned* bar; unsigned x;
    volatile LAS unsigned* st;
};

__device__ __forceinline__ XcdBarrier xcd_barrier_post(unsigned* bar, volatile LAS unsigned* st, const int tid) {
    XcdBarrier b; b.bar = bar; b.x = xb_xcc_id(); b.st = st;
    if (tid == 0) (void)xb_add(&bar[XB_XCNT(b.x)], 1u);
    return b;
}
__device__ __forceinline__ void xcd_barrier_complete(unsigned* bar, unsigned x, unsigned& nloc, unsigned& nx) {
    const unsigned G = gridDim.x * gridDim.y * gridDim.z;
    unsigned sum, cnt, mine, sp = 0u;
    for (;;) {
        sum = 0u; cnt = 0u; mine = 0u;
#pragma unroll
        for (unsigned j = 0; j < 16; ++j) { const unsigned c = xb_ld(&bar[XB_XCNT(j)]); sum += c; cnt += (c > 0u) ? 1u : 0u; mine = (j == x) ? c : mine; }
        if (sum == G) break;
        __builtin_amdgcn_s_sleep(1);
        if ((++sp & 255u) == 0u) { if (xb_ld(&bar[XB_TMO])) break; if (sp > XB_SPIN_CAP) { atomicAdd(&bar[XB_TMO], 1u); break; } }
    }
    nloc = mine > 0u ? mine : 1u; nx = cnt > 0u ? cnt : 1u;
}

__device__ __forceinline__ void xcd_barrier(const XcdBarrier& b, const int tid) {
    asm volatile("s_waitcnt vmcnt(0)" ::: "memory");
    __syncthreads();
    if (tid == 0) {
        unsigned* bar = b.bar;
        __builtin_amdgcn_s_waitcnt(0);
        unsigned nloc = b.st[0], nx = b.st[1];
        if (nloc == 0u) { xcd_barrier_complete(bar, b.x, nloc, nx); b.st[0] = nloc; b.st[1] = nx; }
        const unsigned old = xb_add(&bar[XB_XSUB(b.x)], 1u);
        const unsigned gen = old / nloc;
        if (old + 1u == (gen + 1u) * nloc) {
            __builtin_amdgcn_fence(__ATOMIC_RELEASE, "agent");
            asm volatile("s_waitcnt vmcnt(0)" ::: "memory");
            const unsigned og = xb_add(&bar[XB_TOP], 1u);
            const unsigned tg = og / nx;
            if (og + 1u == (tg + 1u) * nx) xb_add(&bar[XB_TOPGEN], 1u);
            else XB_SPIN(xb_ld(&bar[XB_TOPGEN]) == tg, bar);
            __builtin_amdgcn_fence(__ATOMIC_ACQUIRE, "agent");
            xb_add(&bar[XB_XGEN(b.x)], 1u);
            asm volatile("s_waitcnt vmcnt(0)" ::: "memory");
        } else {
            XB_SPIN(xb_ld(&bar[XB_XGEN(b.x)]) == gen, bar);
            __builtin_amdgcn_fence(__ATOMIC_ACQUIRE, "agent");
            asm volatile("s_waitcnt vmcnt(0)" ::: "memory");
        }
    }
    __syncthreads();
}

struct Args { const float* in[26]; float* out; unsigned char* ws; int ph_lo, ph_hi; };
struct Frame {
    LAS unsigned char* lds;
    int tid, lane, wave, vcu, G;
};
__device__ __forceinline__ int hw_lane() { int l; asm volatile("v_mbcnt_lo_u32_b32 %0, -1, 0\n\tv_mbcnt_hi_u32_b32 %0, -1, %0" : "=v"(l)); return l; }
__device__ __forceinline__ int opaque(int x) { asm volatile("" : "+v"(x)); return x; }
__device__ __forceinline__ float wave_sum(float v) {
#pragma unroll
    for (int o = 1; o < 64; o <<= 1) v += __shfl_xor(v, o);
    return v;
}
__device__ __forceinline__ void p0_tr_item(const float* W, int ldw, int K, int nsrc, int nblk, bf16* WT, int mode, const float* kscale, LAS float* scr, int item, int lane) {
    const int kb = item / nblk, nb = item % nblk, k0 = 64 * kb, n0 = 32 * nb;
    const int nn = n0 + (lane & 31);
#pragma unroll 8
    for (int i = 0; i < 32; ++i) { const int kk = 2 * i + (lane >> 5); float v = 0.f; if (nn < nsrc) { v = W[(size_t)(k0 + kk) * ldw + nn]; if (kscale) v *= kscale[k0 + kk]; } scr[kk * 33 + (lane & 31)] = v; }
    LDS_WAIT(); asm volatile("" ::: "memory");
    const int c = lane & 7;
#pragma unroll
    for (int j = 0; j < 4; ++j) { const int n = (lane >> 3) + 8 * j; const LAS float* s = scr + (8 * c) * 33 + n;
        v4u o; o.x = pk2(s[0 * 33], s[1 * 33]); o.y = pk2(s[2 * 33], s[3 * 33]); o.z = pk2(s[4 * 33], s[5 * 33]); o.w = pk2(s[6 * 33], s[7 * 33]);
        const int ng = n0 + n; const int drow = (mode == 0) ? ng : (256 * (ng >> 7) + (ng & 127) + (mode == 2 ? 128 : 0));
        *(GAS v4u*)(WT + (size_t)drow * K + k0 + 8 * c) = o; }
    LDS_WAIT(); asm volatile("" ::: "memory");
}
__device__ __forceinline__ void rms_row_to_bf16(const float* xrow, const float* g, bf16* orow, int lane) {
    const GAS f32x4* xr = (const GAS f32x4*)xrow + lane; const GAS f32x4* gr = (const GAS f32x4*)g + lane;
    f32x4 v[4]; float s = 0.f;
#pragma unroll
    for (int j = 0; j < 4; ++j) { v[j] = xr[64 * j]; s += (v[j].x * v[j].x + v[j].y * v[j].y) + (v[j].z * v[j].z + v[j].w * v[j].w); }
    const float rstd = 1.0f / sqrtf(wave_sum(s) * (1.f / DM) + EPS);
    GAS unsigned long long* o8 = (GAS unsigned long long*)orow + lane;
#pragma unroll
    for (int j = 0; j < 4; ++j) { const f32x4 gg = gr[64 * j];
        o8[64 * j] = (unsigned long long)pk2(v[j].x * rstd * gg.x, v[j].y * rstd * gg.y) | ((unsigned long long)pk2(v[j].z * rstd * gg.z, v[j].w * rstd * gg.w) << 32); }
}
__device__ __forceinline__ void p0_prologue(const Frame& F, const Args& A) {
    unsigned char* ws = A.ws;
    LAS float* scr = (LAS float*)(F.lds + F.wave * 16384);
    const int gw = F.vcu * NWAVES + F.wave, NGW = F.G * NWAVES, lane = F.lane;
    constexpr int I_IN = 16 * 96, I_O = 16 * 32, I_G = 16 * 88, I_D = 44 * 32, I_PG = 16 * 32, I_PL = 4 * 32, I_C1 = 128  , I_C2 = 2 * 1 * 2;
    constexpr int NITEMS = I_IN + I_O + 2 * I_G + I_D + I_PG + I_PL + I_C1 + I_C2;
    for (int it = gw; it < NITEMS; it += NGW) {
        int r = it;
        if (r < I_IN) { p0_tr_item(A.in[9], NIN, 1024, NIN, 96, (bf16*)(ws + WS_WIN), 0, nullptr, scr, r, lane); continue; } r -= I_IN;
        if (r < I_O) { p0_tr_item(A.in[16], 1024, 1024, 1024, 32, (bf16*)(ws + WS_WO), 0, nullptr, scr, r, lane); continue; } r -= I_O;
        if (r < I_G) { p0_tr_item(A.in[18], DFF, 1024, DFF, 88, (bf16*)(ws + WS_WGU), 1, A.in[17], scr, r, lane); continue; } r -= I_G;
        if (r < I_G) { p0_tr_item(A.in[19], DFF, 1024, DFF, 88, (bf16*)(ws + WS_WGU), 2, A.in[17], scr, r, lane); continue; } r -= I_G;
        if (r < I_D) { p0_tr_item(A.in[20], 1024, DFF, 1024, 32, (bf16*)(ws + WS_WDN), 0, nullptr, scr, r, lane); continue; } r -= I_D;
        if (r < I_PG) { p0_tr_item(A.in[23], 1024, 1024, 1024, 32, (bf16*)(ws + WS_WPG), 0, A.in[22], scr, r, lane); continue; } r -= I_PG;
        if (r < I_PL) { p0_tr_item(A.in[21], 1024, 256, 1024, 32, (bf16*)(ws + WS_WPLE), 0, nullptr, scr, r, lane); continue; } r -= I_PL;
        if (r < I_C1) {
#pragma unroll
            for (int q4 = 0; q4 < 4; ++q4) { const int ch = (r * 4 + q4) * 64 + lane; const int l = ch & 63, ks = (ch >> 6) & 63, ht = (ch >> 12) & 1, jj = (ch >> 13) & 1, slot = ch >> 14;
                const float* src = A.in[11] + ((size_t)slot * 2048 + jj * 1024 + 16 * ks + 8 * (l >> 5)) * 64 + 32 * ht + (l & 31);
                v4u o; o.x = pk2(src[0], src[64]); o.y = pk2(src[128], src[192]); o.z = pk2(src[256], src[320]); o.w = pk2(src[384], src[448]);
                *(GAS v4u*)((bf16*)(ws + WS_WC1) + (size_t)ch * 8) = o; }
            continue; } r -= I_C1;
        { const int slot = r / 2; p0_tr_item(A.in[12] + (size_t)slot * 64 * 64, 64, 64, 64, 2, (bf16*)(ws + WS_WC2) + (size_t)slot * 64 * 64, 0, nullptr, scr, r % 2, lane); }
    }
    if (F.vcu < 2) { const int slot = F.vcu; const float* pe = A.in[10] + slot * 2048 + F.wave * 256; const float* w1 = A.in[11] + (size_t)slot * 2048 * 64 + (size_t)F.wave * 256 * 64; float a = 0.f;
#pragma unroll 16
        for (int k = 0; k < 256; ++k) a += pe[k] * w1[k * 64 + lane];
        ((LAS float*)(F.lds + F.wave * 16384 + 12288))[lane] = a; __syncthreads();
        if (F.wave == 0) { float t = 0.f;
#pragma unroll
            for (int w = 0; w < 8; ++w) t += ((LAS float*)(F.lds + w * 16384 + 12288))[lane];
            ((float*)(ws + WS_C1))[slot * 64 + lane] = t; }
    }
    bf16* XN = (bf16*)(ws + WS_XN);
    for (int m = gw; m < MPAD; m += NGW) {
        if (m < MTOT) { const float* xr = (m < TP) ? A.in[0] + (size_t)m * DM : A.in[1] + (size_t)(m - TP) * DM; rms_row_to_bf16(xr, A.in[8], XN + (size_t)m * DM, lane); }
        else { GAS v4u* o = (GAS v4u*)(XN + (size_t)m * DM) + lane; o[0] = (v4u){0, 0, 0, 0}; o[64] = (v4u){0, 0, 0, 0}; }
    }
    bf16* PP = (bf16*)(ws + WS_PPLE);
    for (int m = gw; m < MPAD; m += NGW) {
        v2u o = (v2u){0, 0};
        if (m < MTOT) { const float* pr = (m < TP) ? A.in[6] + (size_t)m * DPLE : A.in[7] + (size_t)(m - TP) * DPLE; const f32x4 v = ((const GAS f32x4*)pr)[lane]; o.x = pk2(v.x, v.y); o.y = pk2(v.z, v.w); }
        ((GAS v2u*)(PP + (size_t)m * DPLE))[lane] = o;
        if (m >= MTOT) { GAS v4u* z = (GAS v4u*)((bf16*)(ws + WS_MIX) + (size_t)m * DM) + lane; z[0] = (v4u){0, 0, 0, 0}; z[64] = (v4u){0, 0, 0, 0}; }
    }
    for (int it = gw; it < DBATCH * 508; it += NGW) { const int b = it / 508, r = it % 508;
        ((GAS f32x4*)(A.out + O_WINS + (size_t)(b * 512 + r) * 256))[lane] = ((const GAS f32x4*)(A.in[3] + (size_t)(b * 512 + r + 4) * 256))[lane]; }
}

constexpr float LOG2E = 1.4426950408889634f;
typedef short v4i16_t __attribute__((ext_vector_type(4)));
__device__ __forceinline__ s16x4 vtr(LAS const unsigned char* p) { return __builtin_bit_cast(s16x4, __builtin_amdgcn_ds_read_tr16_b64_v4i16((LAS v4i16_t*)p)); }
__device__ __forceinline__ unsigned cvtpk(float lo, float hi) { typedef float f2 __attribute__((ext_vector_type(2))); typedef __bf16 b2 __attribute__((ext_vector_type(2))); f2 v = {lo, hi}; b2 b = __builtin_convertvector(v, b2); return __builtin_bit_cast(unsigned, b); }
__device__ __forceinline__ int t5_bucket(int n) {
    if (n < 16) return n;
    const int large = 16 + (int)(logf((float)n / 16.0f) / 2.0794415416798357f * 16.0f);
    return large < 31 ? large : 31;
}
constexpr int HI_BASE = 131072 + 512, AT_LUT = HI_BASE, HI_IMPA = AT_LUT + 4096, HI_IMPB = HI_IMPA + 2176, HI_SEL = HI_IMPB + 2176, HI_SCS = HI_SEL + 128, HI_TL = HI_SCS + 512, HI_XCH = HI_TL + 512, HI_Q = HI_XCH + 8192, HI_END = HI_Q + 64;
constexpr int AT_K0 = 0, AT_V0 = 16384, AT_IMPA = 36864, AT_IMPB = AT_IMPA + 64 * 65 * 4 + 64, AT_SEL = AT_IMPB + 64 * 65 * 4 + 64, AT_MISC = AT_SEL + 1024, AT_QF = ((AT_MISC + 4096 + 1023) / 1024) * 1024, AT_END = AT_QF + 32768;
struct AttnLane {
    int koff;
    int kx;
    int voff0, voff1;
    int r32, h;
};
__device__ __forceinline__ AttnLane attn_lane(int lane) {
    AttnLane L; L.r32 = lane & 31; L.h = lane >> 5; L.koff = L.r32 * 128; L.kx = (L.r32 >> 1) & 7;
    const int i16 = lane & 15, q = i16 >> 2, p = i16 & 3, g1 = (lane >> 4) & 1;
    const int base = (4 * L.h + q) * 128 + g1 * 32 + (p >> 1) * 16 + (p & 1) * 8;
    L.voff0 = base + ((q >> 1) * 64); L.voff1 = base + (((q >> 1) ^ 1) * 64);
    return L;
}
__device__ __forceinline__ void attn_fill_lut(LAS float* lut, const float* rel_bias, int tid) {
    for (int e = tid; e < 1024; e += NWAVES * 64) { const int dist = e >> 3, hd = e & 7; lut[e] = rel_bias[t5_bucket(dist) * 8 + hd] * LOG2E; }
}
__device__ __forceinline__ void attn_commit(LAS unsigned char* kb, LAS unsigned char* vb, int tid, v4u k, v4u v) {
    const int row = tid >> 3, ch = tid & 7;
    *(LAS v4u*)(kb + row * 128 + ((ch ^ ((row >> 1) & 7)) << 4)) = k;
    *(LAS v4u*)(vb + row * 128 + ((ch ^ (((row >> 1) & 1) << 2)) << 4)) = v;
}
__device__ __forceinline__ f32x16 attn_qk(LAS const unsigned char* kb, int hf, const AttnLane& L, const bf16x8 (&qf)[4]) {
    f32x16 s = {};
#pragma unroll
    for (int ks = 0; ks < 4; ++ks) { const bf16x8 kf = *(LAS const bf16x8*)(kb + hf * 4096 + L.koff + (((2 * ks + L.h) ^ L.kx) << 4)); s = __builtin_amdgcn_mfma_f32_32x32x16_bf16(kf, qf[ks], s, 0, 0, 0); }
    return s;
}
__device__ __forceinline__ void attn_pv(LAS const unsigned char* vb, int hf, const AttnLane& L, const f32x16& p, f32x16 (&o)[2]) {
#pragma unroll
    for (int s = 0; s < 2; ++s) {
        v4u pw; pw.x = cvtpk(p[8 * s + 0], p[8 * s + 1]); pw.y = cvtpk(p[8 * s + 2], p[8 * s + 3]); pw.z = cvtpk(p[8 * s + 4], p[8 * s + 5]); pw.w = cvtpk(p[8 * s + 6], p[8 * s + 7]);
        const bf16x8 pb = __builtin_bit_cast(bf16x8, pw);
        const int rb = (32 * hf + 16 * s) * 128;
        { const s16x4 lo = vtr(vb + rb + L.voff0), hi = vtr(vb + rb + 1024 + L.voff0); const bf16x8 vf = {lo[0], lo[1], lo[2], lo[3], hi[0], hi[1], hi[2], hi[3]};
          o[0] = __builtin_amdgcn_mfma_f32_32x32x16_bf16(vf, pb, o[0], 0, 0, 0); }
        { const s16x4 lo = vtr(vb + rb + L.voff1), hi = vtr(vb + rb + 1024 + L.voff1); const bf16x8 vf = {lo[0], lo[1], lo[2], lo[3], hi[0], hi[1], hi[2], hi[3]};
          o[1] = __builtin_amdgcn_mfma_f32_32x32x16_bf16(vf, pb, o[1], 0, 0, 0); }
    }
}
__device__ __forceinline__ float max16(const f32x16& a) {
    float m0 = fmaxf(fmaxf(a[0], a[1]), fmaxf(a[2], a[3])), m1 = fmaxf(fmaxf(a[4], a[5]), fmaxf(a[6], a[7])), m2 = fmaxf(fmaxf(a[8], a[9]), fmaxf(a[10], a[11])), m3 = fmaxf(fmaxf(a[12], a[13]), fmaxf(a[14], a[15]));
    return fmaxf(fmaxf(m0, m1), fmaxf(m2, m3));
}
__device__ __forceinline__ float sum16(const f32x16& a) {
    return ((a[0] + a[1]) + (a[2] + a[3])) + ((a[4] + a[5]) + (a[6] + a[7])) + (((a[8] + a[9]) + (a[10] + a[11])) + ((a[12] + a[13]) + (a[14] + a[15])));
}
__device__ __forceinline__ float xmax32(float v) { const auto rr = __builtin_amdgcn_permlane32_swap(__float_as_uint(v), __float_as_uint(v), false, false); return fmaxf(__uint_as_float(rr[0]), __uint_as_float(rr[1])); }
__device__ __forceinline__ float xsum32(float v) { const auto rr = __builtin_amdgcn_permlane32_swap(__float_as_uint(v), __float_as_uint(v), false, false); return __uint_as_float(rr[0]) + __uint_as_float(rr[1]); }
__device__ __forceinline__ void attn_softmax_pv(LAS const unsigned char* vb, const AttnLane& L, f32x16& t0, f32x16& t1, float& m, float& lh, f32x16 (&o)[2]) {
    const float tm = xmax32(fmaxf(max16(t0), max16(t1)));
    if (__any(tm > m + 8.0f)) {
        const float mn = fmaxf(m, tm), mu0 = (mn == -INFINITY) ? 0.f : mn;
        const float alpha = __builtin_amdgcn_exp2f(m - mu0);
#pragma unroll
        for (int r = 0; r < 16; ++r) { o[0][r] *= alpha; o[1][r] *= alpha; }
        lh *= alpha; m = mn;
    }
    const float mu = (m == -INFINITY) ? 0.f : m;
#pragma unroll
    for (int r = 0; r < 16; ++r) { t0[r] = __builtin_amdgcn_exp2f(t0[r] - mu); t1[r] = __builtin_amdgcn_exp2f(t1[r] - mu); }
    lh += sum16(t0) + sum16(t1);
    attn_pv(vb, 0, L, t0, o); attn_pv(vb, 1, L, t1, o);
}
#define KEYIDX(hf, reg, h) (32 * (hf) + ((reg) & 3) + 8 * ((reg) >> 2) + 4 * (h))
__device__ __forceinline__ void score_far(f32x16& t0, f32x16& t1, float cb) {
#pragma unroll
    for (int r = 0; r < 16; ++r) { t0[r] = fmaf(t0[r], LOG2E, cb); t1[r] = fmaf(t1[r], LOG2E, cb); }
}
__device__ __forceinline__ void score_near1(f32x16& t, int hf, int h, LAS const float* lut, int hd, int dbase, int dstep, int dmax, int klim, bool colok) {
#pragma unroll
    for (int r = 0; r < 16; ++r) {
        const int ki = KEYIDX(hf, r, h); const int dist = dbase - dstep * ki; const int di = dist < 0 ? 0 : (dist > 127 ? 127 : dist); const float bv = lut[di * 8 + hd];
        const bool ok = colok && dist >= 0 && dist < dmax && ki < klim; const float v = fmaf(t[r], LOG2E, bv); t[r] = ok ? v : -INFINITY; }
}
__device__ __forceinline__ void score_near(f32x16& t0, f32x16& t1, int h, LAS const float* lut, int hd, int dbase, int dstep, int dmax, int klim, bool colok) {
    score_near1(t0, 0, h, lut, hd, dbase, dstep, dmax, klim, colok);
    __builtin_amdgcn_sched_barrier(0);
    score_near1(t1, 1, h, lut, hd, dbase, dstep, dmax, klim, colok);
    __builtin_amdgcn_sched_barrier(0);
}

__device__ __forceinline__ void win_unit(const Frame& F, const Args& A, LAS unsigned char* sh, int b, int g, int qb) {
    const bf16* PROJ = (const bf16*)(A.ws + WS_PROJ);
    const int lane = hw_lane(), w = F.wave, tid = w * 64 + lane;
    const AttnLane L = attn_lane(lane);
    const int tq = 64 * qb + 8 * w + (L.r32 >> 2), hd = g * 4 + (L.r32 & 3);
    const size_t tokq = (size_t)b * SEQ + tq;
    bf16x8 qf[4];
#pragma unroll
    for (int ks = 0; ks < 4; ++ks) qf[ks] = *(const bf16x8*)(PROJ + tokq * NPROJ + C_QN + hd * 64 + 16 * ks + 8 * L.h);
    LAS const float* lut = (LAS const float*)(sh + AT_LUT);
    const float bfar = lut[127 * 8 + hd];
    const int kt0 = qb >= 8 ? qb - 8 : 0, nt = qb - kt0 + 1;
    const int srow = tid >> 3, sch = tid & 7;
    const bf16* ksrc = PROJ + ((size_t)b * SEQ + srow) * NPROJ + C_WIN + g * 64 + sch * 8;
    v4u kr, vr;
    kr = *(const v4u*)(ksrc + (size_t)(64 * kt0) * NPROJ); vr = *(const v4u*)(ksrc + (size_t)(64 * kt0) * NPROJ + 128);
    __syncthreads();
    attn_commit(sh + AT_K0, sh + AT_V0, tid, kr, vr);
    __syncthreads();
    float m = -INFINITY, l = 0.f; f32x16 o[2]; o[0] = f32x16{}; o[1] = f32x16{};
    for (int it = 0; it < nt; ++it) {
        const int kt = kt0 + it, buf = it & 1;
        if (it + 1 < nt) { kr = *(const v4u*)(ksrc + (size_t)(64 * (kt + 1)) * NPROJ); vr = *(const v4u*)(ksrc + (size_t)(64 * (kt + 1)) * NPROJ + 128); }
        LAS const unsigned char* kb = sh + AT_K0 + buf * 8192; LAS const unsigned char* vb = sh + AT_V0 + buf * 8192;
        f32x16 t0 = attn_qk(kb, 0, L, qf), t1 = attn_qk(kb, 1, L, qf);
        if (kt <= qb - 3 && kt >= qb - 7) score_far(t0, t1, bfar);
        else score_near(t0, t1, L.h, lut, hd, tq - 64 * kt, 1, 512, 64, true);
        attn_softmax_pv(vb, L, t0, t1, m, l, o);
        if (it + 1 < nt) attn_commit(sh + AT_K0 + (buf ^ 1) * 8192, sh + AT_V0 + (buf ^ 1) * 8192, tid, kr, vr);
        __syncthreads();
    }
    const float rl = __builtin_amdgcn_rcpf(xsum32(l));
    bf16* dst = (bf16*)(A.ws + WS_OWIN) + tokq * 512 + hd * 64;
#pragma unroll
    for (int dt = 0; dt < 2; ++dt)
#pragma unroll
        for (int rq = 0; rq < 4; ++rq) { v2u wv; wv.x = cvtpk(o[dt][4 * rq] * rl, o[dt][4 * rq + 1] * rl); wv.y = cvtpk(o[dt][4 * rq + 2] * rl, o[dt][4 * rq + 3] * rl);
            *(v2u*)(dst + 32 * dt + 8 * rq + 4 * L.h) = wv; }
}

__device__ __forceinline__ void nsa_unit(const Frame& F, const Args& A, LAS unsigned char* sh, int b, int g, int qb) {
    const bf16* PROJ = (const bf16*)(A.ws + WS_PROJ);
    const int lane = hw_lane(), w = F.wave, tid = w * 64 + lane;
    const AttnLane L = attn_lane(lane);
    const int qloc = 8 * w + (L.r32 >> 2);
    const int tq = 64 * qb + qloc, hd = g * 4 + (L.r32 & 3);
    const size_t tokq = (size_t)b * SEQ + tq;
    LAS bf16x8* qlds = (LAS bf16x8*)(sh + AT_QF) + tid;
    __syncthreads();
#pragma unroll
    for (int ks = 0; ks < 4; ++ks) qlds[ks * 512] = *(const bf16x8*)(PROJ + tokq * NPROJ + C_QN + hd * 64 + 16 * ks + 8 * L.h);
#define NSA_LOADQ() bf16x8 qf[4]; _Pragma("unroll") for (int ks = 0; ks < 4; ++ks) qf[ks] = qlds[ks * 512]
    LAS const float* lut = (LAS const float*)(sh + AT_LUT);
    const float bfar = lut[127 * 8 + hd];
    LAS float* impA = (LAS float*)(sh + AT_IMPA); LAS float* impB = (LAS float*)(sh + AT_IMPB);
    LAS unsigned long long* selm = (LAS unsigned long long*)(sh + AT_SEL);
    const int srow = tid >> 3, sch = tid & 7;
    v4u kr, vr;
    const int nct = (4 * qb + 3 + 63) >> 6;
    const bf16* kcs = (const bf16*)(A.ws + WS_KCP) + ((size_t)(b * 256 + srow) * 2 + g) * 64 + sch * 8;
    const bf16* vcs = (const bf16*)(A.ws + WS_VCP) + ((size_t)(b * 256 + srow) * 2 + g) * 64 + sch * 8;
    __syncthreads();
    for (int e = tid; e < 64 * 65; e += NWAVES * 64) { impA[e] = 0.f; impB[e] = 0.f; }
    float mc = -INFINITY, lc = 0.f;
#pragma unroll 1
    for (int pass = 0; pass < 2; ++pass) {
        kr = *(const v4u*)(kcs); vr = *(const v4u*)(vcs);
        __syncthreads();
        attn_commit(sh + AT_K0, sh + AT_V0, tid, kr, vr);
        __syncthreads();
        const float mu = (mc == -INFINITY) ? 0.f : mc, il = lc > 0.f ? __builtin_amdgcn_rcpf(lc) : 0.f;
#pragma unroll 1
        for (int ct = 0; ct < nct; ++ct) {
            const int buf = ct & 1;
            if (ct + 1 < nct) { kr = *(const v4u*)(kcs + (size_t)(64 * (ct + 1)) * 128); vr = *(const v4u*)(vcs + (size_t)(64 * (ct + 1)) * 128); }
            LAS const unsigned char* kb = sh + AT_K0 + buf * 8192; LAS const unsigned char* vb = sh + AT_V0 + buf * 8192;
            NSA_LOADQ();
            f32x16 t0 = attn_qk(kb, 0, L, qf), t1 = attn_qk(kb, 1, L, qf);
            score_near(t0, t1, L.h, lut, hd, tq - 31 - 1024 * ct, 16, 1 << 30, 255 - 64 * ct, true);
            if (pass == 0) {
                const float tm = xmax32(fmaxf(max16(t0), max16(t1)));
                const float mn = fmaxf(mc, tm), mu0 = (mn == -INFINITY) ? 0.f : mn;
                const float alpha = __builtin_amdgcn_exp2f(mc - mu0);
                float ps = 0.f;
#pragma unroll
                for (int r = 0; r < 16; ++r) ps += __builtin_amdgcn_exp2f(t0[r] - mu0) + __builtin_amdgcn_exp2f(t1[r] - mu0);
                ps = xsum32(ps);
                lc = lc * alpha + ps; mc = mn;
            } else {
#pragma unroll
                for (int r = 0; r < 16; ++r) { t0[r] = __builtin_amdgcn_exp2f(t0[r] - mu) * il; t1[r] = __builtin_amdgcn_exp2f(t1[r] - mu) * il; }
#pragma unroll
                for (int hf = 0; hf < 2; ++hf) {
                    float x[16];
#pragma unroll
                    for (int r = 0; r < 16; ++r) { float v = hf ? t1[r] : t0[r]; v += __shfl_xor(v, 1); v += __shfl_xor(v, 2); x[r] = v; }
                    if ((L.r32 & 3) == 0) {
#pragma unroll
                        for (int rq = 0; rq < 4; ++rq) { const int jq = 16 * ct + 8 * hf + 2 * rq + L.h;
                            impA[qloc * 65 + jq] = 2.0f * (x[4 * rq] + x[4 * rq + 1] + x[4 * rq + 2]) + x[4 * rq + 3];
                            impB[qloc * 65 + jq + 1] = x[4 * rq + 3]; }
                    }
                }
            }
            if (ct + 1 < nct) attn_commit(sh + AT_K0 + (buf ^ 1) * 8192, sh + AT_V0 + (buf ^ 1) * 8192, tid, kr, vr);
            __syncthreads();
        }
    }
#pragma unroll 1
    for (int qi = 0; qi < 8; ++qi) {
        const int q = 8 * w + qi;
        unsigned long long mk;
        if (qb < 16) mk = (2ull << qb) - 1ull;
        else {
            const bool forced = (lane == 0) || (lane == qb) || (lane == qb - 1);
            const float sc = forced ? 1e9f : (lane <= qb ? impA[q * 65 + lane] + impB[q * 65 + lane] : -1.0f);
            int rank = 0;
#pragma unroll 8
            for (int jj = 0; jj < 64; ++jj) { const float ov = __uint_as_float(__builtin_amdgcn_readlane(__float_as_uint(sc), jj)); rank += ((ov > sc) || (ov == sc && jj < lane)) ? 1 : 0; }
            mk = __ballot(rank < 16 && lane <= qb);
        }
        if (lane == 0) selm[q] = mk;
    }
    __syncthreads();
    const unsigned long long mysel = selm[qloc];
    unsigned long long um = 0ull;
#pragma unroll 8
    for (int q_ = 0; q_ < 64; ++q_) um |= selm[q_];
    um = ((unsigned long long)__builtin_amdgcn_readfirstlane((unsigned)(um >> 32)) << 32) | (unsigned long long)__builtin_amdgcn_readfirstlane((unsigned)um);
    const bf16* ksrc = PROJ + ((size_t)b * SEQ + srow) * NPROJ + C_KV + 2 * 128 + g * 64 + sch * 8;
    float m = -INFINITY, l = 0.f; f32x16 o[2]; o[0] = f32x16{}; o[1] = f32x16{};
    int j = __builtin_ctzll(um); um &= um - 1;
    kr = *(const v4u*)(ksrc + (size_t)(64 * j) * NPROJ); vr = *(const v4u*)(ksrc + (size_t)(64 * j) * NPROJ + 128);
    attn_commit(sh + AT_K0, sh + AT_V0, tid, kr, vr);
    __syncthreads();
    int buf = 0;
#pragma unroll 1
    for (;;) {
        const int jn = um ? __builtin_ctzll(um) : -1; um &= um - 1;
        if (jn >= 0) { kr = *(const v4u*)(ksrc + (size_t)(64 * jn) * NPROJ); vr = *(const v4u*)(ksrc + (size_t)(64 * jn) * NPROJ + 128); }
        LAS const unsigned char* kb = sh + AT_K0 + buf * 8192; LAS const unsigned char* vb = sh + AT_V0 + buf * 8192;
        const bool selj = (mysel >> j) & 1ull;
        if (__any(selj)) {
            NSA_LOADQ();
            f32x16 t0 = attn_qk(kb, 0, L, qf), t1 = attn_qk(kb, 1, L, qf);
            if (j <= qb - 3) score_far(t0, t1, selj ? bfar : -INFINITY);
            else score_near(t0, t1, L.h, lut, hd, tq - 64 * j, 1, 1 << 30, 64, selj);
            attn_softmax_pv(vb, L, t0, t1, m, l, o);
        }
        if (jn >= 0) attn_commit(sh + AT_K0 + (buf ^ 1) * 8192, sh + AT_V0 + (buf ^ 1) * 8192, tid, kr, vr);
        __syncthreads();
        if (jn < 0) break;
        j = jn; buf ^= 1;
    }
    const bf16* gp = PROJ + tokq * NPROJ + C_GT + hd;
    const float g0 = __builtin_amdgcn_rcpf(1.0f + __expf(-bf2f(gp[0]))), g1 = __builtin_amdgcn_rcpf(1.0f + __expf(-bf2f(gp[8]))), g2 = __builtin_amdgcn_rcpf(1.0f + __expf(-bf2f(gp[16])));
    const float rl = g1 * __builtin_amdgcn_rcpf(xsum32(l));
    const bf16* ow = (const bf16*)(A.ws + WS_OWIN) + tokq * 512 + hd * 64;
#pragma unroll
    for (int dt = 0; dt < 2; ++dt)
#pragma unroll
        for (int rq = 0; rq < 4; ++rq) { const int d0 = 32 * dt + 8 * rq + 4 * L.h; const v2u wv = *(const v2u*)(ow + d0);
            o[dt][4 * rq] = rl * o[dt][4 * rq] + g2 * bflo(wv.x); o[dt][4 * rq + 1] = rl * o[dt][4 * rq + 1] + g2 * bfhi(wv.x);
            o[dt][4 * rq + 2] = rl * o[dt][4 * rq + 2] + g2 * bflo(wv.y); o[dt][4 * rq + 3] = rl * o[dt][4 * rq + 3] + g2 * bfhi(wv.y); }
    {
        const float mu = (mc == -INFINITY) ? 0.f : mc, il = lc > 0.f ? g0 * __builtin_amdgcn_rcpf(lc) : 0.f;
        kr = *(const v4u*)(kcs); vr = *(const v4u*)(vcs);
        attn_commit(sh + AT_K0, sh + AT_V0, tid, kr, vr);
        __syncthreads();
#pragma unroll 1
        for (int ct = 0; ct < nct; ++ct) {
            const int cbuf = ct & 1;
            if (ct + 1 < nct) { kr = *(const v4u*)(kcs + (size_t)(64 * (ct + 1)) * 128); vr = *(const v4u*)(vcs + (size_t)(64 * (ct + 1)) * 128); }
            LAS const unsigned char* kb = sh + AT_K0 + cbuf * 8192; LAS const unsigned char* vb = sh + AT_V0 + cbuf * 8192;
            NSA_LOADQ();
            f32x16 t0 = attn_qk(kb, 0, L, qf), t1 = attn_qk(kb, 1, L, qf);
            score_near(t0, t1, L.h, lut, hd, tq - 31 - 1024 * ct, 16, 1 << 30, 255 - 64 * ct, true);
#pragma unroll
            for (int r = 0; r < 16; ++r) { t0[r] = __builtin_amdgcn_exp2f(t0[r] - mu) * il; t1[r] = __builtin_amdgcn_exp2f(t1[r] - mu) * il; }
            attn_pv(vb, 0, L, t0, o); attn_pv(vb, 1, L, t1, o);
            if (ct + 1 < nct) attn_commit(sh + AT_K0 + (cbuf ^ 1) * 8192, sh + AT_V0 + (cbuf ^ 1) * 8192, tid, kr, vr);
            __syncthreads();
        }
    }
    bf16* dst = (bf16*)(A.ws + WS_MIX) + tokq * 1024 + hd * 64;
#pragma unroll
    for (int dt = 0; dt < 2; ++dt)
#pragma unroll
        for (int rq = 0; rq < 4; ++rq) { v2u ov; ov.x = cvtpk(o[dt][4 * rq], o[dt][4 * rq + 1]); ov.y = cvtpk(o[dt][4 * rq + 2], o[dt][4 * rq + 3]); *(v2u*)(dst + 32 * dt + 8 * rq + 4 * L.h) = ov; }
}
#undef NSA_LOADQ

__device__ __forceinline__ v4u pack_f32x8(const float* p) { const f32x4 a = *(const f32x4*)p, b = *(const f32x4*)(p + 4); v4u w; w.x = pk2(a.x, a.y); w.y = pk2(a.z, a.w); w.z = pk2(b.x, b.y); w.w = pk2(b.z, b.w); return w; }
__device__ __forceinline__ void samp_load(const Args& A, int mode, int tile, int b, int g, int srow, int sch, v4u& kr, v4u& vr) {
    const bf16* PROJ = (const bf16*)(A.ws + WS_PROJ);
    kr = (v4u){0, 0, 0, 0}; vr = (v4u){0, 0, 0, 0};
    if (mode == 0) {
        const size_t off = ((size_t)(b * 512 + 64 * tile + srow) * 2 + g) * 64 + sch * 8;
        kr = *(const v4u*)((const bf16*)(A.ws + WS_KCS) + off); vr = *(const v4u*)((const bf16*)(A.ws + WS_VCS) + off);
    } else if (mode == 1) {
        if (tile < 128) { const int page = ((const int*)A.in[5])[b * 64 + (tile >> 1)]; const int row = (tile & 1) * 64 + srow;
            const float* p = A.in[2] + ((size_t)(page * 128 + row) * 4 + 2) * 128 + g * 64 + sch * 8; kr = pack_f32x8(p); vr = pack_f32x8(p + 128); }
        else if (srow < 4) { const bf16* p = PROJ + (size_t)(TP + b * 4 + srow) * NPROJ + C_KV + 2 * 128 + g * 64 + sch * 8; kr = *(const v4u*)p; vr = *(const v4u*)(p + 128); }
    } else {
        const int idx = 64 * tile + srow;
        if (idx < 512) { const float* p = A.in[3] + ((size_t)(b * 512 + idx) * 2) * 128 + g * 64 + sch * 8; kr = pack_f32x8(p); vr = pack_f32x8(p + 128); }
        else if (idx < 516) { const bf16* p = PROJ + (size_t)(TP + b * 4 + idx - 512) * NPROJ + C_WIN + g * 64 + sch * 8; kr = *(const v4u*)p; vr = *(const v4u*)(p + 128); }
    }
}
__device__ __forceinline__ void samp_stage_tile(const Args& A, int mode, int tile, int b, int g, int lane, LAS unsigned char* kb, LAS unsigned char* vb) {
#pragma unroll 1
    for (int i0 = 0; i0 < 8; i0 += 2) {
        v4u kr[2], vr[2];
#pragma unroll
        for (int i = 0; i < 2; ++i) samp_load(A, mode, tile, b, g, (lane >> 3) + 8 * (i0 + i), lane & 7, kr[i], vr[i]);
#pragma unroll
        for (int i = 0; i < 2; ++i) { const int row = (lane >> 3) + 8 * (i0 + i), ch = lane & 7;
            *(LAS v4u*)(kb + row * 128 + ((ch ^ ((row >> 1) & 7)) << 4)) = kr[i];
            *(LAS v4u*)(vb + row * 128 + ((ch ^ (((row >> 1) & 1) << 2)) << 4)) = vr[i]; }
    }
}
__device__ __forceinline__ void samp_unit(const Frame& F, const Args& A, LAS unsigned char* sh, int b, int g) {
    const bf16* PROJ = (const bf16*)(A.ws + WS_PROJ);
    const int lane = hw_lane(), w = F.wave, tid = w * 64 + lane;
    const AttnLane L = attn_lane(lane);
    const bool colok = L.r32 < 16;
    const int qi = (L.r32 >> 2) & 3, hd = g * 4 + (L.r32 & 3);
    const int pos = PAST + qi;
    const size_t tokq = (size_t)TP + b * 4 + qi;
    LAS unsigned char* kb = sh + w * 16384; LAS unsigned char* vb = kb + 8192;
    LAS float* lut = (LAS float*)(sh + AT_LUT);
    LAS float* impA = (LAS float*)(sh + HI_IMPA); LAS float* impB = (LAS float*)(sh + HI_IMPB);
    LAS unsigned long long* selm = (LAS unsigned long long*)(sh + HI_SEL);
    LAS float* scs = (LAS float*)(sh + HI_SCS);
    LAS int* tlist = (LAS int*)(sh + HI_TL);
    LAS float* xch = (LAS float*)(sh + HI_XCH);
    bf16x8 qf[4];
#pragma unroll
    for (int ks = 0; ks < 4; ++ks) qf[ks] = *(const bf16x8*)(PROJ + tokq * NPROJ + C_QN + hd * 64 + 16 * ks + 8 * L.h);
    const float bfar = lut[127 * 8 + hd];
    __syncthreads();
    for (int e = tid; e < 4 * 132; e += NWAVES * 64) { impA[e] = 0.f; impB[e] = 0.f; }
    f32x16 oc[2]; oc[0] = f32x16{}; oc[1] = f32x16{};
    {
        samp_stage_tile(A, 0, w, b, g, lane, kb, vb);
        f32x16 t0 = attn_qk(kb, 0, L, qf), t1 = attn_qk(kb, 1, L, qf);
        score_near(t0, t1, L.h, lut, hd, pos - 31 - 1024 * w, 16, 1 << 30, 511 - 64 * w, colok);
        const float tm = xmax32(fmaxf(max16(t0), max16(t1)));
        xch[(w * 64 + lane) * 4] = tm;
        __syncthreads();
        float M = -INFINITY;
#pragma unroll
        for (int ww = 0; ww < 8; ++ww) M = fmaxf(M, xch[(ww * 64 + lane) * 4]);
        const float mu = (M == -INFINITY) ? 0.f : M;
#pragma unroll
        for (int r = 0; r < 16; ++r) { t0[r] = __builtin_amdgcn_exp2f(t0[r] - mu); t1[r] = __builtin_amdgcn_exp2f(t1[r] - mu); }
        const float ps = xsum32(sum16(t0) + sum16(t1));
        xch[(w * 64 + lane) * 4 + 1] = ps;
        __syncthreads();
        float Lc = 0.f;
#pragma unroll
        for (int ww = 0; ww < 8; ++ww) Lc += xch[(ww * 64 + lane) * 4 + 1];
        const float il = Lc > 0.f ? __builtin_amdgcn_rcpf(Lc) : 0.f;
#pragma unroll
        for (int r = 0; r < 16; ++r) { t0[r] *= il; t1[r] *= il; }
        attn_pv(vb, 0, L, t0, oc); attn_pv(vb, 1, L, t1, oc);
#pragma unroll
        for (int hf = 0; hf < 2; ++hf) {
            float x[16];
#pragma unroll
            for (int r = 0; r < 16; ++r) { float v = hf ? t1[r] : t0[r]; v += __shfl_xor(v, 1); v += __shfl_xor(v, 2); x[r] = v; }
            if ((L.r32 & 3) == 0 && colok) {
#pragma unroll
                for (int rq = 0; rq < 4; ++rq) { const int jq = 16 * w + 8 * hf + 2 * rq + L.h;
                    impA[qi * 132 + jq] = 2.0f * (x[4 * rq] + x[4 * rq + 1] + x[4 * rq + 2]) + x[4 * rq + 3];
                    impB[qi * 132 + jq + 1] = x[4 * rq + 3]; }
            }
        }
    }
    __syncthreads();
    if (w == 0) {
        unsigned long long ulo = 0ull, uhi = 0ull;
#pragma unroll 1
        for (int q = 0; q < 4; ++q) {
            const int j0 = lane, j1 = lane + 64;
            const float s0 = (j0 == 0) ? 1e9f : impA[q * 132 + j0] + impB[q * 132 + j0];
            const float s1 = (j1 == 127) ? 1e9f : impA[q * 132 + j1] + impB[q * 132 + j1];
            scs[j0] = s0; scs[j1] = s1;
            LDS_WAIT(); asm volatile("" ::: "memory");
            int r0 = 0, r1 = 0;
#pragma unroll 8
            for (int jj = 0; jj < 128; ++jj) { const float ov = scs[jj]; r0 += ((ov > s0) || (ov == s0 && jj < j0)) ? 1 : 0; r1 += ((ov > s1) || (ov == s1 && jj < j1)) ? 1 : 0; }
            const unsigned long long mlo = __ballot(r0 < 15), mhi = __ballot(r1 < 15);
            if (lane == 0) { selm[2 * q] = mlo; selm[2 * q + 1] = mhi; }
            ulo |= mlo; uhi |= mhi;
            LDS_WAIT(); asm volatile("" ::: "memory");
        }
        if (lane == 0) { int n = 0; for (int j = 0; j < 64; ++j) if ((ulo >> j) & 1ull) tlist[1 + n++] = j; for (int j = 0; j < 64; ++j) if ((uhi >> j) & 1ull) tlist[1 + n++] = 64 + j; tlist[1 + n++] = 128; tlist[0] = n; }
    }
    __syncthreads();
    const unsigned long long mylo = selm[2 * qi], myhi = selm[2 * qi + 1];
    const int nsel = tlist[0];
    const bf16* gp = PROJ + tokq * NPROJ + C_GT + hd;
    const float g0 = __builtin_amdgcn_rcpf(1.0f + __expf(-bf2f(gp[0]))), g1 = __builtin_amdgcn_rcpf(1.0f + __expf(-bf2f(gp[8]))), g2 = __builtin_amdgcn_rcpf(1.0f + __expf(-bf2f(gp[16])));
#pragma unroll
    for (int r = 0; r < 16; ++r) { oc[0][r] *= g0; oc[1][r] *= g0; }
#pragma unroll 1
    for (int br = 0; br < 2; ++br) {
        const int nt = br == 0 ? nsel : 9;
        float m = -INFINITY, l = 0.f; f32x16 o[2]; o[0] = f32x16{}; o[1] = f32x16{};
#pragma unroll 1
        for (int it = w; it < nt; it += 8) {
            const int j = br == 0 ? tlist[1 + it] : it;
            samp_stage_tile(A, 1 + br, j, b, g, lane, kb, vb);
            f32x16 t0 = attn_qk(kb, 0, L, qf), t1 = attn_qk(kb, 1, L, qf);
            if (br == 0) {
                const bool selj = colok && (j >= 128 ? true : (j < 64 ? ((mylo >> j) & 1ull) : ((myhi >> (j - 64)) & 1ull)));
                if (j <= 125) score_far(t0, t1, selj ? bfar : -INFINITY);
                else score_near(t0, t1, L.h, lut, hd, pos - 64 * j, 1, 1 << 30, 64, selj);
            } else score_near(t0, t1, L.h, lut, hd, pos - (PAST - 512 + 64 * j), 1, 512, 516 - 64 * j, colok);
            attn_softmax_pv(vb, L, t0, t1, m, l, o);
        }
        l = xsum32(l);
        xch[(w * 64 + lane) * 4 + 2] = m; xch[(w * 64 + lane) * 4 + 3] = l;
        __syncthreads();
        float M = -INFINITY;
#pragma unroll
        for (int ww = 0; ww < 8; ++ww) M = fmaxf(M, xch[(ww * 64 + lane) * 4 + 2]);
        float Lt = 0.f;
#pragma unroll
        for (int ww = 0; ww < 8; ++ww) { const float mw = xch[(ww * 64 + lane) * 4 + 2]; Lt += (mw == -INFINITY) ? 0.f : xch[(ww * 64 + lane) * 4 + 3] * __builtin_amdgcn_exp2f(mw - M); }
        const float sc = (m == -INFINITY || !(Lt > 0.f)) ? 0.f : (br == 0 ? g1 : g2) * __builtin_amdgcn_exp2f(m - M) * __builtin_amdgcn_rcpf(Lt);
#pragma unroll
        for (int r = 0; r < 16; ++r) { oc[0][r] += sc * o[0][r]; oc[1][r] += sc * o[1][r]; }
        __syncthreads();
    }
    { LAS float* part = (LAS float*)kb;
#pragma unroll
      for (int r = 0; r < 16; ++r) { part[r * 64 + lane] = oc[0][r]; part[(16 + r) * 64 + lane] = oc[1][r]; } }
    __syncthreads();
    if (w == 0 && colok) {
        float res[32];
#pragma unroll
        for (int r = 0; r < 32; ++r) { float a = 0.f;
#pragma unroll
            for (int ww = 0; ww < 8; ++ww) a += ((LAS const float*)(sh + ww * 16384))[r * 64 + lane];
            res[r] = a; }
        bf16* dst = (bf16*)(A.ws + WS_MIX) + tokq * 1024 + hd * 64;
#pragma unroll
        for (int dt = 0; dt < 2; ++dt)
#pragma unroll
            for (int rq = 0; rq < 4; ++rq) { const int d0 = 32 * dt + 8 * rq + 4 * L.h;
                v2u ov; ov.x = cvtpk(res[16 * dt + 4 * rq], res[16 * dt + 4 * rq + 1]); ov.y = cvtpk(res[16 * dt + 4 * rq + 2], res[16 * dt + 4 * rq + 3]); *(v2u*)(dst + d0) = ov; }
    }
}

__device__ __forceinline__ float gelu_tanh(float x) { const float u = 0.7978845608028654f * (x + 0.044715f * x * x * x); const float t = 1.0f - 2.0f / (1.0f + __expf(2.0f * u)); return 0.5f * x * (1.0f + t); }
constexpr int CM_X = 0, CM_SB = 2064  , CM_H = 32 * CM_SB + 1024, CM_HCOL = 272  , CM_HT = 32 * CM_HCOL, CM_END = CM_H + 4 * CM_HT;
constexpr int NCU_P = 4 * 2 * 2 * 9, NCU_S = 32 * 2 * 2 * 17;
__device__ __forceinline__ int cmp_decode(int u) { if (u < NCU_S) return (1 << 20) | ((u / 68) << 12) | (((u / 34) & 1) << 9) | (((u / 17) & 1) << 8) | (u % 17); const int j = u - NCU_S; return ((j / 36) << 12) | (((j / 18) & 1) << 9) | (((j / 9) & 1) << 8) | (j % 9); }
#define CU_SAMPLE(c) ((c) >> 20)
#define CU_B(c) (((c) >> 12) & 255)
#define CU_SLOT(c) (((c) >> 9) & 1)
#define CU_G(c) (((c) >> 8) & 1)
#define CU_GRP(c) ((c) & 255)
__device__ __forceinline__ void cmp_issue(const Args& A, const int c, int tid, v4u (&R)[16]) {
    if (CU_SAMPLE(c)) {
        const float* cache = A.in[2]; const int* pt = (const int*)A.in[5] + CU_B(c) * 64;
#pragma unroll
        for (int i = 0; i < 16; ++i) { const int q = tid + 512 * i, row = q >> 4, pc = q & 15; int p = 16 * 31 * CU_GRP(c) + row; p = p < PAST ? p : PAST - 1;
            const int page = pt[p >> 7];
            R[i] = *(const v4u*)(cache + ((size_t)(page * 128 + (p & 127)) * 4 + CU_SLOT(c)) * 128 + CU_G(c) * 64 + pc * 4); }
    } else {
        const bf16* PROJ = (const bf16*)(A.ws + WS_PROJ);
#pragma unroll
        for (int i = 0; i < 8; ++i) { const int q = tid + 512 * i, row = q >> 3, pc = q & 7; int p = 16 * 31 * CU_GRP(c) + row; p = p < SEQ ? p : SEQ - 1;
            R[i] = *(const v4u*)(PROJ + ((size_t)CU_B(c) * SEQ + p) * NPROJ + C_KV + CU_SLOT(c) * 128 + CU_G(c) * 64 + pc * 8); }
#pragma unroll
        for (int i = 8; i < 16; ++i) R[i] = (v4u){0u, 0u, 0u, 0u};
    }
}
__device__ __forceinline__ void cmp_commit(LAS unsigned char* sh, const int c, int tid, const v4u (&R)[16]) {
    if (CU_SAMPLE(c)) {
#pragma unroll
        for (int i = 0; i < 16; ++i) { const int q = tid + 512 * i, row = q >> 4, pc = q & 15;
            v2u w; w.x = pk2(__uint_as_float(R[i].x), __uint_as_float(R[i].y)); w.y = pk2(__uint_as_float(R[i].z), __uint_as_float(R[i].w));
            *(LAS v2u*)(sh + CM_X + (row >> 4) * CM_SB + (row & 15) * 128 + pc * 8) = w; }
    } else {
#pragma unroll
        for (int i = 0; i < 8; ++i) { const int q = tid + 512 * i, row = q >> 3, pc = q & 7; *(LAS v4u*)(sh + CM_X + (row >> 4) * CM_SB + (row & 15) * 128 + pc * 16) = R[i]; }
    }
}
__device__ __forceinline__ void cmp_phase(const Frame& F, const Args& A, LAS unsigned char* sh) {
    const int lane = hw_lane(), w = F.wave, tid = w * 64 + lane, r32 = lane & 31, h = lane >> 5;
    const int j = w & 1, ht = (w >> 1) & 1, kh = w >> 2;
    v4u R[16];
    int u = F.vcu;
    if (u >= NCU_S + NCU_P) return;
    int cu = cmp_decode(u);
    cmp_issue(A, cu, tid, R);
    for (;;) {
        __syncthreads();
        cmp_commit(sh, cu, tid, R);
        __syncthreads();
        const int cur = cu;
        const int un = u + F.G; const bool more = un < NCU_S + NCU_P;
        cu = cmp_decode(more ? un : u); cmp_issue(A, cu, tid, R);
        { const bf16* wf = (const bf16*)(A.ws + WS_WC1) + ((size_t)(((CU_SLOT(cur) * 2 + j) * 2 + ht) * 64 + 32 * kh) * 64 + lane) * 8;
          LAS const unsigned char* xb = sh + CM_X + r32 * CM_SB + h * 16;
          f32x16 acc = {};
#pragma unroll 8
          for (int k2 = 0; k2 < 32; ++k2) { const int ks = 32 * kh + k2; const bf16x8 af = *(const bf16x8*)(wf + (size_t)k2 * 512);
              const bf16x8 bf = *(LAS const bf16x8*)(xb + (ks >> 2) * 128 + (ks & 3) * 32);
              acc = __builtin_amdgcn_mfma_f32_32x32x16_bf16(af, bf, acc, 0, 0, 0); }
          LAS unsigned char* hb = sh + CM_H + (j * 2 + kh) * CM_HT + r32 * CM_HCOL + (32 * ht + 4 * h) * 4;
#pragma unroll
          for (int rq = 0; rq < 4; ++rq) *(LAS f32x4*)(hb + 32 * rq) = (f32x4){acc[4 * rq], acc[4 * rq + 1], acc[4 * rq + 2], acc[4 * rq + 3]}; }
        __syncthreads();
        if (w < 2) {
            const float* c1p = (const float*)(A.ws + WS_C1) + CU_SLOT(cur) * 64;
            const bf16* W2 = (const bf16*)(A.ws + WS_WC2) + (size_t)CU_SLOT(cur) * 64 * 64;
            const int i1 = r32 < 31 ? r32 + 1 : 31;
            f32x16 oo = {};
#pragma unroll
            for (int ks = 0; ks < 4; ++ks) {
                const int hid0 = 16 * ks + 8 * h; float xv[8];
#pragma unroll
                for (int e4 = 0; e4 < 2; ++e4) {
                    const f32x4 a0 = *(LAS const f32x4*)(sh + CM_H + 0 * CM_HT + r32 * CM_HCOL + (hid0 + 4 * e4) * 4), a1 = *(LAS const f32x4*)(sh + CM_H + 1 * CM_HT + r32 * CM_HCOL + (hid0 + 4 * e4) * 4);
                    const f32x4 b0 = *(LAS const f32x4*)(sh + CM_H + 2 * CM_HT + i1 * CM_HCOL + (hid0 + 4 * e4) * 4), b1 = *(LAS const f32x4*)(sh + CM_H + 3 * CM_HT + i1 * CM_HCOL + (hid0 + 4 * e4) * 4);
                    const f32x4 cc = *(const f32x4*)(c1p + hid0 + 4 * e4);
#pragma unroll
                    for (int e = 0; e < 4; ++e) xv[4 * e4 + e] = gelu_tanh((a0[e] + a1[e]) + (b0[e] + b1[e]) + cc[e]);
                }
                v4u pw; pw.x = cvtpk(xv[0], xv[1]); pw.y = cvtpk(xv[2], xv[3]); pw.z = cvtpk(xv[4], xv[5]); pw.w = cvtpk(xv[6], xv[7]);
                const bf16x8 af = *(const bf16x8*)(W2 + (size_t)(32 * w + r32) * 64 + hid0);
                oo = __builtin_amdgcn_mfma_f32_32x32x16_bf16(af, __builtin_bit_cast(bf16x8, pw), oo, 0, 0, 0);
            }
            const int nsb = CU_SAMPLE(cur) ? 512 : 256, sb = 31 * CU_GRP(cur) + r32;
            if (r32 < 31 && sb < nsb - 1) {
                bf16* dst = (bf16*)(A.ws + (CU_SAMPLE(cur) ? (CU_SLOT(cur) ? WS_VCS : WS_KCS) : (CU_SLOT(cur) ? WS_VCP : WS_KCP))) + ((size_t)(CU_B(cur) * nsb + sb) * 2 + CU_G(cur)) * 64 + 32 * w + 4 * h;
#pragma unroll
                for (int rq = 0; rq < 4; ++rq) { v2u wv; wv.x = cvtpk(oo[4 * rq], oo[4 * rq + 1]); wv.y = cvtpk(oo[4 * rq + 2], oo[4 * rq + 3]); *(v2u*)(dst + 8 * rq) = wv; }
            }
        }
        if (!more) break;
        u = un;
    }
}

__device__ __forceinline__ float log_sigmoid(float x) { return fminf(x, 0.f) - __logf(1.0f + __expf(-fabsf(x))); }
constexpr int G_QE = 0, G_KE = 8192, G_KDT = 16384, G_V = 24576, G_ST = 40960, G_LR = 73728, G_SEG = 77824, G_DEC = 79872, G_END = 80128;
__device__ __forceinline__ int sw128(int row, int ch) { return row * 128 + ((ch ^ ((row >> 1) & 7)) << 4); }

__device__ __forceinline__ void gla_local(const Frame& F, const Args& A, LAS unsigned char* sh, int unit) {
    const int b = unit >> 6, hh = (unit >> 4) & 3, sc = unit & 15;
    const int lane = hw_lane(), w = F.wave, tid = w * 64 + lane, r32 = lane & 31, h = lane >> 5;
    const bf16* PROJ = (const bf16*)(A.ws + WS_PROJ);
    const size_t tok0 = (size_t)b * SEQ + 256 * sc;
    const int c = lane;
    float wg[16];
#pragma unroll
    for (int r = 0; r < 16; ++r) wg[r] = A.in[13][r * 256 + hh * 64 + c];
    const float bg = A.in[14][hh * 64 + c];
    float Bprev = 0.f;
    const int dvt = w >> 1, it = w & 1;
    f32x16 accS = {};
    const int i16 = lane & 15, tq = i16 >> 2, tp = i16 & 3, g1 = (lane >> 4) & 1;
    const int vcol = ((4 * (dvt ^ tq) + 2 * g1 + (tp >> 1)) << 4) + (tp & 1) * 8;
    __syncthreads();
#pragma unroll 1
    for (int n = 0; n < 4; ++n) {
        const size_t tb = tok0 + 64 * n;
        { const int trow = tid >> 3, pr = tid & 7; const unsigned lw = *(const unsigned*)(PROJ + (tb + trow) * NPROJ + C_LR + 2 * pr);
          LAS float* lr = (LAS float*)(sh + G_LR); lr[trow * 16 + 2 * pr] = bflo(lw); lr[trow * 16 + 2 * pr + 1] = bfhi(lw);
#pragma unroll
          for (int k2 = 0; k2 < 2; ++k2) { const int ch = pr * 2 + k2; const v4u vv = *(const v4u*)(PROJ + (tb + trow) * NPROJ + C_VG + hh * 128 + ch * 8);
              *(LAS v4u*)(sh + G_V + trow * 256 + ((ch ^ ((trow & 3) << 2)) << 4)) = vv; } }
        __syncthreads();
        float cum[8], qv[8], kv[8];
        { LAS const float* lr = (LAS const float*)(sh + G_LR); float run = 0.f;
#pragma unroll
          for (int k = 0; k < 8; ++k) { const int i = 8 * w + k; float x = bg;
#pragma unroll
              for (int r = 0; r < 16; ++r) x += lr[i * 16 + r] * wg[r];
              run += log_sigmoid(x) * (1.0f / 16.0f); cum[k] = run;
              qv[k] = 0.125f * bf2f(PROJ[(tb + i) * NPROJ + C_QG + hh * 64 + c]); kv[k] = bf2f(PROJ[(tb + i) * NPROJ + C_KG + hh * 64 + c]); }
          ((LAS float*)(sh + G_SEG))[w * 64 + c] = run; }
        __syncthreads();
        { LAS const float* seg = (LAS const float*)(sh + G_SEG); float pre = 0.f, tot = 0.f;
#pragma unroll
          for (int g_ = 0; g_ < 8; ++g_) { const float sv = seg[g_ * 64 + c]; tot += sv; if (g_ < w) pre += sv; }
          const float eB = __expf(Bprev);
          unsigned kdw[4];
#pragma unroll
          for (int k = 0; k < 8; ++k) { const int i = 8 * w + k; const float bb = pre + cum[k];
              const float qe = qv[k] * __expf(bb), ke = kv[k] * __expf(-bb), kd = kv[k] * __expf(tot - bb);
              *(LAS unsigned short*)(sh + G_QE + sw128(i, c >> 3) + (c & 7) * 2) = (unsigned short)f2bf(qe);
              *(LAS unsigned short*)(sh + G_KE + sw128(i, c >> 3) + (c & 7) * 2) = (unsigned short)f2bf(ke);
              ((bf16*)(A.ws + WS_QB))[(tb + i) * 256 + hh * 64 + c] = (bf16)f2bf(qe * eB);
              if (k & 1) kdw[k >> 1] |= f2bf(kd) << 16; else kdw[k >> 1] = f2bf(kd); }
          *(LAS v4u*)(sh + G_KDT + sw128(c, w)) = (v4u){kdw[0], kdw[1], kdw[2], kdw[3]};
          if (w == 0) ((LAS float*)(sh + G_DEC))[c] = __expf(tot);
          Bprev += tot; }
        __syncthreads();
        LAS const unsigned char* qeb = sh + G_QE; LAS const unsigned char* keb = sh + G_KE; LAS const unsigned char* vbase = sh + G_V;
        bf16x8 qfr[4];
#pragma unroll
        for (int ks = 0; ks < 4; ++ks) qfr[ks] = *(LAS const bf16x8*)(qeb + sw128(32 * it + r32, 2 * ks + h));
        f32x16 oT = {};
#pragma unroll
        for (int jt = 0; jt < 2; ++jt) {
            if (jt <= it) {
                f32x16 s = {};
#pragma unroll
                for (int ks = 0; ks < 4; ++ks) { const bf16x8 kf = *(LAS const bf16x8*)(keb + sw128(32 * jt + r32, 2 * ks + h)); s = __builtin_amdgcn_mfma_f32_32x32x16_bf16(kf, qfr[ks], s, 0, 0, 0); }
                if (jt == it) {
#pragma unroll
                    for (int r = 0; r < 16; ++r) { const int j = (r & 3) + 8 * (r >> 2) + 4 * h; if (j > r32) s[r] = 0.f; }
                }
#pragma unroll
                for (int s2 = 0; s2 < 2; ++s2) {
                    v4u pw; pw.x = cvtpk(s[8 * s2], s[8 * s2 + 1]); pw.y = cvtpk(s[8 * s2 + 2], s[8 * s2 + 3]); pw.z = cvtpk(s[8 * s2 + 4], s[8 * s2 + 5]); pw.w = cvtpk(s[8 * s2 + 6], s[8 * s2 + 7]);
                    const int row = 32 * jt + 16 * s2 + 4 * h + tq;
                    const s16x4 lo = vtr(vbase + row * 256 + vcol), hi = vtr(vbase + (row + 8) * 256 + vcol);
                    const bf16x8 vf = {lo[0], lo[1], lo[2], lo[3], hi[0], hi[1], hi[2], hi[3]};
                    oT = __builtin_amdgcn_mfma_f32_32x32x16_bf16(vf, __builtin_bit_cast(bf16x8, pw), oT, 0, 0, 0);
                }
            }
        }
        if (n > 0) {
            LAS const unsigned char* stb = sh + G_ST + (n & 1) * 16384;
#pragma unroll
            for (int ks = 0; ks < 4; ++ks) { const bf16x8 sf = *(LAS const bf16x8*)(stb + sw128(32 * dvt + r32, 2 * ks + h)); oT = __builtin_amdgcn_mfma_f32_32x32x16_bf16(sf, qfr[ks], oT, 0, 0, 0); }
        }
        { float* op = (float*)(A.ws + WS_OLOC) + (tb + 32 * it + r32) * 512 + hh * 128 + 32 * dvt + 4 * h;
#pragma unroll
          for (int rq = 0; rq < 4; ++rq) *(f32x4*)(op + 8 * rq) = (f32x4){oT[4 * rq], oT[4 * rq + 1], oT[4 * rq + 2], oT[4 * rq + 3]}; }
        { const float dec = ((LAS const float*)(sh + G_DEC))[32 * it + r32];
#pragma unroll
          for (int r = 0; r < 16; ++r) accS[r] *= dec;
#pragma unroll
          for (int ks = 0; ks < 4; ++ks) {
              const bf16x8 kdf = *(LAS const bf16x8*)(sh + G_KDT + sw128(32 * it + r32, 2 * ks + h));
              const int row = 16 * ks + 8 * h + tq;
              const s16x4 lo = vtr(vbase + row * 256 + vcol), hi = vtr(vbase + (row + 4) * 256 + vcol);
              const bf16x8 vf = {lo[0], lo[1], lo[2], lo[3], hi[0], hi[1], hi[2], hi[3]};
              accS = __builtin_amdgcn_mfma_f32_32x32x16_bf16(vf, kdf, accS, 0, 0, 0);
          }
          LAS unsigned char* stn = sh + G_ST + ((n + 1) & 1) * 16384; const int d = 32 * it + r32;
#pragma unroll
          for (int r = 0; r < 16; ++r) { const int dv = 32 * dvt + (r & 3) + 8 * (r >> 2) + 4 * h; *(LAS unsigned short*)(stn + sw128(dv, d >> 3) + (d & 7) * 2) = (unsigned short)f2bf(accS[r]); } }
        __syncthreads();
    }
    { float* up = (float*)(A.ws + WS_USC) + (size_t)unit * 8192; const int d = 32 * it + r32;
#pragma unroll
      for (int r = 0; r < 16; ++r) { const int dv = 32 * dvt + (r & 3) + 8 * (r >> 2) + 4 * h; up[dv * 64 + d] = accS[r]; }
      if (w == 0) ((float*)(A.ws + WS_DSC))[unit * 64 + c] = __expf(Bprev); }
}

__device__ __forceinline__ void gla_out(const Frame& F, const Args& A, LAS unsigned char* sh, int unit) {
    const int b = unit >> 6, hh = (unit >> 4) & 3, sc = unit & 15;
    const int lane = hw_lane(), w = F.wave, tid = w * 64 + lane, r32 = lane & 31, h = lane >> 5;
    const bf16* PROJ = (const bf16*)(A.ws + WS_PROJ);
    const size_t tok0 = (size_t)b * SEQ + 256 * sc;
    const int d4 = (tid & 15) * 4, dvr = tid >> 4;
    f32x4 S[4];
#pragma unroll
    for (int k = 0; k < 4; ++k) S[k] = (f32x4){0.f, 0.f, 0.f, 0.f};
    const float* U0 = (const float*)(A.ws + WS_USC) + (size_t)(unit - sc) * 8192; const float* D0 = (const float*)(A.ws + WS_DSC) + (size_t)(unit - sc) * 64;
#pragma unroll 1
    for (int s = 0; s < sc; ++s) { const f32x4 dd = *(const f32x4*)(D0 + s * 64 + d4);
#pragma unroll
        for (int k = 0; k < 4; ++k) { const f32x4 u = *(const f32x4*)(U0 + (size_t)s * 8192 + (32 * k + dvr) * 64 + d4); S[k] = S[k] * dd + u; } }
    __syncthreads();
#pragma unroll
    for (int k = 0; k < 4; ++k) { const int dv = 32 * k + dvr; v2u wv; wv.x = pk2(S[k].x, S[k].y); wv.y = pk2(S[k].z, S[k].w);
        *(LAS v2u*)(sh + sw128(dv, d4 >> 3) + (d4 & 7) * 2) = wv; }
    if (sc == 15) {
        const f32x4 dd = *(const f32x4*)(D0 + 15 * 64 + d4); float* op = A.out + O_GLAP + (size_t)(b * 4 + hh) * 8192;
#pragma unroll
        for (int k = 0; k < 4; ++k) { const int dv = 32 * k + dvr; const f32x4 u = *(const f32x4*)(U0 + (size_t)15 * 8192 + dv * 64 + d4); const f32x4 e = S[k] * dd + u;
            op[(d4 + 0) * 128 + dv] = e.x; op[(d4 + 1) * 128 + dv] = e.y; op[(d4 + 2) * 128 + dv] = e.z; op[(d4 + 3) * 128 + dv] = e.w; }
    }
    __syncthreads();
    const size_t tok = tok0 + 32 * w + r32;
    f32x16 acc[4];
#pragma unroll
    for (int t = 0; t < 4; ++t) acc[t] = f32x16{};
#pragma unroll
    for (int ks = 0; ks < 4; ++ks) { const bf16x8 qb = *(const bf16x8*)((const bf16*)(A.ws + WS_QB) + tok * 256 + hh * 64 + 16 * ks + 8 * h);
#pragma unroll
        for (int t = 0; t < 4; ++t) { const bf16x8 sf = *(LAS const bf16x8*)(sh + sw128(32 * t + r32, 2 * ks + h)); acc[t] = __builtin_amdgcn_mfma_f32_32x32x16_bf16(sf, qb, acc[t], 0, 0, 0); } }
    const float* ol = (const float*)(A.ws + WS_OLOC) + tok * 512 + hh * 128;
    float ss = 0.f;
#pragma unroll
    for (int t = 0; t < 4; ++t)
#pragma unroll
        for (int rq = 0; rq < 4; ++rq) { const f32x4 v = *(const f32x4*)(ol + 32 * t + 8 * rq + 4 * h);
#pragma unroll
            for (int e = 0; e < 4; ++e) { acc[t][4 * rq + e] += v[e]; ss += acc[t][4 * rq + e] * acc[t][4 * rq + e]; } }
    ss += __shfl_xor(ss, 32);
    const float rstd = 1.0f / sqrtf(ss * (1.0f / 128.0f) + EPS);
    const float* gn = A.in[15]; const bf16* gg = PROJ + tok * NPROJ + C_GG + hh * 128;
    bf16* dst = (bf16*)(A.ws + WS_MIX) + tok * 1024 + 512 + hh * 128;
#pragma unroll
    for (int t = 0; t < 4; ++t)
#pragma unroll
        for (int rq = 0; rq < 4; ++rq) { const int dv0 = 32 * t + 8 * rq + 4 * h; const f32x4 gnv = *(const f32x4*)(gn + dv0); const v2u gw = *(const v2u*)(gg + dv0);
            const float gv[4] = {bflo(gw.x), bfhi(gw.x), bflo(gw.y), bfhi(gw.y)}; float y[4];
#pragma unroll
            for (int e = 0; e < 4; ++e) y[e] = acc[t][4 * rq + e] * rstd * gnv[e] * gv[e] * __builtin_amdgcn_rcpf(1.0f + __expf(-gv[e]));
            v2u ov; ov.x = cvtpk(y[0], y[1]); ov.y = cvtpk(y[2], y[3]); *(v2u*)(dst + dv0) = ov; }
}

__device__ __forceinline__ void gla_sample(const Frame& F, const Args& A, LAS unsigned char* sh, int unit) {
    const int b = unit >> 2, hh = unit & 3, tid = F.wave * 64 + hw_lane();
    const bf16* PROJ = (const bf16*)(A.ws + WS_PROJ);
    LAS float* la = (LAS float*)sh;
    LAS float* qs = la + 256;
    LAS float* ks = qs + 256;
    LAS float* op = ks + 256;
    LAS float* of = op + 2048;
    __syncthreads();
    if (tid < 256) { const int t = tid >> 6, c = tid & 63; const size_t tok = (size_t)TP + b * 4 + t; float x = A.in[14][hh * 64 + c];
#pragma unroll
        for (int r = 0; r < 16; ++r) x += bf2f(PROJ[tok * NPROJ + C_LR + r]) * A.in[13][r * 256 + hh * 64 + c];
        la[tid] = __expf(log_sigmoid(x) * (1.0f / 16.0f)); qs[tid] = 0.125f * bf2f(PROJ[tok * NPROJ + C_QG + hh * 64 + c]); ks[tid] = bf2f(PROJ[tok * NPROJ + C_KG + hh * 64 + c]); }
    __syncthreads();
    const int dv = tid & 127, cg = tid >> 7;
    const float* s0 = A.in[4] + (size_t)(b * 4 + hh) * 8192;
    float S[16];
#pragma unroll
    for (int k = 0; k < 16; ++k) S[k] = s0[(16 * cg + k) * 128 + dv];
#pragma unroll
    for (int t = 0; t < 4; ++t) { const float vv = bf2f(PROJ[((size_t)TP + b * 4 + t) * NPROJ + C_VG + hh * 128 + dv]); float o = 0.f;
#pragma unroll
        for (int k = 0; k < 16; ++k) { const int c = 16 * cg + k; S[k] = la[t * 64 + c] * S[k] + ks[t * 64 + c] * vv; o += qs[t * 64 + c] * S[k]; }
        op[(cg * 4 + t) * 128 + dv] = o; }
    float* so = A.out + O_GLAS + (size_t)(b * 4 + hh) * 8192;
#pragma unroll
    for (int k = 0; k < 16; ++k) so[(16 * cg + k) * 128 + dv] = S[k];
    __syncthreads();
    { const int t = tid >> 7; of[t * 128 + dv] = (op[(0 * 4 + t) * 128 + dv] + op[(1 * 4 + t) * 128 + dv]) + (op[(2 * 4 + t) * 128 + dv] + op[(3 * 4 + t) * 128 + dv]); }
    __syncthreads();
    { const int t = tid >> 7; float ss = 0.f;
      for (int k = 0; k < 128; ++k) { const float v = of[t * 128 + k]; ss += v * v; }
      const float rstd = 1.0f / sqrtf(ss * (1.0f / 128.0f) + EPS); const size_t tok = (size_t)TP + b * 4 + t;
      const float gv = bf2f(PROJ[tok * NPROJ + C_GG + hh * 128 + dv]);
      const float y = of[t * 128 + dv] * rstd * A.in[15][dv] * gv * __builtin_amdgcn_rcpf(1.0f + __expf(-gv));
      ((bf16*)(A.ws + WS_MIX))[tok * 1024 + 512 + hh * 128 + dv] = (bf16)f2bf(y); }
}

#ifdef PROBE_PHASE
#define PREP(k) ((PROBE_PHASE) == (k) ? 2 : 1)
#else
#define PREP(k) 1
#endif
__device__ __forceinline__ void phase2(const Frame& F, const Args& A) {
    LAS unsigned char* sh = F.lds;
#ifndef SKIP_CMP
    _Pragma("unroll 1") for (int rep = 0; rep < PREP(21); ++rep) cmp_phase(F, A, sh);
#endif
    #ifndef SKIP_GLAL
    _Pragma("unroll 1") for (int rep = 0; rep < PREP(22); ++rep) for (int u = F.vcu; u < 256; u += F.G) gla_local(F, A, sh, u);
#endif
    #ifndef SKIP_GLAS
    _Pragma("unroll 1") for (int rep = 0; rep < PREP(24); ++rep) for (int u = F.vcu; u < 128; u += F.G) gla_sample(F, A, sh, u);
#endif
    __syncthreads();
    attn_fill_lut((LAS float*)(sh + AT_LUT), A.in[24], F.tid);
    __syncthreads();
    _Pragma("unroll 1") for (int rep = 0; rep < PREP(23); ++rep) for (int p = F.vcu; p < 256; p += F.G) { const int bg = p >> 5, s = p & 31;
#ifndef SKIP_WIN
 win_unit(F, A, sh, bg >> 1, bg & 1, 63 - s); win_unit(F, A, sh, bg >> 1, bg & 1, s);
#endif
 }
}
__device__ __forceinline__ void phase3(const Frame& F, const Args& A) {
    LAS unsigned char* sh = F.lds;
    #ifndef SKIP_GLAO
    _Pragma("unroll 1") for (int rep = 0; rep < PREP(31); ++rep) for (int u = F.vcu; u < 256; u += F.G) gla_out(F, A, sh, u);
#endif
    __syncthreads();
    attn_fill_lut((LAS float*)(sh + AT_LUT), A.in[24], F.tid);
    __syncthreads();
    { gu32* qh = (gu32*)(A.ws + WS_CTL) + CW_Q3 + 64 * (F.vcu >> 5); LAS int* slot = (LAS int*)(sh + HI_Q);
      const int bg = (F.vcu >> 5) & 7;
      for (;;) {
          __syncthreads();
          if (F.wave == 0 && hw_lane() == 0) *slot = (int)__hip_atomic_fetch_add(qh, 1u, __ATOMIC_RELAXED, __HIP_MEMORY_SCOPE_AGENT);
          __syncthreads();
          const int idx = *slot;
          if (idx >= 72 * PREP(33)) break;
          const int k = idx % 72;
          if (k < 8) {
#ifndef SKIP_SAMP
              const int u = bg * 8 + k; samp_unit(F, A, sh, u >> 1, u & 1);
#endif
          } else {
#ifndef SKIP_NSA
              nsa_unit(F, A, sh, bg >> 1, bg & 1, 71 - k);
#endif
          }
      } }
}

template <class Epi>
__device__ __forceinline__ void skinny_phase(const Frame& F, const bf16* Act, int lda, const bf16* Bt, int K, int ncolgrp, const Epi& E) {
    const int lane = hw_lane(), w = F.wave, c16 = lane & 15, kg = lane >> 4;
    const int tg = w & 1, kq = w >> 1, kq_len = K / 4;
    LAS f32x4* xs = (LAS f32x4*)F.lds;
    for (int job = blockIdx.x; job < 4 * ncolgrp; job += F.G) {
        const int cg = job >> 2, tok = TP + 32 * (job & 3) + 16 * tg + c16;
        const bf16* ap = Bt + (size_t)(16 * cg + c16) * K + kq * kq_len + 8 * kg;
        const bf16* bp = Act + (size_t)tok * lda + kq * kq_len + 8 * kg;
        f32x4 acc = {0.f, 0.f, 0.f, 0.f};
#pragma unroll 8
        for (int ks = 0; ks < kq_len / 32; ++ks) { const bf16x8 af = *(const bf16x8*)(ap + 32 * ks), bf = *(const bf16x8*)(bp + 32 * ks); acc = __builtin_amdgcn_mfma_f32_16x16x32_bf16(af, bf, acc, 0, 0, 0); }
        __syncthreads();
        xs[w * 64 + lane] = acc;
        __syncthreads();
        if (kq == 0) { const f32x4 v = (xs[tg * 64 + lane] + xs[(2 + tg) * 64 + lane]) + (xs[(4 + tg) * 64 + lane] + xs[(6 + tg) * 64 + lane]); E(v, tok, 16 * cg + 4 * kg, kg); }
    }
}
struct SkInProj { bf16* proj; float* out;
    __device__ __forceinline__ void operator()(f32x4 v, int tok, int col, int kg) const {
        if (col < 512) v = v * 0.125f;
        v2u w; w.x = cvtpk(v[0], v[1]); w.y = cvtpk(v[2], v[3]); *(v2u*)(proj + (size_t)tok * NPROJ + col) = w;
        if (col >= C_KV && col < C_WIN) *(f32x4*)(out + O_KV + (size_t)tok * 512 + (col - C_KV)) = v;
        else if (col >= C_WIN && col < C_GT) { const int rs = tok - TP, b = rs >> 2, i = rs & 3; *(f32x4*)(out + O_WINS + ((size_t)(b * 512 + 508 + i) * 256 + (col - C_WIN))) = v; }
    } };
struct SkResid { const float* base; float* hout; bf16* hb; float* rowss;
    __device__ __forceinline__ void operator()(f32x4 v, int tok, int col, int kg) const {
        v = v + *(const f32x4*)(base + (size_t)(tok - TP) * 1024 + col);
        *(f32x4*)(hout + (size_t)tok * 1024 + col) = v;
        v2u w; w.x = cvtpk(v[0], v[1]); w.y = cvtpk(v[2], v[3]); *(v2u*)(hb + (size_t)tok * 1024 + col) = w;
        float ss = (v[0] * v[0] + v[1] * v[1]) + (v[2] * v[2] + v[3] * v[3]); ss += __shfl_xor(ss, 16); ss += __shfl_xor(ss, 32);
        if (kg == 0) atomicAdd(rowss + tok, ss);
    } };
struct SkBf { bf16* O; int ldc;
    __device__ __forceinline__ void operator()(f32x4 v, int tok, int col, int kg) const { v2u w; w.x = cvtpk(v[0], v[1]); w.y = cvtpk(v[2], v[3]); *(v2u*)(O + (size_t)tok * ldc + col) = w; } };
struct SkPleGate { const float* h2; const bf16* ple; const float* rowss2; float* y; float* rowss3;
    __device__ __forceinline__ void operator()(f32x4 a, int tok, int col, int kg) const {
        const float rstd = __builtin_amdgcn_rsqf(rowss2[tok] * (1.0f / 1024.0f) + EPS);
        const v2u pw = *(const v2u*)(ple + (size_t)tok * 1024 + col); const f32x4 b = *(const f32x4*)(h2 + (size_t)tok * 1024 + col);
        const float pv[4] = {bflo(pw.x), bfhi(pw.x), bflo(pw.y), bfhi(pw.y)}; f32x4 v;
#pragma unroll
        for (int e = 0; e < 4; ++e) v[e] = b[e] + pv[e] * __builtin_amdgcn_rcpf(1.0f + __expf(-a[e] * rstd));
        *(f32x4*)(y + (size_t)tok * 1024 + col) = v;
        float ss = (v[0] * v[0] + v[1] * v[1]) + (v[2] * v[2] + v[3] * v[3]); ss += __shfl_xor(ss, 16); ss += __shfl_xor(ss, 32);
        if (kg == 0) atomicAdd(rowss3 + tok, ss);
    } };

typedef const __attribute__((address_space(4))) Args* ArgsP;
__device__ __forceinline__ Args load_args() {
    Args r{};
#if defined(__HIP_DEVICE_COMPILE__)
    ArgsP p = (ArgsP)__builtin_amdgcn_kernarg_segment_ptr(); asm volatile("" : "+s"(p));
#pragma unroll
    for (int i = 0; i < 26; ++i) r.in[i] = p->in[i];
    r.out = p->out; r.ws = p->ws; r.ph_lo = p->ph_lo; r.ph_hi = p->ph_hi;
#endif
    return r;
}
__global__ void __launch_bounds__(NWAVES * 64, 2) mega_fwd(Args args_unused) {
    extern __shared__ __attribute__((aligned(16))) unsigned char lds_raw[];
    Frame F;
    F.lds = (LAS unsigned char*)lds_raw;
    F.wave = __builtin_amdgcn_readfirstlane((int)threadIdx.x >> 6); F.lane = hw_lane(); F.tid = F.wave * 64 + F.lane;
    F.G = gridDim.x; { const int bx = blockIdx.x; F.vcu = (F.G % 8 == 0) ? (bx % 8) * (F.G / 8) + bx / 8 : bx; }
    int lo, hi; unsigned char* ws;
    { const Args a0 = load_args(); lo = a0.ph_lo; hi = a0.ph_hi; ws = a0.ws; }
    gu32* ctl = (gu32*)(ws + WS_CTL);
    volatile LAS unsigned* MISC = (volatile LAS unsigned*)(F.lds + MISC_OFF);
    for (int u = F.tid; u < (LDS_BYTES - RING_BYTES) / 4; u += NWAVES * 64) ((LAS unsigned*)(F.lds + RING_BYTES))[u] = 0u;
    __syncthreads();
    const bool multi = (hi - lo) > 1;
    XcdBarrier bar; bar.bar = (unsigned*)(ctl + CW_BAR); bar.x = 0; bar.st = nullptr;
    if (multi) bar = xcd_barrier_post((unsigned*)(ctl + CW_BAR), MISC + 8, F.tid);
#define IN(k) (lo <= (k) && (k) < hi)
#ifdef PROBE_PHASE
#define NREP(k) ((PROBE_PHASE) == (k) ? 2 : 1)
#else
#define NREP(k) 1
#endif
    float* dummy_rowss = (float*)(ws + WS_END);
#define SEAM(k) do { if (IN(k) && IN((k) + 1)) { F.lane = hw_lane(); F.tid = F.wave * 64 + F.lane; xcd_barrier(bar, F.tid); } } while (0)
#define REFRESH() do { F.lane = hw_lane(); F.tid = F.wave * 64 + F.lane; } while (0)

    if (IN(0)) { REFRESH(); const Args args = load_args(); _Pragma("unroll 1") for (int rep = 0; rep < NREP(0); ++rep) { __syncthreads(); p0_prologue(F, args); } } SEAM(0);
    if (IN(1)) { REFRESH(); const Args args = load_args(); unsigned char* ws = args.ws;
        pg8::Gemm g{(const pg8::bf16_t*)(ws + WS_XN), (const pg8::bf16_t*)(ws + WS_WIN), TP, NPROJ, 1024}; pg8::StaticOrder S; S.init(TP, NPROJ, F.G, (int)blockIdx.x);
        pg8::EpiInProj E{(pg8::bf16_t*)(ws + WS_PROJ), args.out};
        _Pragma("unroll 1") for (int rep = 0; rep < NREP(1); ++rep) pg8::gemm_phase<pg8::EpiInProj, pg8::StaticOrder, true, true>(F.lds, g, S, E, F.tid);
        skinny_phase(F, (const bf16*)(ws + WS_XN), 1024, (const bf16*)(ws + WS_WIN), 1024, (NIN + 15) / 16, SkInProj{(bf16*)(ws + WS_PROJ), args.out});
    } SEAM(1);
    if (IN(2)) { REFRESH(); const Args args = load_args(); phase2(F, args); } SEAM(2);
    if (IN(3)) { REFRESH(); const Args args = load_args(); phase3(F, args); } SEAM(3);
    if (IN(4)) { REFRESH(); const Args args = load_args(); unsigned char* ws = args.ws; float* rowss1 = (float*)(ws + WS_ROWSS);
        { pg8::Gemm g{(const pg8::bf16_t*)(ws + WS_MIX), (const pg8::bf16_t*)(ws + WS_WO), TP, 1024, 1024}; pg8::StaticOrder S; S.init(TP, 1024, F.G, (int)blockIdx.x);
          _Pragma("unroll 1") for (int rep = 0; rep < NREP(4); ++rep) { pg8::EpiResid E{args.in[0], args.in[1], (float*)(ws + WS_H1), (pg8::bf16_t*)(ws + WS_H1B), rep ? dummy_rowss : rowss1};
          pg8::gemm_phase<pg8::EpiResid, pg8::StaticOrder, true, true>(F.lds, g, S, E, F.tid); } }
        { pg8::Gemm g{(const pg8::bf16_t*)(ws + WS_PPLE), (const pg8::bf16_t*)(ws + WS_WPLE), TP, 1024, 256}; pg8::StaticOrder S; S.init(TP, 1024, F.G, (int)blockIdx.x);
          pg8::EpiBf E{(pg8::bf16_t*)(ws + WS_PLEB), 1024};
          _Pragma("unroll 1") for (int rep = 0; rep < NREP(41); ++rep) pg8::gemm_phase<pg8::EpiBf, pg8::StaticOrder, true, true>(F.lds, g, S, E, F.tid); }
        skinny_phase(F, (const bf16*)(ws + WS_MIX), 1024, (const bf16*)(ws + WS_WO), 1024, 64, SkResid{args.in[1], (float*)(ws + WS_H1), (bf16*)(ws + WS_H1B), rowss1});
        skinny_phase(F, (const bf16*)(ws + WS_PPLE), 256, (const bf16*)(ws + WS_WPLE), 256, 64, SkBf{(bf16*)(ws + WS_PLEB), 1024});
    } SEAM(4);
    if (IN(5)) { REFRESH(); const Args args = load_args(); unsigned char* ws = args.ws; float* rowss1 = (float*)(ws + WS_ROWSS);
        pg8::Gemm g{(const pg8::bf16_t*)(ws + WS_H1B), (const pg8::bf16_t*)(ws + WS_WGU), MPAD, NGU, 1024}; pg8::StaticOrder S; S.init(MPAD, NGU, F.G, (int)blockIdx.x);
        pg8::EpiGateUp E{(pg8::bf16_t*)(ws + WS_ACT), rowss1};
        _Pragma("unroll 1") for (int rep = 0; rep < NREP(5); ++rep) pg8::gemm_phase<pg8::EpiGateUp, pg8::StaticOrder, true, true>(F.lds, g, S, E, F.tid);
    } SEAM(5);
    if (IN(6)) { REFRESH(); const Args args = load_args(); unsigned char* ws = args.ws; float* rowss2 = (float*)(ws + WS_ROWSS) + MPAD;
        pg8::Gemm g{(const pg8::bf16_t*)(ws + WS_ACT), (const pg8::bf16_t*)(ws + WS_WDN), TP, 1024, DFF}; pg8::StaticOrder S; S.init(TP, 1024, F.G, (int)blockIdx.x);
        _Pragma("unroll 1") for (int rep = 0; rep < NREP(6); ++rep) { pg8::EpiResid E{(const float*)(ws + WS_H1), (const float*)(ws + WS_H1) + (size_t)TP * 1024, (float*)(ws + WS_H2), (pg8::bf16_t*)(ws + WS_H2B), rep ? dummy_rowss : rowss2};
        pg8::gemm_phase<pg8::EpiResid, pg8::StaticOrder, true, true>(F.lds, g, S, E, F.tid); }
        skinny_phase(F, (const bf16*)(ws + WS_ACT), DFF, (const bf16*)(ws + WS_WDN), DFF, 64, SkResid{(const float*)(ws + WS_H1) + (size_t)TP * 1024, (float*)(ws + WS_H2), (bf16*)(ws + WS_H2B), rowss2});
    } SEAM(6);
    if (IN(7)) { REFRESH(); const Args args = load_args(); unsigned char* ws = args.ws; float* rowss2 = (float*)(ws + WS_ROWSS) + MPAD; float* rowss3 = rowss2 + MPAD;
        pg8::Gemm g{(const pg8::bf16_t*)(ws + WS_H2B), (const pg8::bf16_t*)(ws + WS_WPG), TP, 1024, 1024}; pg8::StaticOrder S; S.init(TP, 1024, F.G, (int)blockIdx.x);
        _Pragma("unroll 1") for (int rep = 0; rep < NREP(7); ++rep) { pg8::EpiPleGate E{(const float*)(ws + WS_H2), (const pg8::bf16_t*)(ws + WS_PLEB), rowss2, args.out + O_Y, rep ? dummy_rowss : rowss3};
        pg8::gemm_phase<pg8::EpiPleGate, pg8::StaticOrder, true, true>(F.lds, g, S, E, F.tid); }
        skinny_phase(F, (const bf16*)(ws + WS_H2B), 1024, (const bf16*)(ws + WS_WPG), 1024, 64, SkPleGate{(const float*)(ws + WS_H2), (const bf16*)(ws + WS_PLEB), rowss2, args.out + O_Y, rowss3});
    } SEAM(7);
    if (IN(8)) { REFRESH(); const Args args = load_args(); unsigned char* ws = args.ws; float* rowss3 = (float*)(ws + WS_ROWSS) + 2 * MPAD;
        const int gw = F.vcu * NWAVES + F.wave, NGW = F.G * NWAVES; const GAS f32x4* gr = (const GAS f32x4*)args.in[25] + F.lane;
        for (int m = gw; m < MTOT; m += NGW) { GAS f32x4* yr = (GAS f32x4*)(args.out + O_Y + (size_t)m * 1024) + F.lane; const float rstd = 1.0f / sqrtf(rowss3[m] * (1.0f / 1024.0f) + EPS);
#pragma unroll
            for (int j = 0; j < 4; ++j) { const f32x4 v = yr[64 * j], gg = gr[64 * j]; yr[64 * j] = (f32x4){v.x * rstd * gg.x, v.y * rstd * gg.y, v.z * rstd * gg.z, v.w * rstd * gg.w}; } }
    }
#undef IN
#undef SEAM
#undef REFRESH
}

extern "C" void kernel_launch(void* const* d_in, const int* in_sizes, int n_in, void* d_out, int out_size, void* d_ws, size_t ws_size, hipStream_t stream) {
    static int grid = 0;
    if (grid == 0) {
        if (n_in != 26 || (size_t)out_size != O_END || ws_size < WS_END + (1u << 20)) { fprintf(stderr, "kernel_launch: unexpected shapes: n_in %d out %d ws %zu\n", n_in, out_size, ws_size); grid = -1; return; }
        int dev = 0, cus = 0, per_cu = 0;
        if (hipGetDevice(&dev) != hipSuccess || hipDeviceGetAttribute(&cus, hipDeviceAttributeMultiprocessorCount, dev) != hipSuccess) { grid = -1; return; }
        if (hipFuncSetAttribute((const void*)mega_fwd, hipFuncAttributeMaxDynamicSharedMemorySize, LDS_BYTES) != hipSuccess) { fprintf(stderr, "kernel_launch: hipFuncSetAttribute failed\n"); grid = -1; return; }
        if (hipOccupancyMaxActiveBlocksPerMultiprocessor(&per_cu, (const void*)mega_fwd, NWAVES * 64, LDS_BYTES) != hipSuccess || per_cu < 1) { fprintf(stderr, "kernel_launch: occupancy query says %d blocks per CU\n", per_cu); grid = -1; return; }
        (void)hipGetLastError();
        grid = cus;
    }
    if (grid < 0) return;
    (void)hipMemsetAsync((char*)d_ws + WS_CTL, 0, CTL_ZERO_BYTES, stream);
    Args a{};
    for (int i = 0; i < 26; ++i) a.in[i] = (const float*)d_in[i];
    a.out = (float*)d_out; a.ws = (unsigned char*)d_ws;
#ifndef N_LAUNCH_SPLIT
    a.ph_lo = 0; a.ph_hi = 9;
    hipLaunchKernelGGL(mega_fwd, dim3(grid), dim3(NWAVES * 64), LDS_BYTES, stream, a);
#else
    for (int p = 0; p < 9; ++p) { a.ph_lo = p; a.ph_hi = p + 1; hipLaunchKernelGGL(mega_fwd, dim3(grid), dim3(NWAVES * 64), LDS_BYTES, stream, a); }
#endif
}
```

```cpp
#include <hip/hip_runtime.h>
#include <cstdio>
#include <cstdint>

constexpr int DM = 1024, TP = 16384, TS = 128, MTOT = TP + TS, MPAD = 16640, SEQ = 4096, NBATCH = 4, DBATCH = 32, DSEQ = 4, PAST = 8192;
constexpr int NPROJ = 3072, DFF = 2816, DPLE = 256, NGU = 2 * DFF;
constexpr int C_QN = 0, C_KV = 512, C_WIN = 1024, C_GT = 1280, C_QG = 1304, C_KG = 1560, C_VG = 1816, C_LR = 2328, C_GG = 2344, NIN = 2856;
constexpr float EPS = 1e-6f;
constexpr size_t O_Y = 0, O_KV = (size_t)MTOT * 1024, O_WINP = O_KV + (size_t)MTOT * 512, O_WINS = O_WINP + 4 * 512 * 256,
                 O_GLAP = O_WINS + (size_t)32 * 512 * 256, O_GLAS = O_GLAP + 4 * 4 * 64 * 128, O_END = O_GLAS + (size_t)32 * 4 * 64 * 128;
namespace pg8 {
#define PG8_LAS __attribute__((address_space(3)))
typedef unsigned short bf16_t;
typedef short bf16x8 __attribute__((ext_vector_type(8)));
typedef float f32x4 __attribute__((ext_vector_type(4)));
typedef unsigned u32x4 __attribute__((ext_vector_type(4)));
constexpr int BM = 256, BK = 64, HALF = 128, HTB = HALF * BK * 2  , STAGE_BYTES = 8 * HTB, NXCD = 8, WGM = 8;

__host__ __device__ __forceinline__ int lds_byte(int r, int c) { const int st = (r >> 4) * 2 + (c >> 5), rr = r & 15, cc = c & 31, ob = rr * 64 + cc * 2; return st * 1024 + (ob ^ (((ob >> 9) & 1) << 5)); }
__host__ __device__ __forceinline__ void stage_rc(int b, int& R, int& C) { const int st = b / 1024, sb = b % 1024, swz = sb ^ (((sb >> 9) & 1) << 5); R = (st >> 1) * 16 + swz / 64; C = (st & 1) * 32 + (swz % 64) / 2; }
__host__ __device__ __forceinline__ int perm32(int rho) { const int n = rho >> 4, i = rho & 15; return 8 * (i >> 2) + 4 * n + (i & 3); }

struct Unit { int pm, pn; };
struct Gemm { const bf16_t* A; const bf16_t* Bt; int M, N, K; };

struct StaticOrder {
    int nM, nN, nwg, G, c;
    __host__ __device__ void init(int M, int N, int G_, int c_) { nM = M / BM; nN = N / BM; nwg = nM * nN; G = G_; c = c_; }
    __host__ __device__ bool next(int i, Unit& u) const {
        const long L = (long)i * G + c; if (L >= nwg) return false;
        int wgid = (int)L; { const int q = nwg / NXCD, r = nwg % NXCD, xcd = wgid % NXCD, off = wgid / NXCD; wgid = (xcd < r ? xcd * (q + 1) : r * (q + 1) + (xcd - r) * q) + off; }
        const int nig = WGM * nN, gid = wgid / nig, fm = gid * WGM, gsz = (nM - fm) < WGM ? (nM - fm) : WGM;
        u.pm = fm + ((wgid % nig) % gsz); u.pn = (wgid % nig) / gsz; return true;
    }
    __device__ __forceinline__ void a_ready(const Unit&) const {}
    __device__ __forceinline__ void done(const Unit&) const {}
};

__device__ __forceinline__ unsigned cvt_pk_bf16(float lo, float hi) { unsigned r; asm volatile("v_cvt_pk_bf16_f32 %0, %1, %2" : "=v"(r) : "v"(lo), "v"(hi)); return r; }

__device__ __forceinline__ u32x4 pack8(const f32x4 v0, const f32x4 v1) { u32x4 w; w.x = cvt_pk_bf16(v0[0], v0[1]); w.y = cvt_pk_bf16(v0[2], v0[3]); w.z = cvt_pk_bf16(v1[0], v1[1]); w.w = cvt_pk_bf16(v1[2], v1[3]); return w; }

struct EpiInProj {
    static constexpr bool PERM = true, AFTER_DRAIN = false;
    bf16_t* proj; float* out;
    __device__ __forceinline__ void operator()(const f32x4 (&acc)[2][2][4][2], const Unit& u, int wr, int wc, int fr, int fq) const {
        const int row0 = u.pm * BM + wr * 64 + fr, colb = u.pn * BM + wc * 32 + 8 * fq;
        const float sc = (u.pn < 2) ? 0.125f : 1.0f;
#pragma unroll
        for (int ai = 0; ai < 2; ++ai)
#pragma unroll
            for (int m = 0; m < 4; ++m) {
                const int r = row0 + ai * HALF + m * 16;
                if (r < MTOT) {
#pragma unroll
                    for (int bj = 0; bj < 2; ++bj) {
                        const int c = colb + bj * HALF;
                        const f32x4 v0 = acc[ai][bj][m][0] * sc, v1 = acc[ai][bj][m][1] * sc;
                        *(u32x4*)(proj + (size_t)r * NPROJ + c) = pack8(v0, v1);
                        if (u.pn == 2 || u.pn == 3) { float* o = out + O_KV + (size_t)r * 512 + (c - C_KV); *(f32x4*)o = v0; *(f32x4*)(o + 4) = v1; }
                        if (u.pn == 4) {
                            const int cc = c - C_WIN; float* o = nullptr;
                            if (r < TP) { const int pos = r & (SEQ - 1), b = r >> 12; if (pos >= SEQ - 512) o = out + O_WINP + ((size_t)(b * 512 + pos - (SEQ - 512)) * 256 + cc); }
                            else { const int rs = r - TP, b = rs >> 2, i = rs & 3; o = out + O_WINS + ((size_t)(b * 512 + 508 + i) * 256 + cc); }
                            if (o) { *(f32x4*)o = v0; *(f32x4*)(o + 4) = v1; }
                        }
                    }
                }
            }
    }
};
struct EpiResid {
    static constexpr bool PERM = true, AFTER_DRAIN = false;
    const float* baseA; const float* baseB;
    float* hout; bf16_t* hb; float* rowss;
    __device__ __forceinline__ void operator()(const f32x4 (&acc)[2][2][4][2], const Unit& u, int wr, int wc, int fr, int fq) const {
        const int row0 = u.pm * BM + wr * 64 + fr, colb = u.pn * BM + wc * 32 + 8 * fq;
#pragma unroll
        for (int ai = 0; ai < 2; ++ai)
#pragma unroll
            for (int m = 0; m < 4; ++m) {
                const int r = row0 + ai * HALF + m * 16;
                float ss = 0.f;
                if (r < MTOT) {
                    const float* bp = (r < TP) ? baseA + (size_t)r * 1024 : baseB + (size_t)(r - TP) * 1024;
#pragma unroll
                    for (int bj = 0; bj < 2; ++bj) {
                        const int c = colb + bj * HALF;
                        const f32x4 v0 = acc[ai][bj][m][0] + *(const f32x4*)(bp + c), v1 = acc[ai][bj][m][1] + *(const f32x4*)(bp + c + 4);
                        float* o = hout + (size_t)r * 1024 + c; *(f32x4*)o = v0; *(f32x4*)(o + 4) = v1;
                        *(u32x4*)(hb + (size_t)r * 1024 + c) = pack8(v0, v1);
                        ss += (v0[0] * v0[0] + v0[1] * v0[1]) + (v0[2] * v0[2] + v0[3] * v0[3]) + (v1[0] * v1[0] + v1[1] * v1[1]) + (v1[2] * v1[2] + v1[3] * v1[3]);
                    }
                }
                ss += __shfl_xor(ss, 16); ss += __shfl_xor(ss, 32);
                if (fq == 0 && r < MTOT) atomicAdd(rowss + r, ss);
            }
    }
};
struct EpiGateUp {
    static constexpr bool PERM = true, AFTER_DRAIN = false;
    bf16_t* act; const float* rowss;
    __device__ __forceinline__ void operator()(const f32x4 (&acc)[2][2][4][2], const Unit& u, int wr, int wc, int fr, int fq) const {
        const int row0 = u.pm * BM + wr * 64 + fr, colb = u.pn * HALF + wc * 32 + 8 * fq;
#pragma unroll
        for (int ai = 0; ai < 2; ++ai)
#pragma unroll
            for (int m = 0; m < 4; ++m) {
                const int r = row0 + ai * HALF + m * 16;
                if (r < MTOT) {
                    const float rstd = __builtin_amdgcn_rsqf(rowss[r] * (1.0f / 1024.0f) + EPS);
                    f32x4 o[2];
#pragma unroll
                    for (int n = 0; n < 2; ++n)
#pragma unroll
                        for (int e = 0; e < 4; ++e) { const float g = acc[ai][0][m][n][e] * rstd, up = acc[ai][1][m][n][e] * rstd; o[n][e] = g * up * __builtin_amdgcn_rcpf(1.0f + __expf(-g)); }
                    *(u32x4*)(act + (size_t)r * DFF + colb) = pack8(o[0], o[1]);
                }
            }
    }
};
struct EpiBf {
    static constexpr bool PERM = true, AFTER_DRAIN = false;
    bf16_t* O; int ldc;
    __device__ __forceinline__ void operator()(const f32x4 (&acc)[2][2][4][2], const Unit& u, int wr, int wc, int fr, int fq) const {
        const int row0 = u.pm * BM + wr * 64 + fr, colb = u.pn * BM + wc * 32 + 8 * fq;
#pragma unroll
        for (int ai = 0; ai < 2; ++ai)
#pragma unroll
            for (int m = 0; m < 4; ++m) {
                const int r = row0 + ai * HALF + m * 16;
                if (r < MTOT) {
#pragma unroll
                    for (int bj = 0; bj < 2; ++bj) *(u32x4*)(O + (size_t)r * ldc + colb + bj * HALF) = pack8(acc[ai][bj][m][0], acc[ai][bj][m][1]);
                }
            }
    }
};
struct EpiPleGate {
    static constexpr bool PERM = true, AFTER_DRAIN = false;
    const float* h2; const bf16_t* ple; const float* rowss2; float* y; float* rowss3;
    __device__ __forceinline__ void operator()(const f32x4 (&acc)[2][2][4][2], const Unit& u, int wr, int wc, int fr, int fq) const {
        const int row0 = u.pm * BM + wr * 64 + fr, colb = u.pn * BM + wc * 32 + 8 * fq;
#pragma unroll
        for (int ai = 0; ai < 2; ++ai)
#pragma unroll
            for (int m = 0; m < 4; ++m) {
                const int r = row0 + ai * HALF + m * 16;
                float ss = 0.f;
                if (r < MTOT) {
                    const float rstd = __builtin_amdgcn_rsqf(rowss2[r] * (1.0f / 1024.0f) + EPS);
#pragma unroll
                    for (int bj = 0; bj < 2; ++bj) {
                        const int c = colb + bj * HALF;
                        const u32x4 pw = *(const u32x4*)(ple + (size_t)r * 1024 + c);
                        const f32x4 b0 = *(const f32x4*)(h2 + (size_t)r * 1024 + c), b1 = *(const f32x4*)(h2 + (size_t)r * 1024 + c + 4);
                        float pv[8];
#pragma unroll
                        for (int e = 0; e < 4; ++e) { pv[2 * e] = __uint_as_float(pw[e] << 16); pv[2 * e + 1] = __uint_as_float(pw[e] & 0xffff0000u); }
                        f32x4 v0, v1;
#pragma unroll
                        for (int e = 0; e < 4; ++e) {
                            v0[e] = b0[e] + pv[e] * __builtin_amdgcn_rcpf(1.0f + __expf(-acc[ai][bj][m][0][e] * rstd));
                            v1[e] = b1[e] + pv[4 + e] * __builtin_amdgcn_rcpf(1.0f + __expf(-acc[ai][bj][m][1][e] * rstd));
                        }
                        float* o = y + (size_t)r * 1024 + c; *(f32x4*)o = v0; *(f32x4*)(o + 4) = v1;
                        ss += (v0[0] * v0[0] + v0[1] * v0[1]) + (v0[2] * v0[2] + v0[3] * v0[3]) + (v1[0] * v1[0] + v1[1] * v1[1]) + (v1[2] * v1[2] + v1[3] * v1[3]);
                    }
                }
                ss += __shfl_xor(ss, 16); ss += __shfl_xor(ss, 32);
                if (fq == 0 && r < MTOT) atomicAdd(rowss3 + r, ss);
            }
    }
};
template <class Epi, class Sched, bool ALIGN_EPI = false, bool SP2 = false>
__device__ __forceinline__ void gemm_phase(PG8_LAS unsigned char* lds, const Gemm g, const Sched& S, const Epi& E, const int tid) {
    const int wid = __builtin_amdgcn_readfirstlane(tid >> 6), lane = tid & 63, wr = wid >> 2, wc = wid & 3, fr = lane & 15, fq = lane >> 4;
    const int K = g.K, nt = K / BK;
    unsigned voffA[2], voffB[2];
#pragma unroll
    for (int i = 0; i < 2; ++i) { int R, C; stage_rc(tid * 16 + i * 8192, R, C); const int Rb = Epi::PERM ? ((R & ~31) + perm32(R & 31)) : R;
        voffA[i] = (unsigned)(R * K + C) * 2u; voffB[i] = (unsigned)(Rb * K + C) * 2u; }
    const size_t kstep = (size_t)(BK * 2);
    const size_t hstep = (size_t)HALF * K * 2;
    const size_t tstep = 2 * hstep;
    const unsigned ldsw = (unsigned)wid * 1024u;
    const int aoff = lds_byte(wr * 64 + fr, fq * 8), boff = lds_byte(wc * 32 + fr, fq * 8);
#define PG8_SA(b, h) (((b) * 2 + (h)) * HTB)
#define PG8_SB(b, h) ((4 + (b) * 2 + (h)) * HTB)
#define PG8_STAGE(bufoff, gbase, voff) do { _Pragma("unroll") for (int _i = 0; _i < 2; ++_i) \
        __builtin_amdgcn_global_load_lds((const unsigned*)((const char*)(gbase) + (voff)[_i]), (PG8_LAS unsigned*)(lds + (bufoff) + ldsw + _i * 8192), 16, 0, 0); } while (0)
#define PG8_LDA(dst, b, h) do { _Pragma("unroll") for (int m = 0; m < 4; ++m) _Pragma("unroll") for (int k = 0; k < 2; ++k) dst[m][k] = *(const PG8_LAS bf16x8*)(lds + PG8_SA(b, h) + aoff + m * 2048 + k * 1024); } while (0)
#define PG8_LDB(dst, b, h) do { _Pragma("unroll") for (int n = 0; n < 2; ++n) _Pragma("unroll") for (int k = 0; k < 2; ++k) dst[n][k] = *(const PG8_LAS bf16x8*)(lds + PG8_SB(b, h) + boff + n * 2048 + k * 1024); } while (0)
#define PG8_MMA(ai, bj, At, Bt) do { __builtin_amdgcn_s_setprio(1); _Pragma("unroll") for (int m = 0; m < 4; ++m) _Pragma("unroll") for (int n = 0; n < 2; ++n) _Pragma("unroll") for (int k = 0; k < 2; ++k) \
        acc[ai][bj][m][n] = __builtin_amdgcn_mfma_f32_16x16x32_bf16(Bt[n][k], At[m][k], acc[ai][bj][m][n], 0, 0, 0); __builtin_amdgcn_s_setprio(0); } while (0)
#define PG8_WAIT_V(n) asm volatile("s_waitcnt vmcnt(" #n ")" ::: "memory")
#define PG8_WAIT_L(n) asm volatile("s_waitcnt lgkmcnt(" #n ")" ::: "memory")
#define PG8_BAR __builtin_amdgcn_s_barrier()
#define PG8_SCHED __builtin_amdgcn_sched_barrier(0)
    Unit cur, nxt; int ui = 0;
    if (!S.next(0, cur)) return;
    f32x4 acc[2][2][4][2];
#pragma unroll
    for (int a = 0; a < 2; ++a)
#pragma unroll
        for (int b = 0; b < 2; ++b)
#pragma unroll
            for (int m = 0; m < 4; ++m)
#pragma unroll
                for (int n = 0; n < 2; ++n) acc[a][b][m][n] = (f32x4){0.f, 0.f, 0.f, 0.f};
    bf16x8 At[4][2], B0[2][2], B1[2][2];
    const char* cA = (const char*)g.A + (size_t)cur.pm * tstep; const char* cB = (const char*)g.Bt + (size_t)cur.pn * tstep;
    S.a_ready(cur);
    if constexpr (SP2) {
        PG8_STAGE(PG8_SB(0, 0), cB, voffB); PG8_STAGE(PG8_SB(0, 1), cB + hstep, voffB); PG8_STAGE(PG8_SA(0, 0), cA, voffA); PG8_STAGE(PG8_SA(0, 1), cA + hstep, voffA);
        if (wr == 1) PG8_BAR;
        PG8_WAIT_V(2); PG8_BAR;
        PG8_STAGE(PG8_SB(1, 0), cB + kstep, voffB); PG8_STAGE(PG8_SA(1, 0), cA + kstep, voffA); PG8_STAGE(PG8_SB(1, 1), cB + hstep + kstep, voffB);
        PG8_WAIT_V(6); PG8_BAR;
    } else {
        PG8_STAGE(PG8_SB(0, 0), cB, voffB); PG8_STAGE(PG8_SA(0, 0), cA, voffA); PG8_STAGE(PG8_SB(0, 1), cB + hstep, voffB); PG8_STAGE(PG8_SA(0, 1), cA + hstep, voffA);
        if (wr == 1) PG8_BAR;
        PG8_WAIT_V(4); PG8_BAR;
        PG8_STAGE(PG8_SB(1, 0), cB + kstep, voffB); PG8_STAGE(PG8_SA(1, 0), cA + kstep, voffA); PG8_STAGE(PG8_SB(1, 1), cB + hstep + kstep, voffB);
        PG8_WAIT_V(6); PG8_BAR;
    }
    for (;;) {
        const bool has_next = S.next(ui + 1, nxt);
        const char* nA = has_next ? (const char*)g.A + (size_t)nxt.pm * tstep : cA; const char* nB = has_next ? (const char*)g.Bt + (size_t)nxt.pn * tstep : cB;
        for (int t = 0; t < nt; t += 2) {
            const bool last = (t == nt - 2);
            const char* a1 = cA + (size_t)(t + 1) * kstep;
            const char* a2 = last ? nA : cA + (size_t)(t + 2) * kstep; const char* b2 = last ? nB : cB + (size_t)(t + 2) * kstep;
            const char* a3 = a2 + kstep; const char* b3 = b2 + kstep;
            if (last && has_next) S.a_ready(nxt);
            if constexpr (SP2) {
            PG8_LDB(B0, 0, 0); PG8_LDB(B1, 0, 1); PG8_SCHED; PG8_LDA(At, 0, 0); PG8_STAGE(PG8_SA(1, 1), a1 + hstep, voffA);
            PG8_WAIT_V(8); PG8_WAIT_L(0); PG8_BAR; PG8_MMA(0, 0, At, B0); PG8_MMA(0, 1, At, B1); PG8_BAR; PG8_SCHED;
            PG8_LDA(At, 0, 1); PG8_STAGE(PG8_SB(0, 0), b2, voffB); PG8_STAGE(PG8_SB(0, 1), b2 + hstep, voffB); PG8_STAGE(PG8_SA(0, 0), a2, voffA);
            PG8_WAIT_V(8); PG8_WAIT_L(0); PG8_BAR; PG8_MMA(1, 0, At, B0); PG8_MMA(1, 1, At, B1); PG8_BAR; PG8_SCHED;
            PG8_LDB(B0, 1, 0); PG8_LDB(B1, 1, 1); PG8_SCHED; PG8_LDA(At, 1, 0); PG8_STAGE(PG8_SA(0, 1), a2 + hstep, voffA);
            PG8_WAIT_V(8); PG8_WAIT_L(0); PG8_BAR; PG8_MMA(0, 0, At, B0); PG8_MMA(0, 1, At, B1); PG8_BAR; PG8_SCHED;
            PG8_LDA(At, 1, 1); PG8_STAGE(PG8_SB(1, 0), b3, voffB); PG8_STAGE(PG8_SB(1, 1), b3 + hstep, voffB); PG8_STAGE(PG8_SA(1, 0), a3, voffA);
            PG8_WAIT_V(8); PG8_WAIT_L(0); PG8_BAR; PG8_MMA(1, 0, At, B0); PG8_MMA(1, 1, At, B1); PG8_BAR; PG8_SCHED;
            } else {
            PG8_LDB(B0, 0, 0); PG8_SCHED; PG8_LDA(At, 0, 0); PG8_STAGE(PG8_SA(1, 1), a1 + hstep, voffA);
            PG8_WAIT_L(8); PG8_BAR; PG8_WAIT_L(0); PG8_MMA(0, 0, At, B0); PG8_BAR; PG8_SCHED;
            PG8_LDB(B1, 0, 1); PG8_STAGE(PG8_SB(0, 0), b2, voffB);
            PG8_BAR; PG8_WAIT_L(0); PG8_MMA(0, 1, At, B1); PG8_BAR;
            PG8_LDA(At, 0, 1); PG8_STAGE(PG8_SA(0, 0), a2, voffA);
            PG8_BAR; PG8_WAIT_L(0); PG8_MMA(1, 0, At, B0); PG8_BAR; PG8_SCHED;
            PG8_STAGE(PG8_SB(0, 1), b2 + hstep, voffB);
            PG8_WAIT_V(6); PG8_BAR; PG8_MMA(1, 1, At, B1); PG8_BAR;
            PG8_LDB(B0, 1, 0); PG8_SCHED; PG8_LDA(At, 1, 0); PG8_STAGE(PG8_SA(0, 1), a2 + hstep, voffA);
            PG8_WAIT_L(8); PG8_BAR; PG8_WAIT_L(0); PG8_MMA(0, 0, At, B0); PG8_BAR; PG8_SCHED;
            PG8_LDB(B1, 1, 1); PG8_STAGE(PG8_SB(1, 0), b3, voffB);
            PG8_BAR; PG8_WAIT_L(0); PG8_MMA(0, 1, At, B1); PG8_BAR;
            PG8_LDA(At, 1, 1); PG8_STAGE(PG8_SA(1, 0), a3, voffA);
            PG8_BAR; PG8_WAIT_L(0); PG8_MMA(1, 0, At, B0); PG8_BAR; PG8_SCHED;
            PG8_STAGE(PG8_SB(1, 1), b3 + hstep, voffB);
            PG8_WAIT_V(6); PG8_BAR; PG8_MMA(1, 1, At, B1); PG8_BAR;
            }
        }
        if constexpr (ALIGN_EPI) { if (wr == 0) PG8_BAR; }
        if constexpr (!Epi::AFTER_DRAIN) { E(acc, cur, wr, wc, fr, fq); S.done(cur); }
        if (!has_next) break;
#pragma unroll
        for (int a = 0; a < 2; ++a)
#pragma unroll
            for (int b = 0; b < 2; ++b)
#pragma unroll
                for (int m = 0; m < 4; ++m)
#pragma unroll
                    for (int n = 0; n < 2; ++n) acc[a][b][m][n] = (f32x4){0.f, 0.f, 0.f, 0.f};
        cur = nxt; cA = nA; cB = nB; ++ui;
        if constexpr (ALIGN_EPI) { if (wr == 1) PG8_BAR; }
    }
    PG8_WAIT_V(0);
    if constexpr (!ALIGN_EPI) { if (wr == 0) PG8_BAR; }
    PG8_BAR;
    if constexpr (Epi::AFTER_DRAIN) { E.fused(acc, cur, wr, wc, fr, fq, lds, wid, lane); S.done(cur); }
#undef PG8_SA
#undef PG8_SB
#undef PG8_STAGE
#undef PG8_LDA
#undef PG8_LDB
#undef PG8_MMA
#undef PG8_WAIT_V
#undef PG8_WAIT_L
#undef PG8_BAR
#undef PG8_SCHED
}
}


#define GAS __attribute__((address_space(1)))
#define LAS __attribute__((address_space(3)))
typedef unsigned short bf16;
typedef unsigned v4u __attribute__((ext_vector_type(4)));
typedef unsigned v2u __attribute__((ext_vector_type(2)));
typedef float f32x4 __attribute__((ext_vector_type(4)));
typedef float f32x2 __attribute__((ext_vector_type(2)));
typedef float f32x16 __attribute__((ext_vector_type(16)));
typedef short bf16x8 __attribute__((ext_vector_type(8)));
typedef short s16x4 __attribute__((ext_vector_type(4)));
typedef GAS unsigned gu32;
#define RLX_AGENT __ATOMIC_RELAXED, __HIP_MEMORY_SCOPE_AGENT
#define LDS_WAIT() asm volatile("s_waitcnt lgkmcnt(0)" ::: "memory")
#define VM_WAIT() asm volatile("s_waitcnt vmcnt(0)" ::: "memory")
__device__ __forceinline__ unsigned f2bf(float f) { unsigned u = __builtin_bit_cast(unsigned, f); return (u + 0x7fffu + ((u >> 16) & 1u)) >> 16; }
__device__ __forceinline__ unsigned pk2(float lo, float hi) { return f2bf(lo) | (f2bf(hi) << 16); }
__device__ __forceinline__ float bf2f(unsigned short h) { return __uint_as_float(((unsigned)h) << 16); }
__device__ __forceinline__ float bflo(unsigned w) { return __uint_as_float(w << 16); }
__device__ __forceinline__ float bfhi(unsigned w) { return __uint_as_float(w & 0xffff0000u); }

constexpr int NWAVES = 8;
constexpr size_t MiB = 1u << 20;
constexpr size_t WS_CTL = 0, CTL_ZERO_BYTES = 1 * MiB;
constexpr int CW_BAR = 4096, CW_Q3 = 16384;
constexpr size_t WS_ROWSS = 256 * 1024;
constexpr size_t WS_WIN = 2 * MiB;
constexpr size_t WS_WO = 8 * MiB;
constexpr size_t WS_WGU = 10 * MiB;
constexpr size_t WS_WDN = 21 * MiB;
constexpr size_t WS_WPG = 27 * MiB;
constexpr size_t WS_WPLE = 29 * MiB;
constexpr size_t WS_WC1 = 30 * MiB;
constexpr size_t WS_WC2 = 31 * MiB;
constexpr size_t WS_C1 = 31 * MiB + 65536;
constexpr size_t WS_KCP = 32 * MiB;
constexpr size_t WS_VCP = 33 * MiB;
constexpr size_t WS_KCS = 34 * MiB;
constexpr size_t WS_VCS = 38 * MiB;
constexpr size_t WS_DSC = 42 * MiB;
constexpr size_t WS_USC = 43 * MiB;
constexpr size_t WS_QB = 51 * MiB;
constexpr size_t WS_XN = 64 * MiB;
constexpr size_t WS_PPLE = 97 * MiB;
constexpr size_t WS_PROJ = 106 * MiB;
constexpr size_t WS_OWIN = 204 * MiB;
constexpr size_t WS_MIX = 221 * MiB;
constexpr size_t WS_OLOC = 254 * MiB;
constexpr size_t WS_H1 = 287 * MiB;
constexpr size_t WS_H1B = 353 * MiB;
constexpr size_t WS_ACT = 386 * MiB;
constexpr size_t WS_H2 = 476 * MiB;
constexpr size_t WS_H2B = 542 * MiB;
constexpr size_t WS_PLEB = 575 * MiB;
constexpr size_t WS_END = 608 * MiB;
constexpr int RING_BYTES = 131072;
constexpr int MISC_OFF = RING_BYTES + 320;
constexpr int LDS_BYTES = 163840;
#define XB_TMO      128
#define XB_XCNT(j)  (256  + 64 * (j))
#define XB_XSUB(j)  (1280 + 64 * (j))
#define XB_XGEN(j)  (2304 + 64 * (j))
#define XB_TOP      3328
#define XB_TOPGEN   3392
#define XCD_BAR_WORDS 3456
#define XB_SPIN_CAP (1u << 18)

__device__ __forceinline__ unsigned xb_ld(unsigned* p)              { return __hip_atomic_load(p, __ATOMIC_RELAXED, __HIP_MEMORY_SCOPE_AGENT); }
__device__ __forceinline__ unsigned xb_add(unsigned* p, unsigned v) { return __hip_atomic_fetch_add(p, v, __ATOMIC_RELAXED, __HIP_MEMORY_SCOPE_AGENT); }
__device__ __forceinline__ unsigned xb_xcc_id() { return (unsigned)__builtin_amdgcn_s_getreg((3 << 11) | 20) & 0xFu; }
#define XB_SPIN(cond, bar) do { unsigned _sp = 0; while (cond) { __builtin_amdgcn_s_sleep(1); \
    if ((++_sp & 255u) == 0u) { if (xb_ld(&(bar)[XB_TMO])) break; if (_sp > XB_SPIN_CAP) { atomicAdd(&(bar)[XB_TMO], 1u); break; } } } } while (0)

struct XcdBarrier {
    unsigned* bar; unsigned x;
    volatile LAS unsigned* st;
};

__device__ __forceinline__ XcdBarrier xcd_barrier_post(unsigned* bar, volatile LAS unsigned* st, const int tid) {
    XcdBarrier b; b.bar = bar; b.x = xb_xcc_id(); b.st = st;
    if (tid == 0) (void)xb_add(&bar[XB_XCNT(b.x)], 1u);
    return b;
}
__device__ __forceinline__ void xcd_barrier_complete(unsigned* bar, unsigned x, unsigned& nloc, unsigned& nx) {
    const unsigned G = gridDim.x * gridDim.y * gridDim.z;
    unsigned sum, cnt, mine, sp = 0u;
    for (;;) {
        sum = 0u; cnt = 0u; mine = 0u;
#pragma unroll
        for (unsigned j = 0; j < 16; ++j) { const unsigned c = xb_ld(&bar[XB_XCNT(j)]); sum += c; cnt += (c > 0u) ? 1u : 0u; mine = (j == x) ? c : mine; }
        if (sum == G) break;
        __builtin_amdgcn_s_sleep(1);
        if ((++sp & 255u) == 0u) { if (xb_ld(&bar[XB_TMO])) break; if (sp > XB_SPIN_CAP) { atomicAdd(&bar[XB_TMO], 1u); break; } }
    }
    nloc = mine > 0u ? mine : 1u; nx = cnt > 0u ? cnt : 1u;
}

__device__ __forceinline__ void xcd_barrier(const XcdBarrier& b, const int tid) {
    asm volatile("s_waitcnt vmcnt(0)" ::: "memory");
    __syncthreads();
    if (tid == 0) {
        unsigned* bar = b.bar;
        __builtin_amdgcn_s_waitcnt(0);
        unsigned nloc = b.st[0], nx = b.st[1];
        if (nloc == 0u) { xcd_barrier_complete(bar, b.x, nloc, nx); b.st[0] = nloc; b.st[1] = nx; }
        const unsigned old = xb_add(&bar[XB_XSUB(b.x)], 1u);
        const unsigned gen = old / nloc;
        if (old + 1u == (gen + 1u) * nloc) {
            __builtin_amdgcn_fence(__ATOMIC_RELEASE, "agent");
            asm volatile("s_waitcnt vmcnt(0)" ::: "memory");
            const unsigned og = xb_add(&bar[XB_TOP], 1u);
            const unsigned tg = og / nx;
            if (og + 1u == (tg + 1u) * nx) xb_add(&bar[XB_TOPGEN], 1u);
            else XB_SPIN(xb_ld(&bar[XB_TOPGEN]) == tg, bar);
            __builtin_amdgcn_fence(__ATOMIC_ACQUIRE, "agent");
            xb_add(&bar[XB_XGEN(b.x)], 1u);
            asm volatile("s_waitcnt vmcnt(0)" ::: "memory");
        } else {
            XB_SPIN(xb_ld(&bar[XB_XGEN(b.x)]) == gen, bar);
            __builtin_amdgcn_fence(__ATOMIC_ACQUIRE, "agent");
            asm volatile("s_waitcnt vmcnt(0)" ::: "memory");
        }
    }
    __syncthreads();
}

struct Args { const float* in[26]; float* out; unsigned char* ws; int ph_lo, ph_hi; };
struct Frame {
    LAS unsigned char* lds;
    int tid, lane, wave, vcu, G;
};
__device__ __forceinline__ int hw_lane() { int l; asm volatile("v_mbcnt_lo_u32_b32 %0, -1, 0\n\tv_mbcnt_hi_u32_b32 %0, -1, %0" : "=v"(l)); return l; }
__device__ __forceinline__ int opaque(int x) { asm volatile("" : "+v"(x)); return x; }
__device__ __forceinline__ float wave_sum(float v) {
#pragma unroll
    for (int o = 1; o < 64; o <<= 1) v += __shfl_xor(v, o);
    return v;
}
__device__ __forceinline__ void p0_tr_item(const float* W, int ldw, int K, int nsrc, int nblk, bf16* WT, int mode, const float* kscale, LAS float* scr, int item, int lane) {
    const int kb = item / nblk, nb = item % nblk, k0 = 64 * kb, n0 = 32 * nb;
    const int nn = n0 + (lane & 31);
#pragma unroll 16
    for (int i = 0; i < 32; ++i) { const int kk = 2 * i + (lane >> 5); float v = 0.f; if (nn < nsrc) { v = W[(size_t)(k0 + kk) * ldw + nn]; if (kscale) v *= kscale[k0 + kk]; } scr[kk * 33 + (lane & 31)] = v; }
    LDS_WAIT(); asm volatile("" ::: "memory");
    const int c = lane & 7;
#pragma unroll
    for (int j = 0; j < 4; ++j) { const int n = (lane >> 3) + 8 * j; const LAS float* s = scr + (8 * c) * 33 + n;
        v4u o; o.x = pk2(s[0 * 33], s[1 * 33]); o.y = pk2(s[2 * 33], s[3 * 33]); o.z = pk2(s[4 * 33], s[5 * 33]); o.w = pk2(s[6 * 33], s[7 * 33]);
        const int ng = n0 + n; const int drow = (mode == 0) ? ng : (256 * (ng >> 7) + (ng & 127) + (mode == 2 ? 128 : 0));
        *(GAS v4u*)(WT + (size_t)drow * K + k0 + 8 * c) = o; }
    LDS_WAIT(); asm volatile("" ::: "memory");
}
__device__ __forceinline__ void rms_row_to_bf16(const float* xrow, const float* g, bf16* orow, int lane) {
    const GAS f32x4* xr = (const GAS f32x4*)xrow + lane; const GAS f32x4* gr = (const GAS f32x4*)g + lane;
    f32x4 v[4]; float s = 0.f;
#pragma unroll
    for (int j = 0; j < 4; ++j) { v[j] = xr[64 * j]; s += (v[j].x * v[j].x + v[j].y * v[j].y) + (v[j].z * v[j].z + v[j].w * v[j].w); }
    const float rstd = 1.0f / sqrtf(wave_sum(s) * (1.f / DM) + EPS);
    GAS unsigned long long* o8 = (GAS unsigned long long*)orow + lane;
#pragma unroll
    for (int j = 0; j < 4; ++j) { const f32x4 gg = gr[64 * j];
        o8[64 * j] = (unsigned long long)pk2(v[j].x * rstd * gg.x, v[j].y * rstd * gg.y) | ((unsigned long long)pk2(v[j].z * rstd * gg.z, v[j].w * rstd * gg.w) << 32); }
}
__device__ __forceinline__ void p0_prologue(const Frame& F, const Args& A) {
    unsigned char* ws = A.ws;
    LAS float* scr = (LAS float*)(F.lds + F.wave * 16384);
    const int gw = F.vcu * NWAVES + F.wave, NGW = F.G * NWAVES, lane = F.lane;
    constexpr int I_IN = 16 * 96, I_O = 16 * 32, I_G = 16 * 88, I_D = 44 * 32, I_PG = 16 * 32, I_PL = 4 * 32, I_C1 = 128  , I_C2 = 2 * 1 * 2;
    constexpr int NITEMS = I_IN + I_O + 2 * I_G + I_D + I_PG + I_PL + I_C1 + I_C2;
    for (int it = gw; it < NITEMS; it += NGW) {
        int r = it;
        if (r < I_IN) { p0_tr_item(A.in[9], NIN, 1024, NIN, 96, (bf16*)(ws + WS_WIN), 0, nullptr, scr, r, lane); continue; } r -= I_IN;
        if (r < I_O) { p0_tr_item(A.in[16], 1024, 1024, 1024, 32, (bf16*)(ws + WS_WO), 0, nullptr, scr, r, lane); continue; } r -= I_O;
        if (r < I_G) { p0_tr_item(A.in[18], DFF, 1024, DFF, 88, (bf16*)(ws + WS_WGU), 1, A.in[17], scr, r, lane); continue; } r -= I_G;
        if (r < I_G) { p0_tr_item(A.in[19], DFF, 1024, DFF, 88, (bf16*)(ws + WS_WGU), 2, A.in[17], scr, r, lane); continue; } r -= I_G;
        if (r < I_D) { p0_tr_item(A.in[20], 1024, DFF, 1024, 32, (bf16*)(ws + WS_WDN), 0, nullptr, scr, r, lane); continue; } r -= I_D;
        if (r < I_PG) { p0_tr_item(A.in[23], 1024, 1024, 1024, 32, (bf16*)(ws + WS_WPG), 0, A.in[22], scr, r, lane); continue; } r -= I_PG;
        if (r < I_PL) { p0_tr_item(A.in[21], 1024, 256, 1024, 32, (bf16*)(ws + WS_WPLE), 0, nullptr, scr, r, lane); continue; } r -= I_PL;
        if (r < I_C1) {
#pragma unroll
            for (int q4 = 0; q4 < 4; ++q4) { const int ch = (r * 4 + q4) * 64 + lane; const int l = ch & 63, ks = (ch >> 6) & 63, ht = (ch >> 12) & 1, jj = (ch >> 13) & 1, slot = ch >> 14;
                const float* src = A.in[11] + ((size_t)slot * 2048 + jj * 1024 + 16 * ks + 8 * (l >> 5)) * 64 + 32 * ht + (l & 31);
                v4u o; o.x = pk2(src[0], src[64]); o.y = pk2(src[128], src[192]); o.z = pk2(src[256], src[320]); o.w = pk2(src[384], src[448]);
                *(GAS v4u*)((bf16*)(ws + WS_WC1) + (size_t)ch * 8) = o; }
            continue; } r -= I_C1;
        { const int slot = r / 2; p0_tr_item(A.in[12] + (size_t)slot * 64 * 64, 64, 64, 64, 2, (bf16*)(ws + WS_WC2) + (size_t)slot * 64 * 64, 0, nullptr, scr, r % 2, lane); }
    }
    if (F.vcu < 2) { const int slot = F.vcu; const float* pe = A.in[10] + slot * 2048 + F.wave * 256; const float* w1 = A.in[11] + (size_t)slot * 2048 * 64 + (size_t)F.wave * 256 * 64; float a = 0.f;
#pragma unroll 16
        for (int k = 0; k < 256; ++k) a += pe[k] * w1[k * 64 + lane];
        ((LAS float*)(F.lds + F.wave * 16384 + 12288))[lane] = a; __syncthreads();
        if (F.wave == 0) { float t = 0.f;
#pragma unroll
            for (int w = 0; w < 8; ++w) t += ((LAS float*)(F.lds + w * 16384 + 12288))[lane];
            ((float*)(ws + WS_C1))[slot * 64 + lane] = t; }
    }
    bf16* XN = (bf16*)(ws + WS_XN);
    for (int m0 = gw; m0 < MPAD; m0 += 2 * NGW) {
        f32x4 v[2][4];
#pragma unroll
        for (int q = 0; q < 2; ++q) { const int m = m0 + q * NGW; if (m < MTOT) { const GAS f32x4* xr = (const GAS f32x4*)((m < TP) ? A.in[0] + (size_t)m * DM : A.in[1] + (size_t)(m - TP) * DM) + lane;
#pragma unroll
            for (int j = 0; j < 4; ++j) v[q][j] = xr[64 * j]; } else {
#pragma unroll
            for (int j = 0; j < 4; ++j) v[q][j] = (f32x4){0.f, 0.f, 0.f, 0.f}; } }
#pragma unroll
        for (int q = 0; q < 2; ++q) { const int m = m0 + q * NGW; if (m < MPAD) {
            float s = 0.f;
#pragma unroll
            for (int j = 0; j < 4; ++j) s += (v[q][j].x * v[q][j].x + v[q][j].y * v[q][j].y) + (v[q][j].z * v[q][j].z + v[q][j].w * v[q][j].w);
            const float rstd = 1.0f / sqrtf(wave_sum(s) * (1.f / DM) + EPS);
            GAS unsigned long long* o8 = (GAS unsigned long long*)(XN + (size_t)m * DM) + lane; const GAS f32x4* gr = (const GAS f32x4*)A.in[8] + lane;
#pragma unroll
            for (int j = 0; j < 4; ++j) { const f32x4 gg = gr[64 * j];
                o8[64 * j] = (unsigned long long)pk2(v[q][j].x * rstd * gg.x, v[q][j].y * rstd * gg.y) | ((unsigned long long)pk2(v[q][j].z * rstd * gg.z, v[q][j].w * rstd * gg.w) << 32); } } }
    }
    bf16* PP = (bf16*)(ws + WS_PPLE);
    for (int m0 = gw; m0 < MPAD; m0 += 4 * NGW) {
        f32x4 v[4];
#pragma unroll
        for (int q = 0; q < 4; ++q) { const int m = m0 + q * NGW; v[q] = (f32x4){0.f, 0.f, 0.f, 0.f}; if (m < MTOT) v[q] = ((const GAS f32x4*)((m < TP) ? A.in[6] + (size_t)m * DPLE : A.in[7] + (size_t)(m - TP) * DPLE))[lane]; }
#pragma unroll
        for (int q = 0; q < 4; ++q) { const int m = m0 + q * NGW; if (m < MPAD) { v2u o; o.x = pk2(v[q].x, v[q].y); o.y = pk2(v[q].z, v[q].w); ((GAS v2u*)(PP + (size_t)m * DPLE))[lane] = o;
            if (m >= MTOT) { GAS v4u* z = (GAS v4u*)((bf16*)(ws + WS_MIX) + (size_t)m * DM) + lane; z[0] = (v4u){0, 0, 0, 0}; z[64] = (v4u){0, 0, 0, 0}; } } }
    }
    for (int it0 = gw; it0 < DBATCH * 508; it0 += 4 * NGW) {
        f32x4 v[4];
#pragma unroll
        for (int q = 0; q < 4; ++q) { const int it = it0 + q * NGW; if (it < DBATCH * 508) { const int b = it / 508, r = it % 508; v[q] = ((const GAS f32x4*)(A.in[3] + (size_t)(b * 512 + r + 4) * 256))[lane]; } }
#pragma unroll
        for (int q = 0; q < 4; ++q) { const int it = it0 + q * NGW; if (it < DBATCH * 508) { const int b = it / 508, r = it % 508; ((GAS f32x4*)(A.out + O_WINS + (size_t)(b * 512 + r) * 256))[lane] = v[q]; } }
    }
}

constexpr float LOG2E = 1.4426950408889634f;
typedef short v4i16_t __attribute__((ext_vector_type(4)));
__device__ __forceinline__ s16x4 vtr(LAS const unsigned char* p) { return __builtin_bit_cast(s16x4, __builtin_amdgcn_ds_read_tr16_b64_v4i16((LAS v4i16_t*)p)); }
__device__ __forceinline__ unsigned cvtpk(float lo, float hi) { typedef float f2 __attribute__((ext_vector_type(2))); typedef __bf16 b2 __attribute__((ext_vector_type(2))); f2 v = {lo, hi}; b2 b = __builtin_convertvector(v, b2); return __builtin_bit_cast(unsigned, b); }
__device__ __forceinline__ int t5_bucket(int n) {
    if (n < 16) return n;
    const int large = 16 + (int)(logf((float)n / 16.0f) / 2.0794415416798357f * 16.0f);
    return large < 31 ? large : 31;
}
constexpr int HI_BASE = 131072 + 512, AT_LUT = HI_BASE, HI_IMPA = AT_LUT + 4096, HI_IMPB = HI_IMPA + 2176, HI_SEL = HI_IMPB + 2176, HI_SCS = HI_SEL + 128, HI_TL = HI_SCS + 512, HI_XCH = HI_TL + 512, HI_Q = HI_XCH + 8192, HI_END = HI_Q + 64;
constexpr int AT_K0 = 0, AT_V0 = 16384, AT_IMPA = 36864, AT_IMPB = AT_IMPA + 64 * 65 * 4 + 64, AT_SEL = AT_IMPB + 64 * 65 * 4 + 64, AT_MISC = AT_SEL + 1024, AT_QF = ((AT_MISC + 4096 + 1023) / 1024) * 1024, AT_END = AT_QF + 32768;
struct AttnLane {
    int koff;
    int kx;
    int voff0, voff1;
    int r32, h;
};
__device__ __forceinline__ AttnLane attn_lane(int lane) {
    AttnLane L; L.r32 = lane & 31; L.h = lane >> 5; L.koff = L.r32 * 128; L.kx = (L.r32 >> 1) & 7;
    const int i16 = lane & 15, q = i16 >> 2, p = i16 & 3, g1 = (lane >> 4) & 1;
    const int base = (4 * L.h + q) * 128 + g1 * 32 + (p >> 1) * 16 + (p & 1) * 8;
    L.voff0 = base + ((q >> 1) * 64); L.voff1 = base + (((q >> 1) ^ 1) * 64);
    return L;
}
__device__ __forceinline__ void attn_fill_lut(LAS float* lut, const float* rel_bias, int tid) {
    for (int e = tid; e < 1024; e += NWAVES * 64) { const int dist = e >> 3, hd = e & 7; lut[e] = rel_bias[t5_bucket(dist) * 8 + hd] * LOG2E; }
}
__device__ __forceinline__ void attn_commit(LAS unsigned char* kb, LAS unsigned char* vb, int tid, v4u k, v4u v) {
    const int row = tid >> 3, ch = tid & 7;
    *(LAS v4u*)(kb + row * 128 + ((ch ^ ((row >> 1) & 7)) << 4)) = k;
    *(LAS v4u*)(vb + row * 128 + ((ch ^ (((row >> 1) & 1) << 2)) << 4)) = v;
}
__device__ __forceinline__ f32x16 attn_qk(LAS const unsigned char* kb, int hf, const AttnLane& L, const bf16x8 (&qf)[4]) {
    f32x16 s = {};
#pragma unroll
    for (int ks = 0; ks < 4; ++ks) { const bf16x8 kf = *(LAS const bf16x8*)(kb + hf * 4096 + L.koff + (((2 * ks + L.h) ^ L.kx) << 4)); s = __builtin_amdgcn_mfma_f32_32x32x16_bf16(kf, qf[ks], s, 0, 0, 0); }
    return s;
}
__device__ __forceinline__ void attn_pv(LAS const unsigned char* vb, int hf, const AttnLane& L, const f32x16& p, f32x16 (&o)[2]) {
#pragma unroll
    for (int s = 0; s < 2; ++s) {
        v4u pw; pw.x = cvtpk(p[8 * s + 0], p[8 * s + 1]); pw.y = cvtpk(p[8 * s + 2], p[8 * s + 3]); pw.z = cvtpk(p[8 * s + 4], p[8 * s + 5]); pw.w = cvtpk(p[8 * s + 6], p[8 * s + 7]);
        const bf16x8 pb = __builtin_bit_cast(bf16x8, pw);
        const int rb = (32 * hf + 16 * s) * 128;
        { const s16x4 lo = vtr(vb + rb + L.voff0), hi = vtr(vb + rb + 1024 + L.voff0); const bf16x8 vf = {lo[0], lo[1], lo[2], lo[3], hi[0], hi[1], hi[2], hi[3]};
          o[0] = __builtin_amdgcn_mfma_f32_32x32x16_bf16(vf, pb, o[0], 0, 0, 0); }
        { const s16x4 lo = vtr(vb + rb + L.voff1), hi = vtr(vb + rb + 1024 + L.voff1); const bf16x8 vf = {lo[0], lo[1], lo[2], lo[3], hi[0], hi[1], hi[2], hi[3]};
          o[1] = __builtin_amdgcn_mfma_f32_32x32x16_bf16(vf, pb, o[1], 0, 0, 0); }
    }
}
__device__ __forceinline__ float max16(const f32x16& a) {
    float m0 = fmaxf(fmaxf(a[0], a[1]), fmaxf(a[2], a[3])), m1 = fmaxf(fmaxf(a[4], a[5]), fmaxf(a[6], a[7])), m2 = fmaxf(fmaxf(a[8], a[9]), fmaxf(a[10], a[11])), m3 = fmaxf(fmaxf(a[12], a[13]), fmaxf(a[14], a[15]));
    return fmaxf(fmaxf(m0, m1), fmaxf(m2, m3));
}
__device__ __forceinline__ float sum16(const f32x16& a) {
    return ((a[0] + a[1]) + (a[2] + a[3])) + ((a[4] + a[5]) + (a[6] + a[7])) + (((a[8] + a[9]) + (a[10] + a[11])) + ((a[12] + a[13]) + (a[14] + a[15])));
}
__device__ __forceinline__ float xmax32(float v) { const auto rr = __builtin_amdgcn_permlane32_swap(__float_as_uint(v), __float_as_uint(v), false, false); return fmaxf(__uint_as_float(rr[0]), __uint_as_float(rr[1])); }
__device__ __forceinline__ float xsum32(float v) { const auto rr = __builtin_amdgcn_permlane32_swap(__float_as_uint(v), __float_as_uint(v), false, false); return __uint_as_float(rr[0]) + __uint_as_float(rr[1]); }
__device__ __forceinline__ void attn_softmax_pv(LAS const unsigned char* vb, const AttnLane& L, f32x16& t0, f32x16& t1, float& m, float& lh, f32x16 (&o)[2]) {
    const float tm = xmax32(fmaxf(max16(t0), max16(t1)));
    if (__any(tm > m + 8.0f)) {
        const float mn = fmaxf(m, tm), mu0 = (mn == -INFINITY) ? 0.f : mn;
        const float alpha = __builtin_amdgcn_exp2f(m - mu0);
#pragma unroll
        for (int r = 0; r < 16; ++r) { o[0][r] *= alpha; o[1][r] *= alpha; }
        lh *= alpha; m = mn;
    }
    const float mu = (m == -INFINITY) ? 0.f : m;
#pragma unroll
    for (int r = 0; r < 16; ++r) { t0[r] = __builtin_amdgcn_exp2f(t0[r] - mu); t1[r] = __builtin_amdgcn_exp2f(t1[r] - mu); }
    lh += sum16(t0) + sum16(t1);
    attn_pv(vb, 0, L, t0, o); attn_pv(vb, 1, L, t1, o);
}
#define KEYIDX(hf, reg, h) (32 * (hf) + ((reg) & 3) + 8 * ((reg) >> 2) + 4 * (h))
__device__ __forceinline__ void score_far(f32x16& t0, f32x16& t1, float cb) {
#pragma unroll
    for (int r = 0; r < 16; ++r) { t0[r] = fmaf(t0[r], LOG2E, cb); t1[r] = fmaf(t1[r], LOG2E, cb); }
}
__device__ __forceinline__ void score_near1(f32x16& t, int hf, int h, LAS const float* lut, int hd, int dbase, int dstep, int dmax, int klim, bool colok) {
#pragma unroll
    for (int r = 0; r < 16; ++r) {
        const int ki = KEYIDX(hf, r, h); const int dist = dbase - dstep * ki; const int di = dist < 0 ? 0 : (dist > 127 ? 127 : dist); const float bv = lut[di * 8 + hd];
        const bool ok = colok && dist >= 0 && dist < dmax && ki < klim; const float v = fmaf(t[r], LOG2E, bv); t[r] = ok ? v : -INFINITY; }
}
__device__ __forceinline__ void score_near(f32x16& t0, f32x16& t1, int h, LAS const float* lut, int hd, int dbase, int dstep, int dmax, int klim, bool colok) {
    score_near1(t0, 0, h, lut, hd, dbase, dstep, dmax, klim, colok);
    __builtin_amdgcn_sched_barrier(0);
    score_near1(t1, 1, h, lut, hd, dbase, dstep, dmax, klim, colok);
    __builtin_amdgcn_sched_barrier(0);
}

__device__ __forceinline__ void win_unit(const Frame& F, const Args& A, LAS unsigned char* sh, int b, int g, int qb) {
    const bf16* PROJ = (const bf16*)(A.ws + WS_PROJ);
    const int lane = hw_lane(), w = F.wave, tid = w * 64 + lane;
    const AttnLane L = attn_lane(lane);
    const int tq = 64 * qb + 8 * w + (L.r32 >> 2), hd = g * 4 + (L.r32 & 3);
    const size_t tokq = (size_t)b * SEQ + tq;
    bf16x8 qf[4];
#pragma unroll
    for (int ks = 0; ks < 4; ++ks) qf[ks] = *(const bf16x8*)(PROJ + tokq * NPROJ + C_QN + hd * 64 + 16 * ks + 8 * L.h);
    LAS const float* lut = (LAS const float*)(sh + AT_LUT);
    const float bfar = lut[127 * 8 + hd];
    const int kt0 = qb >= 8 ? qb - 8 : 0, nt = qb - kt0 + 1;
    const int srow = tid >> 3, sch = tid & 7;
    const bf16* ksrc = PROJ + ((size_t)b * SEQ + srow) * NPROJ + C_WIN + g * 64 + sch * 8;
    v4u kr, vr;
    kr = *(const v4u*)(ksrc + (size_t)(64 * kt0) * NPROJ); vr = *(const v4u*)(ksrc + (size_t)(64 * kt0) * NPROJ + 128);
    __syncthreads();
    attn_commit(sh + AT_K0, sh + AT_V0, tid, kr, vr);
    __syncthreads();
    float m = -INFINITY, l = 0.f; f32x16 o[2]; o[0] = f32x16{}; o[1] = f32x16{};
    for (int it = 0; it < nt; ++it) {
        const int kt = kt0 + it, buf = it & 1;
        if (it + 1 < nt) { kr = *(const v4u*)(ksrc + (size_t)(64 * (kt + 1)) * NPROJ); vr = *(const v4u*)(ksrc + (size_t)(64 * (kt + 1)) * NPROJ + 128); }
        LAS const unsigned char* kb = sh + AT_K0 + buf * 8192; LAS const unsigned char* vb = sh + AT_V0 + buf * 8192;
        f32x16 t0 = attn_qk(kb, 0, L, qf), t1 = attn_qk(kb, 1, L, qf);
        if (kt <= qb - 3 && kt >= qb - 7) score_far(t0, t1, bfar);
        else score_near(t0, t1, L.h, lut, hd, tq - 64 * kt, 1, 512, 64, true);
        attn_softmax_pv(vb, L, t0, t1, m, l, o);
        if (it + 1 < nt) attn_commit(sh + AT_K0 + (buf ^ 1) * 8192, sh + AT_V0 + (buf ^ 1) * 8192, tid, kr, vr);
        __syncthreads();
    }
    const float rl = __builtin_amdgcn_rcpf(xsum32(l));
    bf16* dst = (bf16*)(A.ws + WS_OWIN) + tokq * 512 + hd * 64;
#pragma unroll
    for (int dt = 0; dt < 2; ++dt)
#pragma unroll
        for (int rq = 0; rq < 4; ++rq) { v2u wv; wv.x = cvtpk(o[dt][4 * rq] * rl, o[dt][4 * rq + 1] * rl); wv.y = cvtpk(o[dt][4 * rq + 2] * rl, o[dt][4 * rq + 3] * rl);
            *(v2u*)(dst + 32 * dt + 8 * rq + 4 * L.h) = wv; }
}

__device__ __forceinline__ void nsa_unit(const Frame& F, const Args& A, LAS unsigned char* sh, int b, int g, int qb) {
    const bf16* PROJ = (const bf16*)(A.ws + WS_PROJ);
    const int lane = hw_lane(), w = F.wave, tid = w * 64 + lane;
    const AttnLane L = attn_lane(lane);
    const int qloc = 8 * w + (L.r32 >> 2);
    const int tq = 64 * qb + qloc, hd = g * 4 + (L.r32 & 3);
    const size_t tokq = (size_t)b * SEQ + tq;
    LAS bf16x8* qlds = (LAS bf16x8*)(sh + AT_QF) + tid;
    __syncthreads();
#pragma unroll
    for (int ks = 0; ks < 4; ++ks) qlds[ks * 512] = *(const bf16x8*)(PROJ + tokq * NPROJ + C_QN + hd * 64 + 16 * ks + 8 * L.h);
#define NSA_LOADQ() bf16x8 qf[4]; _Pragma("unroll") for (int ks = 0; ks < 4; ++ks) qf[ks] = qlds[ks * 512]
    LAS const float* lut = (LAS const float*)(sh + AT_LUT);
    const float bfar = lut[127 * 8 + hd];
    LAS float* impA = (LAS float*)(sh + AT_IMPA); LAS float* impB = (LAS float*)(sh + AT_IMPB);
    LAS unsigned long long* selm = (LAS unsigned long long*)(sh + AT_SEL);
    const int srow = tid >> 3, sch = tid & 7;
    v4u kr, vr;
    const int nct = (4 * qb + 3 + 63) >> 6;
    const bf16* kcs = (const bf16*)(A.ws + WS_KCP) + ((size_t)(b * 256 + srow) * 2 + g) * 64 + sch * 8;
    const bf16* vcs = (const bf16*)(A.ws + WS_VCP) + ((size_t)(b * 256 + srow) * 2 + g) * 64 + sch * 8;
    __syncthreads();
    for (int e = tid; e < 64 * 65; e += NWAVES * 64) { impA[e] = 0.f; impB[e] = 0.f; }
    float mc = -INFINITY, lc = 0.f;
#pragma unroll 1
    for (int pass = 0; pass < 2; ++pass) {
        kr = *(const v4u*)(kcs); vr = *(const v4u*)(vcs);
        __syncthreads();
        attn_commit(sh + AT_K0, sh + AT_V0, tid, kr, vr);
        __syncthreads();
        const float mu = (mc == -INFINITY) ? 0.f : mc, il = lc > 0.f ? __builtin_amdgcn_rcpf(lc) : 0.f;
#pragma unroll 1
        for (int ct = 0; ct < nct; ++ct) {
            const int buf = ct & 1;
            if (ct + 1 < nct) { kr = *(const v4u*)(kcs + (size_t)(64 * (ct + 1)) * 128); vr = *(const v4u*)(vcs + (size_t)(64 * (ct + 1)) * 128); }
            LAS const unsigned char* kb = sh + AT_K0 + buf * 8192; LAS const unsigned char* vb = sh + AT_V0 + buf * 8192;
            NSA_LOADQ();
            f32x16 t0 = attn_qk(kb, 0, L, qf), t1 = attn_qk(kb, 1, L, qf);
            score_near(t0, t1, L.h, lut, hd, tq - 31 - 1024 * ct, 16, 1 << 30, 255 - 64 * ct, true);
            if (pass == 0) {
                const float tm = xmax32(fmaxf(max16(t0), max16(t1)));
                const float mn = fmaxf(mc, tm), mu0 = (mn == -INFINITY) ? 0.f : mn;
                const float alpha = __builtin_amdgcn_exp2f(mc - mu0);
                float ps = 0.f;
#pragma unroll
                for (int r = 0; r < 16; ++r) ps += __builtin_amdgcn_exp2f(t0[r] - mu0) + __builtin_amdgcn_exp2f(t1[r] - mu0);
                ps = xsum32(ps);
                lc = lc * alpha + ps; mc = mn;
            } else {
#pragma unroll
                for (int r = 0; r < 16; ++r) { t0[r] = __builtin_amdgcn_exp2f(t0[r] - mu) * il; t1[r] = __builtin_amdgcn_exp2f(t1[r] - mu) * il; }
#pragma unroll
                for (int hf = 0; hf < 2; ++hf) {
                    float x[16];
#pragma unroll
                    for (int r = 0; r < 16; ++r) { float v = hf ? t1[r] : t0[r]; v += __shfl_xor(v, 1); v += __shfl_xor(v, 2); x[r] = v; }
                    if ((L.r32 & 3) == 0) {
#pragma unroll
                        for (int rq = 0; rq < 4; ++rq) { const int jq = 16 * ct + 8 * hf + 2 * rq + L.h;
                            impA[qloc * 65 + jq] = 2.0f * (x[4 * rq] + x[4 * rq + 1] + x[4 * rq + 2]) + x[4 * rq + 3];
                            impB[qloc * 65 + jq + 1] = x[4 * rq + 3]; }
                    }
                }
            }
            if (ct + 1 < nct) attn_commit(sh + AT_K0 + (buf ^ 1) * 8192, sh + AT_V0 + (buf ^ 1) * 8192, tid, kr, vr);
            __syncthreads();
        }
    }
#pragma unroll 1
    for (int qi = 0; qi < 8; ++qi) {
        const int q = 8 * w + qi;
        unsigned long long mk;
        if (qb < 16) mk = (2ull << qb) - 1ull;
        else {
            const bool forced = (lane == 0) || (lane == qb) || (lane == qb - 1);
            const float sc = forced ? 1e9f : (lane <= qb ? impA[q * 65 + lane] + impB[q * 65 + lane] : -1.0f);
            int rank = 0;
#pragma unroll 8
            for (int jj = 0; jj < 64; ++jj) { const float ov = __uint_as_float(__builtin_amdgcn_readlane(__float_as_uint(sc), jj)); rank += ((ov > sc) || (ov == sc && jj < lane)) ? 1 : 0; }
            mk = __ballot(rank < 16 && lane <= qb);
        }
        if (lane == 0) selm[q] = mk;
    }
    __syncthreads();
    const unsigned long long mysel = selm[qloc];
    unsigned long long um = 0ull;
#pragma unroll 8
    for (int q_ = 0; q_ < 64; ++q_) um |= selm[q_];
    um = ((unsigned long long)__builtin_amdgcn_readfirstlane((unsigned)(um >> 32)) << 32) | (unsigned long long)__builtin_amdgcn_readfirstlane((unsigned)um);
    const bf16* ksrc = PROJ + ((size_t)b * SEQ + srow) * NPROJ + C_KV + 2 * 128 + g * 64 + sch * 8;
    float m = -INFINITY, l = 0.f; f32x16 o[2]; o[0] = f32x16{}; o[1] = f32x16{};
    int j = __builtin_ctzll(um); um &= um - 1;
    kr = *(const v4u*)(ksrc + (size_t)(64 * j) * NPROJ); vr = *(const v4u*)(ksrc + (size_t)(64 * j) * NPROJ + 128);
    attn_commit(sh + AT_K0, sh + AT_V0, tid, kr, vr);
    __syncthreads();
    int buf = 0;
#pragma unroll 1
    for (;;) {
        const int jn = um ? __builtin_ctzll(um) : -1; um &= um - 1;
        if (jn >= 0) { kr = *(const v4u*)(ksrc + (size_t)(64 * jn) * NPROJ); vr = *(const v4u*)(ksrc + (size_t)(64 * jn) * NPROJ + 128); }
        LAS const unsigned char* kb = sh + AT_K0 + buf * 8192; LAS const unsigned char* vb = sh + AT_V0 + buf * 8192;
        const bool selj = (mysel >> j) & 1ull;
        if (__any(selj)) {
            NSA_LOADQ();
            f32x16 t0 = attn_qk(kb, 0, L, qf), t1 = attn_qk(kb, 1, L, qf);
            if (j <= qb - 3) score_far(t0, t1, selj ? bfar : -INFINITY);
            else score_near(t0, t1, L.h, lut, hd, tq - 64 * j, 1, 1 << 30, 64, selj);
            attn_softmax_pv(vb, L, t0, t1, m, l, o);
        }
        if (jn >= 0) attn_commit(sh + AT_K0 + (buf ^ 1) * 8192, sh + AT_V0 + (buf ^ 1) * 8192, tid, kr, vr);
        __syncthreads();
        if (jn < 0) break;
        j = jn; buf ^= 1;
    }
    const bf16* gp = PROJ + tokq * NPROJ + C_GT + hd;
    const float g0 = __builtin_amdgcn_rcpf(1.0f + __expf(-bf2f(gp[0]))), g1 = __builtin_amdgcn_rcpf(1.0f + __expf(-bf2f(gp[8]))), g2 = __builtin_amdgcn_rcpf(1.0f + __expf(-bf2f(gp[16])));
    const float rl = g1 * __builtin_amdgcn_rcpf(xsum32(l));
    const bf16* ow = (const bf16*)(A.ws + WS_OWIN) + tokq * 512 + hd * 64;
#pragma unroll
    for (int dt = 0; dt < 2; ++dt)
#pragma unroll
        for (int rq = 0; rq < 4; ++rq) { const int d0 = 32 * dt + 8 * rq + 4 * L.h; const v2u wv = *(const v2u*)(ow + d0);
            o[dt][4 * rq] = rl * o[dt][4 * rq] + g2 * bflo(wv.x); o[dt][4 * rq + 1] = rl * o[dt][4 * rq + 1] + g2 * bfhi(wv.x);
            o[dt][4 * rq + 2] = rl * o[dt][4 * rq + 2] + g2 * bflo(wv.y); o[dt][4 * rq + 3] = rl * o[dt][4 * rq + 3] + g2 * bfhi(wv.y); }
    {
        const float mu = (mc == -INFINITY) ? 0.f : mc, il = lc > 0.f ? g0 * __builtin_amdgcn_rcpf(lc) : 0.f;
        kr = *(const v4u*)(kcs); vr = *(const v4u*)(vcs);
        attn_commit(sh + AT_K0, sh + AT_V0, tid, kr, vr);
        __syncthreads();
#pragma unroll 1
        for (int ct = 0; ct < nct; ++ct) {
            const int cbuf = ct & 1;
            if (ct + 1 < nct) { kr = *(const v4u*)(kcs + (size_t)(64 * (ct + 1)) * 128); vr = *(const v4u*)(vcs + (size_t)(64 * (ct + 1)) * 128); }
            LAS const unsigned char* kb = sh + AT_K0 + cbuf * 8192; LAS const unsigned char* vb = sh + AT_V0 + cbuf * 8192;
            NSA_LOADQ();
            f32x16 t0 = attn_qk(kb, 0, L, qf), t1 = attn_qk(kb, 1, L, qf);
            score_near(t0, t1, L.h, lut, hd, tq - 31 - 1024 * ct, 16, 1 << 30, 255 - 64 * ct, true);
#pragma unroll
            for (int r = 0; r < 16; ++r) { t0[r] = __builtin_amdgcn_exp2f(t0[r] - mu) * il; t1[r] = __builtin_amdgcn_exp2f(t1[r] - mu) * il; }
            attn_pv(vb, 0, L, t0, o); attn_pv(vb, 1, L, t1, o);
            if (ct + 1 < nct) attn_commit(sh + AT_K0 + (cbuf ^ 1) * 8192, sh + AT_V0 + (cbuf ^ 1) * 8192, tid, kr, vr);
            __syncthreads();
        }
    }
    bf16* dst = (bf16*)(A.ws + WS_MIX) + tokq * 1024 + hd * 64;
#pragma unroll
    for (int dt = 0; dt < 2; ++dt)
#pragma unroll
        for (int rq = 0; rq < 4; ++rq) { v2u ov; ov.x = cvtpk(o[dt][4 * rq], o[dt][4 * rq + 1]); ov.y = cvtpk(o[dt][4 * rq + 2], o[dt][4 * rq + 3]); *(v2u*)(dst + 32 * dt + 8 * rq + 4 * L.h) = ov; }
}
#undef NSA_LOADQ

__device__ __forceinline__ v4u pack_f32x8(const float* p) { const f32x4 a = *(const f32x4*)p, b = *(const f32x4*)(p + 4); v4u w; w.x = pk2(a.x, a.y); w.y = pk2(a.z, a.w); w.z = pk2(b.x, b.y); w.w = pk2(b.z, b.w); return w; }
__device__ __forceinline__ void samp_load(const Args& A, int mode, int tile, int b, int g, int srow, int sch, v4u& kr, v4u& vr) {
    const bf16* PROJ = (const bf16*)(A.ws + WS_PROJ);
    kr = (v4u){0, 0, 0, 0}; vr = (v4u){0, 0, 0, 0};
    if (mode == 0) {
        const size_t off = ((size_t)(b * 512 + 64 * tile + srow) * 2 + g) * 64 + sch * 8;
        kr = *(const v4u*)((const bf16*)(A.ws + WS_KCS) + off); vr = *(const v4u*)((const bf16*)(A.ws + WS_VCS) + off);
    } else if (mode == 1) {
        if (tile < 128) { const int page = ((const int*)A.in[5])[b * 64 + (tile >> 1)]; const int row = (tile & 1) * 64 + srow;
            const float* p = A.in[2] + ((size_t)(page * 128 + row) * 4 + 2) * 128 + g * 64 + sch * 8; kr = pack_f32x8(p); vr = pack_f32x8(p + 128); }
        else if (srow < 4) { const bf16* p = PROJ + (size_t)(TP + b * 4 + srow) * NPROJ + C_KV + 2 * 128 + g * 64 + sch * 8; kr = *(const v4u*)p; vr = *(const v4u*)(p + 128); }
    } else {
        const int idx = 64 * tile + srow;
        if (idx < 512) { const float* p = A.in[3] + ((size_t)(b * 512 + idx) * 2) * 128 + g * 64 + sch * 8; kr = pack_f32x8(p); vr = pack_f32x8(p + 128); }
        else if (idx < 516) { const bf16* p = PROJ + (size_t)(TP + b * 4 + idx - 512) * NPROJ + C_WIN + g * 64 + sch * 8; kr = *(const v4u*)p; vr = *(const v4u*)(p + 128); }
    }
}
__device__ __forceinline__ void samp_stage_tile(const Args& A, int mode, int tile, int b, int g, int lane, LAS unsigned char* kb, LAS unsigned char* vb) {
#pragma unroll 1
    for (int i0 = 0; i0 < 8; i0 += 2) {
        v4u kr[2], vr[2];
#pragma unroll
        for (int i = 0; i < 2; ++i) samp_load(A, mode, tile, b, g, (lane >> 3) + 8 * (i0 + i), lane & 7, kr[i], vr[i]);
#pragma unroll
        for (int i = 0; i < 2; ++i) { const int row = (lane >> 3) + 8 * (i0 + i), ch = lane & 7;
            *(LAS v4u*)(kb + row * 128 + ((ch ^ ((row >> 1) & 7)) << 4)) = kr[i];
            *(LAS v4u*)(vb + row * 128 + ((ch ^ (((row >> 1) & 1) << 2)) << 4)) = vr[i]; }
    }
}
__device__ __forceinline__ void samp_unit(const Frame& F, const Args& A, LAS unsigned char* sh, int b, int g) {
    const bf16* PROJ = (const bf16*)(A.ws + WS_PROJ);
    const int lane = hw_lane(), w = F.wave, tid = w * 64 + lane;
    const AttnLane L = attn_lane(lane);
    const bool colok = L.r32 < 16;
    const int qi = (L.r32 >> 2) & 3, hd = g * 4 + (L.r32 & 3);
    const int pos = PAST + qi;
    const size_t tokq = (size_t)TP + b * 4 + qi;
    LAS unsigned char* kb = sh + w * 16384; LAS unsigned char* vb = kb + 8192;
    LAS float* lut = (LAS float*)(sh + AT_LUT);
    LAS float* impA = (LAS float*)(sh + HI_IMPA); LAS float* impB = (LAS float*)(sh + HI_IMPB);
    LAS unsigned long long* selm = (LAS unsigned long long*)(sh + HI_SEL);
    LAS float* scs = (LAS float*)(sh + HI_SCS);
    LAS int* tlist = (LAS int*)(sh + HI_TL);
    LAS float* xch = (LAS float*)(sh + HI_XCH);
    bf16x8 qf[4];
#pragma unroll
    for (int ks = 0; ks < 4; ++ks) qf[ks] = *(const bf16x8*)(PROJ + tokq * NPROJ + C_QN + hd * 64 + 16 * ks + 8 * L.h);
    const float bfar = lut[127 * 8 + hd];
    __syncthreads();
    for (int e = tid; e < 4 * 132; e += NWAVES * 64) { impA[e] = 0.f; impB[e] = 0.f; }
    f32x16 oc[2]; oc[0] = f32x16{}; oc[1] = f32x16{};
    {
        samp_stage_tile(A, 0, w, b, g, lane, kb, vb);
        f32x16 t0 = attn_qk(kb, 0, L, qf), t1 = attn_qk(kb, 1, L, qf);
        score_near(t0, t1, L.h, lut, hd, pos - 31 - 1024 * w, 16, 1 << 30, 511 - 64 * w, colok);
        const float tm = xmax32(fmaxf(max16(t0), max16(t1)));
        xch[(w * 64 + lane) * 4] = tm;
        __syncthreads();
        float M = -INFINITY;
#pragma unroll
        for (int ww = 0; ww < 8; ++ww) M = fmaxf(M, xch[(ww * 64 + lane) * 4]);
        const float mu = (M == -INFINITY) ? 0.f : M;
#pragma unroll
        for (int r = 0; r < 16; ++r) { t0[r] = __builtin_amdgcn_exp2f(t0[r] - mu); t1[r] = __builtin_amdgcn_exp2f(t1[r] - mu); }
        const float ps = xsum32(sum16(t0) + sum16(t1));
        xch[(w * 64 + lane) * 4 + 1] = ps;
        __syncthreads();
        float Lc = 0.f;
#pragma unroll
        for (int ww = 0; ww < 8; ++ww) Lc += xch[(ww * 64 + lane) * 4 + 1];
        const float il = Lc > 0.f ? __builtin_amdgcn_rcpf(Lc) : 0.f;
#pragma unroll
        for (int r = 0; r < 16; ++r) { t0[r] *= il; t1[r] *= il; }
        attn_pv(vb, 0, L, t0, oc); attn_pv(vb, 1, L, t1, oc);
#pragma unroll
        for (int hf = 0; hf < 2; ++hf) {
            float x[16];
#pragma unroll
            for (int r = 0; r < 16; ++r) { float v = hf ? t1[r] : t0[r]; v += __shfl_xor(v, 1); v += __shfl_xor(v, 2); x[r] = v; }
            if ((L.r32 & 3) == 0 && colok) {
#pragma unroll
                for (int rq = 0; rq < 4; ++rq) { const int jq = 16 * w + 8 * hf + 2 * rq + L.h;
                    impA[qi * 132 + jq] = 2.0f * (x[4 * rq] + x[4 * rq + 1] + x[4 * rq + 2]) + x[4 * rq + 3];
                    impB[qi * 132 + jq + 1] = x[4 * rq + 3]; }
            }
        }
    }
    __syncthreads();
    if (w == 0) {
        unsigned long long ulo = 0ull, uhi = 0ull;
#pragma unroll 1
        for (int q = 0; q < 4; ++q) {
            const int j0 = lane, j1 = lane + 64;
            const float s0 = (j0 == 0) ? 1e9f : impA[q * 132 + j0] + impB[q * 132 + j0];
            const float s1 = (j1 == 127) ? 1e9f : impA[q * 132 + j1] + impB[q * 132 + j1];
            scs[j0] = s0; scs[j1] = s1;
            LDS_WAIT(); asm volatile("" ::: "memory");
            int r0 = 0, r1 = 0;
#pragma unroll 8
            for (int jj = 0; jj < 128; ++jj) { const float ov = scs[jj]; r0 += ((ov > s0) || (ov == s0 && jj < j0)) ? 1 : 0; r1 += ((ov > s1) || (ov == s1 && jj < j1)) ? 1 : 0; }
            const unsigned long long mlo = __ballot(r0 < 15), mhi = __ballot(r1 < 15);
            if (lane == 0) { selm[2 * q] = mlo; selm[2 * q + 1] = mhi; }
            ulo |= mlo; uhi |= mhi;
            LDS_WAIT(); asm volatile("" ::: "memory");
        }
        if (lane == 0) { int n = 0; for (int j = 0; j < 64; ++j) if ((ulo >> j) & 1ull) tlist[1 + n++] = j; for (int j = 0; j < 64; ++j) if ((uhi >> j) & 1ull) tlist[1 + n++] = 64 + j; tlist[1 + n++] = 128; tlist[0] = n; }
    }
    __syncthreads();
    const unsigned long long mylo = selm[2 * qi], myhi = selm[2 * qi + 1];
    const int nsel = tlist[0];
    const bf16* gp = PROJ + tokq * NPROJ + C_GT + hd;
    const float g0 = __builtin_amdgcn_rcpf(1.0f + __expf(-bf2f(gp[0]))), g1 = __builtin_amdgcn_rcpf(1.0f + __expf(-bf2f(gp[8]))), g2 = __builtin_amdgcn_rcpf(1.0f + __expf(-bf2f(gp[16])));
#pragma unroll
    for (int r = 0; r < 16; ++r) { oc[0][r] *= g0; oc[1][r] *= g0; }
#pragma unroll 1
    for (int br = 0; br < 2; ++br) {
        const int nt = br == 0 ? nsel : 9;
        float m = -INFINITY, l = 0.f; f32x16 o[2]; o[0] = f32x16{}; o[1] = f32x16{};
#pragma unroll 1
        for (int it = w; it < nt; it += 8) {
            const int j = br == 0 ? tlist[1 + it] : it;
            samp_stage_tile(A, 1 + br, j, b, g, lane, kb, vb);
            f32x16 t0 = attn_qk(kb, 0, L, qf), t1 = attn_qk(kb, 1, L, qf);
            if (br == 0) {
                const bool selj = colok && (j >= 128 ? true : (j < 64 ? ((mylo >> j) & 1ull) : ((myhi >> (j - 64)) & 1ull)));
                if (j <= 125) score_far(t0, t1, selj ? bfar : -INFINITY);
                else score_near(t0, t1, L.h, lut, hd, pos - 64 * j, 1, 1 << 30, 64, selj);
            } else score_near(t0, t1, L.h, lut, hd, pos - (PAST - 512 + 64 * j), 1, 512, 516 - 64 * j, colok);
            attn_softmax_pv(vb, L, t0, t1, m, l, o);
        }
        l = xsum32(l);
        xch[(w * 64 + lane) * 4 + 2] = m; xch[(w * 64 + lane) * 4 + 3] = l;
        __syncthreads();
        float M = -INFINITY;
#pragma unroll
        for (int ww = 0; ww < 8; ++ww) M = fmaxf(M, xch[(ww * 64 + lane) * 4 + 2]);
        float Lt = 0.f;
#pragma unroll
        for (int ww = 0; ww < 8; ++ww) { const float mw = xch[(ww * 64 + lane) * 4 + 2]; Lt += (mw == -INFINITY) ? 0.f : xch[(ww * 64 + lane) * 4 + 3] * __builtin_amdgcn_exp2f(mw - M); }
        const float sc = (m == -INFINITY || !(Lt > 0.f)) ? 0.f : (br == 0 ? g1 : g2) * __builtin_amdgcn_exp2f(m - M) * __builtin_amdgcn_rcpf(Lt);
#pragma unroll
        for (int r = 0; r < 16; ++r) { oc[0][r] += sc * o[0][r]; oc[1][r] += sc * o[1][r]; }
        __syncthreads();
    }
    { LAS float* part = (LAS float*)kb;
#pragma unroll
      for (int r = 0; r < 16; ++r) { part[r * 64 + lane] = oc[0][r]; part[(16 + r) * 64 + lane] = oc[1][r]; } }
    __syncthreads();
    if (w == 0 && colok) {
        float res[32];
#pragma unroll
        for (int r = 0; r < 32; ++r) { float a = 0.f;
#pragma unroll
            for (int ww = 0; ww < 8; ++ww) a += ((LAS const float*)(sh + ww * 16384))[r * 64 + lane];
            res[r] = a; }
        bf16* dst = (bf16*)(A.ws + WS_MIX) + tokq * 1024 + hd * 64;
#pragma unroll
        for (int dt = 0; dt < 2; ++dt)
#pragma unroll
            for (int rq = 0; rq < 4; ++rq) { const int d0 = 32 * dt + 8 * rq + 4 * L.h;
                v2u ov; ov.x = cvtpk(res[16 * dt + 4 * rq], res[16 * dt + 4 * rq + 1]); ov.y = cvtpk(res[16 * dt + 4 * rq + 2], res[16 * dt + 4 * rq + 3]); *(v2u*)(dst + d0) = ov; }
    }
}

__device__ __forceinline__ float gelu_tanh(float x) { const float u = 0.7978845608028654f * (x + 0.044715f * x * x * x); const float t = 1.0f - 2.0f / (1.0f + __expf(2.0f * u)); return 0.5f * x * (1.0f + t); }
constexpr int CM_X = 0, CM_SB = 2064  , CM_H = 32 * CM_SB + 1024, CM_HCOL = 272  , CM_HT = 32 * CM_HCOL, CM_END = CM_H + 4 * CM_HT;
constexpr int NCU_P = 4 * 2 * 2 * 9, NCU_S = 32 * 2 * 2 * 17;
__device__ __forceinline__ int cmp_decode(int u) { if (u < NCU_S) return (1 << 20) | ((u / 68) << 12) | (((u / 34) & 1) << 9) | (((u / 17) & 1) << 8) | (u % 17); const int j = u - NCU_S; return ((j / 36) << 12) | (((j / 18) & 1) << 9) | (((j / 9) & 1) << 8) | (j % 9); }
#define CU_SAMPLE(c) ((c) >> 20)
#define CU_B(c) (((c) >> 12) & 255)
#define CU_SLOT(c) (((c) >> 9) & 1)
#define CU_G(c) (((c) >> 8) & 1)
#define CU_GRP(c) ((c) & 255)
__device__ __forceinline__ void cmp_issue(const Args& A, const int c, int tid, v4u (&R)[16]) {
    if (CU_SAMPLE(c)) {
        const float* cache = A.in[2]; const int* pt = (const int*)A.in[5] + CU_B(c) * 64;
#pragma unroll
        for (int i = 0; i < 16; ++i) { const int q = tid + 512 * i, row = q >> 4, pc = q & 15; int p = 16 * 31 * CU_GRP(c) + row; p = p < PAST ? p : PAST - 1;
            const int page = pt[p >> 7];
            R[i] = *(const v4u*)(cache + ((size_t)(page * 128 + (p & 127)) * 4 + CU_SLOT(c)) * 128 + CU_G(c) * 64 + pc * 4); }
    } else {
        const bf16* PROJ = (const bf16*)(A.ws + WS_PROJ);
#pragma unroll
        for (int i = 0; i < 8; ++i) { const int q = tid + 512 * i, row = q >> 3, pc = q & 7; int p = 16 * 31 * CU_GRP(c) + row; p = p < SEQ ? p : SEQ - 1;
            R[i] = *(const v4u*)(PROJ + ((size_t)CU_B(c) * SEQ + p) * NPROJ + C_KV + CU_SLOT(c) * 128 + CU_G(c) * 64 + pc * 8); }
#pragma unroll
        for (int i = 8; i < 16; ++i) R[i] = (v4u){0u, 0u, 0u, 0u};
    }
}
__device__ __forceinline__ void cmp_commit(LAS unsigned char* sh, const int c, int tid, const v4u (&R)[16]) {
    if (CU_SAMPLE(c)) {
#pragma unroll
        for (int i = 0; i < 16; ++i) { const int q = tid + 512 * i, row = q >> 4, pc = q & 15;
            v2u w; w.x = pk2(__uint_as_float(R[i].x), __uint_as_float(R[i].y)); w.y = pk2(__uint_as_float(R[i].z), __uint_as_float(R[i].w));
            *(LAS v2u*)(sh + CM_X + (row >> 4) * CM_SB + (row & 15) * 128 + pc * 8) = w; }
    } else {
#pragma unroll
        for (int i = 0; i < 8; ++i) { const int q = tid + 512 * i, row = q >> 3, pc = q & 7; *(LAS v4u*)(sh + CM_X + (row >> 4) * CM_SB + (row & 15) * 128 + pc * 16) = R[i]; }
    }
}
__device__ __forceinline__ void cmp_phase(const Frame& F, const Args& A, LAS unsigned char* sh) {
    const int lane = hw_lane(), w = F.wave, tid = w * 64 + lane, r32 = lane & 31, h = lane >> 5;
    const int j = w & 1, ht = (w >> 1) & 1, kh = w >> 2;
    v4u R[16];
    int u = F.vcu;
    if (u >= NCU_S + NCU_P) return;
    int cu = cmp_decode(u);
    cmp_issue(A, cu, tid, R);
    for (;;) {
        __syncthreads();
        cmp_commit(sh, cu, tid, R);
        __syncthreads();
        const int cur = cu;
        const int un = u + F.G; const bool more = un < NCU_S + NCU_P;
        cu = cmp_decode(more ? un : u); cmp_issue(A, cu, tid, R);
        { const bf16* wf = (const bf16*)(A.ws + WS_WC1) + ((size_t)(((CU_SLOT(cur) * 2 + j) * 2 + ht) * 64 + 32 * kh) * 64 + lane) * 8;
          LAS const unsigned char* xb = sh + CM_X + r32 * CM_SB + h * 16;
          f32x16 acc = {};
#pragma unroll 16
          for (int k2 = 0; k2 < 32; ++k2) { const int ks = 32 * kh + k2; const bf16x8 af = *(const bf16x8*)(wf + (size_t)k2 * 512);
              const bf16x8 bf = *(LAS const bf16x8*)(xb + (ks >> 2) * 128 + (ks & 3) * 32);
              acc = __builtin_amdgcn_mfma_f32_32x32x16_bf16(af, bf, acc, 0, 0, 0); }
          LAS unsigned char* hb = sh + CM_H + (j * 2 + kh) * CM_HT + r32 * CM_HCOL + (32 * ht + 4 * h) * 4;
#pragma unroll
          for (int rq = 0; rq < 4; ++rq) *(LAS f32x4*)(hb + 32 * rq) = (f32x4){acc[4 * rq], acc[4 * rq + 1], acc[4 * rq + 2], acc[4 * rq + 3]}; }
        __syncthreads();
        if (w < 2) {
            const float* c1p = (const float*)(A.ws + WS_C1) + CU_SLOT(cur) * 64;
            const bf16* W2 = (const bf16*)(A.ws + WS_WC2) + (size_t)CU_SLOT(cur) * 64 * 64;
            const int i1 = r32 < 31 ? r32 + 1 : 31;
            f32x16 oo = {};
#pragma unroll
            for (int ks = 0; ks < 4; ++ks) {
                const int hid0 = 16 * ks + 8 * h; float xv[8];
#pragma unroll
                for (int e4 = 0; e4 < 2; ++e4) {
                    const f32x4 a0 = *(LAS const f32x4*)(sh + CM_H + 0 * CM_HT + r32 * CM_HCOL + (hid0 + 4 * e4) * 4), a1 = *(LAS const f32x4*)(sh + CM_H + 1 * CM_HT + r32 * CM_HCOL + (hid0 + 4 * e4) * 4);
                    const f32x4 b0 = *(LAS const f32x4*)(sh + CM_H + 2 * CM_HT + i1 * CM_HCOL + (hid0 + 4 * e4) * 4), b1 = *(LAS const f32x4*)(sh + CM_H + 3 * CM_HT + i1 * CM_HCOL + (hid0 + 4 * e4) * 4);
                    const f32x4 cc = *(const f32x4*)(c1p + hid0 + 4 * e4);
#pragma unroll
                    for (int e = 0; e < 4; ++e) xv[4 * e4 + e] = gelu_tanh((a0[e] + a1[e]) + (b0[e] + b1[e]) + cc[e]);
                }
                v4u pw; pw.x = cvtpk(xv[0], xv[1]); pw.y = cvtpk(xv[2], xv[3]); pw.z = cvtpk(xv[4], xv[5]); pw.w = cvtpk(xv[6], xv[7]);
                const bf16x8 af = *(const bf16x8*)(W2 + (size_t)(32 * w + r32) * 64 + hid0);
                oo = __builtin_amdgcn_mfma_f32_32x32x16_bf16(af, __builtin_bit_cast(bf16x8, pw), oo, 0, 0, 0);
            }
            const int nsb = CU_SAMPLE(cur) ? 512 : 256, sb = 31 * CU_GRP(cur) + r32;
            if (r32 < 31 && sb < nsb - 1) {
                bf16* dst = (bf16*)(A.ws + (CU_SAMPLE(cur) ? (CU_SLOT(cur) ? WS_VCS : WS_KCS) : (CU_SLOT(cur) ? WS_VCP : WS_KCP))) + ((size_t)(CU_B(cur) * nsb + sb) * 2 + CU_G(cur)) * 64 + 32 * w + 4 * h;
#pragma unroll
                for (int rq = 0; rq < 4; ++rq) { v2u wv; wv.x = cvtpk(oo[4 * rq], oo[4 * rq + 1]); wv.y = cvtpk(oo[4 * rq + 2], oo[4 * rq + 3]); *(v2u*)(dst + 8 * rq) = wv; }
            }
        }
        if (!more) break;
        u = un;
    }
}

__device__ __forceinline__ float log_sigmoid(float x) { return fminf(x, 0.f) - __logf(1.0f + __expf(-fabsf(x))); }
constexpr int G_QE = 0, G_KE = 8192, G_KDT = 16384, G_V = 24576, G_ST = 40960, G_LR = 73728, G_SEG = 77824, G_DEC = 79872, G_END = 80128;
__device__ __forceinline__ int sw128(int row, int ch) { return row * 128 + ((ch ^ ((row >> 1) & 7)) << 4); }

__device__ __forceinline__ void gla_local(const Frame& F, const Args& A, LAS unsigned char* sh, int unit) {
    const int b = unit >> 6, hh = (unit >> 4) & 3, sc = unit & 15;
    const int lane = hw_lane(), w = F.wave, tid = w * 64 + lane, r32 = lane & 31, h = lane >> 5;
    const bf16* PROJ = (const bf16*)(A.ws + WS_PROJ);
    const size_t tok0 = (size_t)b * SEQ + 256 * sc;
    const int c = lane;
    float wg[16];
#pragma unroll
    for (int r = 0; r < 16; ++r) wg[r] = A.in[13][r * 256 + hh * 64 + c];
    const float bg = A.in[14][hh * 64 + c];
    float Bprev = 0.f;
    const int dvt = w >> 1, it = w & 1;
    f32x16 accS = {};
    const int i16 = lane & 15, tq = i16 >> 2, tp = i16 & 3, g1 = (lane >> 4) & 1;
    const int vcol = ((4 * (dvt ^ tq) + 2 * g1 + (tp >> 1)) << 4) + (tp & 1) * 8;
    __syncthreads();
#pragma unroll 1
    for (int n = 0; n < 4; ++n) {
        const size_t tb = tok0 + 64 * n;
        { const int trow = tid >> 3, pr = tid & 7; const unsigned lw = *(const unsigned*)(PROJ + (tb + trow) * NPROJ + C_LR + 2 * pr);
          LAS float* lr = (LAS float*)(sh + G_LR); lr[trow * 16 + 2 * pr] = bflo(lw); lr[trow * 16 + 2 * pr + 1] = bfhi(lw);
#pragma unroll
          for (int k2 = 0; k2 < 2; ++k2) { const int ch = pr * 2 + k2; const v4u vv = *(const v4u*)(PROJ + (tb + trow) * NPROJ + C_VG + hh * 128 + ch * 8);
              *(LAS v4u*)(sh + G_V + trow * 256 + ((ch ^ ((trow & 3) << 2)) << 4)) = vv; } }
        __syncthreads();
        float cum[8], qv[8], kv[8];
        { LAS const float* lr = (LAS const float*)(sh + G_LR); float run = 0.f;
#pragma unroll
          for (int k = 0; k < 8; ++k) { const int i = 8 * w + k; float x = bg;
#pragma unroll
              for (int r = 0; r < 16; ++r) x += lr[i * 16 + r] * wg[r];
              run += log_sigmoid(x) * (1.0f / 16.0f); cum[k] = run;
              qv[k] = 0.125f * bf2f(PROJ[(tb + i) * NPROJ + C_QG + hh * 64 + c]); kv[k] = bf2f(PROJ[(tb + i) * NPROJ + C_KG + hh * 64 + c]); }
          ((LAS float*)(sh + G_SEG))[w * 64 + c] = run; }
        __syncthreads();
        { LAS const float* seg = (LAS const float*)(sh + G_SEG); float pre = 0.f, tot = 0.f;
#pragma unroll
          for (int g_ = 0; g_ < 8; ++g_) { const float sv = seg[g_ * 64 + c]; tot += sv; if (g_ < w) pre += sv; }
          const float eB = __expf(Bprev);
          unsigned kdw[4];
#pragma unroll
          for (int k = 0; k < 8; ++k) { const int i = 8 * w + k; const float bb = pre + cum[k];
              const float qe = qv[k] * __expf(bb), ke = kv[k] * __expf(-bb), kd = kv[k] * __expf(tot - bb);
              *(LAS unsigned short*)(sh + G_QE + sw128(i, c >> 3) + (c & 7) * 2) = (unsigned short)f2bf(qe);
              *(LAS unsigned short*)(sh + G_KE + sw128(i, c >> 3) + (c & 7) * 2) = (unsigned short)f2bf(ke);
              ((bf16*)(A.ws + WS_QB))[(tb + i) * 256 + hh * 64 + c] = (bf16)f2bf(qe * eB);
              if (k & 1) kdw[k >> 1] |= f2bf(kd) << 16; else kdw[k >> 1] = f2bf(kd); }
          *(LAS v4u*)(sh + G_KDT + sw128(c, w)) = (v4u){kdw[0], kdw[1], kdw[2], kdw[3]};
          if (w == 0) ((LAS float*)(sh + G_DEC))[c] = __expf(tot);
          Bprev += tot; }
        __syncthreads();
        LAS const unsigned char* qeb = sh + G_QE; LAS const unsigned char* keb = sh + G_KE; LAS const unsigned char* vbase = sh + G_V;
        bf16x8 qfr[4];
#pragma unroll
        for (int ks = 0; ks < 4; ++ks) qfr[ks] = *(LAS const bf16x8*)(qeb + sw128(32 * it + r32, 2 * ks + h));
        f32x16 oT = {};
#pragma unroll
        for (int jt = 0; jt < 2; ++jt) {
            if (jt <= it) {
                f32x16 s = {};
#pragma unroll
                for (int ks = 0; ks < 4; ++ks) { const bf16x8 kf = *(LAS const bf16x8*)(keb + sw128(32 * jt + r32, 2 * ks + h)); s = __builtin_amdgcn_mfma_f32_32x32x16_bf16(kf, qfr[ks], s, 0, 0, 0); }
                if (jt == it) {
#pragma unroll
                    for (int r = 0; r < 16; ++r) { const int j = (r & 3) + 8 * (r >> 2) + 4 * h; if (j > r32) s[r] = 0.f; }
                }
#pragma unroll
                for (int s2 = 0; s2 < 2; ++s2) {
                    v4u pw; pw.x = cvtpk(s[8 * s2], s[8 * s2 + 1]); pw.y = cvtpk(s[8 * s2 + 2], s[8 * s2 + 3]); pw.z = cvtpk(s[8 * s2 + 4], s[8 * s2 + 5]); pw.w = cvtpk(s[8 * s2 + 6], s[8 * s2 + 7]);
                    const int row = 32 * jt + 16 * s2 + 4 * h + tq;
                    const s16x4 lo = vtr(vbase + row * 256 + vcol), hi = vtr(vbase + (row + 8) * 256 + vcol);
                    const bf16x8 vf = {lo[0], lo[1], lo[2], lo[3], hi[0], hi[1], hi[2], hi[3]};
                    oT = __builtin_amdgcn_mfma_f32_32x32x16_bf16(vf, __builtin_bit_cast(bf16x8, pw), oT, 0, 0, 0);
                }
            }
        }
        if (n > 0) {
            LAS const unsigned char* stb = sh + G_ST + (n & 1) * 16384;
#pragma unroll
            for (int ks = 0; ks < 4; ++ks) { const bf16x8 sf = *(LAS const bf16x8*)(stb + sw128(32 * dvt + r32, 2 * ks + h)); oT = __builtin_amdgcn_mfma_f32_32x32x16_bf16(sf, qfr[ks], oT, 0, 0, 0); }
        }
        { float* op = (float*)(A.ws + WS_OLOC) + (tb + 32 * it + r32) * 512 + hh * 128 + 32 * dvt + 4 * h;
#pragma unroll
          for (int rq = 0; rq < 4; ++rq) *(f32x4*)(op + 8 * rq) = (f32x4){oT[4 * rq], oT[4 * rq + 1], oT[4 * rq + 2], oT[4 * rq + 3]}; }
        { const float dec = ((LAS const float*)(sh + G_DEC))[32 * it + r32];
#pragma unroll
          for (int r = 0; r < 16; ++r) accS[r] *= dec;
#pragma unroll
          for (int ks = 0; ks < 4; ++ks) {
              const bf16x8 kdf = *(LAS const bf16x8*)(sh + G_KDT + sw128(32 * it + r32, 2 * ks + h));
              const int row = 16 * ks + 8 * h + tq;
              const s16x4 lo = vtr(vbase + row * 256 + vcol), hi = vtr(vbase + (row + 4) * 256 + vcol);
              const bf16x8 vf = {lo[0], lo[1], lo[2], lo[3], hi[0], hi[1], hi[2], hi[3]};
              accS = __builtin_amdgcn_mfma_f32_32x32x16_bf16(vf, kdf, accS, 0, 0, 0);
          }
          LAS unsigned char* stn = sh + G_ST + ((n + 1) & 1) * 16384; const int d = 32 * it + r32;
#pragma unroll
          for (int r = 0; r < 16; ++r) { const int dv = 32 * dvt + (r & 3) + 8 * (r >> 2) + 4 * h; *(LAS unsigned short*)(stn + sw128(dv, d >> 3) + (d & 7) * 2) = (unsigned short)f2bf(accS[r]); } }
        __syncthreads();
    }
    { float* up = (float*)(A.ws + WS_USC) + (size_t)unit * 8192; const int d = 32 * it + r32;
#pragma unroll
      for (int r = 0; r < 16; ++r) { const int dv = 32 * dvt + (r & 3) + 8 * (r >> 2) + 4 * h; up[dv * 64 + d] = accS[r]; }
      if (w == 0) ((float*)(A.ws + WS_DSC))[unit * 64 + c] = __expf(Bprev); }
}

__device__ __forceinline__ void gla_out(const Frame& F, const Args& A, LAS unsigned char* sh, int unit) {
    const int b = unit >> 6, hh = (unit >> 4) & 3, sc = unit & 15;
    const int lane = hw_lane(), w = F.wave, tid = w * 64 + lane, r32 = lane & 31, h = lane >> 5;
    const bf16* PROJ = (const bf16*)(A.ws + WS_PROJ);
    const size_t tok0 = (size_t)b * SEQ + 256 * sc;
    const int d4 = (tid & 15) * 4, dvr = tid >> 4;
    f32x4 S[4];
#pragma unroll
    for (int k = 0; k < 4; ++k) S[k] = (f32x4){0.f, 0.f, 0.f, 0.f};
    const float* U0 = (const float*)(A.ws + WS_USC) + (size_t)(unit - sc) * 8192; const float* D0 = (const float*)(A.ws + WS_DSC) + (size_t)(unit - sc) * 64;
#pragma unroll 1
    for (int s = 0; s < sc; ++s) { const f32x4 dd = *(const f32x4*)(D0 + s * 64 + d4);
#pragma unroll
        for (int k = 0; k < 4; ++k) { const f32x4 u = *(const f32x4*)(U0 + (size_t)s * 8192 + (32 * k + dvr) * 64 + d4); S[k] = S[k] * dd + u; } }
    __syncthreads();
#pragma unroll
    for (int k = 0; k < 4; ++k) { const int dv = 32 * k + dvr; v2u wv; wv.x = pk2(S[k].x, S[k].y); wv.y = pk2(S[k].z, S[k].w);
        *(LAS v2u*)(sh + sw128(dv, d4 >> 3) + (d4 & 7) * 2) = wv; }
    if (sc == 15) {
        const f32x4 dd = *(const f32x4*)(D0 + 15 * 64 + d4); float* op = A.out + O_GLAP + (size_t)(b * 4 + hh) * 8192;
#pragma unroll
        for (int k = 0; k < 4; ++k) { const int dv = 32 * k + dvr; const f32x4 u = *(const f32x4*)(U0 + (size_t)15 * 8192 + dv * 64 + d4); const f32x4 e = S[k] * dd + u;
            op[(d4 + 0) * 128 + dv] = e.x; op[(d4 + 1) * 128 + dv] = e.y; op[(d4 + 2) * 128 + dv] = e.z; op[(d4 + 3) * 128 + dv] = e.w; }
    }
    __syncthreads();
    const size_t tok = tok0 + 32 * w + r32;
    f32x16 acc[4];
#pragma unroll
    for (int t = 0; t < 4; ++t) acc[t] = f32x16{};
#pragma unroll
    for (int ks = 0; ks < 4; ++ks) { const bf16x8 qb = *(const bf16x8*)((const bf16*)(A.ws + WS_QB) + tok * 256 + hh * 64 + 16 * ks + 8 * h);
#pragma unroll
        for (int t = 0; t < 4; ++t) { const bf16x8 sf = *(LAS const bf16x8*)(sh + sw128(32 * t + r32, 2 * ks + h)); acc[t] = __builtin_amdgcn_mfma_f32_32x32x16_bf16(sf, qb, acc[t], 0, 0, 0); } }
    const float* ol = (const float*)(A.ws + WS_OLOC) + tok * 512 + hh * 128;
    float ss = 0.f;
#pragma unroll
    for (int t = 0; t < 4; ++t)
#pragma unroll
        for (int rq = 0; rq < 4; ++rq) { const f32x4 v = *(const f32x4*)(ol + 32 * t + 8 * rq + 4 * h);
#pragma unroll
            for (int e = 0; e < 4; ++e) { acc[t][4 * rq + e] += v[e]; ss += acc[t][4 * rq + e] * acc[t][4 * rq + e]; } }
    ss += __shfl_xor(ss, 32);
    const float rstd = 1.0f / sqrtf(ss * (1.0f / 128.0f) + EPS);
    const float* gn = A.in[15]; const bf16* gg = PROJ + tok * NPROJ + C_GG + hh * 128;
    bf16* dst = (bf16*)(A.ws + WS_MIX) + tok * 1024 + 512 + hh * 128;
#pragma unroll
    for (int t = 0; t < 4; ++t)
#pragma unroll
        for (int rq = 0; rq < 4; ++rq) { const int dv0 = 32 * t + 8 * rq + 4 * h; const f32x4 gnv = *(const f32x4*)(gn + dv0); const v2u gw = *(const v2u*)(gg + dv0);
            const float gv[4] = {bflo(gw.x), bfhi(gw.x), bflo(gw.y), bfhi(gw.y)}; float y[4];
#pragma unroll
            for (int e = 0; e < 4; ++e) y[e] = acc[t][4 * rq + e] * rstd * gnv[e] * gv[e] * __builtin_amdgcn_rcpf(1.0f + __expf(-gv[e]));
            v2u ov; ov.x = cvtpk(y[0], y[1]); ov.y = cvtpk(y[2], y[3]); *(v2u*)(dst + dv0) = ov; }
}

__device__ __forceinline__ void gla_sample(const Frame& F, const Args& A, LAS unsigned char* sh, int unit) {
    const int b = unit >> 2, hh = unit & 3, tid = F.wave * 64 + hw_lane();
    const bf16* PROJ = (const bf16*)(A.ws + WS_PROJ);
    LAS float* la = (LAS float*)sh;
    LAS float* qs = la + 256;
    LAS float* ks = qs + 256;
    LAS float* op = ks + 256;
    LAS float* of = op + 2048;
    __syncthreads();
    if (tid < 256) { const int t = tid >> 6, c = tid & 63; const size_t tok = (size_t)TP + b * 4 + t; float x = A.in[14][hh * 64 + c];
#pragma unroll
        for (int r = 0; r < 16; ++r) x += bf2f(PROJ[tok * NPROJ + C_LR + r]) * A.in[13][r * 256 + hh * 64 + c];
        la[tid] = __expf(log_sigmoid(x) * (1.0f / 16.0f)); qs[tid] = 0.125f * bf2f(PROJ[tok * NPROJ + C_QG + hh * 64 + c]); ks[tid] = bf2f(PROJ[tok * NPROJ + C_KG + hh * 64 + c]); }
    __syncthreads();
    const int dv = tid & 127, cg = tid >> 7;
    const float* s0 = A.in[4] + (size_t)(b * 4 + hh) * 8192;
    float S[16];
#pragma unroll
    for (int k = 0; k < 16; ++k) S[k] = s0[(16 * cg + k) * 128 + dv];
#pragma unroll
    for (int t = 0; t < 4; ++t) { const float vv = bf2f(PROJ[((size_t)TP + b * 4 + t) * NPROJ + C_VG + hh * 128 + dv]); float o = 0.f;
#pragma unroll
        for (int k = 0; k < 16; ++k) { const int c = 16 * cg + k; S[k] = la[t * 64 + c] * S[k] + ks[t * 64 + c] * vv; o += qs[t * 64 + c] * S[k]; }
        op[(cg * 4 + t) * 128 + dv] = o; }
    float* so = A.out + O_GLAS + (size_t)(b * 4 + hh) * 8192;
#pragma unroll
    for (int k = 0; k < 16; ++k) so[(16 * cg + k) * 128 + dv] = S[k];
    __syncthreads();
    { const int t = tid >> 7; of[t * 128 + dv] = (op[(0 * 4 + t) * 128 + dv] + op[(1 * 4 + t) * 128 + dv]) + (op[(2 * 4 + t) * 128 + dv] + op[(3 * 4 + t) * 128 + dv]); }
    __syncthreads();
    { const int t = tid >> 7; float ss = 0.f;
      for (int k = 0; k < 128; ++k) { const float v = of[t * 128 + k]; ss += v * v; }
      const float rstd = 1.0f / sqrtf(ss * (1.0f / 128.0f) + EPS); const size_t tok = (size_t)TP + b * 4 + t;
      const float gv = bf2f(PROJ[tok * NPROJ + C_GG + hh * 128 + dv]);
      const float y = of[t * 128 + dv] * rstd * A.in[15][dv] * gv * __builtin_amdgcn_rcpf(1.0f + __expf(-gv));
      ((bf16*)(A.ws + WS_MIX))[tok * 1024 + 512 + hh * 128 + dv] = (bf16)f2bf(y); }
}

#ifdef PROBE_PHASE
#define PREP(k) ((PROBE_PHASE) == (k) ? 2 : 1)
#else
#define PREP(k) 1
#endif
__device__ __forceinline__ void phase2(const Frame& F, const Args& A) {
    LAS unsigned char* sh = F.lds;
#ifndef SKIP_CMP
    _Pragma("unroll 1") for (int rep = 0; rep < PREP(21); ++rep) cmp_phase(F, A, sh);
#endif
    #ifndef SKIP_GLAL
    _Pragma("unroll 1") for (int rep = 0; rep < PREP(22); ++rep) for (int u = F.vcu; u < 256; u += F.G) gla_local(F, A, sh, u);
#endif
    #ifndef SKIP_GLAS
    _Pragma("unroll 1") for (int rep = 0; rep < PREP(24); ++rep) for (int u = F.vcu; u < 128; u += F.G) gla_sample(F, A, sh, u);
#endif
    __syncthreads();
    attn_fill_lut((LAS float*)(sh + AT_LUT), A.in[24], F.tid);
    __syncthreads();
    _Pragma("unroll 1") for (int rep = 0; rep < PREP(23); ++rep) for (int p = F.vcu; p < 256; p += F.G) { const int bg = p >> 5, s = p & 31;
#ifndef SKIP_WIN
 win_unit(F, A, sh, bg >> 1, bg & 1, 63 - s); win_unit(F, A, sh, bg >> 1, bg & 1, s);
#endif
 }
}
__device__ __forceinline__ void phase3(const Frame& F, const Args& A) {
    LAS unsigned char* sh = F.lds;
    #ifndef SKIP_GLAO
    _Pragma("unroll 1") for (int rep = 0; rep < PREP(31); ++rep) for (int u = F.vcu; u < 256; u += F.G) gla_out(F, A, sh, u);
#endif
    __syncthreads();
    attn_fill_lut((LAS float*)(sh + AT_LUT), A.in[24], F.tid);
    __syncthreads();
    { gu32* qh = (gu32*)(A.ws + WS_CTL) + CW_Q3 + 64 * (F.vcu >> 5); LAS int* slot = (LAS int*)(sh + HI_Q);
      const int bg = (F.vcu >> 5) & 7;
      for (;;) {
          __syncthreads();
          if (F.wave == 0 && hw_lane() == 0) *slot = (int)__hip_atomic_fetch_add(qh, 1u, __ATOMIC_RELAXED, __HIP_MEMORY_SCOPE_AGENT);
          __syncthreads();
          const int idx = *slot;
          if (idx >= 72 * PREP(33)) break;
          const int k = idx % 72;
          if (k < 8) {
#ifndef SKIP_SAMP
              const int u = bg * 8 + k; samp_unit(F, A, sh, u >> 1, u & 1);
#endif
          } else {
#ifndef SKIP_NSA
              nsa_unit(F, A, sh, bg >> 1, bg & 1, 71 - k);
#endif
          }
      } }
}

template <class Epi>
__device__ __forceinline__ void skinny_phase(const Frame& F, const bf16* Act, int lda, const bf16* Bt, int K, int ncolgrp, const Epi& E) {
    const int lane = hw_lane(), w = F.wave, c16 = lane & 15, kg = lane >> 4;
    const int tg = w & 1, kq = w >> 1, kq_len = K / 4;
    LAS f32x4* xs = (LAS f32x4*)F.lds;
    for (int job = blockIdx.x; job < 4 * ncolgrp; job += F.G) {
        const int cg = job >> 2, tok = TP + 32 * (job & 3) + 16 * tg + c16;
        const bf16* ap = Bt + (size_t)(16 * cg + c16) * K + kq * kq_len + 8 * kg;
        const bf16* bp = Act + (size_t)tok * lda + kq * kq_len + 8 * kg;
        f32x4 acc = {0.f, 0.f, 0.f, 0.f};
#pragma unroll 8
        for (int ks = 0; ks < kq_len / 32; ++ks) { const bf16x8 af = *(const bf16x8*)(ap + 32 * ks), bf = *(const bf16x8*)(bp + 32 * ks); acc = __builtin_amdgcn_mfma_f32_16x16x32_bf16(af, bf, acc, 0, 0, 0); }
        __syncthreads();
        xs[w * 64 + lane] = acc;
        __syncthreads();
        if (kq == 0) { const f32x4 v = (xs[tg * 64 + lane] + xs[(2 + tg) * 64 + lane]) + (xs[(4 + tg) * 64 + lane] + xs[(6 + tg) * 64 + lane]); E(v, tok, 16 * cg + 4 * kg, kg); }
    }
}
struct SkInProj { bf16* proj; float* out;
    __device__ __forceinline__ void operator()(f32x4 v, int tok, int col, int kg) const {
        if (col < 512) v = v * 0.125f;
        v2u w; w.x = cvtpk(v[0], v[1]); w.y = cvtpk(v[2], v[3]); *(v2u*)(proj + (size_t)tok * NPROJ + col) = w;
        if (col >= C_KV && col < C_WIN) *(f32x4*)(out + O_KV + (size_t)tok * 512 + (col - C_KV)) = v;
        else if (col >= C_WIN && col < C_GT) { const int rs = tok - TP, b = rs >> 2, i = rs & 3; *(f32x4*)(out + O_WINS + ((size_t)(b * 512 + 508 + i) * 256 + (col - C_WIN))) = v; }
    } };
struct SkResid { const float* base; float* hout; bf16* hb; float* rowss;
    __device__ __forceinline__ void operator()(f32x4 v, int tok, int col, int kg) const {
        v = v + *(const f32x4*)(base + (size_t)(tok - TP) * 1024 + col);
        *(f32x4*)(hout + (size_t)tok * 1024 + col) = v;
        v2u w; w.x = cvtpk(v[0], v[1]); w.y = cvtpk(v[2], v[3]); *(v2u*)(hb + (size_t)tok * 1024 + col) = w;
        float ss = (v[0] * v[0] + v[1] * v[1]) + (v[2] * v[2] + v[3] * v[3]); ss += __shfl_xor(ss, 16); ss += __shfl_xor(ss, 32);
        if (kg == 0) atomicAdd(rowss + tok, ss);
    } };
struct SkBf { bf16* O; int ldc;
    __device__ __forceinline__ void operator()(f32x4 v, int tok, int col, int kg) const { v2u w; w.x = cvtpk(v[0], v[1]); w.y = cvtpk(v[2], v[3]); *(v2u*)(O + (size_t)tok * ldc + col) = w; } };
struct SkPleGate { const float* h2; const bf16* ple; const float* rowss2; float* y; float* rowss3;
    __device__ __forceinline__ void operator()(f32x4 a, int tok, int col, int kg) const {
        const float rstd = __builtin_amdgcn_rsqf(rowss2[tok] * (1.0f / 1024.0f) + EPS);
        const v2u pw = *(const v2u*)(ple + (size_t)tok * 1024 + col); const f32x4 b = *(const f32x4*)(h2 + (size_t)tok * 1024 + col);
        const float pv[4] = {bflo(pw.x), bfhi(pw.x), bflo(pw.y), bfhi(pw.y)}; f32x4 v;
#pragma unroll
        for (int e = 0; e < 4; ++e) v[e] = b[e] + pv[e] * __builtin_amdgcn_rcpf(1.0f + __expf(-a[e] * rstd));
        *(f32x4*)(y + (size_t)tok * 1024 + col) = v;
        float ss = (v[0] * v[0] + v[1] * v[1]) + (v[2] * v[2] + v[3] * v[3]); ss += __shfl_xor(ss, 16); ss += __shfl_xor(ss, 32);
        if (kg == 0) atomicAdd(rowss3 + tok, ss);
    } };

typedef const __attribute__((address_space(4))) Args* ArgsP;
__device__ __forceinline__ Args load_args() {
    Args r{};
#if defined(__HIP_DEVICE_COMPILE__)
    ArgsP p = (ArgsP)__builtin_amdgcn_kernarg_segment_ptr(); asm volatile("" : "+s"(p));
#pragma unroll
    for (int i = 0; i < 26; ++i) r.in[i] = p->in[i];
    r.out = p->out; r.ws = p->ws; r.ph_lo = p->ph_lo; r.ph_hi = p->ph_hi;
#endif
    return r;
}
__global__ void __launch_bounds__(NWAVES * 64, 2) mega_fwd(Args args_unused) {
    extern __shared__ __attribute__((aligned(16))) unsigned char lds_raw[];
    Frame F;
    F.lds = (LAS unsigned char*)lds_raw;
    F.wave = __builtin_amdgcn_readfirstlane((int)threadIdx.x >> 6); F.lane = hw_lane(); F.tid = F.wave * 64 + F.lane;
    F.G = gridDim.x; { const int bx = blockIdx.x; F.vcu = (F.G % 8 == 0) ? (bx % 8) * (F.G / 8) + bx / 8 : bx; }
    int lo, hi; unsigned char* ws;
    { const Args a0 = load_args(); lo = a0.ph_lo; hi = a0.ph_hi; ws = a0.ws; }
    gu32* ctl = (gu32*)(ws + WS_CTL);
    volatile LAS unsigned* MISC = (volatile LAS unsigned*)(F.lds + MISC_OFF);
    for (int u = F.tid; u < (LDS_BYTES - RING_BYTES) / 4; u += NWAVES * 64) ((LAS unsigned*)(F.lds + RING_BYTES))[u] = 0u;
    __syncthreads();
    const bool multi = (hi - lo) > 1;
    XcdBarrier bar; bar.bar = (unsigned*)(ctl + CW_BAR); bar.x = 0; bar.st = nullptr;
    if (multi) bar = xcd_barrier_post((unsigned*)(ctl + CW_BAR), MISC + 8, F.tid);
#define IN(k) (lo <= (k) && (k) < hi)
#ifdef PROBE_PHASE
#define NREP(k) ((PROBE_PHASE) == (k) ? 2 : 1)
#else
#define NREP(k) 1
#endif
    float* dummy_rowss = (float*)(ws + WS_END);
#define SEAM(k) do { if (IN(k) && IN((k) + 1)) { F.lane = hw_lane(); F.tid = F.wave * 64 + F.lane; xcd_barrier(bar, F.tid); } } while (0)
#define REFRESH() do { F.lane = hw_lane(); F.tid = F.wave * 64 + F.lane; } while (0)

    if (IN(0)) { REFRESH(); const Args args = load_args(); _Pragma("unroll 1") for (int rep = 0; rep < NREP(0); ++rep) { __syncthreads(); p0_prologue(F, args); } } SEAM(0);
    if (IN(1)) { REFRESH(); const Args args = load_args(); unsigned char* ws = args.ws;
        pg8::Gemm g{(const pg8::bf16_t*)(ws + WS_XN), (const pg8::bf16_t*)(ws + WS_WIN), TP, NPROJ, 1024}; pg8::StaticOrder S; S.init(TP, NPROJ, F.G, (int)blockIdx.x);
        pg8::EpiInProj E{(pg8::bf16_t*)(ws + WS_PROJ), args.out};
        _Pragma("unroll 1") for (int rep = 0; rep < NREP(1); ++rep) pg8::gemm_phase<pg8::EpiInProj, pg8::StaticOrder, true, true>(F.lds, g, S, E, F.tid);
        skinny_phase(F, (const bf16*)(ws + WS_XN), 1024, (const bf16*)(ws + WS_WIN), 1024, (NIN + 15) / 16, SkInProj{(bf16*)(ws + WS_PROJ), args.out});
    } SEAM(1);
    if (IN(2)) { REFRESH(); const Args args = load_args(); phase2(F, args); } SEAM(2);
    if (IN(3)) { REFRESH(); const Args args = load_args(); phase3(F, args); } SEAM(3);
    if (IN(4)) { REFRESH(); const Args args = load_args(); unsigned char* ws = args.ws; float* rowss1 = (float*)(ws + WS_ROWSS);
        { pg8::Gemm g{(const pg8::bf16_t*)(ws + WS_MIX), (const pg8::bf16_t*)(ws + WS_WO), TP, 1024, 1024}; pg8::StaticOrder S; S.init(TP, 1024, F.G, (int)blockIdx.x);
          _Pragma("unroll 1") for (int rep = 0; rep < NREP(4); ++rep) { pg8::EpiResid E{args.in[0], args.in[1], (float*)(ws + WS_H1), (pg8::bf16_t*)(ws + WS_H1B), rep ? dummy_rowss : rowss1};
          pg8::gemm_phase<pg8::EpiResid, pg8::StaticOrder, true, true>(F.lds, g, S, E, F.tid); } }
        { pg8::Gemm g{(const pg8::bf16_t*)(ws + WS_PPLE), (const pg8::bf16_t*)(ws + WS_WPLE), TP, 1024, 256}; pg8::StaticOrder S; S.init(TP, 1024, F.G, (int)blockIdx.x);
          pg8::EpiBf E{(pg8::bf16_t*)(ws + WS_PLEB), 1024};
          _Pragma("unroll 1") for (int rep = 0; rep < NREP(41); ++rep) pg8::gemm_phase<pg8::EpiBf, pg8::StaticOrder, true, true>(F.lds, g, S, E, F.tid); }
        skinny_phase(F, (const bf16*)(ws + WS_MIX), 1024, (const bf16*)(ws + WS_WO), 1024, 64, SkResid{args.in[1], (float*)(ws + WS_H1), (bf16*)(ws + WS_H1B), rowss1});
        skinny_phase(F, (const bf16*)(ws + WS_PPLE), 256, (const bf16*)(ws + WS_WPLE), 256, 64, SkBf{(bf16*)(ws + WS_PLEB), 1024});
    } SEAM(4);
    if (IN(5)) { REFRESH(); const Args args = load_args(); unsigned char* ws = args.ws; float* rowss1 = (float*)(ws + WS_ROWSS);
        pg8::Gemm g{(const pg8::bf16_t*)(ws + WS_H1B), (const pg8::bf16_t*)(ws + WS_WGU), MPAD, NGU, 1024}; pg8::StaticOrder S; S.init(MPAD, NGU, F.G, (int)blockIdx.x);
        pg8::EpiGateUp E{(pg8::bf16_t*)(ws + WS_ACT), rowss1};
        _Pragma("unroll 1") for (int rep = 0; rep < NREP(5); ++rep) pg8::gemm_phase<pg8::EpiGateUp, pg8::StaticOrder, true, true>(F.lds, g, S, E, F.tid);
    } SEAM(5);
    if (IN(6)) { REFRESH(); const Args args = load_args(); unsigned char* ws = args.ws; float* rowss2 = (float*)(ws + WS_ROWSS) + MPAD;
        pg8::Gemm g{(const pg8::bf16_t*)(ws + WS_ACT), (const pg8::bf16_t*)(ws + WS_WDN), TP, 1024, DFF}; pg8::StaticOrder S; S.init(TP, 1024, F.G, (int)blockIdx.x);
        _Pragma("unroll 1") for (int rep = 0; rep < NREP(6); ++rep) { pg8::EpiResid E{(const float*)(ws + WS_H1), (const float*)(ws + WS_H1) + (size_t)TP * 1024, (float*)(ws + WS_H2), (pg8::bf16_t*)(ws + WS_H2B), rep ? dummy_rowss : rowss2};
        pg8::gemm_phase<pg8::EpiResid, pg8::StaticOrder, true, true>(F.lds, g, S, E, F.tid); }
        skinny_phase(F, (const bf16*)(ws + WS_ACT), DFF, (const bf16*)(ws + WS_WDN), DFF, 64, SkResid{(const float*)(ws + WS_H1) + (size_t)TP * 1024, (float*)(ws + WS_H2), (bf16*)(ws + WS_H2B), rowss2});
    } SEAM(6);
    if (IN(7)) { REFRESH(); const Args args = load_args(); unsigned char* ws = args.ws; float* rowss2 = (float*)(ws + WS_ROWSS) + MPAD; float* rowss3 = rowss2 + MPAD;
        pg8::Gemm g{(const pg8::bf16_t*)(ws + WS_H2B), (const pg8::bf16_t*)(ws + WS_WPG), TP, 1024, 1024}; pg8::StaticOrder S; S.init(TP, 1024, F.G, (int)blockIdx.x);
        _Pragma("unroll 1") for (int rep = 0; rep < NREP(7); ++rep) { pg8::EpiPleGate E{(const float*)(ws + WS_H2), (const pg8::bf16_t*)(ws + WS_PLEB), rowss2, args.out + O_Y, rep ? dummy_rowss : rowss3};
        pg8::gemm_phase<pg8::EpiPleGate, pg8::StaticOrder, true, true>(F.lds, g, S, E, F.tid); }
        skinny_phase(F, (const bf16*)(ws + WS_H2B), 1024, (const bf16*)(ws + WS_WPG), 1024, 64, SkPleGate{(const float*)(ws + WS_H2), (const bf16*)(ws + WS_PLEB), rowss2, args.out + O_Y, rowss3});
    } SEAM(7);
    if (IN(8)) { REFRESH(); const Args args = load_args(); unsigned char* ws = args.ws; float* rowss3 = (float*)(ws + WS_ROWSS) + 2 * MPAD;
        const int gw = F.vcu * NWAVES + F.wave, NGW = F.G * NWAVES; const GAS f32x4* gr = (const GAS f32x4*)args.in[25] + F.lane;
        for (int m = gw; m < MTOT; m += NGW) { GAS f32x4* yr = (GAS f32x4*)(args.out + O_Y + (size_t)m * 1024) + F.lane; const float rstd = 1.0f / sqrtf(rowss3[m] * (1.0f / 1024.0f) + EPS);
#pragma unroll
            for (int j = 0; j < 4; ++j) { const f32x4 v = yr[64 * j], gg = gr[64 * j]; yr[64 * j] = (f32x4){v.x * rstd * gg.x, v.y * rstd * gg.y, v.z * rstd * gg.z, v.w * rstd * gg.w}; } }
    }
#undef IN
#undef SEAM
#undef REFRESH
}

extern "C" void kernel_launch(void* const* d_in, const int* in_sizes, int n_in, void* d_out, int out_size, void* d_ws, size_t ws_size, hipStream_t stream) {
    static int grid = 0;
    if (grid == 0) {
        if (n_in != 26 || (size_t)out_size != O_END || ws_size < WS_END + (1u << 20)) { fprintf(stderr, "kernel_launch: unexpected shapes: n_in %d out %d ws %zu\n", n_in, out_size, ws_size); grid = -1; return; }
        int dev = 0, cus = 0, per_cu = 0;
        if (hipGetDevice(&dev) != hipSuccess || hipDeviceGetAttribute(&cus, hipDeviceAttributeMultiprocessorCount, dev) != hipSuccess) { grid = -1; return; }
        if (hipFuncSetAttribute((const void*)mega_fwd, hipFuncAttributeMaxDynamicSharedMemorySize, LDS_BYTES) != hipSuccess) { fprintf(stderr, "kernel_launch: hipFuncSetAttribute failed\n"); grid = -1; return; }
        if (hipOccupancyMaxActiveBlocksPerMultiprocessor(&per_cu, (const void*)mega_fwd, NWAVES * 64, LDS_BYTES) != hipSuccess || per_cu < 1) { fprintf(stderr, "kernel_launch: occupancy query says %d blocks per CU\n", per_cu); grid = -1; return; }
        (void)hipGetLastError();
        grid = cus;
    }
    if (grid < 0) return;
    (void)hipMemsetAsync((char*)d_ws + WS_CTL, 0, CTL_ZERO_BYTES, stream);
    Args a{};
    for (int i = 0; i < 26; ++i) a.in[i] = (const float*)d_in[i];
    a.out = (float*)d_out; a.ws = (unsigned char*)d_ws;
#ifndef N_LAUNCH_SPLIT
    a.ph_lo = 0; a.ph_hi = 9;
    hipLaunchKernelGGL(mega_fwd, dim3(grid), dim3(NWAVES * 64), LDS_BYTES, stream, a);
#else
    for (int p = 0; p < 9; ++p) { a.ph_lo = p; a.ph_hi = p + 1; hipLaunchKernelGGL(mega_fwd, dim3(grid), dim3(NWAVES * 64), LDS_BYTES, stream, a); }
#endif
}
```

```cpp
#include <hip/hip_runtime.h>
#include <cstdio>
#include <cstdint>

constexpr int DM = 1024, TP = 16384, TS = 128, MTOT = TP + TS, MPAD = 16640, SEQ = 4096, NBATCH = 4, DBATCH = 32, DSEQ = 4, PAST = 8192;
constexpr int NPROJ = 3072, DFF = 2816, DPLE = 256, NGU = 2 * DFF;
constexpr int C_QN = 0, C_KV = 512, C_WIN = 1024, C_GT = 1280, C_QG = 1304, C_KG = 1560, C_VG = 1816, C_LR = 2328, C_GG = 2344, NIN = 2856;
constexpr float EPS = 1e-6f;
constexpr size_t O_Y = 0, O_KV = (size_t)MTOT * 1024, O_WINP = O_KV + (size_t)MTOT * 512, O_WINS = O_WINP + 4 * 512 * 256,
                 O_GLAP = O_WINS + (size_t)32 * 512 * 256, O_GLAS = O_GLAP + 4 * 4 * 64 * 128, O_END = O_GLAS + (size_t)32 * 4 * 64 * 128;
namespace pg8 {
#define PG8_LAS __attribute__((address_space(3)))
typedef unsigned short bf16_t;
typedef short bf16x8 __attribute__((ext_vector_type(8)));
typedef float f32x4 __attribute__((ext_vector_type(4)));
typedef unsigned u32x4 __attribute__((ext_vector_type(4)));
constexpr int BM = 256, BK = 64, HALF = 128, HTB = HALF * BK * 2  , STAGE_BYTES = 8 * HTB, NXCD = 8, WGM = 8;

__host__ __device__ __forceinline__ int lds_byte(int r, int c) { const int st = (r >> 4) * 2 + (c >> 5), rr = r & 15, cc = c & 31, ob = rr * 64 + cc * 2; return st * 1024 + (ob ^ (((ob >> 9) & 1) << 5)); }
__host__ __device__ __forceinline__ void stage_rc(int b, int& R, int& C) { const int st = b / 1024, sb = b % 1024, swz = sb ^ (((sb >> 9) & 1) << 5); R = (st >> 1) * 16 + swz / 64; C = (st & 1) * 32 + (swz % 64) / 2; }
__host__ __device__ __forceinline__ int perm32(int rho) { const int n = rho >> 4, i = rho & 15; return 8 * (i >> 2) + 4 * n + (i & 3); }

struct Unit { int pm, pn; };
struct Gemm { const bf16_t* A; const bf16_t* Bt; int M, N, K; };

struct StaticOrder {
    int nM, nN, nwg, G, c;
    __host__ __device__ void init(int M, int N, int G_, int c_) { nM = M / BM; nN = N / BM; nwg = nM * nN; G = G_; c = c_; }
    __host__ __device__ bool next(int i, Unit& u) const {
        const long L = (long)i * G + c; if (L >= nwg) return false;
        int wgid = (int)L; { const int q = nwg / NXCD, r = nwg % NXCD, xcd = wgid % NXCD, off = wgid / NXCD; wgid = (xcd < r ? xcd * (q + 1) : r * (q + 1) + (xcd - r) * q) + off; }
        const int nig = WGM * nN, gid = wgid / nig, fm = gid * WGM, gsz = (nM - fm) < WGM ? (nM - fm) : WGM;
        u.pm = fm + ((wgid % nig) % gsz); u.pn = (wgid % nig) / gsz; return true;
    }
    __device__ __forceinline__ void a_ready(const Unit&) const {}
    __device__ __forceinline__ void done(const Unit&) const {}
};

__device__ __forceinline__ unsigned cvt_pk_bf16(float lo, float hi) { unsigned r; asm volatile("v_cvt_pk_bf16_f32 %0, %1, %2" : "=v"(r) : "v"(lo), "v"(hi)); return r; }

__device__ __forceinline__ u32x4 pack8(const f32x4 v0, const f32x4 v1) { u32x4 w; w.x = cvt_pk_bf16(v0[0], v0[1]); w.y = cvt_pk_bf16(v0[2], v0[3]); w.z = cvt_pk_bf16(v1[0], v1[1]); w.w = cvt_pk_bf16(v1[2], v1[3]); return w; }

struct EpiInProj {
    static constexpr bool PERM = true, AFTER_DRAIN = false;
    bf16_t* proj; float* out;
    __device__ __forceinline__ void operator()(const f32x4 (&acc)[2][2][4][2], const Unit& u, int wr, int wc, int fr, int fq) const {
        const int row0 = u.pm * BM + wr * 64 + fr, colb = u.pn * BM + wc * 32 + 8 * fq;
        const float sc = (u.pn < 2) ? 0.125f : 1.0f;
#pragma unroll
        for (int ai = 0; ai < 2; ++ai)
#pragma unroll
            for (int m = 0; m < 4; ++m) {
                const int r = row0 + ai * HALF + m * 16;
                if (r < MTOT) {
#pragma unroll
                    for (int bj = 0; bj < 2; ++bj) {
                        const int c = colb + bj * HALF;
                        const f32x4 v0 = acc[ai][bj][m][0] * sc, v1 = acc[ai][bj][m][1] * sc;
                        *(u32x4*)(proj + (size_t)r * NPROJ + c) = pack8(v0, v1);
                        if (u.pn == 2 || u.pn == 3) { float* o = out + O_KV + (size_t)r * 512 + (c - C_KV); *(f32x4*)o = v0; *(f32x4*)(o + 4) = v1; }
                        if (u.pn == 4) {
                            const int cc = c - C_WIN; float* o = nullptr;
                            if (r < TP) { const int pos = r & (SEQ - 1), b = r >> 12; if (pos >= SEQ - 512) o = out + O_WINP + ((size_t)(b * 512 + pos - (SEQ - 512)) * 256 + cc); }
                            else { const int rs = r - TP, b = rs >> 2, i = rs & 3; o = out + O_WINS + ((size_t)(b * 512 + 508 + i) * 256 + cc); }
                            if (o) { *(f32x4*)o = v0; *(f32x4*)(o + 4) = v1; }
                        }
                    }
                }
            }
    }
};
struct EpiResid {
    static constexpr bool PERM = true, AFTER_DRAIN = false;
    const float* baseA; const float* baseB;
    float* hout; bf16_t* hb; float* rowss;
    __device__ __forceinline__ void operator()(const f32x4 (&acc)[2][2][4][2], const Unit& u, int wr, int wc, int fr, int fq) const {
        const int row0 = u.pm * BM + wr * 64 + fr, colb = u.pn * BM + wc * 32 + 8 * fq;
#pragma unroll
        for (int ai = 0; ai < 2; ++ai)
#pragma unroll
            for (int m = 0; m < 4; ++m) {
                const int r = row0 + ai * HALF + m * 16;
                float ss = 0.f;
                if (r < MTOT) {
                    const float* bp = (r < TP) ? baseA + (size_t)r * 1024 : baseB + (size_t)(r - TP) * 1024;
#pragma unroll
                    for (int bj = 0; bj < 2; ++bj) {
                        const int c = colb + bj * HALF;
                        const f32x4 v0 = acc[ai][bj][m][0] + *(const f32x4*)(bp + c), v1 = acc[ai][bj][m][1] + *(const f32x4*)(bp + c + 4);
                        float* o = hout + (size_t)r * 1024 + c; *(f32x4*)o = v0; *(f32x4*)(o + 4) = v1;
                        *(u32x4*)(hb + (size_t)r * 1024 + c) = pack8(v0, v1);
                        ss += (v0[0] * v0[0] + v0[1] * v0[1]) + (v0[2] * v0[2] + v0[3] * v0[3]) + (v1[0] * v1[0] + v1[1] * v1[1]) + (v1[2] * v1[2] + v1[3] * v1[3]);
                    }
                }
                ss += __shfl_xor(ss, 16); ss += __shfl_xor(ss, 32);
                if (fq == 0 && r < MTOT) atomicAdd(rowss + r, ss);
            }
    }
};
struct EpiGateUp {
    static constexpr bool PERM = true, AFTER_DRAIN = false;
    bf16_t* act; const float* rowss;
    __device__ __forceinline__ void operator()(const f32x4 (&acc)[2][2][4][2], const Unit& u, int wr, int wc, int fr, int fq) const {
        const int row0 = u.pm * BM + wr * 64 + fr, colb = u.pn * HALF + wc * 32 + 8 * fq;
#pragma unroll
        for (int ai = 0; ai < 2; ++ai)
#pragma unroll
            for (int m = 0; m < 4; ++m) {
                const int r = row0 + ai * HALF + m * 16;
                if (r < MTOT) {
                    const float rstd = __builtin_amdgcn_rsqf(rowss[r] * (1.0f / 1024.0f) + EPS);
                    f32x4 o[2];
#pragma unroll
                    for (int n = 0; n < 2; ++n)
#pragma unroll
                        for (int e = 0; e < 4; ++e) { const float g = acc[ai][0][m][n][e] * rstd, up = acc[ai][1][m][n][e] * rstd; o[n][e] = g * up * __builtin_amdgcn_rcpf(1.0f + __expf(-g)); }
                    *(u32x4*)(act + (size_t)r * DFF + colb) = pack8(o[0], o[1]);
                }
            }
    }
};
struct EpiBf {
    static constexpr bool PERM = true, AFTER_DRAIN = false;
    bf16_t* O; int ldc;
    __device__ __forceinline__ void operator()(const f32x4 (&acc)[2][2][4][2], const Unit& u, int wr, int wc, int fr, int fq) const {
        const int row0 = u.pm * BM + wr * 64 + fr, colb = u.pn * BM + wc * 32 + 8 * fq;
#pragma unroll
        for (int ai = 0; ai < 2; ++ai)
#pragma unroll
            for (int m = 0; m < 4; ++m) {
                const int r = row0 + ai * HALF + m * 16;
                if (r < MTOT) {
#pragma unroll
                    for (int bj = 0; bj < 2; ++bj) *(u32x4*)(O + (size_t)r * ldc + colb + bj * HALF) = pack8(acc[ai][bj][m][0], acc[ai][bj][m][1]);
                }
            }
    }
};
struct EpiPleGate {
    static constexpr bool PERM = true, AFTER_DRAIN = false;
    const float* h2; const bf16_t* ple; const float* rowss2; float* y; float* rowss3;
    __device__ __forceinline__ void operator()(const f32x4 (&acc)[2][2][4][2], const Unit& u, int wr, int wc, int fr, int fq) const {
        const int row0 = u.pm * BM + wr * 64 + fr, colb = u.pn * BM + wc * 32 + 8 * fq;
#pragma unroll
        for (int ai = 0; ai < 2; ++ai)
#pragma unroll
            for (int m = 0; m < 4; ++m) {
                const int r = row0 + ai * HALF + m * 16;
                float ss = 0.f;
                if (r < MTOT) {
                    const float rstd = __builtin_amdgcn_rsqf(rowss2[r] * (1.0f / 1024.0f) + EPS);
#pragma unroll
                    for (int bj = 0; bj < 2; ++bj) {
                        const int c = colb + bj * HALF;
                        const u32x4 pw = *(const u32x4*)(ple + (size_t)r * 1024 + c);
                        const f32x4 b0 = *(const f32x4*)(h2 + (size_t)r * 1024 + c), b1 = *(const f32x4*)(h2 + (size_t)r * 1024 + c + 4);
                        float pv[8];
#pragma unroll
                        for (int e = 0; e < 4; ++e) { pv[2 * e] = __uint_as_float(pw[e] << 16); pv[2 * e + 1] = __uint_as_float(pw[e] & 0xffff0000u); }
                        f32x4 v0, v1;
#pragma unroll
                        for (int e = 0; e < 4; ++e) {
                            v0[e] = b0[e] + pv[e] * __builtin_amdgcn_rcpf(1.0f + __expf(-acc[ai][bj][m][0][e] * rstd));
                            v1[e] = b1[e] + pv[4 + e] * __builtin_amdgcn_rcpf(1.0f + __expf(-acc[ai][bj][m][1][e] * rstd));
                        }
                        float* o = y + (size_t)r * 1024 + c; *(f32x4*)o = v0; *(f32x4*)(o + 4) = v1;
                        ss += (v0[0] * v0[0] + v0[1] * v0[1]) + (v0[2] * v0[2] + v0[3] * v0[3]) + (v1[0] * v1[0] + v1[1] * v1[1]) + (v1[2] * v1[2] + v1[3] * v1[3]);
                    }
                }
                ss += __shfl_xor(ss, 16); ss += __shfl_xor(ss, 32);
                if (fq == 0 && r < MTOT) atomicAdd(rowss3 + r, ss);
            }
    }
};
template <class Epi, class Sched, bool ALIGN_EPI = false, bool SP2 = false>
__device__ __forceinline__ void gemm_phase(PG8_LAS unsigned char* lds, const Gemm g, const Sched& S, const Epi& E, const int tid) {
    const int wid = __builtin_amdgcn_readfirstlane(tid >> 6), lane = tid & 63, wr = wid >> 2, wc = wid & 3, fr = lane & 15, fq = lane >> 4;
    const int K = g.K, nt = K / BK;
    unsigned voffA[2], voffB[2];
#pragma unroll
    for (int i = 0; i < 2; ++i) { int R, C; stage_rc(tid * 16 + i * 8192, R, C); const int Rb = Epi::PERM ? ((R & ~31) + perm32(R & 31)) : R;
        voffA[i] = (unsigned)(R * K + C) * 2u; voffB[i] = (unsigned)(Rb * K + C) * 2u; }
    const size_t kstep = (size_t)(BK * 2);
    const size_t hstep = (size_t)HALF * K * 2;
    const size_t tstep = 2 * hstep;
    const unsigned ldsw = (unsigned)wid * 1024u;
    const int aoff = lds_byte(wr * 64 + fr, fq * 8), boff = lds_byte(wc * 32 + fr, fq * 8);
#define PG8_SA(b, h) (((b) * 2 + (h)) * HTB)
#define PG8_SB(b, h) ((4 + (b) * 2 + (h)) * HTB)
#define PG8_STAGE(bufoff, gbase, voff) do { _Pragma("unroll") for (int _i = 0; _i < 2; ++_i) \
        __builtin_amdgcn_global_load_lds((const unsigned*)((const char*)(gbase) + (voff)[_i]), (PG8_LAS unsigned*)(lds + (bufoff) + ldsw + _i * 8192), 16, 0, 0); } while (0)
#define PG8_LDA(dst, b, h) do { _Pragma("unroll") for (int m = 0; m < 4; ++m) _Pragma("unroll") for (int k = 0; k < 2; ++k) dst[m][k] = *(const PG8_LAS bf16x8*)(lds + PG8_SA(b, h) + aoff + m * 2048 + k * 1024); } while (0)
#define PG8_LDB(dst, b, h) do { _Pragma("unroll") for (int n = 0; n < 2; ++n) _Pragma("unroll") for (int k = 0; k < 2; ++k) dst[n][k] = *(const PG8_LAS bf16x8*)(lds + PG8_SB(b, h) + boff + n * 2048 + k * 1024); } while (0)
#define PG8_MMA(ai, bj, At, Bt) do { __builtin_amdgcn_s_setprio(1); _Pragma("unroll") for (int m = 0; m < 4; ++m) _Pragma("unroll") for (int n = 0; n < 2; ++n) _Pragma("unroll") for (int k = 0; k < 2; ++k) \
        acc[ai][bj][m][n] = __builtin_amdgcn_mfma_f32_16x16x32_bf16(Bt[n][k], At[m][k], acc[ai][bj][m][n], 0, 0, 0); __builtin_amdgcn_s_setprio(0); } while (0)
#define PG8_WAIT_V(n) asm volatile("s_waitcnt vmcnt(" #n ")" ::: "memory")
#define PG8_WAIT_L(n) asm volatile("s_waitcnt lgkmcnt(" #n ")" ::: "memory")
#define PG8_BAR __builtin_amdgcn_s_barrier()
#define PG8_SCHED __builtin_amdgcn_sched_barrier(0)
    Unit cur, nxt; int ui = 0;
    if (!S.next(0, cur)) return;
    f32x4 acc[2][2][4][2];
#pragma unroll
    for (int a = 0; a < 2; ++a)
#pragma unroll
        for (int b = 0; b < 2; ++b)
#pragma unroll
            for (int m = 0; m < 4; ++m)
#pragma unroll
                for (int n = 0; n < 2; ++n) acc[a][b][m][n] = (f32x4){0.f, 0.f, 0.f, 0.f};
    bf16x8 At[4][2], B0[2][2], B1[2][2];
    const char* cA = (const char*)g.A + (size_t)cur.pm * tstep; const char* cB = (const char*)g.Bt + (size_t)cur.pn * tstep;
    S.a_ready(cur);
    if constexpr (SP2) {
        PG8_STAGE(PG8_SB(0, 0), cB, voffB); PG8_STAGE(PG8_SB(0, 1), cB + hstep, voffB); PG8_STAGE(PG8_SA(0, 0), cA, voffA); PG8_STAGE(PG8_SA(0, 1), cA + hstep, voffA);
        if (wr == 1) PG8_BAR;
        PG8_WAIT_V(2); PG8_BAR;
        PG8_STAGE(PG8_SB(1, 0), cB + kstep, voffB); PG8_STAGE(PG8_SA(1, 0), cA + kstep, voffA); PG8_STAGE(PG8_SB(1, 1), cB + hstep + kstep, voffB);
        PG8_WAIT_V(6); PG8_BAR;
    } else {
        PG8_STAGE(PG8_SB(0, 0), cB, voffB); PG8_STAGE(PG8_SA(0, 0), cA, voffA); PG8_STAGE(PG8_SB(0, 1), cB + hstep, voffB); PG8_STAGE(PG8_SA(0, 1), cA + hstep, voffA);
        if (wr == 1) PG8_BAR;
        PG8_WAIT_V(4); PG8_BAR;
        PG8_STAGE(PG8_SB(1, 0), cB + kstep, voffB); PG8_STAGE(PG8_SA(1, 0), cA + kstep, voffA); PG8_STAGE(PG8_SB(1, 1), cB + hstep + kstep, voffB);
        PG8_WAIT_V(6); PG8_BAR;
    }
    for (;;) {
        const bool has_next = S.next(ui + 1, nxt);
        const char* nA = has_next ? (const char*)g.A + (size_t)nxt.pm * tstep : cA; const char* nB = has_next ? (const char*)g.Bt + (size_t)nxt.pn * tstep : cB;
        for (int t = 0; t < nt; t += 2) {
            const bool last = (t == nt - 2);
            const char* a1 = cA + (size_t)(t + 1) * kstep;
            const char* a2 = last ? nA : cA + (size_t)(t + 2) * kstep; const char* b2 = last ? nB : cB + (size_t)(t + 2) * kstep;
            const char* a3 = a2 + kstep; const char* b3 = b2 + kstep;
            if (last && has_next) S.a_ready(nxt);
            if constexpr (SP2) {
            PG8_LDB(B0, 0, 0); PG8_LDB(B1, 0, 1); PG8_SCHED; PG8_LDA(At, 0, 0); PG8_STAGE(PG8_SA(1, 1), a1 + hstep, voffA);
            PG8_WAIT_V(8); PG8_WAIT_L(0); PG8_BAR; PG8_MMA(0, 0, At, B0); PG8_MMA(0, 1, At, B1); PG8_BAR; PG8_SCHED;
            PG8_LDA(At, 0, 1); PG8_STAGE(PG8_SB(0, 0), b2, voffB); PG8_STAGE(PG8_SB(0, 1), b2 + hstep, voffB); PG8_STAGE(PG8_SA(0, 0), a2, voffA);
            PG8_WAIT_V(8); PG8_WAIT_L(0); PG8_BAR; PG8_MMA(1, 0, At, B0); PG8_MMA(1, 1, At, B1); PG8_BAR; PG8_SCHED;
            PG8_LDB(B0, 1, 0); PG8_LDB(B1, 1, 1); PG8_SCHED; PG8_LDA(At, 1, 0); PG8_STAGE(PG8_SA(0, 1), a2 + hstep, voffA);
            PG8_WAIT_V(8); PG8_WAIT_L(0); PG8_BAR; PG8_MMA(0, 0, At, B0); PG8_MMA(0, 1, At, B1); PG8_BAR; PG8_SCHED;
            PG8_LDA(At, 1, 1); PG8_STAGE(PG8_SB(1, 0), b3, voffB); PG8_STAGE(PG8_SB(1, 1), b3 + hstep, voffB); PG8_STAGE(PG8_SA(1, 0), a3, voffA);
            PG8_WAIT_V(8); PG8_WAIT_L(0); PG8_BAR; PG8_MMA(1, 0, At, B0); PG8_MMA(1, 1, At, B1); PG8_BAR; PG8_SCHED;
            } else {
            PG8_LDB(B0, 0, 0); PG8_SCHED; PG8_LDA(At, 0, 0); PG8_STAGE(PG8_SA(1, 1), a1 + hstep, voffA);
            PG8_WAIT_L(8); PG8_BAR; PG8_WAIT_L(0); PG8_MMA(0, 0, At, B0); PG8_BAR; PG8_SCHED;
            PG8_LDB(B1, 0, 1); PG8_STAGE(PG8_SB(0, 0), b2, voffB);
            PG8_BAR; PG8_WAIT_L(0); PG8_MMA(0, 1, At, B1); PG8_BAR;
            PG8_LDA(At, 0, 1); PG8_STAGE(PG8_SA(0, 0), a2, voffA);
            PG8_BAR; PG8_WAIT_L(0); PG8_MMA(1, 0, At, B0); PG8_BAR; PG8_SCHED;
            PG8_STAGE(PG8_SB(0, 1), b2 + hstep, voffB);
            PG8_WAIT_V(6); PG8_BAR; PG8_MMA(1, 1, At, B1); PG8_BAR;
            PG8_LDB(B0, 1, 0); PG8_SCHED; PG8_LDA(At, 1, 0); PG8_STAGE(PG8_SA(0, 1), a2 + hstep, voffA);
            PG8_WAIT_L(8); PG8_BAR; PG8_WAIT_L(0); PG8_MMA(0, 0, At, B0); PG8_BAR; PG8_SCHED;
            PG8_LDB(B1, 1, 1); PG8_STAGE(PG8_SB(1, 0), b3, voffB);
            PG8_BAR; PG8_WAIT_L(0); PG8_MMA(0, 1, At, B1); PG8_BAR;
            PG8_LDA(At, 1, 1); PG8_STAGE(PG8_SA(1, 0), a3, voffA);
            PG8_BAR; PG8_WAIT_L(0); PG8_MMA(1, 0, At, B0); PG8_BAR; PG8_SCHED;
            PG8_STAGE(PG8_SB(1, 1), b3 + hstep, voffB);
            PG8_WAIT_V(6); PG8_BAR; PG8_MMA(1, 1, At, B1); PG8_BAR;
            }
        }
        if constexpr (ALIGN_EPI) { if (wr == 0) PG8_BAR; }
        if constexpr (!Epi::AFTER_DRAIN) { E(acc, cur, wr, wc, fr, fq); S.done(cur); }
        if (!has_next) break;
#pragma unroll
        for (int a = 0; a < 2; ++a)
#pragma unroll
            for (int b = 0; b < 2; ++b)
#pragma unroll
                for (int m = 0; m < 4; ++m)
#pragma unroll
                    for (int n = 0; n < 2; ++n) acc[a][b][m][n] = (f32x4){0.f, 0.f, 0.f, 0.f};
        cur = nxt; cA = nA; cB = nB; ++ui;
        if constexpr (ALIGN_EPI) { if (wr == 1) PG8_BAR; }
    }
    PG8_WAIT_V(0);
    if constexpr (!ALIGN_EPI) { if (wr == 0) PG8_BAR; }
    PG8_BAR;
    if constexpr (Epi::AFTER_DRAIN) { E.fused(acc, cur, wr, wc, fr, fq, lds, wid, lane); S.done(cur); }
#undef PG8_SA
#undef PG8_SB
#undef PG8_STAGE
#undef PG8_LDA
#undef PG8_LDB
#undef PG8_MMA
#undef PG8_WAIT_V
#undef PG8_WAIT_L
#undef PG8_BAR
#undef PG8_SCHED
}
}


#define GAS __attribute__((address_space(1)))
#define LAS __attribute__((address_space(3)))
typedef unsigned short bf16;
typedef unsigned v4u __attribute__((ext_vector_type(4)));
typedef unsigned v2u __attribute__((ext_vector_type(2)));
typedef float f32x4 __attribute__((ext_vector_type(4)));
typedef float f32x2 __attribute__((ext_vector_type(2)));
typedef float f32x16 __attribute__((ext_vector_type(16)));
typedef short bf16x8 __attribute__((ext_vector_type(8)));
typedef short s16x4 __attribute__((ext_vector_type(4)));
typedef GAS unsigned gu32;
#define RLX_AGENT __ATOMIC_RELAXED, __HIP_MEMORY_SCOPE_AGENT
#define LDS_WAIT() asm volatile("s_waitcnt lgkmcnt(0)" ::: "memory")
#define VM_WAIT() asm volatile("s_waitcnt vmcnt(0)" ::: "memory")
__device__ __forceinline__ unsigned f2bf(float f) { unsigned u = __builtin_bit_cast(unsigned, f); return (u + 0x7fffu + ((u >> 16) & 1u)) >> 16; }
__device__ __forceinline__ unsigned pk2(float lo, float hi) { return f2bf(lo) | (f2bf(hi) << 16); }
__device__ __forceinline__ float bf2f(unsigned short h) { return __uint_as_float(((unsigned)h) << 16); }
__device__ __forceinline__ float bflo(unsigned w) { return __uint_as_float(w << 16); }
__device__ __forceinline__ float bfhi(unsigned w) { return __uint_as_float(w & 0xffff0000u); }

constexpr int NWAVES = 8;
constexpr size_t MiB = 1u << 20;
constexpr size_t WS_CTL = 0, CTL_ZERO_BYTES = 1 * MiB;
constexpr int CW_BAR = 4096, CW_Q3 = 16384;
constexpr size_t WS_ROWSS = 256 * 1024;
constexpr size_t WS_WIN = 2 * MiB;
constexpr size_t WS_WO = 8 * MiB;
constexpr size_t WS_WGU = 10 * MiB;
constexpr size_t WS_WDN = 21 * MiB;
constexpr size_t WS_WPG = 27 * MiB;
constexpr size_t WS_WPLE = 29 * MiB;
constexpr size_t WS_WC1 = 30 * MiB;
constexpr size_t WS_WC2 = 31 * MiB;
constexpr size_t WS_C1 = 31 * MiB + 65536;
constexpr size_t WS_KCP = 32 * MiB;
constexpr size_t WS_VCP = 33 * MiB;
constexpr size_t WS_KCS = 34 * MiB;
constexpr size_t WS_VCS = 38 * MiB;
constexpr size_t WS_DSC = 42 * MiB;
constexpr size_t WS_USC = 43 * MiB;
constexpr size_t WS_QB = 51 * MiB;
constexpr size_t WS_XN = 64 * MiB;
constexpr size_t WS_PPLE = 97 * MiB;
constexpr size_t WS_PROJ = 106 * MiB;
constexpr size_t WS_OWIN = 204 * MiB;
constexpr size_t WS_MIX = 221 * MiB;
constexpr size_t WS_OLOC = 254 * MiB;
constexpr size_t WS_H1 = 287 * MiB;
constexpr size_t WS_H1B = 353 * MiB;
constexpr size_t WS_ACT = 386 * MiB;
constexpr size_t WS_H2 = 476 * MiB;
constexpr size_t WS_H2B = 542 * MiB;
constexpr size_t WS_PLEB = 575 * MiB;
constexpr size_t WS_END = 608 * MiB;
constexpr int RING_BYTES = 131072;
constexpr int MISC_OFF = RING_BYTES + 320;
constexpr int LDS_BYTES = 163840;
#define XB_TMO      128
#define XB_XCNT(j)  (256  + 64 * (j))
#define XB_XSUB(j)  (1280 + 64 * (j))
#define XB_XGEN(j)  (2304 + 64 * (j))
#define XB_TOP      3328
#define XB_TOPGEN   3392
#define XCD_BAR_WORDS 3456
#define XB_SPIN_CAP (1u << 18)

__device__ __forceinline__ unsigned xb_ld(unsigned* p)              { return __hip_atomic_load(p, __ATOMIC_RELAXED, __HIP_MEMORY_SCOPE_AGENT); }
__device__ __forceinline__ unsigned xb_add(unsigned* p, unsigned v) { return __hip_atomic_fetch_add(p, v, __ATOMIC_RELAXED, __HIP_MEMORY_SCOPE_AGENT); }
__device__ __forceinline__ unsigned xb_xcc_id() { return (unsigned)__builtin_amdgcn_s_getreg((3 << 11) | 20) & 0xFu; }
#define XB_SPIN(cond, bar) do { unsigned _sp = 0; while (cond) { __builtin_amdgcn_s_sleep(1); \
    if ((++_sp & 255u) == 0u) { if (xb_ld(&(bar)[XB_TMO])) break; if (_sp > XB_SPIN_CAP) { atomicAdd(&(bar)[XB_TMO], 1u); break; } } } } while (0)

struct XcdBarrier {
    unsigned* bar; unsigned x;
    volatile LAS unsigned* st;
};

__device__ __forceinline__ XcdBarrier xcd_barrier_post(unsigned* bar, volatile LAS unsigned* st, const int tid) {
    XcdBarrier b; b.bar = bar; b.x = xb_xcc_id(); b.st = st;
    if (tid == 0) (void)xb_add(&bar[XB_XCNT(b.x)], 1u);
    return b;
}
__device__ __forceinline__ void xcd_barrier_complete(unsigned* bar, unsigned x, unsigned& nloc, unsigned& nx) {
    const unsigned G = gridDim.x * gridDim.y * gridDim.z;
    unsigned sum, cnt, mine, sp = 0u;
    for (;;) {
        sum = 0u; cnt = 0u; mine = 0u;
#pragma unroll
        for (unsigned j = 0; j < 16; ++j) { const unsigned c = xb_ld(&bar[XB_XCNT(j)]); sum += c; cnt += (c > 0u) ? 1u : 0u; mine = (j == x) ? c : mine; }
        if (sum == G) break;
        __builtin_amdgcn_s_sleep(1);
        if ((++sp & 255u) == 0u) { if (xb_ld(&bar[XB_TMO])) break; if (sp > XB_SPIN_CAP) { atomicAdd(&bar[XB_TMO], 1u); break; } }
    }
    nloc = mine > 0u ? mine : 1u; nx = cnt > 0u ? cnt : 1u;
}

__device__ __forceinline__ void xcd_barrier(const XcdBarrier& b, const int tid) {
    asm volatile("s_waitcnt vmcnt(0)" ::: "memory");
    __syncthreads();
    if (tid == 0) {
        unsigned* bar = b.bar;
        __builtin_amdgcn_s_waitcnt(0);
        unsigned nloc = b.st[0], nx = b.st[1];
        if (nloc == 0u) { xcd_barrier_complete(bar, b.x, nloc, nx); b.st[0] = nloc; b.st[1] = nx; }
        const unsigned old = xb_add(&bar[XB_XSUB(b.x)], 1u);
        const unsigned gen = old / nloc;
        if (old + 1u == (gen + 1u) * nloc) {
            __builtin_amdgcn_fence(__ATOMIC_RELEASE, "agent");
            asm volatile("s_waitcnt vmcnt(0)" ::: "memory");
            const unsigned og = xb_add(&bar[XB_TOP], 1u);
            const unsigned tg = og / nx;
            if (og + 1u == (tg + 1u) * nx) xb_add(&bar[XB_TOPGEN], 1u);
            else XB_SPIN(xb_ld(&bar[XB_TOPGEN]) == tg, bar);
            __builtin_amdgcn_fence(__ATOMIC_ACQUIRE, "agent");
            xb_add(&bar[XB_XGEN(b.x)], 1u);
            asm volatile("s_waitcnt vmcnt(0)" ::: "memory");
        } else {
            XB_SPIN(xb_ld(&bar[XB_XGEN(b.x)]) == gen, bar);
            __builtin_amdgcn_fence(__ATOMIC_ACQUIRE, "agent");
            asm volatile("s_waitcnt vmcnt(0)" ::: "memory");
        }
    }
    __syncthreads();
}

struct Args { const float* in[26]; float* out; unsigned char* ws; int ph_lo, ph_hi; };
struct Frame {
    LAS unsigned char* lds;
    int tid, lane, wave, vcu, G;
};
__device__ __forceinline__ int hw_lane() { int l; asm volatile("v_mbcnt_lo_u32_b32 %0, -1, 0\n\tv_mbcnt_hi_u32_b32 %0, -1, %0" : "=v"(l)); return l; }
__device__ __forceinline__ int opaque(int x) { asm volatile("" : "+v"(x)); return x; }
__device__ __forceinline__ float wave_sum(float v) {
#pragma unroll
    for (int o = 1; o < 64; o <<= 1) v += __shfl_xor(v, o);
    return v;
}
__device__ __forceinline__ void p0_tr_item(const float* W, int ldw, int K, int nsrc, int nblk, bf16* WT, int mode, const float* kscale, LAS float* scr, int item, int lane) {
    const int kb = item / nblk, nb = item % nblk, k0 = 64 * kb, n0 = 32 * nb;
    const int nn = n0 + (lane & 31);
#pragma unroll 16
    for (int i = 0; i < 32; ++i) { const int kk = 2 * i + (lane >> 5); float v = 0.f; if (nn < nsrc) { v = W[(size_t)(k0 + kk) * ldw + nn]; if (kscale) v *= kscale[k0 + kk]; } scr[kk * 33 + (lane & 31)] = v; }
    LDS_WAIT(); asm volatile("" ::: "memory");
    const int c = lane & 7;
#pragma unroll
    for (int j = 0; j < 4; ++j) { const int n = (lane >> 3) + 8 * j; const LAS float* s = scr + (8 * c) * 33 + n;
        v4u o; o.x = pk2(s[0 * 33], s[1 * 33]); o.y = pk2(s[2 * 33], s[3 * 33]); o.z = pk2(s[4 * 33], s[5 * 33]); o.w = pk2(s[6 * 33], s[7 * 33]);
        const int ng = n0 + n; const int drow = (mode == 0) ? ng : (256 * (ng >> 7) + (ng & 127) + (mode == 2 ? 128 : 0));
        *(GAS v4u*)(WT + (size_t)drow * K + k0 + 8 * c) = o; }
    LDS_WAIT(); asm volatile("" ::: "memory");
}
__device__ __forceinline__ void rms_row_to_bf16(const float* xrow, const float* g, bf16* orow, int lane) {
    const GAS f32x4* xr = (const GAS f32x4*)xrow + lane; const GAS f32x4* gr = (const GAS f32x4*)g + lane;
    f32x4 v[4]; float s = 0.f;
#pragma unroll
    for (int j = 0; j < 4; ++j) { v[j] = xr[64 * j]; s += (v[j].x * v[j].x + v[j].y * v[j].y) + (v[j].z * v[j].z + v[j].w * v[j].w); }
    const float rstd = 1.0f / sqrtf(wave_sum(s) * (1.f / DM) + EPS);
    GAS unsigned long long* o8 = (GAS unsigned long long*)orow + lane;
#pragma unroll
    for (int j = 0; j < 4; ++j) { const f32x4 gg = gr[64 * j];
        o8[64 * j] = (unsigned long long)pk2(v[j].x * rstd * gg.x, v[j].y * rstd * gg.y) | ((unsigned long long)pk2(v[j].z * rstd * gg.z, v[j].w * rstd * gg.w) << 32); }
}
__device__ __forceinline__ void p0_prologue(const Frame& F, const Args& A) {
    unsigned char* ws = A.ws;
    LAS float* scr = (LAS float*)(F.lds + F.wave * 16384);
    const int gw = F.vcu * NWAVES + F.wave, NGW = F.G * NWAVES, lane = F.lane;
    constexpr int I_IN = 16 * 96, I_O = 16 * 32, I_G = 16 * 88, I_D = 44 * 32, I_PG = 16 * 32, I_PL = 4 * 32, I_C1 = 128  , I_C2 = 2 * 1 * 2;
    constexpr int NITEMS = I_IN + I_O + 2 * I_G + I_D + I_PG + I_PL + I_C1 + I_C2;
    for (int it = gw; it < NITEMS; it += NGW) {
        int r = it;
        if (r < I_IN) { p0_tr_item(A.in[9], NIN, 1024, NIN, 96, (bf16*)(ws + WS_WIN), 0, nullptr, scr, r, lane); continue; } r -= I_IN;
        if (r < I_O) { p0_tr_item(A.in[16], 1024, 1024, 1024, 32, (bf16*)(ws + WS_WO), 0, nullptr, scr, r, lane); continue; } r -= I_O;
        if (r < I_G) { p0_tr_item(A.in[18], DFF, 1024, DFF, 88, (bf16*)(ws + WS_WGU), 1, A.in[17], scr, r, lane); continue; } r -= I_G;
        if (r < I_G) { p0_tr_item(A.in[19], DFF, 1024, DFF, 88, (bf16*)(ws + WS_WGU), 2, A.in[17], scr, r, lane); continue; } r -= I_G;
        if (r < I_D) { p0_tr_item(A.in[20], 1024, DFF, 1024, 32, (bf16*)(ws + WS_WDN), 0, nullptr, scr, r, lane); continue; } r -= I_D;
        if (r < I_PG) { p0_tr_item(A.in[23], 1024, 1024, 1024, 32, (bf16*)(ws + WS_WPG), 0, A.in[22], scr, r, lane); continue; } r -= I_PG;
        if (r < I_PL) { p0_tr_item(A.in[21], 1024, 256, 1024, 32, (bf16*)(ws + WS_WPLE), 0, nullptr, scr, r, lane); continue; } r -= I_PL;
        if (r < I_C1) {
#pragma unroll
            for (int q4 = 0; q4 < 4; ++q4) { const int ch = (r * 4 + q4) * 64 + lane; const int l = ch & 63, ks = (ch >> 6) & 63, ht = (ch >> 12) & 1, jj = (ch >> 13) & 1, slot = ch >> 14;
                const float* src = A.in[11] + ((size_t)slot * 2048 + jj * 1024 + 16 * ks + 8 * (l >> 5)) * 64 + 32 * ht + (l & 31);
                v4u o; o.x = pk2(src[0], src[64]); o.y = pk2(src[128], src[192]); o.z = pk2(src[256], src[320]); o.w = pk2(src[384], src[448]);
                *(GAS v4u*)((bf16*)(ws + WS_WC1) + (size_t)ch * 8) = o; }
            continue; } r -= I_C1;
        { const int slot = r / 2; p0_tr_item(A.in[12] + (size_t)slot * 64 * 64, 64, 64, 64, 2, (bf16*)(ws + WS_WC2) + (size_t)slot * 64 * 64, 0, nullptr, scr, r % 2, lane); }
    }
    if (F.vcu < 2) { const int slot = F.vcu; const float* pe = A.in[10] + slot * 2048 + F.wave * 256; const float* w1 = A.in[11] + (size_t)slot * 2048 * 64 + (size_t)F.wave * 256 * 64; float a = 0.f;
#pragma unroll 16
        for (int k = 0; k < 256; ++k) a += pe[k] * w1[k * 64 + lane];
        ((LAS float*)(F.lds + F.wave * 16384 + 12288))[lane] = a; __syncthreads();
        if (F.wave == 0) { float t = 0.f;
#pragma unroll
            for (int w = 0; w < 8; ++w) t += ((LAS float*)(F.lds + w * 16384 + 12288))[lane];
            ((float*)(ws + WS_C1))[slot * 64 + lane] = t; }
    }
    bf16* XN = (bf16*)(ws + WS_XN);
    for (int m0 = gw; m0 < MPAD; m0 += 2 * NGW) {
        f32x4 v[2][4];
#pragma unroll
        for (int q = 0; q < 2; ++q) { const int m = m0 + q * NGW; if (m < MTOT) { const GAS f32x4* xr = (const GAS f32x4*)((m < TP) ? A.in[0] + (size_t)m * DM : A.in[1] + (size_t)(m - TP) * DM) + lane;
#pragma unroll
            for (int j = 0; j < 4; ++j) v[q][j] = xr[64 * j]; } else {
#pragma unroll
            for (int j = 0; j < 4; ++j) v[q][j] = (f32x4){0.f, 0.f, 0.f, 0.f}; } }
#pragma unroll
        for (int q = 0; q < 2; ++q) { const int m = m0 + q * NGW; if (m < MPAD) {
            float s = 0.f;
#pragma unroll
            for (int j = 0; j < 4; ++j) s += (v[q][j].x * v[q][j].x + v[q][j].y * v[q][j].y) + (v[q][j].z * v[q][j].z + v[q][j].w * v[q][j].w);
            const float rstd = 1.0f / sqrtf(wave_sum(s) * (1.f / DM) + EPS);
            GAS unsigned long long* o8 = (GAS unsigned long long*)(XN + (size_t)m * DM) + lane; const GAS f32x4* gr = (const GAS f32x4*)A.in[8] + lane;
#pragma unroll
            for (int j = 0; j < 4; ++j) { const f32x4 gg = gr[64 * j];
                o8[64 * j] = (unsigned long long)pk2(v[q][j].x * rstd * gg.x, v[q][j].y * rstd * gg.y) | ((unsigned long long)pk2(v[q][j].z * rstd * gg.z, v[q][j].w * rstd * gg.w) << 32); } } }
    }
    bf16* PP = (bf16*)(ws + WS_PPLE);
    for (int m0 = gw; m0 < MPAD; m0 += 4 * NGW) {
        f32x4 v[4];
#pragma unroll
        for (int q = 0; q < 4; ++q) { const int m = m0 + q * NGW; v[q] = (f32x4){0.f, 0.f, 0.f, 0.f}; if (m < MTOT) v[q] = ((const GAS f32x4*)((m < TP) ? A.in[6] + (size_t)m * DPLE : A.in[7] + (size_t)(m - TP) * DPLE))[lane]; }
#pragma unroll
        for (int q = 0; q < 4; ++q) { const int m = m0 + q * NGW; if (m < MPAD) { v2u o; o.x = pk2(v[q].x, v[q].y); o.y = pk2(v[q].z, v[q].w); ((GAS v2u*)(PP + (size_t)m * DPLE))[lane] = o;
            if (m >= MTOT) { GAS v4u* z = (GAS v4u*)((bf16*)(ws + WS_MIX) + (size_t)m * DM) + lane; z[0] = (v4u){0, 0, 0, 0}; z[64] = (v4u){0, 0, 0, 0}; } } }
    }
    for (int it0 = gw; it0 < DBATCH * 508; it0 += 4 * NGW) {
        f32x4 v[4];
#pragma unroll
        for (int q = 0; q < 4; ++q) { const int it = it0 + q * NGW; if (it < DBATCH * 508) { const int b = it / 508, r = it % 508; v[q] = ((const GAS f32x4*)(A.in[3] + (size_t)(b * 512 + r + 4) * 256))[lane]; } }
#pragma unroll
        for (int q = 0; q < 4; ++q) { const int it = it0 + q * NGW; if (it < DBATCH * 508) { const int b = it / 508, r = it % 508; ((GAS f32x4*)(A.out + O_WINS + (size_t)(b * 512 + r) * 256))[lane] = v[q]; } }
    }
}

constexpr float LOG2E = 1.4426950408889634f;
typedef short v4i16_t __attribute__((ext_vector_type(4)));
__device__ __forceinline__ s16x4 vtr(LAS const unsigned char* p) { return __builtin_bit_cast(s16x4, __builtin_amdgcn_ds_read_tr16_b64_v4i16((LAS v4i16_t*)p)); }
__device__ __forceinline__ unsigned cvtpk(float lo, float hi) { typedef float f2 __attribute__((ext_vector_type(2))); typedef __bf16 b2 __attribute__((ext_vector_type(2))); f2 v = {lo, hi}; b2 b = __builtin_convertvector(v, b2); return __builtin_bit_cast(unsigned, b); }
__device__ __forceinline__ int t5_bucket(int n) {
    if (n < 16) return n;
    const int large = 16 + (int)(logf((float)n / 16.0f) / 2.0794415416798357f * 16.0f);
    return large < 31 ? large : 31;
}
constexpr int HI_BASE = 131072 + 512, AT_LUT = HI_BASE, HI_IMPA = AT_LUT + 4096, HI_IMPB = HI_IMPA + 2176, HI_SEL = HI_IMPB + 2176, HI_SCS = HI_SEL + 128, HI_TL = HI_SCS + 512, HI_XCH = HI_TL + 512, HI_Q = HI_XCH + 8192, HI_END = HI_Q + 64;
constexpr int AT_K0 = 0, AT_V0 = 16384, AT_ST = 32768  , AT_IMPA = 65536, AT_IMPB = AT_IMPA + 64 * 65 * 4 + 64, AT_SEL = AT_IMPB + 64 * 65 * 4 + 64, AT_MISC = AT_SEL + 1024, AT_QF = ((AT_MISC + 4096 + 1023) / 1024) * 1024, AT_END = AT_QF + 32768;
struct AttnLane {
    int koff;
    int kx;
    int voff0, voff1;
    int r32, h;
};
__device__ __forceinline__ AttnLane attn_lane(int lane) {
    AttnLane L; L.r32 = lane & 31; L.h = lane >> 5; L.koff = L.r32 * 128; L.kx = (L.r32 >> 1) & 7;
    const int i16 = lane & 15, q = i16 >> 2, p = i16 & 3, g1 = (lane >> 4) & 1;
    const int base = (4 * L.h + q) * 128 + g1 * 32 + (p >> 1) * 16 + (p & 1) * 8;
    L.voff0 = base + ((q >> 1) * 64); L.voff1 = base + (((q >> 1) ^ 1) * 64);
    return L;
}
__device__ __forceinline__ void attn_fill_lut(LAS float* lut, const float* rel_bias, int tid) {
    for (int e = tid; e < 1024; e += NWAVES * 64) { const int dist = e >> 3, hd = e & 7; lut[e] = rel_bias[t5_bucket(dist) * 8 + hd] * LOG2E; }
}
__device__ __forceinline__ void attn_commit(LAS unsigned char* kb, LAS unsigned char* vb, int tid, v4u k, v4u v) {
    const int row = tid >> 3, ch = tid & 7;
    *(LAS v4u*)(kb + row * 128 + ((ch ^ ((row >> 1) & 7)) << 4)) = k;
    *(LAS v4u*)(vb + row * 128 + ((ch ^ (((row >> 1) & 1) << 2)) << 4)) = v;
}
__device__ __forceinline__ f32x16 attn_qk(LAS const unsigned char* kb, int hf, const AttnLane& L, const bf16x8 (&qf)[4]) {
    f32x16 s = {};
#pragma unroll
    for (int ks = 0; ks < 4; ++ks) { const bf16x8 kf = *(LAS const bf16x8*)(kb + hf * 4096 + L.koff + (((2 * ks + L.h) ^ L.kx) << 4)); s = __builtin_amdgcn_mfma_f32_32x32x16_bf16(kf, qf[ks], s, 0, 0, 0); }
    return s;
}
__device__ __forceinline__ void attn_pv(LAS const unsigned char* vb, int hf, const AttnLane& L, const f32x16& p, f32x16 (&o)[2]) {
#pragma unroll
    for (int s = 0; s < 2; ++s) {
        v4u pw; pw.x = cvtpk(p[8 * s + 0], p[8 * s + 1]); pw.y = cvtpk(p[8 * s + 2], p[8 * s + 3]); pw.z = cvtpk(p[8 * s + 4], p[8 * s + 5]); pw.w = cvtpk(p[8 * s + 6], p[8 * s + 7]);
        const bf16x8 pb = __builtin_bit_cast(bf16x8, pw);
        const int rb = (32 * hf + 16 * s) * 128;
        { const s16x4 lo = vtr(vb + rb + L.voff0), hi = vtr(vb + rb + 1024 + L.voff0); const bf16x8 vf = {lo[0], lo[1], lo[2], lo[3], hi[0], hi[1], hi[2], hi[3]};
          o[0] = __builtin_amdgcn_mfma_f32_32x32x16_bf16(vf, pb, o[0], 0, 0, 0); }
        { const s16x4 lo = vtr(vb + rb + L.voff1), hi = vtr(vb + rb + 1024 + L.voff1); const bf16x8 vf = {lo[0], lo[1], lo[2], lo[3], hi[0], hi[1], hi[2], hi[3]};
          o[1] = __builtin_amdgcn_mfma_f32_32x32x16_bf16(vf, pb, o[1], 0, 0, 0); }
    }
}
__device__ __forceinline__ float max16(const f32x16& a) {
    float m0 = fmaxf(fmaxf(a[0], a[1]), fmaxf(a[2], a[3])), m1 = fmaxf(fmaxf(a[4], a[5]), fmaxf(a[6], a[7])), m2 = fmaxf(fmaxf(a[8], a[9]), fmaxf(a[10], a[11])), m3 = fmaxf(fmaxf(a[12], a[13]), fmaxf(a[14], a[15]));
    return fmaxf(fmaxf(m0, m1), fmaxf(m2, m3));
}
__device__ __forceinline__ float sum16(const f32x16& a) {
    return ((a[0] + a[1]) + (a[2] + a[3])) + ((a[4] + a[5]) + (a[6] + a[7])) + (((a[8] + a[9]) + (a[10] + a[11])) + ((a[12] + a[13]) + (a[14] + a[15])));
}
__device__ __forceinline__ float xmax32(float v) { const auto rr = __builtin_amdgcn_permlane32_swap(__float_as_uint(v), __float_as_uint(v), false, false); return fmaxf(__uint_as_float(rr[0]), __uint_as_float(rr[1])); }
__device__ __forceinline__ float xsum32(float v) { const auto rr = __builtin_amdgcn_permlane32_swap(__float_as_uint(v), __float_as_uint(v), false, false); return __uint_as_float(rr[0]) + __uint_as_float(rr[1]); }
__device__ __forceinline__ void attn_softmax_pv(LAS const unsigned char* vb, const AttnLane& L, f32x16& t0, f32x16& t1, float& m, float& lh, f32x16 (&o)[2]) {
    const float tm = xmax32(fmaxf(max16(t0), max16(t1)));
    if (__any(tm > m + 8.0f)) {
        const float mn = fmaxf(m, tm), mu0 = (mn == -INFINITY) ? 0.f : mn;
        const float alpha = __builtin_amdgcn_exp2f(m - mu0);
#pragma unroll
        for (int r = 0; r < 16; ++r) { o[0][r] *= alpha; o[1][r] *= alpha; }
        lh *= alpha; m = mn;
    }
    const float mu = (m == -INFINITY) ? 0.f : m;
#pragma unroll
    for (int r = 0; r < 16; ++r) { t0[r] = __builtin_amdgcn_exp2f(t0[r] - mu); t1[r] = __builtin_amdgcn_exp2f(t1[r] - mu); }
    lh += sum16(t0) + sum16(t1);
    attn_pv(vb, 0, L, t0, o); attn_pv(vb, 1, L, t1, o);
}
__device__ __forceinline__ void attn_softmax_pv2(LAS const unsigned char* vbA, LAS const unsigned char* vbB, const AttnLane& L, f32x16& a0, f32x16& a1, f32x16& b0, f32x16& b1, float& m, float& lh, f32x16 (&o)[2]) {
    const float tm = xmax32(fmaxf(fmaxf(max16(a0), max16(a1)), fmaxf(max16(b0), max16(b1))));
    if (__any(tm > m + 8.0f)) {
        const float mn = fmaxf(m, tm), mu0 = (mn == -INFINITY) ? 0.f : mn;
        const float alpha = __builtin_amdgcn_exp2f(m - mu0);
#pragma unroll
        for (int r = 0; r < 16; ++r) { o[0][r] *= alpha; o[1][r] *= alpha; }
        lh *= alpha; m = mn;
    }
    const float mu = (m == -INFINITY) ? 0.f : m;
#pragma unroll
    for (int r = 0; r < 16; ++r) { a0[r] = __builtin_amdgcn_exp2f(a0[r] - mu); a1[r] = __builtin_amdgcn_exp2f(a1[r] - mu); }
    attn_pv(vbA, 0, L, a0, o); attn_pv(vbA, 1, L, a1, o);
#pragma unroll
    for (int r = 0; r < 16; ++r) { b0[r] = __builtin_amdgcn_exp2f(b0[r] - mu); b1[r] = __builtin_amdgcn_exp2f(b1[r] - mu); }
    lh += (sum16(a0) + sum16(a1)) + (sum16(b0) + sum16(b1));
    attn_pv(vbB, 0, L, b0, o); attn_pv(vbB, 1, L, b1, o);
}
#define KEYIDX(hf, reg, h) (32 * (hf) + ((reg) & 3) + 8 * ((reg) >> 2) + 4 * (h))
__device__ __forceinline__ void score_far(f32x16& t0, f32x16& t1, float cb) {
#pragma unroll
    for (int r = 0; r < 16; ++r) { t0[r] = fmaf(t0[r], LOG2E, cb); t1[r] = fmaf(t1[r], LOG2E, cb); }
}
__device__ __forceinline__ void score_near1(f32x16& t, int hf, int h, LAS const float* lut, int hd, int dbase, int dstep, int dmax, int klim, bool colok) {
#pragma unroll
    for (int r = 0; r < 16; ++r) {
        const int ki = KEYIDX(hf, r, h); const int dist = dbase - dstep * ki; const int di = dist < 0 ? 0 : (dist > 127 ? 127 : dist); const float bv = lut[di * 8 + hd];
        const bool ok = colok && dist >= 0 && dist < dmax && ki < klim; const float v = fmaf(t[r], LOG2E, bv); t[r] = ok ? v : -INFINITY; }
}
__device__ __forceinline__ void score_near(f32x16& t0, f32x16& t1, int h, LAS const float* lut, int hd, int dbase, int dstep, int dmax, int klim, bool colok) {
    score_near1(t0, 0, h, lut, hd, dbase, dstep, dmax, klim, colok);
    __builtin_amdgcn_sched_barrier(0);
    score_near1(t1, 1, h, lut, hd, dbase, dstep, dmax, klim, colok);
    __builtin_amdgcn_sched_barrier(0);
}

__device__ __forceinline__ void win_unit(const Frame& F, const Args& A, LAS unsigned char* sh, int b, int g, int qb) {
    const bf16* PROJ = (const bf16*)(A.ws + WS_PROJ);
    const int lane = hw_lane(), w = F.wave, tid = w * 64 + lane;
    const AttnLane L = attn_lane(lane);
    const int tq = 64 * qb + 8 * w + (L.r32 >> 2), hd = g * 4 + (L.r32 & 3);
    const size_t tokq = (size_t)b * SEQ + tq;
    bf16x8 qf[4];
#pragma unroll
    for (int ks = 0; ks < 4; ++ks) qf[ks] = *(const bf16x8*)(PROJ + tokq * NPROJ + C_QN + hd * 64 + 16 * ks + 8 * L.h);
    LAS const float* lut = (LAS const float*)(sh + AT_LUT);
    const float bfar = lut[127 * 8 + hd];
    const int kt0 = qb >= 8 ? qb - 8 : 0, nt = qb - kt0 + 1, nst = (nt + 1) >> 1;
    const int srow = tid >> 3, sch = tid & 7;
    const bf16* ksrc = PROJ + ((size_t)b * SEQ + srow) * NPROJ + C_WIN + g * 64 + sch * 8;
    v4u kra, vra, krb, vrb;
#define WIN_LOAD(st) do { const int ka_ = kt0 + 2 * (st), kb_ = (ka_ + 1 <= qb) ? ka_ + 1 : ka_; \
        kra = *(const v4u*)(ksrc + (size_t)(64 * ka_) * NPROJ); vra = *(const v4u*)(ksrc + (size_t)(64 * ka_) * NPROJ + 128); \
        krb = *(const v4u*)(ksrc + (size_t)(64 * kb_) * NPROJ); vrb = *(const v4u*)(ksrc + (size_t)(64 * kb_) * NPROJ + 128); } while (0)
#define WIN_COMMIT(buf) do { attn_commit(sh + (buf) * AT_ST, sh + (buf) * AT_ST + 8192, tid, kra, vra); attn_commit(sh + (buf) * AT_ST + 16384, sh + (buf) * AT_ST + 24576, tid, krb, vrb); } while (0)
    WIN_LOAD(0);
    __syncthreads();
    WIN_COMMIT(0);
    __syncthreads();
    float m = -INFINITY, l = 0.f; f32x16 o[2]; o[0] = f32x16{}; o[1] = f32x16{};
#pragma unroll 1
    for (int st = 0; st < nst; ++st) {
        const int buf = st & 1, ka = kt0 + 2 * st, kb2 = ka + 1;
        if (st + 1 < nst) WIN_LOAD(st + 1);
        LAS const unsigned char* sb = sh + buf * AT_ST;
        f32x16 a0 = attn_qk(sb, 0, L, qf), a1 = attn_qk(sb, 1, L, qf), b0 = attn_qk(sb + 16384, 0, L, qf), b1 = attn_qk(sb + 16384, 1, L, qf);
        if (ka <= qb - 3 && ka >= qb - 7) score_far(a0, a1, bfar); else score_near(a0, a1, L.h, lut, hd, tq - 64 * ka, 1, 512, 64, true);
        if (kb2 > qb) score_far(b0, b1, -INFINITY);
        else if (kb2 <= qb - 3 && kb2 >= qb - 7) score_far(b0, b1, bfar); else score_near(b0, b1, L.h, lut, hd, tq - 64 * kb2, 1, 512, 64, true);
        attn_softmax_pv2(sb + 8192, sb + 24576, L, a0, a1, b0, b1, m, l, o);
        if (st + 1 < nst) WIN_COMMIT(buf ^ 1);
        __syncthreads();
    }
#undef WIN_LOAD
#undef WIN_COMMIT
    const float rl = __builtin_amdgcn_rcpf(xsum32(l));
    bf16* dst = (bf16*)(A.ws + WS_OWIN) + tokq * 512 + hd * 64;
#pragma unroll
    for (int dt = 0; dt < 2; ++dt)
#pragma unroll
        for (int rq = 0; rq < 4; ++rq) { v2u wv; wv.x = cvtpk(o[dt][4 * rq] * rl, o[dt][4 * rq + 1] * rl); wv.y = cvtpk(o[dt][4 * rq + 2] * rl, o[dt][4 * rq + 3] * rl);
            *(v2u*)(dst + 32 * dt + 8 * rq + 4 * L.h) = wv; }
}

__device__ __forceinline__ void nsa_unit(const Frame& F, const Args& A, LAS unsigned char* sh, int b, int g, int qb) {
    const bf16* PROJ = (const bf16*)(A.ws + WS_PROJ);
    const int lane = hw_lane(), w = F.wave, tid = w * 64 + lane;
    const AttnLane L = attn_lane(lane);
    const int qloc = 8 * w + (L.r32 >> 2);
    const int tq = 64 * qb + qloc, hd = g * 4 + (L.r32 & 3);
    const size_t tokq = (size_t)b * SEQ + tq;
    bf16x8 qf[4];
#pragma unroll
    for (int ks = 0; ks < 4; ++ks) qf[ks] = *(const bf16x8*)(PROJ + tokq * NPROJ + C_QN + hd * 64 + 16 * ks + 8 * L.h);
#define NSA_LOADQ() do {} while (0)
    LAS const float* lut = (LAS const float*)(sh + AT_LUT);
    const float bfar = lut[127 * 8 + hd];
    LAS float* impA = (LAS float*)(sh + AT_IMPA); LAS float* impB = (LAS float*)(sh + AT_IMPB);
    LAS unsigned long long* selm = (LAS unsigned long long*)(sh + AT_SEL);
    const int srow = tid >> 3, sch = tid & 7;
    v4u kr, vr;
    const int nct = (4 * qb + 3 + 63) >> 6;
    const bf16* kcs = (const bf16*)(A.ws + WS_KCP) + ((size_t)(b * 256 + srow) * 2 + g) * 64 + sch * 8;
    const bf16* vcs = (const bf16*)(A.ws + WS_VCP) + ((size_t)(b * 256 + srow) * 2 + g) * 64 + sch * 8;
    __syncthreads();
    for (int e = tid; e < 64 * 65; e += NWAVES * 64) { impA[e] = 0.f; impB[e] = 0.f; }
    float mc = -INFINITY, lc = 0.f;
#pragma unroll 1
    for (int pass = 0; pass < 2; ++pass) {
        kr = *(const v4u*)(kcs); vr = *(const v4u*)(vcs);
        __syncthreads();
        attn_commit(sh + AT_K0, sh + AT_V0, tid, kr, vr);
        __syncthreads();
        const float mu = (mc == -INFINITY) ? 0.f : mc, il = lc > 0.f ? __builtin_amdgcn_rcpf(lc) : 0.f;
#pragma unroll 1
        for (int ct = 0; ct < nct; ++ct) {
            const int buf = ct & 1;
            if (ct + 1 < nct) { kr = *(const v4u*)(kcs + (size_t)(64 * (ct + 1)) * 128); vr = *(const v4u*)(vcs + (size_t)(64 * (ct + 1)) * 128); }
            LAS const unsigned char* kb = sh + AT_K0 + buf * 8192; LAS const unsigned char* vb = sh + AT_V0 + buf * 8192;
            NSA_LOADQ();
            f32x16 t0 = attn_qk(kb, 0, L, qf), t1 = attn_qk(kb, 1, L, qf);
            score_near(t0, t1, L.h, lut, hd, tq - 31 - 1024 * ct, 16, 1 << 30, 255 - 64 * ct, true);
            if (pass == 0) {
                const float tm = xmax32(fmaxf(max16(t0), max16(t1)));
                const float mn = fmaxf(mc, tm), mu0 = (mn == -INFINITY) ? 0.f : mn;
                const float alpha = __builtin_amdgcn_exp2f(mc - mu0);
                float ps = 0.f;
#pragma unroll
                for (int r = 0; r < 16; ++r) ps += __builtin_amdgcn_exp2f(t0[r] - mu0) + __builtin_amdgcn_exp2f(t1[r] - mu0);
                ps = xsum32(ps);
                lc = lc * alpha + ps; mc = mn;
            } else {
#pragma unroll
                for (int r = 0; r < 16; ++r) { t0[r] = __builtin_amdgcn_exp2f(t0[r] - mu) * il; t1[r] = __builtin_amdgcn_exp2f(t1[r] - mu) * il; }
#pragma unroll
                for (int hf = 0; hf < 2; ++hf) {
                    float x[16];
#pragma unroll
                    for (int r = 0; r < 16; ++r) { float v = hf ? t1[r] : t0[r]; v += __shfl_xor(v, 1); v += __shfl_xor(v, 2); x[r] = v; }
                    if ((L.r32 & 3) == 0) {
#pragma unroll
                        for (int rq = 0; rq < 4; ++rq) { const int jq = 16 * ct + 8 * hf + 2 * rq + L.h;
                            impA[qloc * 65 + jq] = 2.0f * (x[4 * rq] + x[4 * rq + 1] + x[4 * rq + 2]) + x[4 * rq + 3];
                            impB[qloc * 65 + jq + 1] = x[4 * rq + 3]; }
                    }
                }
            }
            if (ct + 1 < nct) attn_commit(sh + AT_K0 + (buf ^ 1) * 8192, sh + AT_V0 + (buf ^ 1) * 8192, tid, kr, vr);
            __syncthreads();
        }
    }
#pragma unroll 1
    for (int qi = 0; qi < 8; ++qi) {
        const int q = 8 * w + qi;
        unsigned long long mk;
        if (qb < 16) mk = (2ull << qb) - 1ull;
        else {
            const bool forced = (lane == 0) || (lane == qb) || (lane == qb - 1);
            const float sc = forced ? 1e9f : (lane <= qb ? impA[q * 65 + lane] + impB[q * 65 + lane] : -1.0f);
            int rank = 0;
#pragma unroll 8
            for (int jj = 0; jj < 64; ++jj) { const float ov = __uint_as_float(__builtin_amdgcn_readlane(__float_as_uint(sc), jj)); rank += ((ov > sc) || (ov == sc && jj < lane)) ? 1 : 0; }
            mk = __ballot(rank < 16 && lane <= qb);
        }
        if (lane == 0) selm[q] = mk;
    }
    __syncthreads();
    const unsigned long long mysel = selm[qloc];
    unsigned long long um = 0ull;
#pragma unroll 8
    for (int q_ = 0; q_ < 64; ++q_) um |= selm[q_];
    um = ((unsigned long long)__builtin_amdgcn_readfirstlane((unsigned)(um >> 32)) << 32) | (unsigned long long)__builtin_amdgcn_readfirstlane((unsigned)um);
    const bf16* ksrc = PROJ + ((size_t)b * SEQ + srow) * NPROJ + C_KV + 2 * 128 + g * 64 + sch * 8;
    float m = -INFINITY, l = 0.f; f32x16 o[2]; o[0] = f32x16{}; o[1] = f32x16{};
    v4u krb, vrb;
    int ja, jb;
#define SLC_NEXT(JA, JB) do { JA = um ? __builtin_ctzll(um) : -1; um &= um - 1; JB = um ? __builtin_ctzll(um) : -1; um &= um - 1; } while (0)
#define SLC_LOAD(JA, JB) do { const int jb_ = (JB) >= 0 ? (JB) : (JA); \
        kr = *(const v4u*)(ksrc + (size_t)(64 * (JA)) * NPROJ); vr = *(const v4u*)(ksrc + (size_t)(64 * (JA)) * NPROJ + 128); \
        krb = *(const v4u*)(ksrc + (size_t)(64 * jb_) * NPROJ); vrb = *(const v4u*)(ksrc + (size_t)(64 * jb_) * NPROJ + 128); } while (0)
#define SLC_COMMIT(buf) do { attn_commit(sh + (buf) * AT_ST, sh + (buf) * AT_ST + 8192, tid, kr, vr); attn_commit(sh + (buf) * AT_ST + 16384, sh + (buf) * AT_ST + 24576, tid, krb, vrb); } while (0)
    SLC_NEXT(ja, jb);
    SLC_LOAD(ja, jb);
    SLC_COMMIT(0);
    __syncthreads();
    int buf = 0;
#pragma unroll 1
    for (;;) {
        int na, nb; SLC_NEXT(na, nb);
        if (na >= 0) SLC_LOAD(na, nb);
        LAS const unsigned char* sb = sh + buf * AT_ST;
        const bool sela = (mysel >> ja) & 1ull, selb = jb >= 0 && ((mysel >> jb) & 1ull);
        if (__any(sela || selb)) {
            f32x16 a0 = attn_qk(sb, 0, L, qf), a1 = attn_qk(sb, 1, L, qf), b0 = attn_qk(sb + 16384, 0, L, qf), b1 = attn_qk(sb + 16384, 1, L, qf);
            if (ja <= qb - 3) score_far(a0, a1, sela ? bfar : -INFINITY); else score_near(a0, a1, L.h, lut, hd, tq - 64 * ja, 1, 1 << 30, 64, sela);
            if (jb <= qb - 3) score_far(b0, b1, selb ? bfar : -INFINITY); else score_near(b0, b1, L.h, lut, hd, tq - 64 * jb, 1, 1 << 30, 64, selb);
            attn_softmax_pv2(sb + 8192, sb + 24576, L, a0, a1, b0, b1, m, l, o);
        }
        if (na >= 0) SLC_COMMIT(buf ^ 1);
        __syncthreads();
        if (na < 0) break;
        ja = na; jb = nb; buf ^= 1;
    }
#undef SLC_NEXT
#undef SLC_LOAD
#undef SLC_COMMIT
    const bf16* gp = PROJ + tokq * NPROJ + C_GT + hd;
    const float g0 = __builtin_amdgcn_rcpf(1.0f + __expf(-bf2f(gp[0]))), g1 = __builtin_amdgcn_rcpf(1.0f + __expf(-bf2f(gp[8]))), g2 = __builtin_amdgcn_rcpf(1.0f + __expf(-bf2f(gp[16])));
    const float rl = g1 * __builtin_amdgcn_rcpf(xsum32(l));
    const bf16* ow = (const bf16*)(A.ws + WS_OWIN) + tokq * 512 + hd * 64;
#pragma unroll
    for (int dt = 0; dt < 2; ++dt)
#pragma unroll
        for (int rq = 0; rq < 4; ++rq) { const int d0 = 32 * dt + 8 * rq + 4 * L.h; const v2u wv = *(const v2u*)(ow + d0);
            o[dt][4 * rq] = rl * o[dt][4 * rq] + g2 * bflo(wv.x); o[dt][4 * rq + 1] = rl * o[dt][4 * rq + 1] + g2 * bfhi(wv.x);
            o[dt][4 * rq + 2] = rl * o[dt][4 * rq + 2] + g2 * bflo(wv.y); o[dt][4 * rq + 3] = rl * o[dt][4 * rq + 3] + g2 * bfhi(wv.y); }
    {
        const float mu = (mc == -INFINITY) ? 0.f : mc, il = lc > 0.f ? g0 * __builtin_amdgcn_rcpf(lc) : 0.f;
        kr = *(const v4u*)(kcs); vr = *(const v4u*)(vcs);
        attn_commit(sh + AT_K0, sh + AT_V0, tid, kr, vr);
        __syncthreads();
#pragma unroll 1
        for (int ct = 0; ct < nct; ++ct) {
            const int cbuf = ct & 1;
            if (ct + 1 < nct) { kr = *(const v4u*)(kcs + (size_t)(64 * (ct + 1)) * 128); vr = *(const v4u*)(vcs + (size_t)(64 * (ct + 1)) * 128); }
            LAS const unsigned char* kb = sh + AT_K0 + cbuf * 8192; LAS const unsigned char* vb = sh + AT_V0 + cbuf * 8192;
            NSA_LOADQ();
            f32x16 t0 = attn_qk(kb, 0, L, qf), t1 = attn_qk(kb, 1, L, qf);
            score_near(t0, t1, L.h, lut, hd, tq - 31 - 1024 * ct, 16, 1 << 30, 255 - 64 * ct, true);
#pragma unroll
            for (int r = 0; r < 16; ++r) { t0[r] = __builtin_amdgcn_exp2f(t0[r] - mu) * il; t1[r] = __builtin_amdgcn_exp2f(t1[r] - mu) * il; }
            attn_pv(vb, 0, L, t0, o); attn_pv(vb, 1, L, t1, o);
            if (ct + 1 < nct) attn_commit(sh + AT_K0 + (cbuf ^ 1) * 8192, sh + AT_V0 + (cbuf ^ 1) * 8192, tid, kr, vr);
            __syncthreads();
        }
    }
    bf16* dst = (bf16*)(A.ws + WS_MIX) + tokq * 1024 + hd * 64;
#pragma unroll
    for (int dt = 0; dt < 2; ++dt)
#pragma unroll
        for (int rq = 0; rq < 4; ++rq) { v2u ov; ov.x = cvtpk(o[dt][4 * rq], o[dt][4 * rq + 1]); ov.y = cvtpk(o[dt][4 * rq + 2], o[dt][4 * rq + 3]); *(v2u*)(dst + 32 * dt + 8 * rq + 4 * L.h) = ov; }
}
#undef NSA_LOADQ

__device__ __forceinline__ v4u pack_f32x8(const float* p) { const f32x4 a = *(const f32x4*)p, b = *(const f32x4*)(p + 4); v4u w; w.x = pk2(a.x, a.y); w.y = pk2(a.z, a.w); w.z = pk2(b.x, b.y); w.w = pk2(b.z, b.w); return w; }
__device__ __forceinline__ void samp_load(const Args& A, int mode, int tile, int b, int g, int srow, int sch, v4u& kr, v4u& vr) {
    const bf16* PROJ = (const bf16*)(A.ws + WS_PROJ);
    kr = (v4u){0, 0, 0, 0}; vr = (v4u){0, 0, 0, 0};
    if (mode == 0) {
        const size_t off = ((size_t)(b * 512 + 64 * tile + srow) * 2 + g) * 64 + sch * 8;
        kr = *(const v4u*)((const bf16*)(A.ws + WS_KCS) + off); vr = *(const v4u*)((const bf16*)(A.ws + WS_VCS) + off);
    } else if (mode == 1) {
        if (tile < 128) { const int page = ((const int*)A.in[5])[b * 64 + (tile >> 1)]; const int row = (tile & 1) * 64 + srow;
            const float* p = A.in[2] + ((size_t)(page * 128 + row) * 4 + 2) * 128 + g * 64 + sch * 8; kr = pack_f32x8(p); vr = pack_f32x8(p + 128); }
        else if (srow < 4) { const bf16* p = PROJ + (size_t)(TP + b * 4 + srow) * NPROJ + C_KV + 2 * 128 + g * 64 + sch * 8; kr = *(const v4u*)p; vr = *(const v4u*)(p + 128); }
    } else {
        const int idx = 64 * tile + srow;
        if (idx < 512) { const float* p = A.in[3] + ((size_t)(b * 512 + idx) * 2) * 128 + g * 64 + sch * 8; kr = pack_f32x8(p); vr = pack_f32x8(p + 128); }
        else if (idx < 516) { const bf16* p = PROJ + (size_t)(TP + b * 4 + idx - 512) * NPROJ + C_WIN + g * 64 + sch * 8; kr = *(const v4u*)p; vr = *(const v4u*)(p + 128); }
    }
}
__device__ __forceinline__ void samp_stage_tile(const Args& A, int mode, int tile, int b, int g, int lane, LAS unsigned char* kb, LAS unsigned char* vb) {
#pragma unroll 1
    for (int i0 = 0; i0 < 8; i0 += 2) {
        v4u kr[2], vr[2];
#pragma unroll
        for (int i = 0; i < 2; ++i) samp_load(A, mode, tile, b, g, (lane >> 3) + 8 * (i0 + i), lane & 7, kr[i], vr[i]);
#pragma unroll
        for (int i = 0; i < 2; ++i) { const int row = (lane >> 3) + 8 * (i0 + i), ch = lane & 7;
            *(LAS v4u*)(kb + row * 128 + ((ch ^ ((row >> 1) & 7)) << 4)) = kr[i];
            *(LAS v4u*)(vb + row * 128 + ((ch ^ (((row >> 1) & 1) << 2)) << 4)) = vr[i]; }
    }
}
__device__ __forceinline__ void samp_unit(const Frame& F, const Args& A, LAS unsigned char* sh, int b, int g) {
    const bf16* PROJ = (const bf16*)(A.ws + WS_PROJ);
    const int lane = hw_lane(), w = F.wave, tid = w * 64 + lane;
    const AttnLane L = attn_lane(lane);
    const bool colok = L.r32 < 16;
    const int qi = (L.r32 >> 2) & 3, hd = g * 4 + (L.r32 & 3);
    const int pos = PAST + qi;
    const size_t tokq = (size_t)TP + b * 4 + qi;
    LAS unsigned char* kb = sh + w * 16384; LAS unsigned char* vb = kb + 8192;
    LAS float* lut = (LAS float*)(sh + AT_LUT);
    LAS float* impA = (LAS float*)(sh + HI_IMPA); LAS float* impB = (LAS float*)(sh + HI_IMPB);
    LAS unsigned long long* selm = (LAS unsigned long long*)(sh + HI_SEL);
    LAS float* scs = (LAS float*)(sh + HI_SCS);
    LAS int* tlist = (LAS int*)(sh + HI_TL);
    LAS float* xch = (LAS float*)(sh + HI_XCH);
    bf16x8 qf[4];
#pragma unroll
    for (int ks = 0; ks < 4; ++ks) qf[ks] = *(const bf16x8*)(PROJ + tokq * NPROJ + C_QN + hd * 64 + 16 * ks + 8 * L.h);
    const float bfar = lut[127 * 8 + hd];
    __syncthreads();
    for (int e = tid; e < 4 * 132; e += NWAVES * 64) { impA[e] = 0.f; impB[e] = 0.f; }
    f32x16 oc[2]; oc[0] = f32x16{}; oc[1] = f32x16{};
    {
        samp_stage_tile(A, 0, w, b, g, lane, kb, vb);
        f32x16 t0 = attn_qk(kb, 0, L, qf), t1 = attn_qk(kb, 1, L, qf);
        score_near(t0, t1, L.h, lut, hd, pos - 31 - 1024 * w, 16, 1 << 30, 511 - 64 * w, colok);
        const float tm = xmax32(fmaxf(max16(t0), max16(t1)));
        xch[(w * 64 + lane) * 4] = tm;
        __syncthreads();
        float M = -INFINITY;
#pragma unroll
        for (int ww = 0; ww < 8; ++ww) M = fmaxf(M, xch[(ww * 64 + lane) * 4]);
        const float mu = (M == -INFINITY) ? 0.f : M;
#pragma unroll
        for (int r = 0; r < 16; ++r) { t0[r] = __builtin_amdgcn_exp2f(t0[r] - mu); t1[r] = __builtin_amdgcn_exp2f(t1[r] - mu); }
        const float ps = xsum32(sum16(t0) + sum16(t1));
        xch[(w * 64 + lane) * 4 + 1] = ps;
        __syncthreads();
        float Lc = 0.f;
#pragma unroll
        for (int ww = 0; ww < 8; ++ww) Lc += xch[(ww * 64 + lane) * 4 + 1];
        const float il = Lc > 0.f ? __builtin_amdgcn_rcpf(Lc) : 0.f;
#pragma unroll
        for (int r = 0; r < 16; ++r) { t0[r] *= il; t1[r] *= il; }
        attn_pv(vb, 0, L, t0, oc); attn_pv(vb, 1, L, t1, oc);
#pragma unroll
        for (int hf = 0; hf < 2; ++hf) {
            float x[16];
#pragma unroll
            for (int r = 0; r < 16; ++r) { float v = hf ? t1[r] : t0[r]; v += __shfl_xor(v, 1); v += __shfl_xor(v, 2); x[r] = v; }
            if ((L.r32 & 3) == 0 && colok) {
#pragma unroll
                for (int rq = 0; rq < 4; ++rq) { const int jq = 16 * w + 8 * hf + 2 * rq + L.h;
                    impA[qi * 132 + jq] = 2.0f * (x[4 * rq] + x[4 * rq + 1] + x[4 * rq + 2]) + x[4 * rq + 3];
                    impB[qi * 132 + jq + 1] = x[4 * rq + 3]; }
            }
        }
    }
    __syncthreads();
    if (w == 0) {
        unsigned long long ulo = 0ull, uhi = 0ull;
#pragma unroll 1
        for (int q = 0; q < 4; ++q) {
            const int j0 = lane, j1 = lane + 64;
            const float s0 = (j0 == 0) ? 1e9f : impA[q * 132 + j0] + impB[q * 132 + j0];
            const float s1 = (j1 == 127) ? 1e9f : impA[q * 132 + j1] + impB[q * 132 + j1];
            scs[j0] = s0; scs[j1] = s1;
            LDS_WAIT(); asm volatile("" ::: "memory");
            int r0 = 0, r1 = 0;
#pragma unroll 8
            for (int jj = 0; jj < 128; ++jj) { const float ov = scs[jj]; r0 += ((ov > s0) || (ov == s0 && jj < j0)) ? 1 : 0; r1 += ((ov > s1) || (ov == s1 && jj < j1)) ? 1 : 0; }
            const unsigned long long mlo = __ballot(r0 < 15), mhi = __ballot(r1 < 15);
            if (lane == 0) { selm[2 * q] = mlo; selm[2 * q + 1] = mhi; }
            ulo |= mlo; uhi |= mhi;
            LDS_WAIT(); asm volatile("" ::: "memory");
        }
        if (lane == 0) { int n = 0; for (int j = 0; j < 64; ++j) if ((ulo >> j) & 1ull) tlist[1 + n++] = j; for (int j = 0; j < 64; ++j) if ((uhi >> j) & 1ull) tlist[1 + n++] = 64 + j; tlist[1 + n++] = 128; tlist[0] = n; }
    }
    __syncthreads();
    const unsigned long long mylo = selm[2 * qi], myhi = selm[2 * qi + 1];
    const int nsel = tlist[0];
    const bf16* gp = PROJ + tokq * NPROJ + C_GT + hd;
    const float g0 = __builtin_amdgcn_rcpf(1.0f + __expf(-bf2f(gp[0]))), g1 = __builtin_amdgcn_rcpf(1.0f + __expf(-bf2f(gp[8]))), g2 = __builtin_amdgcn_rcpf(1.0f + __expf(-bf2f(gp[16])));
#pragma unroll
    for (int r = 0; r < 16; ++r) { oc[0][r] *= g0; oc[1][r] *= g0; }
#pragma unroll 1
    for (int br = 0; br < 2; ++br) {
        const int nt = br == 0 ? nsel : 9;
        float m = -INFINITY, l = 0.f; f32x16 o[2]; o[0] = f32x16{}; o[1] = f32x16{};
#pragma unroll 1
        for (int it = w; it < nt; it += 8) {
            const int j = br == 0 ? tlist[1 + it] : it;
            samp_stage_tile(A, 1 + br, j, b, g, lane, kb, vb);
            f32x16 t0 = attn_qk(kb, 0, L, qf), t1 = attn_qk(kb, 1, L, qf);
            if (br == 0) {
                const bool selj = colok && (j >= 128 ? true : (j < 64 ? ((mylo >> j) & 1ull) : ((myhi >> (j - 64)) & 1ull)));
                if (j <= 125) score_far(t0, t1, selj ? bfar : -INFINITY);
                else score_near(t0, t1, L.h, lut, hd, pos - 64 * j, 1, 1 << 30, 64, selj);
            } else score_near(t0, t1, L.h, lut, hd, pos - (PAST - 512 + 64 * j), 1, 512, 516 - 64 * j, colok);
            attn_softmax_pv(vb, L, t0, t1, m, l, o);
        }
        l = xsum32(l);
        xch[(w * 64 + lane) * 4 + 2] = m; xch[(w * 64 + lane) * 4 + 3] = l;
        __syncthreads();
        float M = -INFINITY;
#pragma unroll
        for (int ww = 0; ww < 8; ++ww) M = fmaxf(M, xch[(ww * 64 + lane) * 4 + 2]);
        float Lt = 0.f;
#pragma unroll
        for (int ww = 0; ww < 8; ++ww) { const float mw = xch[(ww * 64 + lane) * 4 + 2]; Lt += (mw == -INFINITY) ? 0.f : xch[(ww * 64 + lane) * 4 + 3] * __builtin_amdgcn_exp2f(mw - M); }
        const float sc = (m == -INFINITY || !(Lt > 0.f)) ? 0.f : (br == 0 ? g1 : g2) * __builtin_amdgcn_exp2f(m - M) * __builtin_amdgcn_rcpf(Lt);
#pragma unroll
        for (int r = 0; r < 16; ++r) { oc[0][r] += sc * o[0][r]; oc[1][r] += sc * o[1][r]; }
        __syncthreads();
    }
    { LAS float* part = (LAS float*)kb;
#pragma unroll
      for (int r = 0; r < 16; ++r) { part[r * 64 + lane] = oc[0][r]; part[(16 + r) * 64 + lane] = oc[1][r]; } }
    __syncthreads();
    if (w == 0 && colok) {
        float res[32];
#pragma unroll
        for (int r = 0; r < 32; ++r) { float a = 0.f;
#pragma unroll
            for (int ww = 0; ww < 8; ++ww) a += ((LAS const float*)(sh + ww * 16384))[r * 64 + lane];
            res[r] = a; }
        bf16* dst = (bf16*)(A.ws + WS_MIX) + tokq * 1024 + hd * 64;
#pragma unroll
        for (int dt = 0; dt < 2; ++dt)
#pragma unroll
            for (int rq = 0; rq < 4; ++rq) { const int d0 = 32 * dt + 8 * rq + 4 * L.h;
                v2u ov; ov.x = cvtpk(res[16 * dt + 4 * rq], res[16 * dt + 4 * rq + 1]); ov.y = cvtpk(res[16 * dt + 4 * rq + 2], res[16 * dt + 4 * rq + 3]); *(v2u*)(dst + d0) = ov; }
    }
}

__device__ __forceinline__ float gelu_tanh(float x) { const float u = 0.7978845608028654f * (x + 0.044715f * x * x * x); const float t = 1.0f - 2.0f / (1.0f + __expf(2.0f * u)); return 0.5f * x * (1.0f + t); }
constexpr int CM_X = 0, CM_SB = 2064  , CM_H = 32 * CM_SB + 1024, CM_HCOL = 272  , CM_HT = 32 * CM_HCOL, CM_END = CM_H + 4 * CM_HT;
constexpr int NCU_P = 4 * 2 * 2 * 9, NCU_S = 32 * 2 * 2 * 17;
__device__ __forceinline__ int cmp_decode(int u) { if (u < NCU_S) return (1 << 20) | ((u / 68) << 12) | (((u / 34) & 1) << 9) | (((u / 17) & 1) << 8) | (u % 17); const int j = u - NCU_S; return ((j / 36) << 12) | (((j / 18) & 1) << 9) | (((j / 9) & 1) << 8) | (j % 9); }
#define CU_SAMPLE(c) ((c) >> 20)
#define CU_B(c) (((c) >> 12) & 255)
#define CU_SLOT(c) (((c) >> 9) & 1)
#define CU_G(c) (((c) >> 8) & 1)
#define CU_GRP(c) ((c) & 255)
__device__ __forceinline__ void cmp_issue(const Args& A, const int c, int tid, v4u (&R)[16]) {
    if (CU_SAMPLE(c)) {
        const float* cache = A.in[2]; const int* pt = (const int*)A.in[5] + CU_B(c) * 64;
#pragma unroll
        for (int i = 0; i < 16; ++i) { const int q = tid + 512 * i, row = q >> 4, pc = q & 15; int p = 16 * 31 * CU_GRP(c) + row; p = p < PAST ? p : PAST - 1;
            const int page = pt[p >> 7];
            R[i] = *(const v4u*)(cache + ((size_t)(page * 128 + (p & 127)) * 4 + CU_SLOT(c)) * 128 + CU_G(c) * 64 + pc * 4); }
    } else {
        const bf16* PROJ = (const bf16*)(A.ws + WS_PROJ);
#pragma unroll
        for (int i = 0; i < 8; ++i) { const int q = tid + 512 * i, row = q >> 3, pc = q & 7; int p = 16 * 31 * CU_GRP(c) + row; p = p < SEQ ? p : SEQ - 1;
            R[i] = *(const v4u*)(PROJ + ((size_t)CU_B(c) * SEQ + p) * NPROJ + C_KV + CU_SLOT(c) * 128 + CU_G(c) * 64 + pc * 8); }
#pragma unroll
        for (int i = 8; i < 16; ++i) R[i] = (v4u){0u, 0u, 0u, 0u};
    }
}
__device__ __forceinline__ void cmp_commit(LAS unsigned char* sh, const int c, int tid, const v4u (&R)[16]) {
    if (CU_SAMPLE(c)) {
#pragma unroll
        for (int i = 0; i < 16; ++i) { const int q = tid + 512 * i, row = q >> 4, pc = q & 15;
            v2u w; w.x = pk2(__uint_as_float(R[i].x), __uint_as_float(R[i].y)); w.y = pk2(__uint_as_float(R[i].z), __uint_as_float(R[i].w));
            *(LAS v2u*)(sh + CM_X + (row >> 4) * CM_SB + (row & 15) * 128 + pc * 8) = w; }
    } else {
#pragma unroll
        for (int i = 0; i < 8; ++i) { const int q = tid + 512 * i, row = q >> 3, pc = q & 7; *(LAS v4u*)(sh + CM_X + (row >> 4) * CM_SB + (row & 15) * 128 + pc * 16) = R[i]; }
    }
}
__device__ __forceinline__ void cmp_phase(const Frame& F, const Args& A, LAS unsigned char* sh) {
    const int lane = hw_lane(), w = F.wave, tid = w * 64 + lane, r32 = lane & 31, h = lane >> 5;
    const int j = w & 1, ht = (w >> 1) & 1, kh = w >> 2;
    v4u R[16];
    int u = F.vcu;
    if (u >= NCU_S + NCU_P) return;
    int cu = cmp_decode(u);
    cmp_issue(A, cu, tid, R);
    for (;;) {
        __syncthreads();
        cmp_commit(sh, cu, tid, R);
        __syncthreads();
        const int cur = cu;
        const int un = u + F.G; const bool more = un < NCU_S + NCU_P;
        cu = cmp_decode(more ? un : u); cmp_issue(A, cu, tid, R);
        { const bf16* wf = (const bf16*)(A.ws + WS_WC1) + ((size_t)(((CU_SLOT(cur) * 2 + j) * 2 + ht) * 64 + 32 * kh) * 64 + lane) * 8;
          LAS const unsigned char* xb = sh + CM_X + r32 * CM_SB + h * 16;
          f32x16 acc = {};
#pragma unroll 16
          for (int k2 = 0; k2 < 32; ++k2) { const int ks = 32 * kh + k2; const bf16x8 af = *(const bf16x8*)(wf + (size_t)k2 * 512);
              const bf16x8 bf = *(LAS const bf16x8*)(xb + (ks >> 2) * 128 + (ks & 3) * 32);
              acc = __builtin_amdgcn_mfma_f32_32x32x16_bf16(af, bf, acc, 0, 0, 0); }
          LAS unsigned char* hb = sh + CM_H + (j * 2 + kh) * CM_HT + r32 * CM_HCOL + (32 * ht + 4 * h) * 4;
#pragma unroll
          for (int rq = 0; rq < 4; ++rq) *(LAS f32x4*)(hb + 32 * rq) = (f32x4){acc[4 * rq], acc[4 * rq + 1], acc[4 * rq + 2], acc[4 * rq + 3]}; }
        __syncthreads();
        if (w < 2) {
            const float* c1p = (const float*)(A.ws + WS_C1) + CU_SLOT(cur) * 64;
            const bf16* W2 = (const bf16*)(A.ws + WS_WC2) + (size_t)CU_SLOT(cur) * 64 * 64;
            const int i1 = r32 < 31 ? r32 + 1 : 31;
            f32x16 oo = {};
#pragma unroll
            for (int ks = 0; ks < 4; ++ks) {
                const int hid0 = 16 * ks + 8 * h; float xv[8];
#pragma unroll
                for (int e4 = 0; e4 < 2; ++e4) {
                    const f32x4 a0 = *(LAS const f32x4*)(sh + CM_H + 0 * CM_HT + r32 * CM_HCOL + (hid0 + 4 * e4) * 4), a1 = *(LAS const f32x4*)(sh + CM_H + 1 * CM_HT + r32 * CM_HCOL + (hid0 + 4 * e4) * 4);
                    const f32x4 b0 = *(LAS const f32x4*)(sh + CM_H + 2 * CM_HT + i1 * CM_HCOL + (hid0 + 4 * e4) * 4), b1 = *(LAS const f32x4*)(sh + CM_H + 3 * CM_HT + i1 * CM_HCOL + (hid0 + 4 * e4) * 4);
                    const f32x4 cc = *(const f32x4*)(c1p + hid0 + 4 * e4);
#pragma unroll
                    for (int e = 0; e < 4; ++e) xv[4 * e4 + e] = gelu_tanh((a0[e] + a1[e]) + (b0[e] + b1[e]) + cc[e]);
                }
                v4u pw; pw.x = cvtpk(xv[0], xv[1]); pw.y = cvtpk(xv[2], xv[3]); pw.z = cvtpk(xv[4], xv[5]); pw.w = cvtpk(xv[6], xv[7]);
                const bf16x8 af = *(const bf16x8*)(W2 + (size_t)(32 * w + r32) * 64 + hid0);
                oo = __builtin_amdgcn_mfma_f32_32x32x16_bf16(af, __builtin_bit_cast(bf16x8, pw), oo, 0, 0, 0);
            }
            const int nsb = CU_SAMPLE(cur) ? 512 : 256, sb = 31 * CU_GRP(cur) + r32;
            if (r32 < 31 && sb < nsb - 1) {
                bf16* dst = (bf16*)(A.ws + (CU_SAMPLE(cur) ? (CU_SLOT(cur) ? WS_VCS : WS_KCS) : (CU_SLOT(cur) ? WS_VCP : WS_KCP))) + ((size_t)(CU_B(cur) * nsb + sb) * 2 + CU_G(cur)) * 64 + 32 * w + 4 * h;
#pragma unroll
                for (int rq = 0; rq < 4; ++rq) { v2u wv; wv.x = cvtpk(oo[4 * rq], oo[4 * rq + 1]); wv.y = cvtpk(oo[4 * rq + 2], oo[4 * rq + 3]); *(v2u*)(dst + 8 * rq) = wv; }
            }
        }
        if (!more) break;
        u = un;
    }
}

__device__ __forceinline__ float log_sigmoid(float x) { return fminf(x, 0.f) - __logf(1.0f + __expf(-fabsf(x))); }
constexpr int G_QE = 0, G_KE = 8192, G_KDT = 16384, G_V = 24576, G_ST = 40960, G_LR = 73728, G_SEG = 77824, G_DEC = 79872, G_END = 80128;
__device__ __forceinline__ int sw128(int row, int ch) { return row * 128 + ((ch ^ ((row >> 1) & 7)) << 4); }

__device__ __forceinline__ void gla_local(const Frame& F, const Args& A, LAS unsigned char* sh, int unit) {
    const int b = unit >> 6, hh = (unit >> 4) & 3, sc = unit & 15;
    const int lane = hw_lane(), w = F.wave, tid = w * 64 + lane, r32 = lane & 31, h = lane >> 5;
    const bf16* PROJ = (const bf16*)(A.ws + WS_PROJ);
    const size_t tok0 = (size_t)b * SEQ + 256 * sc;
    const int c = lane;
    float wg[16];
#pragma unroll
    for (int r = 0; r < 16; ++r) wg[r] = A.in[13][r * 256 + hh * 64 + c];
    const float bg = A.in[14][hh * 64 + c];
    float Bprev = 0.f;
    const int dvt = w >> 1, it = w & 1;
    f32x16 accS = {};
    const int i16 = lane & 15, tq = i16 >> 2, tp = i16 & 3, g1 = (lane >> 4) & 1;
    const int vcol = ((4 * (dvt ^ tq) + 2 * g1 + (tp >> 1)) << 4) + (tp & 1) * 8;
    __syncthreads();
#pragma unroll 1
    for (int n = 0; n < 4; ++n) {
        const size_t tb = tok0 + 64 * n;
        { const int trow = tid >> 3, pr = tid & 7; const unsigned lw = *(const unsigned*)(PROJ + (tb + trow) * NPROJ + C_LR + 2 * pr);
          LAS float* lr = (LAS float*)(sh + G_LR); lr[trow * 16 + 2 * pr] = bflo(lw); lr[trow * 16 + 2 * pr + 1] = bfhi(lw);
#pragma unroll
          for (int k2 = 0; k2 < 2; ++k2) { const int ch = pr * 2 + k2; const v4u vv = *(const v4u*)(PROJ + (tb + trow) * NPROJ + C_VG + hh * 128 + ch * 8);
              *(LAS v4u*)(sh + G_V + trow * 256 + ((ch ^ ((trow & 3) << 2)) << 4)) = vv; } }
        __syncthreads();
        float cum[8], qv[8], kv[8];
        { LAS const float* lr = (LAS const float*)(sh + G_LR); float run = 0.f;
#pragma unroll
          for (int k = 0; k < 8; ++k) { const int i = 8 * w + k; float x = bg;
#pragma unroll
              for (int r = 0; r < 16; ++r) x += lr[i * 16 + r] * wg[r];
              run += log_sigmoid(x) * (1.0f / 16.0f); cum[k] = run;
              qv[k] = 0.125f * bf2f(PROJ[(tb + i) * NPROJ + C_QG + hh * 64 + c]); kv[k] = bf2f(PROJ[(tb + i) * NPROJ + C_KG + hh * 64 + c]); }
          ((LAS float*)(sh + G_SEG))[w * 64 + c] = run; }
        __syncthreads();
        { LAS const float* seg = (LAS const float*)(sh + G_SEG); float pre = 0.f, tot = 0.f;
#pragma unroll
          for (int g_ = 0; g_ < 8; ++g_) { const float sv = seg[g_ * 64 + c]; tot += sv; if (g_ < w) pre += sv; }
          const float eB = __expf(Bprev);
          unsigned kdw[4];
#pragma unroll
          for (int k = 0; k < 8; ++k) { const int i = 8 * w + k; const float bb = pre + cum[k];
              const float qe = qv[k] * __expf(bb), ke = kv[k] * __expf(-bb), kd = kv[k] * __expf(tot - bb);
              *(LAS unsigned short*)(sh + G_QE + sw128(i, c >> 3) + (c & 7) * 2) = (unsigned short)f2bf(qe);
              *(LAS unsigned short*)(sh + G_KE + sw128(i, c >> 3) + (c & 7) * 2) = (unsigned short)f2bf(ke);
              ((bf16*)(A.ws + WS_QB))[(tb + i) * 256 + hh * 64 + c] = (bf16)f2bf(qe * eB);
              if (k & 1) kdw[k >> 1] |= f2bf(kd) << 16; else kdw[k >> 1] = f2bf(kd); }
          *(LAS v4u*)(sh + G_KDT + sw128(c, w)) = (v4u){kdw[0], kdw[1], kdw[2], kdw[3]};
          if (w == 0) ((LAS float*)(sh + G_DEC))[c] = __expf(tot);
          Bprev += tot; }
        __syncthreads();
        LAS const unsigned char* qeb = sh + G_QE; LAS const unsigned char* keb = sh + G_KE; LAS const unsigned char* vbase = sh + G_V;
        bf16x8 qfr[4];
#pragma unroll
        for (int ks = 0; ks < 4; ++ks) qfr[ks] = *(LAS const bf16x8*)(qeb + sw128(32 * it + r32, 2 * ks + h));
        f32x16 oT = {};
#pragma unroll
        for (int jt = 0; jt < 2; ++jt) {
            if (jt <= it) {
                f32x16 s = {};
#pragma unroll
                for (int ks = 0; ks < 4; ++ks) { const bf16x8 kf = *(LAS const bf16x8*)(keb + sw128(32 * jt + r32, 2 * ks + h)); s = __builtin_amdgcn_mfma_f32_32x32x16_bf16(kf, qfr[ks], s, 0, 0, 0); }
                if (jt == it) {
#pragma unroll
                    for (int r = 0; r < 16; ++r) { const int j = (r & 3) + 8 * (r >> 2) + 4 * h; if (j > r32) s[r] = 0.f; }
                }
#pragma unroll
                for (int s2 = 0; s2 < 2; ++s2) {
                    v4u pw; pw.x = cvtpk(s[8 * s2], s[8 * s2 + 1]); pw.y = cvtpk(s[8 * s2 + 2], s[8 * s2 + 3]); pw.z = cvtpk(s[8 * s2 + 4], s[8 * s2 + 5]); pw.w = cvtpk(s[8 * s2 + 6], s[8 * s2 + 7]);
                    const int row = 32 * jt + 16 * s2 + 4 * h + tq;
                    const s16x4 lo = vtr(vbase + row * 256 + vcol), hi = vtr(vbase + (row + 8) * 256 + vcol);
                    const bf16x8 vf = {lo[0], lo[1], lo[2], lo[3], hi[0], hi[1], hi[2], hi[3]};
                    oT = __builtin_amdgcn_mfma_f32_32x32x16_bf16(vf, __builtin_bit_cast(bf16x8, pw), oT, 0, 0, 0);
                }
            }
        }
        if (n > 0) {
            LAS const unsigned char* stb = sh + G_ST + (n & 1) * 16384;
#pragma unroll
            for (int ks = 0; ks < 4; ++ks) { const bf16x8 sf = *(LAS const bf16x8*)(stb + sw128(32 * dvt + r32, 2 * ks + h)); oT = __builtin_amdgcn_mfma_f32_32x32x16_bf16(sf, qfr[ks], oT, 0, 0, 0); }
        }
        { float* op = (float*)(A.ws + WS_OLOC) + (tb + 32 * it + r32) * 512 + hh * 128 + 32 * dvt + 4 * h;
#pragma unroll
          for (int rq = 0; rq < 4; ++rq) *(f32x4*)(op + 8 * rq) = (f32x4){oT[4 * rq], oT[4 * rq + 1], oT[4 * rq + 2], oT[4 * rq + 3]}; }
        { const float dec = ((LAS const float*)(sh + G_DEC))[32 * it + r32];
#pragma unroll
          for (int r = 0; r < 16; ++r) accS[r] *= dec;
#pragma unroll
          for (int ks = 0; ks < 4; ++ks) {
              const bf16x8 kdf = *(LAS const bf16x8*)(sh + G_KDT + sw128(32 * it + r32, 2 * ks + h));
              const int row = 16 * ks + 8 * h + tq;
              const s16x4 lo = vtr(vbase + row * 256 + vcol), hi = vtr(vbase + (row + 4) * 256 + vcol);
              const bf16x8 vf = {lo[0], lo[1], lo[2], lo[3], hi[0], hi[1], hi[2], hi[3]};
              accS = __builtin_amdgcn_mfma_f32_32x32x16_bf16(vf, kdf, accS, 0, 0, 0);
          }
          LAS unsigned char* stn = sh + G_ST + ((n + 1) & 1) * 16384; const int d = 32 * it + r32;
#pragma unroll
          for (int r = 0; r < 16; ++r) { const int dv = 32 * dvt + (r & 3) + 8 * (r >> 2) + 4 * h; *(LAS unsigned short*)(stn + sw128(dv, d >> 3) + (d & 7) * 2) = (unsigned short)f2bf(accS[r]); } }
        __syncthreads();
    }
    { float* up = (float*)(A.ws + WS_USC) + (size_t)unit * 8192; const int d = 32 * it + r32;
#pragma unroll
      for (int r = 0; r < 16; ++r) { const int dv = 32 * dvt + (r & 3) + 8 * (r >> 2) + 4 * h; up[dv * 64 + d] = accS[r]; }
      if (w == 0) ((float*)(A.ws + WS_DSC))[unit * 64 + c] = __expf(Bprev); }
}

__device__ __forceinline__ void gla_out(const Frame& F, const Args& A, LAS unsigned char* sh, int unit) {
    const int b = unit >> 6, hh = (unit >> 4) & 3, sc = unit & 15;
    const int lane = hw_lane(), w = F.wave, tid = w * 64 + lane, r32 = lane & 31, h = lane >> 5;
    const bf16* PROJ = (const bf16*)(A.ws + WS_PROJ);
    const size_t tok0 = (size_t)b * SEQ + 256 * sc;
    const int d4 = (tid & 15) * 4, dvr = tid >> 4;
    f32x4 S[4];
#pragma unroll
    for (int k = 0; k < 4; ++k) S[k] = (f32x4){0.f, 0.f, 0.f, 0.f};
    const float* U0 = (const float*)(A.ws + WS_USC) + (size_t)(unit - sc) * 8192; const float* D0 = (const float*)(A.ws + WS_DSC) + (size_t)(unit - sc) * 64;
#pragma unroll 1
    for (int s = 0; s < sc; ++s) { const f32x4 dd = *(const f32x4*)(D0 + s * 64 + d4);
#pragma unroll
        for (int k = 0; k < 4; ++k) { const f32x4 u = *(const f32x4*)(U0 + (size_t)s * 8192 + (32 * k + dvr) * 64 + d4); S[k] = S[k] * dd + u; } }
    __syncthreads();
#pragma unroll
    for (int k = 0; k < 4; ++k) { const int dv = 32 * k + dvr; v2u wv; wv.x = pk2(S[k].x, S[k].y); wv.y = pk2(S[k].z, S[k].w);
        *(LAS v2u*)(sh + sw128(dv, d4 >> 3) + (d4 & 7) * 2) = wv; }
    if (sc == 15) {
        const f32x4 dd = *(const f32x4*)(D0 + 15 * 64 + d4); float* op = A.out + O_GLAP + (size_t)(b * 4 + hh) * 8192;
#pragma unroll
        for (int k = 0; k < 4; ++k) { const int dv = 32 * k + dvr; const f32x4 u = *(const f32x4*)(U0 + (size_t)15 * 8192 + dv * 64 + d4); const f32x4 e = S[k] * dd + u;
            op[(d4 + 0) * 128 + dv] = e.x; op[(d4 + 1) * 128 + dv] = e.y; op[(d4 + 2) * 128 + dv] = e.z; op[(d4 + 3) * 128 + dv] = e.w; }
    }
    __syncthreads();
    const size_t tok = tok0 + 32 * w + r32;
    f32x16 acc[4];
#pragma unroll
    for (int t = 0; t < 4; ++t) acc[t] = f32x16{};
#pragma unroll
    for (int ks = 0; ks < 4; ++ks) { const bf16x8 qb = *(const bf16x8*)((const bf16*)(A.ws + WS_QB) + tok * 256 + hh * 64 + 16 * ks + 8 * h);
#pragma unroll
        for (int t = 0; t < 4; ++t) { const bf16x8 sf = *(LAS const bf16x8*)(sh + sw128(32 * t + r32, 2 * ks + h)); acc[t] = __builtin_amdgcn_mfma_f32_32x32x16_bf16(sf, qb, acc[t], 0, 0, 0); } }
    const float* ol = (const float*)(A.ws + WS_OLOC) + tok * 512 + hh * 128;
    float ss = 0.f;
#pragma unroll
    for (int t = 0; t < 4; ++t)
#pragma unroll
        for (int rq = 0; rq < 4; ++rq) { const f32x4 v = *(const f32x4*)(ol + 32 * t + 8 * rq + 4 * h);
#pragma unroll
            for (int e = 0; e < 4; ++e) { acc[t][4 * rq + e] += v[e]; ss += acc[t][4 * rq + e] * acc[t][4 * rq + e]; } }
    ss += __shfl_xor(ss, 32);
    const float rstd = 1.0f / sqrtf(ss * (1.0f / 128.0f) + EPS);
    const float* gn = A.in[15]; const bf16* gg = PROJ + tok * NPROJ + C_GG + hh * 128;
    bf16* dst = (bf16*)(A.ws + WS_MIX) + tok * 1024 + 512 + hh * 128;
#pragma unroll
    for (int t = 0; t < 4; ++t)
#pragma unroll
        for (int rq = 0; rq < 4; ++rq) { const int dv0 = 32 * t + 8 * rq + 4 * h; const f32x4 gnv = *(const f32x4*)(gn + dv0); const v2u gw = *(const v2u*)(gg + dv0);
            const float gv[4] = {bflo(gw.x), bfhi(gw.x), bflo(gw.y), bfhi(gw.y)}; float y[4];
#pragma unroll
            for (int e = 0; e < 4; ++e) y[e] = acc[t][4 * rq + e] * rstd * gnv[e] * gv[e] * __builtin_amdgcn_rcpf(1.0f + __expf(-gv[e]));
            v2u ov; ov.x = cvtpk(y[0], y[1]); ov.y = cvtpk(y[2], y[3]); *(v2u*)(dst + dv0) = ov; }
}

__device__ __forceinline__ void gla_sample(const Frame& F, const Args& A, LAS unsigned char* sh, int unit) {
    const int b = unit >> 2, hh = unit & 3, tid = F.wave * 64 + hw_lane();
    const bf16* PROJ = (const bf16*)(A.ws + WS_PROJ);
    LAS float* la = (LAS float*)sh;
    LAS float* qs = la + 256;
    LAS float* ks = qs + 256;
    LAS float* op = ks + 256;
    LAS float* of = op + 2048;
    __syncthreads();
    if (tid < 256) { const int t = tid >> 6, c = tid & 63; const size_t tok = (size_t)TP + b * 4 + t; float x = A.in[14][hh * 64 + c];
#pragma unroll
        for (int r = 0; r < 16; ++r) x += bf2f(PROJ[tok * NPROJ + C_LR + r]) * A.in[13][r * 256 + hh * 64 + c];
        la[tid] = __expf(log_sigmoid(x) * (1.0f / 16.0f)); qs[tid] = 0.125f * bf2f(PROJ[tok * NPROJ + C_QG + hh * 64 + c]); ks[tid] = bf2f(PROJ[tok * NPROJ + C_KG + hh * 64 + c]); }
    __syncthreads();
    const int dv = tid & 127, cg = tid >> 7;
    const float* s0 = A.in[4] + (size_t)(b * 4 + hh) * 8192;
    float S[16];
#pragma unroll
    for (int k = 0; k < 16; ++k) S[k] = s0[(16 * cg + k) * 128 + dv];
#pragma unroll
    for (int t = 0; t < 4; ++t) { const float vv = bf2f(PROJ[((size_t)TP + b * 4 + t) * NPROJ + C_VG + hh * 128 + dv]); float o = 0.f;
#pragma unroll
        for (int k = 0; k < 16; ++k) { const int c = 16 * cg + k; S[k] = la[t * 64 + c] * S[k] + ks[t * 64 + c] * vv; o += qs[t * 64 + c] * S[k]; }
        op[(cg * 4 + t) * 128 + dv] = o; }
    float* so = A.out + O_GLAS + (size_t)(b * 4 + hh) * 8192;
#pragma unroll
    for (int k = 0; k < 16; ++k) so[(16 * cg + k) * 128 + dv] = S[k];
    __syncthreads();
    { const int t = tid >> 7; of[t * 128 + dv] = (op[(0 * 4 + t) * 128 + dv] + op[(1 * 4 + t) * 128 + dv]) + (op[(2 * 4 + t) * 128 + dv] + op[(3 * 4 + t) * 128 + dv]); }
    __syncthreads();
    { const int t = tid >> 7; float ss = 0.f;
      for (int k = 0; k < 128; ++k) { const float v = of[t * 128 + k]; ss += v * v; }
      const float rstd = 1.0f / sqrtf(ss * (1.0f / 128.0f) + EPS); const size_t tok = (size_t)TP + b * 4 + t;
      const float gv = bf2f(PROJ[tok * NPROJ + C_GG + hh * 128 + dv]);
      const float y = of[t * 128 + dv] * rstd * A.in[15][dv] * gv * __builtin_amdgcn_rcpf(1.0f + __expf(-gv));
      ((bf16*)(A.ws + WS_MIX))[tok * 1024 + 512 + hh * 128 + dv] = (bf16)f2bf(y); }
}

#ifdef PROBE_PHASE
#define PREP(k) ((PROBE_PHASE) == (k) ? 2 : 1)
#else
#define PREP(k) 1
#endif
__device__ __forceinline__ void phase2(const Frame& F, const Args& A) {
    LAS unsigned char* sh = F.lds;
#ifndef SKIP_CMP
    _Pragma("unroll 1") for (int rep = 0; rep < PREP(21); ++rep) cmp_phase(F, A, sh);
#endif
    #ifndef SKIP_GLAL
    _Pragma("unroll 1") for (int rep = 0; rep < PREP(22); ++rep) for (int u = F.vcu; u < 256; u += F.G) gla_local(F, A, sh, u);
#endif
    #ifndef SKIP_GLAS
    _Pragma("unroll 1") for (int rep = 0; rep < PREP(24); ++rep) for (int u = F.vcu; u < 128; u += F.G) gla_sample(F, A, sh, u);
#endif
    __syncthreads();
    attn_fill_lut((LAS float*)(sh + AT_LUT), A.in[24], F.tid);
    __syncthreads();
    _Pragma("unroll 1") for (int rep = 0; rep < PREP(23); ++rep) for (int p = F.vcu; p < 256; p += F.G) { const int bg = p >> 5, s = p & 31;
#ifndef SKIP_WIN
 win_unit(F, A, sh, bg >> 1, bg & 1, 63 - s); win_unit(F, A, sh, bg >> 1, bg & 1, s);
#endif
 }
}
__device__ __forceinline__ void phase3(const Frame& F, const Args& A) {
    LAS unsigned char* sh = F.lds;
    #ifndef SKIP_GLAO
    _Pragma("unroll 1") for (int rep = 0; rep < PREP(31); ++rep) for (int u = F.vcu; u < 256; u += F.G) gla_out(F, A, sh, u);
#endif
    __syncthreads();
    attn_fill_lut((LAS float*)(sh + AT_LUT), A.in[24], F.tid);
    __syncthreads();
    { gu32* qh = (gu32*)(A.ws + WS_CTL) + CW_Q3 + 64 * (F.vcu >> 5); LAS int* slot = (LAS int*)(sh + HI_Q);
      const int bg = (F.vcu >> 5) & 7;
      for (;;) {
          __syncthreads();
          if (F.wave == 0 && hw_lane() == 0) *slot = (int)__hip_atomic_fetch_add(qh, 1u, __ATOMIC_RELAXED, __HIP_MEMORY_SCOPE_AGENT);
          __syncthreads();
          const int idx = *slot;
          if (idx >= 72 * PREP(33)) break;
          const int k = idx % 72;
          if (k < 8) {
#ifndef SKIP_SAMP
              const int u = bg * 8 + k; samp_unit(F, A, sh, u >> 1, u & 1);
#endif
          } else {
#ifndef SKIP_NSA
              nsa_unit(F, A, sh, bg >> 1, bg & 1, 71 - k);
#endif
          }
      } }
}

template <class Epi>
__device__ __forceinline__ void skinny_phase(const Frame& F, const bf16* Act, int lda, const bf16* Bt, int K, int ncolgrp, const Epi& E) {
    const int lane = hw_lane(), w = F.wave, c16 = lane & 15, kg = lane >> 4;
    const int tg = w & 1, kq = w >> 1, kq_len = K / 4;
    LAS f32x4* xs = (LAS f32x4*)F.lds;
    for (int job = blockIdx.x; job < 4 * ncolgrp; job += F.G) {
        const int cg = job >> 2, tok = TP + 32 * (job & 3) + 16 * tg + c16;
        const bf16* ap = Bt + (size_t)(16 * cg + c16) * K + kq * kq_len + 8 * kg;
        const bf16* bp = Act + (size_t)tok * lda + kq * kq_len + 8 * kg;
        f32x4 acc = {0.f, 0.f, 0.f, 0.f};
#pragma unroll 8
        for (int ks = 0; ks < kq_len / 32; ++ks) { const bf16x8 af = *(const bf16x8*)(ap + 32 * ks), bf = *(const bf16x8*)(bp + 32 * ks); acc = __builtin_amdgcn_mfma_f32_16x16x32_bf16(af, bf, acc, 0, 0, 0); }
        __syncthreads();
        xs[w * 64 + lane] = acc;
        __syncthreads();
        if (kq == 0) { const f32x4 v = (xs[tg * 64 + lane] + xs[(2 + tg) * 64 + lane]) + (xs[(4 + tg) * 64 + lane] + xs[(6 + tg) * 64 + lane]); E(v, tok, 16 * cg + 4 * kg, kg); }
    }
}
struct SkInProj { bf16* proj; float* out;
    __device__ __forceinline__ void operator()(f32x4 v, int tok, int col, int kg) const {
        if (col < 512) v = v * 0.125f;
        v2u w; w.x = cvtpk(v[0], v[1]); w.y = cvtpk(v[2], v[3]); *(v2u*)(proj + (size_t)tok * NPROJ + col) = w;
        if (col >= C_KV && col < C_WIN) *(f32x4*)(out + O_KV + (size_t)tok * 512 + (col - C_KV)) = v;
        else if (col >= C_WIN && col < C_GT) { const int rs = tok - TP, b = rs >> 2, i = rs & 3; *(f32x4*)(out + O_WINS + ((size_t)(b * 512 + 508 + i) * 256 + (col - C_WIN))) = v; }
    } };
struct SkResid { const float* base; float* hout; bf16* hb; float* rowss;
    __device__ __forceinline__ void operator()(f32x4 v, int tok, int col, int kg) const {
        v = v + *(const f32x4*)(base + (size_t)(tok - TP) * 1024 + col);
        *(f32x4*)(hout + (size_t)tok * 1024 + col) = v;
        v2u w; w.x = cvtpk(v[0], v[1]); w.y = cvtpk(v[2], v[3]); *(v2u*)(hb + (size_t)tok * 1024 + col) = w;
        float ss = (v[0] * v[0] + v[1] * v[1]) + (v[2] * v[2] + v[3] * v[3]); ss += __shfl_xor(ss, 16); ss += __shfl_xor(ss, 32);
        if (kg == 0) atomicAdd(rowss + tok, ss);
    } };
struct SkBf { bf16* O; int ldc;
    __device__ __forceinline__ void operator()(f32x4 v, int tok, int col, int kg) const { v2u w; w.x = cvtpk(v[0], v[1]); w.y = cvtpk(v[2], v[3]); *(v2u*)(O + (size_t)tok * ldc + col) = w; } };
struct SkPleGate { const float* h2; const bf16* ple; const float* rowss2; float* y; float* rowss3;
    __device__ __forceinline__ void operator()(f32x4 a, int tok, int col, int kg) const {
        const float rstd = __builtin_amdgcn_rsqf(rowss2[tok] * (1.0f / 1024.0f) + EPS);
        const v2u pw = *(const v2u*)(ple + (size_t)tok * 1024 + col); const f32x4 b = *(const f32x4*)(h2 + (size_t)tok * 1024 + col);
        const float pv[4] = {bflo(pw.x), bfhi(pw.x), bflo(pw.y), bfhi(pw.y)}; f32x4 v;
#pragma unroll
        for (int e = 0; e < 4; ++e) v[e] = b[e] + pv[e] * __builtin_amdgcn_rcpf(1.0f + __expf(-a[e] * rstd));
        *(f32x4*)(y + (size_t)tok * 1024 + col) = v;
        float ss = (v[0] * v[0] + v[1] * v[1]) + (v[2] * v[2] + v[3] * v[3]); ss += __shfl_xor(ss, 16); ss += __shfl_xor(ss, 32);
        if (kg == 0) atomicAdd(rowss3 + tok, ss);
    } };

typedef const __attribute__((address_space(4))) Args* ArgsP;
__device__ __forceinline__ Args load_args() {
    Args r{};
#if defined(__HIP_DEVICE_COMPILE__)
    ArgsP p = (ArgsP)__builtin_amdgcn_kernarg_segment_ptr(); asm volatile("" : "+s"(p));
#pragma unroll
    for (int i = 0; i < 26; ++i) r.in[i] = p->in[i];
    r.out = p->out; r.ws = p->ws; r.ph_lo = p->ph_lo; r.ph_hi = p->ph_hi;
#endif
    return r;
}
__global__ void __launch_bounds__(NWAVES * 64, 2) mega_fwd(Args args_unused) {
    extern __shared__ __attribute__((aligned(16))) unsigned char lds_raw[];
    Frame F;
    F.lds = (LAS unsigned char*)lds_raw;
    F.wave = __builtin_amdgcn_readfirstlane((int)threadIdx.x >> 6); F.lane = hw_lane(); F.tid = F.wave * 64 + F.lane;
    F.G = gridDim.x; { const int bx = blockIdx.x; F.vcu = (F.G % 8 == 0) ? (bx % 8) * (F.G / 8) + bx / 8 : bx; }
    int lo, hi; unsigned char* ws;
    { const Args a0 = load_args(); lo = a0.ph_lo; hi = a0.ph_hi; ws = a0.ws; }
    gu32* ctl = (gu32*)(ws + WS_CTL);
    volatile LAS unsigned* MISC = (volatile LAS unsigned*)(F.lds + MISC_OFF);
    for (int u = F.tid; u < (LDS_BYTES - RING_BYTES) / 4; u += NWAVES * 64) ((LAS unsigned*)(F.lds + RING_BYTES))[u] = 0u;
    __syncthreads();
    const bool multi = (hi - lo) > 1;
    XcdBarrier bar; bar.bar = (unsigned*)(ctl + CW_BAR); bar.x = 0; bar.st = nullptr;
    if (multi) bar = xcd_barrier_post((unsigned*)(ctl + CW_BAR), MISC + 8, F.tid);
#define IN(k) (lo <= (k) && (k) < hi)
#ifdef PROBE_PHASE
#define NREP(k) ((PROBE_PHASE) == (k) ? 2 : 1)
#else
#define NREP(k) 1
#endif
    float* dummy_rowss = (float*)(ws + WS_END);
#define SEAM(k) do { if (IN(k) && IN((k) + 1)) { F.lane = hw_lane(); F.tid = F.wave * 64 + F.lane; xcd_barrier(bar, F.tid); } } while (0)
#define REFRESH() do { F.lane = hw_lane(); F.tid = F.wave * 64 + F.lane; } while (0)

    if (IN(0)) { REFRESH(); const Args args = load_args(); _Pragma("unroll 1") for (int rep = 0; rep < NREP(0); ++rep) { __syncthreads(); p0_prologue(F, args); } } SEAM(0);
    if (IN(1)) { REFRESH(); const Args args = load_args(); unsigned char* ws = args.ws;
        pg8::Gemm g{(const pg8::bf16_t*)(ws + WS_XN), (const pg8::bf16_t*)(ws + WS_WIN), TP, NPROJ, 1024}; pg8::StaticOrder S; S.init(TP, NPROJ, F.G, (int)blockIdx.x);
        pg8::EpiInProj E{(pg8::bf16_t*)(ws + WS_PROJ), args.out};
        _Pragma("unroll 1") for (int rep = 0; rep < NREP(1); ++rep) pg8::gemm_phase<pg8::EpiInProj, pg8::StaticOrder, true, true>(F.lds, g, S, E, F.tid);
        skinny_phase(F, (const bf16*)(ws + WS_XN), 1024, (const bf16*)(ws + WS_WIN), 1024, (NIN + 15) / 16, SkInProj{(bf16*)(ws + WS_PROJ), args.out});
    } SEAM(1);
    if (IN(2)) { REFRESH(); const Args args = load_args(); phase2(F, args); } SEAM(2);
    if (IN(3)) { REFRESH(); const Args args = load_args(); phase3(F, args); } SEAM(3);
    if (IN(4)) { REFRESH(); const Args args = load_args(); unsigned char* ws = args.ws; float* rowss1 = (float*)(ws + WS_ROWSS);
        { pg8::Gemm g{(const pg8::bf16_t*)(ws + WS_MIX), (const pg8::bf16_t*)(ws + WS_WO), TP, 1024, 1024}; pg8::StaticOrder S; S.init(TP, 1024, F.G, (int)blockIdx.x);
          _Pragma("unroll 1") for (int rep = 0; rep < NREP(4); ++rep) { pg8::EpiResid E{args.in[0], args.in[1], (float*)(ws + WS_H1), (pg8::bf16_t*)(ws + WS_H1B), rep ? dummy_rowss : rowss1};
          pg8::gemm_phase<pg8::EpiResid, pg8::StaticOrder, true, true>(F.lds, g, S, E, F.tid); } }
        { pg8::Gemm g{(const pg8::bf16_t*)(ws + WS_PPLE), (const pg8::bf16_t*)(ws + WS_WPLE), TP, 1024, 256}; pg8::StaticOrder S; S.init(TP, 1024, F.G, (int)blockIdx.x);
          pg8::EpiBf E{(pg8::bf16_t*)(ws + WS_PLEB), 1024};
          _Pragma("unroll 1") for (int rep = 0; rep < NREP(41); ++rep) pg8::gemm_phase<pg8::EpiBf, pg8::StaticOrder, true, true>(F.lds, g, S, E, F.tid); }
        skinny_phase(F, (const bf16*)(ws + WS_MIX), 1024, (const bf16*)(ws + WS_WO), 1024, 64, SkResid{args.in[1], (float*)(ws + WS_H1), (bf16*)(ws + WS_H1B), rowss1});
        skinny_phase(F, (const bf16*)(ws + WS_PPLE), 256, (const bf16*)(ws + WS_WPLE), 256, 64, SkBf{(bf16*)(ws + WS_PLEB), 1024});
    } SEAM(4);
    if (IN(5)) { REFRESH(); const Args args = load_args(); unsigned char* ws = args.ws; float* rowss1 = (float*)(ws + WS_ROWSS);
        pg8::Gemm g{(const pg8::bf16_t*)(ws + WS_H1B), (const pg8::bf16_t*)(ws + WS_WGU), MPAD, NGU, 1024}; pg8::StaticOrder S; S.init(MPAD, NGU, F.G, (int)blockIdx.x);
        pg8::EpiGateUp E{(pg8::bf16_t*)(ws + WS_ACT), rowss1};
        _Pragma("unroll 1") for (int rep = 0; rep < NREP(5); ++rep) pg8::gemm_phase<pg8::EpiGateUp, pg8::StaticOrder, true, true>(F.lds, g, S, E, F.tid);
    } SEAM(5);
    if (IN(6)) { REFRESH(); const Args args = load_args(); unsigned char* ws = args.ws; float* rowss2 = (float*)(ws + WS_ROWSS) + MPAD;
        pg8::Gemm g{(const pg8::bf16_t*)(ws + WS_ACT), (const pg8::bf16_t*)(ws + WS_WDN), TP, 1024, DFF}; pg8::StaticOrder S; S.init(TP, 1024, F.G, (int)blockIdx.x);
        _Pragma("unroll 1") for (int rep = 0; rep < NREP(6); ++rep) { pg8::EpiResid E{(const float*)(ws + WS_H1), (const float*)(ws + WS_H1) + (size_t)TP * 1024, (float*)(ws + WS_H2), (pg8::bf16_t*)(ws + WS_H2B), rep ? dummy_rowss : rowss2};
        pg8::gemm_phase<pg8::EpiResid, pg8::StaticOrder, true, true>(F.lds, g, S, E, F.tid); }
        skinny_phase(F, (const bf16*)(ws + WS_ACT), DFF, (const bf16*)(ws + WS_WDN), DFF, 64, SkResid{(const float*)(ws + WS_H1) + (size_t)TP * 1024, (float*)(ws + WS_H2), (bf16*)(ws + WS_H2B), rowss2});
    } SEAM(6);
    if (IN(7)) { REFRESH(); const Args args = load_args(); unsigned char* ws = args.ws; float* rowss2 = (float*)(ws + WS_ROWSS) + MPAD; float* rowss3 = rowss2 + MPAD;
        pg8::Gemm g{(const pg8::bf16_t*)(ws + WS_H2B), (const pg8::bf16_t*)(ws + WS_WPG), TP, 1024, 1024}; pg8::StaticOrder S; S.init(TP, 1024, F.G, (int)blockIdx.x);
        _Pragma("unroll 1") for (int rep = 0; rep < NREP(7); ++rep) { pg8::EpiPleGate E{(const float*)(ws + WS_H2), (const pg8::bf16_t*)(ws + WS_PLEB), rowss2, args.out + O_Y, rep ? dummy_rowss : rowss3};
        pg8::gemm_phase<pg8::EpiPleGate, pg8::StaticOrder, true, true>(F.lds, g, S, E, F.tid); }
        skinny_phase(F, (const bf16*)(ws + WS_H2B), 1024, (const bf16*)(ws + WS_WPG), 1024, 64, SkPleGate{(const float*)(ws + WS_H2), (const bf16*)(ws + WS_PLEB), rowss2, args.out + O_Y, rowss3});
    } SEAM(7);
    if (IN(8)) { REFRESH(); const Args args = load_args(); unsigned char* ws = args.ws; float* rowss3 = (float*)(ws + WS_ROWSS) + 2 * MPAD;
        const int gw = F.vcu * NWAVES + F.wave, NGW = F.G * NWAVES; const GAS f32x4* gr = (const GAS f32x4*)args.in[25] + F.lane;
        for (int m = gw; m < MTOT; m += NGW) { GAS f32x4* yr = (GAS f32x4*)(args.out + O_Y + (size_t)m * 1024) + F.lane; const float rstd = 1.0f / sqrtf(rowss3[m] * (1.0f / 1024.0f) + EPS);
#pragma unroll
            for (int j = 0; j < 4; ++j) { const f32x4 v = yr[64 * j], gg = gr[64 * j]; yr[64 * j] = (f32x4){v.x * rstd * gg.x, v.y * rstd * gg.y, v.z * rstd * gg.z, v.w * rstd * gg.w}; } }
    }
#undef IN
#undef SEAM
#undef REFRESH
}

extern "C" void kernel_launch(void* const* d_in, const int* in_sizes, int n_in, void* d_out, int out_size, void* d_ws, size_t ws_size, hipStream_t stream) {
    static int grid = 0;
    if (grid == 0) {
        if (n_in != 26 || (size_t)out_size != O_END || ws_size < WS_END + (1u << 20)) { fprintf(stderr, "kernel_launch: unexpected shapes: n_in %d out %d ws %zu\n", n_in, out_size, ws_size); grid = -1; return; }
        int dev = 0, cus = 0, per_cu = 0;
        if (hipGetDevice(&dev) != hipSuccess || hipDeviceGetAttribute(&cus, hipDeviceAttributeMultiprocessorCount, dev) != hipSuccess) { grid = -1; return; }
        if (hipFuncSetAttribute((const void*)mega_fwd, hipFuncAttributeMaxDynamicSharedMemorySize, LDS_BYTES) != hipSuccess) { fprintf(stderr, "kernel_launch: hipFuncSetAttribute failed\n"); grid = -1; return; }
        if (hipOccupancyMaxActiveBlocksPerMultiprocessor(&per_cu, (const void*)mega_fwd, NWAVES * 64, LDS_BYTES) != hipSuccess || per_cu < 1) { fprintf(stderr, "kernel_launch: occupancy query says %d blocks per CU\n", per_cu); grid = -1; return; }
        (void)hipGetLastError();
        grid = cus;
    }
    if (grid < 0) return;
    (void)hipMemsetAsync((char*)d_ws + WS_CTL, 0, CTL_ZERO_BYTES, stream);
    Args a{};
    for (int i = 0; i < 26; ++i) a.in[i] = (const float*)d_in[i];
    a.out = (float*)d_out; a.ws = (unsigned char*)d_ws;
#ifndef N_LAUNCH_SPLIT
    a.ph_lo = 0; a.ph_hi = 9;
    hipLaunchKernelGGL(mega_fwd, dim3(grid), dim3(NWAVES * 64), LDS_BYTES, stream, a);
#else
    for (int p = 0; p < 9; ++p) { a.ph_lo = p; a.ph_hi = p + 1; hipLaunchKernelGGL(mega_fwd, dim3(grid), dim3(NWAVES * 64), LDS_BYTES, stream, a); }
#endif
}
```

```cpp
#include <hip/hip_runtime.h>
#include <cstdio>
#include <cstdint>

constexpr int DM = 1024, TP = 16384, TS = 128, MTOT = TP + TS, MPAD = 16640, SEQ = 4096, NBATCH = 4, DBATCH = 32, DSEQ = 4, PAST = 8192;
constexpr int NPROJ = 3072, DFF = 2816, DPLE = 256, NGU = 2 * DFF;
constexpr int C_QN = 0, C_KV = 512, C_WIN = 1024, C_GT = 1280, C_QG = 1304, C_KG = 1560, C_VG = 1816, C_LR = 2328, C_GG = 2344, NIN = 2856;
constexpr float EPS = 1e-6f;
constexpr size_t O_Y = 0, O_KV = (size_t)MTOT * 1024, O_WINP = O_KV + (size_t)MTOT * 512, O_WINS = O_WINP + 4 * 512 * 256,
                 O_GLAP = O_WINS + (size_t)32 * 512 * 256, O_GLAS = O_GLAP + 4 * 4 * 64 * 128, O_END = O_GLAS + (size_t)32 * 4 * 64 * 128;
namespace pg8 {
#define PG8_LAS __attribute__((address_space(3)))
typedef unsigned short bf16_t;
typedef short bf16x8 __attribute__((ext_vector_type(8)));
typedef float f32x4 __attribute__((ext_vector_type(4)));
typedef unsigned u32x4 __attribute__((ext_vector_type(4)));
constexpr int BM = 256, BK = 64, HALF = 128, HTB = HALF * BK * 2  , STAGE_BYTES = 8 * HTB, NXCD = 8, WGM = 8;

__host__ __device__ __forceinline__ int lds_byte(int r, int c) { const int st = (r >> 4) * 2 + (c >> 5), rr = r & 15, cc = c & 31, ob = rr * 64 + cc * 2; return st * 1024 + (ob ^ (((ob >> 9) & 1) << 5)); }
__host__ __device__ __forceinline__ void stage_rc(int b, int& R, int& C) { const int st = b / 1024, sb = b % 1024, swz = sb ^ (((sb >> 9) & 1) << 5); R = (st >> 1) * 16 + swz / 64; C = (st & 1) * 32 + (swz % 64) / 2; }
__host__ __device__ __forceinline__ int perm32(int rho) { const int n = rho >> 4, i = rho & 15; return 8 * (i >> 2) + 4 * n + (i & 3); }

struct Unit { int pm, pn; };
struct Gemm { const bf16_t* A; const bf16_t* Bt; int M, N, K; };

struct StaticOrder {
    int nM, nN, nwg, G, c;
    __host__ __device__ void init(int M, int N, int G_, int c_) { nM = M / BM; nN = N / BM; nwg = nM * nN; G = G_; c = c_; }
    __host__ __device__ bool next(int i, Unit& u) const {
        const long L = (long)i * G + c; if (L >= nwg) return false;
        int wgid = (int)L; { const int q = nwg / NXCD, r = nwg % NXCD, xcd = wgid % NXCD, off = wgid / NXCD; wgid = (xcd < r ? xcd * (q + 1) : r * (q + 1) + (xcd - r) * q) + off; }
        const int nig = WGM * nN, gid = wgid / nig, fm = gid * WGM, gsz = (nM - fm) < WGM ? (nM - fm) : WGM;
        u.pm = fm + ((wgid % nig) % gsz); u.pn = (wgid % nig) / gsz; return true;
    }
    __device__ __forceinline__ void a_ready(const Unit&) const {}
    __device__ __forceinline__ void done(const Unit&) const {}
};

__device__ __forceinline__ unsigned cvt_pk_bf16(float lo, float hi) { unsigned r; asm volatile("v_cvt_pk_bf16_f32 %0, %1, %2" : "=v"(r) : "v"(lo), "v"(hi)); return r; }

__device__ __forceinline__ u32x4 pack8(const f32x4 v0, const f32x4 v1) { u32x4 w; w.x = cvt_pk_bf16(v0[0], v0[1]); w.y = cvt_pk_bf16(v0[2], v0[3]); w.z = cvt_pk_bf16(v1[0], v1[1]); w.w = cvt_pk_bf16(v1[2], v1[3]); return w; }

struct EpiInProj {
    static constexpr bool PERM = true, AFTER_DRAIN = false;
    bf16_t* proj; float* out;
    __device__ __forceinline__ void operator()(const f32x4 (&acc)[2][2][4][2], const Unit& u, int wr, int wc, int fr, int fq) const {
        const int row0 = u.pm * BM + wr * 64 + fr, colb = u.pn * BM + wc * 32 + 8 * fq;
        const float sc = (u.pn < 2) ? 0.125f : 1.0f;
#pragma unroll
        for (int ai = 0; ai < 2; ++ai)
#pragma unroll
            for (int m = 0; m < 4; ++m) {
                const int r = row0 + ai * HALF + m * 16;
                if (r < MTOT) {
#pragma unroll
                    for (int bj = 0; bj < 2; ++bj) {
                        const int c = colb + bj * HALF;
                        const f32x4 v0 = acc[ai][bj][m][0] * sc, v1 = acc[ai][bj][m][1] * sc;
                        *(u32x4*)(proj + (size_t)r * NPROJ + c) = pack8(v0, v1);
                        if (u.pn == 2 || u.pn == 3) { float* o = out + O_KV + (size_t)r * 512 + (c - C_KV); *(f32x4*)o = v0; *(f32x4*)(o + 4) = v1; }
                        if (u.pn == 4) {
                            const int cc = c - C_WIN; float* o = nullptr;
                            if (r < TP) { const int pos = r & (SEQ - 1), b = r >> 12; if (pos >= SEQ - 512) o = out + O_WINP + ((size_t)(b * 512 + pos - (SEQ - 512)) * 256 + cc); }
                            else { const int rs = r - TP, b = rs >> 2, i = rs & 3; o = out + O_WINS + ((size_t)(b * 512 + 508 + i) * 256 + cc); }
                            if (o) { *(f32x4*)o = v0; *(f32x4*)(o + 4) = v1; }
                        }
                    }
                }
            }
    }
};
struct EpiResid {
    static constexpr bool PERM = true, AFTER_DRAIN = false;
    const float* baseA; const float* baseB;
    float* hout; bf16_t* hb; float* rowss;
    __device__ __forceinline__ void operator()(const f32x4 (&acc)[2][2][4][2], const Unit& u, int wr, int wc, int fr, int fq) const {
        const int row0 = u.pm * BM + wr * 64 + fr, colb = u.pn * BM + wc * 32 + 8 * fq;
#pragma unroll
        for (int ai = 0; ai < 2; ++ai)
#pragma unroll
            for (int m = 0; m < 4; ++m) {
                const int r = row0 + ai * HALF + m * 16;
                float ss = 0.f;
                if (r < MTOT) {
                    const float* bp = (r < TP) ? baseA + (size_t)r * 1024 : baseB + (size_t)(r - TP) * 1024;
#pragma unroll
                    for (int bj = 0; bj < 2; ++bj) {
                        const int c = colb + bj * HALF;
                        const f32x4 v0 = acc[ai][bj][m][0] + *(const f32x4*)(bp + c), v1 = acc[ai][bj][m][1] + *(const f32x4*)(bp + c + 4);
                        float* o = hout + (size_t)r * 1024 + c; *(f32x4*)o = v0; *(f32x4*)(o + 4) = v1;
                        *(u32x4*)(hb + (size_t)r * 1024 + c) = pack8(v0, v1);
                        ss += (v0[0] * v0[0] + v0[1] * v0[1]) + (v0[2] * v0[2] + v0[3] * v0[3]) + (v1[0] * v1[0] + v1[1] * v1[1]) + (v1[2] * v1[2] + v1[3] * v1[3]);
                    }
                }
                ss += __shfl_xor(ss, 16); ss += __shfl_xor(ss, 32);
                if (fq == 0 && r < MTOT) atomicAdd(rowss + r, ss);
            }
    }
};
struct EpiGateUp {
    static constexpr bool PERM = true, AFTER_DRAIN = false;
    bf16_t* act; const float* rowss;
    __device__ __forceinline__ void operator()(const f32x4 (&acc)[2][2][4][2], const Unit& u, int wr, int wc, int fr, int fq) const {
        const int row0 = u.pm * BM + wr * 64 + fr, colb = u.pn * HALF + wc * 32 + 8 * fq;
#pragma unroll
        for (int ai = 0; ai < 2; ++ai)
#pragma unroll
            for (int m = 0; m < 4; ++m) {
                const int r = row0 + ai * HALF + m * 16;
                if (r < MTOT) {
                    const float rstd = __builtin_amdgcn_rsqf(rowss[r] * (1.0f / 1024.0f) + EPS);
                    f32x4 o[2];
#pragma unroll
                    for (int n = 0; n < 2; ++n)
#pragma unroll
                        for (int e = 0; e < 4; ++e) { const float g = acc[ai][0][m][n][e] * rstd, up = acc[ai][1][m][n][e] * rstd; o[n][e] = g * up * __builtin_amdgcn_rcpf(1.0f + __expf(-g)); }
                    *(u32x4*)(act + (size_t)r * DFF + colb) = pack8(o[0], o[1]);
                }
            }
    }
};
struct EpiBf {
    static constexpr bool PERM = true, AFTER_DRAIN = false;
    bf16_t* O; int ldc;
    __device__ __forceinline__ void operator()(const f32x4 (&acc)[2][2][4][2], const Unit& u, int wr, int wc, int fr, int fq) const {
        const int row0 = u.pm * BM + wr * 64 + fr, colb = u.pn * BM + wc * 32 + 8 * fq;
#pragma unroll
        for (int ai = 0; ai < 2; ++ai)
#pragma unroll
            for (int m = 0; m < 4; ++m) {
                const int r = row0 + ai * HALF + m * 16;
                if (r < MTOT) {
#pragma unroll
                    for (int bj = 0; bj < 2; ++bj) *(u32x4*)(O + (size_t)r * ldc + colb + bj * HALF) = pack8(acc[ai][bj][m][0], acc[ai][bj][m][1]);
                }
            }
    }
};
struct EpiPleGate {
    static constexpr bool PERM = true, AFTER_DRAIN = false;
    const float* h2; const bf16_t* ple; const float* rowss2; float* y; float* rowss3;
    __device__ __forceinline__ void operator()(const f32x4 (&acc)[2][2][4][2], const Unit& u, int wr, int wc, int fr, int fq) const {
        const int row0 = u.pm * BM + wr * 64 + fr, colb = u.pn * BM + wc * 32 + 8 * fq;
#pragma unroll
        for (int ai = 0; ai < 2; ++ai)
#pragma unroll
            for (int m = 0; m < 4; ++m) {
                const int r = row0 + ai * HALF + m * 16;
                float ss = 0.f;
                if (r < MTOT) {
                    const float rstd = __builtin_amdgcn_rsqf(rowss2[r] * (1.0f / 1024.0f) + EPS);
#pragma unroll
                    for (int bj = 0; bj < 2; ++bj) {
                        const int c = colb + bj * HALF;
                        const u32x4 pw = *(const u32x4*)(ple + (size_t)r * 1024 + c);
                        const f32x4 b0 = *(const f32x4*)(h2 + (size_t)r * 1024 + c), b1 = *(const f32x4*)(h2 + (size_t)r * 1024 + c + 4);
                        float pv[8];
#pragma unroll
                        for (int e = 0; e < 4; ++e) { pv[2 * e] = __uint_as_float(pw[e] << 16); pv[2 * e + 1] = __uint_as_float(pw[e] & 0xffff0000u); }
                        f32x4 v0, v1;
#pragma unroll
                        for (int e = 0; e < 4; ++e) {
                            v0[e] = b0[e] + pv[e] * __builtin_amdgcn_rcpf(1.0f + __expf(-acc[ai][bj][m][0][e] * rstd));
                            v1[e] = b1[e] + pv[4 + e] * __builtin_amdgcn_rcpf(1.0f + __expf(-acc[ai][bj][m][1][e] * rstd));
                        }
                        float* o = y + (size_t)r * 1024 + c; *(f32x4*)o = v0; *(f32x4*)(o + 4) = v1;
                        ss += (v0[0] * v0[0] + v0[1] * v0[1]) + (v0[2] * v0[2] + v0[3] * v0[3]) + (v1[0] * v1[0] + v1[1] * v1[1]) + (v1[2] * v1[2] + v1[3] * v1[3]);
                    }
                }
                ss += __shfl_xor(ss, 16); ss += __shfl_xor(ss, 32);
                if (fq == 0 && r < MTOT) atomicAdd(rowss3 + r, ss);
            }
    }
};
template <class Epi, class Sched, bool ALIGN_EPI = false, bool SP2 = false>
__device__ __forceinline__ void gemm_phase(PG8_LAS unsigned char* lds, const Gemm g, const Sched& S, const Epi& E, const int tid) {
    const int wid = __builtin_amdgcn_readfirstlane(tid >> 6), lane = tid & 63, wr = wid >> 2, wc = wid & 3, fr = lane & 15, fq = lane >> 4;
    const int K = g.K, nt = K / BK;
    unsigned voffA[2], voffB[2];
#pragma unroll
    for (int i = 0; i < 2; ++i) { int R, C; stage_rc(tid * 16 + i * 8192, R, C); const int Rb = Epi::PERM ? ((R & ~31) + perm32(R & 31)) : R;
        voffA[i] = (unsigned)(R * K + C) * 2u; voffB[i] = (unsigned)(Rb * K + C) * 2u; }
    const size_t kstep = (size_t)(BK * 2);
    const size_t hstep = (size_t)HALF * K * 2;
    const size_t tstep = 2 * hstep;
    const unsigned ldsw = (unsigned)wid * 1024u;
    const int aoff = lds_byte(wr * 64 + fr, fq * 8), boff = lds_byte(wc * 32 + fr, fq * 8);
#define PG8_SA(b, h) (((b) * 2 + (h)) * HTB)
#define PG8_SB(b, h) ((4 + (b) * 2 + (h)) * HTB)
#define PG8_STAGE(bufoff, gbase, voff) do { _Pragma("unroll") for (int _i = 0; _i < 2; ++_i) \
        __builtin_amdgcn_global_load_lds((const unsigned*)((const char*)(gbase) + (voff)[_i]), (PG8_LAS unsigned*)(lds + (bufoff) + ldsw + _i * 8192), 16, 0, 0); } while (0)
#define PG8_LDA(dst, b, h) do { _Pragma("unroll") for (int m = 0; m < 4; ++m) _Pragma("unroll") for (int k = 0; k < 2; ++k) dst[m][k] = *(const PG8_LAS bf16x8*)(lds + PG8_SA(b, h) + aoff + m * 2048 + k * 1024); } while (0)
#define PG8_LDB(dst, b, h) do { _Pragma("unroll") for (int n = 0; n < 2; ++n) _Pragma("unroll") for (int k = 0; k < 2; ++k) dst[n][k] = *(const PG8_LAS bf16x8*)(lds + PG8_SB(b, h) + boff + n * 2048 + k * 1024); } while (0)
#define PG8_MMA(ai, bj, At, Bt) do { __builtin_amdgcn_s_setprio(1); _Pragma("unroll") for (int m = 0; m < 4; ++m) _Pragma("unroll") for (int n = 0; n < 2; ++n) _Pragma("unroll") for (int k = 0; k < 2; ++k) \
        acc[ai][bj][m][n] = __builtin_amdgcn_mfma_f32_16x16x32_bf16(Bt[n][k], At[m][k], acc[ai][bj][m][n], 0, 0, 0); __builtin_amdgcn_s_setprio(0); } while (0)
#define PG8_WAIT_V(n) asm volatile("s_waitcnt vmcnt(" #n ")" ::: "memory")
#define PG8_WAIT_L(n) asm volatile("s_waitcnt lgkmcnt(" #n ")" ::: "memory")
#define PG8_BAR __builtin_amdgcn_s_barrier()
#define PG8_SCHED __builtin_amdgcn_sched_barrier(0)
    Unit cur, nxt; int ui = 0;
    if (!S.next(0, cur)) return;
    f32x4 acc[2][2][4][2];
#pragma unroll
    for (int a = 0; a < 2; ++a)
#pragma unroll
        for (int b = 0; b < 2; ++b)
#pragma unroll
            for (int m = 0; m < 4; ++m)
#pragma unroll
                for (int n = 0; n < 2; ++n) acc[a][b][m][n] = (f32x4){0.f, 0.f, 0.f, 0.f};
    bf16x8 At[4][2], B0[2][2], B1[2][2];
    const char* cA = (const char*)g.A + (size_t)cur.pm * tstep; const char* cB = (const char*)g.Bt + (size_t)cur.pn * tstep;
    S.a_ready(cur);
    if constexpr (SP2) {
        PG8_STAGE(PG8_SB(0, 0), cB, voffB); PG8_STAGE(PG8_SB(0, 1), cB + hstep, voffB); PG8_STAGE(PG8_SA(0, 0), cA, voffA); PG8_STAGE(PG8_SA(0, 1), cA + hstep, voffA);
        if (wr == 1) PG8_BAR;
        PG8_WAIT_V(2); PG8_BAR;
        PG8_STAGE(PG8_SB(1, 0), cB + kstep, voffB); PG8_STAGE(PG8_SA(1, 0), cA + kstep, voffA); PG8_STAGE(PG8_SB(1, 1), cB + hstep + kstep, voffB);
        PG8_WAIT_V(6); PG8_BAR;
    } else {
        PG8_STAGE(PG8_SB(0, 0), cB, voffB); PG8_STAGE(PG8_SA(0, 0), cA, voffA); PG8_STAGE(PG8_SB(0, 1), cB + hstep, voffB); PG8_STAGE(PG8_SA(0, 1), cA + hstep, voffA);
        if (wr == 1) PG8_BAR;
        PG8_WAIT_V(4); PG8_BAR;
        PG8_STAGE(PG8_SB(1, 0), cB + kstep, voffB); PG8_STAGE(PG8_SA(1, 0), cA + kstep, voffA); PG8_STAGE(PG8_SB(1, 1), cB + hstep + kstep, voffB);
        PG8_WAIT_V(6); PG8_BAR;
    }
    for (;;) {
        const bool has_next = S.next(ui + 1, nxt);
        const char* nA = has_next ? (const char*)g.A + (size_t)nxt.pm * tstep : cA; const char* nB = has_next ? (const char*)g.Bt + (size_t)nxt.pn * tstep : cB;
        for (int t = 0; t < nt; t += 2) {
            const bool last = (t == nt - 2);
            const char* a1 = cA + (size_t)(t + 1) * kstep;
            const char* a2 = last ? nA : cA + (size_t)(t + 2) * kstep; const char* b2 = last ? nB : cB + (size_t)(t + 2) * kstep;
            const char* a3 = a2 + kstep; const char* b3 = b2 + kstep;
            if (last && has_next) S.a_ready(nxt);
            if constexpr (SP2) {
            PG8_LDB(B0, 0, 0); PG8_LDB(B1, 0, 1); PG8_SCHED; PG8_LDA(At, 0, 0); PG8_STAGE(PG8_SA(1, 1), a1 + hstep, voffA);
            PG8_WAIT_V(8); PG8_WAIT_L(0); PG8_BAR; PG8_MMA(0, 0, At, B0); PG8_MMA(0, 1, At, B1); PG8_BAR; PG8_SCHED;
            PG8_LDA(At, 0, 1); PG8_STAGE(PG8_SB(0, 0), b2, voffB); PG8_STAGE(PG8_SB(0, 1), b2 + hstep, voffB); PG8_STAGE(PG8_SA(0, 0), a2, voffA);
            PG8_WAIT_V(8); PG8_WAIT_L(0); PG8_BAR; PG8_MMA(1, 0, At, B0); PG8_MMA(1, 1, At, B1); PG8_BAR; PG8_SCHED;
            PG8_LDB(B0, 1, 0); PG8_LDB(B1, 1, 1); PG8_SCHED; PG8_LDA(At, 1, 0); PG8_STAGE(PG8_SA(0, 1), a2 + hstep, voffA);
            PG8_WAIT_V(8); PG8_WAIT_L(0); PG8_BAR; PG8_MMA(0, 0, At, B0); PG8_MMA(0, 1, At, B1); PG8_BAR; PG8_SCHED;
            PG8_LDA(At, 1, 1); PG8_STAGE(PG8_SB(1, 0), b3, voffB); PG8_STAGE(PG8_SB(1, 1), b3 + hstep, voffB); PG8_STAGE(PG8_SA(1, 0), a3, voffA);
            PG8_WAIT_V(8); PG8_WAIT_L(0); PG8_BAR; PG8_MMA(1, 0, At, B0); PG8_MMA(1, 1, At, B1); PG8_BAR; PG8_SCHED;
            } else {
            PG8_LDB(B0, 0, 0); PG8_SCHED; PG8_LDA(At, 0, 0); PG8_STAGE(PG8_SA(1, 1), a1 + hstep, voffA);
            PG8_WAIT_L(8); PG8_BAR; PG8_WAIT_L(0); PG8_MMA(0, 0, At, B0); PG8_BAR; PG8_SCHED;
            PG8_LDB(B1, 0, 1); PG8_STAGE(PG8_SB(0, 0), b2, voffB);
            PG8_BAR; PG8_WAIT_L(0); PG8_MMA(0, 1, At, B1); PG8_BAR;
            PG8_LDA(At, 0, 1); PG8_STAGE(PG8_SA(0, 0), a2, voffA);
            PG8_BAR; PG8_WAIT_L(0); PG8_MMA(1, 0, At, B0); PG8_BAR; PG8_SCHED;
            PG8_STAGE(PG8_SB(0, 1), b2 + hstep, voffB);
            PG8_WAIT_V(6); PG8_BAR; PG8_MMA(1, 1, At, B1); PG8_BAR;
            PG8_LDB(B0, 1, 0); PG8_SCHED; PG8_LDA(At, 1, 0); PG8_STAGE(PG8_SA(0, 1), a2 + hstep, voffA);
            PG8_WAIT_L(8); PG8_BAR; PG8_WAIT_L(0); PG8_MMA(0, 0, At, B0); PG8_BAR; PG8_SCHED;
            PG8_LDB(B1, 1, 1); PG8_STAGE(PG8_SB(1, 0), b3, voffB);
            PG8_BAR; PG8_WAIT_L(0); PG8_MMA(0, 1, At, B1); PG8_BAR;
            PG8_LDA(At, 1, 1); PG8_STAGE(PG8_SA(1, 0), a3, voffA);
            PG8_BAR; PG8_WAIT_L(0); PG8_MMA(1, 0, At, B0); PG8_BAR; PG8_SCHED;
            PG8_STAGE(PG8_SB(1, 1), b3 + hstep, voffB);
            PG8_WAIT_V(6); PG8_BAR; PG8_MMA(1, 1, At, B1); PG8_BAR;
            }
        }
        if constexpr (ALIGN_EPI) { if (wr == 0) PG8_BAR; }
        if constexpr (!Epi::AFTER_DRAIN) { E(acc, cur, wr, wc, fr, fq); S.done(cur); }
        if (!has_next) break;
#pragma unroll
        for (int a = 0; a < 2; ++a)
#pragma unroll
            for (int b = 0; b < 2; ++b)
#pragma unroll
                for (int m = 0; m < 4; ++m)
#pragma unroll
                    for (int n = 0; n < 2; ++n) acc[a][b][m][n] = (f32x4){0.f, 0.f, 0.f, 0.f};
        cur = nxt; cA = nA; cB = nB; ++ui;
        if constexpr (ALIGN_EPI) { if (wr == 1) PG8_BAR; }
    }
    PG8_WAIT_V(0);
    if constexpr (!ALIGN_EPI) { if (wr == 0) PG8_BAR; }
    PG8_BAR;
    if constexpr (Epi::AFTER_DRAIN) { E.fused(acc, cur, wr, wc, fr, fq, lds, wid, lane); S.done(cur); }
#undef PG8_SA
#undef PG8_SB
#undef PG8_STAGE
#undef PG8_LDA
#undef PG8_LDB
#undef PG8_MMA
#undef PG8_WAIT_V
#undef PG8_WAIT_L
#undef PG8_BAR
#undef PG8_SCHED
}
}


#define GAS __attribute__((address_space(1)))
#define LAS __attribute__((address_space(3)))
typedef unsigned short bf16;
typedef unsigned v4u __attribute__((ext_vector_type(4)));
typedef unsigned v2u __attribute__((ext_vector_type(2)));
typedef float f32x4 __attribute__((ext_vector_type(4)));
typedef float f32x2 __attribute__((ext_vector_type(2)));
typedef float f32x16 __attribute__((ext_vector_type(16)));
typedef short bf16x8 __attribute__((ext_vector_type(8)));
typedef short s16x4 __attribute__((ext_vector_type(4)));
typedef GAS unsigned gu32;
#define RLX_AGENT __ATOMIC_RELAXED, __HIP_MEMORY_SCOPE_AGENT
#define LDS_WAIT() asm volatile("s_waitcnt lgkmcnt(0)" ::: "memory")
#define VM_WAIT() asm volatile("s_waitcnt vmcnt(0)" ::: "memory")
__device__ __forceinline__ unsigned f2bf(float f) { unsigned u = __builtin_bit_cast(unsigned, f); return (u + 0x7fffu + ((u >> 16) & 1u)) >> 16; }
__device__ __forceinline__ unsigned pk2(float lo, float hi) { return f2bf(lo) | (f2bf(hi) << 16); }
__device__ __forceinline__ float bf2f(unsigned short h) { return __uint_as_float(((unsigned)h) << 16); }
__device__ __forceinline__ float bflo(unsigned w) { return __uint_as_float(w << 16); }
__device__ __forceinline__ float bfhi(unsigned w) { return __uint_as_float(w & 0xffff0000u); }

constexpr int NWAVES = 8;
constexpr size_t MiB = 1u << 20;
constexpr size_t WS_CTL = 0, CTL_ZERO_BYTES = 1 * MiB;
constexpr int CW_BAR = 4096, CW_Q3 = 16384;
constexpr size_t WS_ROWSS = 256 * 1024;
constexpr size_t WS_WIN = 2 * MiB;
constexpr size_t WS_WO = 8 * MiB;
constexpr size_t WS_WGU = 10 * MiB;
constexpr size_t WS_WDN = 21 * MiB;
constexpr size_t WS_WPG = 27 * MiB;
constexpr size_t WS_WPLE = 29 * MiB;
constexpr size_t WS_WC1 = 30 * MiB;
constexpr size_t WS_WC2 = 31 * MiB;
constexpr size_t WS_C1 = 31 * MiB + 65536;
constexpr size_t WS_KCP = 32 * MiB;
constexpr size_t WS_VCP = 33 * MiB;
constexpr size_t WS_KCS = 34 * MiB;
constexpr size_t WS_VCS = 38 * MiB;
constexpr size_t WS_DSC = 42 * MiB;
constexpr size_t WS_USC = 43 * MiB;
constexpr size_t WS_QB = 51 * MiB;
constexpr size_t WS_XN = 64 * MiB;
constexpr size_t WS_PPLE = 97 * MiB;
constexpr size_t WS_PROJ = 106 * MiB;
constexpr size_t WS_OWIN = 204 * MiB;
constexpr size_t WS_MIX = 221 * MiB;
constexpr size_t WS_OLOC = 254 * MiB;
constexpr size_t WS_H1 = 287 * MiB;
constexpr size_t WS_H1B = 353 * MiB;
constexpr size_t WS_ACT = 386 * MiB;
constexpr size_t WS_H2 = 476 * MiB;
constexpr size_t WS_H2B = 542 * MiB;
constexpr size_t WS_PLEB = 575 * MiB;
constexpr size_t WS_END = 608 * MiB;
constexpr int RING_BYTES = 131072;
constexpr int MISC_OFF = RING_BYTES + 320;
constexpr int LDS_BYTES = 163840;
#define XB_TMO      128
#define XB_XCNT(j)  (256  + 64 * (j))
#define XB_XSUB(j)  (1280 + 64 * (j))
#define XB_XGEN(j)  (2304 + 64 * (j))
#define XB_TOP      3328
#define XB_TOPGEN   3392
#define XCD_BAR_WORDS 3456
#define XB_SPIN_CAP (1u << 18)

__device__ __forceinline__ unsigned xb_ld(unsigned* p)              { return __hip_atomic_load(p, __ATOMIC_RELAXED, __HIP_MEMORY_SCOPE_AGENT); }
__device__ __forceinline__ unsigned xb_add(unsigned* p, unsigned v) { return __hip_atomic_fetch_add(p, v, __ATOMIC_RELAXED, __HIP_MEMORY_SCOPE_AGENT); }
__device__ __forceinline__ unsigned xb_xcc_id() { return (unsigned)__builtin_amdgcn_s_getreg((3 << 11) | 20) & 0xFu; }
#define XB_SPIN(cond, bar) do { unsigned _sp = 0; while (cond) { __builtin_amdgcn_s_sleep(1); \
    if ((++_sp & 255u) == 0u) { if (xb_ld(&(bar)[XB_TMO])) break; if (_sp > XB_SPIN_CAP) { atomicAdd(&(bar)[XB_TMO], 1u); break; } } } } while (0)

struct XcdBarrier {
    unsigned* bar; unsigned x;
    volatile LAS unsigned* st;
};

__device__ __forceinline__ XcdBarrier xcd_barrier_post(unsigned* bar, volatile LAS unsigned* st, const int tid) {
    XcdBarrier b; b.bar = bar; b.x = xb_xcc_id(); b.st = st;
    if (tid == 0) (void)xb_add(&bar[XB_XCNT(b.x)], 1u);
    return b;
}
__device__ __forceinline__ void xcd_barrier_complete(unsigned* bar, unsigned x, unsigned& nloc, unsigned& nx) {
    const unsigned G = gridDim.x * gridDim.y * gridDim.z;
    unsigned sum, cnt, mine, sp = 0u;
    for (;;) {
        sum = 0u; cnt = 0u; mine = 0u;
#pragma unroll
        for (unsigned j = 0; j < 16; ++j) { const unsigned c = xb_ld(&bar[XB_XCNT(j)]); sum += c; cnt += (c > 0u) ? 1u : 0u; mine = (j == x) ? c : mine; }
        if (sum == G) break;
        __builtin_amdgcn_s_sleep(1);
        if ((++sp & 255u) == 0u) { if (xb_ld(&bar[XB_TMO])) break; if (sp > XB_SPIN_CAP) { atomicAdd(&bar[XB_TMO], 1u); break; } }
    }
    nloc = mine > 0u ? mine : 1u; nx = cnt > 0u ? cnt : 1u;
}

__device__ __forceinline__ void xcd_barrier(const XcdBarrier& b, const int tid) {
    asm volatile("s_waitcnt vmcnt(0)" ::: "memory");
    __syncthreads();
    if (tid == 0) {
        unsigned* bar = b.bar;
        __builtin_amdgcn_s_waitcnt(0);
        unsigned nloc = b.st[0], nx = b.st[1];
        if (nloc == 0u) { xcd_barrier_complete(bar, b.x, nloc, nx); b.st[0] = nloc; b.st[1] = nx; }
        const unsigned old = xb_add(&bar[XB_XSUB(b.x)], 1u);
        const unsigned gen = old / nloc;
        if (old + 1u == (gen + 1u) * nloc) {
            __builtin_amdgcn_fence(__ATOMIC_RELEASE, "agent");
            asm volatile("s_waitcnt vmcnt(0)" ::: "memory");
            const unsigned og = xb_add(&bar[XB_TOP], 1u);
            const unsigned tg = og / nx;
            if (og + 1u == (tg + 1u) * nx) xb_add(&bar[XB_TOPGEN], 1u);
            else XB_SPIN(xb_ld(&bar[XB_TOPGEN]) == tg, bar);
            __builtin_amdgcn_fence(__ATOMIC_ACQUIRE, "agent");
            xb_add(&bar[XB_XGEN(b.x)], 1u);
            asm volatile("s_waitcnt vmcnt(0)" ::: "memory");
        } else {
            XB_SPIN(xb_ld(&bar[XB_XGEN(b.x)]) == gen, bar);
            __builtin_amdgcn_fence(__ATOMIC_ACQUIRE, "agent");
            asm volatile("s_waitcnt vmcnt(0)" ::: "memory");
        }
    }
    __syncthreads();
}

struct Args { const float* in[26]; float* out; unsigned char* ws; int ph_lo, ph_hi; };
struct Frame {
    LAS unsigned char* lds;
    int tid, lane, wave, vcu, G;
};
__device__ __forceinline__ int hw_lane() { int l; asm volatile("v_mbcnt_lo_u32_b32 %0, -1, 0\n\tv_mbcnt_hi_u32_b32 %0, -1, %0" : "=v"(l)); return l; }
__device__ __forceinline__ int opaque(int x) { asm volatile("" : "+v"(x)); return x; }
__device__ __forceinline__ float wave_sum(float v) {
#pragma unroll
    for (int o = 1; o < 64; o <<= 1) v += __shfl_xor(v, o);
    return v;
}
__device__ __forceinline__ void p0_tr_item(const float* W, int ldw, int K, int nsrc, int nblk, bf16* WT, int mode, const float* kscale, LAS float* scr, int item, int lane) {
    const int kb = item / nblk, nb = item % nblk, k0 = 64 * kb, n0 = 32 * nb;
    const int nn = n0 + (lane & 31);
#pragma unroll 16
    for (int i = 0; i < 32; ++i) { const int kk = 2 * i + (lane >> 5); float v = 0.f; if (nn < nsrc) { v = W[(size_t)(k0 + kk) * ldw + nn]; if (kscale) v *= kscale[k0 + kk]; } scr[kk * 33 + (lane & 31)] = v; }
    LDS_WAIT(); asm volatile("" ::: "memory");
    const int c = lane & 7;
#pragma unroll
    for (int j = 0; j < 4; ++j) { const int n = (lane >> 3) + 8 * j; const LAS float* s = scr + (8 * c) * 33 + n;
        v4u o; o.x = pk2(s[0 * 33], s[1 * 33]); o.y = pk2(s[2 * 33], s[3 * 33]); o.z = pk2(s[4 * 33], s[5 * 33]); o.w = pk2(s[6 * 33], s[7 * 33]);
        const int ng = n0 + n; const int drow = (mode == 0) ? ng : (256 * (ng >> 7) + (ng & 127) + (mode == 2 ? 128 : 0));
        *(GAS v4u*)(WT + (size_t)drow * K + k0 + 8 * c) = o; }
    LDS_WAIT(); asm volatile("" ::: "memory");
}
__device__ __forceinline__ void rms_row_to_bf16(const float* xrow, const float* g, bf16* orow, int lane) {
    const GAS f32x4* xr = (const GAS f32x4*)xrow + lane; const GAS f32x4* gr = (const GAS f32x4*)g + lane;
    f32x4 v[4]; float s = 0.f;
#pragma unroll
    for (int j = 0; j < 4; ++j) { v[j] = xr[64 * j]; s += (v[j].x * v[j].x + v[j].y * v[j].y) + (v[j].z * v[j].z + v[j].w * v[j].w); }
    const float rstd = 1.0f / sqrtf(wave_sum(s) * (1.f / DM) + EPS);
    GAS unsigned long long* o8 = (GAS unsigned long long*)orow + lane;
#pragma unroll
    for (int j = 0; j < 4; ++j) { const f32x4 gg = gr[64 * j];
        o8[64 * j] = (unsigned long long)pk2(v[j].x * rstd * gg.x, v[j].y * rstd * gg.y) | ((unsigned long long)pk2(v[j].z * rstd * gg.z, v[j].w * rstd * gg.w) << 32); }
}
__device__ __forceinline__ void p0_prologue(const Frame& F, const Args& A) {
    unsigned char* ws = A.ws;
    LAS float* scr = (LAS float*)(F.lds + F.wave * 16384);
    const int gw = F.vcu * NWAVES + F.wave, NGW = F.G * NWAVES, lane = F.lane;
    constexpr int I_IN = 16 * 96, I_O = 16 * 32, I_G = 16 * 88, I_D = 44 * 32, I_PG = 16 * 32, I_PL = 4 * 32, I_C1 = 128  , I_C2 = 2 * 1 * 2;
    constexpr int NITEMS = I_IN + I_O + 2 * I_G + I_D + I_PG + I_PL + I_C1 + I_C2;
    for (int it = gw; it < NITEMS; it += NGW) {
        int r = it;
        if (r < I_IN) { p0_tr_item(A.in[9], NIN, 1024, NIN, 96, (bf16*)(ws + WS_WIN), 0, nullptr, scr, r, lane); continue; } r -= I_IN;
        if (r < I_O) { p0_tr_item(A.in[16], 1024, 1024, 1024, 32, (bf16*)(ws + WS_WO), 0, nullptr, scr, r, lane); continue; } r -= I_O;
        if (r < I_G) { p0_tr_item(A.in[18], DFF, 1024, DFF, 88, (bf16*)(ws + WS_WGU), 1, A.in[17], scr, r, lane); continue; } r -= I_G;
        if (r < I_G) { p0_tr_item(A.in[19], DFF, 1024, DFF, 88, (bf16*)(ws + WS_WGU), 2, A.in[17], scr, r, lane); continue; } r -= I_G;
        if (r < I_D) { p0_tr_item(A.in[20], 1024, DFF, 1024, 32, (bf16*)(ws + WS_WDN), 0, nullptr, scr, r, lane); continue; } r -= I_D;
        if (r < I_PG) { p0_tr_item(A.in[23], 1024, 1024, 1024, 32, (bf16*)(ws + WS_WPG), 0, A.in[22], scr, r, lane); continue; } r -= I_PG;
        if (r < I_PL) { p0_tr_item(A.in[21], 1024, 256, 1024, 32, (bf16*)(ws + WS_WPLE), 0, nullptr, scr, r, lane); continue; } r -= I_PL;
        if (r < I_C1) {
#pragma unroll
            for (int q4 = 0; q4 < 4; ++q4) { const int ch = (r * 4 + q4) * 64 + lane; const int l = ch & 63, ks = (ch >> 6) & 63, ht = (ch >> 12) & 1, jj = (ch >> 13) & 1, slot = ch >> 14;
                const float* src = A.in[11] + ((size_t)slot * 2048 + jj * 1024 + 16 * ks + 8 * (l >> 5)) * 64 + 32 * ht + (l & 31);
                v4u o; o.x = pk2(src[0], src[64]); o.y = pk2(src[128], src[192]); o.z = pk2(src[256], src[320]); o.w = pk2(src[384], src[448]);
                *(GAS v4u*)((bf16*)(ws + WS_WC1) + (size_t)ch * 8) = o; }
            continue; } r -= I_C1;
        { const int slot = r / 2; p0_tr_item(A.in[12] + (size_t)slot * 64 * 64, 64, 64, 64, 2, (bf16*)(ws + WS_WC2) + (size_t)slot * 64 * 64, 0, nullptr, scr, r % 2, lane); }
    }
    if (F.vcu < 2) { const int slot = F.vcu; const float* pe = A.in[10] + slot * 2048 + F.wave * 256; const float* w1 = A.in[11] + (size_t)slot * 2048 * 64 + (size_t)F.wave * 256 * 64; float a = 0.f;
#pragma unroll 16
        for (int k = 0; k < 256; ++k) a += pe[k] * w1[k * 64 + lane];
        ((LAS float*)(F.lds + F.wave * 16384 + 12288))[lane] = a; __syncthreads();
        if (F.wave == 0) { float t = 0.f;
#pragma unroll
            for (int w = 0; w < 8; ++w) t += ((LAS float*)(F.lds + w * 16384 + 12288))[lane];
            ((float*)(ws + WS_C1))[slot * 64 + lane] = t; }
    }
    bf16* XN = (bf16*)(ws + WS_XN);
    for (int m0 = gw; m0 < MPAD; m0 += 2 * NGW) {
        f32x4 v[2][4];
#pragma unroll
        for (int q = 0; q < 2; ++q) { const int m = m0 + q * NGW; if (m < MTOT) { const GAS f32x4* xr = (const GAS f32x4*)((m < TP) ? A.in[0] + (size_t)m * DM : A.in[1] + (size_t)(m - TP) * DM) + lane;
#pragma unroll
            for (int j = 0; j < 4; ++j) v[q][j] = xr[64 * j]; } else {
#pragma unroll
            for (int j = 0; j < 4; ++j) v[q][j] = (f32x4){0.f, 0.f, 0.f, 0.f}; } }
#pragma unroll
        for (int q = 0; q < 2; ++q) { const int m = m0 + q * NGW; if (m < MPAD) {
            float s = 0.f;
#pragma unroll
            for (int j = 0; j < 4; ++j) s += (v[q][j].x * v[q][j].x + v[q][j].y * v[q][j].y) + (v[q][j].z * v[q][j].z + v[q][j].w * v[q][j].w);
            const float rstd = 1.0f / sqrtf(wave_sum(s) * (1.f / DM) + EPS);
            GAS unsigned long long* o8 = (GAS unsigned long long*)(XN + (size_t)m * DM) + lane; const GAS f32x4* gr = (const GAS f32x4*)A.in[8] + lane;
#pragma unroll
            for (int j = 0; j < 4; ++j) { const f32x4 gg = gr[64 * j];
                o8[64 * j] = (unsigned long long)pk2(v[q][j].x * rstd * gg.x, v[q][j].y * rstd * gg.y) | ((unsigned long long)pk2(v[q][j].z * rstd * gg.z, v[q][j].w * rstd * gg.w) << 32); } } }
    }
    bf16* PP = (bf16*)(ws + WS_PPLE);
    for (int m0 = gw; m0 < MPAD; m0 += 4 * NGW) {
        f32x4 v[4];
#pragma unroll
        for (int q = 0; q < 4; ++q) { const int m = m0 + q * NGW; v[q] = (f32x4){0.f, 0.f, 0.f, 0.f}; if (m < MTOT) v[q] = ((const GAS f32x4*)((m < TP) ? A.in[6] + (size_t)m * DPLE : A.in[7] + (size_t)(m - TP) * DPLE))[lane]; }
#pragma unroll
        for (int q = 0; q < 4; ++q) { const int m = m0 + q * NGW; if (m < MPAD) { v2u o; o.x = pk2(v[q].x, v[q].y); o.y = pk2(v[q].z, v[q].w); ((GAS v2u*)(PP + (size_t)m * DPLE))[lane] = o;
            if (m >= MTOT) { GAS v4u* z = (GAS v4u*)((bf16*)(ws + WS_MIX) + (size_t)m * DM) + lane; z[0] = (v4u){0, 0, 0, 0}; z[64] = (v4u){0, 0, 0, 0}; } } }
    }
    for (int it0 = gw; it0 < DBATCH * 508; it0 += 4 * NGW) {
        f32x4 v[4];
#pragma unroll
        for (int q = 0; q < 4; ++q) { const int it = it0 + q * NGW; if (it < DBATCH * 508) { const int b = it / 508, r = it % 508; v[q] = ((const GAS f32x4*)(A.in[3] + (size_t)(b * 512 + r + 4) * 256))[lane]; } }
#pragma unroll
        for (int q = 0; q < 4; ++q) { const int it = it0 + q * NGW; if (it < DBATCH * 508) { const int b = it / 508, r = it % 508; ((GAS f32x4*)(A.out + O_WINS + (size_t)(b * 512 + r) * 256))[lane] = v[q]; } }
    }
}

constexpr float LOG2E = 1.4426950408889634f;
typedef short v4i16_t __attribute__((ext_vector_type(4)));
__device__ __forceinline__ s16x4 vtr(LAS const unsigned char* p) { return __builtin_bit_cast(s16x4, __builtin_amdgcn_ds_read_tr16_b64_v4i16((LAS v4i16_t*)p)); }
__device__ __forceinline__ unsigned cvtpk(float lo, float hi) { typedef float f2 __attribute__((ext_vector_type(2))); typedef __bf16 b2 __attribute__((ext_vector_type(2))); f2 v = {lo, hi}; b2 b = __builtin_convertvector(v, b2); return __builtin_bit_cast(unsigned, b); }
__device__ __forceinline__ int t5_bucket(int n) {
    if (n < 16) return n;
    const int large = 16 + (int)(logf((float)n / 16.0f) / 2.0794415416798357f * 16.0f);
    return large < 31 ? large : 31;
}
constexpr int HI_BASE = 131072 + 512, AT_LUT = HI_BASE, HI_IMPA = AT_LUT + 4096, HI_IMPB = HI_IMPA + 2176, HI_SEL = HI_IMPB + 2176, HI_SCS = HI_SEL + 128, HI_TL = HI_SCS + 512, HI_XCH = HI_TL + 512, HI_Q = HI_XCH + 8192, HI_END = HI_Q + 64;
constexpr int AT_K0 = 0, AT_V0 = 16384, AT_ST = 32768  , AT_IMPA = 65536, AT_IMPB = AT_IMPA + 64 * 65 * 4 + 64, AT_SEL = AT_IMPB + 64 * 65 * 4 + 64, AT_MISC = AT_SEL + 1024, AT_QF = ((AT_MISC + 4096 + 1023) / 1024) * 1024, AT_END = AT_QF + 32768;
struct AttnLane {
    int koff;
    int kx;
    int voff0, voff1;
    int r32, h;
};
__device__ __forceinline__ AttnLane attn_lane(int lane) {
    AttnLane L; L.r32 = lane & 31; L.h = lane >> 5; L.koff = L.r32 * 128; L.kx = (L.r32 >> 1) & 7;
    const int i16 = lane & 15, q = i16 >> 2, p = i16 & 3, g1 = (lane >> 4) & 1;
    const int base = (4 * L.h + q) * 128 + g1 * 32 + (p >> 1) * 16 + (p & 1) * 8;
    L.voff0 = base + ((q >> 1) * 64); L.voff1 = base + (((q >> 1) ^ 1) * 64);
    return L;
}
__device__ __forceinline__ void attn_fill_lut(LAS float* lut, const float* rel_bias, int tid) {
    for (int e = tid; e < 1024; e += NWAVES * 64) { const int dist = e >> 3, hd = e & 7; lut[e] = rel_bias[t5_bucket(dist) * 8 + hd] * LOG2E; }
}
__device__ __forceinline__ void attn_commit(LAS unsigned char* kb, LAS unsigned char* vb, int tid, v4u k, v4u v) {
    const int row = tid >> 3, ch = tid & 7;
    *(LAS v4u*)(kb + row * 128 + ((ch ^ ((row >> 1) & 7)) << 4)) = k;
    *(LAS v4u*)(vb + row * 128 + ((ch ^ (((row >> 1) & 1) << 2)) << 4)) = v;
}
__device__ __forceinline__ f32x16 attn_qk(LAS const unsigned char* kb, int hf, const AttnLane& L, const bf16x8 (&qf)[4]) {
    f32x16 s = {};
#pragma unroll
    for (int ks = 0; ks < 4; ++ks) { const bf16x8 kf = *(LAS const bf16x8*)(kb + hf * 4096 + L.koff + (((2 * ks + L.h) ^ L.kx) << 4)); s = __builtin_amdgcn_mfma_f32_32x32x16_bf16(kf, qf[ks], s, 0, 0, 0); }
    return s;
}
__device__ __forceinline__ void attn_pv(LAS const unsigned char* vb, int hf, const AttnLane& L, const f32x16& p, f32x16 (&o)[2]) {
#pragma unroll
    for (int s = 0; s < 2; ++s) {
        v4u pw; pw.x = cvtpk(p[8 * s + 0], p[8 * s + 1]); pw.y = cvtpk(p[8 * s + 2], p[8 * s + 3]); pw.z = cvtpk(p[8 * s + 4], p[8 * s + 5]); pw.w = cvtpk(p[8 * s + 6], p[8 * s + 7]);
        const bf16x8 pb = __builtin_bit_cast(bf16x8, pw);
        const int rb = (32 * hf + 16 * s) * 128;
        { const s16x4 lo = vtr(vb + rb + L.voff0), hi = vtr(vb + rb + 1024 + L.voff0); const bf16x8 vf = {lo[0], lo[1], lo[2], lo[3], hi[0], hi[1], hi[2], hi[3]};
          o[0] = __builtin_amdgcn_mfma_f32_32x32x16_bf16(vf, pb, o[0], 0, 0, 0); }
        { const s16x4 lo = vtr(vb + rb + L.voff1), hi = vtr(vb + rb + 1024 + L.voff1); const bf16x8 vf = {lo[0], lo[1], lo[2], lo[3], hi[0], hi[1], hi[2], hi[3]};
          o[1] = __builtin_amdgcn_mfma_f32_32x32x16_bf16(vf, pb, o[1], 0, 0, 0); }
    }
}
__device__ __forceinline__ float max16(const f32x16& a) {
    float m0 = fmaxf(fmaxf(a[0], a[1]), fmaxf(a[2], a[3])), m1 = fmaxf(fmaxf(a[4], a[5]), fmaxf(a[6], a[7])), m2 = fmaxf(fmaxf(a[8], a[9]), fmaxf(a[10], a[11])), m3 = fmaxf(fmaxf(a[12], a[13]), fmaxf(a[14], a[15]));
    return fmaxf(fmaxf(m0, m1), fmaxf(m2, m3));
}
__device__ __forceinline__ float sum16(const f32x16& a) {
    return ((a[0] + a[1]) + (a[2] + a[3])) + ((a[4] + a[5]) + (a[6] + a[7])) + (((a[8] + a[9]) + (a[10] + a[11])) + ((a[12] + a[13]) + (a[14] + a[15])));
}
__device__ __forceinline__ float xmax32(float v) { const auto rr = __builtin_amdgcn_permlane32_swap(__float_as_uint(v), __float_as_uint(v), false, false); return fmaxf(__uint_as_float(rr[0]), __uint_as_float(rr[1])); }
__device__ __forceinline__ float xsum32(float v) { const auto rr = __builtin_amdgcn_permlane32_swap(__float_as_uint(v), __float_as_uint(v), false, false); return __uint_as_float(rr[0]) + __uint_as_float(rr[1]); }
__device__ __forceinline__ void attn_softmax_pv(LAS const unsigned char* vb, const AttnLane& L, f32x16& t0, f32x16& t1, float& m, float& lh, f32x16 (&o)[2]) {
    const float tm = xmax32(fmaxf(max16(t0), max16(t1)));
    if (__any(tm > m + 8.0f)) {
        const float mn = fmaxf(m, tm), mu0 = (mn == -INFINITY) ? 0.f : mn;
        const float alpha = __builtin_amdgcn_exp2f(m - mu0);
#pragma unroll
        for (int r = 0; r < 16; ++r) { o[0][r] *= alpha; o[1][r] *= alpha; }
        lh *= alpha; m = mn;
    }
    const float mu = (m == -INFINITY) ? 0.f : m;
#pragma unroll
    for (int r = 0; r < 16; ++r) { t0[r] = __builtin_amdgcn_exp2f(t0[r] - mu); t1[r] = __builtin_amdgcn_exp2f(t1[r] - mu); }
    lh += sum16(t0) + sum16(t1);
    attn_pv(vb, 0, L, t0, o); attn_pv(vb, 1, L, t1, o);
}
__device__ __forceinline__ void attn_softmax_pv2(LAS const unsigned char* vbA, LAS const unsigned char* vbB, const AttnLane& L, f32x16& a0, f32x16& a1, f32x16& b0, f32x16& b1, float& m, float& lh, f32x16 (&o)[2]) {
    const float tm = xmax32(fmaxf(fmaxf(max16(a0), max16(a1)), fmaxf(max16(b0), max16(b1))));
    if (__any(tm > m + 8.0f)) {
        const float mn = fmaxf(m, tm), mu0 = (mn == -INFINITY) ? 0.f : mn;
        const float alpha = __builtin_amdgcn_exp2f(m - mu0);
#pragma unroll
        for (int r = 0; r < 16; ++r) { o[0][r] *= alpha; o[1][r] *= alpha; }
        lh *= alpha; m = mn;
    }
    const float mu = (m == -INFINITY) ? 0.f : m;
#pragma unroll
    for (int r = 0; r < 16; ++r) { a0[r] = __builtin_amdgcn_exp2f(a0[r] - mu); a1[r] = __builtin_amdgcn_exp2f(a1[r] - mu); }
    attn_pv(vbA, 0, L, a0, o); attn_pv(vbA, 1, L, a1, o);
#pragma unroll
    for (int r = 0; r < 16; ++r) { b0[r] = __builtin_amdgcn_exp2f(b0[r] - mu); b1[r] = __builtin_amdgcn_exp2f(b1[r] - mu); }
    lh += (sum16(a0) + sum16(a1)) + (sum16(b0) + sum16(b1));
    attn_pv(vbB, 0, L, b0, o); attn_pv(vbB, 1, L, b1, o);
}
#define KEYIDX(hf, reg, h) (32 * (hf) + ((reg) & 3) + 8 * ((reg) >> 2) + 4 * (h))
__device__ __forceinline__ void score_far(f32x16& t0, f32x16& t1, float cb) {
#pragma unroll
    for (int r = 0; r < 16; ++r) { t0[r] = fmaf(t0[r], LOG2E, cb); t1[r] = fmaf(t1[r], LOG2E, cb); }
}
__device__ __forceinline__ void score_near1(f32x16& t, int hf, int h, LAS const float* lut, int hd, int dbase, int dstep, int dmax, int klim, bool colok) {
#pragma unroll
    for (int r = 0; r < 16; ++r) {
        const int ki = KEYIDX(hf, r, h); const int dist = dbase - dstep * ki; const int di = dist < 0 ? 0 : (dist > 127 ? 127 : dist); const float bv = lut[di * 8 + hd];
        const bool ok = colok && dist >= 0 && dist < dmax && ki < klim; const float v = fmaf(t[r], LOG2E, bv); t[r] = ok ? v : -INFINITY; }
}
__device__ __forceinline__ void score_near(f32x16& t0, f32x16& t1, int h, LAS const float* lut, int hd, int dbase, int dstep, int dmax, int klim, bool colok) {
    score_near1(t0, 0, h, lut, hd, dbase, dstep, dmax, klim, colok);
    __builtin_amdgcn_sched_barrier(0);
    score_near1(t1, 1, h, lut, hd, dbase, dstep, dmax, klim, colok);
    __builtin_amdgcn_sched_barrier(0);
}

__device__ __forceinline__ void win_unit(const Frame& F, const Args& A, LAS unsigned char* sh, int b, int g, int qb) {
    const bf16* PROJ = (const bf16*)(A.ws + WS_PROJ);
    const int lane = hw_lane(), w = F.wave, tid = w * 64 + lane;
    const AttnLane L = attn_lane(lane);
    const int tq = 64 * qb + 8 * w + (L.r32 >> 2), hd = g * 4 + (L.r32 & 3);
    const size_t tokq = (size_t)b * SEQ + tq;
    bf16x8 qf[4];
#pragma unroll
    for (int ks = 0; ks < 4; ++ks) qf[ks] = *(const bf16x8*)(PROJ + tokq * NPROJ + C_QN + hd * 64 + 16 * ks + 8 * L.h);
    LAS const float* lut = (LAS const float*)(sh + AT_LUT);
    const float bfar = lut[127 * 8 + hd];
    const int kt0 = qb >= 8 ? qb - 8 : 0, nt = qb - kt0 + 1;
    const int srow = tid >> 3, sch = tid & 7;
    const bf16* ksrc = PROJ + ((size_t)b * SEQ + srow) * NPROJ + C_WIN + g * 64 + sch * 8;
    v4u kr, vr;
#define WIN_LOAD(i) do { kr = *(const v4u*)(ksrc + (size_t)(64 * (kt0 + (i))) * NPROJ); vr = *(const v4u*)(ksrc + (size_t)(64 * (kt0 + (i))) * NPROJ + 128); } while (0)
#define WIN_SCORE(T0, T1, kt) do { if ((kt) <= qb - 3 && (kt) >= qb - 7) score_far(T0, T1, bfar); else score_near(T0, T1, L.h, lut, hd, tq - 64 * (kt), 1, 512, 64, true); } while (0)
    WIN_LOAD(0);
    __syncthreads();
    attn_commit(sh, sh + 8192, tid, kr, vr);
    if (nt > 1) { WIN_LOAD(1); attn_commit(sh + 16384, sh + 16384 + 8192, tid, kr, vr); }
    __syncthreads();
    float m = -INFINITY, l = 0.f; f32x16 o[2]; o[0] = f32x16{}; o[1] = f32x16{};
    f32x16 c0 = attn_qk(sh, 0, L, qf), c1 = attn_qk(sh, 1, L, qf), n0, n1;
    WIN_SCORE(c0, c1, kt0);
    int s_cur = 0, s_nxt = 16384, s_fill = 32768;
#define WIN_STEP(i, C0, C1, N0, N1) do { \
        if ((i) + 2 < nt) WIN_LOAD((i) + 2); \
        if ((i) + 1 < nt) { N0 = attn_qk(sh + s_nxt, 0, L, qf); N1 = attn_qk(sh + s_nxt, 1, L, qf); } \
        attn_softmax_pv(sh + s_cur + 8192, L, C0, C1, m, l, o); \
        if ((i) + 1 < nt) WIN_SCORE(N0, N1, kt0 + (i) + 1); \
        if ((i) + 2 < nt) attn_commit(sh + s_fill, sh + s_fill + 8192, tid, kr, vr); \
        __syncthreads(); \
        { const int t_ = s_cur; s_cur = s_nxt; s_nxt = s_fill; s_fill = t_; } } while (0)
#pragma unroll 1
    for (int i = 0; i < nt; i += 2) {
        WIN_STEP(i, c0, c1, n0, n1);
        if (i + 1 < nt) WIN_STEP(i + 1, n0, n1, c0, c1);
    }
#undef WIN_STEP
#undef WIN_LOAD
#undef WIN_SCORE
    const float rl = __builtin_amdgcn_rcpf(xsum32(l));
    bf16* dst = (bf16*)(A.ws + WS_OWIN) + tokq * 512 + hd * 64;
#pragma unroll
    for (int dt = 0; dt < 2; ++dt)
#pragma unroll
        for (int rq = 0; rq < 4; ++rq) { v2u wv; wv.x = cvtpk(o[dt][4 * rq] * rl, o[dt][4 * rq + 1] * rl); wv.y = cvtpk(o[dt][4 * rq + 2] * rl, o[dt][4 * rq + 3] * rl);
            *(v2u*)(dst + 32 * dt + 8 * rq + 4 * L.h) = wv; }
}

__device__ __forceinline__ void nsa_unit(const Frame& F, const Args& A, LAS unsigned char* sh, int b, int g, int qb) {
    const bf16* PROJ = (const bf16*)(A.ws + WS_PROJ);
    const int lane = hw_lane(), w = F.wave, tid = w * 64 + lane;
    const AttnLane L = attn_lane(lane);
    const int qloc = 8 * w + (L.r32 >> 2);
    const int tq = 64 * qb + qloc, hd = g * 4 + (L.r32 & 3);
    const size_t tokq = (size_t)b * SEQ + tq;
    bf16x8 qf[4];
#pragma unroll
    for (int ks = 0; ks < 4; ++ks) qf[ks] = *(const bf16x8*)(PROJ + tokq * NPROJ + C_QN + hd * 64 + 16 * ks + 8 * L.h);
#define NSA_LOADQ() do {} while (0)
    LAS const float* lut = (LAS const float*)(sh + AT_LUT);
    const float bfar = lut[127 * 8 + hd];
    LAS float* impA = (LAS float*)(sh + AT_IMPA); LAS float* impB = (LAS float*)(sh + AT_IMPB);
    LAS unsigned long long* selm = (LAS unsigned long long*)(sh + AT_SEL);
    const int srow = tid >> 3, sch = tid & 7;
    v4u kr, vr;
    const int nct = (4 * qb + 3 + 63) >> 6;
    const bf16* kcs = (const bf16*)(A.ws + WS_KCP) + ((size_t)(b * 256 + srow) * 2 + g) * 64 + sch * 8;
    const bf16* vcs = (const bf16*)(A.ws + WS_VCP) + ((size_t)(b * 256 + srow) * 2 + g) * 64 + sch * 8;
    __syncthreads();
    for (int e = tid; e < 64 * 65; e += NWAVES * 64) { impA[e] = 0.f; impB[e] = 0.f; }
    float mc = -INFINITY, lc = 0.f;
#pragma unroll 1
    for (int pass = 0; pass < 2; ++pass) {
        kr = *(const v4u*)(kcs); vr = *(const v4u*)(vcs);
        __syncthreads();
        attn_commit(sh + AT_K0, sh + AT_V0, tid, kr, vr);
        __syncthreads();
        const float mu = (mc == -INFINITY) ? 0.f : mc, il = lc > 0.f ? __builtin_amdgcn_rcpf(lc) : 0.f;
#pragma unroll 1
        for (int ct = 0; ct < nct; ++ct) {
            const int buf = ct & 1;
            if (ct + 1 < nct) { kr = *(const v4u*)(kcs + (size_t)(64 * (ct + 1)) * 128); vr = *(const v4u*)(vcs + (size_t)(64 * (ct + 1)) * 128); }
            LAS const unsigned char* kb = sh + AT_K0 + buf * 8192; LAS const unsigned char* vb = sh + AT_V0 + buf * 8192;
            NSA_LOADQ();
            f32x16 t0 = attn_qk(kb, 0, L, qf), t1 = attn_qk(kb, 1, L, qf);
            score_near(t0, t1, L.h, lut, hd, tq - 31 - 1024 * ct, 16, 1 << 30, 255 - 64 * ct, true);
            if (pass == 0) {
                const float tm = xmax32(fmaxf(max16(t0), max16(t1)));
                const float mn = fmaxf(mc, tm), mu0 = (mn == -INFINITY) ? 0.f : mn;
                const float alpha = __builtin_amdgcn_exp2f(mc - mu0);
                float ps = 0.f;
#pragma unroll
                for (int r = 0; r < 16; ++r) ps += __builtin_amdgcn_exp2f(t0[r] - mu0) + __builtin_amdgcn_exp2f(t1[r] - mu0);
                ps = xsum32(ps);
                lc = lc * alpha + ps; mc = mn;
            } else {
#pragma unroll
                for (int r = 0; r < 16; ++r) { t0[r] = __builtin_amdgcn_exp2f(t0[r] - mu) * il; t1[r] = __builtin_amdgcn_exp2f(t1[r] - mu) * il; }
#pragma unroll
                for (int hf = 0; hf < 2; ++hf) {
                    float x[16];
#pragma unroll
                    for (int r = 0; r < 16; ++r) { float v = hf ? t1[r] : t0[r]; v += __shfl_xor(v, 1); v += __shfl_xor(v, 2); x[r] = v; }
                    if ((L.r32 & 3) == 0) {
#pragma unroll
                        for (int rq = 0; rq < 4; ++rq) { const int jq = 16 * ct + 8 * hf + 2 * rq + L.h;
                            impA[qloc * 65 + jq] = 2.0f * (x[4 * rq] + x[4 * rq + 1] + x[4 * rq + 2]) + x[4 * rq + 3];
                            impB[qloc * 65 + jq + 1] = x[4 * rq + 3]; }
                    }
                }
            }
            if (ct + 1 < nct) attn_commit(sh + AT_K0 + (buf ^ 1) * 8192, sh + AT_V0 + (buf ^ 1) * 8192, tid, kr, vr);
            __syncthreads();
        }
    }
#pragma unroll 1
    for (int qi = 0; qi < 8; ++qi) {
        const int q = 8 * w + qi;
        unsigned long long mk;
        if (qb < 16) mk = (2ull << qb) - 1ull;
        else {
            const bool forced = (lane == 0) || (lane == qb) || (lane == qb - 1);
            const float sc = forced ? 1e9f : (lane <= qb ? impA[q * 65 + lane] + impB[q * 65 + lane] : -1.0f);
            int rank = 0;
#pragma unroll 8
            for (int jj = 0; jj < 64; ++jj) { const float ov = __uint_as_float(__builtin_amdgcn_readlane(__float_as_uint(sc), jj)); rank += ((ov > sc) || (ov == sc && jj < lane)) ? 1 : 0; }
            mk = __ballot(rank < 16 && lane <= qb);
        }
        if (lane == 0) selm[q] = mk;
    }
    __syncthreads();
    const unsigned long long mysel = selm[qloc];
    unsigned long long um = 0ull;
#pragma unroll 8
    for (int q_ = 0; q_ < 64; ++q_) um |= selm[q_];
    um = ((unsigned long long)__builtin_amdgcn_readfirstlane((unsigned)(um >> 32)) << 32) | (unsigned long long)__builtin_amdgcn_readfirstlane((unsigned)um);
    const bf16* ksrc = PROJ + ((size_t)b * SEQ + srow) * NPROJ + C_KV + 2 * 128 + g * 64 + sch * 8;
    float m = -INFINITY, l = 0.f; f32x16 o[2]; o[0] = f32x16{}; o[1] = f32x16{};
    v4u krb, vrb;
    int ja, jb;
#define SLC_NEXT(JA, JB) do { JA = um ? __builtin_ctzll(um) : -1; um &= um - 1; JB = um ? __builtin_ctzll(um) : -1; um &= um - 1; } while (0)
#define SLC_LOAD(JA, JB) do { const int jb_ = (JB) >= 0 ? (JB) : (JA); \
        kr = *(const v4u*)(ksrc + (size_t)(64 * (JA)) * NPROJ); vr = *(const v4u*)(ksrc + (size_t)(64 * (JA)) * NPROJ + 128); \
        krb = *(const v4u*)(ksrc + (size_t)(64 * jb_) * NPROJ); vrb = *(const v4u*)(ksrc + (size_t)(64 * jb_) * NPROJ + 128); } while (0)
#define SLC_COMMIT(buf) do { attn_commit(sh + (buf) * AT_ST, sh + (buf) * AT_ST + 8192, tid, kr, vr); attn_commit(sh + (buf) * AT_ST + 16384, sh + (buf) * AT_ST + 24576, tid, krb, vrb); } while (0)
    SLC_NEXT(ja, jb);
    SLC_LOAD(ja, jb);
    SLC_COMMIT(0);
    __syncthreads();
    int buf = 0;
#pragma unroll 1
    for (;;) {
        int na, nb; SLC_NEXT(na, nb);
        if (na >= 0) SLC_LOAD(na, nb);
        LAS const unsigned char* sb = sh + buf * AT_ST;
        const bool sela = (mysel >> ja) & 1ull, selb = jb >= 0 && ((mysel >> jb) & 1ull);
        if (__any(sela || selb)) {
            f32x16 a0 = attn_qk(sb, 0, L, qf), a1 = attn_qk(sb, 1, L, qf), b0 = attn_qk(sb + 16384, 0, L, qf), b1 = attn_qk(sb + 16384, 1, L, qf);
            if (ja <= qb - 3) score_far(a0, a1, sela ? bfar : -INFINITY); else score_near(a0, a1, L.h, lut, hd, tq - 64 * ja, 1, 1 << 30, 64, sela);
            if (jb <= qb - 3) score_far(b0, b1, selb ? bfar : -INFINITY); else score_near(b0, b1, L.h, lut, hd, tq - 64 * jb, 1, 1 << 30, 64, selb);
            attn_softmax_pv2(sb + 8192, sb + 24576, L, a0, a1, b0, b1, m, l, o);
        }
        if (na >= 0) SLC_COMMIT(buf ^ 1);
        __syncthreads();
        if (na < 0) break;
        ja = na; jb = nb; buf ^= 1;
    }
#undef SLC_NEXT
#undef SLC_LOAD
#undef SLC_COMMIT
    const bf16* gp = PROJ + tokq * NPROJ + C_GT + hd;
    const float g0 = __builtin_amdgcn_rcpf(1.0f + __expf(-bf2f(gp[0]))), g1 = __builtin_amdgcn_rcpf(1.0f + __expf(-bf2f(gp[8]))), g2 = __builtin_amdgcn_rcpf(1.0f + __expf(-bf2f(gp[16])));
    const float rl = g1 * __builtin_amdgcn_rcpf(xsum32(l));
    const bf16* ow = (const bf16*)(A.ws + WS_OWIN) + tokq * 512 + hd * 64;
#pragma unroll
    for (int dt = 0; dt < 2; ++dt)
#pragma unroll
        for (int rq = 0; rq < 4; ++rq) { const int d0 = 32 * dt + 8 * rq + 4 * L.h; const v2u wv = *(const v2u*)(ow + d0);
            o[dt][4 * rq] = rl * o[dt][4 * rq] + g2 * bflo(wv.x); o[dt][4 * rq + 1] = rl * o[dt][4 * rq + 1] + g2 * bfhi(wv.x);
            o[dt][4 * rq + 2] = rl * o[dt][4 * rq + 2] + g2 * bflo(wv.y); o[dt][4 * rq + 3] = rl * o[dt][4 * rq + 3] + g2 * bfhi(wv.y); }
    {
        const float mu = (mc == -INFINITY) ? 0.f : mc, il = lc > 0.f ? g0 * __builtin_amdgcn_rcpf(lc) : 0.f;
        kr = *(const v4u*)(kcs); vr = *(const v4u*)(vcs);
        attn_commit(sh + AT_K0, sh + AT_V0, tid, kr, vr);
        __syncthreads();
#pragma unroll 1
        for (int ct = 0; ct < nct; ++ct) {
            const int cbuf = ct & 1;
            if (ct + 1 < nct) { kr = *(const v4u*)(kcs + (size_t)(64 * (ct + 1)) * 128); vr = *(const v4u*)(vcs + (size_t)(64 * (ct + 1)) * 128); }
            LAS const unsigned char* kb = sh + AT_K0 + cbuf * 8192; LAS const unsigned char* vb = sh + AT_V0 + cbuf * 8192;
            NSA_LOADQ();
            f32x16 t0 = attn_qk(kb, 0, L, qf), t1 = attn_qk(kb, 1, L, qf);
            score_near(t0, t1, L.h, lut, hd, tq - 31 - 1024 * ct, 16, 1 << 30, 255 - 64 * ct, true);
#pragma unroll
            for (int r = 0; r < 16; ++r) { t0[r] = __builtin_amdgcn_exp2f(t0[r] - mu) * il; t1[r] = __builtin_amdgcn_exp2f(t1[r] - mu) * il; }
            attn_pv(vb, 0, L, t0, o); attn_pv(vb, 1, L, t1, o);
            if (ct + 1 < nct) attn_commit(sh + AT_K0 + (cbuf ^ 1) * 8192, sh + AT_V0 + (cbuf ^ 1) * 8192, tid, kr, vr);
            __syncthreads();
        }
    }
    bf16* dst = (bf16*)(A.ws + WS_MIX) + tokq * 1024 + hd * 64;
#pragma unroll
    for (int dt = 0; dt < 2; ++dt)
#pragma unroll
        for (int rq = 0; rq < 4; ++rq) { v2u ov; ov.x = cvtpk(o[dt][4 * rq], o[dt][4 * rq + 1]); ov.y = cvtpk(o[dt][4 * rq + 2], o[dt][4 * rq + 3]); *(v2u*)(dst + 32 * dt + 8 * rq + 4 * L.h) = ov; }
}
#undef NSA_LOADQ

__device__ __forceinline__ v4u pack_f32x8(const float* p) { const f32x4 a = *(const f32x4*)p, b = *(const f32x4*)(p + 4); v4u w; w.x = pk2(a.x, a.y); w.y = pk2(a.z, a.w); w.z = pk2(b.x, b.y); w.w = pk2(b.z, b.w); return w; }
__device__ __forceinline__ void samp_load(const Args& A, int mode, int tile, int b, int g, int srow, int sch, v4u& kr, v4u& vr) {
    const bf16* PROJ = (const bf16*)(A.ws + WS_PROJ);
    kr = (v4u){0, 0, 0, 0}; vr = (v4u){0, 0, 0, 0};
    if (mode == 0) {
        const size_t off = ((size_t)(b * 512 + 64 * tile + srow) * 2 + g) * 64 + sch * 8;
        kr = *(const v4u*)((const bf16*)(A.ws + WS_KCS) + off); vr = *(const v4u*)((const bf16*)(A.ws + WS_VCS) + off);
    } else if (mode == 1) {
        if (tile < 128) { const int page = ((const int*)A.in[5])[b * 64 + (tile >> 1)]; const int row = (tile & 1) * 64 + srow;
            const float* p = A.in[2] + ((size_t)(page * 128 + row) * 4 + 2) * 128 + g * 64 + sch * 8; kr = pack_f32x8(p); vr = pack_f32x8(p + 128); }
        else if (srow < 4) { const bf16* p = PROJ + (size_t)(TP + b * 4 + srow) * NPROJ + C_KV + 2 * 128 + g * 64 + sch * 8; kr = *(const v4u*)p; vr = *(const v4u*)(p + 128); }
    } else {
        const int idx = 64 * tile + srow;
        if (idx < 512) { const float* p = A.in[3] + ((size_t)(b * 512 + idx) * 2) * 128 + g * 64 + sch * 8; kr = pack_f32x8(p); vr = pack_f32x8(p + 128); }
        else if (idx < 516) { const bf16* p = PROJ + (size_t)(TP + b * 4 + idx - 512) * NPROJ + C_WIN + g * 64 + sch * 8; kr = *(const v4u*)p; vr = *(const v4u*)(p + 128); }
    }
}
__device__ __forceinline__ void samp_stage_tile(const Args& A, int mode, int tile, int b, int g, int lane, LAS unsigned char* kb, LAS unsigned char* vb) {
#pragma unroll 1
    for (int i0 = 0; i0 < 8; i0 += 2) {
        v4u kr[2], vr[2];
#pragma unroll
        for (int i = 0; i < 2; ++i) samp_load(A, mode, tile, b, g, (lane >> 3) + 8 * (i0 + i), lane & 7, kr[i], vr[i]);
#pragma unroll
        for (int i = 0; i < 2; ++i) { const int row = (lane >> 3) + 8 * (i0 + i), ch = lane & 7;
            *(LAS v4u*)(kb + row * 128 + ((ch ^ ((row >> 1) & 7)) << 4)) = kr[i];
            *(LAS v4u*)(vb + row * 128 + ((ch ^ (((row >> 1) & 1) << 2)) << 4)) = vr[i]; }
    }
}
__device__ __forceinline__ void samp_unit(const Frame& F, const Args& A, LAS unsigned char* sh, int b, int g) {
    const bf16* PROJ = (const bf16*)(A.ws + WS_PROJ);
    const int lane = hw_lane(), w = F.wave, tid = w * 64 + lane;
    const AttnLane L = attn_lane(lane);
    const bool colok = L.r32 < 16;
    const int qi = (L.r32 >> 2) & 3, hd = g * 4 + (L.r32 & 3);
    const int pos = PAST + qi;
    const size_t tokq = (size_t)TP + b * 4 + qi;
    LAS unsigned char* kb = sh + w * 16384; LAS unsigned char* vb = kb + 8192;
    LAS float* lut = (LAS float*)(sh + AT_LUT);
    LAS float* impA = (LAS float*)(sh + HI_IMPA); LAS float* impB = (LAS float*)(sh + HI_IMPB);
    LAS unsigned long long* selm = (LAS unsigned long long*)(sh + HI_SEL);
    LAS float* scs = (LAS float*)(sh + HI_SCS);
    LAS int* tlist = (LAS int*)(sh + HI_TL);
    LAS float* xch = (LAS float*)(sh + HI_XCH);
    bf16x8 qf[4];
#pragma unroll
    for (int ks = 0; ks < 4; ++ks) qf[ks] = *(const bf16x8*)(PROJ + tokq * NPROJ + C_QN + hd * 64 + 16 * ks + 8 * L.h);
    const float bfar = lut[127 * 8 + hd];
    __syncthreads();
    for (int e = tid; e < 4 * 132; e += NWAVES * 64) { impA[e] = 0.f; impB[e] = 0.f; }
    f32x16 oc[2]; oc[0] = f32x16{}; oc[1] = f32x16{};
    {
        samp_stage_tile(A, 0, w, b, g, lane, kb, vb);
        f32x16 t0 = attn_qk(kb, 0, L, qf), t1 = attn_qk(kb, 1, L, qf);
        score_near(t0, t1, L.h, lut, hd, pos - 31 - 1024 * w, 16, 1 << 30, 511 - 64 * w, colok);
        const float tm = xmax32(fmaxf(max16(t0), max16(t1)));
        xch[(w * 64 + lane) * 4] = tm;
        __syncthreads();
        float M = -INFINITY;
#pragma unroll
        for (int ww = 0; ww < 8; ++ww) M = fmaxf(M, xch[(ww * 64 + lane) * 4]);
        const float mu = (M == -INFINITY) ? 0.f : M;
#pragma unroll
        for (int r = 0; r < 16; ++r) { t0[r] = __builtin_amdgcn_exp2f(t0[r] - mu); t1[r] = __builtin_amdgcn_exp2f(t1[r] - mu); }
        const float ps = xsum32(sum16(t0) + sum16(t1));
        xch[(w * 64 + lane) * 4 + 1] = ps;
        __syncthreads();
        float Lc = 0.f;
#pragma unroll
        for (int ww = 0; ww < 8; ++ww) Lc += xch[(ww * 64 + lane) * 4 + 1];
        const float il = Lc > 0.f ? __builtin_amdgcn_rcpf(Lc) : 0.f;
#pragma unroll
        for (int r = 0; r < 16; ++r) { t0[r] *= il; t1[r] *= il; }
        attn_pv(vb, 0, L, t0, oc); attn_pv(vb, 1, L, t1, oc);
#pragma unroll
        for (int hf = 0; hf < 2; ++hf) {
            float x[16];
#pragma unroll
            for (int r = 0; r < 16; ++r) { float v = hf ? t1[r] : t0[r]; v += __shfl_xor(v, 1); v += __shfl_xor(v, 2); x[r] = v; }
            if ((L.r32 & 3) == 0 && colok) {
#pragma unroll
                for (int rq = 0; rq < 4; ++rq) { const int jq = 16 * w + 8 * hf + 2 * rq + L.h;
                    impA[qi * 132 + jq] = 2.0f * (x[4 * rq] + x[4 * rq + 1] + x[4 * rq + 2]) + x[4 * rq + 3];
                    impB[qi * 132 + jq + 1] = x[4 * rq + 3]; }
            }
        }
    }
    __syncthreads();
    if (w == 0) {
        unsigned long long ulo = 0ull, uhi = 0ull;
#pragma unroll 1
        for (int q = 0; q < 4; ++q) {
            const int j0 = lane, j1 = lane + 64;
            const float s0 = (j0 == 0) ? 1e9f : impA[q * 132 + j0] + impB[q * 132 + j0];
            const float s1 = (j1 == 127) ? 1e9f : impA[q * 132 + j1] + impB[q * 132 + j1];
            scs[j0] = s0; scs[j1] = s1;
            LDS_WAIT(); asm volatile("" ::: "memory");
            int r0 = 0, r1 = 0;
#pragma unroll 8
            for (int jj = 0; jj < 128; ++jj) { const float ov = scs[jj]; r0 += ((ov > s0) || (ov == s0 && jj < j0)) ? 1 : 0; r1 += ((ov > s1) || (ov == s1 && jj < j1)) ? 1 : 0; }
            const unsigned long long mlo = __ballot(r0 < 15), mhi = __ballot(r1 < 15);
            if (lane == 0) { selm[2 * q] = mlo; selm[2 * q + 1] = mhi; }
            ulo |= mlo; uhi |= mhi;
            LDS_WAIT(); asm volatile("" ::: "memory");
        }
        if (lane == 0) { int n = 0; for (int j = 0; j < 64; ++j) if ((ulo >> j) & 1ull) tlist[1 + n++] = j; for (int j = 0; j < 64; ++j) if ((uhi >> j) & 1ull) tlist[1 + n++] = 64 + j; tlist[1 + n++] = 128; tlist[0] = n; }
    }
    __syncthreads();
    const unsigned long long mylo = selm[2 * qi], myhi = selm[2 * qi + 1];
    const int nsel = tlist[0];
    const bf16* gp = PROJ + tokq * NPROJ + C_GT + hd;
    const float g0 = __builtin_amdgcn_rcpf(1.0f + __expf(-bf2f(gp[0]))), g1 = __builtin_amdgcn_rcpf(1.0f + __expf(-bf2f(gp[8]))), g2 = __builtin_amdgcn_rcpf(1.0f + __expf(-bf2f(gp[16])));
#pragma unroll
    for (int r = 0; r < 16; ++r) { oc[0][r] *= g0; oc[1][r] *= g0; }
#pragma unroll 1
    for (int br = 0; br < 2; ++br) {
        const int nt = br == 0 ? nsel : 9;
        float m = -INFINITY, l = 0.f; f32x16 o[2]; o[0] = f32x16{}; o[1] = f32x16{};
#pragma unroll 1
        for (int it = w; it < nt; it += 8) {
            const int j = br == 0 ? tlist[1 + it] : it;
            samp_stage_tile(A, 1 + br, j, b, g, lane, kb, vb);
            f32x16 t0 = attn_qk(kb, 0, L, qf), t1 = attn_qk(kb, 1, L, qf);
            if (br == 0) {
                const bool selj = colok && (j >= 128 ? true : (j < 64 ? ((mylo >> j) & 1ull) : ((myhi >> (j - 64)) & 1ull)));
                if (j <= 125) score_far(t0, t1, selj ? bfar : -INFINITY);
                else score_near(t0, t1, L.h, lut, hd, pos - 64 * j, 1, 1 << 30, 64, selj);
            } else score_near(t0, t1, L.h, lut, hd, pos - (PAST - 512 + 64 * j), 1, 512, 516 - 64 * j, colok);
            attn_softmax_pv(vb, L, t0, t1, m, l, o);
        }
        l = xsum32(l);
        xch[(w * 64 + lane) * 4 + 2] = m; xch[(w * 64 + lane) * 4 + 3] = l;
        __syncthreads();
        float M = -INFINITY;
#pragma unroll
        for (int ww = 0; ww < 8; ++ww) M = fmaxf(M, xch[(ww * 64 + lane) * 4 + 2]);
        float Lt = 0.f;
#pragma unroll
        for (int ww = 0; ww < 8; ++ww) { const float mw = xch[(ww * 64 + lane) * 4 + 2]; Lt += (mw == -INFINITY) ? 0.f : xch[(ww * 64 + lane) * 4 + 3] * __builtin_amdgcn_exp2f(mw - M); }
        const float sc = (m == -INFINITY || !(Lt > 0.f)) ? 0.f : (br == 0 ? g1 : g2) * __builtin_amdgcn_exp2f(m - M) * __builtin_amdgcn_rcpf(Lt);
#pragma unroll
        for (int r = 0; r < 16; ++r) { oc[0][r] += sc * o[0][r]; oc[1][r] += sc * o[1][r]; }
        __syncthreads();
    }
    { LAS float* part = (LAS float*)kb;
#pragma unroll
      for (int r = 0; r < 16; ++r) { part[r * 64 + lane] = oc[0][r]; part[(16 + r) * 64 + lane] = oc[1][r]; } }
    __syncthreads();
    if (w == 0 && colok) {
        float res[32];
#pragma unroll
        for (int r = 0; r < 32; ++r) { float a = 0.f;
#pragma unroll
            for (int ww = 0; ww < 8; ++ww) a += ((LAS const float*)(sh + ww * 16384))[r * 64 + lane];
            res[r] = a; }
        bf16* dst = (bf16*)(A.ws + WS_MIX) + tokq * 1024 + hd * 64;
#pragma unroll
        for (int dt = 0; dt < 2; ++dt)
#pragma unroll
            for (int rq = 0; rq < 4; ++rq) { const int d0 = 32 * dt + 8 * rq + 4 * L.h;
                v2u ov; ov.x = cvtpk(res[16 * dt + 4 * rq], res[16 * dt + 4 * rq + 1]); ov.y = cvtpk(res[16 * dt + 4 * rq + 2], res[16 * dt + 4 * rq + 3]); *(v2u*)(dst + d0) = ov; }
    }
}

__device__ __forceinline__ float gelu_tanh(float x) { const float u = 0.7978845608028654f * (x + 0.044715f * x * x * x); const float t = 1.0f - 2.0f / (1.0f + __expf(2.0f * u)); return 0.5f * x * (1.0f + t); }
constexpr int CM_X = 0, CM_SB = 2064  , CM_H = 32 * CM_SB + 1024, CM_HCOL = 272  , CM_HT = 32 * CM_HCOL, CM_END = CM_H + 4 * CM_HT;
constexpr int NCU_P = 4 * 2 * 2 * 9, NCU_S = 32 * 2 * 2 * 17;
__device__ __forceinline__ int cmp_decode(int u) { if (u < NCU_S) return (1 << 20) | ((u / 68) << 12) | (((u / 34) & 1) << 9) | (((u / 17) & 1) << 8) | (u % 17); const int j = u - NCU_S; return ((j / 36) << 12) | (((j / 18) & 1) << 9) | (((j / 9) & 1) << 8) | (j % 9); }
#define CU_SAMPLE(c) ((c) >> 20)
#define CU_B(c) (((c) >> 12) & 255)
#define CU_SLOT(c) (((c) >> 9) & 1)
#define CU_G(c) (((c) >> 8) & 1)
#define CU_GRP(c) ((c) & 255)
__device__ __forceinline__ void cmp_issue(const Args& A, const int c, int tid, v4u (&R)[16]) {
    if (CU_SAMPLE(c)) {
        const float* cache = A.in[2]; const int* pt = (const int*)A.in[5] + CU_B(c) * 64;
#pragma unroll
        for (int i = 0; i < 16; ++i) { const int q = tid + 512 * i, row = q >> 4, pc = q & 15; int p = 16 * 31 * CU_GRP(c) + row; p = p < PAST ? p : PAST - 1;
            const int page = pt[p >> 7];
            R[i] = *(const v4u*)(cache + ((size_t)(page * 128 + (p & 127)) * 4 + CU_SLOT(c)) * 128 + CU_G(c) * 64 + pc * 4); }
    } else {
        const bf16* PROJ = (const bf16*)(A.ws + WS_PROJ);
#pragma unroll
        for (int i = 0; i < 8; ++i) { const int q = tid + 512 * i, row = q >> 3, pc = q & 7; int p = 16 * 31 * CU_GRP(c) + row; p = p < SEQ ? p : SEQ - 1;
            R[i] = *(const v4u*)(PROJ + ((size_t)CU_B(c) * SEQ + p) * NPROJ + C_KV + CU_SLOT(c) * 128 + CU_G(c) * 64 + pc * 8); }
#pragma unroll
        for (int i = 8; i < 16; ++i) R[i] = (v4u){0u, 0u, 0u, 0u};
    }
}
__device__ __forceinline__ void cmp_commit(LAS unsigned char* sh, const int c, int tid, const v4u (&R)[16]) {
    if (CU_SAMPLE(c)) {
#pragma unroll
        for (int i = 0; i < 16; ++i) { const int q = tid + 512 * i, row = q >> 4, pc = q & 15;
            v2u w; w.x = pk2(__uint_as_float(R[i].x), __uint_as_float(R[i].y)); w.y = pk2(__uint_as_float(R[i].z), __uint_as_float(R[i].w));
            *(LAS v2u*)(sh + CM_X + (row >> 4) * CM_SB + (row & 15) * 128 + pc * 8) = w; }
    } else {
#pragma unroll
        for (int i = 0; i < 8; ++i) { const int q = tid + 512 * i, row = q >> 3, pc = q & 7; *(LAS v4u*)(sh + CM_X + (row >> 4) * CM_SB + (row & 15) * 128 + pc * 16) = R[i]; }
    }
}
__device__ __forceinline__ void cmp_phase(const Frame& F, const Args& A, LAS unsigned char* sh) {
    const int lane = hw_lane(), w = F.wave, tid = w * 64 + lane, r32 = lane & 31, h = lane >> 5;
    const int j = w & 1, ht = (w >> 1) & 1, kh = w >> 2;
    v4u R[16];
    int u = F.vcu;
    if (u >= NCU_S + NCU_P) return;
    int cu = cmp_decode(u);
    cmp_issue(A, cu, tid, R);
    for (;;) {
        __syncthreads();
        cmp_commit(sh, cu, tid, R);
        __syncthreads();
        const int cur = cu;
        const int un = u + F.G; const bool more = un < NCU_S + NCU_P;
        cu = cmp_decode(more ? un : u); cmp_issue(A, cu, tid, R);
        { const bf16* wf = (const bf16*)(A.ws + WS_WC1) + ((size_t)(((CU_SLOT(cur) * 2 + j) * 2 + ht) * 64 + 32 * kh) * 64 + lane) * 8;
          LAS const unsigned char* xb = sh + CM_X + r32 * CM_SB + h * 16;
          f32x16 acc = {};
#pragma unroll 16
          for (int k2 = 0; k2 < 32; ++k2) { const int ks = 32 * kh + k2; const bf16x8 af = *(const bf16x8*)(wf + (size_t)k2 * 512);
              const bf16x8 bf = *(LAS const bf16x8*)(xb + (ks >> 2) * 128 + (ks & 3) * 32);
              acc = __builtin_amdgcn_mfma_f32_32x32x16_bf16(af, bf, acc, 0, 0, 0); }
          LAS unsigned char* hb = sh + CM_H + (j * 2 + kh) * CM_HT + r32 * CM_HCOL + (32 * ht + 4 * h) * 4;
#pragma unroll
          for (int rq = 0; rq < 4; ++rq) *(LAS f32x4*)(hb + 32 * rq) = (f32x4){acc[4 * rq], acc[4 * rq + 1], acc[4 * rq + 2], acc[4 * rq + 3]}; }
        __syncthreads();
        if (w < 2) {
            const float* c1p = (const float*)(A.ws + WS_C1) + CU_SLOT(cur) * 64;
            const bf16* W2 = (const bf16*)(A.ws + WS_WC2) + (size_t)CU_SLOT(cur) * 64 * 64;
            const int i1 = r32 < 31 ? r32 + 1 : 31;
            f32x16 oo = {};
#pragma unroll
            for (int ks = 0; ks < 4; ++ks) {
                const int hid0 = 16 * ks + 8 * h; float xv[8];
#pragma unroll
                for (int e4 = 0; e4 < 2; ++e4) {
                    const f32x4 a0 = *(LAS const f32x4*)(sh + CM_H + 0 * CM_HT + r32 * CM_HCOL + (hid0 + 4 * e4) * 4), a1 = *(LAS const f32x4*)(sh + CM_H + 1 * CM_HT + r32 * CM_HCOL + (hid0 + 4 * e4) * 4);
                    const f32x4 b0 = *(LAS const f32x4*)(sh + CM_H + 2 * CM_HT + i1 * CM_HCOL + (hid0 + 4 * e4) * 4), b1 = *(LAS const f32x4*)(sh + CM_H + 3 * CM_HT + i1 * CM_HCOL + (hid0 + 4 * e4) * 4);
                    const f32x4 cc = *(const f32x4*)(c1p + hid0 + 4 * e4);
#pragma unroll
                    for (int e = 0; e < 4; ++e) xv[4 * e4 + e] = gelu_tanh((a0[e] + a1[e]) + (b0[e] + b1[e]) + cc[e]);
                }
                v4u pw; pw.x = cvtpk(xv[0], xv[1]); pw.y = cvtpk(xv[2], xv[3]); pw.z = cvtpk(xv[4], xv[5]); pw.w = cvtpk(xv[6], xv[7]);
                const bf16x8 af = *(const bf16x8*)(W2 + (size_t)(32 * w + r32) * 64 + hid0);
                oo = __builtin_amdgcn_mfma_f32_32x32x16_bf16(af, __builtin_bit_cast(bf16x8, pw), oo, 0, 0, 0);
            }
            const int nsb = CU_SAMPLE(cur) ? 512 : 256, sb = 31 * CU_GRP(cur) + r32;
            if (r32 < 31 && sb < nsb - 1) {
                bf16* dst = (bf16*)(A.ws + (CU_SAMPLE(cur) ? (CU_SLOT(cur) ? WS_VCS : WS_KCS) : (CU_SLOT(cur) ? WS_VCP : WS_KCP))) + ((size_t)(CU_B(cur) * nsb + sb) * 2 + CU_G(cur)) * 64 + 32 * w + 4 * h;
#pragma unroll
                for (int rq = 0; rq < 4; ++rq) { v2u wv; wv.x = cvtpk(oo[4 * rq], oo[4 * rq + 1]); wv.y = cvtpk(oo[4 * rq + 2], oo[4 * rq + 3]); *(v2u*)(dst + 8 * rq) = wv; }
            }
        }
        if (!more) break;
        u = un;
    }
}

__device__ __forceinline__ float log_sigmoid(float x) { return fminf(x, 0.f) - __logf(1.0f + __expf(-fabsf(x))); }
constexpr int G_QE = 0, G_KE = 8192, G_KDT = 16384, G_V = 24576, G_ST = 40960, G_LR = 73728, G_SEG = 77824, G_DEC = 79872, G_END = 80128;
__device__ __forceinline__ int sw128(int row, int ch) { return row * 128 + ((ch ^ ((row >> 1) & 7)) << 4); }

__device__ __forceinline__ void gla_local(const Frame& F, const Args& A, LAS unsigned char* sh, int unit) {
    const int b = unit >> 6, hh = (unit >> 4) & 3, sc = unit & 15;
    const int lane = hw_lane(), w = F.wave, tid = w * 64 + lane, r32 = lane & 31, h = lane >> 5;
    const bf16* PROJ = (const bf16*)(A.ws + WS_PROJ);
    const size_t tok0 = (size_t)b * SEQ + 256 * sc;
    const int c = lane;
    float wg[16];
#pragma unroll
    for (int r = 0; r < 16; ++r) wg[r] = A.in[13][r * 256 + hh * 64 + c];
    const float bg = A.in[14][hh * 64 + c];
    float Bprev = 0.f;
    const int dvt = w >> 1, it = w & 1;
    f32x16 accS = {};
    const int i16 = lane & 15, tq = i16 >> 2, tp = i16 & 3, g1 = (lane >> 4) & 1;
    const int vcol = ((4 * (dvt ^ tq) + 2 * g1 + (tp >> 1)) << 4) + (tp & 1) * 8;
    __syncthreads();
#pragma unroll 1
    for (int n = 0; n < 4; ++n) {
        const size_t tb = tok0 + 64 * n;
        { const int trow = tid >> 3, pr = tid & 7; const unsigned lw = *(const unsigned*)(PROJ + (tb + trow) * NPROJ + C_LR + 2 * pr);
          LAS float* lr = (LAS float*)(sh + G_LR); lr[trow * 16 + 2 * pr] = bflo(lw); lr[trow * 16 + 2 * pr + 1] = bfhi(lw);
#pragma unroll
          for (int k2 = 0; k2 < 2; ++k2) { const int ch = pr * 2 + k2; const v4u vv = *(const v4u*)(PROJ + (tb + trow) * NPROJ + C_VG + hh * 128 + ch * 8);
              *(LAS v4u*)(sh + G_V + trow * 256 + ((ch ^ ((trow & 3) << 2)) << 4)) = vv; } }
        __syncthreads();
        float cum[8], qv[8], kv[8];
        { LAS const float* lr = (LAS const float*)(sh + G_LR); float run = 0.f;
#pragma unroll
          for (int k = 0; k < 8; ++k) { const int i = 8 * w + k; float x = bg;
#pragma unroll
              for (int r = 0; r < 16; ++r) x += lr[i * 16 + r] * wg[r];
              run += log_sigmoid(x) * (1.0f / 16.0f); cum[k] = run;
              qv[k] = 0.125f * bf2f(PROJ[(tb + i) * NPROJ + C_QG + hh * 64 + c]); kv[k] = bf2f(PROJ[(tb + i) * NPROJ + C_KG + hh * 64 + c]); }
          ((LAS float*)(sh + G_SEG))[w * 64 + c] = run; }
        __syncthreads();
        { LAS const float* seg = (LAS const float*)(sh + G_SEG); float pre = 0.f, tot = 0.f;
#pragma unroll
          for (int g_ = 0; g_ < 8; ++g_) { const float sv = seg[g_ * 64 + c]; tot += sv; if (g_ < w) pre += sv; }
          const float eB = __expf(Bprev);
          unsigned kdw[4];
#pragma unroll
          for (int k = 0; k < 8; ++k) { const int i = 8 * w + k; const float bb = pre + cum[k];
              const float qe = qv[k] * __expf(bb), ke = kv[k] * __expf(-bb), kd = kv[k] * __expf(tot - bb);
              *(LAS unsigned short*)(sh + G_QE + sw128(i, c >> 3) + (c & 7) * 2) = (unsigned short)f2bf(qe);
              *(LAS unsigned short*)(sh + G_KE + sw128(i, c >> 3) + (c & 7) * 2) = (unsigned short)f2bf(ke);
              ((bf16*)(A.ws + WS_QB))[(tb + i) * 256 + hh * 64 + c] = (bf16)f2bf(qe * eB);
              if (k & 1) kdw[k >> 1] |= f2bf(kd) << 16; else kdw[k >> 1] = f2bf(kd); }
          *(LAS v4u*)(sh + G_KDT + sw128(c, w)) = (v4u){kdw[0], kdw[1], kdw[2], kdw[3]};
          if (w == 0) ((LAS float*)(sh + G_DEC))[c] = __expf(tot);
          Bprev += tot; }
        __syncthreads();
        LAS const unsigned char* qeb = sh + G_QE; LAS const unsigned char* keb = sh + G_KE; LAS const unsigned char* vbase = sh + G_V;
        bf16x8 qfr[4];
#pragma unroll
        for (int ks = 0; ks < 4; ++ks) qfr[ks] = *(LAS const bf16x8*)(qeb + sw128(32 * it + r32, 2 * ks + h));
        f32x16 oT = {};
#pragma unroll
        for (int jt = 0; jt < 2; ++jt) {
            if (jt <= it) {
                f32x16 s = {};
#pragma unroll
                for (int ks = 0; ks < 4; ++ks) { const bf16x8 kf = *(LAS const bf16x8*)(keb + sw128(32 * jt + r32, 2 * ks + h)); s = __builtin_amdgcn_mfma_f32_32x32x16_bf16(kf, qfr[ks], s, 0, 0, 0); }
                if (jt == it) {
#pragma unroll
                    for (int r = 0; r < 16; ++r) { const int j = (r & 3) + 8 * (r >> 2) + 4 * h; if (j > r32) s[r] = 0.f; }
                }
#pragma unroll
                for (int s2 = 0; s2 < 2; ++s2) {
                    v4u pw; pw.x = cvtpk(s[8 * s2], s[8 * s2 + 1]); pw.y = cvtpk(s[8 * s2 + 2], s[8 * s2 + 3]); pw.z = cvtpk(s[8 * s2 + 4], s[8 * s2 + 5]); pw.w = cvtpk(s[8 * s2 + 6], s[8 * s2 + 7]);
                    const int row = 32 * jt + 16 * s2 + 4 * h + tq;
                    const s16x4 lo = vtr(vbase + row * 256 + vcol), hi = vtr(vbase + (row + 8) * 256 + vcol);
                    const bf16x8 vf = {lo[0], lo[1], lo[2], lo[3], hi[0], hi[1], hi[2], hi[3]};
                    oT = __builtin_amdgcn_mfma_f32_32x32x16_bf16(vf, __builtin_bit_cast(bf16x8, pw), oT, 0, 0, 0);
                }
            }
        }
        if (n > 0) {
            LAS const unsigned char* stb = sh + G_ST + (n & 1) * 16384;
#pragma unroll
            for (int ks = 0; ks < 4; ++ks) { const bf16x8 sf = *(LAS const bf16x8*)(stb + sw128(32 * dvt + r32, 2 * ks + h)); oT = __builtin_amdgcn_mfma_f32_32x32x16_bf16(sf, qfr[ks], oT, 0, 0, 0); }
        }
        { float* op = (float*)(A.ws + WS_OLOC) + (tb + 32 * it + r32) * 512 + hh * 128 + 32 * dvt + 4 * h;
#pragma unroll
          for (int rq = 0; rq < 4; ++rq) *(f32x4*)(op + 8 * rq) = (f32x4){oT[4 * rq], oT[4 * rq + 1], oT[4 * rq + 2], oT[4 * rq + 3]}; }
        { const float dec = ((LAS const float*)(sh + G_DEC))[32 * it + r32];
#pragma unroll
          for (int r = 0; r < 16; ++r) accS[r] *= dec;
#pragma unroll
          for (int ks = 0; ks < 4; ++ks) {
              const bf16x8 kdf = *(LAS const bf16x8*)(sh + G_KDT + sw128(32 * it + r32, 2 * ks + h));
              const int row = 16 * ks + 8 * h + tq;
              const s16x4 lo = vtr(vbase + row * 256 + vcol), hi = vtr(vbase + (row + 4) * 256 + vcol);
              const bf16x8 vf = {lo[0], lo[1], lo[2], lo[3], hi[0], hi[1], hi[2], hi[3]};
              accS = __builtin_amdgcn_mfma_f32_32x32x16_bf16(vf, kdf, accS, 0, 0, 0);
          }
          LAS unsigned char* stn = sh + G_ST + ((n + 1) & 1) * 16384; const int d = 32 * it + r32;
#pragma unroll
          for (int r = 0; r < 16; ++r) { const int dv = 32 * dvt + (r & 3) + 8 * (r >> 2) + 4 * h; *(LAS unsigned short*)(stn + sw128(dv, d >> 3) + (d & 7) * 2) = (unsigned short)f2bf(accS[r]); } }
        __syncthreads();
    }
    { float* up = (float*)(A.ws + WS_USC) + (size_t)unit * 8192; const int d = 32 * it + r32;
#pragma unroll
      for (int r = 0; r < 16; ++r) { const int dv = 32 * dvt + (r & 3) + 8 * (r >> 2) + 4 * h; up[dv * 64 + d] = accS[r]; }
      if (w == 0) ((float*)(A.ws + WS_DSC))[unit * 64 + c] = __expf(Bprev); }
}

__device__ __forceinline__ void gla_out(const Frame& F, const Args& A, LAS unsigned char* sh, int unit) {
    const int b = unit >> 6, hh = (unit >> 4) & 3, sc = unit & 15;
    const int lane = hw_lane(), w = F.wave, tid = w * 64 + lane, r32 = lane & 31, h = lane >> 5;
    const bf16* PROJ = (const bf16*)(A.ws + WS_PROJ);
    const size_t tok0 = (size_t)b * SEQ + 256 * sc;
    const int d4 = (tid & 15) * 4, dvr = tid >> 4;
    f32x4 S[4];
#pragma unroll
    for (int k = 0; k < 4; ++k) S[k] = (f32x4){0.f, 0.f, 0.f, 0.f};
    const float* U0 = (const float*)(A.ws + WS_USC) + (size_t)(unit - sc) * 8192; const float* D0 = (const float*)(A.ws + WS_DSC) + (size_t)(unit - sc) * 64;
#pragma unroll 1
    for (int s = 0; s < sc; ++s) { const f32x4 dd = *(const f32x4*)(D0 + s * 64 + d4);
#pragma unroll
        for (int k = 0; k < 4; ++k) { const f32x4 u = *(const f32x4*)(U0 + (size_t)s * 8192 + (32 * k + dvr) * 64 + d4); S[k] = S[k] * dd + u; } }
    __syncthreads();
#pragma unroll
    for (int k = 0; k < 4; ++k) { const int dv = 32 * k + dvr; v2u wv; wv.x = pk2(S[k].x, S[k].y); wv.y = pk2(S[k].z, S[k].w);
        *(LAS v2u*)(sh + sw128(dv, d4 >> 3) + (d4 & 7) * 2) = wv; }
    if (sc == 15) {
        const f32x4 dd = *(const f32x4*)(D0 + 15 * 64 + d4); float* op = A.out + O_GLAP + (size_t)(b * 4 + hh) * 8192;
#pragma unroll
        for (int k = 0; k < 4; ++k) { const int dv = 32 * k + dvr; const f32x4 u = *(const f32x4*)(U0 + (size_t)15 * 8192 + dv * 64 + d4); const f32x4 e = S[k] * dd + u;
            op[(d4 + 0) * 128 + dv] = e.x; op[(d4 + 1) * 128 + dv] = e.y; op[(d4 + 2) * 128 + dv] = e.z; op[(d4 + 3) * 128 + dv] = e.w; }
    }
    __syncthreads();
    const size_t tok = tok0 + 32 * w + r32;
    f32x16 acc[4];
#pragma unroll
    for (int t = 0; t < 4; ++t) acc[t] = f32x16{};
#pragma unroll
    for (int ks = 0; ks < 4; ++ks) { const bf16x8 qb = *(const bf16x8*)((const bf16*)(A.ws + WS_QB) + tok * 256 + hh * 64 + 16 * ks + 8 * h);
#pragma unroll
        for (int t = 0; t < 4; ++t) { const bf16x8 sf = *(LAS const bf16x8*)(sh + sw128(32 * t + r32, 2 * ks + h)); acc[t] = __builtin_amdgcn_mfma_f32_32x32x16_bf16(sf, qb, acc[t], 0, 0, 0); } }
    const float* ol = (const float*)(A.ws + WS_OLOC) + tok * 512 + hh * 128;
    float ss = 0.f;
#pragma unroll
    for (int t = 0; t < 4; ++t)
#pragma unroll
        for (int rq = 0; rq < 4; ++rq) { const f32x4 v = *(const f32x4*)(ol + 32 * t + 8 * rq + 4 * h);
#pragma unroll
            for (int e = 0; e < 4; ++e) { acc[t][4 * rq + e] += v[e]; ss += acc[t][4 * rq + e] * acc[t][4 * rq + e]; } }
    ss += __shfl_xor(ss, 32);
    const float rstd = 1.0f / sqrtf(ss * (1.0f / 128.0f) + EPS);
    const float* gn = A.in[15]; const bf16* gg = PROJ + tok * NPROJ + C_GG + hh * 128;
    bf16* dst = (bf16*)(A.ws + WS_MIX) + tok * 1024 + 512 + hh * 128;
#pragma unroll
    for (int t = 0; t < 4; ++t)
#pragma unroll
        for (int rq = 0; rq < 4; ++rq) { const int dv0 = 32 * t + 8 * rq + 4 * h; const f32x4 gnv = *(const f32x4*)(gn + dv0); const v2u gw = *(const v2u*)(gg + dv0);
            const float gv[4] = {bflo(gw.x), bfhi(gw.x), bflo(gw.y), bfhi(gw.y)}; float y[4];
#pragma unroll
            for (int e = 0; e < 4; ++e) y[e] = acc[t][4 * rq + e] * rstd * gnv[e] * gv[e] * __builtin_amdgcn_rcpf(1.0f + __expf(-gv[e]));
            v2u ov; ov.x = cvtpk(y[0], y[1]); ov.y = cvtpk(y[2], y[3]); *(v2u*)(dst + dv0) = ov; }
}

__device__ __forceinline__ void gla_sample(const Frame& F, const Args& A, LAS unsigned char* sh, int unit) {
    const int b = unit >> 2, hh = unit & 3, tid = F.wave * 64 + hw_lane();
    const bf16* PROJ = (const bf16*)(A.ws + WS_PROJ);
    LAS float* la = (LAS float*)sh;
    LAS float* qs = la + 256;
    LAS float* ks = qs + 256;
    LAS float* op = ks + 256;
    LAS float* of = op + 2048;
    __syncthreads();
    if (tid < 256) { const int t = tid >> 6, c = tid & 63; const size_t tok = (size_t)TP + b * 4 + t; float x = A.in[14][hh * 64 + c];
#pragma unroll
        for (int r = 0; r < 16; ++r) x += bf2f(PROJ[tok * NPROJ + C_LR + r]) * A.in[13][r * 256 + hh * 64 + c];
        la[tid] = __expf(log_sigmoid(x) * (1.0f / 16.0f)); qs[tid] = 0.125f * bf2f(PROJ[tok * NPROJ + C_QG + hh * 64 + c]); ks[tid] = bf2f(PROJ[tok * NPROJ + C_KG + hh * 64 + c]); }
    __syncthreads();
    const int dv = tid & 127, cg = tid >> 7;
    const float* s0 = A.in[4] + (size_t)(b * 4 + hh) * 8192;
    float S[16];
#pragma unroll
    for (int k = 0; k < 16; ++k) S[k] = s0[(16 * cg + k) * 128 + dv];
#pragma unroll
    for (int t = 0; t < 4; ++t) { const float vv = bf2f(PROJ[((size_t)TP + b * 4 + t) * NPROJ + C_VG + hh * 128 + dv]); float o = 0.f;
#pragma unroll
        for (int k = 0; k < 16; ++k) { const int c = 16 * cg + k; S[k] = la[t * 64 + c] * S[k] + ks[t * 64 + c] * vv; o += qs[t * 64 + c] * S[k]; }
        op[(cg * 4 + t) * 128 + dv] = o; }
    float* so = A.out + O_GLAS + (size_t)(b * 4 + hh) * 8192;
#pragma unroll
    for (int k = 0; k < 16; ++k) so[(16 * cg + k) * 128 + dv] = S[k];
    __syncthreads();
    { const int t = tid >> 7; of[t * 128 + dv] = (op[(0 * 4 + t) * 128 + dv] + op[(1 * 4 + t) * 128 + dv]) + (op[(2 * 4 + t) * 128 + dv] + op[(3 * 4 + t) * 128 + dv]); }
    __syncthreads();
    { const int t = tid >> 7; float ss = 0.f;
      for (int k = 0; k < 128; ++k) { const float v = of[t * 128 + k]; ss += v * v; }
      const float rstd = 1.0f / sqrtf(ss * (1.0f / 128.0f) + EPS); const size_t tok = (size_t)TP + b * 4 + t;
      const float gv = bf2f(PROJ[tok * NPROJ + C_GG + hh * 128 + dv]);
      const float y = of[t * 128 + dv] * rstd * A.in[15][dv] * gv * __builtin_amdgcn_rcpf(1.0f + __expf(-gv));
      ((bf16*)(A.ws + WS_MIX))[tok * 1024 + 512 + hh * 128 + dv] = (bf16)f2bf(y); }
}

#ifdef PROBE_PHASE
#define PREP(k) ((PROBE_PHASE) == (k) ? 2 : 1)
#else
#define PREP(k) 1
#endif
__device__ __forceinline__ void phase2(const Frame& F, const Args& A) {
    LAS unsigned char* sh = F.lds;
#ifndef SKIP_CMP
    _Pragma("unroll 1") for (int rep = 0; rep < PREP(21); ++rep) cmp_phase(F, A, sh);
#endif
    #ifndef SKIP_GLAL
    _Pragma("unroll 1") for (int rep = 0; rep < PREP(22); ++rep) for (int u = F.vcu; u < 256; u += F.G) gla_local(F, A, sh, u);
#endif
    #ifndef SKIP_GLAS
    _Pragma("unroll 1") for (int rep = 0; rep < PREP(24); ++rep) for (int u = F.vcu; u < 128; u += F.G) gla_sample(F, A, sh, u);
#endif
    __syncthreads();
    attn_fill_lut((LAS float*)(sh + AT_LUT), A.in[24], F.tid);
    __syncthreads();
    _Pragma("unroll 1") for (int rep = 0; rep < PREP(23); ++rep) for (int p = F.vcu; p < 256; p += F.G) { const int bg = p >> 5, s = p & 31;
#ifndef SKIP_WIN
 win_unit(F, A, sh, bg >> 1, bg & 1, 63 - s); win_unit(F, A, sh, bg >> 1, bg & 1, s);
#endif
 }
}
__device__ __forceinline__ void phase3(const Frame& F, const Args& A) {
    LAS unsigned char* sh = F.lds;
    #ifndef SKIP_GLAO
    _Pragma("unroll 1") for (int rep = 0; rep < PREP(31); ++rep) for (int u = F.vcu; u < 256; u += F.G) gla_out(F, A, sh, u);
#endif
    __syncthreads();
    attn_fill_lut((LAS float*)(sh + AT_LUT), A.in[24], F.tid);
    __syncthreads();
    { gu32* qh = (gu32*)(A.ws + WS_CTL) + CW_Q3 + 64 * (F.vcu >> 5); LAS int* slot = (LAS int*)(sh + HI_Q);
      const int bg = (F.vcu >> 5) & 7;
      for (;;) {
          __syncthreads();
          if (F.wave == 0 && hw_lane() == 0) *slot = (int)__hip_atomic_fetch_add(qh, 1u, __ATOMIC_RELAXED, __HIP_MEMORY_SCOPE_AGENT);
          __syncthreads();
          const int idx = *slot;
          if (idx >= 72 * PREP(33)) break;
          const int k = idx % 72;
          if (k < 8) {
#ifndef SKIP_SAMP
              const int u = bg * 8 + k; samp_unit(F, A, sh, u >> 1, u & 1);
#endif
          } else {
#ifndef SKIP_NSA
              nsa_unit(F, A, sh, bg >> 1, bg & 1, 71 - k);
#endif
          }
      } }
}

template <class Epi>
__device__ __forceinline__ void skinny_phase(const Frame& F, const bf16* Act, int lda, const bf16* Bt, int K, int ncolgrp, const Epi& E) {
    const int lane = hw_lane(), w = F.wave, c16 = lane & 15, kg = lane >> 4;
    const int tg = w & 1, kq = w >> 1, kq_len = K / 4;
    LAS f32x4* xs = (LAS f32x4*)F.lds;
    for (int job = blockIdx.x; job < 4 * ncolgrp; job += F.G) {
        const int cg = job >> 2, tok = TP + 32 * (job & 3) + 16 * tg + c16;
        const bf16* ap = Bt + (size_t)(16 * cg + c16) * K + kq * kq_len + 8 * kg;
        const bf16* bp = Act + (size_t)tok * lda + kq * kq_len + 8 * kg;
        f32x4 acc = {0.f, 0.f, 0.f, 0.f};
#pragma unroll 8
        for (int ks = 0; ks < kq_len / 32; ++ks) { const bf16x8 af = *(const bf16x8*)(ap + 32 * ks), bf = *(const bf16x8*)(bp + 32 * ks); acc = __builtin_amdgcn_mfma_f32_16x16x32_bf16(af, bf, acc, 0, 0, 0); }
        __syncthreads();
        xs[w * 64 + lane] = acc;
        __syncthreads();
        if (kq == 0) { const f32x4 v = (xs[tg * 64 + lane] + xs[(2 + tg) * 64 + lane]) + (xs[(4 + tg) * 64 + lane] + xs[(6 + tg) * 64 + lane]); E(v, tok, 16 * cg + 4 * kg, kg); }
    }
}
struct SkInProj { bf16* proj; float* out;
    __device__ __forceinline__ void operator()(f32x4 v, int tok, int col, int kg) const {
        if (col < 512) v = v * 0.125f;
        v2u w; w.x = cvtpk(v[0], v[1]); w.y = cvtpk(v[2], v[3]); *(v2u*)(proj + (size_t)tok * NPROJ + col) = w;
        if (col >= C_KV && col < C_WIN) *(f32x4*)(out + O_KV + (size_t)tok * 512 + (col - C_KV)) = v;
        else if (col >= C_WIN && col < C_GT) { const int rs = tok - TP, b = rs >> 2, i = rs & 3; *(f32x4*)(out + O_WINS + ((size_t)(b * 512 + 508 + i) * 256 + (col - C_WIN))) = v; }
    } };
struct SkResid { const float* base; float* hout; bf16* hb; float* rowss;
    __device__ __forceinline__ void operator()(f32x4 v, int tok, int col, int kg) const {
        v = v + *(const f32x4*)(base + (size_t)(tok - TP) * 1024 + col);
        *(f32x4*)(hout + (size_t)tok * 1024 + col) = v;
        v2u w; w.x = cvtpk(v[0], v[1]); w.y = cvtpk(v[2], v[3]); *(v2u*)(hb + (size_t)tok * 1024 + col) = w;
        float ss = (v[0] * v[0] + v[1] * v[1]) + (v[2] * v[2] + v[3] * v[3]); ss += __shfl_xor(ss, 16); ss += __shfl_xor(ss, 32);
        if (kg == 0) atomicAdd(rowss + tok, ss);
    } };
struct SkBf { bf16* O; int ldc;
    __device__ __forceinline__ void operator()(f32x4 v, int tok, int col, int kg) const { v2u w; w.x = cvtpk(v[0], v[1]); w.y = cvtpk(v[2], v[3]); *(v2u*)(O + (size_t)tok * ldc + col) = w; } };
struct SkPleGate { const float* h2; const bf16* ple; const float* rowss2; float* y; float* rowss3;
    __device__ __forceinline__ void operator()(f32x4 a, int tok, int col, int kg) const {
        const float rstd = __builtin_amdgcn_rsqf(rowss2[tok] * (1.0f / 1024.0f) + EPS);
        const v2u pw = *(const v2u*)(ple + (size_t)tok * 1024 + col); const f32x4 b = *(const f32x4*)(h2 + (size_t)tok * 1024 + col);
        const float pv[4] = {bflo(pw.x), bfhi(pw.x), bflo(pw.y), bfhi(pw.y)}; f32x4 v;
#pragma unroll
        for (int e = 0; e < 4; ++e) v[e] = b[e] + pv[e] * __builtin_amdgcn_rcpf(1.0f + __expf(-a[e] * rstd));
        *(f32x4*)(y + (size_t)tok * 1024 + col) = v;
        float ss = (v[0] * v[0] + v[1] * v[1]) + (v[2] * v[2] + v[3] * v[3]); ss += __shfl_xor(ss, 16); ss += __shfl_xor(ss, 32);
        if (kg == 0) atomicAdd(rowss3 + tok, ss);
    } };

typedef const __attribute__((address_space(4))) Args* ArgsP;
__device__ __forceinline__ Args load_args() {
    Args r{};
#if defined(__HIP_DEVICE_COMPILE__)
    ArgsP p = (ArgsP)__builtin_amdgcn_kernarg_segment_ptr(); asm volatile("" : "+s"(p));
#pragma unroll
    for (int i = 0; i < 26; ++i) r.in[i] = p->in[i];
    r.out = p->out; r.ws = p->ws; r.ph_lo = p->ph_lo; r.ph_hi = p->ph_hi;
#endif
    return r;
}
__global__ void __launch_bounds__(NWAVES * 64, 2) mega_fwd(Args args_unused) {
    extern __shared__ __attribute__((aligned(16))) unsigned char lds_raw[];
    Frame F;
    F.lds = (LAS unsigned char*)lds_raw;
    F.wave = __builtin_amdgcn_readfirstlane((int)threadIdx.x >> 6); F.lane = hw_lane(); F.tid = F.wave * 64 + F.lane;
    F.G = gridDim.x; { const int bx = blockIdx.x; F.vcu = (F.G % 8 == 0) ? (bx % 8) * (F.G / 8) + bx / 8 : bx; }
    int lo, hi; unsigned char* ws;
    { const Args a0 = load_args(); lo = a0.ph_lo; hi = a0.ph_hi; ws = a0.ws; }
    gu32* ctl = (gu32*)(ws + WS_CTL);
    volatile LAS unsigned* MISC = (volatile LAS unsigned*)(F.lds + MISC_OFF);
    for (int u = F.tid; u < (LDS_BYTES - RING_BYTES) / 4; u += NWAVES * 64) ((LAS unsigned*)(F.lds + RING_BYTES))[u] = 0u;
    __syncthreads();
    const bool multi = (hi - lo) > 1;
    XcdBarrier bar; bar.bar = (unsigned*)(ctl + CW_BAR); bar.x = 0; bar.st = nullptr;
    if (multi) bar = xcd_barrier_post((unsigned*)(ctl + CW_BAR), MISC + 8, F.tid);
#define IN(k) (lo <= (k) && (k) < hi)
#ifdef PROBE_PHASE
#define NREP(k) ((PROBE_PHASE) == (k) ? 2 : 1)
#else
#define NREP(k) 1
#endif
    float* dummy_rowss = (float*)(ws + WS_END);
#define SEAM(k) do { if (IN(k) && IN((k) + 1)) { F.lane = hw_lane(); F.tid = F.wave * 64 + F.lane; xcd_barrier(bar, F.tid); } } while (0)
#define REFRESH() do { F.lane = hw_lane(); F.tid = F.wave * 64 + F.lane; } while (0)

    if (IN(0)) { REFRESH(); const Args args = load_args(); _Pragma("unroll 1") for (int rep = 0; rep < NREP(0); ++rep) { __syncthreads(); p0_prologue(F, args); } } SEAM(0);
    if (IN(1)) { REFRESH(); const Args args = load_args(); unsigned char* ws = args.ws;
        pg8::Gemm g{(const pg8::bf16_t*)(ws + WS_XN), (const pg8::bf16_t*)(ws + WS_WIN), TP, NPROJ, 1024}; pg8::StaticOrder S; S.init(TP, NPROJ, F.G, (int)blockIdx.x);
        pg8::EpiInProj E{(pg8::bf16_t*)(ws + WS_PROJ), args.out};
        _Pragma("unroll 1") for (int rep = 0; rep < NREP(1); ++rep) pg8::gemm_phase<pg8::EpiInProj, pg8::StaticOrder, true, true>(F.lds, g, S, E, F.tid);
        skinny_phase(F, (const bf16*)(ws + WS_XN), 1024, (const bf16*)(ws + WS_WIN), 1024, (NIN + 15) / 16, SkInProj{(bf16*)(ws + WS_PROJ), args.out});
    } SEAM(1);
    if (IN(2)) { REFRESH(); const Args args = load_args(); phase2(F, args); } SEAM(2);
    if (IN(3)) { REFRESH(); const Args args = load_args(); phase3(F, args); } SEAM(3);
    if (IN(4)) { REFRESH(); const Args args = load_args(); unsigned char* ws = args.ws; float* rowss1 = (float*)(ws + WS_ROWSS);
        { pg8::Gemm g{(const pg8::bf16_t*)(ws + WS_MIX), (const pg8::bf16_t*)(ws + WS_WO), TP, 1024, 1024}; pg8::StaticOrder S; S.init(TP, 1024, F.G, (int)blockIdx.x);
          _Pragma("unroll 1") for (int rep = 0; rep < NREP(4); ++rep) { pg8::EpiResid E{args.in[0], args.in[1], (float*)(ws + WS_H1), (pg8::bf16_t*)(ws + WS_H1B), rep ? dummy_rowss : rowss1};
          pg8::gemm_phase<pg8::EpiResid, pg8::StaticOrder, true, true>(F.lds, g, S, E, F.tid); } }
        { pg8::Gemm g{(const pg8::bf16_t*)(ws + WS_PPLE), (const pg8::bf16_t*)(ws + WS_WPLE), TP, 1024, 256}; pg8::StaticOrder S; S.init(TP, 1024, F.G, (int)blockIdx.x);
          pg8::EpiBf E{(pg8::bf16_t*)(ws + WS_PLEB), 1024};
          _Pragma("unroll 1") for (int rep = 0; rep < NREP(41); ++rep) pg8::gemm_phase<pg8::EpiBf, pg8::StaticOrder, true, true>(F.lds, g, S, E, F.tid); }
        skinny_phase(F, (const bf16*)(ws + WS_MIX), 1024, (const bf16*)(ws + WS_WO), 1024, 64, SkResid{args.in[1], (float*)(ws + WS_H1), (bf16*)(ws + WS_H1B), rowss1});
        skinny_phase(F, (const bf16*)(ws + WS_PPLE), 256, (const bf16*)(ws + WS_WPLE), 256, 64, SkBf{(bf16*)(ws + WS_PLEB), 1024});
    } SEAM(4);
    if (IN(5)) { REFRESH(); const Args args = load_args(); unsigned char* ws = args.ws; float* rowss1 = (float*)(ws + WS_ROWSS);
        pg8::Gemm g{(const pg8::bf16_t*)(ws + WS_H1B), (const pg8::bf16_t*)(ws + WS_WGU), MPAD, NGU, 1024}; pg8::StaticOrder S; S.init(MPAD, NGU, F.G, (int)blockIdx.x);
        pg8::EpiGateUp E{(pg8::bf16_t*)(ws + WS_ACT), rowss1};
        _Pragma("unroll 1") for (int rep = 0; rep < NREP(5); ++rep) pg8::gemm_phase<pg8::EpiGateUp, pg8::StaticOrder, true, true>(F.lds, g, S, E, F.tid);
    } SEAM(5);
    if (IN(6)) { REFRESH(); const Args args = load_args(); unsigned char* ws = args.ws; float* rowss2 = (float*)(ws + WS_ROWSS) + MPAD;
        pg8::Gemm g{(const pg8::bf16_t*)(ws + WS_ACT), (const pg8::bf16_t*)(ws + WS_WDN), TP, 1024, DFF}; pg8::StaticOrder S; S.init(TP, 1024, F.G, (int)blockIdx.x);
        _Pragma("unroll 1") for (int rep = 0; rep < NREP(6); ++rep) { pg8::EpiResid E{(const float*)(ws + WS_H1), (const float*)(ws + WS_H1) + (size_t)TP * 1024, (float*)(ws + WS_H2), (pg8::bf16_t*)(ws + WS_H2B), rep ? dummy_rowss : rowss2};
        pg8::gemm_phase<pg8::EpiResid, pg8::StaticOrder, true, true>(F.lds, g, S, E, F.tid); }
        skinny_phase(F, (const bf16*)(ws + WS_ACT), DFF, (const bf16*)(ws + WS_WDN), DFF, 64, SkResid{(const float*)(ws + WS_H1) + (size_t)TP * 1024, (float*)(ws + WS_H2), (bf16*)(ws + WS_H2B), rowss2});
    } SEAM(6);
    if (IN(7)) { REFRESH(); const Args args = load_args(); unsigned char* ws = args.ws; float* rowss2 = (float*)(ws + WS_ROWSS) + MPAD; float* rowss3 = rowss2 + MPAD;
        pg8::Gemm g{(const pg8::bf16_t*)(ws + WS_H2B), (const pg8::bf16_t*)(ws + WS_WPG), TP, 1024, 1024}; pg8::StaticOrder S; S.init(TP, 1024, F.G, (int)blockIdx.x);
        _Pragma("unroll 1") for (int rep = 0; rep < NREP(7); ++rep) { pg8::EpiPleGate E{(const float*)(ws + WS_H2), (const pg8::bf16_t*)(ws + WS_PLEB), rowss2, args.out + O_Y, rep ? dummy_rowss : rowss3};
        pg8::gemm_phase<pg8::EpiPleGate, pg8::StaticOrder, true, true>(F.lds, g, S, E, F.tid); }
        skinny_phase(F, (const bf16*)(ws + WS_H2B), 1024, (const bf16*)(ws + WS_WPG), 1024, 64, SkPleGate{(const float*)(ws + WS_H2), (const bf16*)(ws + WS_PLEB), rowss2, args.out + O_Y, rowss3});
    } SEAM(7);
    if (IN(8)) { REFRESH(); const Args args = load_args(); unsigned char* ws = args.ws; float* rowss3 = (float*)(ws + WS_ROWSS) + 2 * MPAD;
        const int gw = F.vcu * NWAVES + F.wave, NGW = F.G * NWAVES; const GAS f32x4* gr = (const GAS f32x4*)args.in[25] + F.lane;
        for (int m = gw; m < MTOT; m += NGW) { GAS f32x4* yr = (GAS f32x4*)(args.out + O_Y + (size_t)m * 1024) + F.lane; const float rstd = 1.0f / sqrtf(rowss3[m] * (1.0f / 1024.0f) + EPS);
#pragma unroll
            for (int j = 0; j < 4; ++j) { const f32x4 v = yr[64 * j], gg = gr[64 * j]; yr[64 * j] = (f32x4){v.x * rstd * gg.x, v.y * rstd * gg.y, v.z * rstd * gg.z, v.w * rstd * gg.w}; } }
    }
#undef IN
#undef SEAM
#undef REFRESH
}

extern "C" void kernel_launch(void* const* d_in, const int* in_sizes, int n_in, void* d_out, int out_size, void* d_ws, size_t ws_size, hipStream_t stream) {
    static int grid = 0;
    if (grid == 0) {
        if (n_in != 26 || (size_t)out_size != O_END || ws_size < WS_END + (1u << 20)) { fprintf(stderr, "kernel_launch: unexpected shapes: n_in %d out %d ws %zu\n", n_in, out_size, ws_size); grid = -1; return; }
        int dev = 0, cus = 0, per_cu = 0;
        if (hipGetDevice(&dev) != hipSuccess || hipDeviceGetAttribute(&cus, hipDeviceAttributeMultiprocessorCount, dev) != hipSuccess) { grid = -1; return; }
        if (hipFuncSetAttribute((const void*)mega_fwd, hipFuncAttributeMaxDynamicSharedMemorySize, LDS_BYTES) != hipSuccess) { fprintf(stderr, "kernel_launch: hipFuncSetAttribute failed\n"); grid = -1; return; }
        if (hipOccupancyMaxActiveBlocksPerMultiprocessor(&per_cu, (const void*)mega_fwd, NWAVES * 64, LDS_BYTES) != hipSuccess || per_cu < 1) { fprintf(stderr, "kernel_launch: occupancy query says %d blocks per CU\n", per_cu); grid = -1; return; }
        (void)hipGetLastError();
        grid = cus;
    }
    if (grid < 0) return;
    (void)hipMemsetAsync((char*)d_ws + WS_CTL, 0, CTL_ZERO_BYTES, stream);
    Args a{};
    for (int i = 0; i < 26; ++i) a.in[i] = (const float*)d_in[i];
    a.out = (float*)d_out; a.ws = (unsigned char*)d_ws;
#ifndef N_LAUNCH_SPLIT
    a.ph_lo = 0; a.ph_hi = 9;
    hipLaunchKernelGGL(mega_fwd, dim3(grid), dim3(NWAVES * 64), LDS_BYTES, stream, a);
#else
    for (int p = 0; p < 9; ++p) { a.ph_lo = p; a.ph_hi = p + 1; hipLaunchKernelGGL(mega_fwd, dim3(grid), dim3(NWAVES * 64), LDS_BYTES, stream, a); }
#endif
}
```

```cpp
#include <hip/hip_runtime.h>
#include <cstdio>
#include <cstdint>

constexpr int DM = 1024, TP = 16384, TS = 128, MTOT = TP + TS, MPAD = 16640, SEQ = 4096, NBATCH = 4, DBATCH = 32, DSEQ = 4, PAST = 8192;
constexpr int NPROJ = 3072, DFF = 2816, DPLE = 256, NGU = 2 * DFF;
constexpr int C_QN = 0, C_KV = 512, C_WIN = 1024, C_GT = 1280, C_QG = 1304, C_KG = 1560, C_VG = 1816, C_LR = 2328, C_GG = 2344, NIN = 2856;
constexpr float EPS = 1e-6f;
constexpr size_t O_Y = 0, O_KV = (size_t)MTOT * 1024, O_WINP = O_KV + (size_t)MTOT * 512, O_WINS = O_WINP + 4 * 512 * 256,
                 O_GLAP = O_WINS + (size_t)32 * 512 * 256, O_GLAS = O_GLAP + 4 * 4 * 64 * 128, O_END = O_GLAS + (size_t)32 * 4 * 64 * 128;
__device__ __forceinline__ int hw_lane() { int l; asm volatile("v_mbcnt_lo_u32_b32 %0, -1, 0\n\tv_mbcnt_hi_u32_b32 %0, -1, %0" : "=v"(l)); return l; }
namespace pg8 {
#define PG8_LAS __attribute__((address_space(3)))
typedef unsigned short bf16_t;
typedef short bf16x8 __attribute__((ext_vector_type(8)));
typedef float f32x4 __attribute__((ext_vector_type(4)));
typedef unsigned u32x4 __attribute__((ext_vector_type(4)));
constexpr int BM = 256, BK = 64, HALF = 128, HTB = HALF * BK * 2  , STAGE_BYTES = 8 * HTB, NXCD = 8, WGM = 8;

__host__ __device__ __forceinline__ int lds_byte(int r, int c) { const int st = (r >> 4) * 2 + (c >> 5), rr = r & 15, cc = c & 31, ob = rr * 64 + cc * 2; return st * 1024 + (ob ^ (((ob >> 9) & 1) << 5)); }
__host__ __device__ __forceinline__ void stage_rc(int b, int& R, int& C) { const int st = b / 1024, sb = b % 1024, swz = sb ^ (((sb >> 9) & 1) << 5); R = (st >> 1) * 16 + swz / 64; C = (st & 1) * 32 + (swz % 64) / 2; }
__host__ __device__ __forceinline__ int perm32(int rho) { const int n = rho >> 4, i = rho & 15; return 8 * (i >> 2) + 4 * n + (i & 3); }

struct Unit { int pm, pn; };
struct Gemm { const bf16_t* A; const bf16_t* Bt; int M, N, K; };

struct StaticOrder {
    int nM, nN, nwg, G, c;
    __host__ __device__ void init(int M, int N, int G_, int c_) { nM = M / BM; nN = N / BM; nwg = nM * nN; G = G_; c = c_; }
    __host__ __device__ bool next(int i, Unit& u) const {
        const long L = (long)i * G + c; if (L >= nwg) return false;
        int wgid = (int)L; { const int q = nwg / NXCD, r = nwg % NXCD, xcd = wgid % NXCD, off = wgid / NXCD; wgid = (xcd < r ? xcd * (q + 1) : r * (q + 1) + (xcd - r) * q) + off; }
        const int nig = WGM * nN, gid = wgid / nig, fm = gid * WGM, gsz = (nM - fm) < WGM ? (nM - fm) : WGM;
        u.pm = fm + ((wgid % nig) % gsz); u.pn = (wgid % nig) / gsz; return true;
    }
    __device__ __forceinline__ void a_ready(const Unit&) const {}
    __device__ __forceinline__ void done(const Unit&) const {}
};

__device__ __forceinline__ unsigned cvt_pk_bf16(float lo, float hi) { unsigned r; asm volatile("v_cvt_pk_bf16_f32 %0, %1, %2" : "=v"(r) : "v"(lo), "v"(hi)); return r; }

struct IdleOrder {
    StaticOrder so; int c0, n;
    __host__ __device__ void init(int M, int N, int G_, int c_, int c0_) { c0 = c0_; n = G_ - c0_; so.init(M, N, n > 0 ? n : 1, c_ - c0_); }
    __host__ __device__ bool next(int i, Unit& u) const { if (so.c < 0 || n <= 0) return false; return so.next(i, u); }
    __device__ __forceinline__ void a_ready(const Unit&) const {}
    __device__ __forceinline__ void done(const Unit&) const {}
};

__device__ __forceinline__ u32x4 pack8(const f32x4 v0, const f32x4 v1) { u32x4 w; w.x = cvt_pk_bf16(v0[0], v0[1]); w.y = cvt_pk_bf16(v0[2], v0[3]); w.z = cvt_pk_bf16(v1[0], v1[1]); w.w = cvt_pk_bf16(v1[2], v1[3]); return w; }

struct EpiInProj {
    static constexpr bool PERM = true, AFTER_DRAIN = false;
    bf16_t* proj; float* out;
    __device__ __forceinline__ void operator()(const f32x4 (&acc)[2][2][4][2], const Unit& u, int wr, int wc, int fr, int fq) const {
        const int row0 = u.pm * BM + wr * 64 + fr, colb = u.pn * BM + wc * 32 + 8 * fq;
        const float sc = (u.pn < 2) ? 0.125f : 1.0f;
#pragma unroll
        for (int ai = 0; ai < 2; ++ai)
#pragma unroll
            for (int m = 0; m < 4; ++m) {
                const int r = row0 + ai * HALF + m * 16;
                if (r < MTOT) {
#pragma unroll
                    for (int bj = 0; bj < 2; ++bj) {
                        const int c = colb + bj * HALF;
                        const f32x4 v0 = acc[ai][bj][m][0] * sc, v1 = acc[ai][bj][m][1] * sc;
                        *(u32x4*)(proj + (size_t)r * NPROJ + c) = pack8(v0, v1);
                        if (u.pn == 2 || u.pn == 3) { float* o = out + O_KV + (size_t)r * 512 + (c - C_KV); *(f32x4*)o = v0; *(f32x4*)(o + 4) = v1; }
                        if (u.pn == 4) {
                            const int cc = c - C_WIN; float* o = nullptr;
                            if (r < TP) { const int pos = r & (SEQ - 1), b = r >> 12; if (pos >= SEQ - 512) o = out + O_WINP + ((size_t)(b * 512 + pos - (SEQ - 512)) * 256 + cc); }
                            else { const int rs = r - TP, b = rs >> 2, i = rs & 3; o = out + O_WINS + ((size_t)(b * 512 + 508 + i) * 256 + cc); }
                            if (o) { *(f32x4*)o = v0; *(f32x4*)(o + 4) = v1; }
                        }
                    }
                }
            }
    }
};
struct EpiResid {
    static constexpr bool PERM = true, AFTER_DRAIN = false;
    const float* baseA; const float* baseB;
    float* hout; bf16_t* hb; float* rowss;
    __device__ __forceinline__ void operator()(const f32x4 (&acc)[2][2][4][2], const Unit& u, int wr, int wc, int fr, int fq) const {
        const int row0 = u.pm * BM + wr * 64 + fr, colb = u.pn * BM + wc * 32 + 8 * fq;
#pragma unroll
        for (int ai = 0; ai < 2; ++ai)
#pragma unroll
            for (int m = 0; m < 4; ++m) {
                const int r = row0 + ai * HALF + m * 16;
                float ss = 0.f;
                if (r < MTOT) {
                    const float* bp = (r < TP) ? baseA + (size_t)r * 1024 : baseB + (size_t)(r - TP) * 1024;
#pragma unroll
                    for (int bj = 0; bj < 2; ++bj) {
                        const int c = colb + bj * HALF;
                        const f32x4 v0 = acc[ai][bj][m][0] + *(const f32x4*)(bp + c), v1 = acc[ai][bj][m][1] + *(const f32x4*)(bp + c + 4);
                        float* o = hout + (size_t)r * 1024 + c; *(f32x4*)o = v0; *(f32x4*)(o + 4) = v1;
                        *(u32x4*)(hb + (size_t)r * 1024 + c) = pack8(v0, v1);
                        ss += (v0[0] * v0[0] + v0[1] * v0[1]) + (v0[2] * v0[2] + v0[3] * v0[3]) + (v1[0] * v1[0] + v1[1] * v1[1]) + (v1[2] * v1[2] + v1[3] * v1[3]);
                    }
                }
                ss += __shfl_xor(ss, 16); ss += __shfl_xor(ss, 32);
                if (fq == 0 && r < MTOT) atomicAdd(rowss + r, ss);
            }
    }
};
struct EpiGateUp {
    static constexpr bool PERM = true, AFTER_DRAIN = false;
    bf16_t* act; const float* rowss;
    __device__ __forceinline__ void operator()(const f32x4 (&acc)[2][2][4][2], const Unit& u, int wr, int wc, int fr, int fq) const {
        const int row0 = u.pm * BM + wr * 64 + fr, colb = u.pn * HALF + wc * 32 + 8 * fq;
#pragma unroll
        for (int ai = 0; ai < 2; ++ai)
#pragma unroll
            for (int m = 0; m < 4; ++m) {
                const int r = row0 + ai * HALF + m * 16;
                if (r < MTOT) {
                    const float rstd = __builtin_amdgcn_rsqf(rowss[r] * (1.0f / 1024.0f) + EPS);
                    f32x4 o[2];
#pragma unroll
                    for (int n = 0; n < 2; ++n)
#pragma unroll
                        for (int e = 0; e < 4; ++e) { const float g = acc[ai][0][m][n][e] * rstd, up = acc[ai][1][m][n][e] * rstd; o[n][e] = g * up * __builtin_amdgcn_rcpf(1.0f + __expf(-g)); }
                    *(u32x4*)(act + (size_t)r * DFF + colb) = pack8(o[0], o[1]);
                }
            }
    }
};
struct EpiBf {
    static constexpr bool PERM = true, AFTER_DRAIN = false;
    bf16_t* O; int ldc;
    __device__ __forceinline__ void operator()(const f32x4 (&acc)[2][2][4][2], const Unit& u, int wr, int wc, int fr, int fq) const {
        const int row0 = u.pm * BM + wr * 64 + fr, colb = u.pn * BM + wc * 32 + 8 * fq;
#pragma unroll
        for (int ai = 0; ai < 2; ++ai)
#pragma unroll
            for (int m = 0; m < 4; ++m) {
                const int r = row0 + ai * HALF + m * 16;
                if (r < MTOT) {
#pragma unroll
                    for (int bj = 0; bj < 2; ++bj) *(u32x4*)(O + (size_t)r * ldc + colb + bj * HALF) = pack8(acc[ai][bj][m][0], acc[ai][bj][m][1]);
                }
            }
    }
};
struct EpiPleGate {
    static constexpr bool PERM = true, AFTER_DRAIN = false;
    const float* h2; const bf16_t* ple; const float* rowss2; float* y; float* rowss3;
    __device__ __forceinline__ void operator()(const f32x4 (&acc)[2][2][4][2], const Unit& u, int wr, int wc, int fr, int fq) const {
        const int row0 = u.pm * BM + wr * 64 + fr, colb = u.pn * BM + wc * 32 + 8 * fq;
#pragma unroll
        for (int ai = 0; ai < 2; ++ai)
#pragma unroll
            for (int m = 0; m < 4; ++m) {
                const int r = row0 + ai * HALF + m * 16;
                float ss = 0.f;
                if (r < MTOT) {
                    const float rstd = __builtin_amdgcn_rsqf(rowss2[r] * (1.0f / 1024.0f) + EPS);
#pragma unroll
                    for (int bj = 0; bj < 2; ++bj) {
                        const int c = colb + bj * HALF;
                        const u32x4 pw = *(const u32x4*)(ple + (size_t)r * 1024 + c);
                        const f32x4 b0 = *(const f32x4*)(h2 + (size_t)r * 1024 + c), b1 = *(const f32x4*)(h2 + (size_t)r * 1024 + c + 4);
                        float pv[8];
#pragma unroll
                        for (int e = 0; e < 4; ++e) { pv[2 * e] = __uint_as_float(pw[e] << 16); pv[2 * e + 1] = __uint_as_float(pw[e] & 0xffff0000u); }
                        f32x4 v0, v1;
#pragma unroll
                        for (int e = 0; e < 4; ++e) {
                            v0[e] = b0[e] + pv[e] * __builtin_amdgcn_rcpf(1.0f + __expf(-acc[ai][bj][m][0][e] * rstd));
                            v1[e] = b1[e] + pv[4 + e] * __builtin_amdgcn_rcpf(1.0f + __expf(-acc[ai][bj][m][1][e] * rstd));
                        }
                        float* o = y + (size_t)r * 1024 + c; *(f32x4*)o = v0; *(f32x4*)(o + 4) = v1;
                        ss += (v0[0] * v0[0] + v0[1] * v0[1]) + (v0[2] * v0[2] + v0[3] * v0[3]) + (v1[0] * v1[0] + v1[1] * v1[1]) + (v1[2] * v1[2] + v1[3] * v1[3]);
                    }
                }
                ss += __shfl_xor(ss, 16); ss += __shfl_xor(ss, 32);
                if (fq == 0 && r < MTOT) atomicAdd(rowss3 + r, ss);
            }
    }
};
template <class Epi, class Sched, bool ALIGN_EPI = false, bool SP2 = false>
__device__ __forceinline__ void gemm_phase(PG8_LAS unsigned char* lds, const Gemm g, const Sched& S, const Epi& E, const int tid) {
    const int wid = __builtin_amdgcn_readfirstlane(tid >> 6), lane = tid & 63, wr = wid >> 2, wc = wid & 3, fr = lane & 15, fq = lane >> 4;
    const int K = g.K, nt = K / BK;
    unsigned voffA[2], voffB[2];
#pragma unroll
    for (int i = 0; i < 2; ++i) { int R, C; stage_rc(tid * 16 + i * 8192, R, C); const int Rb = Epi::PERM ? ((R & ~31) + perm32(R & 31)) : R;
        voffA[i] = (unsigned)(R * K + C) * 2u; voffB[i] = (unsigned)(Rb * K + C) * 2u; }
    const size_t kstep = (size_t)(BK * 2);
    const size_t hstep = (size_t)HALF * K * 2;
    const size_t tstep = 2 * hstep;
    const unsigned ldsw = (unsigned)wid * 1024u;
    const int aoff = lds_byte(wr * 64 + fr, fq * 8), boff = lds_byte(wc * 32 + fr, fq * 8);
#define PG8_SA(b, h) (((b) * 2 + (h)) * HTB)
#define PG8_SB(b, h) ((4 + (b) * 2 + (h)) * HTB)
#define PG8_STAGE(bufoff, gbase, voff) do { _Pragma("unroll") for (int _i = 0; _i < 2; ++_i) \
        __builtin_amdgcn_global_load_lds((const unsigned*)((const char*)(gbase) + (voff)[_i]), (PG8_LAS unsigned*)(lds + (bufoff) + ldsw + _i * 8192), 16, 0, 0); } while (0)
#define PG8_LDA(dst, b, h) do { _Pragma("unroll") for (int m = 0; m < 4; ++m) _Pragma("unroll") for (int k = 0; k < 2; ++k) dst[m][k] = *(const PG8_LAS bf16x8*)(lds + PG8_SA(b, h) + aoff + m * 2048 + k * 1024); } while (0)
#define PG8_LDB(dst, b, h) do { _Pragma("unroll") for (int n = 0; n < 2; ++n) _Pragma("unroll") for (int k = 0; k < 2; ++k) dst[n][k] = *(const PG8_LAS bf16x8*)(lds + PG8_SB(b, h) + boff + n * 2048 + k * 1024); } while (0)
#define PG8_MMA(ai, bj, At, Bt) do { __builtin_amdgcn_s_setprio(1); _Pragma("unroll") for (int m = 0; m < 4; ++m) _Pragma("unroll") for (int n = 0; n < 2; ++n) _Pragma("unroll") for (int k = 0; k < 2; ++k) \
        acc[ai][bj][m][n] = __builtin_amdgcn_mfma_f32_16x16x32_bf16(Bt[n][k], At[m][k], acc[ai][bj][m][n], 0, 0, 0); __builtin_amdgcn_s_setprio(0); } while (0)
#define PG8_WAIT_V(n) asm volatile("s_waitcnt vmcnt(" #n ")" ::: "memory")
#define PG8_WAIT_L(n) asm volatile("s_waitcnt lgkmcnt(" #n ")" ::: "memory")
#define PG8_BAR __builtin_amdgcn_s_barrier()
#define PG8_SCHED __builtin_amdgcn_sched_barrier(0)
    Unit cur, nxt; int ui = 0;
    if (!S.next(0, cur)) return;
    f32x4 acc[2][2][4][2];
#pragma unroll
    for (int a = 0; a < 2; ++a)
#pragma unroll
        for (int b = 0; b < 2; ++b)
#pragma unroll
            for (int m = 0; m < 4; ++m)
#pragma unroll
                for (int n = 0; n < 2; ++n) acc[a][b][m][n] = (f32x4){0.f, 0.f, 0.f, 0.f};
    bf16x8 At[4][2], B0[2][2], B1[2][2];
    const char* cA = (const char*)g.A + (size_t)cur.pm * tstep; const char* cB = (const char*)g.Bt + (size_t)cur.pn * tstep;
    S.a_ready(cur);
    if constexpr (SP2) {
        PG8_STAGE(PG8_SB(0, 0), cB, voffB); PG8_STAGE(PG8_SB(0, 1), cB + hstep, voffB); PG8_STAGE(PG8_SA(0, 0), cA, voffA); PG8_STAGE(PG8_SA(0, 1), cA + hstep, voffA);
        if (wr == 1) PG8_BAR;
        PG8_WAIT_V(2); PG8_BAR;
        PG8_STAGE(PG8_SB(1, 0), cB + kstep, voffB); PG8_STAGE(PG8_SA(1, 0), cA + kstep, voffA); PG8_STAGE(PG8_SB(1, 1), cB + hstep + kstep, voffB);
        PG8_WAIT_V(6); PG8_BAR;
    } else {
        PG8_STAGE(PG8_SB(0, 0), cB, voffB); PG8_STAGE(PG8_SA(0, 0), cA, voffA); PG8_STAGE(PG8_SB(0, 1), cB + hstep, voffB); PG8_STAGE(PG8_SA(0, 1), cA + hstep, voffA);
        if (wr == 1) PG8_BAR;
        PG8_WAIT_V(4); PG8_BAR;
        PG8_STAGE(PG8_SB(1, 0), cB + kstep, voffB); PG8_STAGE(PG8_SA(1, 0), cA + kstep, voffA); PG8_STAGE(PG8_SB(1, 1), cB + hstep + kstep, voffB);
        PG8_WAIT_V(6); PG8_BAR;
    }
    for (;;) {
        const bool has_next = S.next(ui + 1, nxt);
        const char* nA = has_next ? (const char*)g.A + (size_t)nxt.pm * tstep : cA; const char* nB = has_next ? (const char*)g.Bt + (size_t)nxt.pn * tstep : cB;
        for (int t = 0; t < nt; t += 2) {
            const bool last = (t == nt - 2);
            const char* a1 = cA + (size_t)(t + 1) * kstep;
            const char* a2 = last ? nA : cA + (size_t)(t + 2) * kstep; const char* b2 = last ? nB : cB + (size_t)(t + 2) * kstep;
            const char* a3 = a2 + kstep; const char* b3 = b2 + kstep;
            if (last && has_next) S.a_ready(nxt);
            if constexpr (SP2) {
            PG8_LDB(B0, 0, 0); PG8_LDB(B1, 0, 1); PG8_SCHED; PG8_LDA(At, 0, 0); PG8_STAGE(PG8_SA(1, 1), a1 + hstep, voffA);
            PG8_WAIT_V(8); PG8_WAIT_L(0); PG8_BAR; PG8_MMA(0, 0, At, B0); PG8_MMA(0, 1, At, B1); PG8_BAR; PG8_SCHED;
            PG8_LDA(At, 0, 1); PG8_STAGE(PG8_SB(0, 0), b2, voffB); PG8_STAGE(PG8_SB(0, 1), b2 + hstep, voffB); PG8_STAGE(PG8_SA(0, 0), a2, voffA);
            PG8_WAIT_V(8); PG8_WAIT_L(0); PG8_BAR; PG8_MMA(1, 0, At, B0); PG8_MMA(1, 1, At, B1); PG8_BAR; PG8_SCHED;
            PG8_LDB(B0, 1, 0); PG8_LDB(B1, 1, 1); PG8_SCHED; PG8_LDA(At, 1, 0); PG8_STAGE(PG8_SA(0, 1), a2 + hstep, voffA);
            PG8_WAIT_V(8); PG8_WAIT_L(0); PG8_BAR; PG8_MMA(0, 0, At, B0); PG8_MMA(0, 1, At, B1); PG8_BAR; PG8_SCHED;
            PG8_LDA(At, 1, 1); PG8_STAGE(PG8_SB(1, 0), b3, voffB); PG8_STAGE(PG8_SB(1, 1), b3 + hstep, voffB); PG8_STAGE(PG8_SA(1, 0), a3, voffA);
            PG8_WAIT_V(8); PG8_WAIT_L(0); PG8_BAR; PG8_MMA(1, 0, At, B0); PG8_MMA(1, 1, At, B1); PG8_BAR; PG8_SCHED;
            } else {
            PG8_LDB(B0, 0, 0); PG8_SCHED; PG8_LDA(At, 0, 0); PG8_STAGE(PG8_SA(1, 1), a1 + hstep, voffA);
            PG8_WAIT_L(8); PG8_BAR; PG8_WAIT_L(0); PG8_MMA(0, 0, At, B0); PG8_BAR; PG8_SCHED;
            PG8_LDB(B1, 0, 1); PG8_STAGE(PG8_SB(0, 0), b2, voffB);
            PG8_BAR; PG8_WAIT_L(0); PG8_MMA(0, 1, At, B1); PG8_BAR;
            PG8_LDA(At, 0, 1); PG8_STAGE(PG8_SA(0, 0), a2, voffA);
            PG8_BAR; PG8_WAIT_L(0); PG8_MMA(1, 0, At, B0); PG8_BAR; PG8_SCHED;
            PG8_STAGE(PG8_SB(0, 1), b2 + hstep, voffB);
            PG8_WAIT_V(6); PG8_BAR; PG8_MMA(1, 1, At, B1); PG8_BAR;
            PG8_LDB(B0, 1, 0); PG8_SCHED; PG8_LDA(At, 1, 0); PG8_STAGE(PG8_SA(0, 1), a2 + hstep, voffA);
            PG8_WAIT_L(8); PG8_BAR; PG8_WAIT_L(0); PG8_MMA(0, 0, At, B0); PG8_BAR; PG8_SCHED;
            PG8_LDB(B1, 1, 1); PG8_STAGE(PG8_SB(1, 0), b3, voffB);
            PG8_BAR; PG8_WAIT_L(0); PG8_MMA(0, 1, At, B1); PG8_BAR;
            PG8_LDA(At, 1, 1); PG8_STAGE(PG8_SA(1, 0), a3, voffA);
            PG8_BAR; PG8_WAIT_L(0); PG8_MMA(1, 0, At, B0); PG8_BAR; PG8_SCHED;
            PG8_STAGE(PG8_SB(1, 1), b3 + hstep, voffB);
            PG8_WAIT_V(6); PG8_BAR; PG8_MMA(1, 1, At, B1); PG8_BAR;
            }
        }
        if constexpr (ALIGN_EPI) { if (wr == 0) PG8_BAR; }
        if constexpr (!Epi::AFTER_DRAIN) { { const int l_ = ::hw_lane(); E(acc, cur, wr, wc, l_ & 15, l_ >> 4); } S.done(cur); }
        if (!has_next) break;
#pragma unroll
        for (int a = 0; a < 2; ++a)
#pragma unroll
            for (int b = 0; b < 2; ++b)
#pragma unroll
                for (int m = 0; m < 4; ++m)
#pragma unroll
                    for (int n = 0; n < 2; ++n) acc[a][b][m][n] = (f32x4){0.f, 0.f, 0.f, 0.f};
        cur = nxt; cA = nA; cB = nB; ++ui;
        if constexpr (ALIGN_EPI) { if (wr == 1) PG8_BAR; }
    }
    PG8_WAIT_V(0);
    if constexpr (!ALIGN_EPI) { if (wr == 0) PG8_BAR; }
    PG8_BAR;
    if constexpr (Epi::AFTER_DRAIN) { E.fused(acc, cur, wr, wc, fr, fq, lds, wid, lane); S.done(cur); }
#undef PG8_SA
#undef PG8_SB
#undef PG8_STAGE
#undef PG8_LDA
#undef PG8_LDB
#undef PG8_MMA
#undef PG8_WAIT_V
#undef PG8_WAIT_L
#undef PG8_BAR
#undef PG8_SCHED
}
}


#define GAS __attribute__((address_space(1)))
#define LAS __attribute__((address_space(3)))
typedef unsigned short bf16;
typedef unsigned v4u __attribute__((ext_vector_type(4)));
typedef unsigned v2u __attribute__((ext_vector_type(2)));
typedef float f32x4 __attribute__((ext_vector_type(4)));
typedef float f32x2 __attribute__((ext_vector_type(2)));
typedef float f32x16 __attribute__((ext_vector_type(16)));
typedef short bf16x8 __attribute__((ext_vector_type(8)));
typedef short s16x4 __attribute__((ext_vector_type(4)));
typedef GAS unsigned gu32;
#define RLX_AGENT __ATOMIC_RELAXED, __HIP_MEMORY_SCOPE_AGENT
#define LDS_WAIT() asm volatile("s_waitcnt lgkmcnt(0)" ::: "memory")
#define VM_WAIT() asm volatile("s_waitcnt vmcnt(0)" ::: "memory")
__device__ __forceinline__ unsigned f2bf(float f) { unsigned u = __builtin_bit_cast(unsigned, f); return (u + 0x7fffu + ((u >> 16) & 1u)) >> 16; }
__device__ __forceinline__ unsigned pk2(float lo, float hi) { return f2bf(lo) | (f2bf(hi) << 16); }
__device__ __forceinline__ float bf2f(unsigned short h) { return __uint_as_float(((unsigned)h) << 16); }
__device__ __forceinline__ float bflo(unsigned w) { return __uint_as_float(w << 16); }
__device__ __forceinline__ float bfhi(unsigned w) { return __uint_as_float(w & 0xffff0000u); }

constexpr int NWAVES = 8;
constexpr size_t MiB = 1u << 20;
constexpr size_t WS_CTL = 0, CTL_ZERO_BYTES = 1 * MiB;
constexpr int CW_BAR = 4096, CW_Q3 = 16384;
constexpr size_t WS_ROWSS = 256 * 1024;
constexpr size_t WS_WIN = 2 * MiB;
constexpr size_t WS_WO = 8 * MiB;
constexpr size_t WS_WGU = 10 * MiB;
constexpr size_t WS_WDN = 21 * MiB;
constexpr size_t WS_WPG = 27 * MiB;
constexpr size_t WS_WPLE = 29 * MiB;
constexpr size_t WS_WC1 = 30 * MiB;
constexpr size_t WS_WC2 = 31 * MiB;
constexpr size_t WS_C1 = 31 * MiB + 65536;
constexpr size_t WS_KCP = 32 * MiB;
constexpr size_t WS_VCP = 33 * MiB;
constexpr size_t WS_KCS = 34 * MiB;
constexpr size_t WS_VCS = 38 * MiB;
constexpr size_t WS_DSC = 42 * MiB;
constexpr size_t WS_USC = 43 * MiB;
constexpr size_t WS_QB = 51 * MiB;
constexpr size_t WS_XN = 64 * MiB;
constexpr size_t WS_PPLE = 97 * MiB;
constexpr size_t WS_PROJ = 106 * MiB;
constexpr size_t WS_OWIN = 204 * MiB;
constexpr size_t WS_MIX = 221 * MiB;
constexpr size_t WS_OLOC = 254 * MiB;
constexpr size_t WS_H1 = 287 * MiB;
constexpr size_t WS_H1B = 353 * MiB;
constexpr size_t WS_ACT = 386 * MiB;
constexpr size_t WS_H2 = 476 * MiB;
constexpr size_t WS_H2B = 542 * MiB;
constexpr size_t WS_PLEB = 575 * MiB;
constexpr size_t WS_END = 608 * MiB;
constexpr int RING_BYTES = 131072;
constexpr int MISC_OFF = RING_BYTES + 320;
constexpr int LDS_BYTES = 163840;
#define XB_TMO      128
#define XB_XCNT(j)  (256  + 64 * (j))
#define XB_XSUB(j)  (1280 + 64 * (j))
#define XB_XGEN(j)  (2304 + 64 * (j))
#define XB_TOP      3328
#define XB_TOPGEN   3392
#define XCD_BAR_WORDS 3456
#define XB_SPIN_CAP (1u << 18)

__device__ __forceinline__ unsigned xb_ld(unsigned* p)              { return __hip_atomic_load(p, __ATOMIC_RELAXED, __HIP_MEMORY_SCOPE_AGENT); }
__device__ __forceinline__ unsigned xb_add(unsigned* p, unsigned v) { return __hip_atomic_fetch_add(p, v, __ATOMIC_RELAXED, __HIP_MEMORY_SCOPE_AGENT); }
__device__ __forceinline__ unsigned xb_xcc_id() { return (unsigned)__builtin_amdgcn_s_getreg((3 << 11) | 20) & 0xFu; }
#define XB_SPIN(cond, bar) do { unsigned _sp = 0; while (cond) { __builtin_amdgcn_s_sleep(1); \
    if ((++_sp & 255u) == 0u) { if (xb_ld(&(bar)[XB_TMO])) break; if (_sp > XB_SPIN_CAP) { atomicAdd(&(bar)[XB_TMO], 1u); break; } } } } while (0)

struct XcdBarrier {
    unsigned* bar; unsigned x;
    volatile LAS unsigned* st;
};

__device__ __forceinline__ XcdBarrier xcd_barrier_post(unsigned* bar, volatile LAS unsigned* st, const int tid) {
    XcdBarrier b; b.bar = bar; b.x = xb_xcc_id(); b.st = st;
    if (tid == 0) (void)xb_add(&bar[XB_XCNT(b.x)], 1u);
    return b;
}
__device__ __forceinline__ void xcd_barrier_complete(unsigned* bar, unsigned x, unsigned& nloc, unsigned& nx) {
    const unsigned G = gridDim.x * gridDim.y * gridDim.z;
    unsigned sum, cnt, mine, sp = 0u;
    for (;;) {
        sum = 0u; cnt = 0u; mine = 0u;
#pragma unroll
        for (unsigned j = 0; j < 16; ++j) { const unsigned c = xb_ld(&bar[XB_XCNT(j)]); sum += c; cnt += (c > 0u) ? 1u : 0u; mine = (j == x) ? c : mine; }
        if (sum == G) break;
        __builtin_amdgcn_s_sleep(1);
        if ((++sp & 255u) == 0u) { if (xb_ld(&bar[XB_TMO])) break; if (sp > XB_SPIN_CAP) { atomicAdd(&bar[XB_TMO], 1u); break; } }
    }
    nloc = mine > 0u ? mine : 1u; nx = cnt > 0u ? cnt : 1u;
}

__device__ __forceinline__ void xcd_barrier(const XcdBarrier& b, const int tid) {
    asm volatile("s_waitcnt vmcnt(0)" ::: "memory");
    __syncthreads();
    if (tid == 0) {
        unsigned* bar = b.bar;
        __builtin_amdgcn_s_waitcnt(0);
        unsigned nloc = b.st[0], nx = b.st[1];
        if (nloc == 0u) { xcd_barrier_complete(bar, b.x, nloc, nx); b.st[0] = nloc; b.st[1] = nx; }
        const unsigned old = xb_add(&bar[XB_XSUB(b.x)], 1u);
        const unsigned gen = old / nloc;
        if (old + 1u == (gen + 1u) * nloc) {
            __builtin_amdgcn_fence(__ATOMIC_RELEASE, "agent");
            asm volatile("s_waitcnt vmcnt(0)" ::: "memory");
            const unsigned og = xb_add(&bar[XB_TOP], 1u);
            const unsigned tg = og / nx;
            if (og + 1u == (tg + 1u) * nx) xb_add(&bar[XB_TOPGEN], 1u);
            else XB_SPIN(xb_ld(&bar[XB_TOPGEN]) == tg, bar);
            __builtin_amdgcn_fence(__ATOMIC_ACQUIRE, "agent");
            xb_add(&bar[XB_XGEN(b.x)], 1u);
            asm volatile("s_waitcnt vmcnt(0)" ::: "memory");
        } else {
            XB_SPIN(xb_ld(&bar[XB_XGEN(b.x)]) == gen, bar);
            __builtin_amdgcn_fence(__ATOMIC_ACQUIRE, "agent");
            asm volatile("s_waitcnt vmcnt(0)" ::: "memory");
        }
    }
    __syncthreads();
}

struct Args { const float* in[26]; float* out; unsigned char* ws; int ph_lo, ph_hi; };
struct Frame {
    LAS unsigned char* lds;
    int tid, lane, wave, vcu, G;
};
__device__ __forceinline__ int opaque(int x) { asm volatile("" : "+v"(x)); return x; }
__device__ __forceinline__ float wave_sum(float v) {
#pragma unroll
    for (int o = 1; o < 64; o <<= 1) v += __shfl_xor(v, o);
    return v;
}
__device__ __forceinline__ void p0_tr_item(const float* W, int ldw, int K, int nsrc, int nblk, bf16* WT, int mode, const float* kscale, LAS float* scr, int item, int lane) {
    const int kb = item / nblk, nb = item % nblk, k0 = 64 * kb, n0 = 32 * nb;
    const int nn = n0 + (lane & 31);
#pragma unroll 16
    for (int i = 0; i < 32; ++i) { const int kk = 2 * i + (lane >> 5); float v = 0.f; if (nn < nsrc) { v = W[(size_t)(k0 + kk) * ldw + nn]; if (kscale) v *= kscale[k0 + kk]; } scr[kk * 33 + (lane & 31)] = v; }
    LDS_WAIT(); asm volatile("" ::: "memory");
    const int c = lane & 7;
#pragma unroll
    for (int j = 0; j < 4; ++j) { const int n = (lane >> 3) + 8 * j; const LAS float* s = scr + (8 * c) * 33 + n;
        v4u o; o.x = pk2(s[0 * 33], s[1 * 33]); o.y = pk2(s[2 * 33], s[3 * 33]); o.z = pk2(s[4 * 33], s[5 * 33]); o.w = pk2(s[6 * 33], s[7 * 33]);
        const int ng = n0 + n; const int drow = (mode == 0) ? ng : (256 * (ng >> 7) + (ng & 127) + (mode == 2 ? 128 : 0));
        *(GAS v4u*)(WT + (size_t)drow * K + k0 + 8 * c) = o; }
    LDS_WAIT(); asm volatile("" ::: "memory");
}
__device__ __forceinline__ void rms_row_to_bf16(const float* xrow, const float* g, bf16* orow, int lane) {
    const GAS f32x4* xr = (const GAS f32x4*)xrow + lane; const GAS f32x4* gr = (const GAS f32x4*)g + lane;
    f32x4 v[4]; float s = 0.f;
#pragma unroll
    for (int j = 0; j < 4; ++j) { v[j] = xr[64 * j]; s += (v[j].x * v[j].x + v[j].y * v[j].y) + (v[j].z * v[j].z + v[j].w * v[j].w); }
    const float rstd = 1.0f / sqrtf(wave_sum(s) * (1.f / DM) + EPS);
    GAS unsigned long long* o8 = (GAS unsigned long long*)orow + lane;
#pragma unroll
    for (int j = 0; j < 4; ++j) { const f32x4 gg = gr[64 * j];
        o8[64 * j] = (unsigned long long)pk2(v[j].x * rstd * gg.x, v[j].y * rstd * gg.y) | ((unsigned long long)pk2(v[j].z * rstd * gg.z, v[j].w * rstd * gg.w) << 32); }
}
__device__ __forceinline__ void p0_prologue(const Frame& F, const Args& A) {
    unsigned char* ws = A.ws;
    LAS float* scr = (LAS float*)(F.lds + F.wave * 16384);
    const int gw = F.vcu * NWAVES + F.wave, NGW = F.G * NWAVES, lane = F.lane;
    constexpr int I_IN = 16 * 96, I_O = 16 * 32, I_G = 16 * 88, I_D = 44 * 32, I_PG = 16 * 32, I_PL = 4 * 32, I_C1 = 128  , I_C2 = 2 * 1 * 2;
    constexpr int NITEMS = I_IN + I_O + 2 * I_G + I_D + I_PG + I_PL + I_C1 + I_C2;
    for (int it = gw; it < NITEMS; it += NGW) {
        int r = it;
        if (r < I_IN) { p0_tr_item(A.in[9], NIN, 1024, NIN, 96, (bf16*)(ws + WS_WIN), 0, nullptr, scr, r, lane); continue; } r -= I_IN;
        if (r < I_O) { p0_tr_item(A.in[16], 1024, 1024, 1024, 32, (bf16*)(ws + WS_WO), 0, nullptr, scr, r, lane); continue; } r -= I_O;
        if (r < I_G) { p0_tr_item(A.in[18], DFF, 1024, DFF, 88, (bf16*)(ws + WS_WGU), 1, A.in[17], scr, r, lane); continue; } r -= I_G;
        if (r < I_G) { p0_tr_item(A.in[19], DFF, 1024, DFF, 88, (bf16*)(ws + WS_WGU), 2, A.in[17], scr, r, lane); continue; } r -= I_G;
        if (r < I_D) { p0_tr_item(A.in[20], 1024, DFF, 1024, 32, (bf16*)(ws + WS_WDN), 0, nullptr, scr, r, lane); continue; } r -= I_D;
        if (r < I_PG) { p0_tr_item(A.in[23], 1024, 1024, 1024, 32, (bf16*)(ws + WS_WPG), 0, A.in[22], scr, r, lane); continue; } r -= I_PG;
        if (r < I_PL) { p0_tr_item(A.in[21], 1024, 256, 1024, 32, (bf16*)(ws + WS_WPLE), 0, nullptr, scr, r, lane); continue; } r -= I_PL;
        if (r < I_C1) {
#pragma unroll
            for (int q4 = 0; q4 < 4; ++q4) { const int ch = (r * 4 + q4) * 64 + lane; const int l = ch & 63, ks = (ch >> 6) & 63, ht = (ch >> 12) & 1, jj = (ch >> 13) & 1, slot = ch >> 14;
                const float* src = A.in[11] + ((size_t)slot * 2048 + jj * 1024 + 16 * ks + 8 * (l >> 5)) * 64 + 32 * ht + (l & 31);
                v4u o; o.x = pk2(src[0], src[64]); o.y = pk2(src[128], src[192]); o.z = pk2(src[256], src[320]); o.w = pk2(src[384], src[448]);
                *(GAS v4u*)((bf16*)(ws + WS_WC1) + (size_t)ch * 8) = o; }
            continue; } r -= I_C1;
        { const int slot = r / 2; p0_tr_item(A.in[12] + (size_t)slot * 64 * 64, 64, 64, 64, 2, (bf16*)(ws + WS_WC2) + (size_t)slot * 64 * 64, 0, nullptr, scr, r % 2, lane); }
    }
    if (F.vcu < 2) { const int slot = F.vcu; const float* pe = A.in[10] + slot * 2048 + F.wave * 256; const float* w1 = A.in[11] + (size_t)slot * 2048 * 64 + (size_t)F.wave * 256 * 64; float a = 0.f;
#pragma unroll 16
        for (int k = 0; k < 256; ++k) a += pe[k] * w1[k * 64 + lane];
        ((LAS float*)(F.lds + F.wave * 16384 + 12288))[lane] = a; __syncthreads();
        if (F.wave == 0) { float t = 0.f;
#pragma unroll
            for (int w = 0; w < 8; ++w) t += ((LAS float*)(F.lds + w * 16384 + 12288))[lane];
            ((float*)(ws + WS_C1))[slot * 64 + lane] = t; }
    }
    bf16* XN = (bf16*)(ws + WS_XN);
    for (int m0 = gw; m0 < MPAD; m0 += 2 * NGW) {
        f32x4 v[2][4];
#pragma unroll
        for (int q = 0; q < 2; ++q) { const int m = m0 + q * NGW; if (m < MTOT) { const GAS f32x4* xr = (const GAS f32x4*)((m < TP) ? A.in[0] + (size_t)m * DM : A.in[1] + (size_t)(m - TP) * DM) + lane;
#pragma unroll
            for (int j = 0; j < 4; ++j) v[q][j] = xr[64 * j]; } else {
#pragma unroll
            for (int j = 0; j < 4; ++j) v[q][j] = (f32x4){0.f, 0.f, 0.f, 0.f}; } }
#pragma unroll
        for (int q = 0; q < 2; ++q) { const int m = m0 + q * NGW; if (m < MPAD) {
            float s = 0.f;
#pragma unroll
            for (int j = 0; j < 4; ++j) s += (v[q][j].x * v[q][j].x + v[q][j].y * v[q][j].y) + (v[q][j].z * v[q][j].z + v[q][j].w * v[q][j].w);
            const float rstd = 1.0f / sqrtf(wave_sum(s) * (1.f / DM) + EPS);
            GAS unsigned long long* o8 = (GAS unsigned long long*)(XN + (size_t)m * DM) + lane; const GAS f32x4* gr = (const GAS f32x4*)A.in[8] + lane;
#pragma unroll
            for (int j = 0; j < 4; ++j) { const f32x4 gg = gr[64 * j];
                o8[64 * j] = (unsigned long long)pk2(v[q][j].x * rstd * gg.x, v[q][j].y * rstd * gg.y) | ((unsigned long long)pk2(v[q][j].z * rstd * gg.z, v[q][j].w * rstd * gg.w) << 32); } } }
    }
    bf16* PP = (bf16*)(ws + WS_PPLE);
    for (int m0 = gw; m0 < MPAD; m0 += 4 * NGW) {
        f32x4 v[4];
#pragma unroll
        for (int q = 0; q < 4; ++q) { const int m = m0 + q * NGW; v[q] = (f32x4){0.f, 0.f, 0.f, 0.f}; if (m < MTOT) v[q] = ((const GAS f32x4*)((m < TP) ? A.in[6] + (size_t)m * DPLE : A.in[7] + (size_t)(m - TP) * DPLE))[lane]; }
#pragma unroll
        for (int q = 0; q < 4; ++q) { const int m = m0 + q * NGW; if (m < MPAD) { v2u o; o.x = pk2(v[q].x, v[q].y); o.y = pk2(v[q].z, v[q].w); ((GAS v2u*)(PP + (size_t)m * DPLE))[lane] = o;
            if (m >= MTOT) { GAS v4u* z = (GAS v4u*)((bf16*)(ws + WS_MIX) + (size_t)m * DM) + lane; z[0] = (v4u){0, 0, 0, 0}; z[64] = (v4u){0, 0, 0, 0}; } } }
    }
    for (int it0 = gw; it0 < DBATCH * 508; it0 += 4 * NGW) {
        f32x4 v[4];
#pragma unroll
        for (int q = 0; q < 4; ++q) { const int it = it0 + q * NGW; if (it < DBATCH * 508) { const int b = it / 508, r = it % 508; v[q] = ((const GAS f32x4*)(A.in[3] + (size_t)(b * 512 + r + 4) * 256))[lane]; } }
#pragma unroll
        for (int q = 0; q < 4; ++q) { const int it = it0 + q * NGW; if (it < DBATCH * 508) { const int b = it / 508, r = it % 508; ((GAS f32x4*)(A.out + O_WINS + (size_t)(b * 512 + r) * 256))[lane] = v[q]; } }
    }
}

constexpr float LOG2E = 1.4426950408889634f;
typedef short v4i16_t __attribute__((ext_vector_type(4)));
__device__ __forceinline__ s16x4 vtr(LAS const unsigned char* p) { return __builtin_bit_cast(s16x4, __builtin_amdgcn_ds_read_tr16_b64_v4i16((LAS v4i16_t*)p)); }
__device__ __forceinline__ unsigned cvtpk(float lo, float hi) { typedef float f2 __attribute__((ext_vector_type(2))); typedef __bf16 b2 __attribute__((ext_vector_type(2))); f2 v = {lo, hi}; b2 b = __builtin_convertvector(v, b2); return __builtin_bit_cast(unsigned, b); }
__device__ __forceinline__ int t5_bucket(int n) {
    if (n < 16) return n;
    const int large = 16 + (int)(logf((float)n / 16.0f) / 2.0794415416798357f * 16.0f);
    return large < 31 ? large : 31;
}
constexpr int HI_BASE = 131072 + 512, AT_LUT = HI_BASE, HI_IMPA = AT_LUT + 4096, HI_IMPB = HI_IMPA + 2176, HI_SEL = HI_IMPB + 2176, HI_SCS = HI_SEL + 128, HI_TL = HI_SCS + 512, HI_XCH = HI_TL + 512, HI_Q = HI_XCH + 8192, HI_END = HI_Q + 64;
constexpr int AT_K0 = 0, AT_V0 = 16384, AT_ST = 32768  , AT_IMPA = 65536, AT_IMPB = AT_IMPA + 64 * 65 * 4 + 64, AT_SEL = AT_IMPB + 64 * 65 * 4 + 64, AT_MISC = AT_SEL + 1024, AT_QF = ((AT_MISC + 4096 + 1023) / 1024) * 1024, AT_END = AT_QF + 32768;
struct AttnLane {
    int koff;
    int kx;
    int voff0, voff1;
    int r32, h;
};
__device__ __forceinline__ AttnLane attn_lane(int lane) {
    AttnLane L; L.r32 = lane & 31; L.h = lane >> 5; L.koff = L.r32 * 128; L.kx = (L.r32 >> 1) & 7;
    const int i16 = lane & 15, q = i16 >> 2, p = i16 & 3, g1 = (lane >> 4) & 1;
    const int base = (4 * L.h + q) * 128 + g1 * 32 + (p >> 1) * 16 + (p & 1) * 8;
    L.voff0 = base + ((q >> 1) * 64); L.voff1 = base + (((q >> 1) ^ 1) * 64);
    return L;
}
__device__ __forceinline__ void attn_fill_lut(LAS float* lut, const float* rel_bias, int tid) {
    for (int e = tid; e < 1024; e += NWAVES * 64) { const int dist = e >> 3, hd = e & 7; lut[e] = rel_bias[t5_bucket(dist) * 8 + hd] * LOG2E; }
}
__device__ __forceinline__ void attn_commit(LAS unsigned char* kb, LAS unsigned char* vb, int tid, v4u k, v4u v) {
    const int row = tid >> 3, ch = tid & 7;
    *(LAS v4u*)(kb + row * 128 + ((ch ^ ((row >> 1) & 7)) << 4)) = k;
    *(LAS v4u*)(vb + row * 128 + ((ch ^ (((row >> 1) & 1) << 2)) << 4)) = v;
}
__device__ __forceinline__ f32x16 attn_qk(LAS const unsigned char* kb, int hf, const AttnLane& L, const bf16x8 (&qf)[4]) {
    f32x16 s = {};
#pragma unroll
    for (int ks = 0; ks < 4; ++ks) { const bf16x8 kf = *(LAS const bf16x8*)(kb + hf * 4096 + L.koff + (((2 * ks + L.h) ^ L.kx) << 4)); s = __builtin_amdgcn_mfma_f32_32x32x16_bf16(kf, qf[ks], s, 0, 0, 0); }
    return s;
}
__device__ __forceinline__ void attn_pv(LAS const unsigned char* vb, int hf, const AttnLane& L, const f32x16& p, f32x16 (&o)[2]) {
#pragma unroll
    for (int s = 0; s < 2; ++s) {
        v4u pw; pw.x = cvtpk(p[8 * s + 0], p[8 * s + 1]); pw.y = cvtpk(p[8 * s + 2], p[8 * s + 3]); pw.z = cvtpk(p[8 * s + 4], p[8 * s + 5]); pw.w = cvtpk(p[8 * s + 6], p[8 * s + 7]);
        const bf16x8 pb = __builtin_bit_cast(bf16x8, pw);
        const int rb = (32 * hf + 16 * s) * 128;
        { const s16x4 lo = vtr(vb + rb + L.voff0), hi = vtr(vb + rb + 1024 + L.voff0); const bf16x8 vf = {lo[0], lo[1], lo[2], lo[3], hi[0], hi[1], hi[2], hi[3]};
          o[0] = __builtin_amdgcn_mfma_f32_32x32x16_bf16(vf, pb, o[0], 0, 0, 0); }
        { const s16x4 lo = vtr(vb + rb + L.voff1), hi = vtr(vb + rb + 1024 + L.voff1); const bf16x8 vf = {lo[0], lo[1], lo[2], lo[3], hi[0], hi[1], hi[2], hi[3]};
          o[1] = __builtin_amdgcn_mfma_f32_32x32x16_bf16(vf, pb, o[1], 0, 0, 0); }
    }
}
__device__ __forceinline__ float max16(const f32x16& a) {
    float m0 = fmaxf(fmaxf(a[0], a[1]), fmaxf(a[2], a[3])), m1 = fmaxf(fmaxf(a[4], a[5]), fmaxf(a[6], a[7])), m2 = fmaxf(fmaxf(a[8], a[9]), fmaxf(a[10], a[11])), m3 = fmaxf(fmaxf(a[12], a[13]), fmaxf(a[14], a[15]));
    return fmaxf(fmaxf(m0, m1), fmaxf(m2, m3));
}
__device__ __forceinline__ float sum16(const f32x16& a) {
    return ((a[0] + a[1]) + (a[2] + a[3])) + ((a[4] + a[5]) + (a[6] + a[7])) + (((a[8] + a[9]) + (a[10] + a[11])) + ((a[12] + a[13]) + (a[14] + a[15])));
}
__device__ __forceinline__ float xmax32(float v) { const auto rr = __builtin_amdgcn_permlane32_swap(__float_as_uint(v), __float_as_uint(v), false, false); return fmaxf(__uint_as_float(rr[0]), __uint_as_float(rr[1])); }
__device__ __forceinline__ float xsum32(float v) { const auto rr = __builtin_amdgcn_permlane32_swap(__float_as_uint(v), __float_as_uint(v), false, false); return __uint_as_float(rr[0]) + __uint_as_float(rr[1]); }
__device__ __forceinline__ void attn_softmax_pv(LAS const unsigned char* vb, const AttnLane& L, f32x16& t0, f32x16& t1, float& m, float& lh, f32x16 (&o)[2]) {
    const float tm = xmax32(fmaxf(max16(t0), max16(t1)));
    if (__any(tm > m + 8.0f)) {
        const float mn = fmaxf(m, tm), mu0 = (mn == -INFINITY) ? 0.f : mn;
        const float alpha = __builtin_amdgcn_exp2f(m - mu0);
#pragma unroll
        for (int r = 0; r < 16; ++r) { o[0][r] *= alpha; o[1][r] *= alpha; }
        lh *= alpha; m = mn;
    }
    const float mu = (m == -INFINITY) ? 0.f : m;
#pragma unroll
    for (int r = 0; r < 16; ++r) { t0[r] = __builtin_amdgcn_exp2f(t0[r] - mu); t1[r] = __builtin_amdgcn_exp2f(t1[r] - mu); }
    lh += sum16(t0) + sum16(t1);
    attn_pv(vb, 0, L, t0, o); attn_pv(vb, 1, L, t1, o);
}
__device__ __forceinline__ void attn_softmax_pv2(LAS const unsigned char* vbA, LAS const unsigned char* vbB, const AttnLane& L, f32x16& a0, f32x16& a1, f32x16& b0, f32x16& b1, float& m, float& lh, f32x16 (&o)[2]) {
    const float tm = xmax32(fmaxf(fmaxf(max16(a0), max16(a1)), fmaxf(max16(b0), max16(b1))));
    if (__any(tm > m + 8.0f)) {
        const float mn = fmaxf(m, tm), mu0 = (mn == -INFINITY) ? 0.f : mn;
        const float alpha = __builtin_amdgcn_exp2f(m - mu0);
#pragma unroll
        for (int r = 0; r < 16; ++r) { o[0][r] *= alpha; o[1][r] *= alpha; }
        lh *= alpha; m = mn;
    }
    const float mu = (m == -INFINITY) ? 0.f : m;
#pragma unroll
    for (int r = 0; r < 16; ++r) { a0[r] = __builtin_amdgcn_exp2f(a0[r] - mu); a1[r] = __builtin_amdgcn_exp2f(a1[r] - mu); }
    attn_pv(vbA, 0, L, a0, o); attn_pv(vbA, 1, L, a1, o);
#pragma unroll
    for (int r = 0; r < 16; ++r) { b0[r] = __builtin_amdgcn_exp2f(b0[r] - mu); b1[r] = __builtin_amdgcn_exp2f(b1[r] - mu); }
    lh += (sum16(a0) + sum16(a1)) + (sum16(b0) + sum16(b1));
    attn_pv(vbB, 0, L, b0, o); attn_pv(vbB, 1, L, b1, o);
}
#define KEYIDX(hf, reg, h) (32 * (hf) + ((reg) & 3) + 8 * ((reg) >> 2) + 4 * (h))
__device__ __forceinline__ void score_far(f32x16& t0, f32x16& t1, float cb) {
#pragma unroll
    for (int r = 0; r < 16; ++r) { t0[r] = fmaf(t0[r], LOG2E, cb); t1[r] = fmaf(t1[r], LOG2E, cb); }
}
__device__ __forceinline__ void score_near1(f32x16& t, int hf, int h, LAS const float* lut, int hd, int dbase, int dstep, int dmax, int klim, bool colok) {
#pragma unroll
    for (int r = 0; r < 16; ++r) {
        const int ki = KEYIDX(hf, r, h); const int dist = dbase - dstep * ki; const int di = dist < 0 ? 0 : (dist > 127 ? 127 : dist); const float bv = lut[di * 8 + hd];
        const bool ok = colok && dist >= 0 && dist < dmax && ki < klim; const float v = fmaf(t[r], LOG2E, bv); t[r] = ok ? v : -INFINITY; }
}
__device__ __forceinline__ void score_near(f32x16& t0, f32x16& t1, int h, LAS const float* lut, int hd, int dbase, int dstep, int dmax, int klim, bool colok) {
    score_near1(t0, 0, h, lut, hd, dbase, dstep, dmax, klim, colok);
    __builtin_amdgcn_sched_barrier(0);
    score_near1(t1, 1, h, lut, hd, dbase, dstep, dmax, klim, colok);
    __builtin_amdgcn_sched_barrier(0);
}

template <int VAR>
__device__ __forceinline__ void win_unit(const Frame& F, const Args& A, LAS unsigned char* sh, int b, int g, int qb) {
    const bf16* PROJ = (const bf16*)(A.ws + WS_PROJ);
    const int lane = hw_lane(), w = F.wave, tid = w * 64 + lane;
    const AttnLane L = attn_lane(lane);
    const int tq = 64 * qb + 8 * w + (L.r32 >> 2), hd = g * 4 + (L.r32 & 3);
    const size_t tokq = (size_t)b * SEQ + tq;
    bf16x8 qf[4];
#pragma unroll
    for (int ks = 0; ks < 4; ++ks) qf[ks] = *(const bf16x8*)(PROJ + tokq * NPROJ + C_QN + hd * 64 + 16 * ks + 8 * L.h);
    LAS const float* lut = (LAS const float*)(sh + AT_LUT);
    const float bfar = lut[127 * 8 + hd];
    const int kt0 = qb >= 8 ? qb - 8 : 0, nt = qb - kt0 + 1;
    const int srow = tid >> 3, sch = tid & 7;
    const bf16* ksrc = PROJ + ((size_t)b * SEQ + srow) * NPROJ + C_WIN + g * 64 + sch * 8;
    v4u kr, vr;
#define WIN_LOAD(i) do { if (VAR != 5) { kr = *(const v4u*)(ksrc + (size_t)(64 * (kt0 + (i))) * NPROJ); vr = *(const v4u*)(ksrc + (size_t)(64 * (kt0 + (i))) * NPROJ + 128); } } while (0)
#define WIN_SCORE(T0, T1, kt) do { if (VAR == 2) break; if ((kt) <= qb - 3 && (kt) >= qb - 7) score_far(T0, T1, bfar); else score_near(T0, T1, L.h, lut, hd, tq - 64 * (kt), 1, 512, 64, true); } while (0)
    WIN_LOAD(0);
    __syncthreads();
    attn_commit(sh, sh + 8192, tid, kr, vr);
    if (nt > 1) { WIN_LOAD(1); attn_commit(sh + 16384, sh + 16384 + 8192, tid, kr, vr); }
    __syncthreads();
    float m = -INFINITY, l = 0.f; f32x16 o[2]; o[0] = f32x16{}; o[1] = f32x16{};
    f32x16 c0 = attn_qk(sh, 0, L, qf), c1 = attn_qk(sh, 1, L, qf), n0 = c0, n1 = c1;
    WIN_SCORE(c0, c1, kt0);
    int s_cur = 0, s_nxt = 16384, s_fill = 32768;
#define WIN_STEP(i, C0, C1, N0, N1) do { \
        if ((i) + 2 < nt) WIN_LOAD((i) + 2); \
        if ((i) + 1 < nt && VAR != 4) { N0 = attn_qk(sh + s_nxt, 0, L, qf); N1 = attn_qk(sh + s_nxt, 1, L, qf); } \
        if (VAR == 2) { attn_pv(sh + s_cur + 8192, 0, L, C0, o); attn_pv(sh + s_cur + 8192, 1, L, C1, o); } \
        else if (VAR == 3) { float m_ = m, l_ = l; f32x16 od_[2] = {o[0], o[1]}; (void)od_; const float tm_ = xmax32(fmaxf(max16(C0), max16(C1))); m_ = fmaxf(m_, tm_); _Pragma("unroll") for (int r_ = 0; r_ < 16; ++r_) { C0[r_] = __builtin_amdgcn_exp2f(C0[r_] - m_); C1[r_] = __builtin_amdgcn_exp2f(C1[r_] - m_); } l_ += sum16(C0) + sum16(C1); m = m_; l = l_; o[0][0] += C0[3] + C1[5]; } \
        else attn_softmax_pv(sh + s_cur + 8192, L, C0, C1, m, l, o); \
        if ((i) + 1 < nt) WIN_SCORE(N0, N1, kt0 + (i) + 1); \
        if ((i) + 2 < nt && VAR != 5) attn_commit(sh + s_fill, sh + s_fill + 8192, tid, kr, vr); \
        if (VAR != 5) __syncthreads(); \
        { const int t_ = s_cur; s_cur = s_nxt; s_nxt = s_fill; s_fill = t_; } } while (0)
#pragma unroll 1
    for (int i = 0; i < nt; i += 2) {
        WIN_STEP(i, c0, c1, n0, n1);
        if (i + 1 < nt) WIN_STEP(i + 1, n0, n1, c0, c1);
    }
#undef WIN_STEP
#undef WIN_LOAD
#undef WIN_SCORE
    const float rl = __builtin_amdgcn_rcpf(xsum32(l));
    bf16* dst = (bf16*)(A.ws + (VAR == 0 ? WS_OWIN : WS_END + (2u << 20))) + tokq * 512 + hd * 64;
#pragma unroll
    for (int dt = 0; dt < 2; ++dt)
#pragma unroll
        for (int rq = 0; rq < 4; ++rq) { v2u wv; wv.x = cvtpk(o[dt][4 * rq] * rl, o[dt][4 * rq + 1] * rl); wv.y = cvtpk(o[dt][4 * rq + 2] * rl, o[dt][4 * rq + 3] * rl);
            *(v2u*)(dst + 32 * dt + 8 * rq + 4 * L.h) = wv; }
}

__device__ __forceinline__ void nsa_unit(const Frame& F, const Args& A, LAS unsigned char* sh, int b, int g, int qb) {
    const bf16* PROJ = (const bf16*)(A.ws + WS_PROJ);
    const int lane = hw_lane(), w = F.wave, tid = w * 64 + lane;
    const AttnLane L = attn_lane(lane);
    const int qloc = 8 * w + (L.r32 >> 2);
    const int tq = 64 * qb + qloc, hd = g * 4 + (L.r32 & 3);
    const size_t tokq = (size_t)b * SEQ + tq;
    bf16x8 qf[4];
#pragma unroll
    for (int ks = 0; ks < 4; ++ks) qf[ks] = *(const bf16x8*)(PROJ + tokq * NPROJ + C_QN + hd * 64 + 16 * ks + 8 * L.h);
#define NSA_LOADQ() do {} while (0)
    LAS const float* lut = (LAS const float*)(sh + AT_LUT);
    const float bfar = lut[127 * 8 + hd];
    LAS float* impA = (LAS float*)(sh + AT_IMPA); LAS float* impB = (LAS float*)(sh + AT_IMPB);
    LAS unsigned long long* selm = (LAS unsigned long long*)(sh + AT_SEL);
    const int srow = tid >> 3, sch = tid & 7;
    v4u kr, vr;
    const int nct = (4 * qb + 3 + 63) >> 6;
    const bf16* kcs = (const bf16*)(A.ws + WS_KCP) + ((size_t)(b * 256 + srow) * 2 + g) * 64 + sch * 8;
    const bf16* vcs = (const bf16*)(A.ws + WS_VCP) + ((size_t)(b * 256 + srow) * 2 + g) * 64 + sch * 8;
    __syncthreads();
    for (int e = tid; e < 64 * 65; e += NWAVES * 64) { impA[e] = 0.f; impB[e] = 0.f; }
    float mc = -INFINITY, lc = 0.f;
#pragma unroll 1
    for (int pass = 0; pass < 2; ++pass) {
        kr = *(const v4u*)(kcs); vr = *(const v4u*)(vcs);
        __syncthreads();
        attn_commit(sh + AT_K0, sh + AT_V0, tid, kr, vr);
        __syncthreads();
        const float mu = (mc == -INFINITY) ? 0.f : mc, il = lc > 0.f ? __builtin_amdgcn_rcpf(lc) : 0.f;
#pragma unroll 1
        for (int ct = 0; ct < nct; ++ct) {
            const int buf = ct & 1;
            if (ct + 1 < nct) { kr = *(const v4u*)(kcs + (size_t)(64 * (ct + 1)) * 128); vr = *(const v4u*)(vcs + (size_t)(64 * (ct + 1)) * 128); }
            LAS const unsigned char* kb = sh + AT_K0 + buf * 8192; LAS const unsigned char* vb = sh + AT_V0 + buf * 8192;
            NSA_LOADQ();
            f32x16 t0 = attn_qk(kb, 0, L, qf), t1 = attn_qk(kb, 1, L, qf);
            score_near(t0, t1, L.h, lut, hd, tq - 31 - 1024 * ct, 16, 1 << 30, 255 - 64 * ct, true);
            if (pass == 0) {
                const float tm = xmax32(fmaxf(max16(t0), max16(t1)));
                const float mn = fmaxf(mc, tm), mu0 = (mn == -INFINITY) ? 0.f : mn;
                const float alpha = __builtin_amdgcn_exp2f(mc - mu0);
                float ps = 0.f;
#pragma unroll
                for (int r = 0; r < 16; ++r) ps += __builtin_amdgcn_exp2f(t0[r] - mu0) + __builtin_amdgcn_exp2f(t1[r] - mu0);
                ps = xsum32(ps);
                lc = lc * alpha + ps; mc = mn;
            } else {
#pragma unroll
                for (int r = 0; r < 16; ++r) { t0[r] = __builtin_amdgcn_exp2f(t0[r] - mu) * il; t1[r] = __builtin_amdgcn_exp2f(t1[r] - mu) * il; }
#pragma unroll
                for (int hf = 0; hf < 2; ++hf) {
                    float x[16];
#pragma unroll
                    for (int r = 0; r < 16; ++r) { float v = hf ? t1[r] : t0[r]; v += __shfl_xor(v, 1); v += __shfl_xor(v, 2); x[r] = v; }
                    if ((L.r32 & 3) == 0) {
#pragma unroll
                        for (int rq = 0; rq < 4; ++rq) { const int jq = 16 * ct + 8 * hf + 2 * rq + L.h;
                            impA[qloc * 65 + jq] = 2.0f * (x[4 * rq] + x[4 * rq + 1] + x[4 * rq + 2]) + x[4 * rq + 3];
                            impB[qloc * 65 + jq + 1] = x[4 * rq + 3]; }
                    }
                }
            }
            if (ct + 1 < nct) attn_commit(sh + AT_K0 + (buf ^ 1) * 8192, sh + AT_V0 + (buf ^ 1) * 8192, tid, kr, vr);
            __syncthreads();
        }
    }
#pragma unroll 1
    for (int qi = 0; qi < 8; ++qi) {
        const int q = 8 * w + qi;
        unsigned long long mk;
        if (qb < 16) mk = (2ull << qb) - 1ull;
        else {
            const bool forced = (lane == 0) || (lane == qb) || (lane == qb - 1);
            const float sc = forced ? 1e9f : (lane <= qb ? impA[q * 65 + lane] + impB[q * 65 + lane] : -1.0f);
            int rank = 0;
#pragma unroll 8
            for (int jj = 0; jj < 64; ++jj) { const float ov = __uint_as_float(__builtin_amdgcn_readlane(__float_as_uint(sc), jj)); rank += ((ov > sc) || (ov == sc && jj < lane)) ? 1 : 0; }
            mk = __ballot(rank < 16 && lane <= qb);
        }
        if (lane == 0) selm[q] = mk;
    }
    __syncthreads();
    const unsigned long long mysel = selm[qloc];
    unsigned long long um = 0ull;
#pragma unroll 8
    for (int q_ = 0; q_ < 64; ++q_) um |= selm[q_];
    um = ((unsigned long long)__builtin_amdgcn_readfirstlane((unsigned)(um >> 32)) << 32) | (unsigned long long)__builtin_amdgcn_readfirstlane((unsigned)um);
    const bf16* ksrc = PROJ + ((size_t)b * SEQ + srow) * NPROJ + C_KV + 2 * 128 + g * 64 + sch * 8;
    float m = -INFINITY, l = 0.f; f32x16 o[2]; o[0] = f32x16{}; o[1] = f32x16{};
    v4u krb, vrb;
    int ja, jb;
#define SLC_NEXT(JA, JB) do { JA = um ? __builtin_ctzll(um) : -1; um &= um - 1; JB = um ? __builtin_ctzll(um) : -1; um &= um - 1; } while (0)
#define SLC_LOAD(JA, JB) do { const int jb_ = (JB) >= 0 ? (JB) : (JA); \
        kr = *(const v4u*)(ksrc + (size_t)(64 * (JA)) * NPROJ); vr = *(const v4u*)(ksrc + (size_t)(64 * (JA)) * NPROJ + 128); \
        krb = *(const v4u*)(ksrc + (size_t)(64 * jb_) * NPROJ); vrb = *(const v4u*)(ksrc + (size_t)(64 * jb_) * NPROJ + 128); } while (0)
#define SLC_COMMIT(buf) do { attn_commit(sh + (buf) * AT_ST, sh + (buf) * AT_ST + 8192, tid, kr, vr); attn_commit(sh + (buf) * AT_ST + 16384, sh + (buf) * AT_ST + 24576, tid, krb, vrb); } while (0)
    SLC_NEXT(ja, jb);
    SLC_LOAD(ja, jb);
    SLC_COMMIT(0);
    __syncthreads();
    int buf = 0;
#pragma unroll 1
    for (;;) {
        int na, nb; SLC_NEXT(na, nb);
        if (na >= 0) SLC_LOAD(na, nb);
        LAS const unsigned char* sb = sh + buf * AT_ST;
        const bool sela = (mysel >> ja) & 1ull, selb = jb >= 0 && ((mysel >> jb) & 1ull);
        if (__any(sela || selb)) {
            f32x16 a0 = attn_qk(sb, 0, L, qf), a1 = attn_qk(sb, 1, L, qf), b0 = attn_qk(sb + 16384, 0, L, qf), b1 = attn_qk(sb + 16384, 1, L, qf);
            if (ja <= qb - 3) score_far(a0, a1, sela ? bfar : -INFINITY); else score_near(a0, a1, L.h, lut, hd, tq - 64 * ja, 1, 1 << 30, 64, sela);
            if (jb <= qb - 3) score_far(b0, b1, selb ? bfar : -INFINITY); else score_near(b0, b1, L.h, lut, hd, tq - 64 * jb, 1, 1 << 30, 64, selb);
            attn_softmax_pv2(sb + 8192, sb + 24576, L, a0, a1, b0, b1, m, l, o);
        }
        if (na >= 0) SLC_COMMIT(buf ^ 1);
        __syncthreads();
        if (na < 0) break;
        ja = na; jb = nb; buf ^= 1;
    }
#undef SLC_NEXT
#undef SLC_LOAD
#undef SLC_COMMIT
    const bf16* gp = PROJ + tokq * NPROJ + C_GT + hd;
    const float g0 = __builtin_amdgcn_rcpf(1.0f + __expf(-bf2f(gp[0]))), g1 = __builtin_amdgcn_rcpf(1.0f + __expf(-bf2f(gp[8]))), g2 = __builtin_amdgcn_rcpf(1.0f + __expf(-bf2f(gp[16])));
    const float rl = g1 * __builtin_amdgcn_rcpf(xsum32(l));
    const bf16* ow = (const bf16*)(A.ws + WS_OWIN) + tokq * 512 + hd * 64;
#pragma unroll
    for (int dt = 0; dt < 2; ++dt)
#pragma unroll
        for (int rq = 0; rq < 4; ++rq) { const int d0 = 32 * dt + 8 * rq + 4 * L.h; const v2u wv = *(const v2u*)(ow + d0);
            o[dt][4 * rq] = rl * o[dt][4 * rq] + g2 * bflo(wv.x); o[dt][4 * rq + 1] = rl * o[dt][4 * rq + 1] + g2 * bfhi(wv.x);
            o[dt][4 * rq + 2] = rl * o[dt][4 * rq + 2] + g2 * bflo(wv.y); o[dt][4 * rq + 3] = rl * o[dt][4 * rq + 3] + g2 * bfhi(wv.y); }
    {
        const float mu = (mc == -INFINITY) ? 0.f : mc, il = lc > 0.f ? g0 * __builtin_amdgcn_rcpf(lc) : 0.f;
        kr = *(const v4u*)(kcs); vr = *(const v4u*)(vcs);
        attn_commit(sh + AT_K0, sh + AT_V0, tid, kr, vr);
        __syncthreads();
#pragma unroll 1
        for (int ct = 0; ct < nct; ++ct) {
            const int cbuf = ct & 1;
            if (ct + 1 < nct) { kr = *(const v4u*)(kcs + (size_t)(64 * (ct + 1)) * 128); vr = *(const v4u*)(vcs + (size_t)(64 * (ct + 1)) * 128); }
            LAS const unsigned char* kb = sh + AT_K0 + cbuf * 8192; LAS const unsigned char* vb = sh + AT_V0 + cbuf * 8192;
            NSA_LOADQ();
            f32x16 t0 = attn_qk(kb, 0, L, qf), t1 = attn_qk(kb, 1, L, qf);
            score_near(t0, t1, L.h, lut, hd, tq - 31 - 1024 * ct, 16, 1 << 30, 255 - 64 * ct, true);
#pragma unroll
            for (int r = 0; r < 16; ++r) { t0[r] = __builtin_amdgcn_exp2f(t0[r] - mu) * il; t1[r] = __builtin_amdgcn_exp2f(t1[r] - mu) * il; }
            attn_pv(vb, 0, L, t0, o); attn_pv(vb, 1, L, t1, o);
            if (ct + 1 < nct) attn_commit(sh + AT_K0 + (cbuf ^ 1) * 8192, sh + AT_V0 + (cbuf ^ 1) * 8192, tid, kr, vr);
            __syncthreads();
        }
    }
    bf16* dst = (bf16*)(A.ws + WS_MIX) + tokq * 1024 + hd * 64;
#pragma unroll
    for (int dt = 0; dt < 2; ++dt)
#pragma unroll
        for (int rq = 0; rq < 4; ++rq) { v2u ov; ov.x = cvtpk(o[dt][4 * rq], o[dt][4 * rq + 1]); ov.y = cvtpk(o[dt][4 * rq + 2], o[dt][4 * rq + 3]); *(v2u*)(dst + 32 * dt + 8 * rq + 4 * L.h) = ov; }
}
#undef NSA_LOADQ

__device__ __forceinline__ v4u pack_f32x8(const float* p) { const f32x4 a = *(const f32x4*)p, b = *(const f32x4*)(p + 4); v4u w; w.x = pk2(a.x, a.y); w.y = pk2(a.z, a.w); w.z = pk2(b.x, b.y); w.w = pk2(b.z, b.w); return w; }
__device__ __forceinline__ void samp_load(const Args& A, int mode, int tile, int b, int g, int srow, int sch, v4u& kr, v4u& vr) {
    const bf16* PROJ = (const bf16*)(A.ws + WS_PROJ);
    kr = (v4u){0, 0, 0, 0}; vr = (v4u){0, 0, 0, 0};
    if (mode == 0) {
        const size_t off = ((size_t)(b * 512 + 64 * tile + srow) * 2 + g) * 64 + sch * 8;
        kr = *(const v4u*)((const bf16*)(A.ws + WS_KCS) + off); vr = *(const v4u*)((const bf16*)(A.ws + WS_VCS) + off);
    } else if (mode == 1) {
        if (tile < 128) { const int page = ((const int*)A.in[5])[b * 64 + (tile >> 1)]; const int row = (tile & 1) * 64 + srow;
            const float* p = A.in[2] + ((size_t)(page * 128 + row) * 4 + 2) * 128 + g * 64 + sch * 8; kr = pack_f32x8(p); vr = pack_f32x8(p + 128); }
        else if (srow < 4) { const bf16* p = PROJ + (size_t)(TP + b * 4 + srow) * NPROJ + C_KV + 2 * 128 + g * 64 + sch * 8; kr = *(const v4u*)p; vr = *(const v4u*)(p + 128); }
    } else {
        const int idx = 64 * tile + srow;
        if (idx < 512) { const float* p = A.in[3] + ((size_t)(b * 512 + idx) * 2) * 128 + g * 64 + sch * 8; kr = pack_f32x8(p); vr = pack_f32x8(p + 128); }
        else if (idx < 516) { const bf16* p = PROJ + (size_t)(TP + b * 4 + idx - 512) * NPROJ + C_WIN + g * 64 + sch * 8; kr = *(const v4u*)p; vr = *(const v4u*)(p + 128); }
    }
}
__device__ __forceinline__ void samp_stage_tile(const Args& A, int mode, int tile, int b, int g, int lane, LAS unsigned char* kb, LAS unsigned char* vb) {
#pragma unroll 1
    for (int i0 = 0; i0 < 8; i0 += 2) {
        v4u kr[2], vr[2];
#pragma unroll
        for (int i = 0; i < 2; ++i) samp_load(A, mode, tile, b, g, (lane >> 3) + 8 * (i0 + i), lane & 7, kr[i], vr[i]);
#pragma unroll
        for (int i = 0; i < 2; ++i) { const int row = (lane >> 3) + 8 * (i0 + i), ch = lane & 7;
            *(LAS v4u*)(kb + row * 128 + ((ch ^ ((row >> 1) & 7)) << 4)) = kr[i];
            *(LAS v4u*)(vb + row * 128 + ((ch ^ (((row >> 1) & 1) << 2)) << 4)) = vr[i]; }
    }
}
__device__ __forceinline__ void samp_unit(const Frame& F, const Args& A, LAS unsigned char* sh, int b, int g) {
    const bf16* PROJ = (const bf16*)(A.ws + WS_PROJ);
    const int lane = hw_lane(), w = F.wave, tid = w * 64 + lane;
    const AttnLane L = attn_lane(lane);
    const bool colok = L.r32 < 16;
    const int qi = (L.r32 >> 2) & 3, hd = g * 4 + (L.r32 & 3);
    const int pos = PAST + qi;
    const size_t tokq = (size_t)TP + b * 4 + qi;
    LAS unsigned char* kb = sh + w * 16384; LAS unsigned char* vb = kb + 8192;
    LAS float* lut = (LAS float*)(sh + AT_LUT);
    LAS float* impA = (LAS float*)(sh + HI_IMPA); LAS float* impB = (LAS float*)(sh + HI_IMPB);
    LAS unsigned long long* selm = (LAS unsigned long long*)(sh + HI_SEL);
    LAS float* scs = (LAS float*)(sh + HI_SCS);
    LAS int* tlist = (LAS int*)(sh + HI_TL);
    LAS float* xch = (LAS float*)(sh + HI_XCH);
    bf16x8 qf[4];
#pragma unroll
    for (int ks = 0; ks < 4; ++ks) qf[ks] = *(const bf16x8*)(PROJ + tokq * NPROJ + C_QN + hd * 64 + 16 * ks + 8 * L.h);
    const float bfar = lut[127 * 8 + hd];
    __syncthreads();
    for (int e = tid; e < 4 * 132; e += NWAVES * 64) { impA[e] = 0.f; impB[e] = 0.f; }
    f32x16 oc[2]; oc[0] = f32x16{}; oc[1] = f32x16{};
    {
        samp_stage_tile(A, 0, w, b, g, lane, kb, vb);
        f32x16 t0 = attn_qk(kb, 0, L, qf), t1 = attn_qk(kb, 1, L, qf);
        score_near(t0, t1, L.h, lut, hd, pos - 31 - 1024 * w, 16, 1 << 30, 511 - 64 * w, colok);
        const float tm = xmax32(fmaxf(max16(t0), max16(t1)));
        xch[(w * 64 + lane) * 4] = tm;
        __syncthreads();
        float M = -INFINITY;
#pragma unroll
        for (int ww = 0; ww < 8; ++ww) M = fmaxf(M, xch[(ww * 64 + lane) * 4]);
        const float mu = (M == -INFINITY) ? 0.f : M;
#pragma unroll
        for (int r = 0; r < 16; ++r) { t0[r] = __builtin_amdgcn_exp2f(t0[r] - mu); t1[r] = __builtin_amdgcn_exp2f(t1[r] - mu); }
        const float ps = xsum32(sum16(t0) + sum16(t1));
        xch[(w * 64 + lane) * 4 + 1] = ps;
        __syncthreads();
        float Lc = 0.f;
#pragma unroll
        for (int ww = 0; ww < 8; ++ww) Lc += xch[(ww * 64 + lane) * 4 + 1];
        const float il = Lc > 0.f ? __builtin_amdgcn_rcpf(Lc) : 0.f;
#pragma unroll
        for (int r = 0; r < 16; ++r) { t0[r] *= il; t1[r] *= il; }
        attn_pv(vb, 0, L, t0, oc); attn_pv(vb, 1, L, t1, oc);
#pragma unroll
        for (int hf = 0; hf < 2; ++hf) {
            float x[16];
#pragma unroll
            for (int r = 0; r < 16; ++r) { float v = hf ? t1[r] : t0[r]; v += __shfl_xor(v, 1); v += __shfl_xor(v, 2); x[r] = v; }
            if ((L.r32 & 3) == 0 && colok) {
#pragma unroll
                for (int rq = 0; rq < 4; ++rq) { const int jq = 16 * w + 8 * hf + 2 * rq + L.h;
                    impA[qi * 132 + jq] = 2.0f * (x[4 * rq] + x[4 * rq + 1] + x[4 * rq + 2]) + x[4 * rq + 3];
                    impB[qi * 132 + jq + 1] = x[4 * rq + 3]; }
            }
        }
    }
    __syncthreads();
    if (w == 0) {
        unsigned long long ulo = 0ull, uhi = 0ull;
#pragma unroll 1
        for (int q = 0; q < 4; ++q) {
            const int j0 = lane, j1 = lane + 64;
            const float s0 = (j0 == 0) ? 1e9f : impA[q * 132 + j0] + impB[q * 132 + j0];
            const float s1 = (j1 == 127) ? 1e9f : impA[q * 132 + j1] + impB[q * 132 + j1];
            scs[j0] = s0; scs[j1] = s1;
            LDS_WAIT(); asm volatile("" ::: "memory");
            int r0 = 0, r1 = 0;
#pragma unroll 8
            for (int jj = 0; jj < 128; ++jj) { const float ov = scs[jj]; r0 += ((ov > s0) || (ov == s0 && jj < j0)) ? 1 : 0; r1 += ((ov > s1) || (ov == s1 && jj < j1)) ? 1 : 0; }
            const unsigned long long mlo = __ballot(r0 < 15), mhi = __ballot(r1 < 15);
            if (lane == 0) { selm[2 * q] = mlo; selm[2 * q + 1] = mhi; }
            ulo |= mlo; uhi |= mhi;
            LDS_WAIT(); asm volatile("" ::: "memory");
        }
        if (lane == 0) { int n = 0; for (int j = 0; j < 64; ++j) if ((ulo >> j) & 1ull) tlist[1 + n++] = j; for (int j = 0; j < 64; ++j) if ((uhi >> j) & 1ull) tlist[1 + n++] = 64 + j; tlist[1 + n++] = 128; tlist[0] = n; }
    }
    __syncthreads();
    const unsigned long long mylo = selm[2 * qi], myhi = selm[2 * qi + 1];
    const int nsel = tlist[0];
    const bf16* gp = PROJ + tokq * NPROJ + C_GT + hd;
    const float g0 = __builtin_amdgcn_rcpf(1.0f + __expf(-bf2f(gp[0]))), g1 = __builtin_amdgcn_rcpf(1.0f + __expf(-bf2f(gp[8]))), g2 = __builtin_amdgcn_rcpf(1.0f + __expf(-bf2f(gp[16])));
#pragma unroll
    for (int r = 0; r < 16; ++r) { oc[0][r] *= g0; oc[1][r] *= g0; }
#pragma unroll 1
    for (int br = 0; br < 2; ++br) {
        const int nt = br == 0 ? nsel : 9;
        float m = -INFINITY, l = 0.f; f32x16 o[2]; o[0] = f32x16{}; o[1] = f32x16{};
#pragma unroll 1
        for (int it = w; it < nt; it += 8) {
            const int j = br == 0 ? tlist[1 + it] : it;
            samp_stage_tile(A, 1 + br, j, b, g, lane, kb, vb);
            f32x16 t0 = attn_qk(kb, 0, L, qf), t1 = attn_qk(kb, 1, L, qf);
            if (br == 0) {
                const bool selj = colok && (j >= 128 ? true : (j < 64 ? ((mylo >> j) & 1ull) : ((myhi >> (j - 64)) & 1ull)));
                if (j <= 125) score_far(t0, t1, selj ? bfar : -INFINITY);
                else score_near(t0, t1, L.h, lut, hd, pos - 64 * j, 1, 1 << 30, 64, selj);
            } else score_near(t0, t1, L.h, lut, hd, pos - (PAST - 512 + 64 * j), 1, 512, 516 - 64 * j, colok);
            attn_softmax_pv(vb, L, t0, t1, m, l, o);
        }
        l = xsum32(l);
        xch[(w * 64 + lane) * 4 + 2] = m; xch[(w * 64 + lane) * 4 + 3] = l;
        __syncthreads();
        float M = -INFINITY;
#pragma unroll
        for (int ww = 0; ww < 8; ++ww) M = fmaxf(M, xch[(ww * 64 + lane) * 4 + 2]);
        float Lt = 0.f;
#pragma unroll
        for (int ww = 0; ww < 8; ++ww) { const float mw = xch[(ww * 64 + lane) * 4 + 2]; Lt += (mw == -INFINITY) ? 0.f : xch[(ww * 64 + lane) * 4 + 3] * __builtin_amdgcn_exp2f(mw - M); }
        const float sc = (m == -INFINITY || !(Lt > 0.f)) ? 0.f : (br == 0 ? g1 : g2) * __builtin_amdgcn_exp2f(m - M) * __builtin_amdgcn_rcpf(Lt);
#pragma unroll
        for (int r = 0; r < 16; ++r) { oc[0][r] += sc * o[0][r]; oc[1][r] += sc * o[1][r]; }
        __syncthreads();
    }
    { LAS float* part = (LAS float*)kb;
#pragma unroll
      for (int r = 0; r < 16; ++r) { part[r * 64 + lane] = oc[0][r]; part[(16 + r) * 64 + lane] = oc[1][r]; } }
    __syncthreads();
    if (w == 0 && colok) {
        float res[32];
#pragma unroll
        for (int r = 0; r < 32; ++r) { float a = 0.f;
#pragma unroll
            for (int ww = 0; ww < 8; ++ww) a += ((LAS const float*)(sh + ww * 16384))[r * 64 + lane];
            res[r] = a; }
        bf16* dst = (bf16*)(A.ws + WS_MIX) + tokq * 1024 + hd * 64;
#pragma unroll
        for (int dt = 0; dt < 2; ++dt)
#pragma unroll
            for (int rq = 0; rq < 4; ++rq) { const int d0 = 32 * dt + 8 * rq + 4 * L.h;
                v2u ov; ov.x = cvtpk(res[16 * dt + 4 * rq], res[16 * dt + 4 * rq + 1]); ov.y = cvtpk(res[16 * dt + 4 * rq + 2], res[16 * dt + 4 * rq + 3]); *(v2u*)(dst + d0) = ov; }
    }
}

__device__ __forceinline__ float gelu_tanh(float x) { const float u = 0.7978845608028654f * (x + 0.044715f * x * x * x); const float t = 1.0f - 2.0f / (1.0f + __expf(2.0f * u)); return 0.5f * x * (1.0f + t); }
constexpr int CM_X = 0, CM_SB = 2064  , CM_H = 32 * CM_SB + 1024, CM_HCOL = 272  , CM_HT = 32 * CM_HCOL, CM_END = CM_H + 4 * CM_HT;
constexpr int NCU_P = 4 * 2 * 2 * 9, NCU_S = 32 * 2 * 2 * 17;
__device__ __forceinline__ int cmp_decode(int u) { if (u < NCU_S) return (1 << 20) | ((u / 68) << 12) | (((u / 34) & 1) << 9) | (((u / 17) & 1) << 8) | (u % 17); const int j = u - NCU_S; return ((j / 36) << 12) | (((j / 18) & 1) << 9) | (((j / 9) & 1) << 8) | (j % 9); }
#define CU_SAMPLE(c) ((c) >> 20)
#define CU_B(c) (((c) >> 12) & 255)
#define CU_SLOT(c) (((c) >> 9) & 1)
#define CU_G(c) (((c) >> 8) & 1)
#define CU_GRP(c) ((c) & 255)
__device__ __forceinline__ void cmp_issue(const Args& A, const int c, int tid, v4u (&R)[16]) {
    if (CU_SAMPLE(c)) {
        const float* cache = A.in[2]; const int* pt = (const int*)A.in[5] + CU_B(c) * 64;
#pragma unroll
        for (int i = 0; i < 16; ++i) { const int q = tid + 512 * i, row = q >> 4, pc = q & 15; int p = 16 * 31 * CU_GRP(c) + row; p = p < PAST ? p : PAST - 1;
            const int page = pt[p >> 7];
            R[i] = *(const v4u*)(cache + ((size_t)(page * 128 + (p & 127)) * 4 + CU_SLOT(c)) * 128 + CU_G(c) * 64 + pc * 4); }
    } else {
        const bf16* PROJ = (const bf16*)(A.ws + WS_PROJ);
#pragma unroll
        for (int i = 0; i < 8; ++i) { const int q = tid + 512 * i, row = q >> 3, pc = q & 7; int p = 16 * 31 * CU_GRP(c) + row; p = p < SEQ ? p : SEQ - 1;
            R[i] = *(const v4u*)(PROJ + ((size_t)CU_B(c) * SEQ + p) * NPROJ + C_KV + CU_SLOT(c) * 128 + CU_G(c) * 64 + pc * 8); }
#pragma unroll
        for (int i = 8; i < 16; ++i) R[i] = (v4u){0u, 0u, 0u, 0u};
    }
}
__device__ __forceinline__ void cmp_commit(LAS unsigned char* sh, const int c, int tid, const v4u (&R)[16]) {
    if (CU_SAMPLE(c)) {
#pragma unroll
        for (int i = 0; i < 16; ++i) { const int q = tid + 512 * i, row = q >> 4, pc = q & 15;
            v2u w; w.x = pk2(__uint_as_float(R[i].x), __uint_as_float(R[i].y)); w.y = pk2(__uint_as_float(R[i].z), __uint_as_float(R[i].w));
            *(LAS v2u*)(sh + CM_X + (row >> 4) * CM_SB + (row & 15) * 128 + pc * 8) = w; }
    } else {
#pragma unroll
        for (int i = 0; i < 8; ++i) { const int q = tid + 512 * i, row = q >> 3, pc = q & 7; *(LAS v4u*)(sh + CM_X + (row >> 4) * CM_SB + (row & 15) * 128 + pc * 16) = R[i]; }
    }
}
__device__ __forceinline__ void cmp_phase(const Frame& F, const Args& A, LAS unsigned char* sh) {
    const int lane = hw_lane(), w = F.wave, tid = w * 64 + lane, r32 = lane & 31, h = lane >> 5;
    const int j = w & 1, ht = (w >> 1) & 1, kh = w >> 2;
    v4u R[16];
    int u = F.vcu;
    if (u >= NCU_S + NCU_P) return;
    int cu = cmp_decode(u);
    cmp_issue(A, cu, tid, R);
    for (;;) {
        __syncthreads();
        cmp_commit(sh, cu, tid, R);
        __syncthreads();
        const int cur = cu;
        const int un = u + F.G; const bool more = un < NCU_S + NCU_P;
        cu = cmp_decode(more ? un : u); cmp_issue(A, cu, tid, R);
        { const bf16* wf = (const bf16*)(A.ws + WS_WC1) + ((size_t)(((CU_SLOT(cur) * 2 + j) * 2 + ht) * 64 + 32 * kh) * 64 + lane) * 8;
          LAS const unsigned char* xb = sh + CM_X + r32 * CM_SB + h * 16;
          f32x16 acc = {};
#pragma unroll 16
          for (int k2 = 0; k2 < 32; ++k2) { const int ks = 32 * kh + k2; const bf16x8 af = *(const bf16x8*)(wf + (size_t)k2 * 512);
              const bf16x8 bf = *(LAS const bf16x8*)(xb + (ks >> 2) * 128 + (ks & 3) * 32);
              acc = __builtin_amdgcn_mfma_f32_32x32x16_bf16(af, bf, acc, 0, 0, 0); }
          LAS unsigned char* hb = sh + CM_H + (j * 2 + kh) * CM_HT + r32 * CM_HCOL + (32 * ht + 4 * h) * 4;
#pragma unroll
          for (int rq = 0; rq < 4; ++rq) *(LAS f32x4*)(hb + 32 * rq) = (f32x4){acc[4 * rq], acc[4 * rq + 1], acc[4 * rq + 2], acc[4 * rq + 3]}; }
        __syncthreads();
        if (w < 2) {
            const float* c1p = (const float*)(A.ws + WS_C1) + CU_SLOT(cur) * 64;
            const bf16* W2 = (const bf16*)(A.ws + WS_WC2) + (size_t)CU_SLOT(cur) * 64 * 64;
            const int i1 = r32 < 31 ? r32 + 1 : 31;
            f32x16 oo = {};
#pragma unroll
            for (int ks = 0; ks < 4; ++ks) {
                const int hid0 = 16 * ks + 8 * h; float xv[8];
#pragma unroll
                for (int e4 = 0; e4 < 2; ++e4) {
                    const f32x4 a0 = *(LAS const f32x4*)(sh + CM_H + 0 * CM_HT + r32 * CM_HCOL + (hid0 + 4 * e4) * 4), a1 = *(LAS const f32x4*)(sh + CM_H + 1 * CM_HT + r32 * CM_HCOL + (hid0 + 4 * e4) * 4);
                    const f32x4 b0 = *(LAS const f32x4*)(sh + CM_H + 2 * CM_HT + i1 * CM_HCOL + (hid0 + 4 * e4) * 4), b1 = *(LAS const f32x4*)(sh + CM_H + 3 * CM_HT + i1 * CM_HCOL + (hid0 + 4 * e4) * 4);
                    const f32x4 cc = *(const f32x4*)(c1p + hid0 + 4 * e4);
#pragma unroll
                    for (int e = 0; e < 4; ++e) xv[4 * e4 + e] = gelu_tanh((a0[e] + a1[e]) + (b0[e] + b1[e]) + cc[e]);
                }
                v4u pw; pw.x = cvtpk(xv[0], xv[1]); pw.y = cvtpk(xv[2], xv[3]); pw.z = cvtpk(xv[4], xv[5]); pw.w = cvtpk(xv[6], xv[7]);
                const bf16x8 af = *(const bf16x8*)(W2 + (size_t)(32 * w + r32) * 64 + hid0);
                oo = __builtin_amdgcn_mfma_f32_32x32x16_bf16(af, __builtin_bit_cast(bf16x8, pw), oo, 0, 0, 0);
            }
            const int nsb = CU_SAMPLE(cur) ? 512 : 256, sb = 31 * CU_GRP(cur) + r32;
            if (r32 < 31 && sb < nsb - 1) {
                bf16* dst = (bf16*)(A.ws + (CU_SAMPLE(cur) ? (CU_SLOT(cur) ? WS_VCS : WS_KCS) : (CU_SLOT(cur) ? WS_VCP : WS_KCP))) + ((size_t)(CU_B(cur) * nsb + sb) * 2 + CU_G(cur)) * 64 + 32 * w + 4 * h;
#pragma unroll
                for (int rq = 0; rq < 4; ++rq) { v2u wv; wv.x = cvtpk(oo[4 * rq], oo[4 * rq + 1]); wv.y = cvtpk(oo[4 * rq + 2], oo[4 * rq + 3]); *(v2u*)(dst + 8 * rq) = wv; }
            }
        }
        if (!more) break;
        u = un;
    }
}

__device__ __forceinline__ float log_sigmoid(float x) { return fminf(x, 0.f) - __logf(1.0f + __expf(-fabsf(x))); }
constexpr int G_QE = 0, G_KE = 8192, G_KDT = 16384, G_V = 24576, G_ST = 40960, G_LR = 73728, G_SEG = 77824, G_DEC = 79872, G_END = 80128;
__device__ __forceinline__ int sw128(int row, int ch) { return row * 128 + ((ch ^ ((row >> 1) & 7)) << 4); }

__device__ __forceinline__ void gla_local(const Frame& F, const Args& A, LAS unsigned char* sh, int unit) {
    const int b = unit >> 6, hh = (unit >> 4) & 3, sc = unit & 15;
    const int lane = hw_lane(), w = F.wave, tid = w * 64 + lane, r32 = lane & 31, h = lane >> 5;
    const bf16* PROJ = (const bf16*)(A.ws + WS_PROJ);
    const size_t tok0 = (size_t)b * SEQ + 256 * sc;
    const int c = lane;
    float wg[16];
#pragma unroll
    for (int r = 0; r < 16; ++r) wg[r] = A.in[13][r * 256 + hh * 64 + c];
    const float bg = A.in[14][hh * 64 + c];
    float Bprev = 0.f;
    const int dvt = w >> 1, it = w & 1;
    f32x16 accS = {};
    const int i16 = lane & 15, tq = i16 >> 2, tp = i16 & 3, g1 = (lane >> 4) & 1;
    const int vcol = ((4 * (dvt ^ tq) + 2 * g1 + (tp >> 1)) << 4) + (tp & 1) * 8;
    __syncthreads();
#pragma unroll 1
    for (int n = 0; n < 4; ++n) {
        const size_t tb = tok0 + 64 * n;
        { const int trow = tid >> 3, pr = tid & 7; const unsigned lw = *(const unsigned*)(PROJ + (tb + trow) * NPROJ + C_LR + 2 * pr);
          LAS float* lr = (LAS float*)(sh + G_LR); lr[trow * 16 + 2 * pr] = bflo(lw); lr[trow * 16 + 2 * pr + 1] = bfhi(lw);
#pragma unroll
          for (int k2 = 0; k2 < 2; ++k2) { const int ch = pr * 2 + k2; const v4u vv = *(const v4u*)(PROJ + (tb + trow) * NPROJ + C_VG + hh * 128 + ch * 8);
              *(LAS v4u*)(sh + G_V + trow * 256 + ((ch ^ ((trow & 3) << 2)) << 4)) = vv; } }
        __syncthreads();
        float cum[8], qv[8], kv[8];
        { LAS const float* lr = (LAS const float*)(sh + G_LR); float run = 0.f;
#pragma unroll
          for (int k = 0; k < 8; ++k) { const int i = 8 * w + k; float x = bg;
#pragma unroll
              for (int r = 0; r < 16; ++r) x += lr[i * 16 + r] * wg[r];
              run += log_sigmoid(x) * (1.0f / 16.0f); cum[k] = run;
              qv[k] = 0.125f * bf2f(PROJ[(tb + i) * NPROJ + C_QG + hh * 64 + c]); kv[k] = bf2f(PROJ[(tb + i) * NPROJ + C_KG + hh * 64 + c]); }
          ((LAS float*)(sh + G_SEG))[w * 64 + c] = run; }
        __syncthreads();
        { LAS const float* seg = (LAS const float*)(sh + G_SEG); float pre = 0.f, tot = 0.f;
#pragma unroll
          for (int g_ = 0; g_ < 8; ++g_) { const float sv = seg[g_ * 64 + c]; tot += sv; if (g_ < w) pre += sv; }
          const float eB = __expf(Bprev);
          unsigned kdw[4];
#pragma unroll
          for (int k = 0; k < 8; ++k) { const int i = 8 * w + k; const float bb = pre + cum[k];
              const float qe = qv[k] * __expf(bb), ke = kv[k] * __expf(-bb), kd = kv[k] * __expf(tot - bb);
              *(LAS unsigned short*)(sh + G_QE + sw128(i, c >> 3) + (c & 7) * 2) = (unsigned short)f2bf(qe);
              *(LAS unsigned short*)(sh + G_KE + sw128(i, c >> 3) + (c & 7) * 2) = (unsigned short)f2bf(ke);
              ((bf16*)(A.ws + WS_QB))[(tb + i) * 256 + hh * 64 + c] = (bf16)f2bf(qe * eB);
              if (k & 1) kdw[k >> 1] |= f2bf(kd) << 16; else kdw[k >> 1] = f2bf(kd); }
          *(LAS v4u*)(sh + G_KDT + sw128(c, w)) = (v4u){kdw[0], kdw[1], kdw[2], kdw[3]};
          if (w == 0) ((LAS float*)(sh + G_DEC))[c] = __expf(tot);
          Bprev += tot; }
        __syncthreads();
        LAS const unsigned char* qeb = sh + G_QE; LAS const unsigned char* keb = sh + G_KE; LAS const unsigned char* vbase = sh + G_V;
        bf16x8 qfr[4];
#pragma unroll
        for (int ks = 0; ks < 4; ++ks) qfr[ks] = *(LAS const bf16x8*)(qeb + sw128(32 * it + r32, 2 * ks + h));
        f32x16 oT = {};
#pragma unroll
        for (int jt = 0; jt < 2; ++jt) {
            if (jt <= it) {
                f32x16 s = {};
#pragma unroll
                for (int ks = 0; ks < 4; ++ks) { const bf16x8 kf = *(LAS const bf16x8*)(keb + sw128(32 * jt + r32, 2 * ks + h)); s = __builtin_amdgcn_mfma_f32_32x32x16_bf16(kf, qfr[ks], s, 0, 0, 0); }
                if (jt == it) {
#pragma unroll
                    for (int r = 0; r < 16; ++r) { const int j = (r & 3) + 8 * (r >> 2) + 4 * h; if (j > r32) s[r] = 0.f; }
                }
#pragma unroll
                for (int s2 = 0; s2 < 2; ++s2) {
                    v4u pw; pw.x = cvtpk(s[8 * s2], s[8 * s2 + 1]); pw.y = cvtpk(s[8 * s2 + 2], s[8 * s2 + 3]); pw.z = cvtpk(s[8 * s2 + 4], s[8 * s2 + 5]); pw.w = cvtpk(s[8 * s2 + 6], s[8 * s2 + 7]);
                    const int row = 32 * jt + 16 * s2 + 4 * h + tq;
                    const s16x4 lo = vtr(vbase + row * 256 + vcol), hi = vtr(vbase + (row + 8) * 256 + vcol);
                    const bf16x8 vf = {lo[0], lo[1], lo[2], lo[3], hi[0], hi[1], hi[2], hi[3]};
                    oT = __builtin_amdgcn_mfma_f32_32x32x16_bf16(vf, __builtin_bit_cast(bf16x8, pw), oT, 0, 0, 0);
                }
            }
        }
        if (n > 0) {
            LAS const unsigned char* stb = sh + G_ST + (n & 1) * 16384;
#pragma unroll
            for (int ks = 0; ks < 4; ++ks) { const bf16x8 sf = *(LAS const bf16x8*)(stb + sw128(32 * dvt + r32, 2 * ks + h)); oT = __builtin_amdgcn_mfma_f32_32x32x16_bf16(sf, qfr[ks], oT, 0, 0, 0); }
        }
        { float* op = (float*)(A.ws + WS_OLOC) + (tb + 32 * it + r32) * 512 + hh * 128 + 32 * dvt + 4 * h;
#pragma unroll
          for (int rq = 0; rq < 4; ++rq) *(f32x4*)(op + 8 * rq) = (f32x4){oT[4 * rq], oT[4 * rq + 1], oT[4 * rq + 2], oT[4 * rq + 3]}; }
        { const float dec = ((LAS const float*)(sh + G_DEC))[32 * it + r32];
#pragma unroll
          for (int r = 0; r < 16; ++r) accS[r] *= dec;
#pragma unroll
          for (int ks = 0; ks < 4; ++ks) {
              const bf16x8 kdf = *(LAS const bf16x8*)(sh + G_KDT + sw128(32 * it + r32, 2 * ks + h));
              const int row = 16 * ks + 8 * h + tq;
              const s16x4 lo = vtr(vbase + row * 256 + vcol), hi = vtr(vbase + (row + 4) * 256 + vcol);
              const bf16x8 vf = {lo[0], lo[1], lo[2], lo[3], hi[0], hi[1], hi[2], hi[3]};
              accS = __builtin_amdgcn_mfma_f32_32x32x16_bf16(vf, kdf, accS, 0, 0, 0);
          }
          LAS unsigned char* stn = sh + G_ST + ((n + 1) & 1) * 16384; const int d = 32 * it + r32;
#pragma unroll
          for (int r = 0; r < 16; ++r) { const int dv = 32 * dvt + (r & 3) + 8 * (r >> 2) + 4 * h; *(LAS unsigned short*)(stn + sw128(dv, d >> 3) + (d & 7) * 2) = (unsigned short)f2bf(accS[r]); } }
        __syncthreads();
    }
    { float* up = (float*)(A.ws + WS_USC) + (size_t)unit * 8192; const int d = 32 * it + r32;
#pragma unroll
      for (int r = 0; r < 16; ++r) { const int dv = 32 * dvt + (r & 3) + 8 * (r >> 2) + 4 * h; up[dv * 64 + d] = accS[r]; }
      if (w == 0) ((float*)(A.ws + WS_DSC))[unit * 64 + c] = __expf(Bprev); }
}

__device__ __forceinline__ void gla_out(const Frame& F, const Args& A, LAS unsigned char* sh, int unit) {
    const int b = unit >> 6, hh = (unit >> 4) & 3, sc = unit & 15;
    const int lane = hw_lane(), w = F.wave, tid = w * 64 + lane, r32 = lane & 31, h = lane >> 5;
    const bf16* PROJ = (const bf16*)(A.ws + WS_PROJ);
    const size_t tok0 = (size_t)b * SEQ + 256 * sc;
    const int d4 = (tid & 15) * 4, dvr = tid >> 4;
    f32x4 S[4];
#pragma unroll
    for (int k = 0; k < 4; ++k) S[k] = (f32x4){0.f, 0.f, 0.f, 0.f};
    const float* U0 = (const float*)(A.ws + WS_USC) + (size_t)(unit - sc) * 8192; const float* D0 = (const float*)(A.ws + WS_DSC) + (size_t)(unit - sc) * 64;
#pragma unroll 1
    for (int s = 0; s < sc; ++s) { const f32x4 dd = *(const f32x4*)(D0 + s * 64 + d4);
#pragma unroll
        for (int k = 0; k < 4; ++k) { const f32x4 u = *(const f32x4*)(U0 + (size_t)s * 8192 + (32 * k + dvr) * 64 + d4); S[k] = S[k] * dd + u; } }
    __syncthreads();
#pragma unroll
    for (int k = 0; k < 4; ++k) { const int dv = 32 * k + dvr; v2u wv; wv.x = pk2(S[k].x, S[k].y); wv.y = pk2(S[k].z, S[k].w);
        *(LAS v2u*)(sh + sw128(dv, d4 >> 3) + (d4 & 7) * 2) = wv; }
    if (sc == 15) {
        const f32x4 dd = *(const f32x4*)(D0 + 15 * 64 + d4); float* op = A.out + O_GLAP + (size_t)(b * 4 + hh) * 8192;
#pragma unroll
        for (int k = 0; k < 4; ++k) { const int dv = 32 * k + dvr; const f32x4 u = *(const f32x4*)(U0 + (size_t)15 * 8192 + dv * 64 + d4); const f32x4 e = S[k] * dd + u;
            op[(d4 + 0) * 128 + dv] = e.x; op[(d4 + 1) * 128 + dv] = e.y; op[(d4 + 2) * 128 + dv] = e.z; op[(d4 + 3) * 128 + dv] = e.w; }
    }
    __syncthreads();
    const size_t tok = tok0 + 32 * w + r32;
    f32x16 acc[4];
#pragma unroll
    for (int t = 0; t < 4; ++t) acc[t] = f32x16{};
#pragma unroll
    for (int ks = 0; ks < 4; ++ks) { const bf16x8 qb = *(const bf16x8*)((const bf16*)(A.ws + WS_QB) + tok * 256 + hh * 64 + 16 * ks + 8 * h);
#pragma unroll
        for (int t = 0; t < 4; ++t) { const bf16x8 sf = *(LAS const bf16x8*)(sh + sw128(32 * t + r32, 2 * ks + h)); acc[t] = __builtin_amdgcn_mfma_f32_32x32x16_bf16(sf, qb, acc[t], 0, 0, 0); } }
    const float* ol = (const float*)(A.ws + WS_OLOC) + tok * 512 + hh * 128;
    float ss = 0.f;
#pragma unroll
    for (int t = 0; t < 4; ++t)
#pragma unroll
        for (int rq = 0; rq < 4; ++rq) { const f32x4 v = *(const f32x4*)(ol + 32 * t + 8 * rq + 4 * h);
#pragma unroll
            for (int e = 0; e < 4; ++e) { acc[t][4 * rq + e] += v[e]; ss += acc[t][4 * rq + e] * acc[t][4 * rq + e]; } }
    ss += __shfl_xor(ss, 32);
    const float rstd = 1.0f / sqrtf(ss * (1.0f / 128.0f) + EPS);
    const float* gn = A.in[15]; const bf16* gg = PROJ + tok * NPROJ + C_GG + hh * 128;
    bf16* dst = (bf16*)(A.ws + WS_MIX) + tok * 1024 + 512 + hh * 128;
#pragma unroll
    for (int t = 0; t < 4; ++t)
#pragma unroll
        for (int rq = 0; rq < 4; ++rq) { const int dv0 = 32 * t + 8 * rq + 4 * h; const f32x4 gnv = *(const f32x4*)(gn + dv0); const v2u gw = *(const v2u*)(gg + dv0);
            const float gv[4] = {bflo(gw.x), bfhi(gw.x), bflo(gw.y), bfhi(gw.y)}; float y[4];
#pragma unroll
            for (int e = 0; e < 4; ++e) y[e] = acc[t][4 * rq + e] * rstd * gnv[e] * gv[e] * __builtin_amdgcn_rcpf(1.0f + __expf(-gv[e]));
            v2u ov; ov.x = cvtpk(y[0], y[1]); ov.y = cvtpk(y[2], y[3]); *(v2u*)(dst + dv0) = ov; }
}

__device__ __forceinline__ void gla_sample(const Frame& F, const Args& A, LAS unsigned char* sh, int unit) {
    const int b = unit >> 2, hh = unit & 3, tid = F.wave * 64 + hw_lane();
    const bf16* PROJ = (const bf16*)(A.ws + WS_PROJ);
    LAS float* la = (LAS float*)sh;
    LAS float* qs = la + 256;
    LAS float* ks = qs + 256;
    LAS float* op = ks + 256;
    LAS float* of = op + 2048;
    __syncthreads();
    if (tid < 256) { const int t = tid >> 6, c = tid & 63; const size_t tok = (size_t)TP + b * 4 + t; float x = A.in[14][hh * 64 + c];
#pragma unroll
        for (int r = 0; r < 16; ++r) x += bf2f(PROJ[tok * NPROJ + C_LR + r]) * A.in[13][r * 256 + hh * 64 + c];
        la[tid] = __expf(log_sigmoid(x) * (1.0f / 16.0f)); qs[tid] = 0.125f * bf2f(PROJ[tok * NPROJ + C_QG + hh * 64 + c]); ks[tid] = bf2f(PROJ[tok * NPROJ + C_KG + hh * 64 + c]); }
    __syncthreads();
    const int dv = tid & 127, cg = tid >> 7;
    const float* s0 = A.in[4] + (size_t)(b * 4 + hh) * 8192;
    float S[16];
#pragma unroll
    for (int k = 0; k < 16; ++k) S[k] = s0[(16 * cg + k) * 128 + dv];
#pragma unroll
    for (int t = 0; t < 4; ++t) { const float vv = bf2f(PROJ[((size_t)TP + b * 4 + t) * NPROJ + C_VG + hh * 128 + dv]); float o = 0.f;
#pragma unroll
        for (int k = 0; k < 16; ++k) { const int c = 16 * cg + k; S[k] = la[t * 64 + c] * S[k] + ks[t * 64 + c] * vv; o += qs[t * 64 + c] * S[k]; }
        op[(cg * 4 + t) * 128 + dv] = o; }
    float* so = A.out + O_GLAS + (size_t)(b * 4 + hh) * 8192;
#pragma unroll
    for (int k = 0; k < 16; ++k) so[(16 * cg + k) * 128 + dv] = S[k];
    __syncthreads();
    { const int t = tid >> 7; of[t * 128 + dv] = (op[(0 * 4 + t) * 128 + dv] + op[(1 * 4 + t) * 128 + dv]) + (op[(2 * 4 + t) * 128 + dv] + op[(3 * 4 + t) * 128 + dv]); }
    __syncthreads();
    { const int t = tid >> 7; float ss = 0.f;
      for (int k = 0; k < 128; ++k) { const float v = of[t * 128 + k]; ss += v * v; }
      const float rstd = 1.0f / sqrtf(ss * (1.0f / 128.0f) + EPS); const size_t tok = (size_t)TP + b * 4 + t;
      const float gv = bf2f(PROJ[tok * NPROJ + C_GG + hh * 128 + dv]);
      const float y = of[t * 128 + dv] * rstd * A.in[15][dv] * gv * __builtin_amdgcn_rcpf(1.0f + __expf(-gv));
      ((bf16*)(A.ws + WS_MIX))[tok * 1024 + 512 + hh * 128 + dv] = (bf16)f2bf(y); }
}

#ifdef PROBE_PHASE
#define PREP(k) ((PROBE_PHASE) == (k) ? 2 : 1)
#else
#define PREP(k) 1
#endif
__device__ __forceinline__ void phase2(const Frame& F, const Args& A) {
    LAS unsigned char* sh = F.lds;
#ifndef SKIP_CMP
    _Pragma("unroll 1") for (int rep = 0; rep < PREP(21); ++rep) cmp_phase(F, A, sh);
#endif
    #ifndef SKIP_GLAL
    _Pragma("unroll 1") for (int rep = 0; rep < PREP(22); ++rep) for (int u = F.vcu; u < 256; u += F.G) gla_local(F, A, sh, u);
#endif
    #ifndef SKIP_GLAS
    _Pragma("unroll 1") for (int rep = 0; rep < PREP(24); ++rep) for (int u = F.vcu; u < 128; u += F.G) gla_sample(F, A, sh, u);
#endif
    __syncthreads();
    attn_fill_lut((LAS float*)(sh + AT_LUT), A.in[24], F.tid);
    __syncthreads();
    _Pragma("unroll 1") for (int rep = 0; rep < PREP(23); ++rep) for (int p = F.vcu; p < 256; p += F.G) { const int bg = p >> 5, s = p & 31;
#ifndef SKIP_WIN
 win_unit<0>(F, A, sh, bg >> 1, bg & 1, 63 - s); win_unit<0>(F, A, sh, bg >> 1, bg & 1, s);
#ifdef WIN_VAR
 win_unit<WIN_VAR>(F, A, sh, bg >> 1, bg & 1, 63 - s); win_unit<WIN_VAR>(F, A, sh, bg >> 1, bg & 1, s);
#endif
#endif
 }
}
__device__ __forceinline__ void phase3(const Frame& F, const Args& A) {
    LAS unsigned char* sh = F.lds;
    #ifndef SKIP_GLAO
    _Pragma("unroll 1") for (int rep = 0; rep < PREP(31); ++rep) for (int u = F.vcu; u < 256; u += F.G) gla_out(F, A, sh, u);
#endif
    __syncthreads();
    attn_fill_lut((LAS float*)(sh + AT_LUT), A.in[24], F.tid);
    __syncthreads();
    { gu32* qh = (gu32*)(A.ws + WS_CTL) + CW_Q3 + 64 * (F.vcu >> 5); LAS int* slot = (LAS int*)(sh + HI_Q);
      const int bg = (F.vcu >> 5) & 7;
      for (;;) {
          __syncthreads();
          if (F.wave == 0 && hw_lane() == 0) *slot = (int)__hip_atomic_fetch_add(qh, 1u, __ATOMIC_RELAXED, __HIP_MEMORY_SCOPE_AGENT);
          __syncthreads();
          const int idx = *slot;
          if (idx >= 72 * PREP(33)) break;
          const int k = idx % 72;
          if (k < 8) {
#ifndef SKIP_SAMP
              const int u = bg * 8 + k; samp_unit(F, A, sh, u >> 1, u & 1);
#endif
          } else {
#ifndef SKIP_NSA
              nsa_unit(F, A, sh, bg >> 1, bg & 1, 71 - k);
#endif
          }
      } }
}

template <class Epi>
__device__ __forceinline__ void skinny_phase(const Frame& F, const bf16* Act, int lda, const bf16* Bt, int K, int ncolgrp, const Epi& E) {
    const int lane = hw_lane(), w = F.wave, c16 = lane & 15, kg = lane >> 4;
    const int tg = w & 1, kq = w >> 1, kq_len = K / 4;
    LAS f32x4* xs = (LAS f32x4*)F.lds;
    for (int job = blockIdx.x; job < 4 * ncolgrp; job += F.G) {
        const int cg = job >> 2, tok = TP + 32 * (job & 3) + 16 * tg + c16;
        const bf16* ap = Bt + (size_t)(16 * cg + c16) * K + kq * kq_len + 8 * kg;
        const bf16* bp = Act + (size_t)tok * lda + kq * kq_len + 8 * kg;
        f32x4 acc = {0.f, 0.f, 0.f, 0.f};
#pragma unroll 8
        for (int ks = 0; ks < kq_len / 32; ++ks) { const bf16x8 af = *(const bf16x8*)(ap + 32 * ks), bf = *(const bf16x8*)(bp + 32 * ks); acc = __builtin_amdgcn_mfma_f32_16x16x32_bf16(af, bf, acc, 0, 0, 0); }
        __syncthreads();
        xs[w * 64 + lane] = acc;
        __syncthreads();
        if (kq == 0) { const f32x4 v = (xs[tg * 64 + lane] + xs[(2 + tg) * 64 + lane]) + (xs[(4 + tg) * 64 + lane] + xs[(6 + tg) * 64 + lane]); E(v, tok, 16 * cg + 4 * kg, kg); }
    }
}
struct SkInProj { bf16* proj; float* out;
    __device__ __forceinline__ void operator()(f32x4 v, int tok, int col, int kg) const {
        if (col < 512) v = v * 0.125f;
        v2u w; w.x = cvtpk(v[0], v[1]); w.y = cvtpk(v[2], v[3]); *(v2u*)(proj + (size_t)tok * NPROJ + col) = w;
        if (col >= C_KV && col < C_WIN) *(f32x4*)(out + O_KV + (size_t)tok * 512 + (col - C_KV)) = v;
        else if (col >= C_WIN && col < C_GT) { const int rs = tok - TP, b = rs >> 2, i = rs & 3; *(f32x4*)(out + O_WINS + ((size_t)(b * 512 + 508 + i) * 256 + (col - C_WIN))) = v; }
    } };
struct SkResid { const float* base; float* hout; bf16* hb; float* rowss;
    __device__ __forceinline__ void operator()(f32x4 v, int tok, int col, int kg) const {
        v = v + *(const f32x4*)(base + (size_t)(tok - TP) * 1024 + col);
        *(f32x4*)(hout + (size_t)tok * 1024 + col) = v;
        v2u w; w.x = cvtpk(v[0], v[1]); w.y = cvtpk(v[2], v[3]); *(v2u*)(hb + (size_t)tok * 1024 + col) = w;
        float ss = (v[0] * v[0] + v[1] * v[1]) + (v[2] * v[2] + v[3] * v[3]); ss += __shfl_xor(ss, 16); ss += __shfl_xor(ss, 32);
        if (kg == 0) atomicAdd(rowss + tok, ss);
    } };
struct SkBf { bf16* O; int ldc;
    __device__ __forceinline__ void operator()(f32x4 v, int tok, int col, int kg) const { v2u w; w.x = cvtpk(v[0], v[1]); w.y = cvtpk(v[2], v[3]); *(v2u*)(O + (size_t)tok * ldc + col) = w; } };
struct SkPleGate { const float* h2; const bf16* ple; const float* rowss2; float* y; float* rowss3;
    __device__ __forceinline__ void operator()(f32x4 a, int tok, int col, int kg) const {
        const float rstd = __builtin_amdgcn_rsqf(rowss2[tok] * (1.0f / 1024.0f) + EPS);
        const v2u pw = *(const v2u*)(ple + (size_t)tok * 1024 + col); const f32x4 b = *(const f32x4*)(h2 + (size_t)tok * 1024 + col);
        const float pv[4] = {bflo(pw.x), bfhi(pw.x), bflo(pw.y), bfhi(pw.y)}; f32x4 v;
#pragma unroll
        for (int e = 0; e < 4; ++e) v[e] = b[e] + pv[e] * __builtin_amdgcn_rcpf(1.0f + __expf(-a[e] * rstd));
        *(f32x4*)(y + (size_t)tok * 1024 + col) = v;
        float ss = (v[0] * v[0] + v[1] * v[1]) + (v[2] * v[2] + v[3] * v[3]); ss += __shfl_xor(ss, 16); ss += __shfl_xor(ss, 32);
        if (kg == 0) atomicAdd(rowss3 + tok, ss);
    } };

typedef const __attribute__((address_space(4))) Args* ArgsP;
__device__ __forceinline__ Args load_args() {
    Args r{};
#if defined(__HIP_DEVICE_COMPILE__)
    ArgsP p = (ArgsP)__builtin_amdgcn_kernarg_segment_ptr(); asm volatile("" : "+s"(p));
#pragma unroll
    for (int i = 0; i < 26; ++i) r.in[i] = p->in[i];
    r.out = p->out; r.ws = p->ws; r.ph_lo = p->ph_lo; r.ph_hi = p->ph_hi;
#endif
    return r;
}
__global__ void __launch_bounds__(NWAVES * 64, 2) mega_fwd(Args args_unused) {
    extern __shared__ __attribute__((aligned(16))) unsigned char lds_raw[];
    Frame F;
    F.lds = (LAS unsigned char*)lds_raw;
    F.wave = __builtin_amdgcn_readfirstlane((int)threadIdx.x >> 6); F.lane = hw_lane(); F.tid = F.wave * 64 + F.lane;
    F.G = gridDim.x; { const int bx = blockIdx.x; F.vcu = (F.G % 8 == 0) ? (bx % 8) * (F.G / 8) + bx / 8 : bx; }
    int lo, hi; unsigned char* ws;
    { const Args a0 = load_args(); lo = a0.ph_lo; hi = a0.ph_hi; ws = a0.ws; }
    gu32* ctl = (gu32*)(ws + WS_CTL);
    volatile LAS unsigned* MISC = (volatile LAS unsigned*)(F.lds + MISC_OFF);
    for (int u = F.tid; u < (LDS_BYTES - RING_BYTES) / 4; u += NWAVES * 64) ((LAS unsigned*)(F.lds + RING_BYTES))[u] = 0u;
    __syncthreads();
    const bool multi = (hi - lo) > 1;
    XcdBarrier bar; bar.bar = (unsigned*)(ctl + CW_BAR); bar.x = 0; bar.st = nullptr;
    if (multi) bar = xcd_barrier_post((unsigned*)(ctl + CW_BAR), MISC + 8, F.tid);
#define IN(k) (lo <= (k) && (k) < hi)
#ifdef PROBE_PHASE
#define NREP(k) ((PROBE_PHASE) == (k) ? 2 : 1)
#else
#define NREP(k) 1
#endif
    float* dummy_rowss = (float*)(ws + WS_END);
#define SEAM(k) do { if (IN(k) && IN((k) + 1)) { F.lane = hw_lane(); F.tid = F.wave * 64 + F.lane; xcd_barrier(bar, F.tid); } } while (0)
#define REFRESH() do { F.lane = hw_lane(); F.tid = F.wave * 64 + F.lane; } while (0)

    if (IN(0)) { REFRESH(); const Args args = load_args(); _Pragma("unroll 1") for (int rep = 0; rep < NREP(0); ++rep) { __syncthreads(); p0_prologue(F, args); } } SEAM(0);
    if (IN(1)) { REFRESH(); const Args args = load_args(); unsigned char* ws = args.ws;
        pg8::Gemm g{(const pg8::bf16_t*)(ws + WS_XN), (const pg8::bf16_t*)(ws + WS_WIN), TP, NPROJ, 1024}; pg8::StaticOrder S; S.init(TP, NPROJ, F.G, (int)blockIdx.x);
        pg8::EpiInProj E{(pg8::bf16_t*)(ws + WS_PROJ), args.out};
        _Pragma("unroll 1") for (int rep = 0; rep < NREP(1); ++rep) pg8::gemm_phase<pg8::EpiInProj, pg8::StaticOrder, true, true>(F.lds, g, S, E, F.tid);
        skinny_phase(F, (const bf16*)(ws + WS_XN), 1024, (const bf16*)(ws + WS_WIN), 1024, (NIN + 15) / 16, SkInProj{(bf16*)(ws + WS_PROJ), args.out});
    } SEAM(1);
    if (IN(2)) { REFRESH(); const Args args = load_args(); phase2(F, args); } SEAM(2);
    if (IN(3)) { REFRESH(); const Args args = load_args(); phase3(F, args); } SEAM(3);
    if (IN(4)) { REFRESH(); const Args args = load_args(); unsigned char* ws = args.ws; float* rowss1 = (float*)(ws + WS_ROWSS);
        { pg8::Gemm g{(const pg8::bf16_t*)(ws + WS_MIX), (const pg8::bf16_t*)(ws + WS_WO), TP, 1024, 1024}; pg8::StaticOrder S; S.init(TP, 1024, F.G, (int)blockIdx.x);
          _Pragma("unroll 1") for (int rep = 0; rep < NREP(4); ++rep) { pg8::EpiResid E{args.in[0], args.in[1], (float*)(ws + WS_H1), (pg8::bf16_t*)(ws + WS_H1B), rep ? dummy_rowss : rowss1};
          pg8::gemm_phase<pg8::EpiResid, pg8::StaticOrder, true, true>(F.lds, g, S, E, F.tid); } }
        skinny_phase(F, (const bf16*)(ws + WS_MIX), 1024, (const bf16*)(ws + WS_WO), 1024, 64, SkResid{args.in[1], (float*)(ws + WS_H1), (bf16*)(ws + WS_H1B), rowss1});
        skinny_phase(F, (const bf16*)(ws + WS_PPLE), 256, (const bf16*)(ws + WS_WPLE), 256, 64, SkBf{(bf16*)(ws + WS_PLEB), 1024});
    } SEAM(4);
    if (IN(5)) { REFRESH(); const Args args = load_args(); unsigned char* ws = args.ws; float* rowss1 = (float*)(ws + WS_ROWSS);
        pg8::Gemm g{(const pg8::bf16_t*)(ws + WS_H1B), (const pg8::bf16_t*)(ws + WS_WGU), MPAD, NGU, 1024}; pg8::StaticOrder S; S.init(MPAD, NGU, F.G, (int)blockIdx.x);
        pg8::EpiGateUp E{(pg8::bf16_t*)(ws + WS_ACT), rowss1};
        _Pragma("unroll 1") for (int rep = 0; rep < NREP(5); ++rep) pg8::gemm_phase<pg8::EpiGateUp, pg8::StaticOrder, true, true>(F.lds, g, S, E, F.tid);
        { constexpr int NU5 = (MPAD / 256) * (NGU / 256); const int first_idle = NU5 - (NU5 / 256) * 256;
          pg8::Gemm g2{(const pg8::bf16_t*)(ws + WS_PPLE), (const pg8::bf16_t*)(ws + WS_WPLE), TP, 1024, 256}; pg8::IdleOrder S2; S2.init(TP, 1024, F.G, (int)blockIdx.x, first_idle);
          pg8::EpiBf E2{(pg8::bf16_t*)(ws + WS_PLEB), 1024};
          REFRESH();
          pg8::gemm_phase<pg8::EpiBf, pg8::IdleOrder, true, true>(F.lds, g2, S2, E2, F.tid); }
    } SEAM(5);
    if (IN(6)) { REFRESH(); const Args args = load_args(); unsigned char* ws = args.ws; float* rowss2 = (float*)(ws + WS_ROWSS) + MPAD;
        pg8::Gemm g{(const pg8::bf16_t*)(ws + WS_ACT), (const pg8::bf16_t*)(ws + WS_WDN), TP, 1024, DFF}; pg8::StaticOrder S; S.init(TP, 1024, F.G, (int)blockIdx.x);
        _Pragma("unroll 1") for (int rep = 0; rep < NREP(6); ++rep) { pg8::EpiResid E{(const float*)(ws + WS_H1), (const float*)(ws + WS_H1) + (size_t)TP * 1024, (float*)(ws + WS_H2), (pg8::bf16_t*)(ws + WS_H2B), rep ? dummy_rowss : rowss2};
        pg8::gemm_phase<pg8::EpiResid, pg8::StaticOrder, true, true>(F.lds, g, S, E, F.tid); }
        skinny_phase(F, (const bf16*)(ws + WS_ACT), DFF, (const bf16*)(ws + WS_WDN), DFF, 64, SkResid{(const float*)(ws + WS_H1) + (size_t)TP * 1024, (float*)(ws + WS_H2), (bf16*)(ws + WS_H2B), rowss2});
    } SEAM(6);
    if (IN(7)) { REFRESH(); const Args args = load_args(); unsigned char* ws = args.ws; float* rowss2 = (float*)(ws + WS_ROWSS) + MPAD; float* rowss3 = rowss2 + MPAD;
        pg8::Gemm g{(const pg8::bf16_t*)(ws + WS_H2B), (const pg8::bf16_t*)(ws + WS_WPG), TP, 1024, 1024}; pg8::StaticOrder S; S.init(TP, 1024, F.G, (int)blockIdx.x);
        _Pragma("unroll 1") for (int rep = 0; rep < NREP(7); ++rep) { pg8::EpiPleGate E{(const float*)(ws + WS_H2), (const pg8::bf16_t*)(ws + WS_PLEB), rowss2, args.out + O_Y, rep ? dummy_rowss : rowss3};
        pg8::gemm_phase<pg8::EpiPleGate, pg8::StaticOrder, true, true>(F.lds, g, S, E, F.tid); }
        skinny_phase(F, (const bf16*)(ws + WS_H2B), 1024, (const bf16*)(ws + WS_WPG), 1024, 64, SkPleGate{(const float*)(ws + WS_H2), (const bf16*)(ws + WS_PLEB), rowss2, args.out + O_Y, rowss3});
    } SEAM(7);
    if (IN(8)) { REFRESH(); const Args args = load_args(); unsigned char* ws = args.ws; float* rowss3 = (float*)(ws + WS_ROWSS) + 2 * MPAD;
        const int gw = F.vcu * NWAVES + F.wave, NGW = F.G * NWAVES; const GAS f32x4* gr = (const GAS f32x4*)args.in[25] + F.lane;
        for (int m = gw; m < MTOT; m += NGW) { GAS f32x4* yr = (GAS f32x4*)(args.out + O_Y + (size_t)m * 1024) + F.lane; const float rstd = 1.0f / sqrtf(rowss3[m] * (1.0f / 1024.0f) + EPS);
#pragma unroll
            for (int j = 0; j < 4; ++j) { const f32x4 v = yr[64 * j], gg = gr[64 * j]; yr[64 * j] = (f32x4){v.x * rstd * gg.x, v.y * rstd * gg.y, v.z * rstd * gg.z, v.w * rstd * gg.w}; } }
    }
#undef IN
#undef SEAM
#undef REFRESH
}

extern "C" void kernel_launch(void* const* d_in, const int* in_sizes, int n_in, void* d_out, int out_size, void* d_ws, size_t ws_size, hipStream_t stream) {
    static int grid = 0;
    if (grid == 0) {
        if (n_in != 26 || (size_t)out_size != O_END || ws_size < WS_END + (32u << 20)) { fprintf(stderr, "kernel_launch: unexpected shapes: n_in %d out %d ws %zu\n", n_in, out_size, ws_size); grid = -1; return; }
        int dev = 0, cus = 0, per_cu = 0;
        if (hipGetDevice(&dev) != hipSuccess || hipDeviceGetAttribute(&cus, hipDeviceAttributeMultiprocessorCount, dev) != hipSuccess) { grid = -1; return; }
        if (hipFuncSetAttribute((const void*)mega_fwd, hipFuncAttributeMaxDynamicSharedMemorySize, LDS_BYTES) != hipSuccess) { fprintf(stderr, "kernel_launch: hipFuncSetAttribute failed\n"); grid = -1; return; }
        if (hipOccupancyMaxActiveBlocksPerMultiprocessor(&per_cu, (const void*)mega_fwd, NWAVES * 64, LDS_BYTES) != hipSuccess || per_cu < 1) { fprintf(stderr, "kernel_launch: occupancy query says %d blocks per CU\n", per_cu); grid = -1; return; }
        (void)hipGetLastError();
        grid = cus;
    }
    if (grid < 0) return;
    (void)hipMemsetAsync((char*)d_ws + WS_CTL, 0, CTL_ZERO_BYTES, stream);
    Args a{};
    for (int i = 0; i < 26; ++i) a.in[i] = (const float*)d_in[i];
    a.out = (float*)d_out; a.ws = (unsigned char*)d_ws;
#ifndef N_LAUNCH_SPLIT
    a.ph_lo = 0; a.ph_hi = 9;
    hipLaunchKernelGGL(mega_fwd, dim3(grid), dim3(NWAVES * 64), LDS_BYTES, stream, a);
#else
    for (int p = 0; p < 9; ++p) { a.ph_lo = p; a.ph_hi = p + 1; hipLaunchKernelGGL(mega_fwd, dim3(grid), dim3(NWAVES * 64), LDS_BYTES, stream, a); }
#endif
}
```
